# Optimizing an MI355X kernel written in HIP

```python
import math
import jax, jax.numpy as jnp
from jax import lax
import numpy as np

D_MODEL = 1024
BATCH = 4
SEQ = 4096
DEPTH = 4

CTX_LEN = 256
GRID_W = 64
N_HEADS = 8
HEAD_DIM = 64
ATT_W = N_HEADS * HEAD_DIM
WIN_ROWS = 8
WIN_COLS = 16
HY_W = 512
HY_ORDER = 2
HY_SHORT = 3
HY_EMB = 33
HY_BANDS = (HY_EMB - 1) // 2
HY_FILT = 64
HY_DECAY_TARGET = 1e-2
HY_FAST_PCT = 0.3
HY_SLOW_PCT = 1.5
HY_MAX_DECAY = math.log(HY_DECAY_TARGET) / HY_FAST_PCT
HY_MIN_DECAY = math.log(HY_DECAY_TARGET) / HY_SLOW_PCT
HY_DECAY_SHIFT = 0.05
PROJ_W = 3 * ATT_W + 3 * HY_W + 2 * D_MODEL
D_FF = 2816
N_EXPERTS = 8
TOP_K = 2
N_DENSE = (DEPTH + 1) // 2
N_MOE = DEPTH // 2
N_MOD = 6
EPS = 1e-6

kernel_name = "hybrid_na_hyena_moe_dit_block"


def rmsnorm(x, g):
    xf = x.astype(jnp.float32)
    y = xf * lax.rsqrt(jnp.mean(xf * xf, axis=-1, keepdims=True) + EPS)
    return (y * g.astype(jnp.float32)).astype(x.dtype)


def modulate(h, shift, scale):
    return h * (1.0 + scale) + shift


def split_proj(p):
    idx = [ATT_W, 2 * ATT_W, 3 * ATT_W, 3 * ATT_W + 3 * HY_W, 3 * ATT_W + 3 * HY_W + D_MODEL]
    return jnp.split(p, idx, axis=-1)


def heads(t):
    return t.reshape(*t.shape[:-1], N_HEADS, HEAD_DIM)


def neighbourhood_attention(q, k, v, k_ctx, v_ctx, rpb):
    B, L, H, Dh = q.shape
    rows = L // GRID_W
    kr = min(WIN_ROWS, rows)
    qg = q.reshape(B, rows, GRID_W, H, Dh) * (Dh ** -0.5)
    kg = k.reshape(B, rows, GRID_W, H, Dh)
    vg = v.reshape(B, rows, GRID_W, H, Dh)
    r = jnp.arange(rows)
    row_idx = jnp.clip(r - kr // 2, 0, rows - kr)[:, None] + jnp.arange(kr)[None, :]
    k_blk = jnp.take(kg, row_idx, axis=1)
    v_blk = jnp.take(vg, row_idx, axis=1)
    col = jnp.arange(GRID_W)
    c0 = jnp.clip(col - WIN_COLS // 2, 0, GRID_W - WIN_COLS)
    valid = (col[None, :] >= c0[:, None]) & (col[None, :] < c0[:, None] + WIN_COLS)
    dr = row_idx - r[:, None] + (WIN_ROWS - 1)
    dc = jnp.clip(col[None, :] - col[:, None] + (WIN_COLS - 1), 0, 2 * WIN_COLS - 2)
    bias = rpb[:, dr[:, None, :, None], dc[None, :, None, :]]
    s_loc = jnp.einsum('brqhd,brikhd->bhrqik', qg, k_blk).astype(jnp.float32)
    s_loc = jnp.where(valid[:, None, :], s_loc + bias.astype(jnp.float32), -jnp.inf)
    s_loc = s_loc.reshape(B, H, rows, GRID_W, kr * GRID_W)
    s_ctx = jnp.einsum('brqhd,bchd->bhrqc', qg, k_ctx).astype(jnp.float32)
    p = jax.nn.softmax(jnp.concatenate([s_loc, s_ctx], axis=-1), axis=-1).astype(q.dtype)
    p_loc = p[..., :kr * GRID_W].reshape(B, H, rows, GRID_W, kr, GRID_W)
    p_ctx = p[..., kr * GRID_W:]
    o = (jnp.einsum('bhrqik,brikhd->brqhd', p_loc, v_blk)
         + jnp.einsum('bhrqc,bchd->brqhd', p_ctx, v_ctx))
    return o.reshape(B, L, H * Dh)


def context_attention(q, k, v):
    B, C, H, Dh = q.shape
    s = jnp.einsum('bqhd,bkhd->bhqk', q * (Dh ** -0.5), k).astype(jnp.float32)
    p = jax.nn.softmax(s, axis=-1).astype(q.dtype)
    return jnp.einsum('bhqk,bkhd->bqhd', p, v).reshape(B, C, H * Dh)


def short_conv(u, w, b):
    L = u.shape[1]
    pad = HY_SHORT // 2
    up = jnp.pad(u, ((0, 0), (pad, HY_SHORT - 1 - pad), (0, 0)))
    return sum(up[:, j:j + L] * w[j] for j in range(HY_SHORT)) + b


def implicit_filters(L, w1, b1, w2, b2, w3, freq):
    f32 = jnp.float32
    pos = jnp.arange(L, dtype=f32)
    t = pos / max(L - 1, 1)
    bands = jnp.linspace(1e-4, HY_BANDS - 1, HY_BANDS, dtype=f32)
    ang = (2.0 * math.pi / L) * pos[:, None] * bands[None, :]
    z = jnp.concatenate([t[:, None], jnp.cos(ang), -jnp.sin(ang)], axis=-1)
    a = jnp.sin(freq[0].astype(f32) * (z @ w1.astype(f32) + b1.astype(f32)))
    a = jnp.sin(freq[1].astype(f32) * (a @ w2.astype(f32) + b2.astype(f32)))
    h = a @ w3.astype(f32)
    dist = jnp.abs(pos - L // 2) * (2.0 / L)
    rates = jnp.abs(jnp.linspace(HY_MIN_DECAY, HY_MAX_DECAY, HY_ORDER * HY_W, dtype=f32))
    h = h * (jnp.exp(-dist[:, None] * rates[None, :]) + HY_DECAY_SHIFT)
    return h.reshape(L, HY_ORDER, HY_W).transpose(1, 0, 2)


def fft_long_conv(u, h, bias):
    L = u.shape[1]
    uf = u.astype(jnp.float32)
    spec = jnp.fft.rfft(uf, n=2 * L, axis=1) * jnp.fft.rfft(h, n=2 * L, axis=0)[None]
    y = jnp.fft.irfft(spec, n=2 * L, axis=1)[:, L // 2:L // 2 + L]
    return (y + uf * bias.astype(jnp.float32)).astype(u.dtype)


def hyena(u, conv_w, conv_b, w1, b1, w2, b2, w3, freq, bias):
    L = u.shape[1]
    u = short_conv(u, conv_w, conv_b)
    v, x1, x2 = jnp.split(u, 3, axis=-1)
    h = implicit_filters(L, w1, b1, w2, b2, w3, freq)
    z = x1 * fft_long_conv(v, h[0], bias[0])
    return x2 * fft_long_conv(z, h[1], bias[1])


def merge(o_att, o_hy, ga, gb, w_pa, w_pb, w_o):
    return (jax.nn.sigmoid(ga) * (o_att @ w_pa) + jax.nn.sigmoid(gb) * (o_hy @ w_pb)) @ w_o


def swiglu(h, w1, w3, w2):
    return (jax.nn.silu(h @ w1) * (h @ w3)) @ w2


def channel_mixer(h, l, ffn_w1, ffn_w3, ffn_w2, moe_router, moe_w1, moe_w3, moe_w2):
    i = l // 2
    if l % 2 == 0:
        return swiglu(h, ffn_w1[i], ffn_w3[i], ffn_w2[i])
    logits = (h @ moe_router[i]).astype(jnp.float32)
    top_val, top_idx = lax.top_k(logits, TOP_K)
    gate = jax.nn.softmax(top_val, axis=-1)
    weight = jnp.einsum('...k,...ke->...e', gate,
                        jax.nn.one_hot(top_idx, N_EXPERTS, dtype=jnp.float32)).astype(h.dtype)
    out = jnp.zeros_like(h)
    for e in range(N_EXPERTS):
        out = out + weight[..., e:e + 1] * swiglu(h, moe_w1[i, e], moe_w3[i, e], moe_w2[i, e])
    return out


def setup_inputs(seed: int = 0) -> dict:
    key = jax.random.key(seed)
    ks = jax.random.split(key, 32)
    f32 = jnp.float32

    def nrm(k, shape, s):
        return s * jax.random.normal(k, shape, f32)

    D = D_MODEL
    return {
        'x': nrm(ks[0], (BATCH, SEQ, D), 1.0),
        'c': nrm(ks[1], (BATCH, D), 1.0),
        'ctx': nrm(ks[2], (BATCH, CTX_LEN, D), 1.0),
        'c_ctx': nrm(ks[3], (D,), 1.0),
        'w_mod': nrm(ks[4], (DEPTH, D, N_MOD * D), 0.5 * D ** -0.5),
        'b_mod': nrm(ks[5], (DEPTH, N_MOD * D), 0.02),
        'norm1_g': 1.0 + nrm(ks[6], (DEPTH, D), 0.02),
        'norm2_g': 1.0 + nrm(ks[7], (DEPTH, D), 0.02),
        'w_in': nrm(ks[8], (DEPTH, D, PROJ_W), D ** -0.5),
        'rpb': nrm(ks[9], (DEPTH, N_HEADS, 2 * WIN_ROWS - 1, 2 * WIN_COLS - 1), 0.1),
        'hy_conv_w': nrm(ks[10], (DEPTH, HY_SHORT, 3 * HY_W), HY_SHORT ** -0.5),
        'hy_conv_b': nrm(ks[11], (DEPTH, 3 * HY_W), 0.02),
        'hy_w1': nrm(ks[12], (DEPTH, HY_EMB, HY_FILT), HY_EMB ** -0.5),
        'hy_b1': nrm(ks[13], (DEPTH, HY_FILT), 0.1),
        'hy_w2': nrm(ks[14], (DEPTH, HY_FILT, HY_FILT), HY_FILT ** -0.5),
        'hy_b2': nrm(ks[15], (DEPTH, HY_FILT), 0.1),
        'hy_w3': nrm(ks[16], (DEPTH, HY_FILT, HY_ORDER * HY_W), 0.05 * HY_FILT ** -0.5),
        'hy_freq': 1.0 + nrm(ks[17], (DEPTH, 2, HY_FILT), 0.02),
        'hy_bias': nrm(ks[18], (DEPTH, HY_ORDER, HY_W), 0.5),
        'w_pa': nrm(ks[19], (DEPTH, ATT_W, D), ATT_W ** -0.5),
        'w_pb': nrm(ks[20], (DEPTH, HY_W, D), HY_W ** -0.5),
        'w_o': nrm(ks[21], (DEPTH, D, D), D ** -0.5),
        'ffn_w1': nrm(ks[22], (N_DENSE, D, D_FF), D ** -0.5),
        'ffn_w3': nrm(ks[23], (N_DENSE, D, D_FF), D ** -0.5),
        'ffn_w2': nrm(ks[24], (N_DENSE, D_FF, D), D_FF ** -0.5),
        'moe_router': nrm(ks[25], (N_MOE, D, N_EXPERTS), D ** -0.5),
        'moe_w1': nrm(ks[26], (N_MOE, N_EXPERTS, D, D_FF), D ** -0.5),
        'moe_w3': nrm(ks[27], (N_MOE, N_EXPERTS, D, D_FF), D ** -0.5),
        'moe_w2': nrm(ks[28], (N_MOE, N_EXPERTS, D_FF, D), D_FF ** -0.5),
        'final_g': 1.0 + nrm(ks[29], (D,), 0.02),
    }


def reference(x, c, ctx, c_ctx, w_mod, b_mod, norm1_g, norm2_g, w_in, rpb, hy_conv_w, hy_conv_b,
              hy_w1, hy_b1, hy_w2, hy_b2, hy_w3, hy_freq, hy_bias, w_pa, w_pb, w_o,
              ffn_w1, ffn_w3, ffn_w2, moe_router, moe_w1, moe_w3, moe_w2, final_g):
    s_lat = jax.nn.silu(c)[:, None, :]
    s_ctx = jax.nn.silu(c_ctx)[None, None, :]
    xl, xc = x, ctx
    for l in range(DEPTH):
        last = l == DEPTH - 1
        mod_l = jnp.split(s_lat @ w_mod[l] + b_mod[l], N_MOD, axis=-1)
        mod_c = jnp.split(s_ctx @ w_mod[l] + b_mod[l], N_MOD, axis=-1)
        hy_l = (hy_conv_w[l], hy_conv_b[l], hy_w1[l], hy_b1[l], hy_w2[l], hy_b2[l], hy_w3[l],
                hy_freq[l], hy_bias[l])

        hc = modulate(rmsnorm(xc, norm1_g[l]), mod_c[0], mod_c[1])
        if last:
            k_c, v_c = jnp.split(hc @ w_in[l, :, ATT_W:3 * ATT_W], 2, axis=-1)
        else:
            q_c, k_c, v_c, u_c, ga_c, gb_c = split_proj(hc @ w_in[l])
            mix_c = merge(context_attention(heads(q_c), heads(k_c), heads(v_c)), hyena(u_c, *hy_l),
                          ga_c, gb_c, w_pa[l], w_pb[l], w_o[l])

        hl = modulate(rmsnorm(xl, norm1_g[l]), mod_l[0], mod_l[1])
        q_l, k_l, v_l, u_l, ga_l, gb_l = split_proj(hl @ w_in[l])
        o_att = neighbourhood_attention(heads(q_l), heads(k_l), heads(v_l), heads(k_c), heads(v_c), rpb[l])
        o_hy = hyena(u_l, *hy_l)
        xl = xl + mod_l[2] * merge(o_att, o_hy, ga_l, gb_l, w_pa[l], w_pb[l], w_o[l])

        hl = modulate(rmsnorm(xl, norm2_g[l]), mod_l[3], mod_l[4])
        xl = xl + mod_l[5] * channel_mixer(hl, l, ffn_w1, ffn_w3, ffn_w2, moe_router, moe_w1, moe_w3, moe_w2)
        if not last:
            xc = xc + mod_c[2] * mix_c
            hc = modulate(rmsnorm(xc, norm2_g[l]), mod_c[3], mod_c[4])
            xc = xc + mod_c[5] * channel_mixer(hc, l, ffn_w1, ffn_w3, ffn_w2, moe_router, moe_w1, moe_w3, moe_w2)
    return rmsnorm(xl, final_g)
```

```cpp
#include <hip/hip_runtime.h>
#include <cstdio>
#include <cstdint>

#define LAS __attribute__((address_space(3)))
#define GAS __attribute__((address_space(1)))
typedef unsigned short bf16_t;
typedef short bf16x8 __attribute__((ext_vector_type(8)));
typedef float f32x4 __attribute__((ext_vector_type(4)));
typedef float f32x2 __attribute__((ext_vector_type(2)));
typedef unsigned u32x4 __attribute__((ext_vector_type(4)));
typedef unsigned u32x2 __attribute__((ext_vector_type(2)));

constexpr int D = 1024, NB = 4, SEQ = 4096, DEPTH = 4, CTX = 256;
constexpr int TL = NB * SEQ, TC = NB * CTX, T = TL + TC;
constexpr int PW = 5120, FF = 2816, NE = 8, HYW = 512;
constexpr int PQ = 0, PK = 512, PV = 1024, PHY = 1536, PGA = 3072, PGB = 4096;
constexpr float EPS = 1e-6f;

constexpr size_t MiB = 1u << 20;
constexpr size_t WS_CTL = 0, CTL_ZERO_BYTES = 1 * MiB;
constexpr size_t WS_MOD = 1 * MiB;
constexpr size_t WS_RW = 2 * MiB;
constexpr size_t WS_WIN = 4 * MiB;
constexpr size_t WS_WPA = 44 * MiB;
constexpr size_t WS_WPB = 48 * MiB;
constexpr size_t WS_WO = 52 * MiB;
constexpr size_t WS_W13D = 60 * MiB;
constexpr size_t WS_W2D = 82 * MiB;
constexpr size_t WS_W13M = 93 * MiB;
constexpr size_t WS_W2M = 269 * MiB;
constexpr size_t WS_X = 357 * MiB;
constexpr size_t WS_H = 425 * MiB;
constexpr size_t WS_P = 459 * MiB;
constexpr size_t WS_OATT = 629 * MiB;
constexpr size_t WS_OHY = 646 * MiB;
constexpr size_t WS_B = 663 * MiB;
constexpr size_t WS_Z = WS_B + 51 * MiB;
constexpr size_t WS_FL = 748 * MiB;
constexpr size_t WS_FC = 812 * MiB;
constexpr size_t WS_END = 816 * MiB;

constexpr int LDS_BYTES = 147456;
constexpr int NWAVES = 8, NTHR = 512;

#define LDS_WAIT() asm volatile("s_waitcnt lgkmcnt(0)" ::: "memory")
#define VM_WAIT() asm volatile("s_waitcnt vmcnt(0)" ::: "memory")
__device__ __forceinline__ float bf2f(unsigned b) { return __uint_as_float(b << 16); }
__device__ __forceinline__ float bflo(unsigned w) { return __uint_as_float(w << 16); }
__device__ __forceinline__ float bfhi(unsigned w) { return __uint_as_float(w & 0xffff0000u); }
__device__ __forceinline__ unsigned cvt_pk_bf16(float lo, float hi) { unsigned r; asm volatile("v_cvt_pk_bf16_f32 %0, %1, %2" : "=v"(r) : "v"(lo), "v"(hi)); return r; }
__device__ __forceinline__ float wave_sum(float v) {
#pragma unroll
    for (int o = 1; o < 64; o <<= 1) v += __shfl_xor(v, o);
    return v;
}
__device__ __forceinline__ float sigmoidf_(float x) { return 1.f / (1.f + __expf(-x)); }
__device__ __forceinline__ float sin_rev(float r) { return __builtin_amdgcn_sinf(__builtin_amdgcn_fractf(r)); }
__device__ __forceinline__ float sin_rad(float x) { return sin_rev(x * 0.15915494309189535f); }

namespace pg8 {
constexpr int BM = 256, BK = 64, HALF = 128, HTB = HALF * BK * 2, STAGE_BYTES = 8 * HTB, NXCD = 8, WGM = 8;
__host__ __device__ __forceinline__ int lds_byte(int r, int c) { const int st = (r >> 4) * 2 + (c >> 5), rr = r & 15, cc = c & 31, ob = rr * 64 + cc * 2; return st * 1024 + (ob ^ (((ob >> 9) & 1) << 5)); }
__host__ __device__ __forceinline__ void stage_rc(int b, int& R, int& C) { const int st = b / 1024, sb = b % 1024, swz = sb ^ (((sb >> 9) & 1) << 5); R = (st >> 1) * 16 + swz / 64; C = (st & 1) * 32 + (swz % 64) / 2; }
__host__ __device__ __forceinline__ int perm32(int rho) { const int n = rho >> 4, i = rho & 15; return 8 * (i >> 2) + 4 * n + (i & 3); }

struct Unit { int pm, pn; const char* a; const char* b; };
struct Gemm { int K, lda, ldb; };

struct StaticOrder {
    int nM, nN, nwg, G, c; const char* A; const char* B; size_t astep, bstep;
    __device__ void init(const void* A_, int lda, const void* B_, int ldb, int M, int N, int G_, int c_) {
        nM = M / BM; nN = N / BM; nwg = nM * nN; G = G_; c = c_; A = (const char*)A_; B = (const char*)B_; astep = (size_t)BM * lda * 2; bstep = (size_t)BM * ldb * 2; }
    __device__ bool next(int i, Unit& u) const {
        const long L = (long)i * G + c; if (L >= nwg) return false;
        int wgid = (int)L; { const int q = nwg / NXCD, r = nwg % NXCD, xcd = wgid % NXCD, off = wgid / NXCD; wgid = (xcd < r ? xcd * (q + 1) : r * (q + 1) + (xcd - r) * q) + off; }
        const int nig = WGM * nN, gid = wgid / nig, fm = gid * WGM, gsz = (nM - fm) < WGM ? (nM - fm) : WGM;
        u.pm = fm + ((wgid % nig) % gsz); u.pn = (wgid % nig) / gsz; u.a = A + (size_t)u.pm * astep; u.b = B + (size_t)u.pn * bstep; return true;
    }
    __device__ __forceinline__ void a_ready(const Unit&) const {}
    __device__ __forceinline__ void done(const Unit&) const {}
};

template <class Epi, class Sched, bool ALIGN_EPI = true, bool SP2 = true>
__device__ __forceinline__ void gemm_phase(LAS unsigned char* lds, const Gemm g, const Sched& S, const Epi& E) {
    const int tid = threadIdx.x, wid = __builtin_amdgcn_readfirstlane(tid >> 6), lane = tid & 63, wr = wid >> 2, wc = wid & 3, fr = lane & 15, fq = lane >> 4;
    const int K = g.K, nt = K / BK;
    unsigned voffA[2], voffB[2];
#pragma unroll
    for (int i = 0; i < 2; ++i) { int R, C; stage_rc(tid * 16 + i * 8192, R, C); const int Rb = Epi::PERM ? ((R & ~31) + perm32(R & 31)) : R;
        voffA[i] = (unsigned)(R * g.lda + C) * 2u; voffB[i] = (unsigned)(Rb * g.ldb + C) * 2u; }
    const size_t kstep = (size_t)(BK * 2);
    const size_t hstepA = (size_t)HALF * g.lda * 2, hstepB = (size_t)HALF * g.ldb * 2;
    const unsigned ldsw = (unsigned)wid * 1024u;
    const int aoff = lds_byte(wr * 64 + fr, fq * 8), boff = lds_byte(wc * 32 + fr, fq * 8);
#define PG8_SA(b, h) (((b) * 2 + (h)) * HTB)
#define PG8_SB(b, h) ((4 + (b) * 2 + (h)) * HTB)
#define PG8_STAGE(bufoff, gbase, voff) do { _Pragma("unroll") for (int _i = 0; _i < 2; ++_i) \
        __builtin_amdgcn_global_load_lds((const unsigned*)((const char*)(gbase) + (voff)[_i]), (LAS unsigned*)(lds + (bufoff) + ldsw + _i * 8192), 16, 0, 0); } while (0)
#define PG8_LDA(dst, b, h) do { _Pragma("unroll") for (int m = 0; m < 4; ++m) _Pragma("unroll") for (int k = 0; k < 2; ++k) dst[m][k] = *(const LAS bf16x8*)(lds + PG8_SA(b, h) + aoff + m * 2048 + k * 1024); } while (0)
#define PG8_LDB(dst, b, h) do { _Pragma("unroll") for (int n = 0; n < 2; ++n) _Pragma("unroll") for (int k = 0; k < 2; ++k) dst[n][k] = *(const LAS bf16x8*)(lds + PG8_SB(b, h) + boff + n * 2048 + k * 1024); } while (0)
#define PG8_MMA(ai, bj, At, Bt) do { __builtin_amdgcn_s_setprio(1); _Pragma("unroll") for (int m = 0; m < 4; ++m) _Pragma("unroll") for (int n = 0; n < 2; ++n) _Pragma("unroll") for (int k = 0; k < 2; ++k) \
        acc[ai][bj][m][n] = __builtin_amdgcn_mfma_f32_16x16x32_bf16(Bt[n][k], At[m][k], acc[ai][bj][m][n], 0, 0, 0); __builtin_amdgcn_s_setprio(0); } while (0)
#define PG8_WAIT_V(n) asm volatile("s_waitcnt vmcnt(" #n ")" ::: "memory")
#define PG8_WAIT_L(n) asm volatile("s_waitcnt lgkmcnt(" #n ")" ::: "memory")
#define PG8_BAR __builtin_amdgcn_s_barrier()
#define PG8_SCHED __builtin_amdgcn_sched_barrier(0)
    Unit cur, nxt; int ui = 0;
    if (!S.next(0, cur)) return;
    f32x4 acc[2][2][4][2];
#pragma unroll
    for (int a = 0; a < 2; ++a)
#pragma unroll
        for (int b = 0; b < 2; ++b)
#pragma unroll
            for (int m = 0; m < 4; ++m)
#pragma unroll
                for (int n = 0; n < 2; ++n) acc[a][b][m][n] = (f32x4){0.f, 0.f, 0.f, 0.f};
    bf16x8 At[4][2], B0[2][2], B1[2][2];
    const char* cA = cur.a; const char* cB = cur.b;
    S.a_ready(cur);
    if constexpr (SP2) {
        PG8_STAGE(PG8_SB(0, 0), cB, voffB); PG8_STAGE(PG8_SB(0, 1), cB + hstepB, voffB); PG8_STAGE(PG8_SA(0, 0), cA, voffA); PG8_STAGE(PG8_SA(0, 1), cA + hstepA, voffA);
        if (wr == 1) PG8_BAR;
        PG8_WAIT_V(2); PG8_BAR;
        PG8_STAGE(PG8_SB(1, 0), cB + kstep, voffB); PG8_STAGE(PG8_SA(1, 0), cA + kstep, voffA); PG8_STAGE(PG8_SB(1, 1), cB + hstepB + kstep, voffB);
        PG8_WAIT_V(6); PG8_BAR;
    } else {
        PG8_STAGE(PG8_SB(0, 0), cB, voffB); PG8_STAGE(PG8_SA(0, 0), cA, voffA); PG8_STAGE(PG8_SB(0, 1), cB + hstepB, voffB); PG8_STAGE(PG8_SA(0, 1), cA + hstepA, voffA);
        if (wr == 1) PG8_BAR;
        PG8_WAIT_V(4); PG8_BAR;
        PG8_STAGE(PG8_SB(1, 0), cB + kstep, voffB); PG8_STAGE(PG8_SA(1, 0), cA + kstep, voffA); PG8_STAGE(PG8_SB(1, 1), cB + hstepB + kstep, voffB);
        PG8_WAIT_V(6); PG8_BAR;
    }
    for (;;) {
        const bool has_next = S.next(ui + 1, nxt);
        const char* nA = has_next ? nxt.a : cA; const char* nB = has_next ? nxt.b : cB;
        for (int t = 0; t < nt; t += 2) {
            const bool last = (t == nt - 2);
            const char* a1 = cA + (size_t)(t + 1) * kstep;
            const char* a2 = last ? nA : cA + (size_t)(t + 2) * kstep; const char* b2 = last ? nB : cB + (size_t)(t + 2) * kstep;
            const char* a3 = a2 + kstep; const char* b3 = b2 + kstep;
            if (last && has_next) S.a_ready(nxt);
            if constexpr (SP2) {
            PG8_LDB(B0, 0, 0); PG8_LDB(B1, 0, 1); PG8_SCHED; PG8_LDA(At, 0, 0); PG8_STAGE(PG8_SA(1, 1), a1 + hstepA, voffA);
            PG8_WAIT_V(8); PG8_WAIT_L(0); PG8_BAR; PG8_MMA(0, 0, At, B0); PG8_MMA(0, 1, At, B1); PG8_BAR; PG8_SCHED;
            PG8_LDA(At, 0, 1); PG8_STAGE(PG8_SB(0, 0), b2, voffB); PG8_STAGE(PG8_SB(0, 1), b2 + hstepB, voffB); PG8_STAGE(PG8_SA(0, 0), a2, voffA);
            PG8_WAIT_V(8); PG8_WAIT_L(0); PG8_BAR; PG8_MMA(1, 0, At, B0); PG8_MMA(1, 1, At, B1); PG8_BAR; PG8_SCHED;
            PG8_LDB(B0, 1, 0); PG8_LDB(B1, 1, 1); PG8_SCHED; PG8_LDA(At, 1, 0); PG8_STAGE(PG8_SA(0, 1), a2 + hstepA, voffA);
            PG8_WAIT_V(8); PG8_WAIT_L(0); PG8_BAR; PG8_MMA(0, 0, At, B0); PG8_MMA(0, 1, At, B1); PG8_BAR; PG8_SCHED;
            PG8_LDA(At, 1, 1); PG8_STAGE(PG8_SB(1, 0), b3, voffB); PG8_STAGE(PG8_SB(1, 1), b3 + hstepB, voffB); PG8_STAGE(PG8_SA(1, 0), a3, voffA);
            PG8_WAIT_V(8); PG8_WAIT_L(0); PG8_BAR; PG8_MMA(1, 0, At, B0); PG8_MMA(1, 1, At, B1); PG8_BAR; PG8_SCHED;
            } else {
            PG8_LDB(B0, 0, 0); PG8_SCHED; PG8_LDA(At, 0, 0); PG8_STAGE(PG8_SA(1, 1), a1 + hstepA, voffA);
            PG8_WAIT_L(8); PG8_BAR; PG8_WAIT_L(0); PG8_MMA(0, 0, At, B0); PG8_BAR; PG8_SCHED;
            PG8_LDB(B1, 0, 1); PG8_STAGE(PG8_SB(0, 0), b2, voffB);
            PG8_BAR; PG8_WAIT_L(0); PG8_MMA(0, 1, At, B1); PG8_BAR;
            PG8_LDA(At, 0, 1); PG8_STAGE(PG8_SA(0, 0), a2, voffA);
            PG8_BAR; PG8_WAIT_L(0); PG8_MMA(1, 0, At, B0); PG8_BAR; PG8_SCHED;
            PG8_STAGE(PG8_SB(0, 1), b2 + hstepB, voffB);
            PG8_WAIT_V(6); PG8_BAR; PG8_MMA(1, 1, At, B1); PG8_BAR;
            PG8_LDB(B0, 1, 0); PG8_SCHED; PG8_LDA(At, 1, 0); PG8_STAGE(PG8_SA(0, 1), a2 + hstepA, voffA);
            PG8_WAIT_L(8); PG8_BAR; PG8_WAIT_L(0); PG8_MMA(0, 0, At, B0); PG8_BAR; PG8_SCHED;
            PG8_LDB(B1, 1, 1); PG8_STAGE(PG8_SB(1, 0), b3, voffB);
            PG8_BAR; PG8_WAIT_L(0); PG8_MMA(0, 1, At, B1); PG8_BAR;
            PG8_LDA(At, 1, 1); PG8_STAGE(PG8_SA(1, 0), a3, voffA);
            PG8_BAR; PG8_WAIT_L(0); PG8_MMA(1, 0, At, B0); PG8_BAR; PG8_SCHED;
            PG8_STAGE(PG8_SB(1, 1), b3 + hstepB, voffB);
            PG8_WAIT_V(6); PG8_BAR; PG8_MMA(1, 1, At, B1); PG8_BAR;
            }
        }
        if constexpr (ALIGN_EPI) { if (wr == 0) PG8_BAR; }
        E(acc, cur, wr, wc, fr, fq); S.done(cur);
        if (!has_next) break;
#pragma unroll
        for (int a = 0; a < 2; ++a)
#pragma unroll
            for (int b = 0; b < 2; ++b)
#pragma unroll
                for (int m = 0; m < 4; ++m)
#pragma unroll
                    for (int n = 0; n < 2; ++n) acc[a][b][m][n] = (f32x4){0.f, 0.f, 0.f, 0.f};
        cur = nxt; cA = nA; cB = nB; ++ui;
        if constexpr (ALIGN_EPI) { if (wr == 1) PG8_BAR; }
    }
    PG8_WAIT_V(0);
    if constexpr (!ALIGN_EPI) { if (wr == 0) PG8_BAR; }
    PG8_BAR;
#undef PG8_SA
#undef PG8_SB
#undef PG8_STAGE
#undef PG8_LDA
#undef PG8_LDB
#undef PG8_MMA
#undef PG8_WAIT_V
#undef PG8_WAIT_L
#undef PG8_BAR
#undef PG8_SCHED
}
}

typedef f32x4 AccT[2][2][4][2];
struct EpiStoreBf16 {
    static constexpr bool PERM = true;
    bf16_t* O; int ldc;
    __device__ __forceinline__ void operator()(const AccT& acc, const pg8::Unit& u, int wr, int wc, int fr, int fq) const {
        const int row0 = u.pm * 256 + wr * 64 + fr, col0 = u.pn * 256 + wc * 32 + 8 * fq;
#pragma unroll
        for (int ai = 0; ai < 2; ++ai)
#pragma unroll
            for (int m = 0; m < 4; ++m) { bf16_t* rowp = O + (size_t)(row0 + ai * 128 + m * 16) * ldc + col0;
#pragma unroll
                for (int bj = 0; bj < 2; ++bj) { const f32x4 v0 = acc[ai][bj][m][0], v1 = acc[ai][bj][m][1];
                    u32x4 w; w.x = cvt_pk_bf16(v0[0], v0[1]); w.y = cvt_pk_bf16(v0[2], v0[3]); w.z = cvt_pk_bf16(v1[0], v1[1]); w.w = cvt_pk_bf16(v1[2], v1[3]);
                    *(u32x4*)(rowp + bj * 128) = w; } }
    }
};
struct EpiMerge1 {
    static constexpr bool PERM = true;
    float* t1; const bf16_t* P;
    __device__ __forceinline__ void operator()(const AccT& acc, const pg8::Unit& u, int wr, int wc, int fr, int fq) const {
        const int row0 = u.pm * 256 + wr * 64 + fr, col0 = u.pn * 256 + wc * 32 + 8 * fq;
#pragma unroll
        for (int ai = 0; ai < 2; ++ai)
#pragma unroll
            for (int m = 0; m < 4; ++m) { const int r = row0 + ai * 128 + m * 16;
#pragma unroll
                for (int bj = 0; bj < 2; ++bj) { const int c = col0 + bj * 128;
                    const u32x4 g = *(const u32x4*)(P + (size_t)r * PW + PGA + c);
                    const f32x4 v0 = acc[ai][bj][m][0], v1 = acc[ai][bj][m][1];
                    f32x4 o0, o1;
                    o0[0] = sigmoidf_(bflo(g.x)) * v0[0]; o0[1] = sigmoidf_(bfhi(g.x)) * v0[1]; o0[2] = sigmoidf_(bflo(g.y)) * v0[2]; o0[3] = sigmoidf_(bfhi(g.y)) * v0[3];
                    o1[0] = sigmoidf_(bflo(g.z)) * v1[0]; o1[1] = sigmoidf_(bfhi(g.z)) * v1[1]; o1[2] = sigmoidf_(bflo(g.w)) * v1[2]; o1[3] = sigmoidf_(bfhi(g.w)) * v1[3];
                    float* tp = t1 + (size_t)r * D + c; *(f32x4*)tp = o0; *(f32x4*)(tp + 4) = o1; } }
    }
};
struct EpiMerge2 {
    static constexpr bool PERM = true;
    const float* t1; const bf16_t* P; bf16_t* O;
    __device__ __forceinline__ void operator()(const AccT& acc, const pg8::Unit& u, int wr, int wc, int fr, int fq) const {
        const int row0 = u.pm * 256 + wr * 64 + fr, col0 = u.pn * 256 + wc * 32 + 8 * fq;
#pragma unroll
        for (int ai = 0; ai < 2; ++ai)
#pragma unroll
            for (int m = 0; m < 4; ++m) { const int r = row0 + ai * 128 + m * 16;
#pragma unroll
                for (int bj = 0; bj < 2; ++bj) { const int c = col0 + bj * 128;
                    const u32x4 g = *(const u32x4*)(P + (size_t)r * PW + PGB + c);
                    const float* tp = t1 + (size_t)r * D + c; const f32x4 a0 = *(const f32x4*)tp, a1 = *(const f32x4*)(tp + 4);
                    const f32x4 v0 = acc[ai][bj][m][0], v1 = acc[ai][bj][m][1];
                    f32x4 o0, o1;
                    o0[0] = a0[0] + sigmoidf_(bflo(g.x)) * v0[0]; o0[1] = a0[1] + sigmoidf_(bfhi(g.x)) * v0[1]; o0[2] = a0[2] + sigmoidf_(bflo(g.y)) * v0[2]; o0[3] = a0[3] + sigmoidf_(bfhi(g.y)) * v0[3];
                    o1[0] = a1[0] + sigmoidf_(bflo(g.z)) * v1[0]; o1[1] = a1[1] + sigmoidf_(bfhi(g.z)) * v1[1]; o1[2] = a1[2] + sigmoidf_(bflo(g.w)) * v1[2]; o1[3] = a1[3] + sigmoidf_(bfhi(g.w)) * v1[3];
                    u32x4 w; w.x = cvt_pk_bf16(o0[0], o0[1]); w.y = cvt_pk_bf16(o0[2], o0[3]); w.z = cvt_pk_bf16(o1[0], o1[1]); w.w = cvt_pk_bf16(o1[2], o1[3]);
                    *(u32x4*)(O + (size_t)r * D + c) = w; } }
    }
};
struct EpiResid {
    static constexpr bool PERM = false;
    float* x; const float* gate; const float* rw; int e;
    __device__ __forceinline__ void operator()(const AccT& acc, const pg8::Unit& u, int wr, int wc, int fr, int fq) const {
        const int row0 = u.pm * 256 + wr * 64 + fr, col0 = u.pn * 256 + wc * 32 + 4 * fq;
        const int b = (u.pm < 64) ? (u.pm >> 4) : 4;
        const float* gp = gate + (size_t)b * 6144 + col0;
        f32x4 gv[2][2];
#pragma unroll
        for (int bj = 0; bj < 2; ++bj)
#pragma unroll
            for (int n = 0; n < 2; ++n) gv[bj][n] = *(const f32x4*)(gp + bj * 128 + n * 16);
#pragma unroll
        for (int ai = 0; ai < 2; ++ai)
#pragma unroll
            for (int m = 0; m < 4; ++m) { const int r = row0 + ai * 128 + m * 16; float* rowp = x + (size_t)r * D + col0;
                const float rs = rw ? rw[(size_t)r * 8 + e] : 1.f;
#pragma unroll
                for (int bj = 0; bj < 2; ++bj)
#pragma unroll
                    for (int n = 0; n < 2; ++n) { float* p = rowp + bj * 128 + n * 16; *(f32x4*)p = *(const f32x4*)p + gv[bj][n] * acc[ai][bj][m][n] * rs; } }
    }
};
struct EpiSwiglu {
    static constexpr bool PERM = true;
    bf16_t* O;
    __device__ __forceinline__ void operator()(const AccT& acc, const pg8::Unit& u, int wr, int wc, int fr, int fq) const {
        const int row0 = u.pm * 256 + wr * 64 + fr, col0 = u.pn * 128 + wc * 32 + 8 * fq;
#pragma unroll
        for (int ai = 0; ai < 2; ++ai)
#pragma unroll
            for (int m = 0; m < 4; ++m) { const int r = row0 + ai * 128 + m * 16;
                float o[8];
#pragma unroll
                for (int n = 0; n < 2; ++n)
#pragma unroll
                    for (int j = 0; j < 4; ++j) { const float a = acc[ai][0][m][n][j], g = acc[ai][1][m][n][j]; o[n * 4 + j] = a * sigmoidf_(a) * g; }
                u32x4 w; w.x = cvt_pk_bf16(o[0], o[1]); w.y = cvt_pk_bf16(o[2], o[3]); w.z = cvt_pk_bf16(o[4], o[5]); w.w = cvt_pk_bf16(o[6], o[7]);
                *(u32x4*)(O + (size_t)r * FF + col0) = w; }
    }
};

struct Args { const float* in[30]; float* out; unsigned char* ws; int l, e, ph, pad; };
enum { I_X = 0, I_C, I_CTX, I_CCTX, I_WMOD, I_BMOD, I_N1G, I_N2G, I_WIN, I_RPB, I_HCW, I_HCB, I_HW1, I_HB1, I_HW2, I_HB2, I_HW3, I_HFREQ, I_HBIAS,
       I_WPA, I_WPB, I_WO, I_FW1, I_FW3, I_FW2, I_ROUTER, I_MW1, I_MW3, I_MW2, I_FINALG };

struct Ctx {
    LAS unsigned char* lds; int tid, lane, wave, G, bid; const Args* a;
};

__device__ __forceinline__ void transpose_item(const float* W, int N, bf16_t* WT, int ldk, int k0, int n0, int drow0, LAS float* scr, int lane) {
#pragma unroll 8
    for (int i = 0; i < 32; ++i) { const int kk = 2 * i + (lane >> 5); scr[kk * 33 + (lane & 31)] = W[(size_t)(k0 + kk) * N + n0 + (lane & 31)]; }
    LDS_WAIT(); asm volatile("" ::: "memory");
    const int c = lane & 7;
#pragma unroll
    for (int j = 0; j < 4; ++j) { const int n = (lane >> 3) + 8 * j; const LAS float* s = scr + (8 * c) * 33 + n;
        u32x4 o; o.x = cvt_pk_bf16(s[0 * 33], s[1 * 33]); o.y = cvt_pk_bf16(s[2 * 33], s[3 * 33]); o.z = cvt_pk_bf16(s[4 * 33], s[5 * 33]); o.w = cvt_pk_bf16(s[6 * 33], s[7 * 33]);
        *(u32x4*)(WT + (size_t)(drow0 + n) * ldk + k0 + 8 * c) = o; }
    LDS_WAIT(); asm volatile("" ::: "memory");
}
__device__ __forceinline__ void conv_mat(const float* W, int K, int N, bf16_t* WT, int mode, int& base, int gw, int NGW, LAS float* scr, int lane) {
    const int nblk = N / 32, nitems = (K / 64) * nblk;
    const int start = (gw - (base % NGW) + NGW) % NGW;
    for (int it = start; it < nitems; it += NGW) {
        const int kb = it / nblk, nb = it % nblk, n0 = nb * 32;
        const int drow0 = mode == 0 ? n0 : ((n0 >> 7) * 256 + (n0 & 127) + (mode == 2 ? 128 : 0));
        transpose_item(W, N, WT, K, kb * 64, n0, drow0, scr, lane);
    }
    base += nitems;
}
__device__ __forceinline__ void ph_convert(const Ctx& c) {
    const Args& a = *c.a; unsigned char* ws = a.ws;
    LAS float* scr = (LAS float*)(c.lds + c.wave * 16384);
    const int gw = c.bid * NWAVES + c.wave, NGW = c.G * NWAVES; int base = 0;
    for (int l = 0; l < DEPTH; ++l) {
        conv_mat(a.in[I_WIN] + (size_t)l * D * PW, D, PW, (bf16_t*)(ws + WS_WIN) + (size_t)l * PW * D, 0, base, gw, NGW, scr, c.lane);
        conv_mat(a.in[I_WPA] + (size_t)l * 512 * D, 512, D, (bf16_t*)(ws + WS_WPA) + (size_t)l * D * 512, 0, base, gw, NGW, scr, c.lane);
        conv_mat(a.in[I_WPB] + (size_t)l * 512 * D, 512, D, (bf16_t*)(ws + WS_WPB) + (size_t)l * D * 512, 0, base, gw, NGW, scr, c.lane);
        conv_mat(a.in[I_WO] + (size_t)l * D * D, D, D, (bf16_t*)(ws + WS_WO) + (size_t)l * D * D, 0, base, gw, NGW, scr, c.lane);
    }
    for (int i = 0; i < 2; ++i) {
        conv_mat(a.in[I_FW1] + (size_t)i * D * FF, D, FF, (bf16_t*)(ws + WS_W13D) + (size_t)i * 2 * FF * D, 1, base, gw, NGW, scr, c.lane);
        conv_mat(a.in[I_FW3] + (size_t)i * D * FF, D, FF, (bf16_t*)(ws + WS_W13D) + (size_t)i * 2 * FF * D, 2, base, gw, NGW, scr, c.lane);
        conv_mat(a.in[I_FW2] + (size_t)i * FF * D, FF, D, (bf16_t*)(ws + WS_W2D) + (size_t)i * D * FF, 0, base, gw, NGW, scr, c.lane);
    }
    for (int ie = 0; ie < 2 * NE; ++ie) {
        conv_mat(a.in[I_MW1] + (size_t)ie * D * FF, D, FF, (bf16_t*)(ws + WS_W13M) + (size_t)ie * 2 * FF * D, 1, base, gw, NGW, scr, c.lane);
        conv_mat(a.in[I_MW3] + (size_t)ie * D * FF, D, FF, (bf16_t*)(ws + WS_W13M) + (size_t)ie * 2 * FF * D, 2, base, gw, NGW, scr, c.lane);
        conv_mat(a.in[I_MW2] + (size_t)ie * FF * D, FF, D, (bf16_t*)(ws + WS_W2M) + (size_t)ie * D * FF, 0, base, gw, NGW, scr, c.lane);
    }
}

__device__ __forceinline__ void ph_mod(const Ctx& c) {
    const Args& a = *c.a; float* mod = (float*)(a.ws + WS_MOD);
    LAS float* s = (LAS float*)c.lds; LAS float* part = s + 5 * 1024;
    for (int i = c.tid; i < 5 * 1024; i += NTHR) { const int r = i >> 10, k = i & 1023; const float v = r < 4 ? a.in[I_C][r * 1024 + k] : a.in[I_CCTX][k]; s[i] = v * sigmoidf_(v); }
    __syncthreads();
    for (int unit = c.bid; unit < DEPTH * 96; unit += c.G) {
        const int l = unit / 96, j0 = (unit % 96) * 64;
        const float* w = a.in[I_WMOD] + (size_t)l * D * 6144 + j0 + c.lane;
        float acc[5] = {0.f, 0.f, 0.f, 0.f, 0.f};
        const int kb = c.wave * 128;
#pragma unroll 8
        for (int k = 0; k < 128; ++k) { const float wv = w[(size_t)(kb + k) * 6144];
#pragma unroll
            for (int r = 0; r < 5; ++r) acc[r] += s[r * 1024 + kb + k] * wv; }
#pragma unroll
        for (int r = 0; r < 5; ++r) part[(c.wave * 5 + r) * 64 + c.lane] = acc[r];
        __syncthreads();
        if (c.tid < 320) { const int r = c.tid >> 6, ln = c.tid & 63; float sum = 0.f;
#pragma unroll
            for (int w8 = 0; w8 < 8; ++w8) sum += part[(w8 * 5 + r) * 64 + ln];
            mod[(size_t)(l * 5 + r) * 6144 + j0 + ln] = sum + a.in[I_BMOD][l * 6144 + j0 + ln]; }
        __syncthreads();
    }
}

__device__ __forceinline__ void ph_filt(const Ctx& c) {
    const Args& a = *c.a;
    LAS float* zb = (LAS float*)c.lds;
    LAS float* a1 = zb + 16 * 36;
    LAS float* a2 = a1 + 16 * 64;
    const float MINDEC = -3.0701134573253945f, MAXDEC = -15.350567286626973f;
    for (int unit = c.bid; unit < DEPTH * 272; unit += c.G) {
        const int l = unit / 272, uu = unit % 272;
        const int L = uu < 256 ? 4096 : 256, p0 = uu < 256 ? uu * 16 : (uu - 256) * 16;
        float* fout = uu < 256 ? (float*)(a.ws + WS_FL) + (size_t)l * 2 * 4096 * 512 : (float*)(a.ws + WS_FC) + (size_t)l * 2 * 256 * 512;
        for (int i = c.tid; i < 16 * 33; i += NTHR) { const int p = i / 33, q = i % 33; const int pos = p0 + p; float v;
            if (q == 0) v = (float)pos / (float)(L - 1);
            else { const int j = (q - 1) & 15; const double band = 1e-4 + (double)j * ((15.0 - 1e-4) / 15.0); double rev = (double)pos * band / (double)L; rev -= floor(rev);
                v = q <= 16 ? __builtin_amdgcn_cosf((float)rev) : -__builtin_amdgcn_sinf((float)rev); }
            zb[p * 36 + q] = v; }
        __syncthreads();
        for (int i = c.tid; i < 16 * 64; i += NTHR) { const int p = i >> 6, j = i & 63; float s = a.in[I_HB1][l * 64 + j];
            const float* w = a.in[I_HW1] + (size_t)l * 33 * 64 + j;
            for (int q = 0; q < 33; ++q) s += zb[p * 36 + q] * w[q * 64];
            a1[p * 64 + j] = sin_rad(a.in[I_HFREQ][l * 128 + j] * s); }
        __syncthreads();
        for (int i = c.tid; i < 16 * 64; i += NTHR) { const int p = i >> 6, j = i & 63; float s = a.in[I_HB2][l * 64 + j];
            const float* w = a.in[I_HW2] + (size_t)l * 64 * 64 + j;
            for (int q = 0; q < 64; ++q) s += a1[p * 64 + q] * w[q * 64];
            a2[p * 64 + j] = sin_rad(a.in[I_HFREQ][l * 128 + 64 + j] * s); }
        __syncthreads();
        {
            float acc0[16], acc1[16];
#pragma unroll
            for (int p = 0; p < 16; ++p) { acc0[p] = 0.f; acc1[p] = 0.f; }
            const float* w3 = a.in[I_HW3] + (size_t)l * 64 * 1024 + c.tid;
            for (int k = 0; k < 64; ++k) { const float wa = w3[k * 1024], wb = w3[k * 1024 + 512];
#pragma unroll
                for (int p = 0; p < 16; ++p) { const float av = a2[p * 64 + k]; acc0[p] += av * wa; acc1[p] += av * wb; } }
            const float r0 = fabsf(MINDEC + (float)c.tid * ((MAXDEC - MINDEC) / 1023.f)), r1 = fabsf(MINDEC + (float)(c.tid + 512) * ((MAXDEC - MINDEC) / 1023.f));
#pragma unroll
            for (int p = 0; p < 16; ++p) { const int pos = p0 + p; const float dist = fabsf((float)(pos - L / 2)) * (2.f / (float)L);
                fout[(size_t)(0 * L + pos) * 512 + c.tid] = acc0[p] * (__expf(-dist * r0) + 0.05f);
                fout[(size_t)(1 * L + pos) * 512 + c.tid] = acc1[p] * (__expf(-dist * r1) + 0.05f); }
        }
        __syncthreads();
    }
}

__device__ __forceinline__ void ph_norm(const Ctx& c, int l, int which) {
    const Args& a = *c.a; float* xres = (float*)(a.ws + WS_X); bf16_t* h = (bf16_t*)(a.ws + WS_H);
    const float* mod = (const float*)(a.ws + WS_MOD) + (size_t)l * 5 * 6144;
    const float* gp = (which == 0 ? a.in[I_N1G] : a.in[I_N2G]) + l * D;
    const bool first = (l == 0 && which == 0), route = (which == 1 && (l & 1));
    const float* router = a.in[I_ROUTER] + (size_t)(l >> 1) * D * NE;
    float* rw = (float*)(a.ws + WS_RW);
    for (int row = c.bid * NWAVES + c.wave; row < T; row += c.G * NWAVES) {
        const float* src = first ? (row < TL ? a.in[I_X] + (size_t)row * D : a.in[I_CTX] + (size_t)(row - TL) * D) : xres + (size_t)row * D;
        const int b = row < TL ? (row >> 12) : 4;
        const float* sh = mod + (size_t)b * 6144 + (which == 0 ? 0 : 3) * 1024; const float* sc = sh + 1024;
        f32x4 v[4]; float ss = 0.f;
#pragma unroll
        for (int j = 0; j < 4; ++j) { v[j] = *(const f32x4*)(src + 4 * (c.lane + 64 * j)); ss += (v[j][0] * v[j][0] + v[j][1] * v[j][1]) + (v[j][2] * v[j][2] + v[j][3] * v[j][3]); }
        ss = wave_sum(ss);
        const float rstd = 1.f / sqrtf(ss * (1.f / D) + EPS);
        if (first) {
#pragma unroll
            for (int j = 0; j < 4; ++j) *(f32x4*)(xres + (size_t)row * D + 4 * (c.lane + 64 * j)) = v[j];
        }
        float lg[8] = {0.f, 0.f, 0.f, 0.f, 0.f, 0.f, 0.f, 0.f};
#pragma unroll
        for (int j = 0; j < 4; ++j) { const int k0 = 4 * (c.lane + 64 * j);
            const f32x4 g4 = *(const f32x4*)(gp + k0), s4 = *(const f32x4*)(sc + k0), h4 = *(const f32x4*)(sh + k0);
            f32x4 o;
#pragma unroll
            for (int q = 0; q < 4; ++q) o[q] = v[j][q] * rstd * g4[q] * (1.f + s4[q]) + h4[q];
            u32x2 w; w.x = cvt_pk_bf16(o[0], o[1]); w.y = cvt_pk_bf16(o[2], o[3]);
            *(u32x2*)(h + (size_t)row * D + k0) = w;
            if (route) {
#pragma unroll
                for (int q = 0; q < 4; ++q) { const f32x4 ra = *(const f32x4*)(router + (size_t)(k0 + q) * 8), rb = *(const f32x4*)(router + (size_t)(k0 + q) * 8 + 4);
                    lg[0] += o[q] * ra[0]; lg[1] += o[q] * ra[1]; lg[2] += o[q] * ra[2]; lg[3] += o[q] * ra[3];
                    lg[4] += o[q] * rb[0]; lg[5] += o[q] * rb[1]; lg[6] += o[q] * rb[2]; lg[7] += o[q] * rb[3]; }
            }
        }
        if (route) {
#pragma unroll
            for (int e = 0; e < 8; ++e) lg[e] = wave_sum(lg[e]);
            int i1 = 0; float v1 = lg[0];
#pragma unroll
            for (int e = 1; e < 8; ++e) if (lg[e] > v1) { v1 = lg[e]; i1 = e; }
            int i2 = -1; float v2 = -3.0e38f;
#pragma unroll
            for (int e = 0; e < 8; ++e) if (e != i1 && lg[e] > v2) { v2 = lg[e]; i2 = e; }
            const float w1 = 1.f / (1.f + __expf(v2 - v1)), w2 = 1.f - w1;
            if (c.lane < 8) rw[(size_t)row * 8 + c.lane] = (c.lane == i1) ? w1 : ((c.lane == i2) ? w2 : 0.f);
        }
    }
}

__device__ __forceinline__ void attn_key(const bf16_t* P, int ktok, int head, float bias, const float (&q)[64], float (&o)[64], float& m, float& s) {
    const u32x4* kp = (const u32x4*)(P + (size_t)ktok * PW + PK + head * 64);
    float sc = 0.f;
#pragma unroll
    for (int i = 0; i < 8; ++i) { const u32x4 w = kp[i];
        sc += q[8 * i + 0] * bflo(w.x) + q[8 * i + 1] * bfhi(w.x) + q[8 * i + 2] * bflo(w.y) + q[8 * i + 3] * bfhi(w.y)
            + q[8 * i + 4] * bflo(w.z) + q[8 * i + 5] * bfhi(w.z) + q[8 * i + 6] * bflo(w.w) + q[8 * i + 7] * bfhi(w.w); }
    sc += bias;
    const float mn = fmaxf(m, sc), al = __expf(m - mn), p = __expf(sc - mn);
    s = s * al + p; m = mn;
    const u32x4* vp = (const u32x4*)(P + (size_t)ktok * PW + PV + head * 64);
#pragma unroll
    for (int i = 0; i < 8; ++i) { const u32x4 w = vp[i];
        o[8 * i + 0] = o[8 * i + 0] * al + p * bflo(w.x); o[8 * i + 1] = o[8 * i + 1] * al + p * bfhi(w.x);
        o[8 * i + 2] = o[8 * i + 2] * al + p * bflo(w.y); o[8 * i + 3] = o[8 * i + 3] * al + p * bfhi(w.y);
        o[8 * i + 4] = o[8 * i + 4] * al + p * bflo(w.z); o[8 * i + 5] = o[8 * i + 5] * al + p * bfhi(w.z);
        o[8 * i + 6] = o[8 * i + 6] * al + p * bflo(w.w); o[8 * i + 7] = o[8 * i + 7] * al + p * bfhi(w.w); }
}
__device__ __forceinline__ void ph_attn_naive(const Ctx& c, int l) {
    const Args& a = *c.a; const bf16_t* P = (const bf16_t*)(a.ws + WS_P); bf16_t* oatt = (bf16_t*)(a.ws + WS_OATT);
    const float* rpb = a.in[I_RPB] + (size_t)l * 8 * 15 * 31;
    for (int item = c.bid * NTHR + c.tid; item < T * 8; item += c.G * NTHR) {
        const int head = item & 7, tok = item >> 3;
        float q[64], o[64]; float m = -3.0e38f, s = 0.f;
        { const u32x4* qp = (const u32x4*)(P + (size_t)tok * PW + PQ + head * 64);
#pragma unroll
          for (int i = 0; i < 8; ++i) { const u32x4 w = qp[i];
              q[8 * i + 0] = 0.125f * bflo(w.x); q[8 * i + 1] = 0.125f * bfhi(w.x); q[8 * i + 2] = 0.125f * bflo(w.y); q[8 * i + 3] = 0.125f * bfhi(w.y);
              q[8 * i + 4] = 0.125f * bflo(w.z); q[8 * i + 5] = 0.125f * bfhi(w.z); q[8 * i + 6] = 0.125f * bflo(w.w); q[8 * i + 7] = 0.125f * bfhi(w.w); } }
#pragma unroll
        for (int i = 0; i < 64; ++i) o[i] = 0.f;
        int b;
        if (tok < TL) {
            b = tok >> 12; const int t = tok & 4095, r = t >> 6, qc = t & 63;
            const int r0 = min(max(r - 4, 0), 56), c0 = min(max(qc - 8, 0), 48);
            for (int kr = 0; kr < 8; ++kr) for (int kc = 0; kc < 16; ++kc) {
                const int krow = r0 + kr, kcol = c0 + kc;
                const float bias = rpb[(head * 15 + (krow - r + 7)) * 31 + (kcol - qc + 15)];
                attn_key(P, b * 4096 + krow * 64 + kcol, head, bias, q, o, m, s);
            }
        } else b = (tok - TL) >> 8;
        for (int j = 0; j < 256; ++j) attn_key(P, TL + b * 256 + j, head, 0.f, q, o, m, s);
        const float inv = 1.f / s;
        u32x4* op = (u32x4*)(oatt + (size_t)tok * 512 + head * 64);
#pragma unroll
        for (int i = 0; i < 8; ++i) { u32x4 w; w.x = cvt_pk_bf16(o[8 * i] * inv, o[8 * i + 1] * inv); w.y = cvt_pk_bf16(o[8 * i + 2] * inv, o[8 * i + 3] * inv);
            w.z = cvt_pk_bf16(o[8 * i + 4] * inv, o[8 * i + 5] * inv); w.w = cvt_pk_bf16(o[8 * i + 6] * inv, o[8 * i + 7] * inv); op[i] = w; }
    }
}

__device__ __forceinline__ void ph_sc(const Ctx& c, int l) {
    const Args& a = *c.a; const bf16_t* P = (const bf16_t*)(a.ws + WS_P); bf16_t* vsc = (bf16_t*)(a.ws + WS_B);
    const float* cw = a.in[I_HCW] + (size_t)l * 3 * 1536; const float* cb = a.in[I_HCB] + (size_t)l * 1536;
    for (int item = c.bid * NTHR + c.tid; item < T * 192; item += c.G * NTHR) {
        const int row = item / 192, ch0 = (item % 192) * 8;
        const int tpos = row < TL ? (row & 4095) : ((row - TL) & 255), Ls = row < TL ? 4096 : 256;
        const bf16_t* up = P + (size_t)row * PW + PHY + ch0;
        const u32x4 z4 = (u32x4){0u, 0u, 0u, 0u};
        const u32x4 u0 = tpos > 0 ? *(const u32x4*)(up - PW) : z4, u1 = *(const u32x4*)up, u2 = tpos < Ls - 1 ? *(const u32x4*)(up + PW) : z4;
        float o[8];
#pragma unroll
        for (int j = 0; j < 4; ++j) {
            const unsigned w0 = u0[j], w1 = u1[j], w2 = u2[j]; const int ch = ch0 + 2 * j;
            o[2 * j] = cw[ch] * bflo(w0) + cw[1536 + ch] * bflo(w1) + cw[3072 + ch] * bflo(w2) + cb[ch];
            o[2 * j + 1] = cw[ch + 1] * bfhi(w0) + cw[1536 + ch + 1] * bfhi(w1) + cw[3072 + ch + 1] * bfhi(w2) + cb[ch + 1];
        }
        u32x4 w; w.x = cvt_pk_bf16(o[0], o[1]); w.y = cvt_pk_bf16(o[2], o[3]); w.z = cvt_pk_bf16(o[4], o[5]); w.w = cvt_pk_bf16(o[6], o[7]);
        *(u32x4*)(vsc + (size_t)row * 1536 + ch0) = w;
    }
}

__device__ __forceinline__ void ph_conv_naive(const Ctx& c, int l, int o) {
    const Args& a = *c.a; const bf16_t* vsc = (const bf16_t*)(a.ws + WS_B); float* zb = (float*)(a.ws + WS_Z); bf16_t* ohy = (bf16_t*)(a.ws + WS_OHY);
    const int ch = c.tid;
    const float bias = a.in[I_HBIAS][(l * 2 + o) * 512 + ch];
    for (int unit = c.bid; unit < 2048 + 128; unit += c.G) {
        int L, t0, rowbase; const float* filt;
        if (unit < 2048) { const int b = unit >> 9; t0 = (unit & 511) * 8; L = 4096; rowbase = b * 4096; filt = (const float*)(a.ws + WS_FL) + (size_t)(l * 2 + o) * 4096 * 512; }
        else { const int uu = unit - 2048, b = uu >> 5; t0 = (uu & 31) * 8; L = 256; rowbase = TL + b * 256; filt = (const float*)(a.ws + WS_FC) + (size_t)(l * 2 + o) * 256 * 512; }
        const int H = L / 2;
        const int s_lo = max(0, t0 - H + 1), s_hi = min(L - 1, t0 + 7 + H);
        float hw[8], acc[8];
#pragma unroll
        for (int j = 0; j < 8; ++j) { const int k = t0 + j - s_lo + H; hw[j] = (k >= 0 && k < L) ? filt[(size_t)k * 512 + ch] : 0.f; acc[j] = 0.f; }
        for (int s = s_lo; s <= s_hi; ++s) {
            const float uv = o == 0 ? bf2f(vsc[(size_t)(rowbase + s) * 1536 + ch]) : zb[(size_t)(rowbase + s) * 512 + ch];
#pragma unroll
            for (int j = 0; j < 8; ++j) acc[j] += uv * hw[j];
#pragma unroll
            for (int j = 7; j > 0; --j) hw[j] = hw[j - 1];
            const int k = t0 - (s + 1) + H; hw[0] = (k >= 0 && k < L) ? filt[(size_t)k * 512 + ch] : 0.f;
        }
#pragma unroll
        for (int j = 0; j < 8; ++j) { const size_t row = (size_t)(rowbase + t0 + j);
            if (o == 0) { const float uv = bf2f(vsc[row * 1536 + ch]), x1 = bf2f(vsc[row * 1536 + 512 + ch]); zb[row * 512 + ch] = x1 * (acc[j] + bias * uv); }
            else { const float uv = zb[row * 512 + ch], x2 = bf2f(vsc[row * 1536 + 1024 + ch]); ohy[row * 512 + ch] = (bf16_t)(cvt_pk_bf16(x2 * (acc[j] + bias * uv), 0.f) & 0xffffu); } }
    }
}

__device__ __forceinline__ void ph_final(const Ctx& c) {
    const Args& a = *c.a; const float* xres = (const float*)(a.ws + WS_X); const float* gp = a.in[I_FINALG];
    for (int row = c.bid * NWAVES + c.wave; row < TL; row += c.G * NWAVES) {
        const float* src = xres + (size_t)row * D; f32x4 v[4]; float ss = 0.f;
#pragma unroll
        for (int j = 0; j < 4; ++j) { v[j] = *(const f32x4*)(src + 4 * (c.lane + 64 * j)); ss += (v[j][0] * v[j][0] + v[j][1] * v[j][1]) + (v[j][2] * v[j][2] + v[j][3] * v[j][3]); }
        ss = wave_sum(ss);
        const float rstd = 1.f / sqrtf(ss * (1.f / D) + EPS);
#pragma unroll
        for (int j = 0; j < 4; ++j) { const int k0 = 4 * (c.lane + 64 * j); const f32x4 g4 = *(const f32x4*)(gp + k0); *(f32x4*)(a.out + (size_t)row * D + k0) = v[j] * rstd * g4; }
    }
}

enum { PH_CONVERT = 0, PH_MOD, PH_FILT, PH_NORM1, PH_GEMM_IN, PH_ATTN, PH_SC, PH_CONV1, PH_CONV2, PH_MERGE, PH_WO, PH_NORM2, PH_UP, PH_DOWN, PH_FINAL };

template <int PH> __global__ void __launch_bounds__(NTHR, 2) k_ph(Args args) {
    extern __shared__ __attribute__((aligned(16))) unsigned char lds_raw[];
    Ctx c; c.lds = (LAS unsigned char*)lds_raw; c.tid = threadIdx.x; c.lane = c.tid & 63; c.wave = __builtin_amdgcn_readfirstlane(c.tid >> 6); c.G = gridDim.x; c.bid = blockIdx.x; c.a = &args;
    unsigned char* ws = args.ws; const int l = args.l, e = args.e;
    const float* modl = (const float*)(ws + WS_MOD) + (size_t)l * 5 * 6144;
    if constexpr (PH == PH_CONVERT) ph_convert(c);
    if constexpr (PH == PH_MOD) ph_mod(c);
    if constexpr (PH == PH_FILT) ph_filt(c);
    if constexpr (PH == PH_NORM1) ph_norm(c, l, 0);
    if constexpr (PH == PH_NORM2) ph_norm(c, l, 1);
    if constexpr (PH == PH_GEMM_IN) {
        pg8::Gemm g{D, D, D}; pg8::StaticOrder S; S.init(ws + WS_H, D, (bf16_t*)(ws + WS_WIN) + (size_t)l * PW * D, D, T, PW, c.G, c.bid);
        EpiStoreBf16 E{(bf16_t*)(ws + WS_P), PW};
        pg8::gemm_phase(c.lds, g, S, E);
    }
    if constexpr (PH == PH_ATTN) ph_attn_naive(c, l);
    if constexpr (PH == PH_SC) ph_sc(c, l);
    if constexpr (PH == PH_CONV1) ph_conv_naive(c, l, 0);
    if constexpr (PH == PH_CONV2) ph_conv_naive(c, l, 1);
    if constexpr (PH == PH_MERGE) {
        pg8::Gemm g{512, 512, 512};
        { pg8::StaticOrder S; S.init(ws + WS_OATT, 512, (bf16_t*)(ws + WS_WPA) + (size_t)l * D * 512, 512, T, D, c.G, c.bid);
          EpiMerge1 E{(float*)(ws + WS_B), (const bf16_t*)(ws + WS_P)};
          pg8::gemm_phase(c.lds, g, S, E); }
        { pg8::StaticOrder S; S.init(ws + WS_OHY, 512, (bf16_t*)(ws + WS_WPB) + (size_t)l * D * 512, 512, T, D, c.G, c.bid);
          EpiMerge2 E{(const float*)(ws + WS_B), (const bf16_t*)(ws + WS_P), (bf16_t*)(ws + WS_H)};
          pg8::gemm_phase(c.lds, g, S, E); }
    }
    if constexpr (PH == PH_WO) {
        pg8::Gemm g{D, D, D}; pg8::StaticOrder S; S.init(ws + WS_H, D, (bf16_t*)(ws + WS_WO) + (size_t)l * D * D, D, T, D, c.G, c.bid);
        EpiResid E{(float*)(ws + WS_X), modl + 2 * 1024, nullptr, 0};
        pg8::gemm_phase(c.lds, g, S, E);
    }
    if constexpr (PH == PH_UP) {
        const bf16_t* w = e < 0 ? (const bf16_t*)(ws + WS_W13D) + (size_t)(l >> 1) * 2 * FF * D : (const bf16_t*)(ws + WS_W13M) + (size_t)((l >> 1) * NE + e) * 2 * FF * D;
        pg8::Gemm g{D, D, D}; pg8::StaticOrder S; S.init(ws + WS_H, D, w, D, T, 2 * FF, c.G, c.bid);
        EpiSwiglu E{(bf16_t*)(ws + WS_P)};
        pg8::gemm_phase(c.lds, g, S, E);
    }
    if constexpr (PH == PH_DOWN) {
        const bf16_t* w = e < 0 ? (const bf16_t*)(ws + WS_W2D) + (size_t)(l >> 1) * D * FF : (const bf16_t*)(ws + WS_W2M) + (size_t)((l >> 1) * NE + e) * D * FF;
        pg8::Gemm g{FF, FF, FF}; pg8::StaticOrder S; S.init(ws + WS_P, FF, w, FF, T, D, c.G, c.bid);
        EpiResid E{(float*)(ws + WS_X), modl + 5 * 1024, e < 0 ? nullptr : (const float*)(ws + WS_RW), e < 0 ? 0 : e};
        pg8::gemm_phase(c.lds, g, S, E);
    }
    if constexpr (PH == PH_FINAL) ph_final(c);
}

template <int PH> static void launch_ph(Args a, int l, int e, int grid, hipStream_t stream) {
    static bool attr = false;
    if (!attr) { (void)hipFuncSetAttribute((const void*)k_ph<PH>, hipFuncAttributeMaxDynamicSharedMemorySize, LDS_BYTES); attr = true; }
    a.l = l; a.e = e; a.ph = PH; a.pad = 0;
    hipLaunchKernelGGL(k_ph<PH>, dim3(grid), dim3(NTHR), LDS_BYTES, stream, a);
}

extern "C" void kernel_launch(void* const* d_in, const int* in_sizes, int n_in, void* d_out, int out_size, void* d_ws, size_t ws_size, hipStream_t stream) {
    static int grid = 0;
    if (grid == 0) {
        if (n_in != 30 || out_size != TL * D || ws_size < WS_END) { fprintf(stderr, "kernel_launch: unexpected shapes (n_in %d out %d ws %zu)\n", n_in, out_size, ws_size); grid = -1; return; }
        int dev = 0, cus = 0; (void)hipGetDevice(&dev); (void)hipDeviceGetAttribute(&cus, hipDeviceAttributeMultiprocessorCount, dev);
        grid = cus > 0 ? cus : 256;
    }
    if (grid < 0) return;
    (void)hipMemsetAsync((char*)d_ws + WS_CTL, 0, CTL_ZERO_BYTES, stream);
    Args a{};
    for (int i = 0; i < 30; ++i) a.in[i] = (const float*)d_in[i];
    a.out = (float*)d_out; a.ws = (unsigned char*)d_ws;
    launch_ph<PH_CONVERT>(a, 0, 0, grid, stream);
    launch_ph<PH_MOD>(a, 0, 0, grid, stream);
    launch_ph<PH_FILT>(a, 0, 0, grid, stream);
    for (int l = 0; l < DEPTH; ++l) {
        launch_ph<PH_NORM1>(a, l, 0, grid, stream);
        launch_ph<PH_GEMM_IN>(a, l, 0, grid, stream);
        launch_ph<PH_ATTN>(a, l, 0, grid, stream);
        launch_ph<PH_SC>(a, l, 0, grid, stream);
        launch_ph<PH_CONV1>(a, l, 0, grid, stream);
        launch_ph<PH_CONV2>(a, l, 0, grid, stream);
        launch_ph<PH_MERGE>(a, l, 0, grid, stream);
        launch_ph<PH_WO>(a, l, 0, grid, stream);
        launch_ph<PH_NORM2>(a, l, 0, grid, stream);
        if ((l & 1) == 0) { launch_ph<PH_UP>(a, l, -1, grid, stream); launch_ph<PH_DOWN>(a, l, -1, grid, stream); }
        else for (int e = 0; e < NE; ++e) { launch_ph<PH_UP>(a, l, e, grid, stream); launch_ph<PH_DOWN>(a, l, e, grid, stream); }
    }
    launch_ph<PH_FINAL>(a, 0, 0, grid, stream);
}
```

```cpp
#include <hip/hip_runtime.h>
#include <cstdio>
#include <cstdint>

#define LAS __attribute__((address_space(3)))
#define GAS __attribute__((address_space(1)))
typedef unsigned short bf16_t;
typedef short bf16x8 __attribute__((ext_vector_type(8)));
typedef float f32x4 __attribute__((ext_vector_type(4)));
typedef float f32x2 __attribute__((ext_vector_type(2)));
typedef unsigned u32x4 __attribute__((ext_vector_type(4)));
typedef unsigned u32x2 __attribute__((ext_vector_type(2)));

constexpr int D = 1024, NB = 4, SEQ = 4096, DEPTH = 4, CTX = 256;
constexpr int TL = NB * SEQ, TC = NB * CTX, T = TL + TC;
constexpr int PW = 5120, FF = 2816, NE = 8, HYW = 512;
constexpr int PQ = 0, PK = 512, PV = 1024, PHY = 1536, PGA = 3072, PGB = 4096;
constexpr float EPS = 1e-6f;

constexpr size_t MiB = 1u << 20;
constexpr size_t WS_CTL = 0, CTL_ZERO_BYTES = 1 * MiB;
constexpr size_t WS_MOD = 1 * MiB;
constexpr size_t WS_RW = 2 * MiB;
constexpr size_t WS_WIN = 4 * MiB;
constexpr size_t WS_WPA = 44 * MiB;
constexpr size_t WS_WPB = 48 * MiB;
constexpr size_t WS_WO = 52 * MiB;
constexpr size_t WS_W13D = 60 * MiB;
constexpr size_t WS_W2D = 82 * MiB;
constexpr size_t WS_W13M = 93 * MiB;
constexpr size_t WS_W2M = 269 * MiB;
constexpr size_t WS_X = 357 * MiB;
constexpr size_t WS_H = 425 * MiB;
constexpr size_t WS_P = 459 * MiB;
constexpr size_t WS_OATT = 629 * MiB;
constexpr size_t WS_OHY = 646 * MiB;
constexpr size_t WS_B = 663 * MiB;
constexpr size_t WS_Z = WS_B + 51 * MiB;
constexpr size_t WS_FL = 748 * MiB;
constexpr size_t WS_FC = 812 * MiB;
constexpr size_t WS_END = 816 * MiB;

constexpr int LDS_BYTES = 147456;
constexpr int NWAVES = 8, NTHR = 512;

#define LDS_WAIT() asm volatile("s_waitcnt lgkmcnt(0)" ::: "memory")
#define VM_WAIT() asm volatile("s_waitcnt vmcnt(0)" ::: "memory")
__device__ __forceinline__ float bf2f(unsigned b) { return __uint_as_float(b << 16); }
__device__ __forceinline__ float bflo(unsigned w) { return __uint_as_float(w << 16); }
__device__ __forceinline__ float bfhi(unsigned w) { return __uint_as_float(w & 0xffff0000u); }
__device__ __forceinline__ unsigned cvt_pk_bf16(float lo, float hi) { unsigned r; asm volatile("v_cvt_pk_bf16_f32 %0, %1, %2" : "=v"(r) : "v"(lo), "v"(hi)); return r; }
__device__ __forceinline__ float wave_sum(float v) {
#pragma unroll
    for (int o = 1; o < 64; o <<= 1) v += __shfl_xor(v, o);
    return v;
}
__device__ __forceinline__ float sigmoidf_(float x) { return 1.f / (1.f + __expf(-x)); }
__device__ __forceinline__ float sin_rev(float r) { return __builtin_amdgcn_sinf(__builtin_amdgcn_fractf(r)); }
__device__ __forceinline__ float sin_rad(float x) { return sin_rev(x * 0.15915494309189535f); }

namespace pg8 {
constexpr int BM = 256, BK = 64, HALF = 128, HTB = HALF * BK * 2, STAGE_BYTES = 8 * HTB, NXCD = 8, WGM = 8;
__host__ __device__ __forceinline__ int lds_byte(int r, int c) { const int st = (r >> 4) * 2 + (c >> 5), rr = r & 15, cc = c & 31, ob = rr * 64 + cc * 2; return st * 1024 + (ob ^ (((ob >> 9) & 1) << 5)); }
__host__ __device__ __forceinline__ void stage_rc(int b, int& R, int& C) { const int st = b / 1024, sb = b % 1024, swz = sb ^ (((sb >> 9) & 1) << 5); R = (st >> 1) * 16 + swz / 64; C = (st & 1) * 32 + (swz % 64) / 2; }
__host__ __device__ __forceinline__ int perm32(int rho) { const int n = rho >> 4, i = rho & 15; return 8 * (i >> 2) + 4 * n + (i & 3); }

struct Unit { int pm, pn; const char* a; const char* b; };
struct Gemm { int K, lda, ldb; };

struct StaticOrder {
    int nM, nN, nwg, G, c; const char* A; const char* B; size_t astep, bstep;
    __device__ void init(const void* A_, int lda, const void* B_, int ldb, int M, int N, int G_, int c_) {
        nM = M / BM; nN = N / BM; nwg = nM * nN; G = G_; c = c_; A = (const char*)A_; B = (const char*)B_; astep = (size_t)BM * lda * 2; bstep = (size_t)BM * ldb * 2; }
    __device__ bool next(int i, Unit& u) const {
        const long L = (long)i * G + c; if (L >= nwg) return false;
        int wgid = (int)L; { const int q = nwg / NXCD, r = nwg % NXCD, xcd = wgid % NXCD, off = wgid / NXCD; wgid = (xcd < r ? xcd * (q + 1) : r * (q + 1) + (xcd - r) * q) + off; }
        const int nig = WGM * nN, gid = wgid / nig, fm = gid * WGM, gsz = (nM - fm) < WGM ? (nM - fm) : WGM;
        u.pm = fm + ((wgid % nig) % gsz); u.pn = (wgid % nig) / gsz; u.a = A + (size_t)u.pm * astep; u.b = B + (size_t)u.pn * bstep; return true;
    }
    __device__ __forceinline__ void a_ready(const Unit&) const {}
    __device__ __forceinline__ void done(const Unit&) const {}
};

template <class Epi, class Sched, bool ALIGN_EPI = true, bool SP2 = true>
__device__ __forceinline__ void gemm_phase(LAS unsigned char* lds, const Gemm g, const Sched& S, const Epi& E) {
    int tid = threadIdx.x; asm volatile("" : "+v"(tid));
    const int wid = __builtin_amdgcn_readfirstlane(tid >> 6), lane = tid & 63, wr = wid >> 2, wc = wid & 3, fr = lane & 15, fq = lane >> 4;
    const int K = g.K, nt = K / BK;
    unsigned voffA[2], voffB[2];
#pragma unroll
    for (int i = 0; i < 2; ++i) { int R, C; stage_rc(tid * 16 + i * 8192, R, C); const int Rb = Epi::PERM ? ((R & ~31) + perm32(R & 31)) : R;
        voffA[i] = (unsigned)(R * g.lda + C) * 2u; voffB[i] = (unsigned)(Rb * g.ldb + C) * 2u; }
    const size_t kstep = (size_t)(BK * 2);
    const size_t hstepA = (size_t)HALF * g.lda * 2, hstepB = (size_t)HALF * g.ldb * 2;
    const unsigned ldsw = (unsigned)wid * 1024u;
    const int aoff = lds_byte(wr * 64 + fr, fq * 8), boff = lds_byte(wc * 32 + fr, fq * 8);
#define PG8_SA(b, h) (((b) * 2 + (h)) * HTB)
#define PG8_SB(b, h) ((4 + (b) * 2 + (h)) * HTB)
#define PG8_STAGE(bufoff, gbase, voff) do { _Pragma("unroll") for (int _i = 0; _i < 2; ++_i) \
        __builtin_amdgcn_global_load_lds((const unsigned*)((const char*)(gbase) + (voff)[_i]), (LAS unsigned*)(lds + (bufoff) + ldsw + _i * 8192), 16, 0, 0); } while (0)
#define PG8_LDA(dst, b, h) do { _Pragma("unroll") for (int m = 0; m < 4; ++m) _Pragma("unroll") for (int k = 0; k < 2; ++k) dst[m][k] = *(const LAS bf16x8*)(lds + PG8_SA(b, h) + aoff + m * 2048 + k * 1024); } while (0)
#define PG8_LDB(dst, b, h) do { _Pragma("unroll") for (int n = 0; n < 2; ++n) _Pragma("unroll") for (int k = 0; k < 2; ++k) dst[n][k] = *(const LAS bf16x8*)(lds + PG8_SB(b, h) + boff + n * 2048 + k * 1024); } while (0)
#define PG8_MMA(ai, bj, At, Bt) do { __builtin_amdgcn_s_setprio(1); _Pragma("unroll") for (int m = 0; m < 4; ++m) _Pragma("unroll") for (int n = 0; n < 2; ++n) _Pragma("unroll") for (int k = 0; k < 2; ++k) \
        acc[ai][bj][m][n] = __builtin_amdgcn_mfma_f32_16x16x32_bf16(Bt[n][k], At[m][k], acc[ai][bj][m][n], 0, 0, 0); __builtin_amdgcn_s_setprio(0); } while (0)
#define PG8_WAIT_V(n) asm volatile("s_waitcnt vmcnt(" #n ")" ::: "memory")
#define PG8_WAIT_L(n) asm volatile("s_waitcnt lgkmcnt(" #n ")" ::: "memory")
#define PG8_BAR __builtin_amdgcn_s_barrier()
#define PG8_SCHED __builtin_amdgcn_sched_barrier(0)
    Unit cur, nxt; int ui = 0;
    if (!S.next(0, cur)) return;
    f32x4 acc[2][2][4][2];
#pragma unroll
    for (int a = 0; a < 2; ++a)
#pragma unroll
        for (int b = 0; b < 2; ++b)
#pragma unroll
            for (int m = 0; m < 4; ++m)
#pragma unroll
                for (int n = 0; n < 2; ++n) acc[a][b][m][n] = (f32x4){0.f, 0.f, 0.f, 0.f};
    bf16x8 At[4][2], B0[2][2], B1[2][2];
    const char* cA = cur.a; const char* cB = cur.b;
    S.a_ready(cur);
    if constexpr (SP2) {
        PG8_STAGE(PG8_SB(0, 0), cB, voffB); PG8_STAGE(PG8_SB(0, 1), cB + hstepB, voffB); PG8_STAGE(PG8_SA(0, 0), cA, voffA); PG8_STAGE(PG8_SA(0, 1), cA + hstepA, voffA);
        if (wr == 1) PG8_BAR;
        PG8_WAIT_V(2); PG8_BAR;
        PG8_STAGE(PG8_SB(1, 0), cB + kstep, voffB); PG8_STAGE(PG8_SA(1, 0), cA + kstep, voffA); PG8_STAGE(PG8_SB(1, 1), cB + hstepB + kstep, voffB);
        PG8_WAIT_V(6); PG8_BAR;
    } else {
        PG8_STAGE(PG8_SB(0, 0), cB, voffB); PG8_STAGE(PG8_SA(0, 0), cA, voffA); PG8_STAGE(PG8_SB(0, 1), cB + hstepB, voffB); PG8_STAGE(PG8_SA(0, 1), cA + hstepA, voffA);
        if (wr == 1) PG8_BAR;
        PG8_WAIT_V(4); PG8_BAR;
        PG8_STAGE(PG8_SB(1, 0), cB + kstep, voffB); PG8_STAGE(PG8_SA(1, 0), cA + kstep, voffA); PG8_STAGE(PG8_SB(1, 1), cB + hstepB + kstep, voffB);
        PG8_WAIT_V(6); PG8_BAR;
    }
    for (;;) {
        const bool has_next = S.next(ui + 1, nxt);
        const char* nA = has_next ? nxt.a : cA; const char* nB = has_next ? nxt.b : cB;
        for (int t = 0; t < nt; t += 2) {
            const bool last = (t == nt - 2);
            const char* a1 = cA + (size_t)(t + 1) * kstep;
            const char* a2 = last ? nA : cA + (size_t)(t + 2) * kstep; const char* b2 = last ? nB : cB + (size_t)(t + 2) * kstep;
            const char* a3 = a2 + kstep; const char* b3 = b2 + kstep;
            if (last && has_next) S.a_ready(nxt);
            if constexpr (SP2) {
            PG8_LDB(B0, 0, 0); PG8_LDB(B1, 0, 1); PG8_SCHED; PG8_LDA(At, 0, 0); PG8_STAGE(PG8_SA(1, 1), a1 + hstepA, voffA);
            PG8_WAIT_V(8); PG8_WAIT_L(0); PG8_BAR; PG8_MMA(0, 0, At, B0); PG8_MMA(0, 1, At, B1); PG8_BAR; PG8_SCHED;
            PG8_LDA(At, 0, 1); PG8_STAGE(PG8_SB(0, 0), b2, voffB); PG8_STAGE(PG8_SB(0, 1), b2 + hstepB, voffB); PG8_STAGE(PG8_SA(0, 0), a2, voffA);
            PG8_WAIT_V(8); PG8_WAIT_L(0); PG8_BAR; PG8_MMA(1, 0, At, B0); PG8_MMA(1, 1, At, B1); PG8_BAR; PG8_SCHED;
            PG8_LDB(B0, 1, 0); PG8_LDB(B1, 1, 1); PG8_SCHED; PG8_LDA(At, 1, 0); PG8_STAGE(PG8_SA(0, 1), a2 + hstepA, voffA);
            PG8_WAIT_V(8); PG8_WAIT_L(0); PG8_BAR; PG8_MMA(0, 0, At, B0); PG8_MMA(0, 1, At, B1); PG8_BAR; PG8_SCHED;
            PG8_LDA(At, 1, 1); PG8_STAGE(PG8_SB(1, 0), b3, voffB); PG8_STAGE(PG8_SB(1, 1), b3 + hstepB, voffB); PG8_STAGE(PG8_SA(1, 0), a3, voffA);
            PG8_WAIT_V(8); PG8_WAIT_L(0); PG8_BAR; PG8_MMA(1, 0, At, B0); PG8_MMA(1, 1, At, B1); PG8_BAR; PG8_SCHED;
            } else {
            PG8_LDB(B0, 0, 0); PG8_SCHED; PG8_LDA(At, 0, 0); PG8_STAGE(PG8_SA(1, 1), a1 + hstepA, voffA);
            PG8_WAIT_L(8); PG8_BAR; PG8_WAIT_L(0); PG8_MMA(0, 0, At, B0); PG8_BAR; PG8_SCHED;
            PG8_LDB(B1, 0, 1); PG8_STAGE(PG8_SB(0, 0), b2, voffB);
            PG8_BAR; PG8_WAIT_L(0); PG8_MMA(0, 1, At, B1); PG8_BAR;
            PG8_LDA(At, 0, 1); PG8_STAGE(PG8_SA(0, 0), a2, voffA);
            PG8_BAR; PG8_WAIT_L(0); PG8_MMA(1, 0, At, B0); PG8_BAR; PG8_SCHED;
            PG8_STAGE(PG8_SB(0, 1), b2 + hstepB, voffB);
            PG8_WAIT_V(6); PG8_BAR; PG8_MMA(1, 1, At, B1); PG8_BAR;
            PG8_LDB(B0, 1, 0); PG8_SCHED; PG8_LDA(At, 1, 0); PG8_STAGE(PG8_SA(0, 1), a2 + hstepA, voffA);
            PG8_WAIT_L(8); PG8_BAR; PG8_WAIT_L(0); PG8_MMA(0, 0, At, B0); PG8_BAR; PG8_SCHED;
            PG8_LDB(B1, 1, 1); PG8_STAGE(PG8_SB(1, 0), b3, voffB);
            PG8_BAR; PG8_WAIT_L(0); PG8_MMA(0, 1, At, B1); PG8_BAR;
            PG8_LDA(At, 1, 1); PG8_STAGE(PG8_SA(1, 0), a3, voffA);
            PG8_BAR; PG8_WAIT_L(0); PG8_MMA(1, 0, At, B0); PG8_BAR; PG8_SCHED;
            PG8_STAGE(PG8_SB(1, 1), b3 + hstepB, voffB);
            PG8_WAIT_V(6); PG8_BAR; PG8_MMA(1, 1, At, B1); PG8_BAR;
            }
        }
        if constexpr (ALIGN_EPI) { if (wr == 0) PG8_BAR; }
        E(acc, cur, wr, wc, fr, fq); S.done(cur);
        if (!has_next) break;
#pragma unroll
        for (int a = 0; a < 2; ++a)
#pragma unroll
            for (int b = 0; b < 2; ++b)
#pragma unroll
                for (int m = 0; m < 4; ++m)
#pragma unroll
                    for (int n = 0; n < 2; ++n) acc[a][b][m][n] = (f32x4){0.f, 0.f, 0.f, 0.f};
        cur = nxt; cA = nA; cB = nB; ++ui;
        if constexpr (ALIGN_EPI) { if (wr == 1) PG8_BAR; }
    }
    PG8_WAIT_V(0);
    if constexpr (!ALIGN_EPI) { if (wr == 0) PG8_BAR; }
    PG8_BAR;
#undef PG8_SA
#undef PG8_SB
#undef PG8_STAGE
#undef PG8_LDA
#undef PG8_LDB
#undef PG8_MMA
#undef PG8_WAIT_V
#undef PG8_WAIT_L
#undef PG8_BAR
#undef PG8_SCHED
}
}

typedef f32x4 AccT[2][2][4][2];
struct EpiStoreBf16 {
    static constexpr bool PERM = true;
    bf16_t* O; int ldc;
    __device__ __forceinline__ void operator()(const AccT& acc, const pg8::Unit& u, int wr, int wc, int fr, int fq) const {
        const int row0 = u.pm * 256 + wr * 64 + fr, col0 = u.pn * 256 + wc * 32 + 8 * fq;
#pragma unroll
        for (int ai = 0; ai < 2; ++ai)
#pragma unroll
            for (int m = 0; m < 4; ++m) { bf16_t* rowp = O + (size_t)(row0 + ai * 128 + m * 16) * ldc + col0;
#pragma unroll
                for (int bj = 0; bj < 2; ++bj) { const f32x4 v0 = acc[ai][bj][m][0], v1 = acc[ai][bj][m][1];
                    u32x4 w; w.x = cvt_pk_bf16(v0[0], v0[1]); w.y = cvt_pk_bf16(v0[2], v0[3]); w.z = cvt_pk_bf16(v1[0], v1[1]); w.w = cvt_pk_bf16(v1[2], v1[3]);
                    *(u32x4*)(rowp + bj * 128) = w; } }
    }
};
struct EpiMerge1 {
    static constexpr bool PERM = true;
    float* t1; const bf16_t* P;
    __device__ __forceinline__ void operator()(const AccT& acc, const pg8::Unit& u, int wr, int wc, int fr, int fq) const {
        const int row0 = u.pm * 256 + wr * 64 + fr, col0 = u.pn * 256 + wc * 32 + 8 * fq;
#pragma unroll
        for (int ai = 0; ai < 2; ++ai)
#pragma unroll
            for (int m = 0; m < 4; ++m) { const int r = row0 + ai * 128 + m * 16;
#pragma unroll
                for (int bj = 0; bj < 2; ++bj) { const int c = col0 + bj * 128;
                    const u32x4 g = *(const u32x4*)(P + (size_t)r * PW + PGA + c);
                    const f32x4 v0 = acc[ai][bj][m][0], v1 = acc[ai][bj][m][1];
                    f32x4 o0, o1;
                    o0[0] = sigmoidf_(bflo(g.x)) * v0[0]; o0[1] = sigmoidf_(bfhi(g.x)) * v0[1]; o0[2] = sigmoidf_(bflo(g.y)) * v0[2]; o0[3] = sigmoidf_(bfhi(g.y)) * v0[3];
                    o1[0] = sigmoidf_(bflo(g.z)) * v1[0]; o1[1] = sigmoidf_(bfhi(g.z)) * v1[1]; o1[2] = sigmoidf_(bflo(g.w)) * v1[2]; o1[3] = sigmoidf_(bfhi(g.w)) * v1[3];
                    float* tp = t1 + (size_t)r * D + c; *(f32x4*)tp = o0; *(f32x4*)(tp + 4) = o1; } }
    }
};
struct EpiMerge2 {
    static constexpr bool PERM = true;
    const float* t1; const bf16_t* P; bf16_t* O;
    __device__ __forceinline__ void operator()(const AccT& acc, const pg8::Unit& u, int wr, int wc, int fr, int fq) const {
        const int row0 = u.pm * 256 + wr * 64 + fr, col0 = u.pn * 256 + wc * 32 + 8 * fq;
#pragma unroll
        for (int ai = 0; ai < 2; ++ai)
#pragma unroll
            for (int m = 0; m < 4; ++m) { const int r = row0 + ai * 128 + m * 16;
#pragma unroll
                for (int bj = 0; bj < 2; ++bj) { const int c = col0 + bj * 128;
                    const u32x4 g = *(const u32x4*)(P + (size_t)r * PW + PGB + c);
                    const float* tp = t1 + (size_t)r * D + c; const f32x4 a0 = *(const f32x4*)tp, a1 = *(const f32x4*)(tp + 4);
                    const f32x4 v0 = acc[ai][bj][m][0], v1 = acc[ai][bj][m][1];
                    f32x4 o0, o1;
                    o0[0] = a0[0] + sigmoidf_(bflo(g.x)) * v0[0]; o0[1] = a0[1] + sigmoidf_(bfhi(g.x)) * v0[1]; o0[2] = a0[2] + sigmoidf_(bflo(g.y)) * v0[2]; o0[3] = a0[3] + sigmoidf_(bfhi(g.y)) * v0[3];
                    o1[0] = a1[0] + sigmoidf_(bflo(g.z)) * v1[0]; o1[1] = a1[1] + sigmoidf_(bfhi(g.z)) * v1[1]; o1[2] = a1[2] + sigmoidf_(bflo(g.w)) * v1[2]; o1[3] = a1[3] + sigmoidf_(bfhi(g.w)) * v1[3];
                    u32x4 w; w.x = cvt_pk_bf16(o0[0], o0[1]); w.y = cvt_pk_bf16(o0[2], o0[3]); w.z = cvt_pk_bf16(o1[0], o1[1]); w.w = cvt_pk_bf16(o1[2], o1[3]);
                    *(u32x4*)(O + (size_t)r * D + c) = w; } }
    }
};
struct EpiResid {
    static constexpr bool PERM = false;
    float* x; const float* gate; const float* rw; int e;
    __device__ __forceinline__ void operator()(const AccT& acc, const pg8::Unit& u, int wr, int wc, int fr, int fq) const {
        const int row0 = u.pm * 256 + wr * 64 + fr, col0 = u.pn * 256 + wc * 32 + 4 * fq;
        const int b = (u.pm < 64) ? (u.pm >> 4) : 4;
        const float* gp = gate + (size_t)b * 6144 + col0;
        f32x4 gv[2][2];
#pragma unroll
        for (int bj = 0; bj < 2; ++bj)
#pragma unroll
            for (int n = 0; n < 2; ++n) gv[bj][n] = *(const f32x4*)(gp + bj * 128 + n * 16);
#pragma unroll
        for (int ai = 0; ai < 2; ++ai)
#pragma unroll
            for (int m = 0; m < 4; ++m) { const int r = row0 + ai * 128 + m * 16; float* rowp = x + (size_t)r * D + col0;
                const float rs = rw ? rw[(size_t)r * 8 + e] : 1.f;
#pragma unroll
                for (int bj = 0; bj < 2; ++bj)
#pragma unroll
                    for (int n = 0; n < 2; ++n) { float* p = rowp + bj * 128 + n * 16; *(f32x4*)p = *(const f32x4*)p + gv[bj][n] * acc[ai][bj][m][n] * rs; } }
    }
};
struct EpiSwiglu {
    static constexpr bool PERM = true;
    bf16_t* O;
    __device__ __forceinline__ void operator()(const AccT& acc, const pg8::Unit& u, int wr, int wc, int fr, int fq) const {
        const int row0 = u.pm * 256 + wr * 64 + fr, col0 = u.pn * 128 + wc * 32 + 8 * fq;
#pragma unroll
        for (int ai = 0; ai < 2; ++ai)
#pragma unroll
            for (int m = 0; m < 4; ++m) { const int r = row0 + ai * 128 + m * 16;
                float o[8];
#pragma unroll
                for (int n = 0; n < 2; ++n)
#pragma unroll
                    for (int j = 0; j < 4; ++j) { const float a = acc[ai][0][m][n][j], g = acc[ai][1][m][n][j]; o[n * 4 + j] = a * sigmoidf_(a) * g; }
                u32x4 w; w.x = cvt_pk_bf16(o[0], o[1]); w.y = cvt_pk_bf16(o[2], o[3]); w.z = cvt_pk_bf16(o[4], o[5]); w.w = cvt_pk_bf16(o[6], o[7]);
                *(u32x4*)(O + (size_t)r * FF + col0) = w; }
    }
};

struct Args { const float* in[30]; float* out; unsigned char* ws; int l, e, ph, pad; };
enum { I_X = 0, I_C, I_CTX, I_CCTX, I_WMOD, I_BMOD, I_N1G, I_N2G, I_WIN, I_RPB, I_HCW, I_HCB, I_HW1, I_HB1, I_HW2, I_HB2, I_HW3, I_HFREQ, I_HBIAS,
       I_WPA, I_WPB, I_WO, I_FW1, I_FW3, I_FW2, I_ROUTER, I_MW1, I_MW3, I_MW2, I_FINALG };

constexpr int MISC_OFF = 131072 + 320;
constexpr int PTR_OFF = MISC_OFF + 128;
struct Ctx {
    LAS unsigned char* lds; int tid, lane, wave, G, bid; unsigned char* ws;
};
__device__ __forceinline__ Ctx mk_ctx(LAS unsigned char* lds, unsigned char* ws) {
    Ctx c; int t = threadIdx.x; asm volatile("" : "+v"(t)); asm volatile("" : "+s"(ws)); c.lds = lds; c.tid = t; c.lane = t & 63; c.wave = __builtin_amdgcn_readfirstlane(t >> 6); c.G = gridDim.x; c.bid = blockIdx.x; c.ws = ws; return c;
}
__device__ __forceinline__ const float* inp(const Ctx& c, int i) {
    const volatile LAS unsigned* p = (const volatile LAS unsigned*)(c.lds + PTR_OFF) + 2 * i;
    const unsigned lo = __builtin_amdgcn_readfirstlane(p[0]), hi = __builtin_amdgcn_readfirstlane(p[1]);
    return (const float*)(((unsigned long long)hi << 32) | (unsigned long long)lo);
}

__device__ __forceinline__ void transpose_item(const float* W, int N, bf16_t* WT, int ldk, int k0, int n0, int drow0, LAS float* scr, int lane) {
#pragma unroll 8
    for (int i = 0; i < 32; ++i) { const int kk = 2 * i + (lane >> 5); scr[kk * 33 + (lane & 31)] = W[(size_t)(k0 + kk) * N + n0 + (lane & 31)]; }
    LDS_WAIT(); asm volatile("" ::: "memory");
    const int c = lane & 7;
#pragma unroll
    for (int j = 0; j < 4; ++j) { const int n = (lane >> 3) + 8 * j; const LAS float* s = scr + (8 * c) * 33 + n;
        u32x4 o; o.x = cvt_pk_bf16(s[0 * 33], s[1 * 33]); o.y = cvt_pk_bf16(s[2 * 33], s[3 * 33]); o.z = cvt_pk_bf16(s[4 * 33], s[5 * 33]); o.w = cvt_pk_bf16(s[6 * 33], s[7 * 33]);
        *(u32x4*)(WT + (size_t)(drow0 + n) * ldk + k0 + 8 * c) = o; }
    LDS_WAIT(); asm volatile("" ::: "memory");
}
__device__ __forceinline__ void conv_mat(const float* W, int K, int N, bf16_t* WT, int mode, int& base, int gw, int NGW, LAS float* scr, int lane) {
    const int nblk = N / 32, nitems = (K / 64) * nblk;
    const int start = (gw - (base % NGW) + NGW) % NGW;
    for (int it = start; it < nitems; it += NGW) {
        const int kb = it / nblk, nb = it % nblk, n0 = nb * 32;
        const int drow0 = mode == 0 ? n0 : ((n0 >> 7) * 256 + (n0 & 127) + (mode == 2 ? 128 : 0));
        transpose_item(W, N, WT, K, kb * 64, n0, drow0, scr, lane);
    }
    base += nitems;
}
__device__ __forceinline__ void ph_convert(const Ctx& c0) {
    const Ctx c = mk_ctx(c0.lds, c0.ws);
    unsigned char* ws = c.ws;
    LAS float* scr = (LAS float*)(c.lds + c.wave * 16384);
    const int gw = c.bid * NWAVES + c.wave, NGW = c.G * NWAVES; int base = 0;
    for (int l = 0; l < DEPTH; ++l) {
        conv_mat(inp(c, I_WIN) + (size_t)l * D * PW, D, PW, (bf16_t*)(ws + WS_WIN) + (size_t)l * PW * D, 0, base, gw, NGW, scr, c.lane);
        conv_mat(inp(c, I_WPA) + (size_t)l * 512 * D, 512, D, (bf16_t*)(ws + WS_WPA) + (size_t)l * D * 512, 0, base, gw, NGW, scr, c.lane);
        conv_mat(inp(c, I_WPB) + (size_t)l * 512 * D, 512, D, (bf16_t*)(ws + WS_WPB) + (size_t)l * D * 512, 0, base, gw, NGW, scr, c.lane);
        conv_mat(inp(c, I_WO) + (size_t)l * D * D, D, D, (bf16_t*)(ws + WS_WO) + (size_t)l * D * D, 0, base, gw, NGW, scr, c.lane);
    }
    for (int i = 0; i < 2; ++i) {
        conv_mat(inp(c, I_FW1) + (size_t)i * D * FF, D, FF, (bf16_t*)(ws + WS_W13D) + (size_t)i * 2 * FF * D, 1, base, gw, NGW, scr, c.lane);
        conv_mat(inp(c, I_FW3) + (size_t)i * D * FF, D, FF, (bf16_t*)(ws + WS_W13D) + (size_t)i * 2 * FF * D, 2, base, gw, NGW, scr, c.lane);
        conv_mat(inp(c, I_FW2) + (size_t)i * FF * D, FF, D, (bf16_t*)(ws + WS_W2D) + (size_t)i * D * FF, 0, base, gw, NGW, scr, c.lane);
    }
    for (int ie = 0; ie < 2 * NE; ++ie) {
        conv_mat(inp(c, I_MW1) + (size_t)ie * D * FF, D, FF, (bf16_t*)(ws + WS_W13M) + (size_t)ie * 2 * FF * D, 1, base, gw, NGW, scr, c.lane);
        conv_mat(inp(c, I_MW3) + (size_t)ie * D * FF, D, FF, (bf16_t*)(ws + WS_W13M) + (size_t)ie * 2 * FF * D, 2, base, gw, NGW, scr, c.lane);
        conv_mat(inp(c, I_MW2) + (size_t)ie * FF * D, FF, D, (bf16_t*)(ws + WS_W2M) + (size_t)ie * D * FF, 0, base, gw, NGW, scr, c.lane);
    }
}

__device__ __forceinline__ void ph_mod(const Ctx& c0) {
    const Ctx c = mk_ctx(c0.lds, c0.ws);
    float* mod = (float*)(c.ws + WS_MOD);
    LAS float* s = (LAS float*)c.lds; LAS float* part = s + 5 * 1024;
    const float* cin = inp(c, I_C); const float* cctx = inp(c, I_CCTX); const float* wmod = inp(c, I_WMOD); const float* bmod = inp(c, I_BMOD);
    for (int i = c.tid; i < 5 * 1024; i += NTHR) { const int r = i >> 10, k = i & 1023; const float v = r < 4 ? cin[r * 1024 + k] : cctx[k]; s[i] = v * sigmoidf_(v); }
    __syncthreads();
    for (int unit = c.bid; unit < DEPTH * 96; unit += c.G) {
        const int l = unit / 96, j0 = (unit % 96) * 64;
        const float* w = wmod + (size_t)l * D * 6144 + j0 + c.lane;
        float acc[5] = {0.f, 0.f, 0.f, 0.f, 0.f};
        const int kb = c.wave * 128;
#pragma unroll 8
        for (int k = 0; k < 128; ++k) { const float wv = w[(size_t)(kb + k) * 6144];
#pragma unroll
            for (int r = 0; r < 5; ++r) acc[r] += s[r * 1024 + kb + k] * wv; }
#pragma unroll
        for (int r = 0; r < 5; ++r) part[(c.wave * 5 + r) * 64 + c.lane] = acc[r];
        __syncthreads();
        if (c.tid < 320) { const int r = c.tid >> 6, ln = c.tid & 63; float sum = 0.f;
#pragma unroll
            for (int w8 = 0; w8 < 8; ++w8) sum += part[(w8 * 5 + r) * 64 + ln];
            mod[(size_t)(l * 5 + r) * 6144 + j0 + ln] = sum + bmod[l * 6144 + j0 + ln]; }
        __syncthreads();
    }
}

__device__ __forceinline__ void ph_filt(const Ctx& c0) {
    const Ctx c = mk_ctx(c0.lds, c0.ws);
    const float* hb1 = inp(c, I_HB1); const float* hw1 = inp(c, I_HW1); const float* hb2 = inp(c, I_HB2); const float* hw2 = inp(c, I_HW2); const float* hfreq = inp(c, I_HFREQ); const float* hw3 = inp(c, I_HW3);
    LAS float* zb = (LAS float*)c.lds;
    LAS float* a1 = zb + 16 * 36;
    LAS float* a2 = a1 + 16 * 64;
    const float MINDEC = -3.0701134573253945f, MAXDEC = -15.350567286626973f;
    for (int unit = c.bid; unit < DEPTH * 272; unit += c.G) {
        const int l = unit / 272, uu = unit % 272;
        const int L = uu < 256 ? 4096 : 256, p0 = uu < 256 ? uu * 16 : (uu - 256) * 16;
        float* fout = uu < 256 ? (float*)(c.ws + WS_FL) + (size_t)l * 2 * 4096 * 512 : (float*)(c.ws + WS_FC) + (size_t)l * 2 * 256 * 512;
        for (int i = c.tid; i < 16 * 33; i += NTHR) { const int p = i / 33, q = i % 33; const int pos = p0 + p; float v;
            if (q == 0) v = (float)pos / (float)(L - 1);
            else { const int j = (q - 1) & 15; const double band = 1e-4 + (double)j * ((15.0 - 1e-4) / 15.0); double rev = (double)pos * band / (double)L; rev -= floor(rev);
                v = q <= 16 ? __builtin_amdgcn_cosf((float)rev) : -__builtin_amdgcn_sinf((float)rev); }
            zb[p * 36 + q] = v; }
        __syncthreads();
        for (int i = c.tid; i < 16 * 64; i += NTHR) { const int p = i >> 6, j = i & 63; float s = hb1[l * 64 + j];
            const float* w = hw1 + (size_t)l * 33 * 64 + j;
            for (int q = 0; q < 33; ++q) s += zb[p * 36 + q] * w[q * 64];
            a1[p * 64 + j] = sin_rad(hfreq[l * 128 + j] * s); }
        __syncthreads();
        for (int i = c.tid; i < 16 * 64; i += NTHR) { const int p = i >> 6, j = i & 63; float s = hb2[l * 64 + j];
            const float* w = hw2 + (size_t)l * 64 * 64 + j;
            for (int q = 0; q < 64; ++q) s += a1[p * 64 + q] * w[q * 64];
            a2[p * 64 + j] = sin_rad(hfreq[l * 128 + 64 + j] * s); }
        __syncthreads();
        {
            float acc0[16], acc1[16];
#pragma unroll
            for (int p = 0; p < 16; ++p) { acc0[p] = 0.f; acc1[p] = 0.f; }
            const float* w3 = hw3 + (size_t)l * 64 * 1024 + c.tid;
            for (int k = 0; k < 64; ++k) { const float wa = w3[k * 1024], wb = w3[k * 1024 + 512];
#pragma unroll
                for (int p = 0; p < 16; ++p) { const float av = a2[p * 64 + k]; acc0[p] += av * wa; acc1[p] += av * wb; } }
            const float r0 = fabsf(MINDEC + (float)c.tid * ((MAXDEC - MINDEC) / 1023.f)), r1 = fabsf(MINDEC + (float)(c.tid + 512) * ((MAXDEC - MINDEC) / 1023.f));
#pragma unroll
            for (int p = 0; p < 16; ++p) { const int pos = p0 + p; const float dist = fabsf((float)(pos - L / 2)) * (2.f / (float)L);
                fout[(size_t)(0 * L + pos) * 512 + c.tid] = acc0[p] * (__expf(-dist * r0) + 0.05f);
                fout[(size_t)(1 * L + pos) * 512 + c.tid] = acc1[p] * (__expf(-dist * r1) + 0.05f); }
        }
        __syncthreads();
    }
}

__device__ __forceinline__ void ph_norm(const Ctx& c0, int l, int which) {
    const Ctx c = mk_ctx(c0.lds, c0.ws);
    float* xres = (float*)(c.ws + WS_X); bf16_t* h = (bf16_t*)(c.ws + WS_H);
    const float* mod = (const float*)(c.ws + WS_MOD) + (size_t)l * 5 * 6144;
    const float* gp = (which == 0 ? inp(c, I_N1G) : inp(c, I_N2G)) + l * D;
    const bool first = (l == 0 && which == 0), route = (which == 1 && (l & 1));
    const float* router = inp(c, I_ROUTER) + (size_t)(l >> 1) * D * NE;
    float* rw = (float*)(c.ws + WS_RW);
    const float* xin = inp(c, I_X); const float* ctxin = inp(c, I_CTX);
    for (int row = c.bid * NWAVES + c.wave; row < T; row += c.G * NWAVES) {
        const float* src = first ? (row < TL ? xin + (size_t)row * D : ctxin + (size_t)(row - TL) * D) : xres + (size_t)row * D;
        const int b = row < TL ? (row >> 12) : 4;
        const float* sh = mod + (size_t)b * 6144 + (which == 0 ? 0 : 3) * 1024; const float* sc = sh + 1024;
        f32x4 v[4]; float ss = 0.f;
#pragma unroll
        for (int j = 0; j < 4; ++j) { v[j] = *(const f32x4*)(src + 4 * (c.lane + 64 * j)); ss += (v[j][0] * v[j][0] + v[j][1] * v[j][1]) + (v[j][2] * v[j][2] + v[j][3] * v[j][3]); }
        ss = wave_sum(ss);
        const float rstd = 1.f / sqrtf(ss * (1.f / D) + EPS);
        if (first) {
#pragma unroll
            for (int j = 0; j < 4; ++j) *(f32x4*)(xres + (size_t)row * D + 4 * (c.lane + 64 * j)) = v[j];
        }
        float lg[8] = {0.f, 0.f, 0.f, 0.f, 0.f, 0.f, 0.f, 0.f};
#pragma unroll
        for (int j = 0; j < 4; ++j) { const int k0 = 4 * (c.lane + 64 * j);
            const f32x4 g4 = *(const f32x4*)(gp + k0), s4 = *(const f32x4*)(sc + k0), h4 = *(const f32x4*)(sh + k0);
            f32x4 o;
#pragma unroll
            for (int q = 0; q < 4; ++q) o[q] = v[j][q] * rstd * g4[q] * (1.f + s4[q]) + h4[q];
            u32x2 w; w.x = cvt_pk_bf16(o[0], o[1]); w.y = cvt_pk_bf16(o[2], o[3]);
            *(u32x2*)(h + (size_t)row * D + k0) = w;
            if (route) {
#pragma unroll
                for (int q = 0; q < 4; ++q) { const f32x4 ra = *(const f32x4*)(router + (size_t)(k0 + q) * 8), rb = *(const f32x4*)(router + (size_t)(k0 + q) * 8 + 4);
                    lg[0] += o[q] * ra[0]; lg[1] += o[q] * ra[1]; lg[2] += o[q] * ra[2]; lg[3] += o[q] * ra[3];
                    lg[4] += o[q] * rb[0]; lg[5] += o[q] * rb[1]; lg[6] += o[q] * rb[2]; lg[7] += o[q] * rb[3]; }
            }
        }
        if (route) {
#pragma unroll
            for (int e = 0; e < 8; ++e) lg[e] = wave_sum(lg[e]);
            int i1 = 0; float v1 = lg[0];
#pragma unroll
            for (int e = 1; e < 8; ++e) if (lg[e] > v1) { v1 = lg[e]; i1 = e; }
            int i2 = -1; float v2 = -3.0e38f;
#pragma unroll
            for (int e = 0; e < 8; ++e) if (e != i1 && lg[e] > v2) { v2 = lg[e]; i2 = e; }
            const float w1 = 1.f / (1.f + __expf(v2 - v1)), w2 = 1.f - w1;
            if (c.lane < 8) rw[(size_t)row * 8 + c.lane] = (c.lane == i1) ? w1 : ((c.lane == i2) ? w2 : 0.f);
        }
    }
}

__device__ __forceinline__ void attn_key(const bf16_t* P, int ktok, int head, float bias, const float (&q)[64], float (&o)[64], float& m, float& s) {
    const u32x4* kp = (const u32x4*)(P + (size_t)ktok * PW + PK + head * 64);
    float sc = 0.f;
#pragma unroll
    for (int i = 0; i < 8; ++i) { const u32x4 w = kp[i];
        sc += q[8 * i + 0] * bflo(w.x) + q[8 * i + 1] * bfhi(w.x) + q[8 * i + 2] * bflo(w.y) + q[8 * i + 3] * bfhi(w.y)
            + q[8 * i + 4] * bflo(w.z) + q[8 * i + 5] * bfhi(w.z) + q[8 * i + 6] * bflo(w.w) + q[8 * i + 7] * bfhi(w.w); }
    sc += bias;
    const float mn = fmaxf(m, sc), al = __expf(m - mn), p = __expf(sc - mn);
    s = s * al + p; m = mn;
    const u32x4* vp = (const u32x4*)(P + (size_t)ktok * PW + PV + head * 64);
#pragma unroll
    for (int i = 0; i < 8; ++i) { const u32x4 w = vp[i];
        o[8 * i + 0] = o[8 * i + 0] * al + p * bflo(w.x); o[8 * i + 1] = o[8 * i + 1] * al + p * bfhi(w.x);
        o[8 * i + 2] = o[8 * i + 2] * al + p * bflo(w.y); o[8 * i + 3] = o[8 * i + 3] * al + p * bfhi(w.y);
        o[8 * i + 4] = o[8 * i + 4] * al + p * bflo(w.z); o[8 * i + 5] = o[8 * i + 5] * al + p * bfhi(w.z);
        o[8 * i + 6] = o[8 * i + 6] * al + p * bflo(w.w); o[8 * i + 7] = o[8 * i + 7] * al + p * bfhi(w.w); }
}
__device__ __forceinline__ void ph_attn_naive(const Ctx& c0, int l) {
    const Ctx c = mk_ctx(c0.lds, c0.ws);
    const bf16_t* P = (const bf16_t*)(c.ws + WS_P); bf16_t* oatt = (bf16_t*)(c.ws + WS_OATT);
    const float* rpb = inp(c, I_RPB) + (size_t)l * 8 * 15 * 31;
    for (int item = c.bid * NTHR + c.tid; item < T * 8; item += c.G * NTHR) {
        const int head = item & 7, tok = item >> 3;
        float q[64], o[64]; float m = -3.0e38f, s = 0.f;
        { const u32x4* qp = (const u32x4*)(P + (size_t)tok * PW + PQ + head * 64);
#pragma unroll
          for (int i = 0; i < 8; ++i) { const u32x4 w = qp[i];
              q[8 * i + 0] = 0.125f * bflo(w.x); q[8 * i + 1] = 0.125f * bfhi(w.x); q[8 * i + 2] = 0.125f * bflo(w.y); q[8 * i + 3] = 0.125f * bfhi(w.y);
              q[8 * i + 4] = 0.125f * bflo(w.z); q[8 * i + 5] = 0.125f * bfhi(w.z); q[8 * i + 6] = 0.125f * bflo(w.w); q[8 * i + 7] = 0.125f * bfhi(w.w); } }
#pragma unroll
        for (int i = 0; i < 64; ++i) o[i] = 0.f;
        int b;
        if (tok < TL) {
            b = tok >> 12; const int t = tok & 4095, r = t >> 6, qc = t & 63;
            const int r0 = min(max(r - 4, 0), 56), c0 = min(max(qc - 8, 0), 48);
            for (int kr = 0; kr < 8; ++kr) for (int kc = 0; kc < 16; ++kc) {
                const int krow = r0 + kr, kcol = c0 + kc;
                const float bias = rpb[(head * 15 + (krow - r + 7)) * 31 + (kcol - qc + 15)];
                attn_key(P, b * 4096 + krow * 64 + kcol, head, bias, q, o, m, s);
            }
        } else b = (tok - TL) >> 8;
        for (int j = 0; j < 256; ++j) attn_key(P, TL + b * 256 + j, head, 0.f, q, o, m, s);
        const float inv = 1.f / s;
        u32x4* op = (u32x4*)(oatt + (size_t)tok * 512 + head * 64);
#pragma unroll
        for (int i = 0; i < 8; ++i) { u32x4 w; w.x = cvt_pk_bf16(o[8 * i] * inv, o[8 * i + 1] * inv); w.y = cvt_pk_bf16(o[8 * i + 2] * inv, o[8 * i + 3] * inv);
            w.z = cvt_pk_bf16(o[8 * i + 4] * inv, o[8 * i + 5] * inv); w.w = cvt_pk_bf16(o[8 * i + 6] * inv, o[8 * i + 7] * inv); op[i] = w; }
    }
}

__device__ __forceinline__ void ph_sc(const Ctx& c0, int l) {
    const Ctx c = mk_ctx(c0.lds, c0.ws);
    const bf16_t* P = (const bf16_t*)(c.ws + WS_P); bf16_t* vsc = (bf16_t*)(c.ws + WS_B);
    const float* cw = inp(c, I_HCW) + (size_t)l * 3 * 1536; const float* cb = inp(c, I_HCB) + (size_t)l * 1536;
    for (int item = c.bid * NTHR + c.tid; item < T * 192; item += c.G * NTHR) {
        const int row = item / 192, ch0 = (item % 192) * 8;
        const int tpos = row < TL ? (row & 4095) : ((row - TL) & 255), Ls = row < TL ? 4096 : 256;
        const bf16_t* up = P + (size_t)row * PW + PHY + ch0;
        const u32x4 z4 = (u32x4){0u, 0u, 0u, 0u};
        const u32x4 u0 = tpos > 0 ? *(const u32x4*)(up - PW) : z4, u1 = *(const u32x4*)up, u2 = tpos < Ls - 1 ? *(const u32x4*)(up + PW) : z4;
        float o[8];
#pragma unroll
        for (int j = 0; j < 4; ++j) {
            const unsigned w0 = u0[j], w1 = u1[j], w2 = u2[j]; const int ch = ch0 + 2 * j;
            o[2 * j] = cw[ch] * bflo(w0) + cw[1536 + ch] * bflo(w1) + cw[3072 + ch] * bflo(w2) + cb[ch];
            o[2 * j + 1] = cw[ch + 1] * bfhi(w0) + cw[1536 + ch + 1] * bfhi(w1) + cw[3072 + ch + 1] * bfhi(w2) + cb[ch + 1];
        }
        u32x4 w; w.x = cvt_pk_bf16(o[0], o[1]); w.y = cvt_pk_bf16(o[2], o[3]); w.z = cvt_pk_bf16(o[4], o[5]); w.w = cvt_pk_bf16(o[6], o[7]);
        *(u32x4*)(vsc + (size_t)row * 1536 + ch0) = w;
    }
}

__device__ __forceinline__ void ph_conv_naive(const Ctx& c0, int l, int o) {
    const Ctx c = mk_ctx(c0.lds, c0.ws);
    const bf16_t* vsc = (const bf16_t*)(c.ws + WS_B); float* zb = (float*)(c.ws + WS_Z); bf16_t* ohy = (bf16_t*)(c.ws + WS_OHY);
    const int ch = c.tid;
    const float bias = inp(c, I_HBIAS)[(l * 2 + o) * 512 + ch];
    for (int unit = c.bid; unit < 2048 + 128; unit += c.G) {
        int L, t0, rowbase; const float* filt;
        if (unit < 2048) { const int b = unit >> 9; t0 = (unit & 511) * 8; L = 4096; rowbase = b * 4096; filt = (const float*)(c.ws + WS_FL) + (size_t)(l * 2 + o) * 4096 * 512; }
        else { const int uu = unit - 2048, b = uu >> 5; t0 = (uu & 31) * 8; L = 256; rowbase = TL + b * 256; filt = (const float*)(c.ws + WS_FC) + (size_t)(l * 2 + o) * 256 * 512; }
        const int H = L / 2;
        const int s_lo = max(0, t0 - H + 1), s_hi = min(L - 1, t0 + 7 + H);
        float hw[8], acc[8];
#pragma unroll
        for (int j = 0; j < 8; ++j) { const int k = t0 + j - s_lo + H; hw[j] = (k >= 0 && k < L) ? filt[(size_t)k * 512 + ch] : 0.f; acc[j] = 0.f; }
        for (int s = s_lo; s <= s_hi; ++s) {
            const float uv = o == 0 ? bf2f(vsc[(size_t)(rowbase + s) * 1536 + ch]) : zb[(size_t)(rowbase + s) * 512 + ch];
#pragma unroll
            for (int j = 0; j < 8; ++j) acc[j] += uv * hw[j];
#pragma unroll
            for (int j = 7; j > 0; --j) hw[j] = hw[j - 1];
            const int k = t0 - (s + 1) + H; hw[0] = (k >= 0 && k < L) ? filt[(size_t)k * 512 + ch] : 0.f;
        }
#pragma unroll
        for (int j = 0; j < 8; ++j) { const size_t row = (size_t)(rowbase + t0 + j);
            if (o == 0) { const float uv = bf2f(vsc[row * 1536 + ch]), x1 = bf2f(vsc[row * 1536 + 512 + ch]); zb[row * 512 + ch] = x1 * (acc[j] + bias * uv); }
            else { const float uv = zb[row * 512 + ch], x2 = bf2f(vsc[row * 1536 + 1024 + ch]); ohy[row * 512 + ch] = (bf16_t)(cvt_pk_bf16(x2 * (acc[j] + bias * uv), 0.f) & 0xffffu); } }
    }
}

__device__ __forceinline__ void ph_final(const Ctx& c0) {
    const Ctx c = mk_ctx(c0.lds, c0.ws);
    const float* xres = (const float*)(c.ws + WS_X); const float* gp = inp(c, I_FINALG); float* outp = (float*)inp(c, 30);
    for (int row = c.bid * NWAVES + c.wave; row < TL; row += c.G * NWAVES) {
        const float* src = xres + (size_t)row * D; f32x4 v[4]; float ss = 0.f;
#pragma unroll
        for (int j = 0; j < 4; ++j) { v[j] = *(const f32x4*)(src + 4 * (c.lane + 64 * j)); ss += (v[j][0] * v[j][0] + v[j][1] * v[j][1]) + (v[j][2] * v[j][2] + v[j][3] * v[j][3]); }
        ss = wave_sum(ss);
        const float rstd = 1.f / sqrtf(ss * (1.f / D) + EPS);
#pragma unroll
        for (int j = 0; j < 4; ++j) { const int k0 = 4 * (c.lane + 64 * j); const f32x4 g4 = *(const f32x4*)(gp + k0); *(f32x4*)(outp + (size_t)row * D + k0) = v[j] * rstd * g4; }
    }
}

#define XB_TMO      128
#define XB_XCNT(j)  (256  + 64 * (j))
#define XB_XSUB(j)  (1280 + 64 * (j))
#define XB_XGEN(j)  (2304 + 64 * (j))
#define XB_TOP      3328
#define XB_TOPGEN   3392
#define XCD_BAR_WORDS 3456
#define XB_SPIN_CAP (1u << 18)
__device__ __forceinline__ unsigned xb_ld(unsigned* p)              { return __hip_atomic_load(p, __ATOMIC_RELAXED, __HIP_MEMORY_SCOPE_AGENT); }
__device__ __forceinline__ unsigned xb_add(unsigned* p, unsigned v) { return __hip_atomic_fetch_add(p, v, __ATOMIC_RELAXED, __HIP_MEMORY_SCOPE_AGENT); }
__device__ __forceinline__ unsigned xb_xcc_id() { return (unsigned)__builtin_amdgcn_s_getreg((3 << 11) | 20) & 0xFu; }
#define XB_SPIN(cond, bar) do { unsigned _sp = 0; while (cond) { __builtin_amdgcn_s_sleep(1); \
    if ((++_sp & 255u) == 0u) { if (xb_ld(&(bar)[XB_TMO])) break; if (_sp > XB_SPIN_CAP) { atomicAdd(&(bar)[XB_TMO], 1u); break; } } } } while (0)
struct XcdBarrier { unsigned* bar; unsigned x; volatile LAS unsigned* st; };
__device__ __forceinline__ XcdBarrier xcd_barrier_post(unsigned* bar, volatile LAS unsigned* st) {
    XcdBarrier b; b.bar = bar; b.x = xb_xcc_id(); b.st = st;
    if (threadIdx.x == 0) (void)xb_add(&bar[XB_XCNT(b.x)], 1u);
    return b;
}
__device__ __forceinline__ void xcd_barrier_complete(unsigned* bar, unsigned x, unsigned& nloc, unsigned& nx) {
    const unsigned G = gridDim.x * gridDim.y * gridDim.z;
    unsigned sum, cnt, mine, sp = 0u;
    for (;;) {
        sum = 0u; cnt = 0u; mine = 0u;
#pragma unroll
        for (unsigned j = 0; j < 16; ++j) { const unsigned c = xb_ld(&bar[XB_XCNT(j)]); sum += c; cnt += (c > 0u) ? 1u : 0u; mine = (j == x) ? c : mine; }
        if (sum == G) break;
        __builtin_amdgcn_s_sleep(1);
        if ((++sp & 255u) == 0u) { if (xb_ld(&bar[XB_TMO])) break; if (sp > XB_SPIN_CAP) { atomicAdd(&bar[XB_TMO], 1u); break; } }
    }
    nloc = mine > 0u ? mine : 1u; nx = cnt > 0u ? cnt : 1u;
}
__device__ __forceinline__ void xcd_barrier(const XcdBarrier& b) {
    asm volatile("s_waitcnt vmcnt(0)" ::: "memory");
    __syncthreads();
    if (threadIdx.x == 0) {
        unsigned* bar = b.bar;
        __builtin_amdgcn_s_waitcnt(0);
        unsigned nloc = b.st[0], nx = b.st[1];
        if (nloc == 0u) { xcd_barrier_complete(bar, b.x, nloc, nx); b.st[0] = nloc; b.st[1] = nx; }
        const unsigned old = xb_add(&bar[XB_XSUB(b.x)], 1u);
        const unsigned gen = old / nloc;
        if (old + 1u == (gen + 1u) * nloc) {
            __builtin_amdgcn_fence(__ATOMIC_RELEASE, "agent");
            asm volatile("s_waitcnt vmcnt(0)" ::: "memory");
            const unsigned og = xb_add(&bar[XB_TOP], 1u);
            const unsigned tg = og / nx;
            if (og + 1u == (tg + 1u) * nx) xb_add(&bar[XB_TOPGEN], 1u);
            else XB_SPIN(xb_ld(&bar[XB_TOPGEN]) == tg, bar);
            __builtin_amdgcn_fence(__ATOMIC_ACQUIRE, "agent");
            xb_add(&bar[XB_XGEN(b.x)], 1u);
            asm volatile("s_waitcnt vmcnt(0)" ::: "memory");
        } else {
            XB_SPIN(xb_ld(&bar[XB_XGEN(b.x)]) == gen, bar);
            __builtin_amdgcn_fence(__ATOMIC_ACQUIRE, "agent");
            asm volatile("s_waitcnt vmcnt(0)" ::: "memory");
        }
    }
    __syncthreads();
}

constexpr int CW_BAR = 4096;

__global__ void __launch_bounds__(NTHR, 2) fwd(Args args) {
    extern __shared__ __attribute__((aligned(16))) unsigned char lds_raw[];
    Ctx c; c.lds = (LAS unsigned char*)lds_raw; c.tid = threadIdx.x; c.lane = c.tid & 63; c.wave = __builtin_amdgcn_readfirstlane(c.tid >> 6); c.G = gridDim.x; c.bid = blockIdx.x; c.ws = args.ws;
    unsigned char* ws = args.ws;
    volatile LAS unsigned* MISC = (volatile LAS unsigned*)(c.lds + MISC_OFF);
    if (c.tid < 32) MISC[c.tid] = 0u;
    if (c.tid < 31) { const unsigned long long pv = c.tid < 30 ? (unsigned long long)args.in[c.tid] : (unsigned long long)args.out;
        volatile LAS unsigned* pt = (volatile LAS unsigned*)(c.lds + PTR_OFF) + 2 * c.tid; pt[0] = (unsigned)pv; pt[1] = (unsigned)(pv >> 32); }
    __syncthreads();
    XcdBarrier bar = xcd_barrier_post((unsigned*)(ws + WS_CTL) + CW_BAR, MISC + 8);
#define GRID_BAR() xcd_barrier(bar)

    ph_convert(c); __syncthreads(); ph_mod(c); __syncthreads(); ph_filt(c);
    GRID_BAR();
    for (int l = 0; l < DEPTH; ++l) {
        ph_norm(c, l, 0);
        GRID_BAR();
        {   unsigned char* ws = c.ws; asm volatile("" : "+s"(ws));
            pg8::Gemm g{D, D, D}; pg8::StaticOrder S; S.init(ws + WS_H, D, (bf16_t*)(ws + WS_WIN) + (size_t)l * PW * D, D, T, PW, c.G, c.bid);
            EpiStoreBf16 E{(bf16_t*)(ws + WS_P), PW};
            pg8::gemm_phase(c.lds, g, S, E); }
        GRID_BAR();
        ph_attn_naive(c, l); ph_sc(c, l);
        GRID_BAR();
        ph_conv_naive(c, l, 0);
        GRID_BAR();
        ph_conv_naive(c, l, 1);
        GRID_BAR();
        {   unsigned char* ws = c.ws; asm volatile("" : "+s"(ws));
            pg8::Gemm g{512, 512, 512};
            { pg8::StaticOrder S; S.init(ws + WS_OATT, 512, (bf16_t*)(ws + WS_WPA) + (size_t)l * D * 512, 512, T, D, c.G, c.bid);
              EpiMerge1 E{(float*)(ws + WS_B), (const bf16_t*)(ws + WS_P)};
              pg8::gemm_phase(c.lds, g, S, E); }
            { pg8::StaticOrder S; S.init(ws + WS_OHY, 512, (bf16_t*)(ws + WS_WPB) + (size_t)l * D * 512, 512, T, D, c.G, c.bid);
              EpiMerge2 E{(const float*)(ws + WS_B), (const bf16_t*)(ws + WS_P), (bf16_t*)(ws + WS_H)};
              pg8::gemm_phase(c.lds, g, S, E); } }
        GRID_BAR();
        {   unsigned char* ws = c.ws; asm volatile("" : "+s"(ws));
            const float* modl = (const float*)(ws + WS_MOD) + (size_t)l * 5 * 6144;
            pg8::Gemm g{D, D, D}; pg8::StaticOrder S; S.init(ws + WS_H, D, (bf16_t*)(ws + WS_WO) + (size_t)l * D * D, D, T, D, c.G, c.bid);
            EpiResid E{(float*)(ws + WS_X), modl + 2 * 1024, nullptr, 0};
            pg8::gemm_phase(c.lds, g, S, E); }
        GRID_BAR();
        ph_norm(c, l, 1);
        GRID_BAR();
        const bool moe = (l & 1) != 0; const int ne = moe ? NE : 1;
        for (int e = 0; e < ne; ++e) {
            {   unsigned char* ws = c.ws; asm volatile("" : "+s"(ws));
                const bf16_t* w = !moe ? (const bf16_t*)(ws + WS_W13D) + (size_t)(l >> 1) * 2 * FF * D : (const bf16_t*)(ws + WS_W13M) + (size_t)((l >> 1) * NE + e) * 2 * FF * D;
                pg8::Gemm g{D, D, D}; pg8::StaticOrder S; S.init(ws + WS_H, D, w, D, T, 2 * FF, c.G, c.bid);
                EpiSwiglu E{(bf16_t*)(ws + WS_P)};
                pg8::gemm_phase(c.lds, g, S, E); }
            GRID_BAR();
            {   unsigned char* ws = c.ws; asm volatile("" : "+s"(ws));
                const float* modl = (const float*)(ws + WS_MOD) + (size_t)l * 5 * 6144;
                const bf16_t* w = !moe ? (const bf16_t*)(ws + WS_W2D) + (size_t)(l >> 1) * D * FF : (const bf16_t*)(ws + WS_W2M) + (size_t)((l >> 1) * NE + e) * D * FF;
                pg8::Gemm g{FF, FF, FF}; pg8::StaticOrder S; S.init(ws + WS_P, FF, w, FF, T, D, c.G, c.bid);
                EpiResid E{(float*)(ws + WS_X), modl + 5 * 1024, !moe ? nullptr : (const float*)(ws + WS_RW), e};
                pg8::gemm_phase(c.lds, g, S, E); }
            GRID_BAR();
        }
    }
    ph_final(c);
}

extern "C" void kernel_launch(void* const* d_in, const int* in_sizes, int n_in, void* d_out, int out_size, void* d_ws, size_t ws_size, hipStream_t stream) {
    static int grid = 0;
    if (grid == 0) {
        if (n_in != 30 || out_size != TL * D || ws_size < WS_END) { fprintf(stderr, "kernel_launch: unexpected shapes (n_in %d out %d ws %zu)\n", n_in, out_size, ws_size); grid = -1; return; }
        int dev = 0, cus = 0, per_cu = 0; (void)hipGetDevice(&dev); (void)hipDeviceGetAttribute(&cus, hipDeviceAttributeMultiprocessorCount, dev);
        if (hipFuncSetAttribute((const void*)fwd, hipFuncAttributeMaxDynamicSharedMemorySize, LDS_BYTES) != hipSuccess) { fprintf(stderr, "kernel_launch: hipFuncSetAttribute failed\n"); grid = -1; return; }
        if (hipOccupancyMaxActiveBlocksPerMultiprocessor(&per_cu, (const void*)fwd, NTHR, LDS_BYTES) != hipSuccess || per_cu < 1) fprintf(stderr, "kernel_launch: occupancy query reports %d\n", per_cu);
        (void)hipGetLastError();
        grid = cus > 0 ? cus : 256;
    }
    if (grid < 0) return;
    (void)hipMemsetAsync((char*)d_ws + WS_CTL, 0, CTL_ZERO_BYTES, stream);
    Args a{};
    for (int i = 0; i < 30; ++i) a.in[i] = (const float*)d_in[i];
    a.out = (float*)d_out; a.ws = (unsigned char*)d_ws;
    hipLaunchKernelGGL(fwd, dim3(grid), dim3(NTHR), LDS_BYTES, stream, a);
}
```

```cpp
#include <hip/hip_runtime.h>
#include <cstdio>
#include <cstdint>

#define LAS __attribute__((address_space(3)))
#define GAS __attribute__((address_space(1)))
typedef unsigned short bf16_t;
typedef short bf16x8 __attribute__((ext_vector_type(8)));
typedef float f32x4 __attribute__((ext_vector_type(4)));
typedef float f32x2 __attribute__((ext_vector_type(2)));
typedef float f32x16 __attribute__((ext_vector_type(16)));
typedef unsigned u32x4 __attribute__((ext_vector_type(4)));
typedef unsigned u32x2 __attribute__((ext_vector_type(2)));

constexpr int D = 1024, NB = 4, SEQ = 4096, DEPTH = 4, CTX = 256;
constexpr int TL = NB * SEQ, TC = NB * CTX, T = TL + TC;
constexpr int PW = 5120, FF = 2816, NE = 8, HYW = 512;
constexpr int PQ = 0, PK = 512, PV = 1024, PHY = 1536, PGA = 3072, PGB = 4096;
constexpr float EPS = 1e-6f;

constexpr size_t MiB = 1u << 20;
constexpr size_t WS_CTL = 0, CTL_ZERO_BYTES = 1 * MiB;
constexpr size_t WS_MOD = 1 * MiB;
constexpr size_t WS_RW = 2 * MiB;
constexpr size_t WS_WIN = 4 * MiB;
constexpr size_t WS_WPA = 44 * MiB;
constexpr size_t WS_WPB = 48 * MiB;
constexpr size_t WS_WO = 52 * MiB;
constexpr size_t WS_W13D = 60 * MiB;
constexpr size_t WS_W2D = 82 * MiB;
constexpr size_t WS_W13M = 93 * MiB;
constexpr size_t WS_W2M = 269 * MiB;
constexpr size_t WS_X = 357 * MiB;
constexpr size_t WS_H = 425 * MiB;
constexpr size_t WS_P = 459 * MiB;
constexpr size_t WS_OATT = 629 * MiB;
constexpr size_t WS_OHY = 646 * MiB;
constexpr size_t WS_B = 663 * MiB;
constexpr size_t WS_Z = WS_B + 51 * MiB;
constexpr size_t WS_FL = 748 * MiB;
constexpr size_t WS_FC = 812 * MiB;
constexpr size_t WS_HRL = 816 * MiB;
constexpr size_t WS_HRC = 850 * MiB;
constexpr size_t WS_END = 853 * MiB;

constexpr int LDS_BYTES = 147456;
constexpr int NWAVES = 8, NTHR = 512;

#define LDS_WAIT() asm volatile("s_waitcnt lgkmcnt(0)" ::: "memory")
#define VM_WAIT() asm volatile("s_waitcnt vmcnt(0)" ::: "memory")
__device__ __forceinline__ float bf2f(unsigned b) { return __uint_as_float(b << 16); }
__device__ __forceinline__ float bflo(unsigned w) { return __uint_as_float(w << 16); }
__device__ __forceinline__ float bfhi(unsigned w) { return __uint_as_float(w & 0xffff0000u); }
__device__ __forceinline__ unsigned cvt_pk_bf16(float lo, float hi) { unsigned r; asm volatile("v_cvt_pk_bf16_f32 %0, %1, %2" : "=v"(r) : "v"(lo), "v"(hi)); return r; }
__device__ __forceinline__ float wave_sum(float v) {
#pragma unroll
    for (int o = 1; o < 64; o <<= 1) v += __shfl_xor(v, o);
    return v;
}
__device__ __forceinline__ float sigmoidf_(float x) { return 1.f / (1.f + __expf(-x)); }
__device__ __forceinline__ float sin_rev(float r) { return __builtin_amdgcn_sinf(__builtin_amdgcn_fractf(r)); }
__device__ __forceinline__ float sin_rad(float x) { return sin_rev(x * 0.15915494309189535f); }

namespace pg8 {
constexpr int BM = 256, BK = 64, HALF = 128, HTB = HALF * BK * 2, STAGE_BYTES = 8 * HTB, NXCD = 8, WGM = 8;
__host__ __device__ __forceinline__ int lds_byte(int r, int c) { const int st = (r >> 4) * 2 + (c >> 5), rr = r & 15, cc = c & 31, ob = rr * 64 + cc * 2; return st * 1024 + (ob ^ (((ob >> 9) & 1) << 5)); }
__host__ __device__ __forceinline__ void stage_rc(int b, int& R, int& C) { const int st = b / 1024, sb = b % 1024, swz = sb ^ (((sb >> 9) & 1) << 5); R = (st >> 1) * 16 + swz / 64; C = (st & 1) * 32 + (swz % 64) / 2; }
__host__ __device__ __forceinline__ int perm32(int rho) { const int n = rho >> 4, i = rho & 15; return 8 * (i >> 2) + 4 * n + (i & 3); }

struct Unit { int pm, pn; const char* a; const char* b; };
struct Gemm { int K, lda, ldb; };

struct StaticOrder {
    int nM, nN, nwg, G, c; const char* A; const char* B; size_t astep, bstep;
    __device__ void init(const void* A_, int lda, const void* B_, int ldb, int M, int N, int G_, int c_) {
        nM = M / BM; nN = N / BM; nwg = nM * nN; G = G_; c = c_; A = (const char*)A_; B = (const char*)B_; astep = (size_t)BM * lda * 2; bstep = (size_t)BM * ldb * 2; }
    __device__ bool next(int i, Unit& u) const {
        const long L = (long)i * G + c; if (L >= nwg) return false;
        int wgid = (int)L; { const int q = nwg / NXCD, r = nwg % NXCD, xcd = wgid % NXCD, off = wgid / NXCD; wgid = (xcd < r ? xcd * (q + 1) : r * (q + 1) + (xcd - r) * q) + off; }
        const int nig = WGM * nN, gid = wgid / nig, fm = gid * WGM, gsz = (nM - fm) < WGM ? (nM - fm) : WGM;
        u.pm = fm + ((wgid % nig) % gsz); u.pn = (wgid % nig) / gsz; u.a = A + (size_t)u.pm * astep; u.b = B + (size_t)u.pn * bstep; return true;
    }
    __device__ __forceinline__ void a_ready(const Unit&) const {}
    __device__ __forceinline__ void done(const Unit&) const {}
};

template <class Epi, class Sched, bool ALIGN_EPI = true, bool SP2 = true>
__device__ __forceinline__ void gemm_phase(LAS unsigned char* lds, const Gemm g, const Sched& S, const Epi& E) {
    int tid = threadIdx.x; asm volatile("" : "+v"(tid));
    const int wid = __builtin_amdgcn_readfirstlane(tid >> 6), lane = tid & 63, wr = wid >> 2, wc = wid & 3, fr = lane & 15, fq = lane >> 4;
    const int K = g.K, nt = K / BK;
    unsigned voffA[2], voffB[2];
#pragma unroll
    for (int i = 0; i < 2; ++i) { int R, C; stage_rc(tid * 16 + i * 8192, R, C); const int Rb = Epi::PERM ? ((R & ~31) + perm32(R & 31)) : R;
        voffA[i] = (unsigned)(R * g.lda + C) * 2u; voffB[i] = (unsigned)(Rb * g.ldb + C) * 2u; }
    const size_t kstep = (size_t)(BK * 2);
    const size_t hstepA = (size_t)HALF * g.lda * 2, hstepB = (size_t)HALF * g.ldb * 2;
    const unsigned ldsw = (unsigned)wid * 1024u;
    const int aoff = lds_byte(wr * 64 + fr, fq * 8), boff = lds_byte(wc * 32 + fr, fq * 8);
#define PG8_SA(b, h) (((b) * 2 + (h)) * HTB)
#define PG8_SB(b, h) ((4 + (b) * 2 + (h)) * HTB)
#define PG8_STAGE(bufoff, gbase, voff) do { _Pragma("unroll") for (int _i = 0; _i < 2; ++_i) \
        __builtin_amdgcn_global_load_lds((const unsigned*)((const char*)(gbase) + (voff)[_i]), (LAS unsigned*)(lds + (bufoff) + ldsw + _i * 8192), 16, 0, 0); } while (0)
#define PG8_LDA(dst, b, h) do { _Pragma("unroll") for (int m = 0; m < 4; ++m) _Pragma("unroll") for (int k = 0; k < 2; ++k) dst[m][k] = *(const LAS bf16x8*)(lds + PG8_SA(b, h) + aoff + m * 2048 + k * 1024); } while (0)
#define PG8_LDB(dst, b, h) do { _Pragma("unroll") for (int n = 0; n < 2; ++n) _Pragma("unroll") for (int k = 0; k < 2; ++k) dst[n][k] = *(const LAS bf16x8*)(lds + PG8_SB(b, h) + boff + n * 2048 + k * 1024); } while (0)
#define PG8_MMA(ai, bj, At, Bt) do { __builtin_amdgcn_s_setprio(1); _Pragma("unroll") for (int m = 0; m < 4; ++m) _Pragma("unroll") for (int n = 0; n < 2; ++n) _Pragma("unroll") for (int k = 0; k < 2; ++k) \
        acc[ai][bj][m][n] = __builtin_amdgcn_mfma_f32_16x16x32_bf16(Bt[n][k], At[m][k], acc[ai][bj][m][n], 0, 0, 0); __builtin_amdgcn_s_setprio(0); } while (0)
#define PG8_WAIT_V(n) asm volatile("s_waitcnt vmcnt(" #n ")" ::: "memory")
#define PG8_WAIT_L(n) asm volatile("s_waitcnt lgkmcnt(" #n ")" ::: "memory")
#define PG8_BAR __builtin_amdgcn_s_barrier()
#define PG8_SCHED __builtin_amdgcn_sched_barrier(0)
    Unit cur, nxt; int ui = 0;
    if (!S.next(0, cur)) return;
    f32x4 acc[2][2][4][2];
#pragma unroll
    for (int a = 0; a < 2; ++a)
#pragma unroll
        for (int b = 0; b < 2; ++b)
#pragma unroll
            for (int m = 0; m < 4; ++m)
#pragma unroll
                for (int n = 0; n < 2; ++n) acc[a][b][m][n] = (f32x4){0.f, 0.f, 0.f, 0.f};
    bf16x8 At[4][2], B0[2][2], B1[2][2];
    const char* cA = cur.a; const char* cB = cur.b;
    S.a_ready(cur);
    if constexpr (SP2) {
        PG8_STAGE(PG8_SB(0, 0), cB, voffB); PG8_STAGE(PG8_SB(0, 1), cB + hstepB, voffB); PG8_STAGE(PG8_SA(0, 0), cA, voffA); PG8_STAGE(PG8_SA(0, 1), cA + hstepA, voffA);
        if (wr == 1) PG8_BAR;
        PG8_WAIT_V(2); PG8_BAR;
        PG8_STAGE(PG8_SB(1, 0), cB + kstep, voffB); PG8_STAGE(PG8_SA(1, 0), cA + kstep, voffA); PG8_STAGE(PG8_SB(1, 1), cB + hstepB + kstep, voffB);
        PG8_WAIT_V(6); PG8_BAR;
    } else {
        PG8_STAGE(PG8_SB(0, 0), cB, voffB); PG8_STAGE(PG8_SA(0, 0), cA, voffA); PG8_STAGE(PG8_SB(0, 1), cB + hstepB, voffB); PG8_STAGE(PG8_SA(0, 1), cA + hstepA, voffA);
        if (wr == 1) PG8_BAR;
        PG8_WAIT_V(4); PG8_BAR;
        PG8_STAGE(PG8_SB(1, 0), cB + kstep, voffB); PG8_STAGE(PG8_SA(1, 0), cA + kstep, voffA); PG8_STAGE(PG8_SB(1, 1), cB + hstepB + kstep, voffB);
        PG8_WAIT_V(6); PG8_BAR;
    }
    for (;;) {
        const bool has_next = S.next(ui + 1, nxt);
        const char* nA = has_next ? nxt.a : cA; const char* nB = has_next ? nxt.b : cB;
        for (int t = 0; t < nt; t += 2) {
            const bool last = (t == nt - 2);
            const char* a1 = cA + (size_t)(t + 1) * kstep;
            const char* a2 = last ? nA : cA + (size_t)(t + 2) * kstep; const char* b2 = last ? nB : cB + (size_t)(t + 2) * kstep;
            const char* a3 = a2 + kstep; const char* b3 = b2 + kstep;
            if (last && has_next) S.a_ready(nxt);
            if constexpr (SP2) {
            PG8_LDB(B0, 0, 0); PG8_LDB(B1, 0, 1); PG8_SCHED; PG8_LDA(At, 0, 0); PG8_STAGE(PG8_SA(1, 1), a1 + hstepA, voffA);
            PG8_WAIT_V(8); PG8_WAIT_L(0); PG8_BAR; PG8_MMA(0, 0, At, B0); PG8_MMA(0, 1, At, B1); PG8_BAR; PG8_SCHED;
            PG8_LDA(At, 0, 1); PG8_STAGE(PG8_SB(0, 0), b2, voffB); PG8_STAGE(PG8_SB(0, 1), b2 + hstepB, voffB); PG8_STAGE(PG8_SA(0, 0), a2, voffA);
            PG8_WAIT_V(8); PG8_WAIT_L(0); PG8_BAR; PG8_MMA(1, 0, At, B0); PG8_MMA(1, 1, At, B1); PG8_BAR; PG8_SCHED;
            PG8_LDB(B0, 1, 0); PG8_LDB(B1, 1, 1); PG8_SCHED; PG8_LDA(At, 1, 0); PG8_STAGE(PG8_SA(0, 1), a2 + hstepA, voffA);
            PG8_WAIT_V(8); PG8_WAIT_L(0); PG8_BAR; PG8_MMA(0, 0, At, B0); PG8_MMA(0, 1, At, B1); PG8_BAR; PG8_SCHED;
            PG8_LDA(At, 1, 1); PG8_STAGE(PG8_SB(1, 0), b3, voffB); PG8_STAGE(PG8_SB(1, 1), b3 + hstepB, voffB); PG8_STAGE(PG8_SA(1, 0), a3, voffA);
            PG8_WAIT_V(8); PG8_WAIT_L(0); PG8_BAR; PG8_MMA(1, 0, At, B0); PG8_MMA(1, 1, At, B1); PG8_BAR; PG8_SCHED;
            } else {
            PG8_LDB(B0, 0, 0); PG8_SCHED; PG8_LDA(At, 0, 0); PG8_STAGE(PG8_SA(1, 1), a1 + hstepA, voffA);
            PG8_WAIT_L(8); PG8_BAR; PG8_WAIT_L(0); PG8_MMA(0, 0, At, B0); PG8_BAR; PG8_SCHED;
            PG8_LDB(B1, 0, 1); PG8_STAGE(PG8_SB(0, 0), b2, voffB);
            PG8_BAR; PG8_WAIT_L(0); PG8_MMA(0, 1, At, B1); PG8_BAR;
            PG8_LDA(At, 0, 1); PG8_STAGE(PG8_SA(0, 0), a2, voffA);
            PG8_BAR; PG8_WAIT_L(0); PG8_MMA(1, 0, At, B0); PG8_BAR; PG8_SCHED;
            PG8_STAGE(PG8_SB(0, 1), b2 + hstepB, voffB);
            PG8_WAIT_V(6); PG8_BAR; PG8_MMA(1, 1, At, B1); PG8_BAR;
            PG8_LDB(B0, 1, 0); PG8_SCHED; PG8_LDA(At, 1, 0); PG8_STAGE(PG8_SA(0, 1), a2 + hstepA, voffA);
            PG8_WAIT_L(8); PG8_BAR; PG8_WAIT_L(0); PG8_MMA(0, 0, At, B0); PG8_BAR; PG8_SCHED;
            PG8_LDB(B1, 1, 1); PG8_STAGE(PG8_SB(1, 0), b3, voffB);
            PG8_BAR; PG8_WAIT_L(0); PG8_MMA(0, 1, At, B1); PG8_BAR;
            PG8_LDA(At, 1, 1); PG8_STAGE(PG8_SA(1, 0), a3, voffA);
            PG8_BAR; PG8_WAIT_L(0); PG8_MMA(1, 0, At, B0); PG8_BAR; PG8_SCHED;
            PG8_STAGE(PG8_SB(1, 1), b3 + hstepB, voffB);
            PG8_WAIT_V(6); PG8_BAR; PG8_MMA(1, 1, At, B1); PG8_BAR;
            }
        }
        if constexpr (ALIGN_EPI) { if (wr == 0) PG8_BAR; }
        E(acc, cur, wr, wc, fr, fq); S.done(cur);
        if (!has_next) break;
#pragma unroll
        for (int a = 0; a < 2; ++a)
#pragma unroll
            for (int b = 0; b < 2; ++b)
#pragma unroll
                for (int m = 0; m < 4; ++m)
#pragma unroll
                    for (int n = 0; n < 2; ++n) acc[a][b][m][n] = (f32x4){0.f, 0.f, 0.f, 0.f};
        cur = nxt; cA = nA; cB = nB; ++ui;
        if constexpr (ALIGN_EPI) { if (wr == 1) PG8_BAR; }
    }
    PG8_WAIT_V(0);
    if constexpr (!ALIGN_EPI) { if (wr == 0) PG8_BAR; }
    PG8_BAR;
#undef PG8_SA
#undef PG8_SB
#undef PG8_STAGE
#undef PG8_LDA
#undef PG8_LDB
#undef PG8_MMA
#undef PG8_WAIT_V
#undef PG8_WAIT_L
#undef PG8_BAR
#undef PG8_SCHED
}
}

typedef f32x4 AccT[2][2][4][2];
struct EpiStoreBf16 {
    static constexpr bool PERM = true;
    bf16_t* O; int ldc;
    __device__ __forceinline__ void operator()(const AccT& acc, const pg8::Unit& u, int wr, int wc, int fr, int fq) const {
        const int row0 = u.pm * 256 + wr * 64 + fr, col0 = u.pn * 256 + wc * 32 + 8 * fq;
#pragma unroll
        for (int ai = 0; ai < 2; ++ai)
#pragma unroll
            for (int m = 0; m < 4; ++m) { bf16_t* rowp = O + (size_t)(row0 + ai * 128 + m * 16) * ldc + col0;
#pragma unroll
                for (int bj = 0; bj < 2; ++bj) { const f32x4 v0 = acc[ai][bj][m][0], v1 = acc[ai][bj][m][1];
                    u32x4 w; w.x = cvt_pk_bf16(v0[0], v0[1]); w.y = cvt_pk_bf16(v0[2], v0[3]); w.z = cvt_pk_bf16(v1[0], v1[1]); w.w = cvt_pk_bf16(v1[2], v1[3]);
                    *(u32x4*)(rowp + bj * 128) = w; } }
    }
};
struct EpiMerge1 {
    static constexpr bool PERM = true;
    float* t1; const bf16_t* P;
    __device__ __forceinline__ void operator()(const AccT& acc, const pg8::Unit& u, int wr, int wc, int fr, int fq) const {
        const int row0 = u.pm * 256 + wr * 64 + fr, col0 = u.pn * 256 + wc * 32 + 8 * fq;
#pragma unroll
        for (int ai = 0; ai < 2; ++ai)
#pragma unroll
            for (int m = 0; m < 4; ++m) { const int r = row0 + ai * 128 + m * 16;
#pragma unroll
                for (int bj = 0; bj < 2; ++bj) { const int c = col0 + bj * 128;
                    const u32x4 g = *(const u32x4*)(P + (size_t)r * PW + PGA + c);
                    const f32x4 v0 = acc[ai][bj][m][0], v1 = acc[ai][bj][m][1];
                    f32x4 o0, o1;
                    o0[0] = sigmoidf_(bflo(g.x)) * v0[0]; o0[1] = sigmoidf_(bfhi(g.x)) * v0[1]; o0[2] = sigmoidf_(bflo(g.y)) * v0[2]; o0[3] = sigmoidf_(bfhi(g.y)) * v0[3];
                    o1[0] = sigmoidf_(bflo(g.z)) * v1[0]; o1[1] = sigmoidf_(bfhi(g.z)) * v1[1]; o1[2] = sigmoidf_(bflo(g.w)) * v1[2]; o1[3] = sigmoidf_(bfhi(g.w)) * v1[3];
                    float* tp = t1 + (size_t)r * D + c; *(f32x4*)tp = o0; *(f32x4*)(tp + 4) = o1; } }
    }
};
struct EpiMerge2 {
    static constexpr bool PERM = true;
    const float* t1; const bf16_t* P; bf16_t* O;
    __device__ __forceinline__ void operator()(const AccT& acc, const pg8::Unit& u, int wr, int wc, int fr, int fq) const {
        const int row0 = u.pm * 256 + wr * 64 + fr, col0 = u.pn * 256 + wc * 32 + 8 * fq;
#pragma unroll
        for (int ai = 0; ai < 2; ++ai)
#pragma unroll
            for (int m = 0; m < 4; ++m) { const int r = row0 + ai * 128 + m * 16;
#pragma unroll
                for (int bj = 0; bj < 2; ++bj) { const int c = col0 + bj * 128;
                    const u32x4 g = *(const u32x4*)(P + (size_t)r * PW + PGB + c);
                    const float* tp = t1 + (size_t)r * D + c; const f32x4 a0 = *(const f32x4*)tp, a1 = *(const f32x4*)(tp + 4);
                    const f32x4 v0 = acc[ai][bj][m][0], v1 = acc[ai][bj][m][1];
                    f32x4 o0, o1;
                    o0[0] = a0[0] + sigmoidf_(bflo(g.x)) * v0[0]; o0[1] = a0[1] + sigmoidf_(bfhi(g.x)) * v0[1]; o0[2] = a0[2] + sigmoidf_(bflo(g.y)) * v0[2]; o0[3] = a0[3] + sigmoidf_(bfhi(g.y)) * v0[3];
                    o1[0] = a1[0] + sigmoidf_(bflo(g.z)) * v1[0]; o1[1] = a1[1] + sigmoidf_(bfhi(g.z)) * v1[1]; o1[2] = a1[2] + sigmoidf_(bflo(g.w)) * v1[2]; o1[3] = a1[3] + sigmoidf_(bfhi(g.w)) * v1[3];
                    u32x4 w; w.x = cvt_pk_bf16(o0[0], o0[1]); w.y = cvt_pk_bf16(o0[2], o0[3]); w.z = cvt_pk_bf16(o1[0], o1[1]); w.w = cvt_pk_bf16(o1[2], o1[3]);
                    *(u32x4*)(O + (size_t)r * D + c) = w; } }
    }
};
struct EpiResid {
    static constexpr bool PERM = false;
    float* x; const float* gate; const float* rw; int e;
    __device__ __forceinline__ void operator()(const AccT& acc, const pg8::Unit& u, int wr, int wc, int fr, int fq) const {
        const int row0 = u.pm * 256 + wr * 64 + fr, col0 = u.pn * 256 + wc * 32 + 4 * fq;
        const int b = (u.pm < 64) ? (u.pm >> 4) : 4;
        const float* gp = gate + (size_t)b * 6144 + col0;
        f32x4 gv[2][2];
#pragma unroll
        for (int bj = 0; bj < 2; ++bj)
#pragma unroll
            for (int n = 0; n < 2; ++n) gv[bj][n] = *(const f32x4*)(gp + bj * 128 + n * 16);
#pragma unroll
        for (int ai = 0; ai < 2; ++ai)
#pragma unroll
            for (int m = 0; m < 4; ++m) { const int r = row0 + ai * 128 + m * 16; float* rowp = x + (size_t)r * D + col0;
                const float rs = rw ? rw[(size_t)r * 8 + e] : 1.f;
#pragma unroll
                for (int bj = 0; bj < 2; ++bj)
#pragma unroll
                    for (int n = 0; n < 2; ++n) { float* p = rowp + bj * 128 + n * 16; *(f32x4*)p = *(const f32x4*)p + gv[bj][n] * acc[ai][bj][m][n] * rs; } }
    }
};
struct EpiSwiglu {
    static constexpr bool PERM = true;
    bf16_t* O;
    __device__ __forceinline__ void operator()(const AccT& acc, const pg8::Unit& u, int wr, int wc, int fr, int fq) const {
        const int row0 = u.pm * 256 + wr * 64 + fr, col0 = u.pn * 128 + wc * 32 + 8 * fq;
#pragma unroll
        for (int ai = 0; ai < 2; ++ai)
#pragma unroll
            for (int m = 0; m < 4; ++m) { const int r = row0 + ai * 128 + m * 16;
                float o[8];
#pragma unroll
                for (int n = 0; n < 2; ++n)
#pragma unroll
                    for (int j = 0; j < 4; ++j) { const float a = acc[ai][0][m][n][j], g = acc[ai][1][m][n][j]; o[n * 4 + j] = a * sigmoidf_(a) * g; }
                u32x4 w; w.x = cvt_pk_bf16(o[0], o[1]); w.y = cvt_pk_bf16(o[2], o[3]); w.z = cvt_pk_bf16(o[4], o[5]); w.w = cvt_pk_bf16(o[6], o[7]);
                *(u32x4*)(O + (size_t)r * FF + col0) = w; }
    }
};

struct Args { const float* in[30]; float* out; unsigned char* ws; int l, e, ph, pad; };
enum { I_X = 0, I_C, I_CTX, I_CCTX, I_WMOD, I_BMOD, I_N1G, I_N2G, I_WIN, I_RPB, I_HCW, I_HCB, I_HW1, I_HB1, I_HW2, I_HB2, I_HW3, I_HFREQ, I_HBIAS,
       I_WPA, I_WPB, I_WO, I_FW1, I_FW3, I_FW2, I_ROUTER, I_MW1, I_MW3, I_MW2, I_FINALG };

constexpr int MISC_OFF = 131072 + 320;
constexpr int PTR_OFF = MISC_OFF + 128;
struct Ctx {
    LAS unsigned char* lds; int tid, lane, wave, G, bid; unsigned char* ws;
};
__device__ __forceinline__ Ctx mk_ctx(LAS unsigned char* lds, unsigned char* ws) {
    Ctx c; int t = threadIdx.x; asm volatile("" : "+v"(t)); asm volatile("" : "+s"(ws)); c.lds = lds; c.tid = t; c.lane = t & 63; c.wave = __builtin_amdgcn_readfirstlane(t >> 6); c.G = gridDim.x; c.bid = blockIdx.x; c.ws = ws; return c;
}
__device__ __forceinline__ const float* inp(const Ctx& c, int i) {
    const volatile LAS unsigned* p = (const volatile LAS unsigned*)(c.lds + PTR_OFF) + 2 * i;
    const unsigned lo = __builtin_amdgcn_readfirstlane(p[0]), hi = __builtin_amdgcn_readfirstlane(p[1]);
    return (const float*)(((unsigned long long)hi << 32) | (unsigned long long)lo);
}

__device__ __forceinline__ void transpose_item(const float* W, int N, bf16_t* WT, int ldk, int k0, int n0, int drow0, LAS float* scr, int lane) {
#pragma unroll 8
    for (int i = 0; i < 32; ++i) { const int kk = 2 * i + (lane >> 5); scr[kk * 33 + (lane & 31)] = W[(size_t)(k0 + kk) * N + n0 + (lane & 31)]; }
    LDS_WAIT(); asm volatile("" ::: "memory");
    const int c = lane & 7;
#pragma unroll
    for (int j = 0; j < 4; ++j) { const int n = (lane >> 3) + 8 * j; const LAS float* s = scr + (8 * c) * 33 + n;
        u32x4 o; o.x = cvt_pk_bf16(s[0 * 33], s[1 * 33]); o.y = cvt_pk_bf16(s[2 * 33], s[3 * 33]); o.z = cvt_pk_bf16(s[4 * 33], s[5 * 33]); o.w = cvt_pk_bf16(s[6 * 33], s[7 * 33]);
        *(u32x4*)(WT + (size_t)(drow0 + n) * ldk + k0 + 8 * c) = o; }
    LDS_WAIT(); asm volatile("" ::: "memory");
}
__device__ __forceinline__ void conv_mat(const float* W, int K, int N, bf16_t* WT, int mode, int& base, int gw, int NGW, LAS float* scr, int lane) {
    const int nblk = N / 32, nitems = (K / 64) * nblk;
    const int start = (gw - (base % NGW) + NGW) % NGW;
    for (int it = start; it < nitems; it += NGW) {
        const int kb = it / nblk, nb = it % nblk, n0 = nb * 32;
        const int drow0 = mode == 0 ? n0 : ((n0 >> 7) * 256 + (n0 & 127) + (mode == 2 ? 128 : 0));
        transpose_item(W, N, WT, K, kb * 64, n0, drow0, scr, lane);
    }
    base += nitems;
}
__device__ __forceinline__ void ph_convert(const Ctx& c0) {
    const Ctx c = mk_ctx(c0.lds, c0.ws);
    unsigned char* ws = c.ws;
    LAS float* scr = (LAS float*)(c.lds + c.wave * 16384);
    const int gw = c.bid * NWAVES + c.wave, NGW = c.G * NWAVES; int base = 0;
    for (int l = 0; l < DEPTH; ++l) {
        conv_mat(inp(c, I_WIN) + (size_t)l * D * PW, D, PW, (bf16_t*)(ws + WS_WIN) + (size_t)l * PW * D, 0, base, gw, NGW, scr, c.lane);
        conv_mat(inp(c, I_WPA) + (size_t)l * 512 * D, 512, D, (bf16_t*)(ws + WS_WPA) + (size_t)l * D * 512, 0, base, gw, NGW, scr, c.lane);
        conv_mat(inp(c, I_WPB) + (size_t)l * 512 * D, 512, D, (bf16_t*)(ws + WS_WPB) + (size_t)l * D * 512, 0, base, gw, NGW, scr, c.lane);
        conv_mat(inp(c, I_WO) + (size_t)l * D * D, D, D, (bf16_t*)(ws + WS_WO) + (size_t)l * D * D, 0, base, gw, NGW, scr, c.lane);
    }
    for (int i = 0; i < 2; ++i) {
        conv_mat(inp(c, I_FW1) + (size_t)i * D * FF, D, FF, (bf16_t*)(ws + WS_W13D) + (size_t)i * 2 * FF * D, 1, base, gw, NGW, scr, c.lane);
        conv_mat(inp(c, I_FW3) + (size_t)i * D * FF, D, FF, (bf16_t*)(ws + WS_W13D) + (size_t)i * 2 * FF * D, 2, base, gw, NGW, scr, c.lane);
        conv_mat(inp(c, I_FW2) + (size_t)i * FF * D, FF, D, (bf16_t*)(ws + WS_W2D) + (size_t)i * D * FF, 0, base, gw, NGW, scr, c.lane);
    }
    for (int ie = 0; ie < 2 * NE; ++ie) {
        conv_mat(inp(c, I_MW1) + (size_t)ie * D * FF, D, FF, (bf16_t*)(ws + WS_W13M) + (size_t)ie * 2 * FF * D, 1, base, gw, NGW, scr, c.lane);
        conv_mat(inp(c, I_MW3) + (size_t)ie * D * FF, D, FF, (bf16_t*)(ws + WS_W13M) + (size_t)ie * 2 * FF * D, 2, base, gw, NGW, scr, c.lane);
        conv_mat(inp(c, I_MW2) + (size_t)ie * FF * D, FF, D, (bf16_t*)(ws + WS_W2M) + (size_t)ie * D * FF, 0, base, gw, NGW, scr, c.lane);
    }
}

__device__ __forceinline__ void ph_mod(const Ctx& c0) {
    const Ctx c = mk_ctx(c0.lds, c0.ws);
    float* mod = (float*)(c.ws + WS_MOD);
    LAS float* s = (LAS float*)c.lds; LAS float* part = s + 5 * 1024;
    const float* cin = inp(c, I_C); const float* cctx = inp(c, I_CCTX); const float* wmod = inp(c, I_WMOD); const float* bmod = inp(c, I_BMOD);
    for (int i = c.tid; i < 5 * 1024; i += NTHR) { const int r = i >> 10, k = i & 1023; const float v = r < 4 ? cin[r * 1024 + k] : cctx[k]; s[i] = v * sigmoidf_(v); }
    __syncthreads();
    for (int unit = c.bid; unit < DEPTH * 96; unit += c.G) {
        const int l = unit / 96, j0 = (unit % 96) * 64;
        const float* w = wmod + (size_t)l * D * 6144 + j0 + c.lane;
        float acc[5] = {0.f, 0.f, 0.f, 0.f, 0.f};
        const int kb = c.wave * 128;
#pragma unroll 8
        for (int k = 0; k < 128; ++k) { const float wv = w[(size_t)(kb + k) * 6144];
#pragma unroll
            for (int r = 0; r < 5; ++r) acc[r] += s[r * 1024 + kb + k] * wv; }
#pragma unroll
        for (int r = 0; r < 5; ++r) part[(c.wave * 5 + r) * 64 + c.lane] = acc[r];
        __syncthreads();
        if (c.tid < 320) { const int r = c.tid >> 6, ln = c.tid & 63; float sum = 0.f;
#pragma unroll
            for (int w8 = 0; w8 < 8; ++w8) sum += part[(w8 * 5 + r) * 64 + ln];
            mod[(size_t)(l * 5 + r) * 6144 + j0 + ln] = sum + bmod[l * 6144 + j0 + ln]; }
        __syncthreads();
    }
}

__device__ __forceinline__ void ph_filt(const Ctx& c0) {
    const Ctx c = mk_ctx(c0.lds, c0.ws);
    const float* hb1 = inp(c, I_HB1); const float* hw1 = inp(c, I_HW1); const float* hb2 = inp(c, I_HB2); const float* hw2 = inp(c, I_HW2); const float* hfreq = inp(c, I_HFREQ); const float* hw3 = inp(c, I_HW3);
    LAS float* zb = (LAS float*)c.lds;
    LAS float* a1 = zb + 16 * 36;
    LAS float* a2 = a1 + 16 * 64;
    const float MINDEC = -3.0701134573253945f, MAXDEC = -15.350567286626973f;
    for (int unit = c.bid; unit < DEPTH * 272; unit += c.G) {
        const int l = unit / 272, uu = unit % 272;
        const int L = uu < 256 ? 4096 : 256, p0 = uu < 256 ? uu * 16 : (uu - 256) * 16;
        float* fout = uu < 256 ? (float*)(c.ws + WS_FL) + (size_t)l * 2 * 4096 * 512 : (float*)(c.ws + WS_FC) + (size_t)l * 2 * 256 * 512;
        for (int i = c.tid; i < 16 * 33; i += NTHR) { const int p = i / 33, q = i % 33; const int pos = p0 + p; float v;
            if (q == 0) v = (float)pos / (float)(L - 1);
            else { const int j = (q - 1) & 15; const double band = 1e-4 + (double)j * ((15.0 - 1e-4) / 15.0); double rev = (double)pos * band / (double)L; rev -= floor(rev);
                v = q <= 16 ? __builtin_amdgcn_cosf((float)rev) : -__builtin_amdgcn_sinf((float)rev); }
            zb[p * 36 + q] = v; }
        __syncthreads();
        for (int i = c.tid; i < 16 * 64; i += NTHR) { const int p = i >> 6, j = i & 63; float s = hb1[l * 64 + j];
            const float* w = hw1 + (size_t)l * 33 * 64 + j;
            for (int q = 0; q < 33; ++q) s += zb[p * 36 + q] * w[q * 64];
            a1[p * 64 + j] = sin_rad(hfreq[l * 128 + j] * s); }
        __syncthreads();
        for (int i = c.tid; i < 16 * 64; i += NTHR) { const int p = i >> 6, j = i & 63; float s = hb2[l * 64 + j];
            const float* w = hw2 + (size_t)l * 64 * 64 + j;
            for (int q = 0; q < 64; ++q) s += a1[p * 64 + q] * w[q * 64];
            a2[p * 64 + j] = sin_rad(hfreq[l * 128 + 64 + j] * s); }
        __syncthreads();
        {
            float acc0[16], acc1[16];
#pragma unroll
            for (int p = 0; p < 16; ++p) { acc0[p] = 0.f; acc1[p] = 0.f; }
            const float* w3 = hw3 + (size_t)l * 64 * 1024 + c.tid;
            for (int k = 0; k < 64; ++k) { const float wa = w3[k * 1024], wb = w3[k * 1024 + 512];
#pragma unroll
                for (int p = 0; p < 16; ++p) { const float av = a2[p * 64 + k]; acc0[p] += av * wa; acc1[p] += av * wb; } }
            bf16_t* hro = uu < 256 ? (bf16_t*)(c.ws + WS_HRL) + ((size_t)(l * 2) * 512 + c.tid) * (4096 + 64) : (bf16_t*)(c.ws + WS_HRC) + ((size_t)(l * 2) * 512 + c.tid) * (256 + 64);
            const size_t ostride = (size_t)512 * (L + 64);
            float f0[16], f1[16];
            const float r0 = fabsf(MINDEC + (float)c.tid * ((MAXDEC - MINDEC) / 1023.f)), r1 = fabsf(MINDEC + (float)(c.tid + 512) * ((MAXDEC - MINDEC) / 1023.f));
#pragma unroll
            for (int p = 0; p < 16; ++p) { const int pos = p0 + p; const float dist = fabsf((float)(pos - L / 2)) * (2.f / (float)L);
                f0[p] = acc0[p] * (__expf(-dist * r0) + 0.05f); f1[p] = acc1[p] * (__expf(-dist * r1) + 0.05f);
                fout[(size_t)(0 * L + pos) * 512 + c.tid] = f0[p];
                fout[(size_t)(1 * L + pos) * 512 + c.tid] = f1[p]; }
            {   u32x4 w0, w1, v0, v1;
                w0.x = cvt_pk_bf16(f0[15], f0[14]); w0.y = cvt_pk_bf16(f0[13], f0[12]); w0.z = cvt_pk_bf16(f0[11], f0[10]); w0.w = cvt_pk_bf16(f0[9], f0[8]);
                w1.x = cvt_pk_bf16(f0[7], f0[6]); w1.y = cvt_pk_bf16(f0[5], f0[4]); w1.z = cvt_pk_bf16(f0[3], f0[2]); w1.w = cvt_pk_bf16(f0[1], f0[0]);
                v0.x = cvt_pk_bf16(f1[15], f1[14]); v0.y = cvt_pk_bf16(f1[13], f1[12]); v0.z = cvt_pk_bf16(f1[11], f1[10]); v0.w = cvt_pk_bf16(f1[9], f1[8]);
                v1.x = cvt_pk_bf16(f1[7], f1[6]); v1.y = cvt_pk_bf16(f1[5], f1[4]); v1.z = cvt_pk_bf16(f1[3], f1[2]); v1.w = cvt_pk_bf16(f1[1], f1[0]);
                bf16_t* d0 = hro + (L + 16 - p0); bf16_t* d1 = d0 + ostride;
                *(u32x4*)d0 = w0; *(u32x4*)(d0 + 8) = w1; *(u32x4*)d1 = v0; *(u32x4*)(d1 + 8) = v1;
                const u32x4 z4 = (u32x4){0u, 0u, 0u, 0u};
                if (p0 == 0) { for (int k = 0; k < 4; ++k) { *(u32x4*)(hro + L + 32 + 8 * k) = z4; *(u32x4*)(hro + ostride + L + 32 + 8 * k) = z4; } }
                if (p0 == L - 16) { for (int k = 0; k < 4; ++k) { *(u32x4*)(hro + 8 * k) = z4; *(u32x4*)(hro + ostride + 8 * k) = z4; } } }
        }
        __syncthreads();
    }
}

__device__ __forceinline__ void ph_norm(const Ctx& c0, int l, int which) {
    const Ctx c = mk_ctx(c0.lds, c0.ws);
    float* xres = (float*)(c.ws + WS_X); bf16_t* h = (bf16_t*)(c.ws + WS_H);
    const float* mod = (const float*)(c.ws + WS_MOD) + (size_t)l * 5 * 6144;
    const float* gp = (which == 0 ? inp(c, I_N1G) : inp(c, I_N2G)) + l * D;
    const bool first = (l == 0 && which == 0), route = (which == 1 && (l & 1));
    const float* router = inp(c, I_ROUTER) + (size_t)(l >> 1) * D * NE;
    float* rw = (float*)(c.ws + WS_RW);
    const float* xin = inp(c, I_X); const float* ctxin = inp(c, I_CTX);
    for (int row = c.bid * NWAVES + c.wave; row < T; row += c.G * NWAVES) {
        const float* src = first ? (row < TL ? xin + (size_t)row * D : ctxin + (size_t)(row - TL) * D) : xres + (size_t)row * D;
        const int b = row < TL ? (row >> 12) : 4;
        const float* sh = mod + (size_t)b * 6144 + (which == 0 ? 0 : 3) * 1024; const float* sc = sh + 1024;
        f32x4 v[4]; float ss = 0.f;
#pragma unroll
        for (int j = 0; j < 4; ++j) { v[j] = *(const f32x4*)(src + 4 * (c.lane + 64 * j)); ss += (v[j][0] * v[j][0] + v[j][1] * v[j][1]) + (v[j][2] * v[j][2] + v[j][3] * v[j][3]); }
        ss = wave_sum(ss);
        const float rstd = 1.f / sqrtf(ss * (1.f / D) + EPS);
        if (first) {
#pragma unroll
            for (int j = 0; j < 4; ++j) *(f32x4*)(xres + (size_t)row * D + 4 * (c.lane + 64 * j)) = v[j];
        }
        float lg[8] = {0.f, 0.f, 0.f, 0.f, 0.f, 0.f, 0.f, 0.f};
#pragma unroll
        for (int j = 0; j < 4; ++j) { const int k0 = 4 * (c.lane + 64 * j);
            const f32x4 g4 = *(const f32x4*)(gp + k0), s4 = *(const f32x4*)(sc + k0), h4 = *(const f32x4*)(sh + k0);
            f32x4 o;
#pragma unroll
            for (int q = 0; q < 4; ++q) o[q] = v[j][q] * rstd * g4[q] * (1.f + s4[q]) + h4[q];
            u32x2 w; w.x = cvt_pk_bf16(o[0], o[1]); w.y = cvt_pk_bf16(o[2], o[3]);
            *(u32x2*)(h + (size_t)row * D + k0) = w;
            if (route) {
#pragma unroll
                for (int q = 0; q < 4; ++q) { const f32x4 ra = *(const f32x4*)(router + (size_t)(k0 + q) * 8), rb = *(const f32x4*)(router + (size_t)(k0 + q) * 8 + 4);
                    lg[0] += o[q] * ra[0]; lg[1] += o[q] * ra[1]; lg[2] += o[q] * ra[2]; lg[3] += o[q] * ra[3];
                    lg[4] += o[q] * rb[0]; lg[5] += o[q] * rb[1]; lg[6] += o[q] * rb[2]; lg[7] += o[q] * rb[3]; }
            }
        }
        if (route) {
#pragma unroll
            for (int e = 0; e < 8; ++e) lg[e] = wave_sum(lg[e]);
            int i1 = 0; float v1 = lg[0];
#pragma unroll
            for (int e = 1; e < 8; ++e) if (lg[e] > v1) { v1 = lg[e]; i1 = e; }
            int i2 = -1; float v2 = -3.0e38f;
#pragma unroll
            for (int e = 0; e < 8; ++e) if (e != i1 && lg[e] > v2) { v2 = lg[e]; i2 = e; }
            const float w1 = 1.f / (1.f + __expf(v2 - v1)), w2 = 1.f - w1;
            if (c.lane < 8) rw[(size_t)row * 8 + c.lane] = (c.lane == i1) ? w1 : ((c.lane == i2) ? w2 : 0.f);
        }
    }
}

__device__ __forceinline__ void attn_key(const bf16_t* P, int ktok, int head, float bias, const float (&q)[64], float (&o)[64], float& m, float& s) {
    const u32x4* kp = (const u32x4*)(P + (size_t)ktok * PW + PK + head * 64);
    float sc = 0.f;
#pragma unroll
    for (int i = 0; i < 8; ++i) { const u32x4 w = kp[i];
        sc += q[8 * i + 0] * bflo(w.x) + q[8 * i + 1] * bfhi(w.x) + q[8 * i + 2] * bflo(w.y) + q[8 * i + 3] * bfhi(w.y)
            + q[8 * i + 4] * bflo(w.z) + q[8 * i + 5] * bfhi(w.z) + q[8 * i + 6] * bflo(w.w) + q[8 * i + 7] * bfhi(w.w); }
    sc += bias;
    const float mn = fmaxf(m, sc), al = __expf(m - mn), p = __expf(sc - mn);
    s = s * al + p; m = mn;
    const u32x4* vp = (const u32x4*)(P + (size_t)ktok * PW + PV + head * 64);
#pragma unroll
    for (int i = 0; i < 8; ++i) { const u32x4 w = vp[i];
        o[8 * i + 0] = o[8 * i + 0] * al + p * bflo(w.x); o[8 * i + 1] = o[8 * i + 1] * al + p * bfhi(w.x);
        o[8 * i + 2] = o[8 * i + 2] * al + p * bflo(w.y); o[8 * i + 3] = o[8 * i + 3] * al + p * bfhi(w.y);
        o[8 * i + 4] = o[8 * i + 4] * al + p * bflo(w.z); o[8 * i + 5] = o[8 * i + 5] * al + p * bfhi(w.z);
        o[8 * i + 6] = o[8 * i + 6] * al + p * bflo(w.w); o[8 * i + 7] = o[8 * i + 7] * al + p * bfhi(w.w); }
}
__device__ __forceinline__ void ph_attn_naive(const Ctx& c0, int l) {
    const Ctx c = mk_ctx(c0.lds, c0.ws);
    const bf16_t* P = (const bf16_t*)(c.ws + WS_P); bf16_t* oatt = (bf16_t*)(c.ws + WS_OATT);
    const float* rpb = inp(c, I_RPB) + (size_t)l * 8 * 15 * 31;
    for (int item = c.bid * NTHR + c.tid; item < T * 8; item += c.G * NTHR) {
        const int head = item & 7, tok = item >> 3;
        float q[64], o[64]; float m = -3.0e38f, s = 0.f;
        { const u32x4* qp = (const u32x4*)(P + (size_t)tok * PW + PQ + head * 64);
#pragma unroll
          for (int i = 0; i < 8; ++i) { const u32x4 w = qp[i];
              q[8 * i + 0] = 0.125f * bflo(w.x); q[8 * i + 1] = 0.125f * bfhi(w.x); q[8 * i + 2] = 0.125f * bflo(w.y); q[8 * i + 3] = 0.125f * bfhi(w.y);
              q[8 * i + 4] = 0.125f * bflo(w.z); q[8 * i + 5] = 0.125f * bfhi(w.z); q[8 * i + 6] = 0.125f * bflo(w.w); q[8 * i + 7] = 0.125f * bfhi(w.w); } }
#pragma unroll
        for (int i = 0; i < 64; ++i) o[i] = 0.f;
        int b;
        if (tok < TL) {
            b = tok >> 12; const int t = tok & 4095, r = t >> 6, qc = t & 63;
            const int r0 = min(max(r - 4, 0), 56), c0 = min(max(qc - 8, 0), 48);
            for (int kr = 0; kr < 8; ++kr) for (int kc = 0; kc < 16; ++kc) {
                const int krow = r0 + kr, kcol = c0 + kc;
                const float bias = rpb[(head * 15 + (krow - r + 7)) * 31 + (kcol - qc + 15)];
                attn_key(P, b * 4096 + krow * 64 + kcol, head, bias, q, o, m, s);
            }
        } else b = (tok - TL) >> 8;
        for (int j = 0; j < 256; ++j) attn_key(P, TL + b * 256 + j, head, 0.f, q, o, m, s);
        const float inv = 1.f / s;
        u32x4* op = (u32x4*)(oatt + (size_t)tok * 512 + head * 64);
#pragma unroll
        for (int i = 0; i < 8; ++i) { u32x4 w; w.x = cvt_pk_bf16(o[8 * i] * inv, o[8 * i + 1] * inv); w.y = cvt_pk_bf16(o[8 * i + 2] * inv, o[8 * i + 3] * inv);
            w.z = cvt_pk_bf16(o[8 * i + 4] * inv, o[8 * i + 5] * inv); w.w = cvt_pk_bf16(o[8 * i + 6] * inv, o[8 * i + 7] * inv); op[i] = w; }
    }
}

__device__ __forceinline__ void ph_sc(const Ctx& c0, int l) {
    const Ctx c = mk_ctx(c0.lds, c0.ws);
    const bf16_t* P = (const bf16_t*)(c.ws + WS_P); bf16_t* uT = (bf16_t*)(c.ws + WS_B);
    const float* cw = inp(c, I_HCW) + (size_t)l * 3 * 1536; const float* cb = inp(c, I_HCB) + (size_t)l * 1536;
    LAS unsigned char* scr = c.lds + c.wave * 16384;
    for (int tile = c.bid * NWAVES + c.wave; tile < (T / 64) * 24; tile += c.G * NWAVES) {
        const int rt = tile / 24, row0 = rt * 64, ch0 = (tile % 24) * 64;
        const int tpos = row0 < TL ? (row0 & 4095) : ((row0 - TL) & 255), Ls = row0 < TL ? 4096 : 256;
        for (int idx = c.lane; idx < 66 * 8; idx += 64) { const int rr = idx >> 3, ck = idx & 7; const int grow = row0 - 1 + rr;
            const bool ok = !((rr == 0 && tpos == 0) || (rr == 65 && tpos + 64 == Ls));
            u32x4 v = (u32x4){0u, 0u, 0u, 0u};
            if (ok) v = *(const u32x4*)(P + (size_t)grow * PW + PHY + ch0 + ck * 8);
            LAS unsigned* d = (LAS unsigned*)(scr + rr * 132 + ck * 16); d[0] = v.x; d[1] = v.y; d[2] = v.z; d[3] = v.w; }
        LDS_WAIT(); asm volatile("" ::: "memory");
        const int ch = ch0 + c.lane; const float w0 = cw[ch], w1 = cw[1536 + ch], w2 = cw[3072 + ch], bb = cb[ch];
        unsigned ow[32];
        { float prev = bf2f(*(const LAS unsigned short*)(scr + 0 * 132 + c.lane * 2)), cur = bf2f(*(const LAS unsigned short*)(scr + 1 * 132 + c.lane * 2)); float o0 = 0.f;
#pragma unroll
          for (int r = 0; r < 64; ++r) { const float nxt = bf2f(*(const LAS unsigned short*)(scr + (r + 2) * 132 + c.lane * 2));
              const float o = w0 * prev + w1 * cur + w2 * nxt + bb; prev = cur; cur = nxt;
              if (r & 1) ow[r >> 1] = cvt_pk_bf16(o0, o); else o0 = o; } }
        LDS_WAIT(); asm volatile("" ::: "memory");
#pragma unroll
        for (int k = 0; k < 8; ++k) { u32x4 v; v.x = ow[4 * k]; v.y = ow[4 * k + 1]; v.z = ow[4 * k + 2]; v.w = ow[4 * k + 3]; *(LAS u32x4*)(scr + c.lane * 144 + k * 16) = v; }
        LDS_WAIT(); asm volatile("" ::: "memory");
#pragma unroll
        for (int k = 0; k < 8; ++k) { const int cc = (c.lane >> 3) + 8 * k, ck = c.lane & 7; const u32x4 v = *(const LAS u32x4*)(scr + cc * 144 + ck * 16);
            *(u32x4*)(uT + (size_t)(ch0 + cc) * T + row0 + ck * 8) = v; }
        LDS_WAIT(); asm volatile("" ::: "memory");
    }
}

__device__ __forceinline__ void ph_conv_naive(const Ctx& c0, int l, int o) {
    const Ctx c = mk_ctx(c0.lds, c0.ws);
    const bf16_t* uT = (const bf16_t*)(c.ws + WS_B); float* zb = (float*)(c.ws + WS_Z); bf16_t* ohy = (bf16_t*)(c.ws + WS_OHY);
    const int ch = c.tid;
    const float bias = inp(c, I_HBIAS)[(l * 2 + o) * 512 + ch];
    for (int unit = c.bid; unit < 2048 + 128; unit += c.G) {
        int L, t0, rowbase; const float* filt;
        if (unit < 2048) { const int b = unit >> 9; t0 = (unit & 511) * 8; L = 4096; rowbase = b * 4096; filt = (const float*)(c.ws + WS_FL) + (size_t)(l * 2 + o) * 4096 * 512; }
        else { const int uu = unit - 2048, b = uu >> 5; t0 = (uu & 31) * 8; L = 256; rowbase = TL + b * 256; filt = (const float*)(c.ws + WS_FC) + (size_t)(l * 2 + o) * 256 * 512; }
        const int H = L / 2;
        const int s_lo = max(0, t0 - H + 1), s_hi = min(L - 1, t0 + 7 + H);
        float hw[8], acc[8];
#pragma unroll
        for (int j = 0; j < 8; ++j) { const int k = t0 + j - s_lo + H; hw[j] = (k >= 0 && k < L) ? filt[(size_t)k * 512 + ch] : 0.f; acc[j] = 0.f; }
        for (int s = s_lo; s <= s_hi; ++s) {
            const float uv = o == 0 ? bf2f(uT[(size_t)ch * T + rowbase + s]) : zb[(size_t)(rowbase + s) * 512 + ch];
#pragma unroll
            for (int j = 0; j < 8; ++j) acc[j] += uv * hw[j];
#pragma unroll
            for (int j = 7; j > 0; --j) hw[j] = hw[j - 1];
            const int k = t0 - (s + 1) + H; hw[0] = (k >= 0 && k < L) ? filt[(size_t)k * 512 + ch] : 0.f;
        }
#pragma unroll
        for (int j = 0; j < 8; ++j) { const size_t row = (size_t)(rowbase + t0 + j);
            if (o == 0) { const float uv = bf2f(uT[(size_t)ch * T + row]), x1 = bf2f(uT[(size_t)(512 + ch) * T + row]); zb[row * 512 + ch] = x1 * (acc[j] + bias * uv); }
            else { const float uv = zb[row * 512 + ch], x2 = bf2f(uT[(size_t)(1024 + ch) * T + row]); ohy[row * 512 + ch] = (bf16_t)(cvt_pk_bf16(x2 * (acc[j] + bias * uv), 0.f) & 0xffffu); } }
    }
}

constexpr int HY_HR_OFF = 0, HY_U_OFF = 66560, HY_ZB_OFF = HY_U_OFF + 4 * 8208;
template <int L>
__device__ __forceinline__ void hy_unit(const Ctx& c, int l, int ch, const float* hbias) {
    constexpr int H = L / 2, NG = L / 256, LP = L + 64, NW = L / 8 + 8, ROWB = 2 * L + 16;
    LAS unsigned char* lds = c.lds;
    const bf16_t* uT = (const bf16_t*)(c.ws + WS_B); bf16_t* ohy = (bf16_t*)(c.ws + WS_OHY);
    const int seq0 = (L == 4096) ? 0 : TL;
    const bf16_t* hrbase = (L == 4096) ? (const bf16_t*)(c.ws + WS_HRL) : (const bf16_t*)(c.ws + WS_HRC);
    int gA, gB;
    if (NG == 16) { gA = c.wave < 4 ? c.wave : 4 + c.wave; gB = c.wave < 4 ? 7 - c.wave : 19 - c.wave; } else { gA = c.wave == 0 ? 0 : -1; gB = -1; }
    const int n = c.lane & 31, g = c.lane >> 5, tbl = n >> 2, b = n & 3;
    const int loA = gA < 0 ? 1 << 30 : max(-H - 16, 256 * gA - (L - 16)), hiA = gA < 0 ? -(1 << 30) : min(H, 256 * gA + 224);
    const int loB = gB < 0 ? 1 << 30 : max(-H - 16, 256 * gB - (L - 16)), hiB = gB < 0 ? -(1 << 30) : min(H, 256 * gB + 224);
    const int dlo = min(loA, loB), dhi = max(hiA, hiB);
    unsigned zreg[2][4][2];
    for (int o = 0; o < 2; ++o) {
        const bf16_t* hr = hrbase + ((size_t)(l * 2 + o) * 512 + ch) * LP;
        for (int w = c.tid; w < NW; w += NTHR) {
            u32x4 A4 = (u32x4){0u, 0u, 0u, 0u}; if (w > 0) A4 = *(const u32x4*)(hr + 8 * (w - 1));
            const u32x4 B4 = *(const u32x4*)(hr + 8 * w);
            const unsigned Dd[8] = {A4.x, A4.y, A4.z, A4.w, B4.x, B4.y, B4.z, B4.w};
#pragma unroll
            for (int q = 0; q < 8; ++q) { u32x4 ov;
                if ((q & 1) == 0) { const int j = (8 - q) / 2; ov.x = Dd[j]; ov.y = Dd[j + 1]; ov.z = Dd[j + 2]; ov.w = Dd[j + 3]; }
                else { const int j = (7 - q) / 2; ov.x = __builtin_amdgcn_alignbit(Dd[j + 1], Dd[j], 16); ov.y = __builtin_amdgcn_alignbit(Dd[j + 2], Dd[j + 1], 16);
                       ov.z = __builtin_amdgcn_alignbit(Dd[j + 3], Dd[j + 2], 16); ov.w = __builtin_amdgcn_alignbit(Dd[j + 4], Dd[j + 3], 16); }
                *(LAS u32x4*)(lds + HY_HR_OFF + (8 * w + q) * 16) = ov; }
        }
        if (o == 0) {
            for (int idx = c.tid; idx < 4 * (L / 8); idx += NTHR) { const int bb = idx / (L / 8), wq = idx % (L / 8);
                *(LAS u32x4*)(lds + HY_U_OFF + bb * ROWB + wq * 16) = *(const u32x4*)(uT + (size_t)ch * T + seq0 + bb * L + wq * 8); }
            if (c.tid < 16) *(LAS unsigned*)(lds + HY_ZB_OFF + c.tid * 4) = 0u;
        } else {
#pragma unroll
            for (int gi = 0; gi < 2; ++gi) { const int G = gi == 0 ? gA : gB; if (G >= 0) {
#pragma unroll
                for (int rq = 0; rq < 4; ++rq) { const int t = 32 * (8 * G + tbl) + 8 * rq + 4 * g;
                    u32x2 zz; zz.x = zreg[gi][rq][0]; zz.y = zreg[gi][rq][1]; *(LAS u32x2*)(lds + HY_U_OFF + b * ROWB + 2 * t) = zz; } } }
        }
        __syncthreads();
        f32x16 accA, accB;
#pragma unroll
        for (int r = 0; r < 16; ++r) { accA[r] = 0.f; accB[r] = 0.f; }
        if (dlo <= dhi) {
            const int e0 = H + 31 - dlo - n + 8 * g, q = (n + 1) & 7, w = (e0 + q) >> 3;
            int aaddr = HY_HR_OFF + (8 * w + q) * 16;
            int s0A = 32 * (8 * gA + tbl) - dlo, s0B = 32 * (8 * gB + tbl) - dlo;
            const int ubase = HY_U_OFF + b * ROWB + 16 * g;
            for (int d = dlo; d <= dhi; d += 16) {
                const bf16x8 af = *(const LAS bf16x8*)(lds + aaddr);
                if (d >= loA && d <= hiA) { const bool ok = (unsigned)s0A <= (unsigned)(L - 16); const int ba = ok ? ubase + 2 * s0A : HY_ZB_OFF;
                    const bf16x8 bf = *(const LAS bf16x8*)(lds + ba); accA = __builtin_amdgcn_mfma_f32_32x32x16_bf16(af, bf, accA, 0, 0, 0); }
                if (d >= loB && d <= hiB) { const bool ok = (unsigned)s0B <= (unsigned)(L - 16); const int ba = ok ? ubase + 2 * s0B : HY_ZB_OFF;
                    const bf16x8 bf = *(const LAS bf16x8*)(lds + ba); accB = __builtin_amdgcn_mfma_f32_32x32x16_bf16(af, bf, accB, 0, 0, 0); }
                aaddr -= 256; s0A -= 16; s0B -= 16;
            }
        }
        const float bias = hbias[(l * 2 + o) * 512 + ch];
#pragma unroll
        for (int gi = 0; gi < 2; ++gi) { const int G = gi == 0 ? gA : gB; if (G >= 0) {
#pragma unroll
            for (int rq = 0; rq < 4; ++rq) { const int t = 32 * (8 * G + tbl) + 8 * rq + 4 * g;
                const u32x2 uv = *(const LAS u32x2*)(lds + HY_U_OFF + b * ROWB + 2 * t);
                const size_t grow = (size_t)seq0 + b * L + t;
                const u32x2 xv = *(const u32x2*)(uT + (size_t)((o == 0 ? 512 : 1024) + ch) * T + grow);
                float y[4];
#pragma unroll
                for (int k = 0; k < 4; ++k) y[k] = gi == 0 ? accA[4 * rq + k] : accB[4 * rq + k];
                const float r0 = bflo(xv.x) * (y[0] + bias * bflo(uv.x)), r1 = bfhi(xv.x) * (y[1] + bias * bfhi(uv.x));
                const float r2 = bflo(xv.y) * (y[2] + bias * bflo(uv.y)), r3 = bfhi(xv.y) * (y[3] + bias * bfhi(uv.y));
                const unsigned p0 = cvt_pk_bf16(r0, r1), p1 = cvt_pk_bf16(r2, r3);
                if (o == 0) { zreg[gi][rq][0] = p0; zreg[gi][rq][1] = p1; }
                else { bf16_t* op = ohy + grow * 512 + ch; op[0] = (bf16_t)(p0 & 0xffffu); op[512] = (bf16_t)(p0 >> 16); op[1024] = (bf16_t)(p1 & 0xffffu); op[1536] = (bf16_t)(p1 >> 16); } } } }
        __syncthreads();
    }
}
__device__ __forceinline__ void ph_hyena(const Ctx& c0, int l) {
    const Ctx c = mk_ctx(c0.lds, c0.ws);
    const float* hbias = inp(c, I_HBIAS);
    for (int unit = c.bid; unit < HYW; unit += c.G) { hy_unit<4096>(c, l, unit, hbias); hy_unit<256>(c, l, unit, hbias); }
}

__device__ __forceinline__ void ph_final(const Ctx& c0) {
    const Ctx c = mk_ctx(c0.lds, c0.ws);
    const float* xres = (const float*)(c.ws + WS_X); const float* gp = inp(c, I_FINALG); float* outp = (float*)inp(c, 30);
    for (int row = c.bid * NWAVES + c.wave; row < TL; row += c.G * NWAVES) {
        const float* src = xres + (size_t)row * D; f32x4 v[4]; float ss = 0.f;
#pragma unroll
        for (int j = 0; j < 4; ++j) { v[j] = *(const f32x4*)(src + 4 * (c.lane + 64 * j)); ss += (v[j][0] * v[j][0] + v[j][1] * v[j][1]) + (v[j][2] * v[j][2] + v[j][3] * v[j][3]); }
        ss = wave_sum(ss);
        const float rstd = 1.f / sqrtf(ss * (1.f / D) + EPS);
#pragma unroll
        for (int j = 0; j < 4; ++j) { const int k0 = 4 * (c.lane + 64 * j); const f32x4 g4 = *(const f32x4*)(gp + k0); *(f32x4*)(outp + (size_t)row * D + k0) = v[j] * rstd * g4; }
    }
}

#define XB_TMO      128
#define XB_XCNT(j)  (256  + 64 * (j))
#define XB_XSUB(j)  (1280 + 64 * (j))
#define XB_XGEN(j)  (2304 + 64 * (j))
#define XB_TOP      3328
#define XB_TOPGEN   3392
#define XCD_BAR_WORDS 3456
#define XB_SPIN_CAP (1u << 18)
__device__ __forceinline__ unsigned xb_ld(unsigned* p)              { return __hip_atomic_load(p, __ATOMIC_RELAXED, __HIP_MEMORY_SCOPE_AGENT); }
__device__ __forceinline__ unsigned xb_add(unsigned* p, unsigned v) { return __hip_atomic_fetch_add(p, v, __ATOMIC_RELAXED, __HIP_MEMORY_SCOPE_AGENT); }
__device__ __forceinline__ unsigned xb_xcc_id() { return (unsigned)__builtin_amdgcn_s_getreg((3 << 11) | 20) & 0xFu; }
#define XB_SPIN(cond, bar) do { unsigned _sp = 0; while (cond) { __builtin_amdgcn_s_sleep(1); \
    if ((++_sp & 255u) == 0u) { if (xb_ld(&(bar)[XB_TMO])) break; if (_sp > XB_SPIN_CAP) { atomicAdd(&(bar)[XB_TMO], 1u); break; } } } } while (0)
struct XcdBarrier { unsigned* bar; unsigned x; volatile LAS unsigned* st; };
__device__ __forceinline__ XcdBarrier xcd_barrier_post(unsigned* bar, volatile LAS unsigned* st) {
    XcdBarrier b; b.bar = bar; b.x = xb_xcc_id(); b.st = st;
    if (threadIdx.x == 0) (void)xb_add(&bar[XB_XCNT(b.x)], 1u);
    return b;
}
__device__ __forceinline__ void xcd_barrier_complete(unsigned* bar, unsigned x, unsigned& nloc, unsigned& nx) {
    const unsigned G = gridDim.x * gridDim.y * gridDim.z;
    unsigned sum, cnt, mine, sp = 0u;
    for (;;) {
        sum = 0u; cnt = 0u; mine = 0u;
#pragma unroll
        for (unsigned j = 0; j < 16; ++j) { const unsigned c = xb_ld(&bar[XB_XCNT(j)]); sum += c; cnt += (c > 0u) ? 1u : 0u; mine = (j == x) ? c : mine; }
        if (sum == G) break;
        __builtin_amdgcn_s_sleep(1);
        if ((++sp & 255u) == 0u) { if (xb_ld(&bar[XB_TMO])) break; if (sp > XB_SPIN_CAP) { atomicAdd(&bar[XB_TMO], 1u); break; } }
    }
    nloc = mine > 0u ? mine : 1u; nx = cnt > 0u ? cnt : 1u;
}
__device__ __forceinline__ void xcd_barrier(const XcdBarrier& b) {
    asm volatile("s_waitcnt vmcnt(0)" ::: "memory");
    __syncthreads();
    if (threadIdx.x == 0) {
        unsigned* bar = b.bar;
        __builtin_amdgcn_s_waitcnt(0);
        unsigned nloc = b.st[0], nx = b.st[1];
        if (nloc == 0u) { xcd_barrier_complete(bar, b.x, nloc, nx); b.st[0] = nloc; b.st[1] = nx; }
        const unsigned old = xb_add(&bar[XB_XSUB(b.x)], 1u);
        const unsigned gen = old / nloc;
        if (old + 1u == (gen + 1u) * nloc) {
            __builtin_amdgcn_fence(__ATOMIC_RELEASE, "agent");
            asm volatile("s_waitcnt vmcnt(0)" ::: "memory");
            const unsigned og = xb_add(&bar[XB_TOP], 1u);
            const unsigned tg = og / nx;
            if (og + 1u == (tg + 1u) * nx) xb_add(&bar[XB_TOPGEN], 1u);
            else XB_SPIN(xb_ld(&bar[XB_TOPGEN]) == tg, bar);
            __builtin_amdgcn_fence(__ATOMIC_ACQUIRE, "agent");
            xb_add(&bar[XB_XGEN(b.x)], 1u);
            asm volatile("s_waitcnt vmcnt(0)" ::: "memory");
        } else {
            XB_SPIN(xb_ld(&bar[XB_XGEN(b.x)]) == gen, bar);
            __builtin_amdgcn_fence(__ATOMIC_ACQUIRE, "agent");
            asm volatile("s_waitcnt vmcnt(0)" ::: "memory");
        }
    }
    __syncthreads();
}

constexpr int CW_BAR = 4096;

__global__ void __launch_bounds__(NTHR, 2) fwd(Args args) {
    extern __shared__ __attribute__((aligned(16))) unsigned char lds_raw[];
    Ctx c; c.lds = (LAS unsigned char*)lds_raw; c.tid = threadIdx.x; c.lane = c.tid & 63; c.wave = __builtin_amdgcn_readfirstlane(c.tid >> 6); c.G = gridDim.x; c.bid = blockIdx.x; c.ws = args.ws;
    unsigned char* ws = args.ws;
    volatile LAS unsigned* MISC = (volatile LAS unsigned*)(c.lds + MISC_OFF);
    if (c.tid < 32) MISC[c.tid] = 0u;
    if (c.tid < 31) { const unsigned long long pv = c.tid < 30 ? (unsigned long long)args.in[c.tid] : (unsigned long long)args.out;
        volatile LAS unsigned* pt = (volatile LAS unsigned*)(c.lds + PTR_OFF) + 2 * c.tid; pt[0] = (unsigned)pv; pt[1] = (unsigned)(pv >> 32); }
    __syncthreads();
    XcdBarrier bar = xcd_barrier_post((unsigned*)(ws + WS_CTL) + CW_BAR, MISC + 8);
#define GRID_BAR() xcd_barrier(bar)

    ph_convert(c); __syncthreads(); ph_mod(c); __syncthreads(); ph_filt(c);
    GRID_BAR();
    for (int l = 0; l < DEPTH; ++l) {
        ph_norm(c, l, 0);
        GRID_BAR();
        {   unsigned char* ws = c.ws; asm volatile("" : "+s"(ws));
            pg8::Gemm g{D, D, D}; pg8::StaticOrder S; S.init(ws + WS_H, D, (bf16_t*)(ws + WS_WIN) + (size_t)l * PW * D, D, T, PW, c.G, c.bid);
            EpiStoreBf16 E{(bf16_t*)(ws + WS_P), PW};
            pg8::gemm_phase(c.lds, g, S, E); }
        GRID_BAR();
        ph_attn_naive(c, l); ph_sc(c, l);
        GRID_BAR();
#if defined(NAIVE_CONV)
        ph_conv_naive(c, l, 0);
        GRID_BAR();
        ph_conv_naive(c, l, 1);
        GRID_BAR();
#else
        ph_hyena(c, l);
        GRID_BAR();
#endif
        {   unsigned char* ws = c.ws; asm volatile("" : "+s"(ws));
            pg8::Gemm g{512, 512, 512};
            { pg8::StaticOrder S; S.init(ws + WS_OATT, 512, (bf16_t*)(ws + WS_WPA) + (size_t)l * D * 512, 512, T, D, c.G, c.bid);
              EpiMerge1 E{(float*)(ws + WS_B), (const bf16_t*)(ws + WS_P)};
              pg8::gemm_phase(c.lds, g, S, E); }
            { pg8::StaticOrder S; S.init(ws + WS_OHY, 512, (bf16_t*)(ws + WS_WPB) + (size_t)l * D * 512, 512, T, D, c.G, c.bid);
              EpiMerge2 E{(const float*)(ws + WS_B), (const bf16_t*)(ws + WS_P), (bf16_t*)(ws + WS_H)};
              pg8::gemm_phase(c.lds, g, S, E); } }
        GRID_BAR();
        {   unsigned char* ws = c.ws; asm volatile("" : "+s"(ws));
            const float* modl = (const float*)(ws + WS_MOD) + (size_t)l * 5 * 6144;
            pg8::Gemm g{D, D, D}; pg8::StaticOrder S; S.init(ws + WS_H, D, (bf16_t*)(ws + WS_WO) + (size_t)l * D * D, D, T, D, c.G, c.bid);
            EpiResid E{(float*)(ws + WS_X), modl + 2 * 1024, nullptr, 0};
            pg8::gemm_phase(c.lds, g, S, E); }
        GRID_BAR();
        ph_norm(c, l, 1);
        GRID_BAR();
        const bool moe = (l & 1) != 0; const int ne = moe ? NE : 1;
        for (int e = 0; e < ne; ++e) {
            {   unsigned char* ws = c.ws; asm volatile("" : "+s"(ws));
                const bf16_t* w = !moe ? (const bf16_t*)(ws + WS_W13D) + (size_t)(l >> 1) * 2 * FF * D : (const bf16_t*)(ws + WS_W13M) + (size_t)((l >> 1) * NE + e) * 2 * FF * D;
                pg8::Gemm g{D, D, D}; pg8::StaticOrder S; S.init(ws + WS_H, D, w, D, T, 2 * FF, c.G, c.bid);
                EpiSwiglu E{(bf16_t*)(ws + WS_P)};
                pg8::gemm_phase(c.lds, g, S, E); }
            GRID_BAR();
            {   unsigned char* ws = c.ws; asm volatile("" : "+s"(ws));
                const float* modl = (const float*)(ws + WS_MOD) + (size_t)l * 5 * 6144;
                const bf16_t* w = !moe ? (const bf16_t*)(ws + WS_W2D) + (size_t)(l >> 1) * D * FF : (const bf16_t*)(ws + WS_W2M) + (size_t)((l >> 1) * NE + e) * D * FF;
                pg8::Gemm g{FF, FF, FF}; pg8::StaticOrder S; S.init(ws + WS_P, FF, w, FF, T, D, c.G, c.bid);
                EpiResid E{(float*)(ws + WS_X), modl + 5 * 1024, !moe ? nullptr : (const float*)(ws + WS_RW), e};
                pg8::gemm_phase(c.lds, g, S, E); }
            GRID_BAR();
        }
    }
    ph_final(c);
}

extern "C" void kernel_launch(void* const* d_in, const int* in_sizes, int n_in, void* d_out, int out_size, void* d_ws, size_t ws_size, hipStream_t stream) {
    static int grid = 0;
    if (grid == 0) {
        if (n_in != 30 || out_size != TL * D || ws_size < WS_END) { fprintf(stderr, "kernel_launch: unexpected shapes (n_in %d out %d ws %zu)\n", n_in, out_size, ws_size); grid = -1; return; }
        int dev = 0, cus = 0, per_cu = 0; (void)hipGetDevice(&dev); (void)hipDeviceGetAttribute(&cus, hipDeviceAttributeMultiprocessorCount, dev);
        if (hipFuncSetAttribute((const void*)fwd, hipFuncAttributeMaxDynamicSharedMemorySize, LDS_BYTES) != hipSuccess) { fprintf(stderr, "kernel_launch: hipFuncSetAttribute failed\n"); grid = -1; return; }
        if (hipOccupancyMaxActiveBlocksPerMultiprocessor(&per_cu, (const void*)fwd, NTHR, LDS_BYTES) != hipSuccess || per_cu < 1) fprintf(stderr, "kernel_launch: occupancy query reports %d\n", per_cu);
        (void)hipGetLastError();
        grid = cus > 0 ? cus : 256;
    }
    if (grid < 0) return;
    (void)hipMemsetAsync((char*)d_ws + WS_CTL, 0, CTL_ZERO_BYTES, stream);
    Args a{};
    for (int i = 0; i < 30; ++i) a.in[i] = (const float*)d_in[i];
    a.out = (float*)d_out; a.ws = (unsigned char*)d_ws;
    hipLaunchKernelGGL(fwd, dim3(grid), dim3(NTHR), LDS_BYTES, stream, a);
}
```

```cpp
#include <hip/hip_runtime.h>
#include <cstdio>
#include <cstdint>

#define LAS __attribute__((address_space(3)))
#define GAS __attribute__((address_space(1)))
typedef unsigned short bf16_t;
typedef short bf16x8 __attribute__((ext_vector_type(8)));
typedef float f32x4 __attribute__((ext_vector_type(4)));
typedef float f32x2 __attribute__((ext_vector_type(2)));
typedef float f32x16 __attribute__((ext_vector_type(16)));
typedef unsigned u32x4 __attribute__((ext_vector_type(4)));
typedef unsigned u32x2 __attribute__((ext_vector_type(2)));

constexpr int D = 1024, NB = 4, SEQ = 4096, DEPTH = 4, CTX = 256;
constexpr int TL = NB * SEQ, TC = NB * CTX, T = TL + TC;
constexpr int PW = 5120, FF = 2816, NE = 8, HYW = 512;
constexpr int PQ = 0, PK = 512, PV = 1024, PHY = 1536, PGA = 3072, PGB = 4096;
constexpr float EPS = 1e-6f;

constexpr size_t MiB = 1u << 20;
constexpr size_t WS_CTL = 0, CTL_ZERO_BYTES = 1 * MiB;
constexpr size_t WS_MOD = 1 * MiB;
constexpr size_t WS_ROUTE = 2 * MiB;
constexpr size_t WS_RWT = 2 * MiB + 512 * 1024;
constexpr size_t WS_TOK = 3 * MiB;
constexpr int CW_CNT = 8192;
constexpr int MAXSLOT = 36864;
constexpr size_t WS_Y = 660 * MiB;
constexpr size_t WS_WIN = 4 * MiB;
constexpr size_t WS_WPA = 44 * MiB;
constexpr size_t WS_WPB = 48 * MiB;
constexpr size_t WS_WO = 52 * MiB;
constexpr size_t WS_W13D = 60 * MiB;
constexpr size_t WS_W2D = 82 * MiB;
constexpr size_t WS_W13M = 93 * MiB;
constexpr size_t WS_W2M = 269 * MiB;
constexpr size_t WS_X = 357 * MiB;
constexpr size_t WS_H = 425 * MiB;
constexpr size_t WS_P = 459 * MiB;
constexpr size_t WS_OATT = 629 * MiB;
constexpr size_t WS_OHY = 646 * MiB;
constexpr size_t WS_B = 663 * MiB;
constexpr size_t WS_Z = WS_B + 51 * MiB;
constexpr size_t WS_FL = 748 * MiB;
constexpr size_t WS_FC = 812 * MiB;
constexpr size_t WS_HRL = 816 * MiB;
constexpr size_t WS_HRC = 850 * MiB;
constexpr size_t WS_END = 853 * MiB;

constexpr int LDS_BYTES = 147456;
constexpr int NWAVES = 8, NTHR = 512;

#define LDS_WAIT() asm volatile("s_waitcnt lgkmcnt(0)" ::: "memory")
#define VM_WAIT() asm volatile("s_waitcnt vmcnt(0)" ::: "memory")
__device__ __forceinline__ float bf2f(unsigned b) { return __uint_as_float(b << 16); }
__device__ __forceinline__ float bflo(unsigned w) { return __uint_as_float(w << 16); }
__device__ __forceinline__ float bfhi(unsigned w) { return __uint_as_float(w & 0xffff0000u); }
__device__ __forceinline__ unsigned cvt_pk_bf16(float lo, float hi) { unsigned r; asm volatile("v_cvt_pk_bf16_f32 %0, %1, %2" : "=v"(r) : "v"(lo), "v"(hi)); return r; }
__device__ __forceinline__ float wave_sum(float v, int lane) {
#pragma unroll
    for (int o = 1; o < 64; o <<= 1) v += __int_as_float(__builtin_amdgcn_ds_bpermute((lane ^ o) << 2, __float_as_int(v)));
    return v;
}
__device__ __forceinline__ float sigmoidf_(float x) { return 1.f / (1.f + __expf(-x)); }
__device__ __forceinline__ float sin_rev(float r) { return __builtin_amdgcn_sinf(__builtin_amdgcn_fractf(r)); }
__device__ __forceinline__ float sin_rad(float x) { return sin_rev(x * 0.15915494309189535f); }

namespace pg8 {
constexpr int BM = 256, BK = 64, HALF = 128, HTB = HALF * BK * 2, STAGE_BYTES = 8 * HTB, NXCD = 8, WGM = 8;
__host__ __device__ __forceinline__ int lds_byte(int r, int c) { const int st = (r >> 4) * 2 + (c >> 5), rr = r & 15, cc = c & 31, ob = rr * 64 + cc * 2; return st * 1024 + (ob ^ (((ob >> 9) & 1) << 5)); }
__host__ __device__ __forceinline__ void stage_rc(int b, int& R, int& C) { const int st = b / 1024, sb = b % 1024, swz = sb ^ (((sb >> 9) & 1) << 5); R = (st >> 1) * 16 + swz / 64; C = (st & 1) * 32 + (swz % 64) / 2; }
__host__ __device__ __forceinline__ int perm32(int rho) { const int n = rho >> 4, i = rho & 15; return 8 * (i >> 2) + 4 * n + (i & 3); }

struct Unit { int pm, pn; const char* a; const char* b; const int* tk; int nvalid; };
struct Gemm { int K, lda, ldb; };

struct StaticOrder {
    int nM, nN, nwg, G, c; const char* A; const char* B; size_t astep, bstep;
    __device__ void init(const void* A_, int lda, const void* B_, int ldb, int M, int N, int G_, int c_) {
        nM = M / BM; nN = N / BM; nwg = nM * nN; G = G_; c = c_; A = (const char*)A_; B = (const char*)B_; astep = (size_t)BM * lda * 2; bstep = (size_t)BM * ldb * 2; }
    __device__ bool next(int i, Unit& u) const {
        const long L = (long)i * G + c; if (L >= nwg) return false;
        int wgid = (int)L; { const int q = nwg / NXCD, r = nwg % NXCD, xcd = wgid % NXCD, off = wgid / NXCD; wgid = (xcd < r ? xcd * (q + 1) : r * (q + 1) + (xcd - r) * q) + off; }
        const int nig = WGM * nN, gid = wgid / nig, fm = gid * WGM, gsz = (nM - fm) < WGM ? (nM - fm) : WGM;
        u.pm = fm + ((wgid % nig) % gsz); u.pn = (wgid % nig) / gsz; u.a = A + (size_t)u.pm * astep; u.b = B + (size_t)u.pn * bstep; return true;
    }
    static constexpr bool GATHER = false;
    __device__ __forceinline__ int arow(const Unit&, int) const { return 0; }
    __device__ __forceinline__ void a_ready(const Unit&) const {}
    __device__ __forceinline__ void done(const Unit&) const {}
};

template <class Epi, class Sched, bool ALIGN_EPI = true>
__device__ __forceinline__ void gemm_phase(LAS unsigned char* lds, const Gemm g, const Sched& S, const Epi& E) {
    int tid = threadIdx.x; asm volatile("" : "+v"(tid));
    const int wid = __builtin_amdgcn_readfirstlane(tid >> 6), lane = tid & 63, wr = wid >> 2, wc = wid & 3, fr = lane & 15, fq = lane >> 4;
    const int K = g.K, nt = K / BK;
    constexpr bool GATHER = Sched::GATHER;
    unsigned voffB[2]; unsigned cA0[2], cA1[2], nA0[2], nA1[2]; int RA[2], CA[2];
    const size_t hstepA = (size_t)HALF * g.lda * 2, hstepB = (size_t)HALF * g.ldb * 2;
#pragma unroll
    for (int i = 0; i < 2; ++i) { int R, C; stage_rc(tid * 16 + i * 8192, R, C); const int Rb = Epi::PERM ? ((R & ~31) + perm32(R & 31)) : R;
        RA[i] = R; CA[i] = C; voffB[i] = (unsigned)(Rb * g.ldb + C) * 2u;
        cA0[i] = (unsigned)(R * g.lda + C) * 2u; cA1[i] = cA0[i]; nA0[i] = cA0[i]; nA1[i] = cA0[i]; }
    const size_t h1A = GATHER ? 0 : hstepA;
    const size_t kstep = (size_t)(BK * 2);
    const unsigned ldsw = (unsigned)wid * 1024u;
    const int aoff = lds_byte(wr * 64 + fr, fq * 8), boff = lds_byte(wc * 32 + fr, fq * 8);
#define PG8_SA(b, h) (((b) * 2 + (h)) * HTB)
#define PG8_SB(b, h) ((4 + (b) * 2 + (h)) * HTB)
#define PG8_STAGE(bufoff, gbase, voff) do { _Pragma("unroll") for (int _i = 0; _i < 2; ++_i) \
        __builtin_amdgcn_global_load_lds((const unsigned*)((const char*)(gbase) + (voff)[_i]), (LAS unsigned*)(lds + (bufoff) + ldsw + _i * 8192), 16, 0, 0); } while (0)
#define PG8_LDA(dst, b, h) do { _Pragma("unroll") for (int m = 0; m < 4; ++m) _Pragma("unroll") for (int k = 0; k < 2; ++k) dst[m][k] = *(const LAS bf16x8*)(lds + PG8_SA(b, h) + aoff + m * 2048 + k * 1024); } while (0)
#define PG8_LDB(dst, b, h) do { _Pragma("unroll") for (int n = 0; n < 2; ++n) _Pragma("unroll") for (int k = 0; k < 2; ++k) dst[n][k] = *(const LAS bf16x8*)(lds + PG8_SB(b, h) + boff + n * 2048 + k * 1024); } while (0)
#define PG8_MMA(ai, bj, At, Bt) do { __builtin_amdgcn_s_setprio(1); _Pragma("unroll") for (int m = 0; m < 4; ++m) _Pragma("unroll") for (int n = 0; n < 2; ++n) _Pragma("unroll") for (int k = 0; k < 2; ++k) \
        acc[ai][bj][m][n] = __builtin_amdgcn_mfma_f32_16x16x32_bf16(Bt[n][k], At[m][k], acc[ai][bj][m][n], 0, 0, 0); __builtin_amdgcn_s_setprio(0); } while (0)
#define PG8_WAIT_V(n) asm volatile("s_waitcnt vmcnt(" #n ")" ::: "memory")
#define PG8_WAIT_L(n) asm volatile("s_waitcnt lgkmcnt(" #n ")" ::: "memory")
#define PG8_BAR __builtin_amdgcn_s_barrier()
#define PG8_SCHED __builtin_amdgcn_sched_barrier(0)
    Unit cur, nxt; int ui = 0;
    if (!S.next(0, cur)) return;
    if constexpr (GATHER) {
#pragma unroll
        for (int i = 0; i < 2; ++i) { cA0[i] = (unsigned)(S.arow(cur, RA[i]) * g.lda + CA[i]) * 2u; cA1[i] = (unsigned)(S.arow(cur, HALF + RA[i]) * g.lda + CA[i]) * 2u; }
    }
    f32x4 acc[2][2][4][2];
#pragma unroll
    for (int a = 0; a < 2; ++a)
#pragma unroll
        for (int b = 0; b < 2; ++b)
#pragma unroll
            for (int m = 0; m < 4; ++m)
#pragma unroll
                for (int n = 0; n < 2; ++n) acc[a][b][m][n] = (f32x4){0.f, 0.f, 0.f, 0.f};
    bf16x8 At[4][2], B0[2][2], B1[2][2];
    const char* cA = cur.a; const char* cB = cur.b;
    S.a_ready(cur);
    PG8_STAGE(PG8_SB(0, 0), cB, voffB); PG8_STAGE(PG8_SB(0, 1), cB + hstepB, voffB); PG8_STAGE(PG8_SA(0, 0), cA, cA0); PG8_STAGE(PG8_SA(0, 1), cA + h1A, cA1);
    if (wr == 1) PG8_BAR;
    PG8_WAIT_V(2); PG8_BAR;
    PG8_STAGE(PG8_SB(1, 0), cB + kstep, voffB); PG8_STAGE(PG8_SA(1, 0), cA + kstep, cA0); PG8_STAGE(PG8_SB(1, 1), cB + hstepB + kstep, voffB);
    PG8_WAIT_V(6); PG8_BAR;
    for (;;) {
        const bool has_next = S.next(ui + 1, nxt);
        const char* nA = has_next ? nxt.a : cA; const char* nB = has_next ? nxt.b : cB;
        if constexpr (GATHER) {
#pragma unroll
            for (int i = 0; i < 2; ++i) { nA0[i] = has_next ? (unsigned)(S.arow(nxt, RA[i]) * g.lda + CA[i]) * 2u : cA0[i]; nA1[i] = has_next ? (unsigned)(S.arow(nxt, HALF + RA[i]) * g.lda + CA[i]) * 2u : cA1[i]; }
        }
        for (int t = 0; t < nt; t += 2) {
            const bool last = (t == nt - 2);
            const char* a1 = cA + (size_t)(t + 1) * kstep;
            const char* a2 = last ? nA : cA + (size_t)(t + 2) * kstep; const char* b2 = last ? nB : cB + (size_t)(t + 2) * kstep;
            const char* a3 = a2 + kstep; const char* b3 = b2 + kstep;
            unsigned x0[2], x1[2];
#pragma unroll
            for (int i = 0; i < 2; ++i) { x0[i] = (GATHER && last) ? nA0[i] : cA0[i]; x1[i] = GATHER ? (last ? nA1[i] : cA1[i]) : cA0[i]; }
            if (last && has_next) S.a_ready(nxt);
            PG8_LDB(B0, 0, 0); PG8_LDB(B1, 0, 1); PG8_SCHED; PG8_LDA(At, 0, 0); PG8_STAGE(PG8_SA(1, 1), a1 + h1A, cA1);
            PG8_WAIT_V(8); PG8_WAIT_L(0); PG8_BAR; PG8_MMA(0, 0, At, B0); PG8_MMA(0, 1, At, B1); PG8_BAR; PG8_SCHED;
            PG8_LDA(At, 0, 1); PG8_STAGE(PG8_SB(0, 0), b2, voffB); PG8_STAGE(PG8_SB(0, 1), b2 + hstepB, voffB); PG8_STAGE(PG8_SA(0, 0), a2, x0);
            PG8_WAIT_V(8); PG8_WAIT_L(0); PG8_BAR; PG8_MMA(1, 0, At, B0); PG8_MMA(1, 1, At, B1); PG8_BAR; PG8_SCHED;
            PG8_LDB(B0, 1, 0); PG8_LDB(B1, 1, 1); PG8_SCHED; PG8_LDA(At, 1, 0); PG8_STAGE(PG8_SA(0, 1), a2 + h1A, x1);
            PG8_WAIT_V(8); PG8_WAIT_L(0); PG8_BAR; PG8_MMA(0, 0, At, B0); PG8_MMA(0, 1, At, B1); PG8_BAR; PG8_SCHED;
            PG8_LDA(At, 1, 1); PG8_STAGE(PG8_SB(1, 0), b3, voffB); PG8_STAGE(PG8_SB(1, 1), b3 + hstepB, voffB); PG8_STAGE(PG8_SA(1, 0), a3, x0);
            PG8_WAIT_V(8); PG8_WAIT_L(0); PG8_BAR; PG8_MMA(1, 0, At, B0); PG8_MMA(1, 1, At, B1); PG8_BAR; PG8_SCHED;
        }
        if constexpr (ALIGN_EPI) { if (wr == 0) PG8_BAR; }
        E(acc, cur, wr, wc, fr, fq); S.done(cur);
        if (!has_next) break;
#pragma unroll
        for (int a = 0; a < 2; ++a)
#pragma unroll
            for (int b = 0; b < 2; ++b)
#pragma unroll
                for (int m = 0; m < 4; ++m)
#pragma unroll
                    for (int n = 0; n < 2; ++n) acc[a][b][m][n] = (f32x4){0.f, 0.f, 0.f, 0.f};
        cur = nxt; cA = nA; cB = nB; ++ui;
        if constexpr (GATHER) {
#pragma unroll
            for (int i = 0; i < 2; ++i) { cA0[i] = nA0[i]; cA1[i] = nA1[i]; }
        }
        if constexpr (ALIGN_EPI) { if (wr == 1) PG8_BAR; }
    }
    PG8_WAIT_V(0);
    if constexpr (!ALIGN_EPI) { if (wr == 0) PG8_BAR; }
    PG8_BAR;
#undef PG8_SA
#undef PG8_SB
#undef PG8_STAGE
#undef PG8_LDA
#undef PG8_LDB
#undef PG8_MMA
#undef PG8_WAIT_V
#undef PG8_WAIT_L
#undef PG8_BAR
#undef PG8_SCHED
}
}

typedef f32x4 AccT[2][2][4][2];
struct EpiStoreBf16 {
    static constexpr bool PERM = true;
    bf16_t* O; int ldc;
    __device__ __forceinline__ void operator()(const AccT& acc, const pg8::Unit& u, int wr, int wc, int fr, int fq) const {
        const int row0 = u.pm * 256 + wr * 64 + fr, col0 = u.pn * 256 + wc * 32 + 8 * fq;
#pragma unroll
        for (int ai = 0; ai < 2; ++ai)
#pragma unroll
            for (int m = 0; m < 4; ++m) { bf16_t* rowp = O + (size_t)(row0 + ai * 128 + m * 16) * ldc + col0;
#pragma unroll
                for (int bj = 0; bj < 2; ++bj) { const f32x4 v0 = acc[ai][bj][m][0], v1 = acc[ai][bj][m][1];
                    u32x4 w; w.x = cvt_pk_bf16(v0[0], v0[1]); w.y = cvt_pk_bf16(v0[2], v0[3]); w.z = cvt_pk_bf16(v1[0], v1[1]); w.w = cvt_pk_bf16(v1[2], v1[3]);
                    *(u32x4*)(rowp + bj * 128) = w; } }
    }
};
struct EpiMerge1 {
    static constexpr bool PERM = true;
    float* t1; const bf16_t* P;
    __device__ __forceinline__ void operator()(const AccT& acc, const pg8::Unit& u, int wr, int wc, int fr, int fq) const {
        const int row0 = u.pm * 256 + wr * 64 + fr, col0 = u.pn * 256 + wc * 32 + 8 * fq;
#pragma unroll
        for (int ai = 0; ai < 2; ++ai)
#pragma unroll
            for (int m = 0; m < 4; ++m) { const int r = row0 + ai * 128 + m * 16;
#pragma unroll
                for (int bj = 0; bj < 2; ++bj) { const int c = col0 + bj * 128;
                    const u32x4 g = *(const u32x4*)(P + (size_t)r * PW + PGA + c);
                    const f32x4 v0 = acc[ai][bj][m][0], v1 = acc[ai][bj][m][1];
                    f32x4 o0, o1;
                    o0[0] = sigmoidf_(bflo(g.x)) * v0[0]; o0[1] = sigmoidf_(bfhi(g.x)) * v0[1]; o0[2] = sigmoidf_(bflo(g.y)) * v0[2]; o0[3] = sigmoidf_(bfhi(g.y)) * v0[3];
                    o1[0] = sigmoidf_(bflo(g.z)) * v1[0]; o1[1] = sigmoidf_(bfhi(g.z)) * v1[1]; o1[2] = sigmoidf_(bflo(g.w)) * v1[2]; o1[3] = sigmoidf_(bfhi(g.w)) * v1[3];
                    float* tp = t1 + (size_t)r * D + c; *(f32x4*)tp = o0; *(f32x4*)(tp + 4) = o1; } }
    }
};
struct EpiMerge2 {
    static constexpr bool PERM = true;
    const float* t1; const bf16_t* P; bf16_t* O;
    __device__ __forceinline__ void operator()(const AccT& acc, const pg8::Unit& u, int wr, int wc, int fr, int fq) const {
        const int row0 = u.pm * 256 + wr * 64 + fr, col0 = u.pn * 256 + wc * 32 + 8 * fq;
#pragma unroll
        for (int ai = 0; ai < 2; ++ai)
#pragma unroll
            for (int m = 0; m < 4; ++m) { const int r = row0 + ai * 128 + m * 16;
#pragma unroll
                for (int bj = 0; bj < 2; ++bj) { const int c = col0 + bj * 128;
                    const u32x4 g = *(const u32x4*)(P + (size_t)r * PW + PGB + c);
                    const float* tp = t1 + (size_t)r * D + c; const f32x4 a0 = *(const f32x4*)tp, a1 = *(const f32x4*)(tp + 4);
                    const f32x4 v0 = acc[ai][bj][m][0], v1 = acc[ai][bj][m][1];
                    f32x4 o0, o1;
                    o0[0] = a0[0] + sigmoidf_(bflo(g.x)) * v0[0]; o0[1] = a0[1] + sigmoidf_(bfhi(g.x)) * v0[1]; o0[2] = a0[2] + sigmoidf_(bflo(g.y)) * v0[2]; o0[3] = a0[3] + sigmoidf_(bfhi(g.y)) * v0[3];
                    o1[0] = a1[0] + sigmoidf_(bflo(g.z)) * v1[0]; o1[1] = a1[1] + sigmoidf_(bfhi(g.z)) * v1[1]; o1[2] = a1[2] + sigmoidf_(bflo(g.w)) * v1[2]; o1[3] = a1[3] + sigmoidf_(bfhi(g.w)) * v1[3];
                    u32x4 w; w.x = cvt_pk_bf16(o0[0], o0[1]); w.y = cvt_pk_bf16(o0[2], o0[3]); w.z = cvt_pk_bf16(o1[0], o1[1]); w.w = cvt_pk_bf16(o1[2], o1[3]);
                    *(u32x4*)(O + (size_t)r * D + c) = w; } }
    }
};
struct EpiResid {
    static constexpr bool PERM = false;
    float* x; const float* gate;
    __device__ __forceinline__ void operator()(const AccT& acc, const pg8::Unit& u, int wr, int wc, int fr, int fq) const {
        const int row0 = u.pm * 256 + wr * 64 + fr, col0 = u.pn * 256 + wc * 32 + 4 * fq;
        const int b = (u.pm < 64) ? (u.pm >> 4) : 4;
        const float* gp = gate + (size_t)b * 6144 + col0;
        f32x4 gv[2][2];
#pragma unroll
        for (int bj = 0; bj < 2; ++bj)
#pragma unroll
            for (int n = 0; n < 2; ++n) gv[bj][n] = *(const f32x4*)(gp + bj * 128 + n * 16);
#pragma unroll
        for (int ai = 0; ai < 2; ++ai)
#pragma unroll
            for (int m = 0; m < 4; ++m) { const int r = row0 + ai * 128 + m * 16; float* rowp = x + (size_t)r * D + col0;
#pragma unroll
                for (int bj = 0; bj < 2; ++bj)
#pragma unroll
                    for (int n = 0; n < 2; ++n) { float* p = rowp + bj * 128 + n * 16; *(f32x4*)p = *(const f32x4*)p + gv[bj][n] * acc[ai][bj][m][n]; } }
    }
};
struct EpiSwiglu {
    static constexpr bool PERM = true;
    bf16_t* O;
    __device__ __forceinline__ void operator()(const AccT& acc, const pg8::Unit& u, int wr, int wc, int fr, int fq) const {
        const int row0 = u.pm * 256 + wr * 64 + fr, col0 = u.pn * 128 + wc * 32 + 8 * fq;
#pragma unroll
        for (int ai = 0; ai < 2; ++ai)
#pragma unroll
            for (int m = 0; m < 4; ++m) { const int r = row0 + ai * 128 + m * 16;
                float o[8];
#pragma unroll
                for (int n = 0; n < 2; ++n)
#pragma unroll
                    for (int j = 0; j < 4; ++j) { const float a = acc[ai][0][m][n][j], g = acc[ai][1][m][n][j]; o[n * 4 + j] = a * sigmoidf_(a) * g; }
                u32x4 w; w.x = cvt_pk_bf16(o[0], o[1]); w.y = cvt_pk_bf16(o[2], o[3]); w.z = cvt_pk_bf16(o[4], o[5]); w.w = cvt_pk_bf16(o[6], o[7]);
                *(u32x4*)(O + (size_t)r * FF + col0) = w; }
    }
};

struct Args { const float* in[30]; float* out; unsigned char* ws; int l, e, ph, pad; };
enum { I_X = 0, I_C, I_CTX, I_CCTX, I_WMOD, I_BMOD, I_N1G, I_N2G, I_WIN, I_RPB, I_HCW, I_HCB, I_HW1, I_HB1, I_HW2, I_HB2, I_HW3, I_HFREQ, I_HBIAS,
       I_WPA, I_WPB, I_WO, I_FW1, I_FW3, I_FW2, I_ROUTER, I_MW1, I_MW3, I_MW2, I_FINALG };

constexpr int MISC_OFF = 131072 + 320;
constexpr int PTR_OFF = MISC_OFF + 128;
struct Ctx {
    LAS unsigned char* lds; int tid, lane, wave, G, bid; unsigned char* ws;
};
__device__ __forceinline__ Ctx mk_ctx(LAS unsigned char* lds, unsigned char* ws) {
    Ctx c; int t = threadIdx.x; asm volatile("" : "+v"(t)); asm volatile("" : "+s"(ws)); c.lds = lds; c.tid = t; c.lane = t & 63; c.wave = __builtin_amdgcn_readfirstlane(t >> 6); c.G = gridDim.x; c.bid = blockIdx.x; c.ws = ws; return c;
}
__device__ __forceinline__ const float* inp(const Ctx& c, int i) {
    unsigned ao = (unsigned)(PTR_OFF + 8 * i); asm volatile("" : "+v"(ao));
    const volatile LAS unsigned* p = (const volatile LAS unsigned*)(c.lds + ao);
    const unsigned lo = __builtin_amdgcn_readfirstlane(p[0]), hi = __builtin_amdgcn_readfirstlane(p[1]);
    return (const float*)(((unsigned long long)hi << 32) | (unsigned long long)lo);
}

__device__ __forceinline__ void transpose_item(const float* W, int N, bf16_t* WT, int ldk, int k0, int n0, int drow0, LAS float* scr, int lane) {
#pragma unroll 8
    for (int i = 0; i < 32; ++i) { const int kk = 2 * i + (lane >> 5); scr[kk * 33 + (lane & 31)] = W[(size_t)(k0 + kk) * N + n0 + (lane & 31)]; }
    LDS_WAIT(); asm volatile("" ::: "memory");
    const int c = lane & 7;
#pragma unroll
    for (int j = 0; j < 4; ++j) { const int n = (lane >> 3) + 8 * j; const LAS float* s = scr + (8 * c) * 33 + n;
        u32x4 o; o.x = cvt_pk_bf16(s[0 * 33], s[1 * 33]); o.y = cvt_pk_bf16(s[2 * 33], s[3 * 33]); o.z = cvt_pk_bf16(s[4 * 33], s[5 * 33]); o.w = cvt_pk_bf16(s[6 * 33], s[7 * 33]);
        *(u32x4*)(WT + (size_t)(drow0 + n) * ldk + k0 + 8 * c) = o; }
    LDS_WAIT(); asm volatile("" ::: "memory");
}
__device__ __forceinline__ void conv_mat(const float* W, int K, int N, bf16_t* WT, int mode, int& base, int gw, int NGW, LAS float* scr, int lane) {
    const int nblk = N / 32, nitems = (K / 64) * nblk;
    const int start = (gw - (base % NGW) + NGW) % NGW;
    for (int it = start; it < nitems; it += NGW) {
        const int kb = it / nblk, nb = it % nblk, n0 = nb * 32;
        const int drow0 = mode == 0 ? n0 : ((n0 >> 7) * 256 + (n0 & 127) + (mode == 2 ? 128 : 0));
        transpose_item(W, N, WT, K, kb * 64, n0, drow0, scr, lane);
    }
    base += nitems;
}
__device__ __forceinline__ void ph_convert(const Ctx& c0) {
    const Ctx c = mk_ctx(c0.lds, c0.ws);
    unsigned char* ws = c.ws;
    LAS float* scr = (LAS float*)(c.lds + c.wave * 16384);
    const int gw = c.bid * NWAVES + c.wave, NGW = c.G * NWAVES; int base = 0;
    for (int l = 0; l < DEPTH; ++l) {
        conv_mat(inp(c, I_WIN) + (size_t)l * D * PW, D, PW, (bf16_t*)(ws + WS_WIN) + (size_t)l * PW * D, 0, base, gw, NGW, scr, c.lane);
        conv_mat(inp(c, I_WPA) + (size_t)l * 512 * D, 512, D, (bf16_t*)(ws + WS_WPA) + (size_t)l * D * 512, 0, base, gw, NGW, scr, c.lane);
        conv_mat(inp(c, I_WPB) + (size_t)l * 512 * D, 512, D, (bf16_t*)(ws + WS_WPB) + (size_t)l * D * 512, 0, base, gw, NGW, scr, c.lane);
        conv_mat(inp(c, I_WO) + (size_t)l * D * D, D, D, (bf16_t*)(ws + WS_WO) + (size_t)l * D * D, 0, base, gw, NGW, scr, c.lane);
    }
    for (int i = 0; i < 2; ++i) {
        conv_mat(inp(c, I_FW1) + (size_t)i * D * FF, D, FF, (bf16_t*)(ws + WS_W13D) + (size_t)i * 2 * FF * D, 1, base, gw, NGW, scr, c.lane);
        conv_mat(inp(c, I_FW3) + (size_t)i * D * FF, D, FF, (bf16_t*)(ws + WS_W13D) + (size_t)i * 2 * FF * D, 2, base, gw, NGW, scr, c.lane);
        conv_mat(inp(c, I_FW2) + (size_t)i * FF * D, FF, D, (bf16_t*)(ws + WS_W2D) + (size_t)i * D * FF, 0, base, gw, NGW, scr, c.lane);
    }
    for (int ie = 0; ie < 2 * NE; ++ie) {
        conv_mat(inp(c, I_MW1) + (size_t)ie * D * FF, D, FF, (bf16_t*)(ws + WS_W13M) + (size_t)ie * 2 * FF * D, 1, base, gw, NGW, scr, c.lane);
        conv_mat(inp(c, I_MW3) + (size_t)ie * D * FF, D, FF, (bf16_t*)(ws + WS_W13M) + (size_t)ie * 2 * FF * D, 2, base, gw, NGW, scr, c.lane);
        conv_mat(inp(c, I_MW2) + (size_t)ie * FF * D, FF, D, (bf16_t*)(ws + WS_W2M) + (size_t)ie * D * FF, 0, base, gw, NGW, scr, c.lane);
    }
}

__device__ __forceinline__ void ph_mod(const Ctx& c0) {
    const Ctx c = mk_ctx(c0.lds, c0.ws);
    float* mod = (float*)(c.ws + WS_MOD);
    LAS float* s = (LAS float*)c.lds; LAS float* part = s + 5 * 1024;
    const float* cin = inp(c, I_C); const float* cctx = inp(c, I_CCTX); const float* wmod = inp(c, I_WMOD); const float* bmod = inp(c, I_BMOD);
    for (int i = c.tid; i < 5 * 1024; i += NTHR) { const int r = i >> 10, k = i & 1023; const float v = r < 4 ? cin[r * 1024 + k] : cctx[k]; s[i] = v * sigmoidf_(v); }
    __syncthreads();
    for (int unit = c.bid; unit < DEPTH * 96; unit += c.G) {
        const int l = unit / 96, j0 = (unit % 96) * 64;
        const float* w = wmod + (size_t)l * D * 6144 + j0 + c.lane;
        float acc[5] = {0.f, 0.f, 0.f, 0.f, 0.f};
        const int kb = c.wave * 128;
#pragma unroll 8
        for (int k = 0; k < 128; ++k) { const float wv = w[(size_t)(kb + k) * 6144];
#pragma unroll
            for (int r = 0; r < 5; ++r) acc[r] += s[r * 1024 + kb + k] * wv; }
#pragma unroll
        for (int r = 0; r < 5; ++r) part[(c.wave * 5 + r) * 64 + c.lane] = acc[r];
        __syncthreads();
        if (c.tid < 320) { const int r = c.tid >> 6, ln = c.tid & 63; float sum = 0.f;
#pragma unroll
            for (int w8 = 0; w8 < 8; ++w8) sum += part[(w8 * 5 + r) * 64 + ln];
            mod[(size_t)(l * 5 + r) * 6144 + j0 + ln] = sum + bmod[l * 6144 + j0 + ln]; }
        __syncthreads();
    }
}

__device__ __forceinline__ void ph_filt(const Ctx& c0) {
    const Ctx c = mk_ctx(c0.lds, c0.ws);
    const float* hb1 = inp(c, I_HB1); const float* hw1 = inp(c, I_HW1); const float* hb2 = inp(c, I_HB2); const float* hw2 = inp(c, I_HW2); const float* hfreq = inp(c, I_HFREQ); const float* hw3 = inp(c, I_HW3);
    LAS float* zb = (LAS float*)c.lds;
    LAS float* a1 = zb + 16 * 36;
    LAS float* a2 = a1 + 16 * 64;
    const float MINDEC = -3.0701134573253945f, MAXDEC = -15.350567286626973f;
    for (int unit = c.bid; unit < DEPTH * 272; unit += c.G) {
        const int l = unit / 272, uu = unit % 272;
        const int L = uu < 256 ? 4096 : 256, p0 = uu < 256 ? uu * 16 : (uu - 256) * 16;
        float* fout = uu < 256 ? (float*)(c.ws + WS_FL) + (size_t)l * 2 * 4096 * 512 : (float*)(c.ws + WS_FC) + (size_t)l * 2 * 256 * 512;
        for (int i = c.tid; i < 16 * 33; i += NTHR) { const int p = i / 33, q = i % 33; const int pos = p0 + p; float v;
            if (q == 0) v = (float)pos / (float)(L - 1);
            else { const int j = (q - 1) & 15; const double band = 1e-4 + (double)j * ((15.0 - 1e-4) / 15.0); double rev = (double)pos * band / (double)L; rev -= floor(rev);
                v = q <= 16 ? __builtin_amdgcn_cosf((float)rev) : -__builtin_amdgcn_sinf((float)rev); }
            zb[p * 36 + q] = v; }
        __syncthreads();
        for (int i = c.tid; i < 16 * 64; i += NTHR) { const int p = i >> 6, j = i & 63; float s = hb1[l * 64 + j];
            const float* w = hw1 + (size_t)l * 33 * 64 + j;
            for (int q = 0; q < 33; ++q) s += zb[p * 36 + q] * w[q * 64];
            a1[p * 64 + j] = sin_rad(hfreq[l * 128 + j] * s); }
        __syncthreads();
        for (int i = c.tid; i < 16 * 64; i += NTHR) { const int p = i >> 6, j = i & 63; float s = hb2[l * 64 + j];
            const float* w = hw2 + (size_t)l * 64 * 64 + j;
            for (int q = 0; q < 64; ++q) s += a1[p * 64 + q] * w[q * 64];
            a2[p * 64 + j] = sin_rad(hfreq[l * 128 + 64 + j] * s); }
        __syncthreads();
        {
            float acc0[16], acc1[16];
#pragma unroll
            for (int p = 0; p < 16; ++p) { acc0[p] = 0.f; acc1[p] = 0.f; }
            const float* w3 = hw3 + (size_t)l * 64 * 1024 + c.tid;
            for (int k = 0; k < 64; ++k) { const float wa = w3[k * 1024], wb = w3[k * 1024 + 512];
#pragma unroll
                for (int p = 0; p < 16; ++p) { const float av = a2[p * 64 + k]; acc0[p] += av * wa; acc1[p] += av * wb; } }
            bf16_t* hro = uu < 256 ? (bf16_t*)(c.ws + WS_HRL) + ((size_t)(l * 2) * 512 + c.tid) * (4096 + 64) : (bf16_t*)(c.ws + WS_HRC) + ((size_t)(l * 2) * 512 + c.tid) * (256 + 64);
            const size_t ostride = (size_t)512 * (L + 64);
            float f0[16], f1[16];
            const float r0 = fabsf(MINDEC + (float)c.tid * ((MAXDEC - MINDEC) / 1023.f)), r1 = fabsf(MINDEC + (float)(c.tid + 512) * ((MAXDEC - MINDEC) / 1023.f));
#pragma unroll
            for (int p = 0; p < 16; ++p) { const int pos = p0 + p; const float dist = fabsf((float)(pos - L / 2)) * (2.f / (float)L);
                f0[p] = acc0[p] * (__expf(-dist * r0) + 0.05f); f1[p] = acc1[p] * (__expf(-dist * r1) + 0.05f);
                fout[(size_t)(0 * L + pos) * 512 + c.tid] = f0[p];
                fout[(size_t)(1 * L + pos) * 512 + c.tid] = f1[p]; }
            {   u32x4 w0, w1, v0, v1;
                w0.x = cvt_pk_bf16(f0[15], f0[14]); w0.y = cvt_pk_bf16(f0[13], f0[12]); w0.z = cvt_pk_bf16(f0[11], f0[10]); w0.w = cvt_pk_bf16(f0[9], f0[8]);
                w1.x = cvt_pk_bf16(f0[7], f0[6]); w1.y = cvt_pk_bf16(f0[5], f0[4]); w1.z = cvt_pk_bf16(f0[3], f0[2]); w1.w = cvt_pk_bf16(f0[1], f0[0]);
                v0.x = cvt_pk_bf16(f1[15], f1[14]); v0.y = cvt_pk_bf16(f1[13], f1[12]); v0.z = cvt_pk_bf16(f1[11], f1[10]); v0.w = cvt_pk_bf16(f1[9], f1[8]);
                v1.x = cvt_pk_bf16(f1[7], f1[6]); v1.y = cvt_pk_bf16(f1[5], f1[4]); v1.z = cvt_pk_bf16(f1[3], f1[2]); v1.w = cvt_pk_bf16(f1[1], f1[0]);
                bf16_t* d0 = hro + (L + 16 - p0); bf16_t* d1 = d0 + ostride;
                *(u32x4*)d0 = w0; *(u32x4*)(d0 + 8) = w1; *(u32x4*)d1 = v0; *(u32x4*)(d1 + 8) = v1;
                const u32x4 z4 = (u32x4){0u, 0u, 0u, 0u};
                if (p0 == 0) { for (int k = 0; k < 4; ++k) { *(u32x4*)(hro + L + 32 + 8 * k) = z4; *(u32x4*)(hro + ostride + L + 32 + 8 * k) = z4; } }
                if (p0 == L - 16) { for (int k = 0; k < 4; ++k) { *(u32x4*)(hro + 8 * k) = z4; *(u32x4*)(hro + ostride + 8 * k) = z4; } } }
        }
        __syncthreads();
    }
}

struct MoeComb { const int* route; const float* rwt; const bf16_t* y; const float* gate; };
__device__ __forceinline__ void moe_combine_row(const MoeComb& mc, const LAS unsigned* offs, int row, int b, int lane, f32x4 (&v)[4]) {
    const int e1 = mc.route[(size_t)row * 4 + 0], p1 = mc.route[(size_t)row * 4 + 1], e2 = mc.route[(size_t)row * 4 + 2], p2 = mc.route[(size_t)row * 4 + 3];
    const float w1 = mc.rwt[(size_t)row * 2], w2 = mc.rwt[(size_t)row * 2 + 1];
    const size_t s1 = (size_t)offs[e1] + p1, s2 = (size_t)offs[e2] + p2;
    const float* gt = mc.gate + (size_t)b * 6144;
#pragma unroll
    for (int j = 0; j < 4; ++j) { const int k0 = 4 * (lane + 64 * j);
        const u32x2 a = *(const u32x2*)(mc.y + s1 * D + k0), bq = *(const u32x2*)(mc.y + s2 * D + k0); const f32x4 g4 = *(const f32x4*)(gt + k0);
        v[j][0] += g4[0] * (w1 * bflo(a.x) + w2 * bflo(bq.x)); v[j][1] += g4[1] * (w1 * bfhi(a.x) + w2 * bfhi(bq.x));
        v[j][2] += g4[2] * (w1 * bflo(a.y) + w2 * bflo(bq.y)); v[j][3] += g4[3] * (w1 * bfhi(a.y) + w2 * bfhi(bq.y)); }
}
__device__ __forceinline__ void moe_offsets(const Ctx& c, int i, LAS unsigned* offs) {
    if (c.tid == 0) { const unsigned* cnt = (const unsigned*)(c.ws + WS_CTL) + CW_CNT + 64 * i; unsigned o = 0;
        for (int e = 0; e < 8; ++e) { offs[e] = o; o += (cnt[e] + 255u) & ~255u; } offs[8] = o; }
}
__device__ __forceinline__ void ph_norm(const Ctx& c0, int l, int which) {
    const Ctx c = mk_ctx(c0.lds, c0.ws);
    float* xres = (float*)(c.ws + WS_X); bf16_t* h = (bf16_t*)(c.ws + WS_H);
    const float* mod = (const float*)(c.ws + WS_MOD) + (size_t)l * 5 * 6144;
    const float* gp = (which == 0 ? inp(c, I_N1G) : inp(c, I_N2G)) + l * D;
    const bool first = (l == 0 && which == 0), route = (which == 1 && (l & 1));
    const int comb = (which == 0 && l >= 1 && ((l - 1) & 1)) ? ((l - 1) >> 1) : -1;
    const float* router = inp(c, I_ROUTER) + (size_t)(l >> 1) * D * NE;
    int* routeb = (int*)(c.ws + WS_ROUTE); float* rwt = (float*)(c.ws + WS_RWT); int* tokenof = (int*)(c.ws + WS_TOK);
    const MoeComb mc{routeb, rwt, (const bf16_t*)(c.ws + WS_Y), (const float*)(c.ws + WS_MOD) + (size_t)(l > 0 ? l - 1 : 0) * 5 * 6144 + 5 * 1024};
    LAS unsigned* lcnt = (LAS unsigned*)c.lds; LAS unsigned* gbase = lcnt + 16; LAS unsigned* offs = lcnt + 32; LAS int* pend = (LAS int*)(c.lds + 256);
    if (c.tid < 8) lcnt[c.tid] = 0u;
    if (comb >= 0) moe_offsets(c, comb, offs);
    __syncthreads();
    const float* xin = inp(c, I_X); const float* ctxin = inp(c, I_CTX);
    int nrows = 0;
    for (int row = c.bid * NWAVES + c.wave; row < T; row += c.G * NWAVES, ++nrows) {
        const float* src = first ? (row < TL ? xin + (size_t)row * D : ctxin + (size_t)(row - TL) * D) : xres + (size_t)row * D;
        const int b = row < TL ? (row >> 12) : 4;
        const float* sh = mod + (size_t)b * 6144 + (which == 0 ? 0 : 3) * 1024; const float* sc = sh + 1024;
        f32x4 v[4]; float ss = 0.f;
#pragma unroll
        for (int j = 0; j < 4; ++j) v[j] = *(const f32x4*)(src + 4 * (c.lane + 64 * j));
        if (comb >= 0) moe_combine_row(mc, offs, row, b, c.lane, v);
#pragma unroll
        for (int j = 0; j < 4; ++j) ss += (v[j][0] * v[j][0] + v[j][1] * v[j][1]) + (v[j][2] * v[j][2] + v[j][3] * v[j][3]);
        ss = wave_sum(ss, c.lane);
        const float rstd = 1.f / sqrtf(ss * (1.f / D) + EPS);
        if (first || comb >= 0) {
#pragma unroll
            for (int j = 0; j < 4; ++j) *(f32x4*)(xres + (size_t)row * D + 4 * (c.lane + 64 * j)) = v[j];
        }
        float lg[8] = {0.f, 0.f, 0.f, 0.f, 0.f, 0.f, 0.f, 0.f};
#pragma unroll
        for (int j = 0; j < 4; ++j) { const int k0 = 4 * (c.lane + 64 * j);
            const f32x4 g4 = *(const f32x4*)(gp + k0), s4 = *(const f32x4*)(sc + k0), h4 = *(const f32x4*)(sh + k0);
            f32x4 o;
#pragma unroll
            for (int q = 0; q < 4; ++q) o[q] = v[j][q] * rstd * g4[q] * (1.f + s4[q]) + h4[q];
            u32x2 w; w.x = cvt_pk_bf16(o[0], o[1]); w.y = cvt_pk_bf16(o[2], o[3]);
            *(u32x2*)(h + (size_t)row * D + k0) = w;
            if (route) {
#pragma unroll
                for (int q = 0; q < 4; ++q) { const f32x4 ra = *(const f32x4*)(router + (size_t)(k0 + q) * 8), rb = *(const f32x4*)(router + (size_t)(k0 + q) * 8 + 4);
                    lg[0] += o[q] * ra[0]; lg[1] += o[q] * ra[1]; lg[2] += o[q] * ra[2]; lg[3] += o[q] * ra[3];
                    lg[4] += o[q] * rb[0]; lg[5] += o[q] * rb[1]; lg[6] += o[q] * rb[2]; lg[7] += o[q] * rb[3]; }
            }
        }
        if (route) {
#pragma unroll
            for (int e = 0; e < 8; ++e) lg[e] = wave_sum(lg[e], c.lane);
            int i1 = 0; float v1 = lg[0];
#pragma unroll
            for (int e = 1; e < 8; ++e) if (lg[e] > v1) { v1 = lg[e]; i1 = e; }
            int i2 = -1; float v2 = -3.0e38f;
#pragma unroll
            for (int e = 0; e < 8; ++e) if (e != i1 && lg[e] > v2) { v2 = lg[e]; i2 = e; }
            const float w1 = 1.f / (1.f + __expf(v2 - v1)), w2 = 1.f - w1;
            if (c.lane == 0) {
                const unsigned lp1 = __hip_atomic_fetch_add(lcnt + i1, 1u, __ATOMIC_RELAXED, __HIP_MEMORY_SCOPE_WORKGROUP), lp2 = __hip_atomic_fetch_add(lcnt + i2, 1u, __ATOMIC_RELAXED, __HIP_MEMORY_SCOPE_WORKGROUP);
                LAS int* pe = pend + (c.wave * 16 + nrows) * 4; pe[0] = row; pe[1] = i1 | (i2 << 8); pe[2] = (int)lp1; pe[3] = (int)lp2;
                rwt[(size_t)row * 2] = w1; rwt[(size_t)row * 2 + 1] = w2; }
        }
    }
    if (route) {
        __syncthreads();
        if (c.tid < 8) gbase[c.tid] = __hip_atomic_fetch_add((unsigned*)(c.ws + WS_CTL) + CW_CNT + 64 * (l >> 1) + c.tid, lcnt[c.tid], __ATOMIC_RELAXED, __HIP_MEMORY_SCOPE_AGENT);
        __syncthreads();
        if (c.lane < nrows) { const LAS int* pe = pend + (c.wave * 16 + c.lane) * 4; const int row = pe[0], e1 = pe[1] & 255, e2 = pe[1] >> 8;
            const int p1 = (int)gbase[e1] + pe[2], p2 = (int)gbase[e2] + pe[3];
            tokenof[(size_t)e1 * T + p1] = row; tokenof[(size_t)e2 * T + p2] = row;
            routeb[(size_t)row * 4 + 0] = e1; routeb[(size_t)row * 4 + 1] = p1; routeb[(size_t)row * 4 + 2] = e2; routeb[(size_t)row * 4 + 3] = p2; }
    }
    __syncthreads();
}

__device__ __forceinline__ void attn_key(const bf16_t* P, int ktok, int head, float bias, const float (&q)[64], float (&o)[64], float& m, float& s) {
    const u32x4* kp = (const u32x4*)(P + (size_t)ktok * PW + PK + head * 64);
    float sc = 0.f;
#pragma unroll
    for (int i = 0; i < 8; ++i) { const u32x4 w = kp[i];
        sc += q[8 * i + 0] * bflo(w.x) + q[8 * i + 1] * bfhi(w.x) + q[8 * i + 2] * bflo(w.y) + q[8 * i + 3] * bfhi(w.y)
            + q[8 * i + 4] * bflo(w.z) + q[8 * i + 5] * bfhi(w.z) + q[8 * i + 6] * bflo(w.w) + q[8 * i + 7] * bfhi(w.w); }
    sc += bias;
    const float mn = fmaxf(m, sc), al = __expf(m - mn), p = __expf(sc - mn);
    s = s * al + p; m = mn;
    const u32x4* vp = (const u32x4*)(P + (size_t)ktok * PW + PV + head * 64);
#pragma unroll
    for (int i = 0; i < 8; ++i) { const u32x4 w = vp[i];
        o[8 * i + 0] = o[8 * i + 0] * al + p * bflo(w.x); o[8 * i + 1] = o[8 * i + 1] * al + p * bfhi(w.x);
        o[8 * i + 2] = o[8 * i + 2] * al + p * bflo(w.y); o[8 * i + 3] = o[8 * i + 3] * al + p * bfhi(w.y);
        o[8 * i + 4] = o[8 * i + 4] * al + p * bflo(w.z); o[8 * i + 5] = o[8 * i + 5] * al + p * bfhi(w.z);
        o[8 * i + 6] = o[8 * i + 6] * al + p * bflo(w.w); o[8 * i + 7] = o[8 * i + 7] * al + p * bfhi(w.w); }
}
__device__ __forceinline__ void ph_attn_naive(const Ctx& c0, int l) {
    const Ctx c = mk_ctx(c0.lds, c0.ws);
    const bf16_t* P = (const bf16_t*)(c.ws + WS_P); bf16_t* oatt = (bf16_t*)(c.ws + WS_OATT);
    const float* rpb = inp(c, I_RPB) + (size_t)l * 8 * 15 * 31;
    for (int item = c.bid * NTHR + c.tid; item < T * 8; item += c.G * NTHR) {
        const int head = item & 7, tok = item >> 3;
        float q[64], o[64]; float m = -3.0e38f, s = 0.f;
        { const u32x4* qp = (const u32x4*)(P + (size_t)tok * PW + PQ + head * 64);
#pragma unroll
          for (int i = 0; i < 8; ++i) { const u32x4 w = qp[i];
              q[8 * i + 0] = 0.125f * bflo(w.x); q[8 * i + 1] = 0.125f * bfhi(w.x); q[8 * i + 2] = 0.125f * bflo(w.y); q[8 * i + 3] = 0.125f * bfhi(w.y);
              q[8 * i + 4] = 0.125f * bflo(w.z); q[8 * i + 5] = 0.125f * bfhi(w.z); q[8 * i + 6] = 0.125f * bflo(w.w); q[8 * i + 7] = 0.125f * bfhi(w.w); } }
#pragma unroll
        for (int i = 0; i < 64; ++i) o[i] = 0.f;
        int b;
        if (tok < TL) {
            b = tok >> 12; const int t = tok & 4095, r = t >> 6, qc = t & 63;
            const int r0 = min(max(r - 4, 0), 56), c0 = min(max(qc - 8, 0), 48);
            for (int kr = 0; kr < 8; ++kr) for (int kc = 0; kc < 16; ++kc) {
                const int krow = r0 + kr, kcol = c0 + kc;
                const float bias = rpb[(head * 15 + (krow - r + 7)) * 31 + (kcol - qc + 15)];
                attn_key(P, b * 4096 + krow * 64 + kcol, head, bias, q, o, m, s);
            }
        } else b = (tok - TL) >> 8;
        for (int j = 0; j < 256; ++j) attn_key(P, TL + b * 256 + j, head, 0.f, q, o, m, s);
        const float inv = 1.f / s;
        u32x4* op = (u32x4*)(oatt + (size_t)tok * 512 + head * 64);
#pragma unroll
        for (int i = 0; i < 8; ++i) { u32x4 w; w.x = cvt_pk_bf16(o[8 * i] * inv, o[8 * i + 1] * inv); w.y = cvt_pk_bf16(o[8 * i + 2] * inv, o[8 * i + 3] * inv);
            w.z = cvt_pk_bf16(o[8 * i + 4] * inv, o[8 * i + 5] * inv); w.w = cvt_pk_bf16(o[8 * i + 6] * inv, o[8 * i + 7] * inv); op[i] = w; }
    }
}

__device__ __forceinline__ void ph_sc(const Ctx& c0, int l) {
    const Ctx c = mk_ctx(c0.lds, c0.ws);
    const bf16_t* P = (const bf16_t*)(c.ws + WS_P); bf16_t* uT = (bf16_t*)(c.ws + WS_B);
    const float* cw = inp(c, I_HCW) + (size_t)l * 3 * 1536; const float* cb = inp(c, I_HCB) + (size_t)l * 1536;
    LAS unsigned char* scr = c.lds + c.wave * 16384;
    for (int tile = c.bid * NWAVES + c.wave; tile < (T / 64) * 24; tile += c.G * NWAVES) {
        const int rt = tile / 24, row0 = rt * 64, ch0 = (tile % 24) * 64;
        const int tpos = row0 < TL ? (row0 & 4095) : ((row0 - TL) & 255), Ls = row0 < TL ? 4096 : 256;
        for (int idx = c.lane; idx < 66 * 8; idx += 64) { const int rr = idx >> 3, ck = idx & 7; const int grow = row0 - 1 + rr;
            const bool ok = !((rr == 0 && tpos == 0) || (rr == 65 && tpos + 64 == Ls));
            u32x4 v = (u32x4){0u, 0u, 0u, 0u};
            if (ok) v = *(const u32x4*)(P + (size_t)grow * PW + PHY + ch0 + ck * 8);
            LAS unsigned* d = (LAS unsigned*)(scr + rr * 132 + ck * 16); d[0] = v.x; d[1] = v.y; d[2] = v.z; d[3] = v.w; }
        LDS_WAIT(); asm volatile("" ::: "memory");
        const int ch = ch0 + c.lane; const float w0 = cw[ch], w1 = cw[1536 + ch], w2 = cw[3072 + ch], bb = cb[ch];
        unsigned ow[32];
        { float prev = bf2f(*(const LAS unsigned short*)(scr + 0 * 132 + c.lane * 2)), cur = bf2f(*(const LAS unsigned short*)(scr + 1 * 132 + c.lane * 2)); float o0 = 0.f;
#pragma unroll
          for (int r = 0; r < 64; ++r) { const float nxt = bf2f(*(const LAS unsigned short*)(scr + (r + 2) * 132 + c.lane * 2));
              const float o = w0 * prev + w1 * cur + w2 * nxt + bb; prev = cur; cur = nxt;
              if (r & 1) ow[r >> 1] = cvt_pk_bf16(o0, o); else o0 = o; } }
        LDS_WAIT(); asm volatile("" ::: "memory");
#pragma unroll
        for (int k = 0; k < 8; ++k) { u32x4 v; v.x = ow[4 * k]; v.y = ow[4 * k + 1]; v.z = ow[4 * k + 2]; v.w = ow[4 * k + 3]; *(LAS u32x4*)(scr + c.lane * 144 + k * 16) = v; }
        LDS_WAIT(); asm volatile("" ::: "memory");
#pragma unroll
        for (int k = 0; k < 8; ++k) { const int cc = (c.lane >> 3) + 8 * k, ck = c.lane & 7; const u32x4 v = *(const LAS u32x4*)(scr + cc * 144 + ck * 16);
            *(u32x4*)(uT + (size_t)(ch0 + cc) * T + row0 + ck * 8) = v; }
        LDS_WAIT(); asm volatile("" ::: "memory");
    }
}

__device__ __forceinline__ void ph_conv_naive(const Ctx& c0, int l, int o) {
    const Ctx c = mk_ctx(c0.lds, c0.ws);
    const bf16_t* uT = (const bf16_t*)(c.ws + WS_B); float* zb = (float*)(c.ws + WS_Z); bf16_t* ohy = (bf16_t*)(c.ws + WS_OHY);
    const int ch = c.tid;
    const float bias = inp(c, I_HBIAS)[(l * 2 + o) * 512 + ch];
    for (int unit = c.bid; unit < 2048 + 128; unit += c.G) {
        int L, t0, rowbase; const float* filt;
        if (unit < 2048) { const int b = unit >> 9; t0 = (unit & 511) * 8; L = 4096; rowbase = b * 4096; filt = (const float*)(c.ws + WS_FL) + (size_t)(l * 2 + o) * 4096 * 512; }
        else { const int uu = unit - 2048, b = uu >> 5; t0 = (uu & 31) * 8; L = 256; rowbase = TL + b * 256; filt = (const float*)(c.ws + WS_FC) + (size_t)(l * 2 + o) * 256 * 512; }
        const int H = L / 2;
        const int s_lo = max(0, t0 - H + 1), s_hi = min(L - 1, t0 + 7 + H);
        float hw[8], acc[8];
#pragma unroll
        for (int j = 0; j < 8; ++j) { const int k = t0 + j - s_lo + H; hw[j] = (k >= 0 && k < L) ? filt[(size_t)k * 512 + ch] : 0.f; acc[j] = 0.f; }
        for (int s = s_lo; s <= s_hi; ++s) {
            const float uv = o == 0 ? bf2f(uT[(size_t)ch * T + rowbase + s]) : zb[(size_t)(rowbase + s) * 512 + ch];
#pragma unroll
            for (int j = 0; j < 8; ++j) acc[j] += uv * hw[j];
#pragma unroll
            for (int j = 7; j > 0; --j) hw[j] = hw[j - 1];
            const int k = t0 - (s + 1) + H; hw[0] = (k >= 0 && k < L) ? filt[(size_t)k * 512 + ch] : 0.f;
        }
#pragma unroll
        for (int j = 0; j < 8; ++j) { const size_t row = (size_t)(rowbase + t0 + j);
            if (o == 0) { const float uv = bf2f(uT[(size_t)ch * T + row]), x1 = bf2f(uT[(size_t)(512 + ch) * T + row]); zb[row * 512 + ch] = x1 * (acc[j] + bias * uv); }
            else { const float uv = zb[row * 512 + ch], x2 = bf2f(uT[(size_t)(1024 + ch) * T + row]); ohy[row * 512 + ch] = (bf16_t)(cvt_pk_bf16(x2 * (acc[j] + bias * uv), 0.f) & 0xffffu); } }
    }
}

constexpr int HY_HR_OFF = 0, HY_U_OFF = 66560, HY_ZB_OFF = HY_U_OFF + 4 * 8208;
template <int L>
__device__ __forceinline__ void hy_unit(const Ctx& c, int l, int ch, const float* hbias) {
    constexpr int H = L / 2, NG = L / 256, LP = L + 64, NW = L / 8 + 8, ROWB = 2 * L + 16;
    LAS unsigned char* lds = c.lds;
    const bf16_t* uT = (const bf16_t*)(c.ws + WS_B); bf16_t* ohy = (bf16_t*)(c.ws + WS_OHY);
    const int seq0 = (L == 4096) ? 0 : TL;
    const bf16_t* hrbase = (L == 4096) ? (const bf16_t*)(c.ws + WS_HRL) : (const bf16_t*)(c.ws + WS_HRC);
    int gA, gB;
    if (NG == 16) { gA = c.wave < 4 ? c.wave : 4 + c.wave; gB = c.wave < 4 ? 7 - c.wave : 19 - c.wave; } else { gA = c.wave == 0 ? 0 : -1; gB = -1; }
    const int n = c.lane & 31, g = c.lane >> 5, tbl = n >> 2, b = n & 3;
    const int loA = gA < 0 ? 1 << 30 : max(-H - 16, 256 * gA - (L - 16)), hiA = gA < 0 ? -(1 << 30) : min(H, 256 * gA + 224);
    const int loB = gB < 0 ? 1 << 30 : max(-H - 16, 256 * gB - (L - 16)), hiB = gB < 0 ? -(1 << 30) : min(H, 256 * gB + 224);
    const int dlo = min(loA, loB), dhi = max(hiA, hiB);
    unsigned zreg[2][4][2];
    for (int o = 0; o < 2; ++o) {
        const bf16_t* hr = hrbase + ((size_t)(l * 2 + o) * 512 + ch) * LP;
        for (int w = c.tid; w < NW; w += NTHR) {
            u32x4 A4 = (u32x4){0u, 0u, 0u, 0u}; if (w > 0) A4 = *(const u32x4*)(hr + 8 * (w - 1));
            const u32x4 B4 = *(const u32x4*)(hr + 8 * w);
            const unsigned Dd[8] = {A4.x, A4.y, A4.z, A4.w, B4.x, B4.y, B4.z, B4.w};
#pragma unroll
            for (int q = 0; q < 8; ++q) { u32x4 ov;
                if ((q & 1) == 0) { const int j = (8 - q) / 2; ov.x = Dd[j]; ov.y = Dd[j + 1]; ov.z = Dd[j + 2]; ov.w = Dd[j + 3]; }
                else { const int j = (7 - q) / 2; ov.x = __builtin_amdgcn_alignbit(Dd[j + 1], Dd[j], 16); ov.y = __builtin_amdgcn_alignbit(Dd[j + 2], Dd[j + 1], 16);
                       ov.z = __builtin_amdgcn_alignbit(Dd[j + 3], Dd[j + 2], 16); ov.w = __builtin_amdgcn_alignbit(Dd[j + 4], Dd[j + 3], 16); }
                *(LAS u32x4*)(lds + HY_HR_OFF + (8 * w + q) * 16) = ov; }
        }
        if (o == 0) {
            for (int idx = c.tid; idx < 4 * (L / 8); idx += NTHR) { const int bb = idx / (L / 8), wq = idx % (L / 8);
                *(LAS u32x4*)(lds + HY_U_OFF + bb * ROWB + wq * 16) = *(const u32x4*)(uT + (size_t)ch * T + seq0 + bb * L + wq * 8); }
            if (c.tid < 16) *(LAS unsigned*)(lds + HY_ZB_OFF + c.tid * 4) = 0u;
        } else {
#pragma unroll
            for (int gi = 0; gi < 2; ++gi) { const int G = gi == 0 ? gA : gB; if (G >= 0) {
#pragma unroll
                for (int rq = 0; rq < 4; ++rq) { const int t = 32 * (8 * G + tbl) + 8 * rq + 4 * g;
                    u32x2 zz; zz.x = zreg[gi][rq][0]; zz.y = zreg[gi][rq][1]; *(LAS u32x2*)(lds + HY_U_OFF + b * ROWB + 2 * t) = zz; } } }
        }
        __syncthreads();
        f32x16 accA, accB;
#pragma unroll
        for (int r = 0; r < 16; ++r) { accA[r] = 0.f; accB[r] = 0.f; }
        if (dlo <= dhi) {
            const int e0 = H + 31 - dlo - n + 8 * g, q = (n + 1) & 7, w = (e0 + q) >> 3;
            int aaddr = HY_HR_OFF + (8 * w + q) * 16;
            int s0A = 32 * (8 * gA + tbl) - dlo, s0B = 32 * (8 * gB + tbl) - dlo;
            const int ubase = HY_U_OFF + b * ROWB + 16 * g;
            for (int d = dlo; d <= dhi; d += 16) {
                const bf16x8 af = *(const LAS bf16x8*)(lds + aaddr);
                if (d >= loA && d <= hiA) { const bool ok = (unsigned)s0A <= (unsigned)(L - 16); const int ba = ok ? ubase + 2 * s0A : HY_ZB_OFF;
                    const bf16x8 bf = *(const LAS bf16x8*)(lds + ba); accA = __builtin_amdgcn_mfma_f32_32x32x16_bf16(af, bf, accA, 0, 0, 0); }
                if (d >= loB && d <= hiB) { const bool ok = (unsigned)s0B <= (unsigned)(L - 16); const int ba = ok ? ubase + 2 * s0B : HY_ZB_OFF;
                    const bf16x8 bf = *(const LAS bf16x8*)(lds + ba); accB = __builtin_amdgcn_mfma_f32_32x32x16_bf16(af, bf, accB, 0, 0, 0); }
                aaddr -= 256; s0A -= 16; s0B -= 16;
            }
        }
        const float bias = hbias[(l * 2 + o) * 512 + ch];
#pragma unroll
        for (int gi = 0; gi < 2; ++gi) { const int G = gi == 0 ? gA : gB; if (G >= 0) {
#pragma unroll
            for (int rq = 0; rq < 4; ++rq) { const int t = 32 * (8 * G + tbl) + 8 * rq + 4 * g;
                const u32x2 uv = *(const LAS u32x2*)(lds + HY_U_OFF + b * ROWB + 2 * t);
                const size_t grow = (size_t)seq0 + b * L + t;
                const u32x2 xv = *(const u32x2*)(uT + (size_t)((o == 0 ? 512 : 1024) + ch) * T + grow);
                float y[4];
#pragma unroll
                for (int k = 0; k < 4; ++k) y[k] = gi == 0 ? accA[4 * rq + k] : accB[4 * rq + k];
                const float r0 = bflo(xv.x) * (y[0] + bias * bflo(uv.x)), r1 = bfhi(xv.x) * (y[1] + bias * bfhi(uv.x));
                const float r2 = bflo(xv.y) * (y[2] + bias * bflo(uv.y)), r3 = bfhi(xv.y) * (y[3] + bias * bfhi(uv.y));
                const unsigned p0 = cvt_pk_bf16(r0, r1), p1 = cvt_pk_bf16(r2, r3);
                if (o == 0) { zreg[gi][rq][0] = p0; zreg[gi][rq][1] = p1; }
                else { bf16_t* op = ohy + grow * 512 + ch; op[0] = (bf16_t)(p0 & 0xffffu); op[512] = (bf16_t)(p0 >> 16); op[1024] = (bf16_t)(p1 & 0xffffu); op[1536] = (bf16_t)(p1 >> 16); } } } }
        __syncthreads();
    }
}
__device__ __forceinline__ void ph_hyena(const Ctx& c0, int l) {
    const Ctx c = mk_ctx(c0.lds, c0.ws);
    const float* hbias = inp(c, I_HBIAS);
    for (int unit = c.bid; unit < HYW; unit += c.G) { hy_unit<4096>(c, l, unit, hbias); hy_unit<256>(c, l, unit, hbias); }
}

__device__ __forceinline__ void ph_final(const Ctx& c0) {
    const Ctx c = mk_ctx(c0.lds, c0.ws);
    const float* xres = (const float*)(c.ws + WS_X); const float* gp = inp(c, I_FINALG); float* outp = (float*)inp(c, 30);
    const MoeComb mc{(const int*)(c.ws + WS_ROUTE), (const float*)(c.ws + WS_RWT), (const bf16_t*)(c.ws + WS_Y), (const float*)(c.ws + WS_MOD) + (size_t)(DEPTH - 1) * 5 * 6144 + 5 * 1024};
    LAS unsigned* offs = (LAS unsigned*)c.lds + 32;
    moe_offsets(c, 1, offs);
    __syncthreads();
    for (int row = c.bid * NWAVES + c.wave; row < TL; row += c.G * NWAVES) {
        const float* src = xres + (size_t)row * D; f32x4 v[4]; float ss = 0.f;
#pragma unroll
        for (int j = 0; j < 4; ++j) v[j] = *(const f32x4*)(src + 4 * (c.lane + 64 * j));
        moe_combine_row(mc, offs, row, row >> 12, c.lane, v);
#pragma unroll
        for (int j = 0; j < 4; ++j) ss += (v[j][0] * v[j][0] + v[j][1] * v[j][1]) + (v[j][2] * v[j][2] + v[j][3] * v[j][3]);
        ss = wave_sum(ss, c.lane);
        const float rstd = 1.f / sqrtf(ss * (1.f / D) + EPS);
#pragma unroll
        for (int j = 0; j < 4; ++j) { const int k0 = 4 * (c.lane + 64 * j); const f32x4 g4 = *(const f32x4*)(gp + k0); *(f32x4*)(outp + (size_t)row * D + k0) = v[j] * rstd * g4; }
    }
}

constexpr int MOE_OFF = 132096;
template <bool GATHER_> struct MoeOrder {
    static constexpr bool GATHER = GATHER_;
    int nM, nN, nwg, G, c; const char* A; const char* B; size_t astep, bstep, estep; const int* tokenof; const LAS unsigned* tab;
    __device__ void init(const void* A_, int lda, const void* B_, int ldb, size_t estep_bytes, int N, int G_, int c_, const int* tok, const LAS unsigned* tab_) {
        tab = tab_; nM = (int)((unsigned)__builtin_amdgcn_readfirstlane(tab[8]) >> 8); nN = N / pg8::BM; nwg = nM * nN; G = G_; c = c_; A = (const char*)A_; B = (const char*)B_;
        astep = (size_t)pg8::BM * lda * 2; bstep = (size_t)pg8::BM * ldb * 2; estep = estep_bytes; tokenof = tok; }
    __device__ bool next(int i, pg8::Unit& u) const {
        const long L = (long)i * G + c; if (L >= nwg) return false;
        int wgid = (int)L; { const int q = nwg / pg8::NXCD, r = nwg % pg8::NXCD, xcd = wgid % pg8::NXCD, off = wgid / pg8::NXCD; wgid = (xcd < r ? xcd * (q + 1) : r * (q + 1) + (xcd - r) * q) + off; }
        const int nig = pg8::WGM * nN, gid = wgid / nig, fm = gid * pg8::WGM, gsz = (nM - fm) < pg8::WGM ? (nM - fm) : pg8::WGM;
        u.pm = fm + ((wgid % nig) % gsz); u.pn = (wgid % nig) / gsz;
        const unsigned slot0 = (unsigned)u.pm << 8; int e = 0;
#pragma unroll
        for (int j = 1; j < 8; ++j) e += (slot0 >= (unsigned)__builtin_amdgcn_readfirstlane(tab[j])) ? 1 : 0;
        const unsigned pos0 = slot0 - (unsigned)__builtin_amdgcn_readfirstlane(tab[e]), cnt = (unsigned)__builtin_amdgcn_readfirstlane(tab[16 + e]);
        u.nvalid = cnt > pos0 ? (int)(cnt - pos0) : 0; u.tk = tokenof + (size_t)e * T + pos0;
        u.a = GATHER ? A : A + (size_t)u.pm * astep; u.b = B + (size_t)e * estep + (size_t)u.pn * bstep; return true;
    }
    __device__ __forceinline__ int arow(const pg8::Unit& u, int r) const { return r < u.nvalid ? u.tk[r] : 0; }
    __device__ __forceinline__ void a_ready(const pg8::Unit&) const {}
    __device__ __forceinline__ void done(const pg8::Unit&) const {}
};
__device__ __forceinline__ void moe_table(const Ctx& c, int i) {
    LAS unsigned* tab = (LAS unsigned*)(c.lds + MOE_OFF);
    if (c.tid == 0) { const unsigned* cnt = (const unsigned*)(c.ws + WS_CTL) + CW_CNT + 64 * i; unsigned o = 0;
        for (int e = 0; e < 8; ++e) { const unsigned ce = cnt[e]; tab[e] = o; tab[16 + e] = ce; o += (ce + 255u) & ~255u; } tab[8] = o; }
    __syncthreads();
}

#define XB_TMO      128
#define XB_XCNT(j)  (256  + 64 * (j))
#define XB_XSUB(j)  (1280 + 64 * (j))
#define XB_XGEN(j)  (2304 + 64 * (j))
#define XB_TOP      3328
#define XB_TOPGEN   3392
#define XCD_BAR_WORDS 3456
#define XB_SPIN_CAP (1u << 18)
__device__ __forceinline__ unsigned xb_ld(unsigned* p)              { return __hip_atomic_load(p, __ATOMIC_RELAXED, __HIP_MEMORY_SCOPE_AGENT); }
__device__ __forceinline__ unsigned xb_add(unsigned* p, unsigned v) { return __hip_atomic_fetch_add(p, v, __ATOMIC_RELAXED, __HIP_MEMORY_SCOPE_AGENT); }
__device__ __forceinline__ unsigned xb_xcc_id() { return (unsigned)__builtin_amdgcn_s_getreg((3 << 11) | 20) & 0xFu; }
#define XB_SPIN(cond, bar) do { unsigned _sp = 0; while (cond) { __builtin_amdgcn_s_sleep(1); \
    if ((++_sp & 255u) == 0u) { if (xb_ld(&(bar)[XB_TMO])) break; if (_sp > XB_SPIN_CAP) { atomicAdd(&(bar)[XB_TMO], 1u); break; } } } } while (0)
struct XcdBarrier { unsigned* bar; unsigned x; volatile LAS unsigned* st; };
__device__ __forceinline__ XcdBarrier xcd_barrier_post(unsigned* bar, volatile LAS unsigned* st) {
    XcdBarrier b; b.bar = bar; b.x = xb_xcc_id(); b.st = st;
    if (threadIdx.x == 0) (void)xb_add(&bar[XB_XCNT(b.x)], 1u);
    return b;
}
__device__ __forceinline__ void xcd_barrier_complete(unsigned* bar, unsigned x, unsigned& nloc, unsigned& nx) {
    const unsigned G = gridDim.x * gridDim.y * gridDim.z;
    unsigned sum, cnt, mine, sp = 0u;
    for (;;) {
        sum = 0u; cnt = 0u; mine = 0u;
#pragma unroll
        for (unsigned j = 0; j < 16; ++j) { const unsigned c = xb_ld(&bar[XB_XCNT(j)]); sum += c; cnt += (c > 0u) ? 1u : 0u; mine = (j == x) ? c : mine; }
        if (sum == G) break;
        __builtin_amdgcn_s_sleep(1);
        if ((++sp & 255u) == 0u) { if (xb_ld(&bar[XB_TMO])) break; if (sp > XB_SPIN_CAP) { atomicAdd(&bar[XB_TMO], 1u); break; } }
    }
    nloc = mine > 0u ? mine : 1u; nx = cnt > 0u ? cnt : 1u;
}
__device__ __forceinline__ void xcd_barrier(const XcdBarrier& b) {
    asm volatile("s_waitcnt vmcnt(0)" ::: "memory");
    __syncthreads();
    if (threadIdx.x == 0) {
        unsigned* bar = b.bar; const unsigned bx = xb_xcc_id();
        __builtin_amdgcn_s_waitcnt(0);
        unsigned nloc = b.st[0], nx = b.st[1];
        if (nloc == 0u) { xcd_barrier_complete(bar, bx, nloc, nx); b.st[0] = nloc; b.st[1] = nx; }
        const unsigned old = xb_add(&bar[XB_XSUB(bx)], 1u);
        const unsigned gen = old / nloc;
        if (old + 1u == (gen + 1u) * nloc) {
            __builtin_amdgcn_fence(__ATOMIC_RELEASE, "agent");
            asm volatile("s_waitcnt vmcnt(0)" ::: "memory");
            const unsigned og = xb_add(&bar[XB_TOP], 1u);
            const unsigned tg = og / nx;
            if (og + 1u == (tg + 1u) * nx) xb_add(&bar[XB_TOPGEN], 1u);
            else XB_SPIN(xb_ld(&bar[XB_TOPGEN]) == tg, bar);
            __builtin_amdgcn_fence(__ATOMIC_ACQUIRE, "agent");
            xb_add(&bar[XB_XGEN(bx)], 1u);
            asm volatile("s_waitcnt vmcnt(0)" ::: "memory");
        } else {
            XB_SPIN(xb_ld(&bar[XB_XGEN(bx)]) == gen, bar);
            __builtin_amdgcn_fence(__ATOMIC_ACQUIRE, "agent");
            asm volatile("s_waitcnt vmcnt(0)" ::: "memory");
        }
    }
    __syncthreads();
}

constexpr int CW_BAR = 4096;

__global__ void __launch_bounds__(NTHR, 2) fwd(Args args) {
    extern __shared__ __attribute__((aligned(16))) unsigned char lds_raw[];
    Ctx c; c.lds = (LAS unsigned char*)lds_raw; c.tid = threadIdx.x; c.lane = c.tid & 63; c.wave = __builtin_amdgcn_readfirstlane(c.tid >> 6); c.G = gridDim.x; c.bid = blockIdx.x; c.ws = args.ws;
    unsigned char* ws = args.ws;
    volatile LAS unsigned* MISC = (volatile LAS unsigned*)(c.lds + MISC_OFF);
    if (c.tid < 32) MISC[c.tid] = 0u;
    if (c.tid < 31) { const unsigned long long pv = c.tid < 30 ? (unsigned long long)args.in[c.tid] : (unsigned long long)args.out;
        volatile LAS unsigned* pt = (volatile LAS unsigned*)(c.lds + PTR_OFF) + 2 * c.tid; pt[0] = (unsigned)pv; pt[1] = (unsigned)(pv >> 32); }
    __syncthreads();
    XcdBarrier bar = xcd_barrier_post((unsigned*)(ws + WS_CTL) + CW_BAR, MISC + 8);
#define GRID_BAR() xcd_barrier(bar)

    ph_convert(c); __syncthreads(); ph_mod(c); __syncthreads(); ph_filt(c);
    GRID_BAR();
    for (int l = 0; l < DEPTH; ++l) {
        ph_norm(c, l, 0);
        GRID_BAR();
        {   unsigned char* ws = c.ws; asm volatile("" : "+s"(ws));
            pg8::Gemm g{D, D, D}; pg8::StaticOrder S; S.init(ws + WS_H, D, (bf16_t*)(ws + WS_WIN) + (size_t)l * PW * D, D, T, PW, c.G, c.bid);
            EpiStoreBf16 E{(bf16_t*)(ws + WS_P), PW};
            pg8::gemm_phase(c.lds, g, S, E); }
        GRID_BAR();
        ph_attn_naive(c, l); ph_sc(c, l);
        GRID_BAR();
#if defined(NAIVE_CONV)
        ph_conv_naive(c, l, 0);
        GRID_BAR();
        ph_conv_naive(c, l, 1);
        GRID_BAR();
#else
        ph_hyena(c, l);
        GRID_BAR();
#endif
        {   unsigned char* ws = c.ws; asm volatile("" : "+s"(ws));
            pg8::Gemm g{512, 512, 512};
            { pg8::StaticOrder S; S.init(ws + WS_OATT, 512, (bf16_t*)(ws + WS_WPA) + (size_t)l * D * 512, 512, T, D, c.G, c.bid);
              EpiMerge1 E{(float*)(ws + WS_B), (const bf16_t*)(ws + WS_P)};
              pg8::gemm_phase(c.lds, g, S, E); }
            { pg8::StaticOrder S; S.init(ws + WS_OHY, 512, (bf16_t*)(ws + WS_WPB) + (size_t)l * D * 512, 512, T, D, c.G, c.bid);
              EpiMerge2 E{(const float*)(ws + WS_B), (const bf16_t*)(ws + WS_P), (bf16_t*)(ws + WS_H)};
              pg8::gemm_phase(c.lds, g, S, E); } }
        GRID_BAR();
        {   unsigned char* ws = c.ws; asm volatile("" : "+s"(ws));
            const float* modl = (const float*)(ws + WS_MOD) + (size_t)l * 5 * 6144;
            pg8::Gemm g{D, D, D}; pg8::StaticOrder S; S.init(ws + WS_H, D, (bf16_t*)(ws + WS_WO) + (size_t)l * D * D, D, T, D, c.G, c.bid);
            EpiResid E{(float*)(ws + WS_X), modl + 2 * 1024};
            pg8::gemm_phase(c.lds, g, S, E); }
        GRID_BAR();
        ph_norm(c, l, 1);
        GRID_BAR();
        if ((l & 1) == 0) {
            {   unsigned char* ws = c.ws; asm volatile("" : "+s"(ws));
                const bf16_t* w = (const bf16_t*)(ws + WS_W13D) + (size_t)(l >> 1) * 2 * FF * D;
                pg8::Gemm g{D, D, D}; pg8::StaticOrder S; S.init(ws + WS_H, D, w, D, T, 2 * FF, c.G, c.bid);
                EpiSwiglu E{(bf16_t*)(ws + WS_P)};
                pg8::gemm_phase(c.lds, g, S, E); }
            GRID_BAR();
            {   unsigned char* ws = c.ws; asm volatile("" : "+s"(ws));
                const float* modl = (const float*)(ws + WS_MOD) + (size_t)l * 5 * 6144;
                const bf16_t* w = (const bf16_t*)(ws + WS_W2D) + (size_t)(l >> 1) * D * FF;
                pg8::Gemm g{FF, FF, FF}; pg8::StaticOrder S; S.init(ws + WS_P, FF, w, FF, T, D, c.G, c.bid);
                EpiResid E{(float*)(ws + WS_X), modl + 5 * 1024};
                pg8::gemm_phase(c.lds, g, S, E); }
            GRID_BAR();
        } else {
            const Ctx cm = mk_ctx(c.lds, c.ws);
            moe_table(cm, l >> 1);
            {   unsigned char* ws = c.ws; asm volatile("" : "+s"(ws));
                const bf16_t* w = (const bf16_t*)(ws + WS_W13M) + (size_t)((l >> 1) * NE) * 2 * FF * D;
                pg8::Gemm g{D, D, D}; MoeOrder<true> S; S.init(ws + WS_H, D, w, D, (size_t)2 * FF * D * 2, 2 * FF, c.G, c.bid, (const int*)(ws + WS_TOK), (const LAS unsigned*)(c.lds + MOE_OFF));
                EpiSwiglu E{(bf16_t*)(ws + WS_P)};
                pg8::gemm_phase(c.lds, g, S, E); }
            GRID_BAR();
            {   unsigned char* ws = c.ws; asm volatile("" : "+s"(ws));
                const bf16_t* w = (const bf16_t*)(ws + WS_W2M) + (size_t)((l >> 1) * NE) * D * FF;
                pg8::Gemm g{FF, FF, FF}; MoeOrder<false> S; S.init(ws + WS_P, FF, w, FF, (size_t)D * FF * 2, D, c.G, c.bid, (const int*)(ws + WS_TOK), (const LAS unsigned*)(c.lds + MOE_OFF));
                EpiStoreBf16 E{(bf16_t*)(ws + WS_Y), D};
                pg8::gemm_phase(c.lds, g, S, E); }
            GRID_BAR();
        }
    }
    ph_final(c);
}

extern "C" void kernel_launch(void* const* d_in, const int* in_sizes, int n_in, void* d_out, int out_size, void* d_ws, size_t ws_size, hipStream_t stream) {
    static int grid = 0;
    if (grid == 0) {
        if (n_in != 30 || out_size != TL * D || ws_size < WS_END) { fprintf(stderr, "kernel_launch: unexpected shapes (n_in %d out %d ws %zu)\n", n_in, out_size, ws_size); grid = -1; return; }
        int dev = 0, cus = 0, per_cu = 0; (void)hipGetDevice(&dev); (void)hipDeviceGetAttribute(&cus, hipDeviceAttributeMultiprocessorCount, dev);
        if (hipFuncSetAttribute((const void*)fwd, hipFuncAttributeMaxDynamicSharedMemorySize, LDS_BYTES) != hipSuccess) { fprintf(stderr, "kernel_launch: hipFuncSetAttribute failed\n"); grid = -1; return; }
        if (hipOccupancyMaxActiveBlocksPerMultiprocessor(&per_cu, (const void*)fwd, NTHR, LDS_BYTES) != hipSuccess || per_cu < 1) fprintf(stderr, "kernel_launch: occupancy query reports %d\n", per_cu);
        (void)hipGetLastError();
        grid = cus > 0 ? cus : 256;
    }
    if (grid < 0) return;
    (void)hipMemsetAsync((char*)d_ws + WS_CTL, 0, CTL_ZERO_BYTES, stream);
    Args a{};
    for (int i = 0; i < 30; ++i) a.in[i] = (const float*)d_in[i];
    a.out = (float*)d_out; a.ws = (unsigned char*)d_ws;
    hipLaunchKernelGGL(fwd, dim3(grid), dim3(NTHR), LDS_BYTES, stream, a);
}
```

```cpp
#include <hip/hip_runtime.h>
#include <cstdio>
#include <cstdint>

#define LAS __attribute__((address_space(3)))
#define GAS __attribute__((address_space(1)))
typedef unsigned short bf16_t;
typedef short bf16x8 __attribute__((ext_vector_type(8)));
typedef float f32x4 __attribute__((ext_vector_type(4)));
typedef float f32x2 __attribute__((ext_vector_type(2)));
typedef float f32x16 __attribute__((ext_vector_type(16)));
typedef unsigned u32x4 __attribute__((ext_vector_type(4)));
typedef unsigned u32x2 __attribute__((ext_vector_type(2)));

constexpr int D = 1024, NB = 4, SEQ = 4096, DEPTH = 4, CTX = 256;
constexpr int TL = NB * SEQ, TC = NB * CTX, T = TL + TC;
constexpr int PW = 5120, FF = 2816, NE = 8, HYW = 512;
constexpr int PQ = 0, PK = 512, PV = 1024, PHY = 1536, PGA = 3072, PGB = 4096;
constexpr float EPS = 1e-6f;

constexpr size_t MiB = 1u << 20;
constexpr size_t WS_CTL = 0, CTL_ZERO_BYTES = 1 * MiB;
constexpr size_t WS_MOD = 1 * MiB;
constexpr size_t WS_ROUTE = 2 * MiB;
constexpr size_t WS_RWT = 2 * MiB + 512 * 1024;
constexpr size_t WS_TOK = 3 * MiB;
constexpr int CW_CNT = 8192;
constexpr int MAXSLOT = 36864;
constexpr size_t WS_Y = 660 * MiB;
constexpr size_t WS_WIN = 4 * MiB;
constexpr size_t WS_WPA = 44 * MiB;
constexpr size_t WS_WPB = 48 * MiB;
constexpr size_t WS_WO = 52 * MiB;
constexpr size_t WS_W13D = 60 * MiB;
constexpr size_t WS_W2D = 82 * MiB;
constexpr size_t WS_W13M = 93 * MiB;
constexpr size_t WS_W2M = 269 * MiB;
constexpr size_t WS_X = 357 * MiB;
constexpr size_t WS_H = 425 * MiB;
constexpr size_t WS_P = 459 * MiB;
constexpr size_t WS_OATT = 629 * MiB;
constexpr size_t WS_OHY = 646 * MiB;
constexpr size_t WS_B = 663 * MiB;
constexpr size_t WS_Z = WS_B + 51 * MiB;
constexpr size_t WS_VT = 748 * MiB;
constexpr size_t WS_HRL = 816 * MiB;
constexpr size_t WS_HRC = 850 * MiB;
constexpr size_t WS_END = 853 * MiB;

constexpr int LDS_BYTES = 147456;
constexpr int NWAVES = 8, NTHR = 512;

#define LDS_WAIT() asm volatile("s_waitcnt lgkmcnt(0)" ::: "memory")
#define VM_WAIT() asm volatile("s_waitcnt vmcnt(0)" ::: "memory")
__device__ __forceinline__ float bf2f(unsigned b) { return __uint_as_float(b << 16); }
__device__ __forceinline__ float bflo(unsigned w) { return __uint_as_float(w << 16); }
__device__ __forceinline__ float bfhi(unsigned w) { return __uint_as_float(w & 0xffff0000u); }
__device__ __forceinline__ unsigned cvt_pk_bf16(float lo, float hi) { unsigned r; asm volatile("v_cvt_pk_bf16_f32 %0, %1, %2" : "=v"(r) : "v"(lo), "v"(hi)); return r; }
__device__ __forceinline__ float wave_sum(float v, int lane) {
#pragma unroll
    for (int o = 1; o < 64; o <<= 1) v += __int_as_float(__builtin_amdgcn_ds_bpermute((lane ^ o) << 2, __float_as_int(v)));
    return v;
}
__device__ __forceinline__ float sigmoidf_(float x) { return 1.f / (1.f + __expf(-x)); }
__device__ __forceinline__ float sin_rev(float r) { return __builtin_amdgcn_sinf(__builtin_amdgcn_fractf(r)); }
__device__ __forceinline__ float sin_rad(float x) { return sin_rev(x * 0.15915494309189535f); }

namespace pg8 {
constexpr int BM = 256, BK = 64, HALF = 128, HTB = HALF * BK * 2, STAGE_BYTES = 8 * HTB, NXCD = 8, WGM = 8;
__host__ __device__ __forceinline__ int lds_byte(int r, int c) { const int st = (r >> 4) * 2 + (c >> 5), rr = r & 15, cc = c & 31, ob = rr * 64 + cc * 2; return st * 1024 + (ob ^ (((ob >> 9) & 1) << 5)); }
__host__ __device__ __forceinline__ void stage_rc(int b, int& R, int& C) { const int st = b / 1024, sb = b % 1024, swz = sb ^ (((sb >> 9) & 1) << 5); R = (st >> 1) * 16 + swz / 64; C = (st & 1) * 32 + (swz % 64) / 2; }
__host__ __device__ __forceinline__ int perm32(int rho) { const int n = rho >> 4, i = rho & 15; return 8 * (i >> 2) + 4 * n + (i & 3); }

struct Unit { int pm, pn; const char* a; const char* b; const int* tk; int nvalid; };
struct Gemm { int K, lda, ldb; };

struct StaticOrder {
    int nM, nN, nwg, G, c; const char* A; const char* B; size_t astep, bstep;
    __device__ void init(const void* A_, int lda, const void* B_, int ldb, int M, int N, int G_, int c_) {
        nM = M / BM; nN = N / BM; nwg = nM * nN; G = G_; c = c_; A = (const char*)A_; B = (const char*)B_; astep = (size_t)BM * lda * 2; bstep = (size_t)BM * ldb * 2; }
    __device__ bool next(int i, Unit& u) const {
        const long L = (long)i * G + c; if (L >= nwg) return false;
        int wgid = (int)L; { const int q = nwg / NXCD, r = nwg % NXCD, xcd = wgid % NXCD, off = wgid / NXCD; wgid = (xcd < r ? xcd * (q + 1) : r * (q + 1) + (xcd - r) * q) + off; }
        const int nig = WGM * nN, gid = wgid / nig, fm = gid * WGM, gsz = (nM - fm) < WGM ? (nM - fm) : WGM;
        u.pm = fm + ((wgid % nig) % gsz); u.pn = (wgid % nig) / gsz; u.a = A + (size_t)u.pm * astep; u.b = B + (size_t)u.pn * bstep; return true;
    }
    static constexpr bool GATHER = false;
    __device__ __forceinline__ int arow(const Unit&, int) const { return 0; }
    __device__ __forceinline__ void a_ready(const Unit&) const {}
    __device__ __forceinline__ void done(const Unit&) const {}
};

template <class Epi, class Sched, bool ALIGN_EPI = true>
__device__ __forceinline__ void gemm_phase(LAS unsigned char* lds, const Gemm g, const Sched& S, const Epi& E) {
    int tid = threadIdx.x; asm volatile("" : "+v"(tid));
    const int wid = __builtin_amdgcn_readfirstlane(tid >> 6), lane = tid & 63, wr = wid >> 2, wc = wid & 3, fr = lane & 15, fq = lane >> 4;
    const int K = g.K, nt = K / BK;
    constexpr bool GATHER = Sched::GATHER;
    unsigned voffB[2]; unsigned cA0[2], cA1[2], nA0[2], nA1[2]; int RA[2], CA[2];
    const size_t hstepA = (size_t)HALF * g.lda * 2, hstepB = (size_t)HALF * g.ldb * 2;
#pragma unroll
    for (int i = 0; i < 2; ++i) { int R, C; stage_rc(tid * 16 + i * 8192, R, C); const int Rb = Epi::PERM ? ((R & ~31) + perm32(R & 31)) : R;
        RA[i] = R; CA[i] = C; voffB[i] = (unsigned)(Rb * g.ldb + C) * 2u;
        cA0[i] = (unsigned)(R * g.lda + C) * 2u; cA1[i] = cA0[i]; nA0[i] = cA0[i]; nA1[i] = cA0[i]; }
    const size_t h1A = GATHER ? 0 : hstepA;
    const size_t kstep = (size_t)(BK * 2);
    const unsigned ldsw = (unsigned)wid * 1024u;
    const int aoff = lds_byte(wr * 64 + fr, fq * 8), boff = lds_byte(wc * 32 + fr, fq * 8);
#define PG8_SA(b, h) (((b) * 2 + (h)) * HTB)
#define PG8_SB(b, h) ((4 + (b) * 2 + (h)) * HTB)
#define PG8_STAGE(bufoff, gbase, voff) do { _Pragma("unroll") for (int _i = 0; _i < 2; ++_i) \
        __builtin_amdgcn_global_load_lds((const unsigned*)((const char*)(gbase) + (voff)[_i]), (LAS unsigned*)(lds + (bufoff) + ldsw + _i * 8192), 16, 0, 0); } while (0)
#define PG8_LDA(dst, b, h) do { _Pragma("unroll") for (int m = 0; m < 4; ++m) _Pragma("unroll") for (int k = 0; k < 2; ++k) dst[m][k] = *(const LAS bf16x8*)(lds + PG8_SA(b, h) + aoff + m * 2048 + k * 1024); } while (0)
#define PG8_LDB(dst, b, h) do { _Pragma("unroll") for (int n = 0; n < 2; ++n) _Pragma("unroll") for (int k = 0; k < 2; ++k) dst[n][k] = *(const LAS bf16x8*)(lds + PG8_SB(b, h) + boff + n * 2048 + k * 1024); } while (0)
#define PG8_MMA(ai, bj, At, Bt) do { __builtin_amdgcn_s_setprio(1); _Pragma("unroll") for (int m = 0; m < 4; ++m) _Pragma("unroll") for (int n = 0; n < 2; ++n) _Pragma("unroll") for (int k = 0; k < 2; ++k) \
        acc[ai][bj][m][n] = __builtin_amdgcn_mfma_f32_16x16x32_bf16(Bt[n][k], At[m][k], acc[ai][bj][m][n], 0, 0, 0); __builtin_amdgcn_s_setprio(0); } while (0)
#define PG8_WAIT_V(n) asm volatile("s_waitcnt vmcnt(" #n ")" ::: "memory")
#define PG8_WAIT_L(n) asm volatile("s_waitcnt lgkmcnt(" #n ")" ::: "memory")
#define PG8_BAR __builtin_amdgcn_s_barrier()
#define PG8_SCHED __builtin_amdgcn_sched_barrier(0)
    Unit cur, nxt; int ui = 0;
    if (!S.next(0, cur)) return;
    if constexpr (GATHER) {
#pragma unroll
        for (int i = 0; i < 2; ++i) { cA0[i] = (unsigned)(S.arow(cur, RA[i]) * g.lda + CA[i]) * 2u; cA1[i] = (unsigned)(S.arow(cur, HALF + RA[i]) * g.lda + CA[i]) * 2u; }
    }
    f32x4 acc[2][2][4][2];
#pragma unroll
    for (int a = 0; a < 2; ++a)
#pragma unroll
        for (int b = 0; b < 2; ++b)
#pragma unroll
            for (int m = 0; m < 4; ++m)
#pragma unroll
                for (int n = 0; n < 2; ++n) acc[a][b][m][n] = (f32x4){0.f, 0.f, 0.f, 0.f};
    bf16x8 At[4][2], B0[2][2], B1[2][2];
    const char* cA = cur.a; const char* cB = cur.b;
    S.a_ready(cur);
    PG8_STAGE(PG8_SB(0, 0), cB, voffB); PG8_STAGE(PG8_SB(0, 1), cB + hstepB, voffB); PG8_STAGE(PG8_SA(0, 0), cA, cA0); PG8_STAGE(PG8_SA(0, 1), cA + h1A, cA1);
    if (wr == 1) PG8_BAR;
    PG8_WAIT_V(2); PG8_BAR;
    PG8_STAGE(PG8_SB(1, 0), cB + kstep, voffB); PG8_STAGE(PG8_SA(1, 0), cA + kstep, cA0); PG8_STAGE(PG8_SB(1, 1), cB + hstepB + kstep, voffB);
    PG8_WAIT_V(6); PG8_BAR;
    for (;;) {
        const bool has_next = S.next(ui + 1, nxt);
        const char* nA = has_next ? nxt.a : cA; const char* nB = has_next ? nxt.b : cB;
        if constexpr (GATHER) {
#pragma unroll
            for (int i = 0; i < 2; ++i) { nA0[i] = has_next ? (unsigned)(S.arow(nxt, RA[i]) * g.lda + CA[i]) * 2u : cA0[i]; nA1[i] = has_next ? (unsigned)(S.arow(nxt, HALF + RA[i]) * g.lda + CA[i]) * 2u : cA1[i]; }
        }
        for (int t = 0; t < nt; t += 2) {
            const bool last = (t == nt - 2);
            const char* a1 = cA + (size_t)(t + 1) * kstep;
            const char* a2 = last ? nA : cA + (size_t)(t + 2) * kstep; const char* b2 = last ? nB : cB + (size_t)(t + 2) * kstep;
            const char* a3 = a2 + kstep; const char* b3 = b2 + kstep;
            unsigned x0[2], x1[2];
#pragma unroll
            for (int i = 0; i < 2; ++i) { x0[i] = (GATHER && last) ? nA0[i] : cA0[i]; x1[i] = GATHER ? (last ? nA1[i] : cA1[i]) : cA0[i]; }
            if (last && has_next) S.a_ready(nxt);
            PG8_LDB(B0, 0, 0); PG8_LDB(B1, 0, 1); PG8_SCHED; PG8_LDA(At, 0, 0); PG8_STAGE(PG8_SA(1, 1), a1 + h1A, cA1);
            PG8_WAIT_V(8); PG8_WAIT_L(0); PG8_BAR; PG8_MMA(0, 0, At, B0); PG8_MMA(0, 1, At, B1); PG8_BAR; PG8_SCHED;
            PG8_LDA(At, 0, 1); PG8_STAGE(PG8_SB(0, 0), b2, voffB); PG8_STAGE(PG8_SB(0, 1), b2 + hstepB, voffB); PG8_STAGE(PG8_SA(0, 0), a2, x0);
            PG8_WAIT_V(8); PG8_WAIT_L(0); PG8_BAR; PG8_MMA(1, 0, At, B0); PG8_MMA(1, 1, At, B1); PG8_BAR; PG8_SCHED;
            PG8_LDB(B0, 1, 0); PG8_LDB(B1, 1, 1); PG8_SCHED; PG8_LDA(At, 1, 0); PG8_STAGE(PG8_SA(0, 1), a2 + h1A, x1);
            PG8_WAIT_V(8); PG8_WAIT_L(0); PG8_BAR; PG8_MMA(0, 0, At, B0); PG8_MMA(0, 1, At, B1); PG8_BAR; PG8_SCHED;
            PG8_LDA(At, 1, 1); PG8_STAGE(PG8_SB(1, 0), b3, voffB); PG8_STAGE(PG8_SB(1, 1), b3 + hstepB, voffB); PG8_STAGE(PG8_SA(1, 0), a3, x0);
            PG8_WAIT_V(8); PG8_WAIT_L(0); PG8_BAR; PG8_MMA(1, 0, At, B0); PG8_MMA(1, 1, At, B1); PG8_BAR; PG8_SCHED;
        }
        if constexpr (ALIGN_EPI) { if (wr == 0) PG8_BAR; }
        E(acc, cur, wr, wc, fr, fq); S.done(cur);
        if (!has_next) break;
#pragma unroll
        for (int a = 0; a < 2; ++a)
#pragma unroll
            for (int b = 0; b < 2; ++b)
#pragma unroll
                for (int m = 0; m < 4; ++m)
#pragma unroll
                    for (int n = 0; n < 2; ++n) acc[a][b][m][n] = (f32x4){0.f, 0.f, 0.f, 0.f};
        cur = nxt; cA = nA; cB = nB; ++ui;
        if constexpr (GATHER) {
#pragma unroll
            for (int i = 0; i < 2; ++i) { cA0[i] = nA0[i]; cA1[i] = nA1[i]; }
        }
        if constexpr (ALIGN_EPI) { if (wr == 1) PG8_BAR; }
    }
    PG8_WAIT_V(0);
    if constexpr (!ALIGN_EPI) { if (wr == 0) PG8_BAR; }
    PG8_BAR;
#undef PG8_SA
#undef PG8_SB
#undef PG8_STAGE
#undef PG8_LDA
#undef PG8_LDB
#undef PG8_MMA
#undef PG8_WAIT_V
#undef PG8_WAIT_L
#undef PG8_BAR
#undef PG8_SCHED
}
}

typedef f32x4 AccT[2][2][4][2];
struct EpiStoreBf16 {
    static constexpr bool PERM = true;
    bf16_t* O; int ldc;
    __device__ __forceinline__ void operator()(const AccT& acc, const pg8::Unit& u, int wr, int wc, int fr, int fq) const {
        const int row0 = u.pm * 256 + wr * 64 + fr, col0 = u.pn * 256 + wc * 32 + 8 * fq;
#pragma unroll
        for (int ai = 0; ai < 2; ++ai)
#pragma unroll
            for (int m = 0; m < 4; ++m) { bf16_t* rowp = O + (size_t)(row0 + ai * 128 + m * 16) * ldc + col0;
#pragma unroll
                for (int bj = 0; bj < 2; ++bj) { const f32x4 v0 = acc[ai][bj][m][0], v1 = acc[ai][bj][m][1];
                    u32x4 w; w.x = cvt_pk_bf16(v0[0], v0[1]); w.y = cvt_pk_bf16(v0[2], v0[3]); w.z = cvt_pk_bf16(v1[0], v1[1]); w.w = cvt_pk_bf16(v1[2], v1[3]);
                    *(u32x4*)(rowp + bj * 128) = w; } }
    }
};
struct EpiMerge1 {
    static constexpr bool PERM = true;
    float* t1; const bf16_t* P;
    __device__ __forceinline__ void operator()(const AccT& acc, const pg8::Unit& u, int wr, int wc, int fr, int fq) const {
        const int row0 = u.pm * 256 + wr * 64 + fr, col0 = u.pn * 256 + wc * 32 + 8 * fq;
#pragma unroll
        for (int ai = 0; ai < 2; ++ai)
#pragma unroll
            for (int m = 0; m < 4; ++m) { const int r = row0 + ai * 128 + m * 16;
#pragma unroll
                for (int bj = 0; bj < 2; ++bj) { const int c = col0 + bj * 128;
                    const u32x4 g = *(const u32x4*)(P + (size_t)r * PW + PGA + c);
                    const f32x4 v0 = acc[ai][bj][m][0], v1 = acc[ai][bj][m][1];
                    f32x4 o0, o1;
                    o0[0] = sigmoidf_(bflo(g.x)) * v0[0]; o0[1] = sigmoidf_(bfhi(g.x)) * v0[1]; o0[2] = sigmoidf_(bflo(g.y)) * v0[2]; o0[3] = sigmoidf_(bfhi(g.y)) * v0[3];
                    o1[0] = sigmoidf_(bflo(g.z)) * v1[0]; o1[1] = sigmoidf_(bfhi(g.z)) * v1[1]; o1[2] = sigmoidf_(bflo(g.w)) * v1[2]; o1[3] = sigmoidf_(bfhi(g.w)) * v1[3];
                    float* tp = t1 + (size_t)r * D + c; *(f32x4*)tp = o0; *(f32x4*)(tp + 4) = o1; } }
    }
};
struct EpiMerge2 {
    static constexpr bool PERM = true;
    const float* t1; const bf16_t* P; bf16_t* O;
    __device__ __forceinline__ void operator()(const AccT& acc, const pg8::Unit& u, int wr, int wc, int fr, int fq) const {
        const int row0 = u.pm * 256 + wr * 64 + fr, col0 = u.pn * 256 + wc * 32 + 8 * fq;
#pragma unroll
        for (int ai = 0; ai < 2; ++ai)
#pragma unroll
            for (int m = 0; m < 4; ++m) { const int r = row0 + ai * 128 + m * 16;
#pragma unroll
                for (int bj = 0; bj < 2; ++bj) { const int c = col0 + bj * 128;
                    const u32x4 g = *(const u32x4*)(P + (size_t)r * PW + PGB + c);
                    const float* tp = t1 + (size_t)r * D + c; const f32x4 a0 = *(const f32x4*)tp, a1 = *(const f32x4*)(tp + 4);
                    const f32x4 v0 = acc[ai][bj][m][0], v1 = acc[ai][bj][m][1];
                    f32x4 o0, o1;
                    o0[0] = a0[0] + sigmoidf_(bflo(g.x)) * v0[0]; o0[1] = a0[1] + sigmoidf_(bfhi(g.x)) * v0[1]; o0[2] = a0[2] + sigmoidf_(bflo(g.y)) * v0[2]; o0[3] = a0[3] + sigmoidf_(bfhi(g.y)) * v0[3];
                    o1[0] = a1[0] + sigmoidf_(bflo(g.z)) * v1[0]; o1[1] = a1[1] + sigmoidf_(bfhi(g.z)) * v1[1]; o1[2] = a1[2] + sigmoidf_(bflo(g.w)) * v1[2]; o1[3] = a1[3] + sigmoidf_(bfhi(g.w)) * v1[3];
                    u32x4 w; w.x = cvt_pk_bf16(o0[0], o0[1]); w.y = cvt_pk_bf16(o0[2], o0[3]); w.z = cvt_pk_bf16(o1[0], o1[1]); w.w = cvt_pk_bf16(o1[2], o1[3]);
                    *(u32x4*)(O + (size_t)r * D + c) = w; } }
    }
};
struct EpiResid {
    static constexpr bool PERM = false;
    float* x; const float* gate;
    __device__ __forceinline__ void operator()(const AccT& acc, const pg8::Unit& u, int wr, int wc, int fr, int fq) const {
        const int row0 = u.pm * 256 + wr * 64 + fr, col0 = u.pn * 256 + wc * 32 + 4 * fq;
        const int b = (u.pm < 64) ? (u.pm >> 4) : 4;
        const float* gp = gate + (size_t)b * 6144 + col0;
        f32x4 gv[2][2];
#pragma unroll
        for (int bj = 0; bj < 2; ++bj)
#pragma unroll
            for (int n = 0; n < 2; ++n) gv[bj][n] = *(const f32x4*)(gp + bj * 128 + n * 16);
#pragma unroll
        for (int ai = 0; ai < 2; ++ai)
#pragma unroll
            for (int m = 0; m < 4; ++m) { const int r = row0 + ai * 128 + m * 16; float* rowp = x + (size_t)r * D + col0;
#pragma unroll
                for (int bj = 0; bj < 2; ++bj)
#pragma unroll
                    for (int n = 0; n < 2; ++n) { float* p = rowp + bj * 128 + n * 16; *(f32x4*)p = *(const f32x4*)p + gv[bj][n] * acc[ai][bj][m][n]; } }
    }
};
struct EpiSwiglu {
    static constexpr bool PERM = true;
    bf16_t* O;
    __device__ __forceinline__ void operator()(const AccT& acc, const pg8::Unit& u, int wr, int wc, int fr, int fq) const {
        const int row0 = u.pm * 256 + wr * 64 + fr, col0 = u.pn * 128 + wc * 32 + 8 * fq;
#pragma unroll
        for (int ai = 0; ai < 2; ++ai)
#pragma unroll
            for (int m = 0; m < 4; ++m) { const int r = row0 + ai * 128 + m * 16;
                float o[8];
#pragma unroll
                for (int n = 0; n < 2; ++n)
#pragma unroll
                    for (int j = 0; j < 4; ++j) { const float a = acc[ai][0][m][n][j], g = acc[ai][1][m][n][j]; o[n * 4 + j] = a * sigmoidf_(a) * g; }
                u32x4 w; w.x = cvt_pk_bf16(o[0], o[1]); w.y = cvt_pk_bf16(o[2], o[3]); w.z = cvt_pk_bf16(o[4], o[5]); w.w = cvt_pk_bf16(o[6], o[7]);
                *(u32x4*)(O + (size_t)r * FF + col0) = w; }
    }
};

struct Args { const float* in[30]; float* out; unsigned char* ws; int l, e, ph, pad; };
enum { I_X = 0, I_C, I_CTX, I_CCTX, I_WMOD, I_BMOD, I_N1G, I_N2G, I_WIN, I_RPB, I_HCW, I_HCB, I_HW1, I_HB1, I_HW2, I_HB2, I_HW3, I_HFREQ, I_HBIAS,
       I_WPA, I_WPB, I_WO, I_FW1, I_FW3, I_FW2, I_ROUTER, I_MW1, I_MW3, I_MW2, I_FINALG };

constexpr int MISC_OFF = 131072 + 320;
constexpr int PTR_OFF = MISC_OFF + 128;
struct Ctx {
    LAS unsigned char* lds; int tid, lane, wave, G, bid; unsigned char* ws;
};
__device__ __forceinline__ Ctx mk_ctx(LAS unsigned char* lds, unsigned char* ws) {
    Ctx c; int t = threadIdx.x; asm volatile("" : "+v"(t)); asm volatile("" : "+s"(ws)); c.lds = lds; c.tid = t; c.lane = t & 63; c.wave = __builtin_amdgcn_readfirstlane(t >> 6); c.G = gridDim.x; c.bid = blockIdx.x; c.ws = ws; return c;
}
__device__ __forceinline__ const float* inp(const Ctx& c, int i) {
    unsigned ao = (unsigned)(PTR_OFF + 8 * i); asm volatile("" : "+v"(ao));
    const volatile LAS unsigned* p = (const volatile LAS unsigned*)(c.lds + ao);
    const unsigned lo = __builtin_amdgcn_readfirstlane(p[0]), hi = __builtin_amdgcn_readfirstlane(p[1]);
    return (const float*)(((unsigned long long)hi << 32) | (unsigned long long)lo);
}

__device__ __forceinline__ void transpose_item(const float* W, int N, bf16_t* WT, int ldk, int k0, int n0, int drow0, LAS float* scr, int lane) {
#pragma unroll 8
    for (int i = 0; i < 32; ++i) { const int kk = 2 * i + (lane >> 5); scr[kk * 33 + (lane & 31)] = W[(size_t)(k0 + kk) * N + n0 + (lane & 31)]; }
    LDS_WAIT(); asm volatile("" ::: "memory");
    const int c = lane & 7;
#pragma unroll
    for (int j = 0; j < 4; ++j) { const int n = (lane >> 3) + 8 * j; const LAS float* s = scr + (8 * c) * 33 + n;
        u32x4 o; o.x = cvt_pk_bf16(s[0 * 33], s[1 * 33]); o.y = cvt_pk_bf16(s[2 * 33], s[3 * 33]); o.z = cvt_pk_bf16(s[4 * 33], s[5 * 33]); o.w = cvt_pk_bf16(s[6 * 33], s[7 * 33]);
        *(u32x4*)(WT + (size_t)(drow0 + n) * ldk + k0 + 8 * c) = o; }
    LDS_WAIT(); asm volatile("" ::: "memory");
}
__device__ __forceinline__ void conv_mat(const float* W, int K, int N, bf16_t* WT, int mode, int& base, int gw, int NGW, LAS float* scr, int lane) {
    const int nblk = N / 32, nitems = (K / 64) * nblk;
    const int start = (gw - (base % NGW) + NGW) % NGW;
    for (int it = start; it < nitems; it += NGW) {
        const int kb = it / nblk, nb = it % nblk, n0 = nb * 32;
        const int drow0 = mode == 0 ? n0 : ((n0 >> 7) * 256 + (n0 & 127) + (mode == 2 ? 128 : 0));
        transpose_item(W, N, WT, K, kb * 64, n0, drow0, scr, lane);
    }
    base += nitems;
}
__device__ __forceinline__ void ph_convert(const Ctx& c0) {
    const Ctx c = mk_ctx(c0.lds, c0.ws);
    unsigned char* ws = c.ws;
    LAS float* scr = (LAS float*)(c.lds + c.wave * 16384);
    const int gw = c.bid * NWAVES + c.wave, NGW = c.G * NWAVES; int base = 0;
    for (int l = 0; l < DEPTH; ++l) {
        conv_mat(inp(c, I_WIN) + (size_t)l * D * PW, D, PW, (bf16_t*)(ws + WS_WIN) + (size_t)l * PW * D, 0, base, gw, NGW, scr, c.lane);
        conv_mat(inp(c, I_WPA) + (size_t)l * 512 * D, 512, D, (bf16_t*)(ws + WS_WPA) + (size_t)l * D * 512, 0, base, gw, NGW, scr, c.lane);
        conv_mat(inp(c, I_WPB) + (size_t)l * 512 * D, 512, D, (bf16_t*)(ws + WS_WPB) + (size_t)l * D * 512, 0, base, gw, NGW, scr, c.lane);
        conv_mat(inp(c, I_WO) + (size_t)l * D * D, D, D, (bf16_t*)(ws + WS_WO) + (size_t)l * D * D, 0, base, gw, NGW, scr, c.lane);
    }
    for (int i = 0; i < 2; ++i) {
        conv_mat(inp(c, I_FW1) + (size_t)i * D * FF, D, FF, (bf16_t*)(ws + WS_W13D) + (size_t)i * 2 * FF * D, 1, base, gw, NGW, scr, c.lane);
        conv_mat(inp(c, I_FW3) + (size_t)i * D * FF, D, FF, (bf16_t*)(ws + WS_W13D) + (size_t)i * 2 * FF * D, 2, base, gw, NGW, scr, c.lane);
        conv_mat(inp(c, I_FW2) + (size_t)i * FF * D, FF, D, (bf16_t*)(ws + WS_W2D) + (size_t)i * D * FF, 0, base, gw, NGW, scr, c.lane);
    }
    for (int ie = 0; ie < 2 * NE; ++ie) {
        conv_mat(inp(c, I_MW1) + (size_t)ie * D * FF, D, FF, (bf16_t*)(ws + WS_W13M) + (size_t)ie * 2 * FF * D, 1, base, gw, NGW, scr, c.lane);
        conv_mat(inp(c, I_MW3) + (size_t)ie * D * FF, D, FF, (bf16_t*)(ws + WS_W13M) + (size_t)ie * 2 * FF * D, 2, base, gw, NGW, scr, c.lane);
        conv_mat(inp(c, I_MW2) + (size_t)ie * FF * D, FF, D, (bf16_t*)(ws + WS_W2M) + (size_t)ie * D * FF, 0, base, gw, NGW, scr, c.lane);
    }
}

__device__ __forceinline__ void ph_mod(const Ctx& c0) {
    const Ctx c = mk_ctx(c0.lds, c0.ws);
    float* mod = (float*)(c.ws + WS_MOD);
    LAS float* s = (LAS float*)c.lds; LAS float* part = s + 5 * 1024;
    const float* cin = inp(c, I_C); const float* cctx = inp(c, I_CCTX); const float* wmod = inp(c, I_WMOD); const float* bmod = inp(c, I_BMOD);
    for (int i = c.tid; i < 5 * 1024; i += NTHR) { const int r = i >> 10, k = i & 1023; const float v = r < 4 ? cin[r * 1024 + k] : cctx[k]; s[i] = v * sigmoidf_(v); }
    __syncthreads();
    for (int unit = c.bid; unit < DEPTH * 96; unit += c.G) {
        const int l = unit / 96, j0 = (unit % 96) * 64;
        const float* w = wmod + (size_t)l * D * 6144 + j0 + c.lane;
        float acc[5] = {0.f, 0.f, 0.f, 0.f, 0.f};
        const int kb = c.wave * 128;
#pragma unroll 8
        for (int k = 0; k < 128; ++k) { const float wv = w[(size_t)(kb + k) * 6144];
#pragma unroll
            for (int r = 0; r < 5; ++r) acc[r] += s[r * 1024 + kb + k] * wv; }
#pragma unroll
        for (int r = 0; r < 5; ++r) part[(c.wave * 5 + r) * 64 + c.lane] = acc[r];
        __syncthreads();
        if (c.tid < 320) { const int r = c.tid >> 6, ln = c.tid & 63; float sum = 0.f;
#pragma unroll
            for (int w8 = 0; w8 < 8; ++w8) sum += part[(w8 * 5 + r) * 64 + ln];
            mod[(size_t)(l * 5 + r) * 6144 + j0 + ln] = sum + bmod[l * 6144 + j0 + ln]; }
        __syncthreads();
    }
}

__device__ __forceinline__ void ph_filt(const Ctx& c0) {
    const Ctx c = mk_ctx(c0.lds, c0.ws);
    const float* hb1 = inp(c, I_HB1); const float* hw1 = inp(c, I_HW1); const float* hb2 = inp(c, I_HB2); const float* hw2 = inp(c, I_HW2); const float* hfreq = inp(c, I_HFREQ); const float* hw3 = inp(c, I_HW3);
    LAS float* zb = (LAS float*)c.lds;
    LAS float* a1 = zb + 16 * 36;
    LAS float* a2 = a1 + 16 * 64;
    const float MINDEC = -3.0701134573253945f, MAXDEC = -15.350567286626973f;
    for (int unit = c.bid; unit < DEPTH * 272; unit += c.G) {
        const int l = unit / 272, uu = unit % 272;
        const int L = uu < 256 ? 4096 : 256, p0 = uu < 256 ? uu * 16 : (uu - 256) * 16;
        for (int i = c.tid; i < 16 * 33; i += NTHR) { const int p = i / 33, q = i % 33; const int pos = p0 + p; float v;
            if (q == 0) v = (float)pos / (float)(L - 1);
            else { const int j = (q - 1) & 15; const double band = 1e-4 + (double)j * ((15.0 - 1e-4) / 15.0); double rev = (double)pos * band / (double)L; rev -= floor(rev);
                v = q <= 16 ? __builtin_amdgcn_cosf((float)rev) : -__builtin_amdgcn_sinf((float)rev); }
            zb[p * 36 + q] = v; }
        __syncthreads();
        for (int i = c.tid; i < 16 * 64; i += NTHR) { const int p = i >> 6, j = i & 63; float s = hb1[l * 64 + j];
            const float* w = hw1 + (size_t)l * 33 * 64 + j;
            for (int q = 0; q < 33; ++q) s += zb[p * 36 + q] * w[q * 64];
            a1[p * 64 + j] = sin_rad(hfreq[l * 128 + j] * s); }
        __syncthreads();
        for (int i = c.tid; i < 16 * 64; i += NTHR) { const int p = i >> 6, j = i & 63; float s = hb2[l * 64 + j];
            const float* w = hw2 + (size_t)l * 64 * 64 + j;
            for (int q = 0; q < 64; ++q) s += a1[p * 64 + q] * w[q * 64];
            a2[p * 64 + j] = sin_rad(hfreq[l * 128 + 64 + j] * s); }
        __syncthreads();
        {
            float acc0[16], acc1[16];
#pragma unroll
            for (int p = 0; p < 16; ++p) { acc0[p] = 0.f; acc1[p] = 0.f; }
            const float* w3 = hw3 + (size_t)l * 64 * 1024 + c.tid;
            for (int k = 0; k < 64; ++k) { const float wa = w3[k * 1024], wb = w3[k * 1024 + 512];
#pragma unroll
                for (int p = 0; p < 16; ++p) { const float av = a2[p * 64 + k]; acc0[p] += av * wa; acc1[p] += av * wb; } }
            bf16_t* hro = uu < 256 ? (bf16_t*)(c.ws + WS_HRL) + ((size_t)(l * 2) * 512 + c.tid) * (4096 + 64) : (bf16_t*)(c.ws + WS_HRC) + ((size_t)(l * 2) * 512 + c.tid) * (256 + 64);
            const size_t ostride = (size_t)512 * (L + 64);
            float f0[16], f1[16];
            const float r0 = fabsf(MINDEC + (float)c.tid * ((MAXDEC - MINDEC) / 1023.f)), r1 = fabsf(MINDEC + (float)(c.tid + 512) * ((MAXDEC - MINDEC) / 1023.f));
#pragma unroll
            for (int p = 0; p < 16; ++p) { const int pos = p0 + p; const float dist = fabsf((float)(pos - L / 2)) * (2.f / (float)L);
                f0[p] = acc0[p] * (__expf(-dist * r0) + 0.05f); f1[p] = acc1[p] * (__expf(-dist * r1) + 0.05f); }
            {   u32x4 w0, w1, v0, v1;
                w0.x = cvt_pk_bf16(f0[15], f0[14]); w0.y = cvt_pk_bf16(f0[13], f0[12]); w0.z = cvt_pk_bf16(f0[11], f0[10]); w0.w = cvt_pk_bf16(f0[9], f0[8]);
                w1.x = cvt_pk_bf16(f0[7], f0[6]); w1.y = cvt_pk_bf16(f0[5], f0[4]); w1.z = cvt_pk_bf16(f0[3], f0[2]); w1.w = cvt_pk_bf16(f0[1], f0[0]);
                v0.x = cvt_pk_bf16(f1[15], f1[14]); v0.y = cvt_pk_bf16(f1[13], f1[12]); v0.z = cvt_pk_bf16(f1[11], f1[10]); v0.w = cvt_pk_bf16(f1[9], f1[8]);
                v1.x = cvt_pk_bf16(f1[7], f1[6]); v1.y = cvt_pk_bf16(f1[5], f1[4]); v1.z = cvt_pk_bf16(f1[3], f1[2]); v1.w = cvt_pk_bf16(f1[1], f1[0]);
                bf16_t* d0 = hro + (L + 16 - p0); bf16_t* d1 = d0 + ostride;
                *(u32x4*)d0 = w0; *(u32x4*)(d0 + 8) = w1; *(u32x4*)d1 = v0; *(u32x4*)(d1 + 8) = v1;
                const u32x4 z4 = (u32x4){0u, 0u, 0u, 0u};
                if (p0 == 0) { for (int k = 0; k < 4; ++k) { *(u32x4*)(hro + L + 32 + 8 * k) = z4; *(u32x4*)(hro + ostride + L + 32 + 8 * k) = z4; } }
                if (p0 == L - 16) { for (int k = 0; k < 4; ++k) { *(u32x4*)(hro + 8 * k) = z4; *(u32x4*)(hro + ostride + 8 * k) = z4; } } }
        }
        __syncthreads();
    }
}

struct MoeComb { const int* route; const float* rwt; const bf16_t* y; const float* gate; };
__device__ __forceinline__ void moe_combine_row(const MoeComb& mc, const LAS unsigned* offs, int row, int b, int lane, f32x4 (&v)[4]) {
    const int e1 = mc.route[(size_t)row * 4 + 0], p1 = mc.route[(size_t)row * 4 + 1], e2 = mc.route[(size_t)row * 4 + 2], p2 = mc.route[(size_t)row * 4 + 3];
    const float w1 = mc.rwt[(size_t)row * 2], w2 = mc.rwt[(size_t)row * 2 + 1];
    const size_t s1 = (size_t)offs[e1] + p1, s2 = (size_t)offs[e2] + p2;
    const float* gt = mc.gate + (size_t)b * 6144;
#pragma unroll
    for (int j = 0; j < 4; ++j) { const int k0 = 4 * (lane + 64 * j);
        const u32x2 a = *(const u32x2*)(mc.y + s1 * D + k0), bq = *(const u32x2*)(mc.y + s2 * D + k0); const f32x4 g4 = *(const f32x4*)(gt + k0);
        v[j][0] += g4[0] * (w1 * bflo(a.x) + w2 * bflo(bq.x)); v[j][1] += g4[1] * (w1 * bfhi(a.x) + w2 * bfhi(bq.x));
        v[j][2] += g4[2] * (w1 * bflo(a.y) + w2 * bflo(bq.y)); v[j][3] += g4[3] * (w1 * bfhi(a.y) + w2 * bfhi(bq.y)); }
}
__device__ __forceinline__ void moe_offsets(const Ctx& c, int i, LAS unsigned* offs) {
    if (c.tid == 0) { const unsigned* cnt = (const unsigned*)(c.ws + WS_CTL) + CW_CNT + 64 * i; unsigned o = 0;
        for (int e = 0; e < 8; ++e) { offs[e] = o; o += (cnt[e] + 255u) & ~255u; } offs[8] = o; }
}
__device__ __forceinline__ void ph_norm(const Ctx& c0, int l, int which) {
    const Ctx c = mk_ctx(c0.lds, c0.ws);
    float* xres = (float*)(c.ws + WS_X); bf16_t* h = (bf16_t*)(c.ws + WS_H);
    const float* mod = (const float*)(c.ws + WS_MOD) + (size_t)l * 5 * 6144;
    const float* gp = (which == 0 ? inp(c, I_N1G) : inp(c, I_N2G)) + l * D;
    const bool first = (l == 0 && which == 0), route = (which == 1 && (l & 1));
    const int comb = (which == 0 && l >= 1 && ((l - 1) & 1)) ? ((l - 1) >> 1) : -1;
    const float* router = inp(c, I_ROUTER) + (size_t)(l >> 1) * D * NE;
    int* routeb = (int*)(c.ws + WS_ROUTE); float* rwt = (float*)(c.ws + WS_RWT); int* tokenof = (int*)(c.ws + WS_TOK);
    const MoeComb mc{routeb, rwt, (const bf16_t*)(c.ws + WS_Y), (const float*)(c.ws + WS_MOD) + (size_t)(l > 0 ? l - 1 : 0) * 5 * 6144 + 5 * 1024};
    LAS unsigned* lcnt = (LAS unsigned*)c.lds; LAS unsigned* gbase = lcnt + 16; LAS unsigned* offs = lcnt + 32; LAS int* pend = (LAS int*)(c.lds + 256);
    if (c.tid < 8) lcnt[c.tid] = 0u;
    if (comb >= 0) moe_offsets(c, comb, offs);
    __syncthreads();
    const float* xin = inp(c, I_X); const float* ctxin = inp(c, I_CTX);
    int nrows = 0;
    for (int row = c.bid * NWAVES + c.wave; row < T; row += c.G * NWAVES, ++nrows) {
        const float* src = first ? (row < TL ? xin + (size_t)row * D : ctxin + (size_t)(row - TL) * D) : xres + (size_t)row * D;
        const int b = row < TL ? (row >> 12) : 4;
        const float* sh = mod + (size_t)b * 6144 + (which == 0 ? 0 : 3) * 1024; const float* sc = sh + 1024;
        f32x4 v[4]; float ss = 0.f;
#pragma unroll
        for (int j = 0; j < 4; ++j) v[j] = *(const f32x4*)(src + 4 * (c.lane + 64 * j));
        if (comb >= 0) moe_combine_row(mc, offs, row, b, c.lane, v);
#pragma unroll
        for (int j = 0; j < 4; ++j) ss += (v[j][0] * v[j][0] + v[j][1] * v[j][1]) + (v[j][2] * v[j][2] + v[j][3] * v[j][3]);
        ss = wave_sum(ss, c.lane);
        const float rstd = 1.f / sqrtf(ss * (1.f / D) + EPS);
        if (first || comb >= 0) {
#pragma unroll
            for (int j = 0; j < 4; ++j) *(f32x4*)(xres + (size_t)row * D + 4 * (c.lane + 64 * j)) = v[j];
        }
        float lg[8] = {0.f, 0.f, 0.f, 0.f, 0.f, 0.f, 0.f, 0.f};
#pragma unroll
        for (int j = 0; j < 4; ++j) { const int k0 = 4 * (c.lane + 64 * j);
            const f32x4 g4 = *(const f32x4*)(gp + k0), s4 = *(const f32x4*)(sc + k0), h4 = *(const f32x4*)(sh + k0);
            f32x4 o;
#pragma unroll
            for (int q = 0; q < 4; ++q) o[q] = v[j][q] * rstd * g4[q] * (1.f + s4[q]) + h4[q];
            u32x2 w; w.x = cvt_pk_bf16(o[0], o[1]); w.y = cvt_pk_bf16(o[2], o[3]);
            *(u32x2*)(h + (size_t)row * D + k0) = w;
            if (route) {
#pragma unroll
                for (int q = 0; q < 4; ++q) { const f32x4 ra = *(const f32x4*)(router + (size_t)(k0 + q) * 8), rb = *(const f32x4*)(router + (size_t)(k0 + q) * 8 + 4);
                    lg[0] += o[q] * ra[0]; lg[1] += o[q] * ra[1]; lg[2] += o[q] * ra[2]; lg[3] += o[q] * ra[3];
                    lg[4] += o[q] * rb[0]; lg[5] += o[q] * rb[1]; lg[6] += o[q] * rb[2]; lg[7] += o[q] * rb[3]; }
            }
        }
        if (route) {
#pragma unroll
            for (int e = 0; e < 8; ++e) lg[e] = wave_sum(lg[e], c.lane);
            int i1 = 0; float v1 = lg[0];
#pragma unroll
            for (int e = 1; e < 8; ++e) if (lg[e] > v1) { v1 = lg[e]; i1 = e; }
            int i2 = -1; float v2 = -3.0e38f;
#pragma unroll
            for (int e = 0; e < 8; ++e) if (e != i1 && lg[e] > v2) { v2 = lg[e]; i2 = e; }
            const float w1 = 1.f / (1.f + __expf(v2 - v1)), w2 = 1.f - w1;
            if (c.lane == 0) {
                const unsigned lp1 = __hip_atomic_fetch_add(lcnt + i1, 1u, __ATOMIC_RELAXED, __HIP_MEMORY_SCOPE_WORKGROUP), lp2 = __hip_atomic_fetch_add(lcnt + i2, 1u, __ATOMIC_RELAXED, __HIP_MEMORY_SCOPE_WORKGROUP);
                LAS int* pe = pend + (c.wave * 16 + nrows) * 4; pe[0] = row; pe[1] = i1 | (i2 << 8); pe[2] = (int)lp1; pe[3] = (int)lp2;
                rwt[(size_t)row * 2] = w1; rwt[(size_t)row * 2 + 1] = w2; }
        }
    }
    if (route) {
        __syncthreads();
        if (c.tid < 8) gbase[c.tid] = __hip_atomic_fetch_add((unsigned*)(c.ws + WS_CTL) + CW_CNT + 64 * (l >> 1) + c.tid, lcnt[c.tid], __ATOMIC_RELAXED, __HIP_MEMORY_SCOPE_AGENT);
        __syncthreads();
        if (c.lane < nrows) { const LAS int* pe = pend + (c.wave * 16 + c.lane) * 4; const int row = pe[0], e1 = pe[1] & 255, e2 = pe[1] >> 8;
            const int p1 = (int)gbase[e1] + pe[2], p2 = (int)gbase[e2] + pe[3];
            tokenof[(size_t)e1 * T + p1] = row; tokenof[(size_t)e2 * T + p2] = row;
            routeb[(size_t)row * 4 + 0] = e1; routeb[(size_t)row * 4 + 1] = p1; routeb[(size_t)row * 4 + 2] = e2; routeb[(size_t)row * 4 + 3] = p2; }
    }
    __syncthreads();
}

__device__ __forceinline__ void ph_sc(const Ctx& c0, int l) {
    const Ctx c = mk_ctx(c0.lds, c0.ws);
    const bf16_t* P = (const bf16_t*)(c.ws + WS_P); bf16_t* uT = (bf16_t*)(c.ws + WS_B); bf16_t* VT = (bf16_t*)(c.ws + WS_VT);
    const float* cw = inp(c, I_HCW) + (size_t)l * 3 * 1536; const float* cb = inp(c, I_HCB) + (size_t)l * 1536;
    LAS unsigned char* scr = c.lds + c.wave * 16384;
    for (int tile = c.bid * NWAVES + c.wave; tile < (T / 64) * 32; tile += c.G * NWAVES) {
        const int rt = tile / 32, row0 = rt * 64, ct = tile % 32; const bool isv = ct >= 24;
        const int ch0 = isv ? (ct - 24) * 64 : ct * 64, scol = isv ? PV + ch0 : PHY + ch0; bf16_t* dst = isv ? VT : uT;
        const int tpos = row0 < TL ? (row0 & 4095) : ((row0 - TL) & 255), Ls = row0 < TL ? 4096 : 256;
        for (int idx = c.lane; idx < 66 * 8; idx += 64) { const int rr = idx >> 3, ck = idx & 7; const int grow = row0 - 1 + rr;
            const bool ok = !((rr == 0 && tpos == 0) || (rr == 65 && tpos + 64 == Ls));
            u32x4 v = (u32x4){0u, 0u, 0u, 0u};
            if (ok) v = *(const u32x4*)(P + (size_t)grow * PW + scol + ck * 8);
            LAS unsigned* d = (LAS unsigned*)(scr + rr * 132 + ck * 16); d[0] = v.x; d[1] = v.y; d[2] = v.z; d[3] = v.w; }
        LDS_WAIT(); asm volatile("" ::: "memory");
        const int ch = ch0 + c.lane; const float w0 = isv ? 0.f : cw[ch], w1 = isv ? 1.f : cw[1536 + ch], w2 = isv ? 0.f : cw[3072 + ch], bb = isv ? 0.f : cb[ch];
        unsigned ow[32];
        { float prev = bf2f(*(const LAS unsigned short*)(scr + 0 * 132 + c.lane * 2)), cur = bf2f(*(const LAS unsigned short*)(scr + 1 * 132 + c.lane * 2)); float o0 = 0.f;
#pragma unroll
          for (int r = 0; r < 64; ++r) { const float nxt = bf2f(*(const LAS unsigned short*)(scr + (r + 2) * 132 + c.lane * 2));
              const float o = w0 * prev + w1 * cur + w2 * nxt + bb; prev = cur; cur = nxt;
              if (r & 1) ow[r >> 1] = cvt_pk_bf16(o0, o); else o0 = o; } }
        LDS_WAIT(); asm volatile("" ::: "memory");
#pragma unroll
        for (int k = 0; k < 8; ++k) { u32x4 v; v.x = ow[4 * k]; v.y = ow[4 * k + 1]; v.z = ow[4 * k + 2]; v.w = ow[4 * k + 3]; *(LAS u32x4*)(scr + c.lane * 144 + k * 16) = v; }
        LDS_WAIT(); asm volatile("" ::: "memory");
#pragma unroll
        for (int k = 0; k < 8; ++k) { const int cc = (c.lane >> 3) + 8 * k, ck = c.lane & 7; const u32x4 v = *(const LAS u32x4*)(scr + cc * 144 + ck * 16);
            *(u32x4*)(dst + (size_t)(ch0 + cc) * T + row0 + ck * 8) = v; }
        LDS_WAIT(); asm volatile("" ::: "memory");
    }
}

constexpr int HY_HR_OFF = 0, HY_U_OFF = 66560, HY_ZB_OFF = HY_U_OFF + 4 * 8208;
template <int L>
__device__ __forceinline__ void hy_unit(const Ctx& c, int l, int ch, const float* hbias) {
    constexpr int H = L / 2, NG = L / 256, LP = L + 64, NW = L / 8 + 8, ROWB = 2 * L + 16;
    LAS unsigned char* lds = c.lds;
    const bf16_t* uT = (const bf16_t*)(c.ws + WS_B); bf16_t* ohy = (bf16_t*)(c.ws + WS_OHY);
    const int seq0 = (L == 4096) ? 0 : TL;
    const bf16_t* hrbase = (L == 4096) ? (const bf16_t*)(c.ws + WS_HRL) : (const bf16_t*)(c.ws + WS_HRC);
    int gA, gB;
    if (NG == 16) { gA = c.wave < 4 ? c.wave : 4 + c.wave; gB = c.wave < 4 ? 7 - c.wave : 19 - c.wave; } else { gA = c.wave == 0 ? 0 : -1; gB = -1; }
    const int n = c.lane & 31, g = c.lane >> 5, tbl = n >> 2, b = n & 3;
    const int loA = gA < 0 ? 1 << 30 : max(-H - 16, 256 * gA - (L - 16)), hiA = gA < 0 ? -(1 << 30) : min(H, 256 * gA + 224);
    const int loB = gB < 0 ? 1 << 30 : max(-H - 16, 256 * gB - (L - 16)), hiB = gB < 0 ? -(1 << 30) : min(H, 256 * gB + 224);
    const int dlo = min(loA, loB), dhi = max(hiA, hiB);
    unsigned zreg[2][4][2];
    for (int o = 0; o < 2; ++o) {
        const bf16_t* hr = hrbase + ((size_t)(l * 2 + o) * 512 + ch) * LP;
        for (int w = c.tid; w < NW; w += NTHR) {
            u32x4 A4 = (u32x4){0u, 0u, 0u, 0u}; if (w > 0) A4 = *(const u32x4*)(hr + 8 * (w - 1));
            const u32x4 B4 = *(const u32x4*)(hr + 8 * w);
            const unsigned Dd[8] = {A4.x, A4.y, A4.z, A4.w, B4.x, B4.y, B4.z, B4.w};
#pragma unroll
            for (int q = 0; q < 8; ++q) { u32x4 ov;
                if ((q & 1) == 0) { const int j = (8 - q) / 2; ov.x = Dd[j]; ov.y = Dd[j + 1]; ov.z = Dd[j + 2]; ov.w = Dd[j + 3]; }
                else { const int j = (7 - q) / 2; ov.x = __builtin_amdgcn_alignbit(Dd[j + 1], Dd[j], 16); ov.y = __builtin_amdgcn_alignbit(Dd[j + 2], Dd[j + 1], 16);
                       ov.z = __builtin_amdgcn_alignbit(Dd[j + 3], Dd[j + 2], 16); ov.w = __builtin_amdgcn_alignbit(Dd[j + 4], Dd[j + 3], 16); }
                *(LAS u32x4*)(lds + HY_HR_OFF + (8 * w + q) * 16) = ov; }
        }
        if (o == 0) {
            for (int idx = c.tid; idx < 4 * (L / 8); idx += NTHR) { const int bb = idx / (L / 8), wq = idx % (L / 8);
                *(LAS u32x4*)(lds + HY_U_OFF + bb * ROWB + wq * 16) = *(const u32x4*)(uT + (size_t)ch * T + seq0 + bb * L + wq * 8); }
            if (c.tid < 16) *(LAS unsigned*)(lds + HY_ZB_OFF + c.tid * 4) = 0u;
        } else {
#pragma unroll
            for (int gi = 0; gi < 2; ++gi) { const int G = gi == 0 ? gA : gB; if (G >= 0) {
#pragma unroll
                for (int rq = 0; rq < 4; ++rq) { const int t = 32 * (8 * G + tbl) + 8 * rq + 4 * g;
                    u32x2 zz; zz.x = zreg[gi][rq][0]; zz.y = zreg[gi][rq][1]; *(LAS u32x2*)(lds + HY_U_OFF + b * ROWB + 2 * t) = zz; } } }
        }
        __syncthreads();
        f32x16 accA, accB;
#pragma unroll
        for (int r = 0; r < 16; ++r) { accA[r] = 0.f; accB[r] = 0.f; }
        if (dlo <= dhi) {
            const int e0 = H + 31 - dlo - n + 8 * g, q = (n + 1) & 7, w = (e0 + q) >> 3;
            int aaddr = HY_HR_OFF + (8 * w + q) * 16;
            int s0A = 32 * (8 * gA + tbl) - dlo, s0B = 32 * (8 * gB + tbl) - dlo;
            const int ubase = HY_U_OFF + b * ROWB + 16 * g;
            for (int d = dlo; d <= dhi; d += 16) {
                const bf16x8 af = *(const LAS bf16x8*)(lds + aaddr);
                if (d >= loA && d <= hiA) { const bool ok = (unsigned)s0A <= (unsigned)(L - 16); const int ba = ok ? ubase + 2 * s0A : HY_ZB_OFF;
                    const bf16x8 bf = *(const LAS bf16x8*)(lds + ba); accA = __builtin_amdgcn_mfma_f32_32x32x16_bf16(af, bf, accA, 0, 0, 0); }
                if (d >= loB && d <= hiB) { const bool ok = (unsigned)s0B <= (unsigned)(L - 16); const int ba = ok ? ubase + 2 * s0B : HY_ZB_OFF;
                    const bf16x8 bf = *(const LAS bf16x8*)(lds + ba); accB = __builtin_amdgcn_mfma_f32_32x32x16_bf16(af, bf, accB, 0, 0, 0); }
                aaddr -= 256; s0A -= 16; s0B -= 16;
            }
        }
        const float bias = hbias[(l * 2 + o) * 512 + ch];
#pragma unroll
        for (int gi = 0; gi < 2; ++gi) { const int G = gi == 0 ? gA : gB; if (G >= 0) {
#pragma unroll
            for (int rq = 0; rq < 4; ++rq) { const int t = 32 * (8 * G + tbl) + 8 * rq + 4 * g;
                const u32x2 uv = *(const LAS u32x2*)(lds + HY_U_OFF + b * ROWB + 2 * t);
                const size_t grow = (size_t)seq0 + b * L + t;
                const u32x2 xv = *(const u32x2*)(uT + (size_t)((o == 0 ? 512 : 1024) + ch) * T + grow);
                float y[4];
#pragma unroll
                for (int k = 0; k < 4; ++k) y[k] = gi == 0 ? accA[4 * rq + k] : accB[4 * rq + k];
                const float r0 = bflo(xv.x) * (y[0] + bias * bflo(uv.x)), r1 = bfhi(xv.x) * (y[1] + bias * bfhi(uv.x));
                const float r2 = bflo(xv.y) * (y[2] + bias * bflo(uv.y)), r3 = bfhi(xv.y) * (y[3] + bias * bfhi(uv.y));
                const unsigned p0 = cvt_pk_bf16(r0, r1), p1 = cvt_pk_bf16(r2, r3);
                if (o == 0) { zreg[gi][rq][0] = p0; zreg[gi][rq][1] = p1; }
                else { bf16_t* op = ohy + grow * 512 + ch; op[0] = (bf16_t)(p0 & 0xffffu); op[512] = (bf16_t)(p0 >> 16); op[1024] = (bf16_t)(p1 & 0xffffu); op[1536] = (bf16_t)(p1 >> 16); } } } }
        __syncthreads();
    }
}
__device__ __forceinline__ void ph_hyena(const Ctx& c0, int l) {
    const Ctx c = mk_ctx(c0.lds, c0.ws);
    const float* hbias = inp(c, I_HBIAS);
    for (int unit = c.bid; unit < HYW; unit += c.G) { hy_unit<4096>(c, l, unit, hbias); hy_unit<256>(c, l, unit, hbias); }
}

constexpr int ATT_RPB_OFF = 1024, ATT_VT_OFF = ATT_RPB_OFF + 8 * 15 * 32 * 4, ATT_VT_BYTES = 64 * 72;
template <int MODE>
__device__ __forceinline__ void att_block(const bf16_t* P, const bf16_t* VT, LAS unsigned char* lds, LAS unsigned char* vt, int lane, int n, int h, int head,
                                          int tokk, int ctok, int tabaddr, int vb, const bf16x8 (&qf)[4], f32x16& ot0, f32x16& ot1, float& m, float& lsum) {
    bf16x8 kf[4];
#pragma unroll
    for (int ks = 0; ks < 4; ++ks) kf[ks] = *(const bf16x8*)(P + (size_t)tokk * PW + PK + head * 64 + 16 * ks + 8 * h);
    u32x2 vr[8];
#pragma unroll
    for (int it = 0; it < 8; ++it) vr[it] = *(const u32x2*)(VT + (size_t)(head * 64 + it * 8 + (lane >> 3)) * T + ctok);
    f32x16 st;
#pragma unroll
    for (int r = 0; r < 16; ++r) st[r] = 0.f;
#pragma unroll
    for (int ks = 0; ks < 4; ++ks) st = __builtin_amdgcn_mfma_f32_32x32x16_bf16(kf[ks], qf[ks], st, 0, 0, 0);
    const float SC = 0.18033688011112042f;
    float sv[16];
#pragma unroll
    for (int r = 0; r < 16; ++r) {
        if (MODE == 2) sv[r] = st[r] * SC;
        else { const int cr = MODE == 0 ? 8 * (r >> 2) + (r & 3) : (r & 3), imm = MODE == 0 ? cr * 4 : ((r >> 2) * 32 + (r & 3)) * 4;
            const float bias = *(const LAS float*)(lds + tabaddr + imm);
            const bool ok = (unsigned)(vb + cr) < 16u;
            sv[r] = ok ? st[r] * SC + bias : -1.0e30f; }
    }
    float bm = sv[0];
#pragma unroll
    for (int r = 1; r < 16; ++r) bm = fmaxf(bm, sv[r]);
    bm = fmaxf(bm, __int_as_float(__builtin_amdgcn_ds_bpermute((lane ^ 32) << 2, __float_as_int(bm))));
    const float mn = fmaxf(m, bm), alpha = __builtin_amdgcn_exp2f(m - mn); m = mn;
    float psum = 0.f;
#pragma unroll
    for (int r = 0; r < 16; ++r) { const float pv = __builtin_amdgcn_exp2f(sv[r] - mn); psum += pv; sv[r] = pv; }
    lsum = lsum * alpha + psum;
#pragma unroll
    for (int r = 0; r < 16; ++r) { ot0[r] *= alpha; ot1[r] *= alpha; }
    bf16x8 pb[2];
#pragma unroll
    for (int s2 = 0; s2 < 2; ++s2) { u32x4 w; w.x = cvt_pk_bf16(sv[8 * s2], sv[8 * s2 + 1]); w.y = cvt_pk_bf16(sv[8 * s2 + 2], sv[8 * s2 + 3]);
        w.z = cvt_pk_bf16(sv[8 * s2 + 4], sv[8 * s2 + 5]); w.w = cvt_pk_bf16(sv[8 * s2 + 6], sv[8 * s2 + 7]); pb[s2] = __builtin_bit_cast(bf16x8, w); }
#pragma unroll
    for (int it = 0; it < 8; ++it) *(LAS u32x2*)(vt + (it * 8 + (lane >> 3)) * 72 + (lane & 7) * 8) = vr[it];
#pragma unroll
    for (int s2 = 0; s2 < 2; ++s2) {
        { const u32x2 a = *(const LAS u32x2*)(vt + n * 72 + (4 * s2 + h) * 8), bq = *(const LAS u32x2*)(vt + n * 72 + (4 * s2 + 2 + h) * 8);
          u32x4 w; w.x = a.x; w.y = a.y; w.z = bq.x; w.w = bq.y; ot0 = __builtin_amdgcn_mfma_f32_32x32x16_bf16(__builtin_bit_cast(bf16x8, w), pb[s2], ot0, 0, 0, 0); }
        { const u32x2 a = *(const LAS u32x2*)(vt + (32 + n) * 72 + (4 * s2 + h) * 8), bq = *(const LAS u32x2*)(vt + (32 + n) * 72 + (4 * s2 + 2 + h) * 8);
          u32x4 w; w.x = a.x; w.y = a.y; w.z = bq.x; w.w = bq.y; ot1 = __builtin_amdgcn_mfma_f32_32x32x16_bf16(__builtin_bit_cast(bf16x8, w), pb[s2], ot1, 0, 0, 0); }
    }
}
constexpr int ATT_UNITS = 4096 + 256;
__device__ __forceinline__ void ph_attn(const Ctx& c0, int l) {
    const Ctx c = mk_ctx(c0.lds, c0.ws);
    const bf16_t* P = (const bf16_t*)(c.ws + WS_P); const bf16_t* VT = (const bf16_t*)(c.ws + WS_VT); bf16_t* oatt = (bf16_t*)(c.ws + WS_OATT);
    const float* rpb = inp(c, I_RPB) + (size_t)l * 8 * 15 * 31;
    LAS unsigned char* lds = c.lds;
    for (int i = c.tid; i < 8 * 15 * 32; i += NTHR) { const int hd = i / 480, rem = i % 480, dr = rem >> 5, dc = rem & 31;
        *(LAS float*)(lds + ATT_RPB_OFF + i * 4) = dc < 31 ? rpb[(hd * 15 + dr) * 31 + dc] * 1.4426950408889634f : 0.f; }
    __syncthreads();
    LAS unsigned char* vt = lds + ATT_VT_OFF + c.wave * ATT_VT_BYTES;
    const int lane = c.lane, n = lane & 31, h = lane >> 5;
    for (int u = c.bid * NWAVES + c.wave; u < ATT_UNITS; u += c.G * NWAVES) {
        const bool lat = u < 4096;
        int b, head, r = 0, hf = 0, tokq;
        if (lat) { hf = u & 1; r = (u >> 1) & 63; head = (u >> 7) & 7; b = u >> 10; tokq = b * 4096 + r * 64 + 32 * hf + n; }
        else { const int uu = u - 4096; head = (uu >> 3) & 7; b = uu >> 6; tokq = TL + b * 256 + 32 * (uu & 7) + n; }
        bf16x8 qf[4];
#pragma unroll
        for (int ks = 0; ks < 4; ++ks) qf[ks] = *(const bf16x8*)(P + (size_t)tokq * PW + PQ + head * 64 + 16 * ks + 8 * h);
        f32x16 ot0, ot1;
#pragma unroll
        for (int q = 0; q < 16; ++q) { ot0[q] = 0.f; ot1[q] = 0.f; }
        float m = -1.0e30f, lsum = 0.f;
        if (lat) {
            const int r0 = min(max(r - 4, 0), 56), lo = hf ? 24 : 0, qc = 32 * hf + n, c0q = min(max(qc - 8, 0), 48);
            for (int kb = 0; kb < 8; ++kb) {
                const int base = b * 4096 + (r0 + kb) * 64 + lo, kx = lo + 4 * h;
                const int tabaddr = ATT_RPB_OFF + (((head * 15 + (r0 + kb - r + 7)) * 32) + kx - qc + 15) * 4;
                att_block<0>(P, VT, lds, vt, lane, n, h, head, base + n, base + 4 * (lane & 7), tabaddr, kx - c0q, qf, ot0, ot1, m, lsum);
            }
            for (int kb = 0; kb < 2; ++kb) {
                const int rowb = b * 4096 + (r0 + 4 * kb) * 64 + lo + 32, kx = lo + 32 + 4 * h, cc = lane & 7;
                const int tabaddr = ATT_RPB_OFF + (((head * 15 + (r0 + 4 * kb - r + 7)) * 32) + kx - qc + 15) * 4;
                att_block<1>(P, VT, lds, vt, lane, n, h, head, rowb + (n >> 3) * 64 + (n & 7), rowb + (cc >> 1) * 64 + 4 * (cc & 1), tabaddr, kx - c0q, qf, ot0, ot1, m, lsum);
            }
        }
        for (int kb = 0; kb < 8; ++kb) { const int base = TL + b * 256 + 32 * kb;
            att_block<2>(P, VT, lds, vt, lane, n, h, head, base + n, base + 4 * (lane & 7), 0, 0, qf, ot0, ot1, m, lsum); }
        const float ltot = lsum + __int_as_float(__builtin_amdgcn_ds_bpermute((lane ^ 32) << 2, __float_as_int(lsum)));
        const float inv = 1.f / ltot;
        bf16_t* op = oatt + (size_t)tokq * 512 + head * 64 + 4 * h;
#pragma unroll
        for (int rq = 0; rq < 4; ++rq) {
            u32x2 w0, w1; w0.x = cvt_pk_bf16(ot0[4 * rq] * inv, ot0[4 * rq + 1] * inv); w0.y = cvt_pk_bf16(ot0[4 * rq + 2] * inv, ot0[4 * rq + 3] * inv);
            w1.x = cvt_pk_bf16(ot1[4 * rq] * inv, ot1[4 * rq + 1] * inv); w1.y = cvt_pk_bf16(ot1[4 * rq + 2] * inv, ot1[4 * rq + 3] * inv);
            *(u32x2*)(op + 8 * rq) = w0; *(u32x2*)(op + 32 + 8 * rq) = w1; }
    }
    __syncthreads();
}

__device__ __forceinline__ void ph_final(const Ctx& c0) {
    const Ctx c = mk_ctx(c0.lds, c0.ws);
    const float* xres = (const float*)(c.ws + WS_X); const float* gp = inp(c, I_FINALG); float* outp = (float*)inp(c, 30);
    const MoeComb mc{(const int*)(c.ws + WS_ROUTE), (const float*)(c.ws + WS_RWT), (const bf16_t*)(c.ws + WS_Y), (const float*)(c.ws + WS_MOD) + (size_t)(DEPTH - 1) * 5 * 6144 + 5 * 1024};
    LAS unsigned* offs = (LAS unsigned*)c.lds + 32;
    moe_offsets(c, 1, offs);
    __syncthreads();
    for (int row = c.bid * NWAVES + c.wave; row < TL; row += c.G * NWAVES) {
        const float* src = xres + (size_t)row * D; f32x4 v[4]; float ss = 0.f;
#pragma unroll
        for (int j = 0; j < 4; ++j) v[j] = *(const f32x4*)(src + 4 * (c.lane + 64 * j));
        moe_combine_row(mc, offs, row, row >> 12, c.lane, v);
#pragma unroll
        for (int j = 0; j < 4; ++j) ss += (v[j][0] * v[j][0] + v[j][1] * v[j][1]) + (v[j][2] * v[j][2] + v[j][3] * v[j][3]);
        ss = wave_sum(ss, c.lane);
        const float rstd = 1.f / sqrtf(ss * (1.f / D) + EPS);
#pragma unroll
        for (int j = 0; j < 4; ++j) { const int k0 = 4 * (c.lane + 64 * j); const f32x4 g4 = *(const f32x4*)(gp + k0); *(f32x4*)(outp + (size_t)row * D + k0) = v[j] * rstd * g4; }
    }
}

constexpr int MOE_OFF = 132096;
template <bool GATHER_> struct MoeOrder {
    static constexpr bool GATHER = GATHER_;
    int nM, nN, nwg, G, c; const char* A; const char* B; size_t astep, bstep, estep; const int* tokenof; const LAS unsigned* tab;
    __device__ void init(const void* A_, int lda, const void* B_, int ldb, size_t estep_bytes, int N, int G_, int c_, const int* tok, const LAS unsigned* tab_) {
        tab = tab_; nM = (int)((unsigned)__builtin_amdgcn_readfirstlane(tab[8]) >> 8); nN = N / pg8::BM; nwg = nM * nN; G = G_; c = c_; A = (const char*)A_; B = (const char*)B_;
        astep = (size_t)pg8::BM * lda * 2; bstep = (size_t)pg8::BM * ldb * 2; estep = estep_bytes; tokenof = tok; }
    __device__ bool next(int i, pg8::Unit& u) const {
        const long L = (long)i * G + c; if (L >= nwg) return false;
        int wgid = (int)L; { const int q = nwg / pg8::NXCD, r = nwg % pg8::NXCD, xcd = wgid % pg8::NXCD, off = wgid / pg8::NXCD; wgid = (xcd < r ? xcd * (q + 1) : r * (q + 1) + (xcd - r) * q) + off; }
        const int nig = pg8::WGM * nN, gid = wgid / nig, fm = gid * pg8::WGM, gsz = (nM - fm) < pg8::WGM ? (nM - fm) : pg8::WGM;
        u.pm = fm + ((wgid % nig) % gsz); u.pn = (wgid % nig) / gsz;
        const unsigned slot0 = (unsigned)u.pm << 8; int e = 0;
#pragma unroll
        for (int j = 1; j < 8; ++j) e += (slot0 >= (unsigned)__builtin_amdgcn_readfirstlane(tab[j])) ? 1 : 0;
        const unsigned pos0 = slot0 - (unsigned)__builtin_amdgcn_readfirstlane(tab[e]), cnt = (unsigned)__builtin_amdgcn_readfirstlane(tab[16 + e]);
        u.nvalid = cnt > pos0 ? (int)(cnt - pos0) : 0; u.tk = tokenof + (size_t)e * T + pos0;
        u.a = GATHER ? A : A + (size_t)u.pm * astep; u.b = B + (size_t)e * estep + (size_t)u.pn * bstep; return true;
    }
    __device__ __forceinline__ int arow(const pg8::Unit& u, int r) const { return r < u.nvalid ? u.tk[r] : 0; }
    __device__ __forceinline__ void a_ready(const pg8::Unit&) const {}
    __device__ __forceinline__ void done(const pg8::Unit&) const {}
};
__device__ __forceinline__ void moe_table(const Ctx& c, int i) {
    LAS unsigned* tab = (LAS unsigned*)(c.lds + MOE_OFF);
    if (c.tid == 0) { const unsigned* cnt = (const unsigned*)(c.ws + WS_CTL) + CW_CNT + 64 * i; unsigned o = 0;
        for (int e = 0; e < 8; ++e) { const unsigned ce = cnt[e]; tab[e] = o; tab[16 + e] = ce; o += (ce + 255u) & ~255u; } tab[8] = o; }
    __syncthreads();
}

#define XB_TMO      128
#define XB_XCNT(j)  (256  + 64 * (j))
#define XB_XSUB(j)  (1280 + 64 * (j))
#define XB_XGEN(j)  (2304 + 64 * (j))
#define XB_TOP      3328
#define XB_TOPGEN   3392
#define XCD_BAR_WORDS 3456
#define XB_SPIN_CAP (1u << 18)
__device__ __forceinline__ unsigned xb_ld(unsigned* p)              { return __hip_atomic_load(p, __ATOMIC_RELAXED, __HIP_MEMORY_SCOPE_AGENT); }
__device__ __forceinline__ unsigned xb_add(unsigned* p, unsigned v) { return __hip_atomic_fetch_add(p, v, __ATOMIC_RELAXED, __HIP_MEMORY_SCOPE_AGENT); }
__device__ __forceinline__ unsigned xb_xcc_id() { return (unsigned)__builtin_amdgcn_s_getreg((3 << 11) | 20) & 0xFu; }
#define XB_SPIN(cond, bar) do { unsigned _sp = 0; while (cond) { __builtin_amdgcn_s_sleep(1); \
    if ((++_sp & 255u) == 0u) { if (xb_ld(&(bar)[XB_TMO])) break; if (_sp > XB_SPIN_CAP) { atomicAdd(&(bar)[XB_TMO], 1u); break; } } } } while (0)
struct XcdBarrier { unsigned* bar; unsigned x; volatile LAS unsigned* st; };
__device__ __forceinline__ XcdBarrier xcd_barrier_post(unsigned* bar, volatile LAS unsigned* st) {
    XcdBarrier b; b.bar = bar; b.x = xb_xcc_id(); b.st = st;
    if (threadIdx.x == 0) (void)xb_add(&bar[XB_XCNT(b.x)], 1u);
    return b;
}
__device__ __forceinline__ void xcd_barrier_complete(unsigned* bar, unsigned x, unsigned& nloc, unsigned& nx) {
    const unsigned G = gridDim.x * gridDim.y * gridDim.z;
    unsigned sum, cnt, mine, sp = 0u;
    for (;;) {
        sum = 0u; cnt = 0u; mine = 0u;
#pragma unroll
        for (unsigned j = 0; j < 16; ++j) { const unsigned c = xb_ld(&bar[XB_XCNT(j)]); sum += c; cnt += (c > 0u) ? 1u : 0u; mine = (j == x) ? c : mine; }
        if (sum == G) break;
        __builtin_amdgcn_s_sleep(1);
        if ((++sp & 255u) == 0u) { if (xb_ld(&bar[XB_TMO])) break; if (sp > XB_SPIN_CAP) { atomicAdd(&bar[XB_TMO], 1u); break; } }
    }
    nloc = mine > 0u ? mine : 1u; nx = cnt > 0u ? cnt : 1u;
}
__device__ __forceinline__ void xcd_barrier(const XcdBarrier& b) {
    asm volatile("s_waitcnt vmcnt(0)" ::: "memory");
    __syncthreads();
    if (threadIdx.x == 0) {
        unsigned* bar = b.bar; const unsigned bx = xb_xcc_id();
        __builtin_amdgcn_s_waitcnt(0);
        unsigned nloc = b.st[0], nx = b.st[1];
        if (nloc == 0u) { xcd_barrier_complete(bar, bx, nloc, nx); b.st[0] = nloc; b.st[1] = nx; }
        const unsigned old = xb_add(&bar[XB_XSUB(bx)], 1u);
        const unsigned gen = old / nloc;
        if (old + 1u == (gen + 1u) * nloc) {
            __builtin_amdgcn_fence(__ATOMIC_RELEASE, "agent");
            asm volatile("s_waitcnt vmcnt(0)" ::: "memory");
            const unsigned og = xb_add(&bar[XB_TOP], 1u);
            const unsigned tg = og / nx;
            if (og + 1u == (tg + 1u) * nx) xb_add(&bar[XB_TOPGEN], 1u);
            else XB_SPIN(xb_ld(&bar[XB_TOPGEN]) == tg, bar);
            __builtin_amdgcn_fence(__ATOMIC_ACQUIRE, "agent");
            xb_add(&bar[XB_XGEN(bx)], 1u);
            asm volatile("s_waitcnt vmcnt(0)" ::: "memory");
        } else {
            XB_SPIN(xb_ld(&bar[XB_XGEN(bx)]) == gen, bar);
            __builtin_amdgcn_fence(__ATOMIC_ACQUIRE, "agent");
            asm volatile("s_waitcnt vmcnt(0)" ::: "memory");
        }
    }
    __syncthreads();
}

constexpr int CW_BAR = 4096;

__global__ void __launch_bounds__(NTHR, 2) fwd(Args args) {
    extern __shared__ __attribute__((aligned(16))) unsigned char lds_raw[];
    Ctx c; c.lds = (LAS unsigned char*)lds_raw; c.tid = threadIdx.x; c.lane = c.tid & 63; c.wave = __builtin_amdgcn_readfirstlane(c.tid >> 6); c.G = gridDim.x; c.bid = blockIdx.x; c.ws = args.ws;
    unsigned char* ws = args.ws;
    volatile LAS unsigned* MISC = (volatile LAS unsigned*)(c.lds + MISC_OFF);
    if (c.tid < 32) MISC[c.tid] = 0u;
    if (c.tid < 31) { const unsigned long long pv = c.tid < 30 ? (unsigned long long)args.in[c.tid] : (unsigned long long)args.out;
        volatile LAS unsigned* pt = (volatile LAS unsigned*)(c.lds + PTR_OFF) + 2 * c.tid; pt[0] = (unsigned)pv; pt[1] = (unsigned)(pv >> 32); }
    __syncthreads();
    XcdBarrier bar = xcd_barrier_post((unsigned*)(ws + WS_CTL) + CW_BAR, MISC + 8);
#define GRID_BAR() xcd_barrier(bar)

    ph_convert(c); __syncthreads(); ph_mod(c); __syncthreads(); ph_filt(c);
    GRID_BAR();
    for (int l = 0; l < DEPTH; ++l) {
        ph_norm(c, l, 0);
        GRID_BAR();
        {   unsigned char* ws = c.ws; asm volatile("" : "+s"(ws));
            pg8::Gemm g{D, D, D}; pg8::StaticOrder S; S.init(ws + WS_H, D, (bf16_t*)(ws + WS_WIN) + (size_t)l * PW * D, D, T, PW, c.G, c.bid);
            EpiStoreBf16 E{(bf16_t*)(ws + WS_P), PW};
            pg8::gemm_phase(c.lds, g, S, E); }
        GRID_BAR();
        ph_sc(c, l);
        GRID_BAR();
        ph_hyena(c, l); ph_attn(c, l);
        GRID_BAR();
        {   unsigned char* ws = c.ws; asm volatile("" : "+s"(ws));
            pg8::Gemm g{512, 512, 512};
            { pg8::StaticOrder S; S.init(ws + WS_OATT, 512, (bf16_t*)(ws + WS_WPA) + (size_t)l * D * 512, 512, T, D, c.G, c.bid);
              EpiMerge1 E{(float*)(ws + WS_B), (const bf16_t*)(ws + WS_P)};
              pg8::gemm_phase(c.lds, g, S, E); }
            { pg8::StaticOrder S; S.init(ws + WS_OHY, 512, (bf16_t*)(ws + WS_WPB) + (size_t)l * D * 512, 512, T, D, c.G, c.bid);
              EpiMerge2 E{(const float*)(ws + WS_B), (const bf16_t*)(ws + WS_P), (bf16_t*)(ws + WS_H)};
              pg8::gemm_phase(c.lds, g, S, E); } }
        GRID_BAR();
        {   unsigned char* ws = c.ws; asm volatile("" : "+s"(ws));
            const float* modl = (const float*)(ws + WS_MOD) + (size_t)l * 5 * 6144;
            pg8::Gemm g{D, D, D}; pg8::StaticOrder S; S.init(ws + WS_H, D, (bf16_t*)(ws + WS_WO) + (size_t)l * D * D, D, T, D, c.G, c.bid);
            EpiResid E{(float*)(ws + WS_X), modl + 2 * 1024};
            pg8::gemm_phase(c.lds, g, S, E); }
        GRID_BAR();
        ph_norm(c, l, 1);
        GRID_BAR();
        if ((l & 1) == 0) {
            {   unsigned char* ws = c.ws; asm volatile("" : "+s"(ws));
                const bf16_t* w = (const bf16_t*)(ws + WS_W13D) + (size_t)(l >> 1) * 2 * FF * D;
                pg8::Gemm g{D, D, D}; pg8::StaticOrder S; S.init(ws + WS_H, D, w, D, T, 2 * FF, c.G, c.bid);
                EpiSwiglu E{(bf16_t*)(ws + WS_P)};
                pg8::gemm_phase(c.lds, g, S, E); }
            GRID_BAR();
            {   unsigned char* ws = c.ws; asm volatile("" : "+s"(ws));
                const float* modl = (const float*)(ws + WS_MOD) + (size_t)l * 5 * 6144;
                const bf16_t* w = (const bf16_t*)(ws + WS_W2D) + (size_t)(l >> 1) * D * FF;
                pg8::Gemm g{FF, FF, FF}; pg8::StaticOrder S; S.init(ws + WS_P, FF, w, FF, T, D, c.G, c.bid);
                EpiResid E{(float*)(ws + WS_X), modl + 5 * 1024};
                pg8::gemm_phase(c.lds, g, S, E); }
            GRID_BAR();
        } else {
            const Ctx cm = mk_ctx(c.lds, c.ws);
            moe_table(cm, l >> 1);
            {   unsigned char* ws = c.ws; asm volatile("" : "+s"(ws));
                const bf16_t* w = (const bf16_t*)(ws + WS_W13M) + (size_t)((l >> 1) * NE) * 2 * FF * D;
                pg8::Gemm g{D, D, D}; MoeOrder<true> S; S.init(ws + WS_H, D, w, D, (size_t)2 * FF * D * 2, 2 * FF, c.G, c.bid, (const int*)(ws + WS_TOK), (const LAS unsigned*)(c.lds + MOE_OFF));
                EpiSwiglu E{(bf16_t*)(ws + WS_P)};
                pg8::gemm_phase(c.lds, g, S, E); }
            GRID_BAR();
            {   unsigned char* ws = c.ws; asm volatile("" : "+s"(ws));
                const bf16_t* w = (const bf16_t*)(ws + WS_W2M) + (size_t)((l >> 1) * NE) * D * FF;
                pg8::Gemm g{FF, FF, FF}; MoeOrder<false> S; S.init(ws + WS_P, FF, w, FF, (size_t)D * FF * 2, D, c.G, c.bid, (const int*)(ws + WS_TOK), (const LAS unsigned*)(c.lds + MOE_OFF));
                EpiStoreBf16 E{(bf16_t*)(ws + WS_Y), D};
                pg8::gemm_phase(c.lds, g, S, E); }
            GRID_BAR();
        }
    }
    ph_final(c);
}

extern "C" void kernel_launch(void* const* d_in, const int* in_sizes, int n_in, void* d_out, int out_size, void* d_ws, size_t ws_size, hipStream_t stream) {
    static int grid = 0;
    if (grid == 0) {
        if (n_in != 30 || out_size != TL * D || ws_size < WS_END) { fprintf(stderr, "kernel_launch: unexpected shapes (n_in %d out %d ws %zu)\n", n_in, out_size, ws_size); grid = -1; return; }
        int dev = 0, cus = 0, per_cu = 0; (void)hipGetDevice(&dev); (void)hipDeviceGetAttribute(&cus, hipDeviceAttributeMultiprocessorCount, dev);
        if (hipFuncSetAttribute((const void*)fwd, hipFuncAttributeMaxDynamicSharedMemorySize, LDS_BYTES) != hipSuccess) { fprintf(stderr, "kernel_launch: hipFuncSetAttribute failed\n"); grid = -1; return; }
        if (hipOccupancyMaxActiveBlocksPerMultiprocessor(&per_cu, (const void*)fwd, NTHR, LDS_BYTES) != hipSuccess || per_cu < 1) fprintf(stderr, "kernel_launch: occupancy query reports %d\n", per_cu);
        (void)hipGetLastError();
        grid = cus > 0 ? cus : 256;
    }
    if (grid < 0) return;
    (void)hipMemsetAsync((char*)d_ws + WS_CTL, 0, CTL_ZERO_BYTES, stream);
    Args a{};
    for (int i = 0; i < 30; ++i) a.in[i] = (const float*)d_in[i];
    a.out = (float*)d_out; a.ws = (unsigned char*)d_ws;
    hipLaunchKernelGGL(fwd, dim3(grid), dim3(NTHR), LDS_BYTES, stream, a);
}
```

```cpp
#include <hip/hip_runtime.h>
#include <cstdio>
#include <cstdint>

#define LAS __attribute__((address_space(3)))
#define GAS __attribute__((address_space(1)))
typedef unsigned short bf16_t;
typedef short bf16x8 __attribute__((ext_vector_type(8)));
typedef float f32x4 __attribute__((ext_vector_type(4)));
typedef float f32x2 __attribute__((ext_vector_type(2)));
typedef float f32x16 __attribute__((ext_vector_type(16)));
typedef unsigned u32x4 __attribute__((ext_vector_type(4)));
typedef unsigned u32x2 __attribute__((ext_vector_type(2)));

constexpr int D = 1024, NB = 4, SEQ = 4096, DEPTH = 4, CTX = 256;
constexpr int TL = NB * SEQ, TC = NB * CTX, T = TL + TC;
constexpr int PW = 5120, FF = 2816, NE = 8, HYW = 512;
constexpr int PQ = 0, PK = 512, PV = 1024, PHY = 1536, PGA = 3072, PGB = 4096;
constexpr float EPS = 1e-6f;

constexpr size_t MiB = 1u << 20;
constexpr size_t WS_CTL = 0, CTL_ZERO_BYTES = 1 * MiB;
constexpr size_t WS_MOD = 1 * MiB;
constexpr size_t WS_ROUTE = 2 * MiB;
constexpr size_t WS_RWT = 2 * MiB + 512 * 1024;
constexpr size_t WS_TOK = 3 * MiB;
constexpr int CW_CNT = 8192;
constexpr int MAXSLOT = 36864;
constexpr size_t WS_Y = 660 * MiB;
constexpr size_t WS_WIN = 4 * MiB;
constexpr size_t WS_WPA = 44 * MiB;
constexpr size_t WS_WPB = 48 * MiB;
constexpr size_t WS_WO = 52 * MiB;
constexpr size_t WS_W13D = 60 * MiB;
constexpr size_t WS_W2D = 82 * MiB;
constexpr size_t WS_W13M = 93 * MiB;
constexpr size_t WS_W2M = 269 * MiB;
constexpr size_t WS_X = 357 * MiB;
constexpr size_t WS_H = 425 * MiB;
constexpr size_t WS_P = 459 * MiB;
constexpr size_t WS_OATT = 629 * MiB;
constexpr size_t WS_OHY = 646 * MiB;
constexpr size_t WS_B = 663 * MiB;
constexpr size_t WS_Z = WS_B + 51 * MiB;
constexpr size_t WS_VT = 748 * MiB;
constexpr size_t WS_HRL = 816 * MiB;
constexpr size_t WS_HRC = 850 * MiB;
constexpr size_t WS_END = 853 * MiB;

constexpr int LDS_BYTES = 147456;
constexpr int NWAVES = 8, NTHR = 512;

#define LDS_WAIT() asm volatile("s_waitcnt lgkmcnt(0)" ::: "memory")
#define VM_WAIT() asm volatile("s_waitcnt vmcnt(0)" ::: "memory")
__device__ __forceinline__ float bf2f(unsigned b) { return __uint_as_float(b << 16); }
__device__ __forceinline__ float bflo(unsigned w) { return __uint_as_float(w << 16); }
__device__ __forceinline__ float bfhi(unsigned w) { return __uint_as_float(w & 0xffff0000u); }
__device__ __forceinline__ unsigned cvt_pk_bf16(float lo, float hi) { unsigned r; asm volatile("v_cvt_pk_bf16_f32 %0, %1, %2" : "=v"(r) : "v"(lo), "v"(hi)); return r; }
__device__ __forceinline__ float wave_sum(float v, int lane) {
#pragma unroll
    for (int o = 1; o < 64; o <<= 1) v += __int_as_float(__builtin_amdgcn_ds_bpermute((lane ^ o) << 2, __float_as_int(v)));
    return v;
}
__device__ __forceinline__ float sigmoidf_(float x) { return 1.f / (1.f + __expf(-x)); }
__device__ __forceinline__ float sin_rev(float r) { return __builtin_amdgcn_sinf(__builtin_amdgcn_fractf(r)); }
__device__ __forceinline__ float sin_rad(float x) { return sin_rev(x * 0.15915494309189535f); }

namespace pg8 {
constexpr int BM = 256, BK = 64, HALF = 128, HTB = HALF * BK * 2, STAGE_BYTES = 8 * HTB, NXCD = 8, WGM = 8;
__host__ __device__ __forceinline__ int lds_byte(int r, int c) { const int st = (r >> 4) * 2 + (c >> 5), rr = r & 15, cc = c & 31, ob = rr * 64 + cc * 2; return st * 1024 + (ob ^ (((ob >> 9) & 1) << 5)); }
__host__ __device__ __forceinline__ void stage_rc(int b, int& R, int& C) { const int st = b / 1024, sb = b % 1024, swz = sb ^ (((sb >> 9) & 1) << 5); R = (st >> 1) * 16 + swz / 64; C = (st & 1) * 32 + (swz % 64) / 2; }
__host__ __device__ __forceinline__ int perm32(int rho) { const int n = rho >> 4, i = rho & 15; return 8 * (i >> 2) + 4 * n + (i & 3); }

struct Unit { int pm, pn; const char* a; const char* b; const int* tk; int nvalid; };
struct Gemm { int K, lda, ldb; };

struct StaticOrder {
    int nM, nN, nwg, G, c; const char* A; const char* B; size_t astep, bstep;
    __device__ void init(const void* A_, int lda, const void* B_, int ldb, int M, int N, int G_, int c_) {
        nM = M / BM; nN = N / BM; nwg = nM * nN; G = G_; c = c_; A = (const char*)A_; B = (const char*)B_; astep = (size_t)BM * lda * 2; bstep = (size_t)BM * ldb * 2; }
    __device__ bool next(int i, Unit& u) const {
        const long L = (long)i * G + c; if (L >= nwg) return false;
        int wgid = (int)L; { const int q = nwg / NXCD, r = nwg % NXCD, xcd = wgid % NXCD, off = wgid / NXCD; wgid = (xcd < r ? xcd * (q + 1) : r * (q + 1) + (xcd - r) * q) + off; }
        const int nig = WGM * nN, gid = wgid / nig, fm = gid * WGM, gsz = (nM - fm) < WGM ? (nM - fm) : WGM;
        u.pm = fm + ((wgid % nig) % gsz); u.pn = (wgid % nig) / gsz; u.a = A + (size_t)u.pm * astep; u.b = B + (size_t)u.pn * bstep; return true;
    }
    static constexpr bool GATHER = false;
    __device__ __forceinline__ int arow(const Unit&, int) const { return 0; }
    __device__ __forceinline__ void a_ready(const Unit&) const {}
    __device__ __forceinline__ void done(const Unit&) const {}
};

template <class Epi, class Sched, bool ALIGN_EPI = true>
__device__ __forceinline__ void gemm_phase(LAS unsigned char* lds, const Gemm g, const Sched& S, const Epi& E) {
    int tid = threadIdx.x; asm volatile("" : "+v"(tid));
    const int wid = __builtin_amdgcn_readfirstlane(tid >> 6), lane = tid & 63, wr = wid >> 2, wc = wid & 3, fr = lane & 15, fq = lane >> 4;
    const int K = g.K, nt = K / BK;
    constexpr bool GATHER = Sched::GATHER;
    unsigned voffB[2]; unsigned cA0[2], cA1[2], nA0[2], nA1[2]; int RA[2], CA[2];
    const size_t hstepA = (size_t)HALF * g.lda * 2, hstepB = (size_t)HALF * g.ldb * 2;
#pragma unroll
    for (int i = 0; i < 2; ++i) { int R, C; stage_rc(tid * 16 + i * 8192, R, C); const int Rb = Epi::PERM ? ((R & ~31) + perm32(R & 31)) : R;
        RA[i] = R; CA[i] = C; voffB[i] = (unsigned)(Rb * g.ldb + C) * 2u;
        cA0[i] = (unsigned)(R * g.lda + C) * 2u; cA1[i] = cA0[i]; nA0[i] = cA0[i]; nA1[i] = cA0[i]; }
    const size_t h1A = GATHER ? 0 : hstepA;
    const size_t kstep = (size_t)(BK * 2);
    const unsigned ldsw = (unsigned)wid * 1024u;
    const int aoff = lds_byte(wr * 64 + fr, fq * 8), boff = lds_byte(wc * 32 + fr, fq * 8);
#define PG8_SA(b, h) (((b) * 2 + (h)) * HTB)
#define PG8_SB(b, h) ((4 + (b) * 2 + (h)) * HTB)
#define PG8_STAGE(bufoff, gbase, voff) do { _Pragma("unroll") for (int _i = 0; _i < 2; ++_i) \
        __builtin_amdgcn_global_load_lds((const unsigned*)((const char*)(gbase) + (voff)[_i]), (LAS unsigned*)(lds + (bufoff) + ldsw + _i * 8192), 16, 0, 0); } while (0)
#define PG8_LDA(dst, b, h) do { _Pragma("unroll") for (int m = 0; m < 4; ++m) _Pragma("unroll") for (int k = 0; k < 2; ++k) dst[m][k] = *(const LAS bf16x8*)(lds + PG8_SA(b, h) + aoff + m * 2048 + k * 1024); } while (0)
#define PG8_LDB(dst, b, h) do { _Pragma("unroll") for (int n = 0; n < 2; ++n) _Pragma("unroll") for (int k = 0; k < 2; ++k) dst[n][k] = *(const LAS bf16x8*)(lds + PG8_SB(b, h) + boff + n * 2048 + k * 1024); } while (0)
#define PG8_MMA(ai, bj, At, Bt) do { __builtin_amdgcn_s_setprio(1); _Pragma("unroll") for (int m = 0; m < 4; ++m) _Pragma("unroll") for (int n = 0; n < 2; ++n) _Pragma("unroll") for (int k = 0; k < 2; ++k) \
        acc[ai][bj][m][n] = __builtin_amdgcn_mfma_f32_16x16x32_bf16(Bt[n][k], At[m][k], acc[ai][bj][m][n], 0, 0, 0); __builtin_amdgcn_s_setprio(0); } while (0)
#define PG8_WAIT_V(n) asm volatile("s_waitcnt vmcnt(" #n ")" ::: "memory")
#define PG8_WAIT_L(n) asm volatile("s_waitcnt lgkmcnt(" #n ")" ::: "memory")
#define PG8_BAR __builtin_amdgcn_s_barrier()
#define PG8_SCHED __builtin_amdgcn_sched_barrier(0)
    Unit cur, nxt; int ui = 0;
    if (!S.next(0, cur)) return;
    if constexpr (GATHER) {
#pragma unroll
        for (int i = 0; i < 2; ++i) { cA0[i] = (unsigned)(S.arow(cur, RA[i]) * g.lda + CA[i]) * 2u; cA1[i] = (unsigned)(S.arow(cur, HALF + RA[i]) * g.lda + CA[i]) * 2u; }
    }
    f32x4 acc[2][2][4][2];
#pragma unroll
    for (int a = 0; a < 2; ++a)
#pragma unroll
        for (int b = 0; b < 2; ++b)
#pragma unroll
            for (int m = 0; m < 4; ++m)
#pragma unroll
                for (int n = 0; n < 2; ++n) acc[a][b][m][n] = (f32x4){0.f, 0.f, 0.f, 0.f};
    bf16x8 At[4][2], B0[2][2], B1[2][2];
    const char* cA = cur.a; const char* cB = cur.b;
    S.a_ready(cur);
    PG8_STAGE(PG8_SB(0, 0), cB, voffB); PG8_STAGE(PG8_SB(0, 1), cB + hstepB, voffB); PG8_STAGE(PG8_SA(0, 0), cA, cA0); PG8_STAGE(PG8_SA(0, 1), cA + h1A, cA1);
    if (wr == 1) PG8_BAR;
    PG8_WAIT_V(2); PG8_BAR;
    PG8_STAGE(PG8_SB(1, 0), cB + kstep, voffB); PG8_STAGE(PG8_SA(1, 0), cA + kstep, cA0); PG8_STAGE(PG8_SB(1, 1), cB + hstepB + kstep, voffB);
    PG8_WAIT_V(6); PG8_BAR;
    for (;;) {
        const bool has_next = S.next(ui + 1, nxt);
        const char* nA = has_next ? nxt.a : cA; const char* nB = has_next ? nxt.b : cB;
        if constexpr (GATHER) {
#pragma unroll
            for (int i = 0; i < 2; ++i) { nA0[i] = has_next ? (unsigned)(S.arow(nxt, RA[i]) * g.lda + CA[i]) * 2u : cA0[i]; nA1[i] = has_next ? (unsigned)(S.arow(nxt, HALF + RA[i]) * g.lda + CA[i]) * 2u : cA1[i]; }
        }
        for (int t = 0; t < nt; t += 2) {
            const bool last = (t == nt - 2);
            const char* a1 = cA + (size_t)(t + 1) * kstep;
            const char* a2 = last ? nA : cA + (size_t)(t + 2) * kstep; const char* b2 = last ? nB : cB + (size_t)(t + 2) * kstep;
            const char* a3 = a2 + kstep; const char* b3 = b2 + kstep;
            unsigned x0[2], x1[2];
#pragma unroll
            for (int i = 0; i < 2; ++i) { x0[i] = (GATHER && last) ? nA0[i] : cA0[i]; x1[i] = GATHER ? (last ? nA1[i] : cA1[i]) : cA0[i]; }
            if (last && has_next) S.a_ready(nxt);
            PG8_LDB(B0, 0, 0); PG8_LDB(B1, 0, 1); PG8_SCHED; PG8_LDA(At, 0, 0); PG8_STAGE(PG8_SA(1, 1), a1 + h1A, cA1);
            PG8_WAIT_V(8); PG8_WAIT_L(0); PG8_BAR; PG8_MMA(0, 0, At, B0); PG8_MMA(0, 1, At, B1); PG8_BAR; PG8_SCHED;
            PG8_LDA(At, 0, 1); PG8_STAGE(PG8_SB(0, 0), b2, voffB); PG8_STAGE(PG8_SB(0, 1), b2 + hstepB, voffB); PG8_STAGE(PG8_SA(0, 0), a2, x0);
            PG8_WAIT_V(8); PG8_WAIT_L(0); PG8_BAR; PG8_MMA(1, 0, At, B0); PG8_MMA(1, 1, At, B1); PG8_BAR; PG8_SCHED;
            PG8_LDB(B0, 1, 0); PG8_LDB(B1, 1, 1); PG8_SCHED; PG8_LDA(At, 1, 0); PG8_STAGE(PG8_SA(0, 1), a2 + h1A, x1);
            PG8_WAIT_V(8); PG8_WAIT_L(0); PG8_BAR; PG8_MMA(0, 0, At, B0); PG8_MMA(0, 1, At, B1); PG8_BAR; PG8_SCHED;
            PG8_LDA(At, 1, 1); PG8_STAGE(PG8_SB(1, 0), b3, voffB); PG8_STAGE(PG8_SB(1, 1), b3 + hstepB, voffB); PG8_STAGE(PG8_SA(1, 0), a3, x0);
            PG8_WAIT_V(8); PG8_WAIT_L(0); PG8_BAR; PG8_MMA(1, 0, At, B0); PG8_MMA(1, 1, At, B1); PG8_BAR; PG8_SCHED;
        }
        if constexpr (ALIGN_EPI) { if (wr == 0) PG8_BAR; }
        E(acc, cur, wr, wc, fr, fq); S.done(cur);
        if (!has_next) break;
#pragma unroll
        for (int a = 0; a < 2; ++a)
#pragma unroll
            for (int b = 0; b < 2; ++b)
#pragma unroll
                for (int m = 0; m < 4; ++m)
#pragma unroll
                    for (int n = 0; n < 2; ++n) acc[a][b][m][n] = (f32x4){0.f, 0.f, 0.f, 0.f};
        cur = nxt; cA = nA; cB = nB; ++ui;
        if constexpr (GATHER) {
#pragma unroll
            for (int i = 0; i < 2; ++i) { cA0[i] = nA0[i]; cA1[i] = nA1[i]; }
        }
        if constexpr (ALIGN_EPI) { if (wr == 1) PG8_BAR; }
    }
    PG8_WAIT_V(0);
    if constexpr (!ALIGN_EPI) { if (wr == 0) PG8_BAR; }
    PG8_BAR;
#undef PG8_SA
#undef PG8_SB
#undef PG8_STAGE
#undef PG8_LDA
#undef PG8_LDB
#undef PG8_MMA
#undef PG8_WAIT_V
#undef PG8_WAIT_L
#undef PG8_BAR
#undef PG8_SCHED
}
}

typedef f32x4 AccT[2][2][4][2];
struct EpiStoreBf16 {
    static constexpr bool PERM = true;
    bf16_t* O; int ldc;
    __device__ __forceinline__ void operator()(const AccT& acc, const pg8::Unit& u, int wr, int wc, int fr, int fq) const {
        const int row0 = u.pm * 256 + wr * 64 + fr, col0 = u.pn * 256 + wc * 32 + 8 * fq;
#pragma unroll
        for (int ai = 0; ai < 2; ++ai)
#pragma unroll
            for (int m = 0; m < 4; ++m) { bf16_t* rowp = O + (size_t)(row0 + ai * 128 + m * 16) * ldc + col0;
#pragma unroll
                for (int bj = 0; bj < 2; ++bj) { const f32x4 v0 = acc[ai][bj][m][0], v1 = acc[ai][bj][m][1];
                    u32x4 w; w.x = cvt_pk_bf16(v0[0], v0[1]); w.y = cvt_pk_bf16(v0[2], v0[3]); w.z = cvt_pk_bf16(v1[0], v1[1]); w.w = cvt_pk_bf16(v1[2], v1[3]);
                    *(u32x4*)(rowp + bj * 128) = w; } }
    }
};
struct EpiMerge1 {
    static constexpr bool PERM = true;
    float* t1; const bf16_t* P;
    __device__ __forceinline__ void operator()(const AccT& acc, const pg8::Unit& u, int wr, int wc, int fr, int fq) const {
        const int row0 = u.pm * 256 + wr * 64 + fr, col0 = u.pn * 256 + wc * 32 + 8 * fq;
#pragma unroll
        for (int ai = 0; ai < 2; ++ai)
#pragma unroll
            for (int m = 0; m < 4; ++m) { const int r = row0 + ai * 128 + m * 16;
#pragma unroll
                for (int bj = 0; bj < 2; ++bj) { const int c = col0 + bj * 128;
                    const u32x4 g = *(const u32x4*)(P + (size_t)r * PW + PGA + c);
                    const f32x4 v0 = acc[ai][bj][m][0], v1 = acc[ai][bj][m][1];
                    f32x4 o0, o1;
                    o0[0] = sigmoidf_(bflo(g.x)) * v0[0]; o0[1] = sigmoidf_(bfhi(g.x)) * v0[1]; o0[2] = sigmoidf_(bflo(g.y)) * v0[2]; o0[3] = sigmoidf_(bfhi(g.y)) * v0[3];
                    o1[0] = sigmoidf_(bflo(g.z)) * v1[0]; o1[1] = sigmoidf_(bfhi(g.z)) * v1[1]; o1[2] = sigmoidf_(bflo(g.w)) * v1[2]; o1[3] = sigmoidf_(bfhi(g.w)) * v1[3];
                    float* tp = t1 + (size_t)r * D + c; *(f32x4*)tp = o0; *(f32x4*)(tp + 4) = o1; } }
    }
};
struct EpiMerge2 {
    static constexpr bool PERM = true;
    const float* t1; const bf16_t* P; bf16_t* O;
    __device__ __forceinline__ void operator()(const AccT& acc, const pg8::Unit& u, int wr, int wc, int fr, int fq) const {
        const int row0 = u.pm * 256 + wr * 64 + fr, col0 = u.pn * 256 + wc * 32 + 8 * fq;
#pragma unroll
        for (int ai = 0; ai < 2; ++ai)
#pragma unroll
            for (int m = 0; m < 4; ++m) { const int r = row0 + ai * 128 + m * 16;
#pragma unroll
                for (int bj = 0; bj < 2; ++bj) { const int c = col0 + bj * 128;
                    const u32x4 g = *(const u32x4*)(P + (size_t)r * PW + PGB + c);
                    const float* tp = t1 + (size_t)r * D + c; const f32x4 a0 = *(const f32x4*)tp, a1 = *(const f32x4*)(tp + 4);
                    const f32x4 v0 = acc[ai][bj][m][0], v1 = acc[ai][bj][m][1];
                    f32x4 o0, o1;
                    o0[0] = a0[0] + sigmoidf_(bflo(g.x)) * v0[0]; o0[1] = a0[1] + sigmoidf_(bfhi(g.x)) * v0[1]; o0[2] = a0[2] + sigmoidf_(bflo(g.y)) * v0[2]; o0[3] = a0[3] + sigmoidf_(bfhi(g.y)) * v0[3];
                    o1[0] = a1[0] + sigmoidf_(bflo(g.z)) * v1[0]; o1[1] = a1[1] + sigmoidf_(bfhi(g.z)) * v1[1]; o1[2] = a1[2] + sigmoidf_(bflo(g.w)) * v1[2]; o1[3] = a1[3] + sigmoidf_(bfhi(g.w)) * v1[3];
                    u32x4 w; w.x = cvt_pk_bf16(o0[0], o0[1]); w.y = cvt_pk_bf16(o0[2], o0[3]); w.z = cvt_pk_bf16(o1[0], o1[1]); w.w = cvt_pk_bf16(o1[2], o1[3]);
                    *(u32x4*)(O + (size_t)r * D + c) = w; } }
    }
};
struct EpiResid {
    static constexpr bool PERM = false;
    float* x; const float* gate;
    __device__ __forceinline__ void operator()(const AccT& acc, const pg8::Unit& u, int wr, int wc, int fr, int fq) const {
        const int row0 = u.pm * 256 + wr * 64 + fr, col0 = u.pn * 256 + wc * 32 + 4 * fq;
        const int b = (u.pm < 64) ? (u.pm >> 4) : 4;
        const float* gp = gate + (size_t)b * 6144 + col0;
        f32x4 gv[2][2];
#pragma unroll
        for (int bj = 0; bj < 2; ++bj)
#pragma unroll
            for (int n = 0; n < 2; ++n) gv[bj][n] = *(const f32x4*)(gp + bj * 128 + n * 16);
#pragma unroll
        for (int ai = 0; ai < 2; ++ai)
#pragma unroll
            for (int m = 0; m < 4; ++m) { const int r = row0 + ai * 128 + m * 16; float* rowp = x + (size_t)r * D + col0;
#pragma unroll
                for (int bj = 0; bj < 2; ++bj)
#pragma unroll
                    for (int n = 0; n < 2; ++n) { float* p = rowp + bj * 128 + n * 16; *(f32x4*)p = *(const f32x4*)p + gv[bj][n] * acc[ai][bj][m][n]; } }
    }
};
struct EpiSwiglu {
    static constexpr bool PERM = true;
    bf16_t* O;
    __device__ __forceinline__ void operator()(const AccT& acc, const pg8::Unit& u, int wr, int wc, int fr, int fq) const {
        const int row0 = u.pm * 256 + wr * 64 + fr, col0 = u.pn * 128 + wc * 32 + 8 * fq;
#pragma unroll
        for (int ai = 0; ai < 2; ++ai)
#pragma unroll
            for (int m = 0; m < 4; ++m) { const int r = row0 + ai * 128 + m * 16;
                float o[8];
#pragma unroll
                for (int n = 0; n < 2; ++n)
#pragma unroll
                    for (int j = 0; j < 4; ++j) { const float a = acc[ai][0][m][n][j], g = acc[ai][1][m][n][j]; o[n * 4 + j] = a * sigmoidf_(a) * g; }
                u32x4 w; w.x = cvt_pk_bf16(o[0], o[1]); w.y = cvt_pk_bf16(o[2], o[3]); w.z = cvt_pk_bf16(o[4], o[5]); w.w = cvt_pk_bf16(o[6], o[7]);
                *(u32x4*)(O + (size_t)r * FF + col0) = w; }
    }
};

struct Args { const float* in[30]; float* out; unsigned char* ws; int l, e, ph, pad; };
enum { I_X = 0, I_C, I_CTX, I_CCTX, I_WMOD, I_BMOD, I_N1G, I_N2G, I_WIN, I_RPB, I_HCW, I_HCB, I_HW1, I_HB1, I_HW2, I_HB2, I_HW3, I_HFREQ, I_HBIAS,
       I_WPA, I_WPB, I_WO, I_FW1, I_FW3, I_FW2, I_ROUTER, I_MW1, I_MW3, I_MW2, I_FINALG };

constexpr int MISC_OFF = 131072 + 320;
constexpr int PTR_OFF = MISC_OFF + 128;
struct Ctx {
    LAS unsigned char* lds; int tid, lane, wave, G, bid; unsigned char* ws;
};
__device__ __forceinline__ Ctx mk_ctx(LAS unsigned char* lds, unsigned char* ws) {
    Ctx c; int t = threadIdx.x; asm volatile("" : "+v"(t)); asm volatile("" : "+s"(ws)); c.lds = lds; c.tid = t; c.lane = t & 63; c.wave = __builtin_amdgcn_readfirstlane(t >> 6); c.G = gridDim.x; c.bid = blockIdx.x; c.ws = ws; return c;
}
__device__ __forceinline__ const float* inp(const Ctx& c, int i) {
    unsigned ao = (unsigned)(PTR_OFF + 8 * i); asm volatile("" : "+v"(ao));
    const volatile LAS unsigned* p = (const volatile LAS unsigned*)(c.lds + ao);
    const unsigned lo = __builtin_amdgcn_readfirstlane(p[0]), hi = __builtin_amdgcn_readfirstlane(p[1]);
    return (const float*)(((unsigned long long)hi << 32) | (unsigned long long)lo);
}

__device__ __forceinline__ void transpose_item(const float* W, int N, bf16_t* WT, int ldk, int k0, int n0, int drow0, LAS float* scr, int lane) {
    float wv[32];
    const float* wp = W + (size_t)(k0 + (lane >> 5)) * N + n0 + (lane & 31);
#pragma unroll
    for (int i = 0; i < 32; ++i) wv[i] = wp[(size_t)(2 * i) * N];
#pragma unroll
    for (int i = 0; i < 32; ++i) scr[(2 * i + (lane >> 5)) * 33 + (lane & 31)] = wv[i];
    LDS_WAIT(); asm volatile("" ::: "memory");
    const int c = lane & 7;
#pragma unroll
    for (int j = 0; j < 4; ++j) { const int n = (lane >> 3) + 8 * j; const LAS float* s = scr + (8 * c) * 33 + n;
        u32x4 o; o.x = cvt_pk_bf16(s[0 * 33], s[1 * 33]); o.y = cvt_pk_bf16(s[2 * 33], s[3 * 33]); o.z = cvt_pk_bf16(s[4 * 33], s[5 * 33]); o.w = cvt_pk_bf16(s[6 * 33], s[7 * 33]);
        *(u32x4*)(WT + (size_t)(drow0 + n) * ldk + k0 + 8 * c) = o; }
    LDS_WAIT(); asm volatile("" ::: "memory");
}
__device__ __forceinline__ void conv_mat(const float* W, int K, int N, bf16_t* WT, int mode, int& base, int gw, int NGW, LAS float* scr, int lane) {
    const int nblk = N / 32, nitems = (K / 64) * nblk;
    const int start = (gw - (base % NGW) + NGW) % NGW;
    for (int it = start; it < nitems; it += NGW) {
        const int kb = it / nblk, nb = it % nblk, n0 = nb * 32;
        const int drow0 = mode == 0 ? n0 : ((n0 >> 7) * 256 + (n0 & 127) + (mode == 2 ? 128 : 0));
        transpose_item(W, N, WT, K, kb * 64, n0, drow0, scr, lane);
    }
    base += nitems;
}
__device__ __forceinline__ void ph_convert(const Ctx& c0) {
    const Ctx c = mk_ctx(c0.lds, c0.ws);
    unsigned char* ws = c.ws;
    LAS float* scr = (LAS float*)(c.lds + c.wave * 16384);
    const int gw = c.bid * NWAVES + c.wave, NGW = c.G * NWAVES; int base = 0;
    for (int l = 0; l < DEPTH; ++l) {
        conv_mat(inp(c, I_WIN) + (size_t)l * D * PW, D, PW, (bf16_t*)(ws + WS_WIN) + (size_t)l * PW * D, 0, base, gw, NGW, scr, c.lane);
        conv_mat(inp(c, I_WPA) + (size_t)l * 512 * D, 512, D, (bf16_t*)(ws + WS_WPA) + (size_t)l * D * 512, 0, base, gw, NGW, scr, c.lane);
        conv_mat(inp(c, I_WPB) + (size_t)l * 512 * D, 512, D, (bf16_t*)(ws + WS_WPB) + (size_t)l * D * 512, 0, base, gw, NGW, scr, c.lane);
        conv_mat(inp(c, I_WO) + (size_t)l * D * D, D, D, (bf16_t*)(ws + WS_WO) + (size_t)l * D * D, 0, base, gw, NGW, scr, c.lane);
    }
    for (int i = 0; i < 2; ++i) {
        conv_mat(inp(c, I_FW1) + (size_t)i * D * FF, D, FF, (bf16_t*)(ws + WS_W13D) + (size_t)i * 2 * FF * D, 1, base, gw, NGW, scr, c.lane);
        conv_mat(inp(c, I_FW3) + (size_t)i * D * FF, D, FF, (bf16_t*)(ws + WS_W13D) + (size_t)i * 2 * FF * D, 2, base, gw, NGW, scr, c.lane);
        conv_mat(inp(c, I_FW2) + (size_t)i * FF * D, FF, D, (bf16_t*)(ws + WS_W2D) + (size_t)i * D * FF, 0, base, gw, NGW, scr, c.lane);
    }
    for (int ie = 0; ie < 2 * NE; ++ie) {
        conv_mat(inp(c, I_MW1) + (size_t)ie * D * FF, D, FF, (bf16_t*)(ws + WS_W13M) + (size_t)ie * 2 * FF * D, 1, base, gw, NGW, scr, c.lane);
        conv_mat(inp(c, I_MW3) + (size_t)ie * D * FF, D, FF, (bf16_t*)(ws + WS_W13M) + (size_t)ie * 2 * FF * D, 2, base, gw, NGW, scr, c.lane);
        conv_mat(inp(c, I_MW2) + (size_t)ie * FF * D, FF, D, (bf16_t*)(ws + WS_W2M) + (size_t)ie * D * FF, 0, base, gw, NGW, scr, c.lane);
    }
}

__device__ __forceinline__ void ph_mod(const Ctx& c0) {
    const Ctx c = mk_ctx(c0.lds, c0.ws);
    float* mod = (float*)(c.ws + WS_MOD);
    LAS float* s = (LAS float*)c.lds; LAS float* part = s + 5 * 1024;
    const float* cin = inp(c, I_C); const float* cctx = inp(c, I_CCTX); const float* wmod = inp(c, I_WMOD); const float* bmod = inp(c, I_BMOD);
    for (int i = c.tid; i < 5 * 1024; i += NTHR) { const int r = i >> 10, k = i & 1023; const float v = r < 4 ? cin[r * 1024 + k] : cctx[k]; s[i] = v * sigmoidf_(v); }
    __syncthreads();
    for (int unit = c.bid; unit < DEPTH * 96; unit += c.G) {
        const int l = unit / 96, j0 = (unit % 96) * 64;
        const float* w = wmod + (size_t)l * D * 6144 + j0 + c.lane;
        float acc[5] = {0.f, 0.f, 0.f, 0.f, 0.f};
        const int kb = c.wave * 128;
#pragma unroll 32
        for (int k = 0; k < 128; ++k) { const float wv = w[(size_t)(kb + k) * 6144];
#pragma unroll
            for (int r = 0; r < 5; ++r) acc[r] += s[r * 1024 + kb + k] * wv; }
#pragma unroll
        for (int r = 0; r < 5; ++r) part[(c.wave * 5 + r) * 64 + c.lane] = acc[r];
        __syncthreads();
        if (c.tid < 320) { const int r = c.tid >> 6, ln = c.tid & 63; float sum = 0.f;
#pragma unroll
            for (int w8 = 0; w8 < 8; ++w8) sum += part[(w8 * 5 + r) * 64 + ln];
            mod[(size_t)(l * 5 + r) * 6144 + j0 + ln] = sum + bmod[l * 6144 + j0 + ln]; }
        __syncthreads();
    }
}

__device__ __forceinline__ void ph_filt(const Ctx& c0) {
    const Ctx c = mk_ctx(c0.lds, c0.ws);
    const float* hb1 = inp(c, I_HB1); const float* hw1 = inp(c, I_HW1); const float* hb2 = inp(c, I_HB2); const float* hw2 = inp(c, I_HW2); const float* hfreq = inp(c, I_HFREQ); const float* hw3 = inp(c, I_HW3);
    LAS float* zb = (LAS float*)c.lds;
    LAS float* a1 = zb + 16 * 36;
    LAS float* a2 = a1 + 16 * 64;
    const float MINDEC = -3.0701134573253945f, MAXDEC = -15.350567286626973f;
    for (int unit = c.bid; unit < DEPTH * 272; unit += c.G) {
        const int l = unit / 272, uu = unit % 272;
        const int L = uu < 256 ? 4096 : 256, p0 = uu < 256 ? uu * 16 : (uu - 256) * 16;
        for (int i = c.tid; i < 16 * 33; i += NTHR) { const int p = i / 33, q = i % 33; const int pos = p0 + p; float v;
            if (q == 0) v = (float)pos / (float)(L - 1);
            else { const int j = (q - 1) & 15; const double band = 1e-4 + (double)j * ((15.0 - 1e-4) / 15.0); double rev = (double)pos * band / (double)L; rev -= floor(rev);
                v = q <= 16 ? __builtin_amdgcn_cosf((float)rev) : -__builtin_amdgcn_sinf((float)rev); }
            zb[p * 36 + q] = v; }
        __syncthreads();
        for (int i = c.tid; i < 16 * 64; i += NTHR) { const int p = i >> 6, j = i & 63; float s = hb1[l * 64 + j];
            const float* w = hw1 + (size_t)l * 33 * 64 + j;
            for (int q = 0; q < 33; ++q) s += zb[p * 36 + q] * w[q * 64];
            a1[p * 64 + j] = sin_rad(hfreq[l * 128 + j] * s); }
        __syncthreads();
        for (int i = c.tid; i < 16 * 64; i += NTHR) { const int p = i >> 6, j = i & 63; float s = hb2[l * 64 + j];
            const float* w = hw2 + (size_t)l * 64 * 64 + j;
            for (int q = 0; q < 64; ++q) s += a1[p * 64 + q] * w[q * 64];
            a2[p * 64 + j] = sin_rad(hfreq[l * 128 + 64 + j] * s); }
        __syncthreads();
        {
            float acc0[16], acc1[16];
#pragma unroll
            for (int p = 0; p < 16; ++p) { acc0[p] = 0.f; acc1[p] = 0.f; }
            const float* w3 = hw3 + (size_t)l * 64 * 1024 + c.tid;
            for (int k = 0; k < 64; ++k) { const float wa = w3[k * 1024], wb = w3[k * 1024 + 512];
#pragma unroll
                for (int p = 0; p < 16; ++p) { const float av = a2[p * 64 + k]; acc0[p] += av * wa; acc1[p] += av * wb; } }
            bf16_t* hro = uu < 256 ? (bf16_t*)(c.ws + WS_HRL) + ((size_t)(l * 2) * 512 + c.tid) * (4096 + 64) : (bf16_t*)(c.ws + WS_HRC) + ((size_t)(l * 2) * 512 + c.tid) * (256 + 64);
            const size_t ostride = (size_t)512 * (L + 64);
            float f0[16], f1[16];
            const float r0 = fabsf(MINDEC + (float)c.tid * ((MAXDEC - MINDEC) / 1023.f)), r1 = fabsf(MINDEC + (float)(c.tid + 512) * ((MAXDEC - MINDEC) / 1023.f));
#pragma unroll
            for (int p = 0; p < 16; ++p) { const int pos = p0 + p; const float dist = fabsf((float)(pos - L / 2)) * (2.f / (float)L);
                f0[p] = acc0[p] * (__expf(-dist * r0) + 0.05f); f1[p] = acc1[p] * (__expf(-dist * r1) + 0.05f); }
            {   u32x4 w0, w1, v0, v1;
                w0.x = cvt_pk_bf16(f0[15], f0[14]); w0.y = cvt_pk_bf16(f0[13], f0[12]); w0.z = cvt_pk_bf16(f0[11], f0[10]); w0.w = cvt_pk_bf16(f0[9], f0[8]);
                w1.x = cvt_pk_bf16(f0[7], f0[6]); w1.y = cvt_pk_bf16(f0[5], f0[4]); w1.z = cvt_pk_bf16(f0[3], f0[2]); w1.w = cvt_pk_bf16(f0[1], f0[0]);
                v0.x = cvt_pk_bf16(f1[15], f1[14]); v0.y = cvt_pk_bf16(f1[13], f1[12]); v0.z = cvt_pk_bf16(f1[11], f1[10]); v0.w = cvt_pk_bf16(f1[9], f1[8]);
                v1.x = cvt_pk_bf16(f1[7], f1[6]); v1.y = cvt_pk_bf16(f1[5], f1[4]); v1.z = cvt_pk_bf16(f1[3], f1[2]); v1.w = cvt_pk_bf16(f1[1], f1[0]);
                bf16_t* d0 = hro + (L + 16 - p0); bf16_t* d1 = d0 + ostride;
                *(u32x4*)d0 = w0; *(u32x4*)(d0 + 8) = w1; *(u32x4*)d1 = v0; *(u32x4*)(d1 + 8) = v1;
                const u32x4 z4 = (u32x4){0u, 0u, 0u, 0u};
                if (p0 == 0) { for (int k = 0; k < 4; ++k) { *(u32x4*)(hro + L + 32 + 8 * k) = z4; *(u32x4*)(hro + ostride + L + 32 + 8 * k) = z4; } }
                if (p0 == L - 16) { for (int k = 0; k < 4; ++k) { *(u32x4*)(hro + 8 * k) = z4; *(u32x4*)(hro + ostride + 8 * k) = z4; } } }
        }
        __syncthreads();
    }
}

struct MoeComb { const int* route; const float* rwt; const bf16_t* y; const float* gate; };
__device__ __forceinline__ void moe_combine_row(const MoeComb& mc, const LAS unsigned* offs, int row, int b, int lane, f32x4 (&v)[4]) {
    const int e1 = mc.route[(size_t)row * 4 + 0], p1 = mc.route[(size_t)row * 4 + 1], e2 = mc.route[(size_t)row * 4 + 2], p2 = mc.route[(size_t)row * 4 + 3];
    const float w1 = mc.rwt[(size_t)row * 2], w2 = mc.rwt[(size_t)row * 2 + 1];
    const size_t s1 = (size_t)offs[e1] + p1, s2 = (size_t)offs[e2] + p2;
    const float* gt = mc.gate + (size_t)b * 6144;
#pragma unroll
    for (int j = 0; j < 4; ++j) { const int k0 = 4 * (lane + 64 * j);
        const u32x2 a = *(const u32x2*)(mc.y + s1 * D + k0), bq = *(const u32x2*)(mc.y + s2 * D + k0); const f32x4 g4 = *(const f32x4*)(gt + k0);
        v[j][0] += g4[0] * (w1 * bflo(a.x) + w2 * bflo(bq.x)); v[j][1] += g4[1] * (w1 * bfhi(a.x) + w2 * bfhi(bq.x));
        v[j][2] += g4[2] * (w1 * bflo(a.y) + w2 * bflo(bq.y)); v[j][3] += g4[3] * (w1 * bfhi(a.y) + w2 * bfhi(bq.y)); }
}
__device__ __forceinline__ void moe_offsets(const Ctx& c, int i, LAS unsigned* offs) {
    if (c.tid == 0) { const unsigned* cnt = (const unsigned*)(c.ws + WS_CTL) + CW_CNT + 64 * i; unsigned o = 0;
        for (int e = 0; e < 8; ++e) { offs[e] = o; o += (cnt[e] + 255u) & ~255u; } offs[8] = o; }
}
__device__ __forceinline__ void ph_norm(const Ctx& c0, int l, int which) {
    const Ctx c = mk_ctx(c0.lds, c0.ws);
    float* xres = (float*)(c.ws + WS_X); bf16_t* h = (bf16_t*)(c.ws + WS_H);
    const float* mod = (const float*)(c.ws + WS_MOD) + (size_t)l * 5 * 6144;
    const float* gp = (which == 0 ? inp(c, I_N1G) : inp(c, I_N2G)) + l * D;
    const bool first = (l == 0 && which == 0), route = (which == 1 && (l & 1));
    const int comb = (which == 0 && l >= 1 && ((l - 1) & 1)) ? ((l - 1) >> 1) : -1;
    const float* router = inp(c, I_ROUTER) + (size_t)(l >> 1) * D * NE;
    int* routeb = (int*)(c.ws + WS_ROUTE); float* rwt = (float*)(c.ws + WS_RWT); int* tokenof = (int*)(c.ws + WS_TOK);
    const MoeComb mc{routeb, rwt, (const bf16_t*)(c.ws + WS_Y), (const float*)(c.ws + WS_MOD) + (size_t)(l > 0 ? l - 1 : 0) * 5 * 6144 + 5 * 1024};
    LAS unsigned* lcnt = (LAS unsigned*)c.lds; LAS unsigned* gbase = lcnt + 16; LAS unsigned* offs = lcnt + 32; LAS int* pend = (LAS int*)(c.lds + 256);
    if (c.tid < 8) lcnt[c.tid] = 0u;
    if (comb >= 0) moe_offsets(c, comb, offs);
    __syncthreads();
    const float* xin = inp(c, I_X); const float* ctxin = inp(c, I_CTX);
    int nrows = 0;
    for (int row = c.bid * NWAVES + c.wave; row < T; row += c.G * NWAVES, ++nrows) {
        const float* src = first ? (row < TL ? xin + (size_t)row * D : ctxin + (size_t)(row - TL) * D) : xres + (size_t)row * D;
        const int b = row < TL ? (row >> 12) : 4;
        const float* sh = mod + (size_t)b * 6144 + (which == 0 ? 0 : 3) * 1024; const float* sc = sh + 1024;
        f32x4 v[4]; float ss = 0.f;
#pragma unroll
        for (int j = 0; j < 4; ++j) v[j] = *(const f32x4*)(src + 4 * (c.lane + 64 * j));
        if (comb >= 0) moe_combine_row(mc, offs, row, b, c.lane, v);
#pragma unroll
        for (int j = 0; j < 4; ++j) ss += (v[j][0] * v[j][0] + v[j][1] * v[j][1]) + (v[j][2] * v[j][2] + v[j][3] * v[j][3]);
        ss = wave_sum(ss, c.lane);
        const float rstd = 1.f / sqrtf(ss * (1.f / D) + EPS);
        if (first || comb >= 0) {
#pragma unroll
            for (int j = 0; j < 4; ++j) *(f32x4*)(xres + (size_t)row * D + 4 * (c.lane + 64 * j)) = v[j];
        }
        float lg[8] = {0.f, 0.f, 0.f, 0.f, 0.f, 0.f, 0.f, 0.f};
#pragma unroll
        for (int j = 0; j < 4; ++j) { const int k0 = 4 * (c.lane + 64 * j);
            const f32x4 g4 = *(const f32x4*)(gp + k0), s4 = *(const f32x4*)(sc + k0), h4 = *(const f32x4*)(sh + k0);
            f32x4 o;
#pragma unroll
            for (int q = 0; q < 4; ++q) o[q] = v[j][q] * rstd * g4[q] * (1.f + s4[q]) + h4[q];
            u32x2 w; w.x = cvt_pk_bf16(o[0], o[1]); w.y = cvt_pk_bf16(o[2], o[3]);
            *(u32x2*)(h + (size_t)row * D + k0) = w;
            if (route) {
#pragma unroll
                for (int q = 0; q < 4; ++q) { const f32x4 ra = *(const f32x4*)(router + (size_t)(k0 + q) * 8), rb = *(const f32x4*)(router + (size_t)(k0 + q) * 8 + 4);
                    lg[0] += o[q] * ra[0]; lg[1] += o[q] * ra[1]; lg[2] += o[q] * ra[2]; lg[3] += o[q] * ra[3];
                    lg[4] += o[q] * rb[0]; lg[5] += o[q] * rb[1]; lg[6] += o[q] * rb[2]; lg[7] += o[q] * rb[3]; }
            }
        }
        if (route) {
#pragma unroll
            for (int e = 0; e < 8; ++e) lg[e] = wave_sum(lg[e], c.lane);
            int i1 = 0; float v1 = lg[0];
#pragma unroll
            for (int e = 1; e < 8; ++e) if (lg[e] > v1) { v1 = lg[e]; i1 = e; }
            int i2 = -1; float v2 = -3.0e38f;
#pragma unroll
            for (int e = 0; e < 8; ++e) if (e != i1 && lg[e] > v2) { v2 = lg[e]; i2 = e; }
            const float w1 = 1.f / (1.f + __expf(v2 - v1)), w2 = 1.f - w1;
            if (c.lane == 0) {
                const unsigned lp1 = __hip_atomic_fetch_add(lcnt + i1, 1u, __ATOMIC_RELAXED, __HIP_MEMORY_SCOPE_WORKGROUP), lp2 = __hip_atomic_fetch_add(lcnt + i2, 1u, __ATOMIC_RELAXED, __HIP_MEMORY_SCOPE_WORKGROUP);
                LAS int* pe = pend + (c.wave * 16 + nrows) * 4; pe[0] = row; pe[1] = i1 | (i2 << 8); pe[2] = (int)lp1; pe[3] = (int)lp2;
                rwt[(size_t)row * 2] = w1; rwt[(size_t)row * 2 + 1] = w2; }
        }
    }
    if (route) {
        __syncthreads();
        if (c.tid < 8) gbase[c.tid] = __hip_atomic_fetch_add((unsigned*)(c.ws + WS_CTL) + CW_CNT + 64 * (l >> 1) + c.tid, lcnt[c.tid], __ATOMIC_RELAXED, __HIP_MEMORY_SCOPE_AGENT);
        __syncthreads();
        if (c.lane < nrows) { const LAS int* pe = pend + (c.wave * 16 + c.lane) * 4; const int row = pe[0], e1 = pe[1] & 255, e2 = pe[1] >> 8;
            const int p1 = (int)gbase[e1] + pe[2], p2 = (int)gbase[e2] + pe[3];
            tokenof[(size_t)e1 * T + p1] = row; tokenof[(size_t)e2 * T + p2] = row;
            routeb[(size_t)row * 4 + 0] = e1; routeb[(size_t)row * 4 + 1] = p1; routeb[(size_t)row * 4 + 2] = e2; routeb[(size_t)row * 4 + 3] = p2; }
    }
    __syncthreads();
}

__device__ __forceinline__ void ph_sc(const Ctx& c0, int l) {
    const Ctx c = mk_ctx(c0.lds, c0.ws);
    const bf16_t* P = (const bf16_t*)(c.ws + WS_P); bf16_t* uT = (bf16_t*)(c.ws + WS_B); bf16_t* VT = (bf16_t*)(c.ws + WS_VT);
    const float* cw = inp(c, I_HCW) + (size_t)l * 3 * 1536; const float* cb = inp(c, I_HCB) + (size_t)l * 1536;
    LAS unsigned char* scr = c.lds + c.wave * 16384;
    for (int tile = c.bid * NWAVES + c.wave; tile < (T / 64) * 32; tile += c.G * NWAVES) {
        const int rt = tile / 32, row0 = rt * 64, ct = tile % 32; const bool isv = ct >= 24;
        const int ch0 = isv ? (ct - 24) * 64 : ct * 64, scol = isv ? PV + ch0 : PHY + ch0; bf16_t* dst = isv ? VT : uT;
        const int tpos = row0 < TL ? (row0 & 4095) : ((row0 - TL) & 255), Ls = row0 < TL ? 4096 : 256;
        for (int idx = c.lane; idx < 66 * 8; idx += 64) { const int rr = idx >> 3, ck = idx & 7; const int grow = row0 - 1 + rr;
            const bool ok = !((rr == 0 && tpos == 0) || (rr == 65 && tpos + 64 == Ls));
            u32x4 v = (u32x4){0u, 0u, 0u, 0u};
            if (ok) v = *(const u32x4*)(P + (size_t)grow * PW + scol + ck * 8);
            LAS unsigned* d = (LAS unsigned*)(scr + rr * 132 + ck * 16); d[0] = v.x; d[1] = v.y; d[2] = v.z; d[3] = v.w; }
        LDS_WAIT(); asm volatile("" ::: "memory");
        const int ch = ch0 + c.lane; const float w0 = isv ? 0.f : cw[ch], w1 = isv ? 1.f : cw[1536 + ch], w2 = isv ? 0.f : cw[3072 + ch], bb = isv ? 0.f : cb[ch];
        unsigned ow[32];
        { float prev = bf2f(*(const LAS unsigned short*)(scr + 0 * 132 + c.lane * 2)), cur = bf2f(*(const LAS unsigned short*)(scr + 1 * 132 + c.lane * 2)); float o0 = 0.f;
#pragma unroll
          for (int r = 0; r < 64; ++r) { const float nxt = bf2f(*(const LAS unsigned short*)(scr + (r + 2) * 132 + c.lane * 2));
              const float o = w0 * prev + w1 * cur + w2 * nxt + bb; prev = cur; cur = nxt;
              if (r & 1) ow[r >> 1] = cvt_pk_bf16(o0, o); else o0 = o; } }
        LDS_WAIT(); asm volatile("" ::: "memory");
#pragma unroll
        for (int k = 0; k < 8; ++k) { u32x4 v; v.x = ow[4 * k]; v.y = ow[4 * k + 1]; v.z = ow[4 * k + 2]; v.w = ow[4 * k + 3]; *(LAS u32x4*)(scr + c.lane * 144 + k * 16) = v; }
        LDS_WAIT(); asm volatile("" ::: "memory");
#pragma unroll
        for (int k = 0; k < 8; ++k) { const int cc = (c.lane >> 3) + 8 * k, ck = c.lane & 7; const u32x4 v = *(const LAS u32x4*)(scr + cc * 144 + ck * 16);
            *(u32x4*)(dst + (size_t)(ch0 + cc) * T + row0 + ck * 8) = v; }
        LDS_WAIT(); asm volatile("" ::: "memory");
    }
}

constexpr int HY_HR_OFF = 512, HY_U_OFF = HY_HR_OFF + 66560, HY_ZB_OFF = HY_U_OFF + 4 * 8208;
template <int L, bool DUAL>
__device__ __forceinline__ void hy_span(LAS unsigned char* lds, int nsteps, int aaddr, int ubase, int sX, int sY, f32x16& accX, f32x16& accY) {
#define HY_BADDR(sv) (((unsigned)(sv) <= (unsigned)(L - 16)) ? ubase + 2 * (sv) : HY_ZB_OFF)
#define HY_LD(av, xv, yv, kk) do { av = *(const LAS bf16x8*)(lds + aaddr - 256 * (kk)); xv = *(const LAS bf16x8*)(lds + HY_BADDR(sX - 16 * (kk))); \
        if (DUAL) yv = *(const LAS bf16x8*)(lds + HY_BADDR(sY - 16 * (kk))); } while (0)
    bf16x8 a0, a1, x0, x1, y0 = {}, y1 = {}, pa0, pa1, px0, px1, py0 = {}, py1 = {};
    HY_LD(a0, x0, y0, 0); HY_LD(a1, x1, y1, 1);
    int k = 0;
    for (; k + 2 <= nsteps; k += 2) {
        aaddr -= 512; sX -= 32; sY -= 32;
        HY_LD(pa0, px0, py0, 0);
        accX = __builtin_amdgcn_mfma_f32_32x32x16_bf16(a0, x0, accX, 0, 0, 0); if (DUAL) accY = __builtin_amdgcn_mfma_f32_32x32x16_bf16(a0, y0, accY, 0, 0, 0);
        HY_LD(pa1, px1, py1, 1);
        accX = __builtin_amdgcn_mfma_f32_32x32x16_bf16(a1, x1, accX, 0, 0, 0); if (DUAL) accY = __builtin_amdgcn_mfma_f32_32x32x16_bf16(a1, y1, accY, 0, 0, 0);
        a0 = pa0; x0 = px0; y0 = py0; a1 = pa1; x1 = px1; y1 = py1;
    }
    if (k < nsteps) { accX = __builtin_amdgcn_mfma_f32_32x32x16_bf16(a0, x0, accX, 0, 0, 0); if (DUAL) accY = __builtin_amdgcn_mfma_f32_32x32x16_bf16(a0, y0, accY, 0, 0, 0); }
#undef HY_LD
#undef HY_BADDR
}
template <int L>
__device__ __forceinline__ void hy_unit(const Ctx& c, int l, int ch, const float* hbias) {
    constexpr int H = L / 2, NG = L / 256, LP = L + 64, NW = L / 8 + 8, ROWB = 2 * L + 16;
    LAS unsigned char* lds = c.lds;
    const bf16_t* uT = (const bf16_t*)(c.ws + WS_B); bf16_t* ohy = (bf16_t*)(c.ws + WS_OHY);
    const int seq0 = (L == 4096) ? 0 : TL;
    const bf16_t* hrbase = (L == 4096) ? (const bf16_t*)(c.ws + WS_HRL) : (const bf16_t*)(c.ws + WS_HRC);
    int gA, gB;
    if (NG == 16) { gA = c.wave < 4 ? c.wave : 4 + c.wave; gB = c.wave < 4 ? 7 - c.wave : 19 - c.wave; } else { gA = c.wave == 0 ? 0 : -1; gB = -1; }
    const int n = c.lane & 31, g = c.lane >> 5, tbl = n >> 2, b = n & 3;
    const int loA = gA < 0 ? 1 << 30 : max(-H - 16, 256 * gA - (L - 16)), hiA = gA < 0 ? -(1 << 30) : min(H, 256 * gA + 224);
    const int loB = gB < 0 ? 1 << 30 : max(-H - 16, 256 * gB - (L - 16)), hiB = gB < 0 ? -(1 << 30) : min(H, 256 * gB + 224);
    const int dlo = min(loA, loB), dhi = max(hiA, hiB);
    unsigned zreg[2][4][2];
    for (int o = 0; o < 2; ++o) {
        const bf16_t* hr = hrbase + ((size_t)(l * 2 + o) * 512 + ch) * LP;
        for (int w = c.tid; w < NW; w += NTHR) {
            u32x4 A4 = (u32x4){0u, 0u, 0u, 0u}; if (w > 0) A4 = *(const u32x4*)(hr + 8 * (w - 1));
            const u32x4 B4 = *(const u32x4*)(hr + 8 * w);
            const unsigned Dd[8] = {A4.x, A4.y, A4.z, A4.w, B4.x, B4.y, B4.z, B4.w};
#pragma unroll
            for (int q = 0; q < 8; ++q) { u32x4 ov;
                if ((q & 1) == 0) { const int j = (8 - q) / 2; ov.x = Dd[j]; ov.y = Dd[j + 1]; ov.z = Dd[j + 2]; ov.w = Dd[j + 3]; }
                else { const int j = (7 - q) / 2; ov.x = __builtin_amdgcn_alignbit(Dd[j + 1], Dd[j], 16); ov.y = __builtin_amdgcn_alignbit(Dd[j + 2], Dd[j + 1], 16);
                       ov.z = __builtin_amdgcn_alignbit(Dd[j + 3], Dd[j + 2], 16); ov.w = __builtin_amdgcn_alignbit(Dd[j + 4], Dd[j + 3], 16); }
                *(LAS u32x4*)(lds + HY_HR_OFF + (8 * w + q) * 16) = ov; }
        }
        if (o == 0) {
            for (int idx = c.tid; idx < 4 * (L / 8); idx += NTHR) { const int bb = idx / (L / 8), wq = idx % (L / 8);
                *(LAS u32x4*)(lds + HY_U_OFF + bb * ROWB + wq * 16) = *(const u32x4*)(uT + (size_t)ch * T + seq0 + bb * L + wq * 8); }
            if (c.tid < 16) *(LAS unsigned*)(lds + HY_ZB_OFF + c.tid * 4) = 0u;
        } else {
#pragma unroll
            for (int gi = 0; gi < 2; ++gi) { const int G = gi == 0 ? gA : gB; if (G >= 0) {
#pragma unroll
                for (int rq = 0; rq < 4; ++rq) { const int t = 32 * (8 * G + tbl) + 8 * rq + 4 * g;
                    u32x2 zz; zz.x = zreg[gi][rq][0]; zz.y = zreg[gi][rq][1]; *(LAS u32x2*)(lds + HY_U_OFF + b * ROWB + 2 * t) = zz; } } }
        }
        __syncthreads();
        f32x16 accA, accB;
#pragma unroll
        for (int r = 0; r < 16; ++r) { accA[r] = 0.f; accB[r] = 0.f; }
        {
            const int qq = (n + 1) & 7, ubase = HY_U_OFF + b * ROWB + 16 * g;
#define HY_AADDR(d) (HY_HR_OFF + (8 * ((H + 31 - (d) - n + 8 * g + qq) >> 3) + qq) * 16)
#define HY_S0(G, d) (32 * (8 * (G) + tbl) - (d))
            if (gB < 0) { if (gA >= 0) hy_span<L, false>(lds, (hiA - loA) / 16 + 1, HY_AADDR(loA), ubase, HY_S0(gA, loA), 0, accA, accB); }
            else {
                const int dS = max(loA, loB), dE = min(hiA, hiB);
                if (loA < dS) hy_span<L, false>(lds, (dS - loA) / 16, HY_AADDR(loA), ubase, HY_S0(gA, loA), 0, accA, accB);
                else if (loB < dS) hy_span<L, false>(lds, (dS - loB) / 16, HY_AADDR(loB), ubase, HY_S0(gB, loB), 0, accB, accA);
                hy_span<L, true>(lds, (dE - dS) / 16 + 1, HY_AADDR(dS), ubase, HY_S0(gA, dS), HY_S0(gB, dS), accA, accB);
                if (hiA > dE) hy_span<L, false>(lds, (hiA - dE) / 16, HY_AADDR(dE + 16), ubase, HY_S0(gA, dE + 16), 0, accA, accB);
                else if (hiB > dE) hy_span<L, false>(lds, (hiB - dE) / 16, HY_AADDR(dE + 16), ubase, HY_S0(gB, dE + 16), 0, accB, accA);
            }
#undef HY_AADDR
#undef HY_S0
        }
        const float bias = hbias[(l * 2 + o) * 512 + ch];
#pragma unroll
        for (int gi = 0; gi < 2; ++gi) { const int G = gi == 0 ? gA : gB; if (G >= 0) {
#pragma unroll
            for (int rq = 0; rq < 4; ++rq) { const int t = 32 * (8 * G + tbl) + 8 * rq + 4 * g;
                const u32x2 uv = *(const LAS u32x2*)(lds + HY_U_OFF + b * ROWB + 2 * t);
                const size_t grow = (size_t)seq0 + b * L + t;
                const u32x2 xv = *(const u32x2*)(uT + (size_t)((o == 0 ? 512 : 1024) + ch) * T + grow);
                float y[4];
#pragma unroll
                for (int k = 0; k < 4; ++k) y[k] = gi == 0 ? accA[4 * rq + k] : accB[4 * rq + k];
                const float r0 = bflo(xv.x) * (y[0] + bias * bflo(uv.x)), r1 = bfhi(xv.x) * (y[1] + bias * bfhi(uv.x));
                const float r2 = bflo(xv.y) * (y[2] + bias * bflo(uv.y)), r3 = bfhi(xv.y) * (y[3] + bias * bfhi(uv.y));
                const unsigned p0 = cvt_pk_bf16(r0, r1), p1 = cvt_pk_bf16(r2, r3);
                if (o == 0) { zreg[gi][rq][0] = p0; zreg[gi][rq][1] = p1; }
                else { bf16_t* op = ohy + grow * 512 + ch; op[0] = (bf16_t)(p0 & 0xffffu); op[512] = (bf16_t)(p0 >> 16); op[1024] = (bf16_t)(p1 & 0xffffu); op[1536] = (bf16_t)(p1 >> 16); } } } }
        __syncthreads();
    }
}
__device__ __forceinline__ void ph_hyena(const Ctx& c0, int l) {
    const Ctx c = mk_ctx(c0.lds, c0.ws);
    const float* hbias = inp(c, I_HBIAS);
    for (int unit = c.bid; unit < HYW; unit += c.G) { hy_unit<4096>(c, l, unit, hbias); hy_unit<256>(c, l, unit, hbias); }
}

constexpr int ATT_RPB_OFF = 1024, ATT_VT_OFF = ATT_RPB_OFF + 8 * 15 * 32 * 4, ATT_VT_BYTES = 64 * 72;
template <int MODE>
__device__ __forceinline__ void att_block(const bf16_t* P, const bf16_t* VT, LAS unsigned char* lds, LAS unsigned char* vt, int lane, int n, int h, int head,
                                          int tokk, int ctok, int tabaddr, int vb, const bf16x8 (&qf)[4], f32x16& ot0, f32x16& ot1, float& m, float& lsum) {
    bf16x8 kf[4];
#pragma unroll
    for (int ks = 0; ks < 4; ++ks) kf[ks] = *(const bf16x8*)(P + (size_t)tokk * PW + PK + head * 64 + 16 * ks + 8 * h);
    u32x2 vr[8];
#pragma unroll
    for (int it = 0; it < 8; ++it) vr[it] = *(const u32x2*)(VT + (size_t)(head * 64 + it * 8 + (lane >> 3)) * T + ctok);
    f32x16 st;
#pragma unroll
    for (int r = 0; r < 16; ++r) st[r] = 0.f;
#pragma unroll
    for (int ks = 0; ks < 4; ++ks) st = __builtin_amdgcn_mfma_f32_32x32x16_bf16(kf[ks], qf[ks], st, 0, 0, 0);
    const float SC = 0.18033688011112042f;
    float sv[16];
#pragma unroll
    for (int r = 0; r < 16; ++r) {
        if (MODE == 2) sv[r] = st[r] * SC;
        else { const int cr = MODE == 0 ? 8 * (r >> 2) + (r & 3) : (r & 3), imm = MODE == 0 ? cr * 4 : ((r >> 2) * 32 + (r & 3)) * 4;
            const float bias = *(const LAS float*)(lds + tabaddr + imm);
            const bool ok = (unsigned)(vb + cr) < 16u;
            sv[r] = ok ? st[r] * SC + bias : -1.0e30f; }
    }
    float bm = sv[0];
#pragma unroll
    for (int r = 1; r < 16; ++r) bm = fmaxf(bm, sv[r]);
    bm = fmaxf(bm, __int_as_float(__builtin_amdgcn_ds_bpermute((lane ^ 32) << 2, __float_as_int(bm))));
    const float mn = fmaxf(m, bm), alpha = __builtin_amdgcn_exp2f(m - mn); m = mn;
    float psum = 0.f;
#pragma unroll
    for (int r = 0; r < 16; ++r) { const float pv = __builtin_amdgcn_exp2f(sv[r] - mn); psum += pv; sv[r] = pv; }
    lsum = lsum * alpha + psum;
#pragma unroll
    for (int r = 0; r < 16; ++r) { ot0[r] *= alpha; ot1[r] *= alpha; }
    bf16x8 pb[2];
#pragma unroll
    for (int s2 = 0; s2 < 2; ++s2) { u32x4 w; w.x = cvt_pk_bf16(sv[8 * s2], sv[8 * s2 + 1]); w.y = cvt_pk_bf16(sv[8 * s2 + 2], sv[8 * s2 + 3]);
        w.z = cvt_pk_bf16(sv[8 * s2 + 4], sv[8 * s2 + 5]); w.w = cvt_pk_bf16(sv[8 * s2 + 6], sv[8 * s2 + 7]); pb[s2] = __builtin_bit_cast(bf16x8, w); }
#pragma unroll
    for (int it = 0; it < 8; ++it) *(LAS u32x2*)(vt + (it * 8 + (lane >> 3)) * 72 + (lane & 7) * 8) = vr[it];
#pragma unroll
    for (int s2 = 0; s2 < 2; ++s2) {
        { const u32x2 a = *(const LAS u32x2*)(vt + n * 72 + (4 * s2 + h) * 8), bq = *(const LAS u32x2*)(vt + n * 72 + (4 * s2 + 2 + h) * 8);
          u32x4 w; w.x = a.x; w.y = a.y; w.z = bq.x; w.w = bq.y; ot0 = __builtin_amdgcn_mfma_f32_32x32x16_bf16(__builtin_bit_cast(bf16x8, w), pb[s2], ot0, 0, 0, 0); }
        { const u32x2 a = *(const LAS u32x2*)(vt + (32 + n) * 72 + (4 * s2 + h) * 8), bq = *(const LAS u32x2*)(vt + (32 + n) * 72 + (4 * s2 + 2 + h) * 8);
          u32x4 w; w.x = a.x; w.y = a.y; w.z = bq.x; w.w = bq.y; ot1 = __builtin_amdgcn_mfma_f32_32x32x16_bf16(__builtin_bit_cast(bf16x8, w), pb[s2], ot1, 0, 0, 0); }
    }
}
constexpr int ATT_UNITS = 4096 + 256;
__device__ __forceinline__ void ph_attn(const Ctx& c0, int l) {
    const Ctx c = mk_ctx(c0.lds, c0.ws);
    const bf16_t* P = (const bf16_t*)(c.ws + WS_P); const bf16_t* VT = (const bf16_t*)(c.ws + WS_VT); bf16_t* oatt = (bf16_t*)(c.ws + WS_OATT);
    const float* rpb = inp(c, I_RPB) + (size_t)l * 8 * 15 * 31;
    LAS unsigned char* lds = c.lds;
    for (int i = c.tid; i < 8 * 15 * 32; i += NTHR) { const int hd = i / 480, rem = i % 480, dr = rem >> 5, dc = rem & 31;
        *(LAS float*)(lds + ATT_RPB_OFF + i * 4) = dc < 31 ? rpb[(hd * 15 + dr) * 31 + dc] * 1.4426950408889634f : 0.f; }
    __syncthreads();
    LAS unsigned char* vt = lds + ATT_VT_OFF + c.wave * ATT_VT_BYTES;
    const int lane = c.lane, n = lane & 31, h = lane >> 5;
    for (int u = c.bid * NWAVES + c.wave; u < ATT_UNITS; u += c.G * NWAVES) {
        const bool lat = u < 4096;
        int b, head, r = 0, hf = 0, tokq;
        if (lat) { hf = u & 1; r = (u >> 1) & 63; head = (u >> 7) & 7; b = u >> 10; tokq = b * 4096 + r * 64 + 32 * hf + n; }
        else { const int uu = u - 4096; head = (uu >> 3) & 7; b = uu >> 6; tokq = TL + b * 256 + 32 * (uu & 7) + n; }
        bf16x8 qf[4];
#pragma unroll
        for (int ks = 0; ks < 4; ++ks) qf[ks] = *(const bf16x8*)(P + (size_t)tokq * PW + PQ + head * 64 + 16 * ks + 8 * h);
        f32x16 ot0, ot1;
#pragma unroll
        for (int q = 0; q < 16; ++q) { ot0[q] = 0.f; ot1[q] = 0.f; }
        float m = -1.0e30f, lsum = 0.f;
        if (lat) {
            const int r0 = min(max(r - 4, 0), 56), lo = hf ? 24 : 0, qc = 32 * hf + n, c0q = min(max(qc - 8, 0), 48);
            for (int kb = 0; kb < 8; ++kb) {
                const int base = b * 4096 + (r0 + kb) * 64 + lo, kx = lo + 4 * h;
                const int tabaddr = ATT_RPB_OFF + (((head * 15 + (r0 + kb - r + 7)) * 32) + kx - qc + 15) * 4;
                att_block<0>(P, VT, lds, vt, lane, n, h, head, base + n, base + 4 * (lane & 7), tabaddr, kx - c0q, qf, ot0, ot1, m, lsum);
            }
            for (int kb = 0; kb < 2; ++kb) {
                const int rowb = b * 4096 + (r0 + 4 * kb) * 64 + lo + 32, kx = lo + 32 + 4 * h, cc = lane & 7;
                const int tabaddr = ATT_RPB_OFF + (((head * 15 + (r0 + 4 * kb - r + 7)) * 32) + kx - qc + 15) * 4;
                att_block<1>(P, VT, lds, vt, lane, n, h, head, rowb + (n >> 3) * 64 + (n & 7), rowb + (cc >> 1) * 64 + 4 * (cc & 1), tabaddr, kx - c0q, qf, ot0, ot1, m, lsum);
            }
        }
        for (int kb = 0; kb < 8; ++kb) { const int base = TL + b * 256 + 32 * kb;
            att_block<2>(P, VT, lds, vt, lane, n, h, head, base + n, base + 4 * (lane & 7), 0, 0, qf, ot0, ot1, m, lsum); }
        const float ltot = lsum + __int_as_float(__builtin_amdgcn_ds_bpermute((lane ^ 32) << 2, __float_as_int(lsum)));
        const float inv = 1.f / ltot;
        bf16_t* op = oatt + (size_t)tokq * 512 + head * 64 + 4 * h;
#pragma unroll
        for (int rq = 0; rq < 4; ++rq) {
            u32x2 w0, w1; w0.x = cvt_pk_bf16(ot0[4 * rq] * inv, ot0[4 * rq + 1] * inv); w0.y = cvt_pk_bf16(ot0[4 * rq + 2] * inv, ot0[4 * rq + 3] * inv);
            w1.x = cvt_pk_bf16(ot1[4 * rq] * inv, ot1[4 * rq + 1] * inv); w1.y = cvt_pk_bf16(ot1[4 * rq + 2] * inv, ot1[4 * rq + 3] * inv);
            *(u32x2*)(op + 8 * rq) = w0; *(u32x2*)(op + 32 + 8 * rq) = w1; }
    }
    __syncthreads();
}

__device__ __forceinline__ void ph_final(const Ctx& c0) {
    const Ctx c = mk_ctx(c0.lds, c0.ws);
    const float* xres = (const float*)(c.ws + WS_X); const float* gp = inp(c, I_FINALG); float* outp = (float*)inp(c, 30);
    const MoeComb mc{(const int*)(c.ws + WS_ROUTE), (const float*)(c.ws + WS_RWT), (const bf16_t*)(c.ws + WS_Y), (const float*)(c.ws + WS_MOD) + (size_t)(DEPTH - 1) * 5 * 6144 + 5 * 1024};
    LAS unsigned* offs = (LAS unsigned*)c.lds + 32;
    moe_offsets(c, 1, offs);
    __syncthreads();
    for (int row = c.bid * NWAVES + c.wave; row < TL; row += c.G * NWAVES) {
        const float* src = xres + (size_t)row * D; f32x4 v[4]; float ss = 0.f;
#pragma unroll
        for (int j = 0; j < 4; ++j) v[j] = *(const f32x4*)(src + 4 * (c.lane + 64 * j));
        moe_combine_row(mc, offs, row, row >> 12, c.lane, v);
#pragma unroll
        for (int j = 0; j < 4; ++j) ss += (v[j][0] * v[j][0] + v[j][1] * v[j][1]) + (v[j][2] * v[j][2] + v[j][3] * v[j][3]);
        ss = wave_sum(ss, c.lane);
        const float rstd = 1.f / sqrtf(ss * (1.f / D) + EPS);
#pragma unroll
        for (int j = 0; j < 4; ++j) { const int k0 = 4 * (c.lane + 64 * j); const f32x4 g4 = *(const f32x4*)(gp + k0); *(f32x4*)(outp + (size_t)row * D + k0) = v[j] * rstd * g4; }
    }
}

constexpr int MOE_OFF = 132096;
template <bool GATHER_> struct MoeOrder {
    static constexpr bool GATHER = GATHER_;
    int nM, nN, nwg, G, c; const char* A; const char* B; size_t astep, bstep, estep; const int* tokenof; const LAS unsigned* tab;
    __device__ void init(const void* A_, int lda, const void* B_, int ldb, size_t estep_bytes, int N, int G_, int c_, const int* tok, const LAS unsigned* tab_) {
        tab = tab_; nM = (int)((unsigned)__builtin_amdgcn_readfirstlane(tab[8]) >> 8); nN = N / pg8::BM; nwg = nM * nN; G = G_; c = c_; A = (const char*)A_; B = (const char*)B_;
        astep = (size_t)pg8::BM * lda * 2; bstep = (size_t)pg8::BM * ldb * 2; estep = estep_bytes; tokenof = tok; }
    __device__ bool next(int i, pg8::Unit& u) const {
        const long L = (long)i * G + c; if (L >= nwg) return false;
        int wgid = (int)L; { const int q = nwg / pg8::NXCD, r = nwg % pg8::NXCD, xcd = wgid % pg8::NXCD, off = wgid / pg8::NXCD; wgid = (xcd < r ? xcd * (q + 1) : r * (q + 1) + (xcd - r) * q) + off; }
        const int nig = pg8::WGM * nN, gid = wgid / nig, fm = gid * pg8::WGM, gsz = (nM - fm) < pg8::WGM ? (nM - fm) : pg8::WGM;
        u.pm = fm + ((wgid % nig) % gsz); u.pn = (wgid % nig) / gsz;
        const unsigned slot0 = (unsigned)u.pm << 8; int e = 0;
#pragma unroll
        for (int j = 1; j < 8; ++j) e += (slot0 >= (unsigned)__builtin_amdgcn_readfirstlane(tab[j])) ? 1 : 0;
        const unsigned pos0 = slot0 - (unsigned)__builtin_amdgcn_readfirstlane(tab[e]), cnt = (unsigned)__builtin_amdgcn_readfirstlane(tab[16 + e]);
        u.nvalid = cnt > pos0 ? (int)(cnt - pos0) : 0; u.tk = tokenof + (size_t)e * T + pos0;
        u.a = GATHER ? A : A + (size_t)u.pm * astep; u.b = B + (size_t)e * estep + (size_t)u.pn * bstep; return true;
    }
    __device__ __forceinline__ int arow(const pg8::Unit& u, int r) const { return r < u.nvalid ? u.tk[r] : 0; }
    __device__ __forceinline__ void a_ready(const pg8::Unit&) const {}
    __device__ __forceinline__ void done(const pg8::Unit&) const {}
};
__device__ __forceinline__ void moe_table(const Ctx& c, int i) {
    LAS unsigned* tab = (LAS unsigned*)(c.lds + MOE_OFF);
    if (c.tid == 0) { const unsigned* cnt = (const unsigned*)(c.ws + WS_CTL) + CW_CNT + 64 * i; unsigned o = 0;
        for (int e = 0; e < 8; ++e) { const unsigned ce = cnt[e]; tab[e] = o; tab[16 + e] = ce; o += (ce + 255u) & ~255u; } tab[8] = o; }
    __syncthreads();
}

#define XB_TMO      128
#define XB_XCNT(j)  (256  + 64 * (j))
#define XB_XSUB(j)  (1280 + 64 * (j))
#define XB_XGEN(j)  (2304 + 64 * (j))
#define XB_TOP      3328
#define XB_TOPGEN   3392
#define XCD_BAR_WORDS 3456
#define XB_SPIN_CAP (1u << 18)
__device__ __forceinline__ unsigned xb_ld(unsigned* p)              { return __hip_atomic_load(p, __ATOMIC_RELAXED, __HIP_MEMORY_SCOPE_AGENT); }
__device__ __forceinline__ unsigned xb_add(unsigned* p, unsigned v) { return __hip_atomic_fetch_add(p, v, __ATOMIC_RELAXED, __HIP_MEMORY_SCOPE_AGENT); }
__device__ __forceinline__ unsigned xb_xcc_id() { return (unsigned)__builtin_amdgcn_s_getreg((3 << 11) | 20) & 0xFu; }
#define XB_SPIN(cond, bar) do { unsigned _sp = 0; while (cond) { __builtin_amdgcn_s_sleep(1); \
    if ((++_sp & 255u) == 0u) { if (xb_ld(&(bar)[XB_TMO])) break; if (_sp > XB_SPIN_CAP) { atomicAdd(&(bar)[XB_TMO], 1u); break; } } } } while (0)
struct XcdBarrier { unsigned* bar; unsigned x; volatile LAS unsigned* st; };
__device__ __forceinline__ XcdBarrier xcd_barrier_post(unsigned* bar, volatile LAS unsigned* st) {
    XcdBarrier b; b.bar = bar; b.x = xb_xcc_id(); b.st = st;
    if (threadIdx.x == 0) (void)xb_add(&bar[XB_XCNT(b.x)], 1u);
    return b;
}
__device__ __forceinline__ void xcd_barrier_complete(unsigned* bar, unsigned x, unsigned& nloc, unsigned& nx) {
    const unsigned G = gridDim.x * gridDim.y * gridDim.z;
    unsigned sum, cnt, mine, sp = 0u;
    for (;;) {
        sum = 0u; cnt = 0u; mine = 0u;
#pragma unroll
        for (unsigned j = 0; j < 16; ++j) { const unsigned c = xb_ld(&bar[XB_XCNT(j)]); sum += c; cnt += (c > 0u) ? 1u : 0u; mine = (j == x) ? c : mine; }
        if (sum == G) break;
        __builtin_amdgcn_s_sleep(1);
        if ((++sp & 255u) == 0u) { if (xb_ld(&bar[XB_TMO])) break; if (sp > XB_SPIN_CAP) { atomicAdd(&bar[XB_TMO], 1u); break; } }
    }
    nloc = mine > 0u ? mine : 1u; nx = cnt > 0u ? cnt : 1u;
}
__device__ __forceinline__ void xcd_barrier(const XcdBarrier& b) {
    asm volatile("s_waitcnt vmcnt(0)" ::: "memory");
    __syncthreads();
    if (threadIdx.x == 0) {
        unsigned* bar = b.bar; const unsigned bx = xb_xcc_id();
        __builtin_amdgcn_s_waitcnt(0);
        unsigned nloc = b.st[0], nx = b.st[1];
        if (nloc == 0u) { xcd_barrier_complete(bar, bx, nloc, nx); b.st[0] = nloc; b.st[1] = nx; }
        const unsigned old = xb_add(&bar[XB_XSUB(bx)], 1u);
        const unsigned gen = old / nloc;
        if (old + 1u == (gen + 1u) * nloc) {
            __builtin_amdgcn_fence(__ATOMIC_RELEASE, "agent");
            asm volatile("s_waitcnt vmcnt(0)" ::: "memory");
            const unsigned og = xb_add(&bar[XB_TOP], 1u);
            const unsigned tg = og / nx;
            if (og + 1u == (tg + 1u) * nx) xb_add(&bar[XB_TOPGEN], 1u);
            else XB_SPIN(xb_ld(&bar[XB_TOPGEN]) == tg, bar);
            __builtin_amdgcn_fence(__ATOMIC_ACQUIRE, "agent");
            xb_add(&bar[XB_XGEN(bx)], 1u);
            asm volatile("s_waitcnt vmcnt(0)" ::: "memory");
        } else {
            XB_SPIN(xb_ld(&bar[XB_XGEN(bx)]) == gen, bar);
            __builtin_amdgcn_fence(__ATOMIC_ACQUIRE, "agent");
            asm volatile("s_waitcnt vmcnt(0)" ::: "memory");
        }
    }
    __syncthreads();
}

constexpr int CW_BAR = 4096;

__global__ void __launch_bounds__(NTHR, 2) fwd(Args args) {
    extern __shared__ __attribute__((aligned(16))) unsigned char lds_raw[];
    Ctx c; c.lds = (LAS unsigned char*)lds_raw; c.tid = threadIdx.x; c.lane = c.tid & 63; c.wave = __builtin_amdgcn_readfirstlane(c.tid >> 6); c.G = gridDim.x; c.bid = blockIdx.x; c.ws = args.ws;
    unsigned char* ws = args.ws;
    volatile LAS unsigned* MISC = (volatile LAS unsigned*)(c.lds + MISC_OFF);
    if (c.tid < 32) MISC[c.tid] = 0u;
    if (c.tid < 31) { const unsigned long long pv = c.tid < 30 ? (unsigned long long)args.in[c.tid] : (unsigned long long)args.out;
        volatile LAS unsigned* pt = (volatile LAS unsigned*)(c.lds + PTR_OFF) + 2 * c.tid; pt[0] = (unsigned)pv; pt[1] = (unsigned)(pv >> 32); }
    __syncthreads();
    XcdBarrier bar = xcd_barrier_post((unsigned*)(ws + WS_CTL) + CW_BAR, MISC + 8);
#define GRID_BAR() xcd_barrier(bar)

    ph_convert(c); __syncthreads(); ph_mod(c); __syncthreads(); ph_filt(c);
    GRID_BAR();
    for (int l = 0; l < DEPTH; ++l) {
        ph_norm(c, l, 0);
        GRID_BAR();
        {   unsigned char* ws = c.ws; asm volatile("" : "+s"(ws));
            pg8::Gemm g{D, D, D}; pg8::StaticOrder S; S.init(ws + WS_H, D, (bf16_t*)(ws + WS_WIN) + (size_t)l * PW * D, D, T, PW, c.G, c.bid);
            EpiStoreBf16 E{(bf16_t*)(ws + WS_P), PW};
            pg8::gemm_phase(c.lds, g, S, E); }
        GRID_BAR();
        ph_sc(c, l);
        GRID_BAR();
        ph_hyena(c, l); ph_attn(c, l);
        GRID_BAR();
        {   unsigned char* ws = c.ws; asm volatile("" : "+s"(ws));
            pg8::Gemm g{512, 512, 512};
            { pg8::StaticOrder S; S.init(ws + WS_OATT, 512, (bf16_t*)(ws + WS_WPA) + (size_t)l * D * 512, 512, T, D, c.G, c.bid);
              EpiMerge1 E{(float*)(ws + WS_B), (const bf16_t*)(ws + WS_P)};
              pg8::gemm_phase(c.lds, g, S, E); }
            { pg8::StaticOrder S; S.init(ws + WS_OHY, 512, (bf16_t*)(ws + WS_WPB) + (size_t)l * D * 512, 512, T, D, c.G, c.bid);
              EpiMerge2 E{(const float*)(ws + WS_B), (const bf16_t*)(ws + WS_P), (bf16_t*)(ws + WS_H)};
              pg8::gemm_phase(c.lds, g, S, E); } }
        GRID_BAR();
        {   unsigned char* ws = c.ws; asm volatile("" : "+s"(ws));
            const float* modl = (const float*)(ws + WS_MOD) + (size_t)l * 5 * 6144;
            pg8::Gemm g{D, D, D}; pg8::StaticOrder S; S.init(ws + WS_H, D, (bf16_t*)(ws + WS_WO) + (size_t)l * D * D, D, T, D, c.G, c.bid);
            EpiResid E{(float*)(ws + WS_X), modl + 2 * 1024};
            pg8::gemm_phase(c.lds, g, S, E); }
        GRID_BAR();
        ph_norm(c, l, 1);
        GRID_BAR();
        if ((l & 1) == 0) {
            {   unsigned char* ws = c.ws; asm volatile("" : "+s"(ws));
                const bf16_t* w = (const bf16_t*)(ws + WS_W13D) + (size_t)(l >> 1) * 2 * FF * D;
                pg8::Gemm g{D, D, D}; pg8::StaticOrder S; S.init(ws + WS_H, D, w, D, T, 2 * FF, c.G, c.bid);
                EpiSwiglu E{(bf16_t*)(ws + WS_P)};
                pg8::gemm_phase(c.lds, g, S, E); }
            GRID_BAR();
            {   unsigned char* ws = c.ws; asm volatile("" : "+s"(ws));
                const float* modl = (const float*)(ws + WS_MOD) + (size_t)l * 5 * 6144;
                const bf16_t* w = (const bf16_t*)(ws + WS_W2D) + (size_t)(l >> 1) * D * FF;
                pg8::Gemm g{FF, FF, FF}; pg8::StaticOrder S; S.init(ws + WS_P, FF, w, FF, T, D, c.G, c.bid);
                EpiResid E{(float*)(ws + WS_X), modl + 5 * 1024};
                pg8::gemm_phase(c.lds, g, S, E); }
            GRID_BAR();
        } else {
            const Ctx cm = mk_ctx(c.lds, c.ws);
            moe_table(cm, l >> 1);
            {   unsigned char* ws = c.ws; asm volatile("" : "+s"(ws));
                const bf16_t* w = (const bf16_t*)(ws + WS_W13M) + (size_t)((l >> 1) * NE) * 2 * FF * D;
                pg8::Gemm g{D, D, D}; MoeOrder<true> S; S.init(ws + WS_H, D, w, D, (size_t)2 * FF * D * 2, 2 * FF, c.G, c.bid, (const int*)(ws + WS_TOK), (const LAS unsigned*)(c.lds + MOE_OFF));
                EpiSwiglu E{(bf16_t*)(ws + WS_P)};
                pg8::gemm_phase(c.lds, g, S, E); }
            GRID_BAR();
            {   unsigned char* ws = c.ws; asm volatile("" : "+s"(ws));
                const bf16_t* w = (const bf16_t*)(ws + WS_W2M) + (size_t)((l >> 1) * NE) * D * FF;
                pg8::Gemm g{FF, FF, FF}; MoeOrder<false> S; S.init(ws + WS_P, FF, w, FF, (size_t)D * FF * 2, D, c.G, c.bid, (const int*)(ws + WS_TOK), (const LAS unsigned*)(c.lds + MOE_OFF));
                EpiStoreBf16 E{(bf16_t*)(ws + WS_Y), D};
                pg8::gemm_phase(c.lds, g, S, E); }
            GRID_BAR();
        }
    }
    ph_final(c);
}

extern "C" void kernel_launch(void* const* d_in, const int* in_sizes, int n_in, void* d_out, int out_size, void* d_ws, size_t ws_size, hipStream_t stream) {
    static int grid = 0;
    if (grid == 0) {
        if (n_in != 30 || out_size != TL * D || ws_size < WS_END) { fprintf(stderr, "kernel_launch: unexpected shapes (n_in %d out %d ws %zu)\n", n_in, out_size, ws_size); grid = -1; return; }
        int dev = 0, cus = 0, per_cu = 0; (void)hipGetDevice(&dev); (void)hipDeviceGetAttribute(&cus, hipDeviceAttributeMultiprocessorCount, dev);
        if (hipFuncSetAttribute((const void*)fwd, hipFuncAttributeMaxDynamicSharedMemorySize, LDS_BYTES) != hipSuccess) { fprintf(stderr, "kernel_launch: hipFuncSetAttribute failed\n"); grid = -1; return; }
        if (hipOccupancyMaxActiveBlocksPerMultiprocessor(&per_cu, (const void*)fwd, NTHR, LDS_BYTES) != hipSuccess || per_cu < 1) fprintf(stderr, "kernel_launch: occupancy query reports %d\n", per_cu);
        (void)hipGetLastError();
        grid = cus > 0 ? cus : 256;
    }
    if (grid < 0) return;
    (void)hipMemsetAsync((char*)d_ws + WS_CTL, 0, CTL_ZERO_BYTES, stream);
    Args a{};
    for (int i = 0; i < 30; ++i) a.in[i] = (const float*)d_in[i];
    a.out = (float*)d_out; a.ws = (unsigned char*)d_ws;
    hipLaunchKernelGGL(fwd, dim3(grid), dim3(NTHR), LDS_BYTES, stream, a);
}
```

```cpp
#include <hip/hip_runtime.h>
#include <cstdio>
#include <cstdint>

#define LAS __attribute__((address_space(3)))
#define GAS __attribute__((address_space(1)))
typedef unsigned short bf16_t;
typedef short bf16x8 __attribute__((ext_vector_type(8)));
typedef float f32x4 __attribute__((ext_vector_type(4)));
typedef float f32x2 __attribute__((ext_vector_type(2)));
typedef float f32x16 __attribute__((ext_vector_type(16)));
typedef unsigned u32x4 __attribute__((ext_vector_type(4)));
typedef unsigned u32x2 __attribute__((ext_vector_type(2)));

constexpr int D = 1024, NB = 4, SEQ = 4096, DEPTH = 4, CTX = 256;
constexpr int TL = NB * SEQ, TC = NB * CTX, T = TL + TC;
constexpr int PW = 5120, FF = 2816, NE = 8, HYW = 512;
constexpr int PQ = 0, PK = 512, PV = 1024, PHY = 1536, PGA = 3072, PGB = 4096;
constexpr float EPS = 1e-6f;

constexpr size_t MiB = 1u << 20;
constexpr size_t WS_CTL = 0, CTL_ZERO_BYTES = 1 * MiB;
constexpr size_t WS_MOD = 1 * MiB;
constexpr size_t WS_ROUTE = 2 * MiB;
constexpr size_t WS_RWT = 2 * MiB + 512 * 1024;
constexpr size_t WS_TOK = 3 * MiB;
constexpr int CW_CNT = 8192;
constexpr int MAXSLOT = 36864;
constexpr size_t WS_Y = 660 * MiB;
constexpr size_t WS_WIN = 4 * MiB;
constexpr size_t WS_WPA = 44 * MiB;
constexpr size_t WS_WPB = 48 * MiB;
constexpr size_t WS_WO = 52 * MiB;
constexpr size_t WS_W13D = 60 * MiB;
constexpr size_t WS_W2D = 82 * MiB;
constexpr size_t WS_W13M = 93 * MiB;
constexpr size_t WS_W2M = 269 * MiB;
constexpr size_t WS_X = 357 * MiB;
constexpr size_t WS_H = 425 * MiB;
constexpr size_t WS_P = 459 * MiB;
constexpr size_t WS_OATT = 629 * MiB;
constexpr size_t WS_OHY = 646 * MiB;
constexpr size_t WS_B = 663 * MiB;
constexpr size_t WS_Z = WS_B + 51 * MiB;
constexpr size_t WS_VT = 748 * MiB;
constexpr size_t WS_HRL = 816 * MiB;
constexpr size_t WS_HRC = 850 * MiB;
constexpr size_t WS_END = 853 * MiB;

constexpr int LDS_BYTES = 147456;
constexpr int NWAVES = 8, NTHR = 512;

#define LDS_WAIT() asm volatile("s_waitcnt lgkmcnt(0)" ::: "memory")
#define VM_WAIT() asm volatile("s_waitcnt vmcnt(0)" ::: "memory")
__device__ __forceinline__ float bf2f(unsigned b) { return __uint_as_float(b << 16); }
__device__ __forceinline__ float bflo(unsigned w) { return __uint_as_float(w << 16); }
__device__ __forceinline__ float bfhi(unsigned w) { return __uint_as_float(w & 0xffff0000u); }
__device__ __forceinline__ unsigned cvt_pk_bf16(float lo, float hi) { unsigned r; asm volatile("v_cvt_pk_bf16_f32 %0, %1, %2" : "=v"(r) : "v"(lo), "v"(hi)); return r; }
__device__ __forceinline__ float wave_sum(float v, int lane) {
#pragma unroll
    for (int o = 1; o < 64; o <<= 1) v += __int_as_float(__builtin_amdgcn_ds_bpermute((lane ^ o) << 2, __float_as_int(v)));
    return v;
}
__device__ __forceinline__ float sigmoidf_(float x) { return 1.f / (1.f + __expf(-x)); }
__device__ __forceinline__ float sin_rev(float r) { return __builtin_amdgcn_sinf(__builtin_amdgcn_fractf(r)); }
__device__ __forceinline__ float sin_rad(float x) { return sin_rev(x * 0.15915494309189535f); }

namespace pg8 {
constexpr int BM = 256, BK = 64, HALF = 128, HTB = HALF * BK * 2, STAGE_BYTES = 8 * HTB, NXCD = 8, WGM = 8;
__host__ __device__ __forceinline__ int lds_byte(int r, int c) { const int st = (r >> 4) * 2 + (c >> 5), rr = r & 15, cc = c & 31, ob = rr * 64 + cc * 2; return st * 1024 + (ob ^ (((ob >> 9) & 1) << 5)); }
__host__ __device__ __forceinline__ void stage_rc(int b, int& R, int& C) { const int st = b / 1024, sb = b % 1024, swz = sb ^ (((sb >> 9) & 1) << 5); R = (st >> 1) * 16 + swz / 64; C = (st & 1) * 32 + (swz % 64) / 2; }
__host__ __device__ __forceinline__ int perm32(int rho) { const int n = rho >> 4, i = rho & 15; return 8 * (i >> 2) + 4 * n + (i & 3); }

struct Unit { int pm, pn; const char* a; const char* b; const int* tk; int nvalid; };
struct Gemm { int K, lda, ldb; };

struct StaticOrder {
    int nM, nN, nwg, G, c; const char* A; const char* B; size_t astep, bstep;
    __device__ void init(const void* A_, int lda, const void* B_, int ldb, int M, int N, int G_, int c_) {
        nM = M / BM; nN = N / BM; nwg = nM * nN; G = G_; c = c_; A = (const char*)A_; B = (const char*)B_; astep = (size_t)BM * lda * 2; bstep = (size_t)BM * ldb * 2; }
    __device__ bool next(int i, Unit& u) const {
        const long L = (long)i * G + c; if (L >= nwg) return false;
        int wgid = (int)L; { const int q = nwg / NXCD, r = nwg % NXCD, xcd = wgid % NXCD, off = wgid / NXCD; wgid = (xcd < r ? xcd * (q + 1) : r * (q + 1) + (xcd - r) * q) + off; }
        const int nig = WGM * nN, gid = wgid / nig, fm = gid * WGM, gsz = (nM - fm) < WGM ? (nM - fm) : WGM;
        u.pm = fm + ((wgid % nig) % gsz); u.pn = (wgid % nig) / gsz; u.a = A + (size_t)u.pm * astep; u.b = B + (size_t)u.pn * bstep; return true;
    }
    static constexpr bool GATHER = false;
    __device__ __forceinline__ int arow(const Unit&, int) const { return 0; }
    __device__ __forceinline__ void a_ready(const Unit&) const {}
    __device__ __forceinline__ void done(const Unit&) const {}
};

template <class Epi, class Sched, bool ALIGN_EPI = true>
__device__ __forceinline__ void gemm_phase(LAS unsigned char* lds, const Gemm g, const Sched& S, const Epi& E) {
    int tid = threadIdx.x; asm volatile("" : "+v"(tid));
    const int wid = __builtin_amdgcn_readfirstlane(tid >> 6), lane = tid & 63, wr = wid >> 2, wc = wid & 3, fr = lane & 15, fq = lane >> 4;
    const int K = g.K, nt = K / BK;
    constexpr bool GATHER = Sched::GATHER;
    unsigned voffB[2]; unsigned cA0[2], cA1[2], nA0[2], nA1[2]; int RA[2], CA[2];
    const size_t hstepA = (size_t)HALF * g.lda * 2, hstepB = (size_t)HALF * g.ldb * 2;
#pragma unroll
    for (int i = 0; i < 2; ++i) { int R, C; stage_rc(tid * 16 + i * 8192, R, C); const int Rb = Epi::PERM ? ((R & ~31) + perm32(R & 31)) : R;
        RA[i] = R; CA[i] = C; voffB[i] = (unsigned)(Rb * g.ldb + C) * 2u;
        cA0[i] = (unsigned)(R * g.lda + C) * 2u; cA1[i] = cA0[i]; nA0[i] = cA0[i]; nA1[i] = cA0[i]; }
    const size_t h1A = GATHER ? 0 : hstepA;
    const size_t kstep = (size_t)(BK * 2);
    const unsigned ldsw = (unsigned)wid * 1024u;
    const int aoff = lds_byte(wr * 64 + fr, fq * 8), boff = lds_byte(wc * 32 + fr, fq * 8);
#define PG8_SA(b, h) (((b) * 2 + (h)) * HTB)
#define PG8_SB(b, h) ((4 + (b) * 2 + (h)) * HTB)
#define PG8_STAGE(bufoff, gbase, voff) do { _Pragma("unroll") for (int _i = 0; _i < 2; ++_i) \
        __builtin_amdgcn_global_load_lds((const unsigned*)((const char*)(gbase) + (voff)[_i]), (LAS unsigned*)(lds + (bufoff) + ldsw + _i * 8192), 16, 0, 0); } while (0)
#define PG8_LDA(dst, b, h) do { _Pragma("unroll") for (int m = 0; m < 4; ++m) _Pragma("unroll") for (int k = 0; k < 2; ++k) dst[m][k] = *(const LAS bf16x8*)(lds + PG8_SA(b, h) + aoff + m * 2048 + k * 1024); } while (0)
#define PG8_LDB(dst, b, h) do { _Pragma("unroll") for (int n = 0; n < 2; ++n) _Pragma("unroll") for (int k = 0; k < 2; ++k) dst[n][k] = *(const LAS bf16x8*)(lds + PG8_SB(b, h) + boff + n * 2048 + k * 1024); } while (0)
#define PG8_MMA(ai, bj, At, Bt) do { __builtin_amdgcn_s_setprio(1); _Pragma("unroll") for (int m = 0; m < 4; ++m) _Pragma("unroll") for (int n = 0; n < 2; ++n) _Pragma("unroll") for (int k = 0; k < 2; ++k) \
        acc[ai][bj][m][n] = __builtin_amdgcn_mfma_f32_16x16x32_bf16(Bt[n][k], At[m][k], acc[ai][bj][m][n], 0, 0, 0); __builtin_amdgcn_s_setprio(0); } while (0)
#define PG8_WAIT_V(n) asm volatile("s_waitcnt vmcnt(" #n ")" ::: "memory")
#define PG8_WAIT_L(n) asm volatile("s_waitcnt lgkmcnt(" #n ")" ::: "memory")
#define PG8_BAR __builtin_amdgcn_s_barrier()
#define PG8_SCHED __builtin_amdgcn_sched_barrier(0)
    Unit cur, nxt; int ui = 0;
    if (!S.next(0, cur)) return;
    if constexpr (GATHER) {
#pragma unroll
        for (int i = 0; i < 2; ++i) { cA0[i] = (unsigned)(S.arow(cur, RA[i]) * g.lda + CA[i]) * 2u; cA1[i] = (unsigned)(S.arow(cur, HALF + RA[i]) * g.lda + CA[i]) * 2u; }
    }
    f32x4 acc[2][2][4][2];
#pragma unroll
    for (int a = 0; a < 2; ++a)
#pragma unroll
        for (int b = 0; b < 2; ++b)
#pragma unroll
            for (int m = 0; m < 4; ++m)
#pragma unroll
                for (int n = 0; n < 2; ++n) acc[a][b][m][n] = (f32x4){0.f, 0.f, 0.f, 0.f};
    bf16x8 At[4][2], B0[2][2], B1[2][2];
    const char* cA = cur.a; const char* cB = cur.b;
    S.a_ready(cur);
    PG8_STAGE(PG8_SB(0, 0), cB, voffB); PG8_STAGE(PG8_SB(0, 1), cB + hstepB, voffB); PG8_STAGE(PG8_SA(0, 0), cA, cA0); PG8_STAGE(PG8_SA(0, 1), cA + h1A, cA1);
    if (wr == 1) PG8_BAR;
    PG8_WAIT_V(2); PG8_BAR;
    PG8_STAGE(PG8_SB(1, 0), cB + kstep, voffB); PG8_STAGE(PG8_SA(1, 0), cA + kstep, cA0); PG8_STAGE(PG8_SB(1, 1), cB + hstepB + kstep, voffB);
    PG8_WAIT_V(6); PG8_BAR;
    for (;;) {
        const bool has_next = S.next(ui + 1, nxt);
        const char* nA = has_next ? nxt.a : cA; const char* nB = has_next ? nxt.b : cB;
        if constexpr (GATHER) {
#pragma unroll
            for (int i = 0; i < 2; ++i) { nA0[i] = has_next ? (unsigned)(S.arow(nxt, RA[i]) * g.lda + CA[i]) * 2u : cA0[i]; nA1[i] = has_next ? (unsigned)(S.arow(nxt, HALF + RA[i]) * g.lda + CA[i]) * 2u : cA1[i]; }
        }
        for (int t = 0; t < nt; t += 2) {
            const bool last = (t == nt - 2);
            const char* a1 = cA + (size_t)(t + 1) * kstep;
            const char* a2 = last ? nA : cA + (size_t)(t + 2) * kstep; const char* b2 = last ? nB : cB + (size_t)(t + 2) * kstep;
            const char* a3 = a2 + kstep; const char* b3 = b2 + kstep;
            unsigned x0[2], x1[2];
#pragma unroll
            for (int i = 0; i < 2; ++i) { x0[i] = (GATHER && last) ? nA0[i] : cA0[i]; x1[i] = GATHER ? (last ? nA1[i] : cA1[i]) : cA0[i]; }
            if (last && has_next) S.a_ready(nxt);
            PG8_LDB(B0, 0, 0); PG8_LDB(B1, 0, 1); PG8_SCHED; PG8_LDA(At, 0, 0); PG8_STAGE(PG8_SA(1, 1), a1 + h1A, cA1);
            PG8_WAIT_V(8); PG8_WAIT_L(0); PG8_BAR; PG8_MMA(0, 0, At, B0); PG8_MMA(0, 1, At, B1); PG8_BAR; PG8_SCHED;
            PG8_LDA(At, 0, 1); PG8_STAGE(PG8_SB(0, 0), b2, voffB); PG8_STAGE(PG8_SB(0, 1), b2 + hstepB, voffB); PG8_STAGE(PG8_SA(0, 0), a2, x0);
            PG8_WAIT_V(8); PG8_WAIT_L(0); PG8_BAR; PG8_MMA(1, 0, At, B0); PG8_MMA(1, 1, At, B1); PG8_BAR; PG8_SCHED;
            PG8_LDB(B0, 1, 0); PG8_LDB(B1, 1, 1); PG8_SCHED; PG8_LDA(At, 1, 0); PG8_STAGE(PG8_SA(0, 1), a2 + h1A, x1);
            PG8_WAIT_V(8); PG8_WAIT_L(0); PG8_BAR; PG8_MMA(0, 0, At, B0); PG8_MMA(0, 1, At, B1); PG8_BAR; PG8_SCHED;
            PG8_LDA(At, 1, 1); PG8_STAGE(PG8_SB(1, 0), b3, voffB); PG8_STAGE(PG8_SB(1, 1), b3 + hstepB, voffB); PG8_STAGE(PG8_SA(1, 0), a3, x0);
            PG8_WAIT_V(8); PG8_WAIT_L(0); PG8_BAR; PG8_MMA(1, 0, At, B0); PG8_MMA(1, 1, At, B1); PG8_BAR; PG8_SCHED;
        }
        if constexpr (ALIGN_EPI) { if (wr == 0) PG8_BAR; }
        E(acc, cur, wr, wc, fr, fq); S.done(cur);
        if (!has_next) break;
#pragma unroll
        for (int a = 0; a < 2; ++a)
#pragma unroll
            for (int b = 0; b < 2; ++b)
#pragma unroll
                for (int m = 0; m < 4; ++m)
#pragma unroll
                    for (int n = 0; n < 2; ++n) acc[a][b][m][n] = (f32x4){0.f, 0.f, 0.f, 0.f};
        cur = nxt; cA = nA; cB = nB; ++ui;
        if constexpr (GATHER) {
#pragma unroll
            for (int i = 0; i < 2; ++i) { cA0[i] = nA0[i]; cA1[i] = nA1[i]; }
        }
        if constexpr (ALIGN_EPI) { if (wr == 1) PG8_BAR; }
    }
    PG8_WAIT_V(0);
    if constexpr (!ALIGN_EPI) { if (wr == 0) PG8_BAR; }
    PG8_BAR;
#undef PG8_SA
#undef PG8_SB
#undef PG8_STAGE
#undef PG8_LDA
#undef PG8_LDB
#undef PG8_MMA
#undef PG8_WAIT_V
#undef PG8_WAIT_L
#undef PG8_BAR
#undef PG8_SCHED
}
}

typedef f32x4 AccT[2][2][4][2];
struct EpiStoreBf16 {
    static constexpr bool PERM = true;
    bf16_t* O; int ldc;
    __device__ __forceinline__ void operator()(const AccT& acc, const pg8::Unit& u, int wr, int wc, int fr, int fq) const {
        const int row0 = u.pm * 256 + wr * 64 + fr, col0 = u.pn * 256 + wc * 32 + 8 * fq;
#pragma unroll
        for (int ai = 0; ai < 2; ++ai)
#pragma unroll
            for (int m = 0; m < 4; ++m) { bf16_t* rowp = O + (size_t)(row0 + ai * 128 + m * 16) * ldc + col0;
#pragma unroll
                for (int bj = 0; bj < 2; ++bj) { const f32x4 v0 = acc[ai][bj][m][0], v1 = acc[ai][bj][m][1];
                    u32x4 w; w.x = cvt_pk_bf16(v0[0], v0[1]); w.y = cvt_pk_bf16(v0[2], v0[3]); w.z = cvt_pk_bf16(v1[0], v1[1]); w.w = cvt_pk_bf16(v1[2], v1[3]);
                    *(u32x4*)(rowp + bj * 128) = w; } }
    }
};
struct EpiMerge1 {
    static constexpr bool PERM = true;
    float* t1; const bf16_t* P;
    __device__ __forceinline__ void operator()(const AccT& acc, const pg8::Unit& u, int wr, int wc, int fr, int fq) const {
        const int row0 = u.pm * 256 + wr * 64 + fr, col0 = u.pn * 256 + wc * 32 + 8 * fq;
#pragma unroll
        for (int ai = 0; ai < 2; ++ai)
#pragma unroll
            for (int m = 0; m < 4; ++m) { const int r = row0 + ai * 128 + m * 16;
#pragma unroll
                for (int bj = 0; bj < 2; ++bj) { const int c = col0 + bj * 128;
                    const u32x4 g = *(const u32x4*)(P + (size_t)r * PW + PGA + c);
                    const f32x4 v0 = acc[ai][bj][m][0], v1 = acc[ai][bj][m][1];
                    f32x4 o0, o1;
                    o0[0] = sigmoidf_(bflo(g.x)) * v0[0]; o0[1] = sigmoidf_(bfhi(g.x)) * v0[1]; o0[2] = sigmoidf_(bflo(g.y)) * v0[2]; o0[3] = sigmoidf_(bfhi(g.y)) * v0[3];
                    o1[0] = sigmoidf_(bflo(g.z)) * v1[0]; o1[1] = sigmoidf_(bfhi(g.z)) * v1[1]; o1[2] = sigmoidf_(bflo(g.w)) * v1[2]; o1[3] = sigmoidf_(bfhi(g.w)) * v1[3];
                    float* tp = t1 + (size_t)r * D + c; *(f32x4*)tp = o0; *(f32x4*)(tp + 4) = o1; } }
    }
};
struct EpiMerge2 {
    static constexpr bool PERM = true;
    const float* t1; const bf16_t* P; bf16_t* O;
    __device__ __forceinline__ void operator()(const AccT& acc, const pg8::Unit& u, int wr, int wc, int fr, int fq) const {
        const int row0 = u.pm * 256 + wr * 64 + fr, col0 = u.pn * 256 + wc * 32 + 8 * fq;
#pragma unroll
        for (int ai = 0; ai < 2; ++ai)
#pragma unroll
            for (int m = 0; m < 4; ++m) { const int r = row0 + ai * 128 + m * 16;
#pragma unroll
                for (int bj = 0; bj < 2; ++bj) { const int c = col0 + bj * 128;
                    const u32x4 g = *(const u32x4*)(P + (size_t)r * PW + PGB + c);
                    const float* tp = t1 + (size_t)r * D + c; const f32x4 a0 = *(const f32x4*)tp, a1 = *(const f32x4*)(tp + 4);
                    const f32x4 v0 = acc[ai][bj][m][0], v1 = acc[ai][bj][m][1];
                    f32x4 o0, o1;
                    o0[0] = a0[0] + sigmoidf_(bflo(g.x)) * v0[0]; o0[1] = a0[1] + sigmoidf_(bfhi(g.x)) * v0[1]; o0[2] = a0[2] + sigmoidf_(bflo(g.y)) * v0[2]; o0[3] = a0[3] + sigmoidf_(bfhi(g.y)) * v0[3];
                    o1[0] = a1[0] + sigmoidf_(bflo(g.z)) * v1[0]; o1[1] = a1[1] + sigmoidf_(bfhi(g.z)) * v1[1]; o1[2] = a1[2] + sigmoidf_(bflo(g.w)) * v1[2]; o1[3] = a1[3] + sigmoidf_(bfhi(g.w)) * v1[3];
                    u32x4 w; w.x = cvt_pk_bf16(o0[0], o0[1]); w.y = cvt_pk_bf16(o0[2], o0[3]); w.z = cvt_pk_bf16(o1[0], o1[1]); w.w = cvt_pk_bf16(o1[2], o1[3]);
                    *(u32x4*)(O + (size_t)r * D + c) = w; } }
    }
};
struct EpiResid {
    static constexpr bool PERM = false;
    float* x; const float* gate;
    __device__ __forceinline__ void operator()(const AccT& acc, const pg8::Unit& u, int wr, int wc, int fr, int fq) const {
        const int row0 = u.pm * 256 + wr * 64 + fr, col0 = u.pn * 256 + wc * 32 + 4 * fq;
        const int b = (u.pm < 64) ? (u.pm >> 4) : 4;
        const float* gp = gate + (size_t)b * 6144 + col0;
        f32x4 gv[2][2];
#pragma unroll
        for (int bj = 0; bj < 2; ++bj)
#pragma unroll
            for (int n = 0; n < 2; ++n) gv[bj][n] = *(const f32x4*)(gp + bj * 128 + n * 16);
#pragma unroll
        for (int ai = 0; ai < 2; ++ai)
#pragma unroll
            for (int m = 0; m < 4; ++m) { const int r = row0 + ai * 128 + m * 16; float* rowp = x + (size_t)r * D + col0;
#pragma unroll
                for (int bj = 0; bj < 2; ++bj)
#pragma unroll
                    for (int n = 0; n < 2; ++n) { float* p = rowp + bj * 128 + n * 16; *(f32x4*)p = *(const f32x4*)p + gv[bj][n] * acc[ai][bj][m][n]; } }
    }
};
struct EpiSwiglu {
    static constexpr bool PERM = true;
    bf16_t* O;
    __device__ __forceinline__ void operator()(const AccT& acc, const pg8::Unit& u, int wr, int wc, int fr, int fq) const {
        const int row0 = u.pm * 256 + wr * 64 + fr, col0 = u.pn * 128 + wc * 32 + 8 * fq;
#pragma unroll
        for (int ai = 0; ai < 2; ++ai)
#pragma unroll
            for (int m = 0; m < 4; ++m) { const int r = row0 + ai * 128 + m * 16;
                float o[8];
#pragma unroll
                for (int n = 0; n < 2; ++n)
#pragma unroll
                    for (int j = 0; j < 4; ++j) { const float a = acc[ai][0][m][n][j], g = acc[ai][1][m][n][j]; o[n * 4 + j] = a * sigmoidf_(a) * g; }
                u32x4 w; w.x = cvt_pk_bf16(o[0], o[1]); w.y = cvt_pk_bf16(o[2], o[3]); w.z = cvt_pk_bf16(o[4], o[5]); w.w = cvt_pk_bf16(o[6], o[7]);
                *(u32x4*)(O + (size_t)r * FF + col0) = w; }
    }
};

struct CEpiMerge1 { float* t1; const bf16_t* P;
    __device__ __forceinline__ void operator()(const f32x4& acc, int r, int c) const { const u32x2 g = *(const u32x2*)(P + (size_t)r * PW + PGA + c);
        f32x4 o; o[0] = sigmoidf_(bflo(g.x)) * acc[0]; o[1] = sigmoidf_(bfhi(g.x)) * acc[1]; o[2] = sigmoidf_(bflo(g.y)) * acc[2]; o[3] = sigmoidf_(bfhi(g.y)) * acc[3];
        *(f32x4*)(t1 + (size_t)r * D + c) = o; } };
struct CEpiMerge2 { const float* t1; const bf16_t* P; bf16_t* O;
    __device__ __forceinline__ void operator()(const f32x4& acc, int r, int c) const { const u32x2 g = *(const u32x2*)(P + (size_t)r * PW + PGB + c); const f32x4 a = *(const f32x4*)(t1 + (size_t)r * D + c);
        u32x2 w; w.x = cvt_pk_bf16(a[0] + sigmoidf_(bflo(g.x)) * acc[0], a[1] + sigmoidf_(bfhi(g.x)) * acc[1]); w.y = cvt_pk_bf16(a[2] + sigmoidf_(bflo(g.y)) * acc[2], a[3] + sigmoidf_(bfhi(g.y)) * acc[3]);
        *(u32x2*)(O + (size_t)r * D + c) = w; } };
struct CEpiResid { float* x; const float* gate;
    __device__ __forceinline__ void operator()(const f32x4& acc, int r, int c) const { float* p = x + (size_t)r * D + c; *(f32x4*)p = *(const f32x4*)p + *(const f32x4*)(gate + c) * acc; } };
template <class Epi>
__device__ __forceinline__ void ctx_gemm(const bf16_t* X, int ldx, const bf16_t* Wt, int ldw, int K, const Epi& E) {
    int tid = threadIdx.x; asm volatile("" : "+v"(tid));
    const int wave = tid >> 6, lane = tid & 63, li = lane & 15, kg = lane >> 4;
    for (int tile = blockIdx.x; tile < 256; tile += gridDim.x) {
        const int row0 = TL + (tile >> 4) * 64 + (wave >> 1) * 16, col0 = (tile & 15) * 64 + (wave & 1) * 32;
        const bf16_t* xp = X + (size_t)(row0 + li) * ldx + 8 * kg;
        const bf16_t* w0 = Wt + (size_t)(col0 + li) * ldw + 8 * kg; const bf16_t* w1 = w0 + (size_t)16 * ldw;
        f32x4 acc0 = (f32x4){0.f, 0.f, 0.f, 0.f}, acc1 = acc0;
#pragma unroll 4
        for (int k0 = 0; k0 < K; k0 += 32) {
            const bf16x8 xf = *(const bf16x8*)(xp + k0), b0 = *(const bf16x8*)(w0 + k0), b1 = *(const bf16x8*)(w1 + k0);
            acc0 = __builtin_amdgcn_mfma_f32_16x16x32_bf16(b0, xf, acc0, 0, 0, 0);
            acc1 = __builtin_amdgcn_mfma_f32_16x16x32_bf16(b1, xf, acc1, 0, 0, 0);
        }
        E(acc0, row0 + li, col0 + 4 * kg); E(acc1, row0 + li, col0 + 16 + 4 * kg);
    }
}

struct Args { const float* in[30]; float* out; unsigned char* ws; int l, e, ph, pad; };
enum { I_X = 0, I_C, I_CTX, I_CCTX, I_WMOD, I_BMOD, I_N1G, I_N2G, I_WIN, I_RPB, I_HCW, I_HCB, I_HW1, I_HB1, I_HW2, I_HB2, I_HW3, I_HFREQ, I_HBIAS,
       I_WPA, I_WPB, I_WO, I_FW1, I_FW3, I_FW2, I_ROUTER, I_MW1, I_MW3, I_MW2, I_FINALG };

constexpr int MISC_OFF = 131072 + 320;
constexpr int PTR_OFF = MISC_OFF + 128;
struct Ctx {
    LAS unsigned char* lds; int tid, lane, wave, G, bid; unsigned char* ws;
};
__device__ __forceinline__ Ctx mk_ctx(LAS unsigned char* lds, unsigned char* ws) {
    Ctx c; int t = threadIdx.x; asm volatile("" : "+v"(t)); asm volatile("" : "+s"(ws)); c.lds = lds; c.tid = t; c.lane = t & 63; c.wave = __builtin_amdgcn_readfirstlane(t >> 6); c.G = gridDim.x; c.bid = blockIdx.x; c.ws = ws; return c;
}
__device__ __forceinline__ const float* inp(const Ctx& c, int i) {
    unsigned ao = (unsigned)(PTR_OFF + 8 * i); asm volatile("" : "+v"(ao));
    const volatile LAS unsigned* p = (const volatile LAS unsigned*)(c.lds + ao);
    const unsigned lo = __builtin_amdgcn_readfirstlane(p[0]), hi = __builtin_amdgcn_readfirstlane(p[1]);
    return (const float*)(((unsigned long long)hi << 32) | (unsigned long long)lo);
}

__device__ __forceinline__ void transpose_item(const float* W, int N, bf16_t* WT, int ldk, int k0, int n0, int drow0, LAS float* scr, int lane) {
    float wv[32];
    const float* wp = W + (size_t)(k0 + (lane >> 5)) * N + n0 + (lane & 31);
#pragma unroll
    for (int i = 0; i < 32; ++i) wv[i] = wp[(size_t)(2 * i) * N];
#pragma unroll
    for (int i = 0; i < 32; ++i) scr[(2 * i + (lane >> 5)) * 33 + (lane & 31)] = wv[i];
    LDS_WAIT(); asm volatile("" ::: "memory");
    const int c = lane & 7;
#pragma unroll
    for (int j = 0; j < 4; ++j) { const int n = (lane >> 3) + 8 * j; const LAS float* s = scr + (8 * c) * 33 + n;
        u32x4 o; o.x = cvt_pk_bf16(s[0 * 33], s[1 * 33]); o.y = cvt_pk_bf16(s[2 * 33], s[3 * 33]); o.z = cvt_pk_bf16(s[4 * 33], s[5 * 33]); o.w = cvt_pk_bf16(s[6 * 33], s[7 * 33]);
        *(u32x4*)(WT + (size_t)(drow0 + n) * ldk + k0 + 8 * c) = o; }
    LDS_WAIT(); asm volatile("" ::: "memory");
}
__device__ __forceinline__ void conv_mat(const float* W, int K, int N, bf16_t* WT, int mode, int& base, int gw, int NGW, LAS float* scr, int lane) {
    const int nblk = N / 32, nitems = (K / 64) * nblk;
    const int start = (gw - (base % NGW) + NGW) % NGW;
    for (int it = start; it < nitems; it += NGW) {
        const int kb = it / nblk, nb = it % nblk, n0 = nb * 32;
        const int drow0 = mode == 0 ? n0 : ((n0 >> 7) * 256 + (n0 & 127) + (mode == 2 ? 128 : 0));
        transpose_item(W, N, WT, K, kb * 64, n0, drow0, scr, lane);
    }
    base += nitems;
}
__device__ __forceinline__ void ph_convert(const Ctx& c0) {
    const Ctx c = mk_ctx(c0.lds, c0.ws);
    unsigned char* ws = c.ws;
    LAS float* scr = (LAS float*)(c.lds + c.wave * 16384);
    const int gw = c.bid * NWAVES + c.wave, NGW = c.G * NWAVES; int base = 0;
    for (int l = 0; l < DEPTH; ++l) {
        conv_mat(inp(c, I_WIN) + (size_t)l * D * PW, D, PW, (bf16_t*)(ws + WS_WIN) + (size_t)l * PW * D, 0, base, gw, NGW, scr, c.lane);
        conv_mat(inp(c, I_WPA) + (size_t)l * 512 * D, 512, D, (bf16_t*)(ws + WS_WPA) + (size_t)l * D * 512, 0, base, gw, NGW, scr, c.lane);
        conv_mat(inp(c, I_WPB) + (size_t)l * 512 * D, 512, D, (bf16_t*)(ws + WS_WPB) + (size_t)l * D * 512, 0, base, gw, NGW, scr, c.lane);
        conv_mat(inp(c, I_WO) + (size_t)l * D * D, D, D, (bf16_t*)(ws + WS_WO) + (size_t)l * D * D, 0, base, gw, NGW, scr, c.lane);
    }
    for (int i = 0; i < 2; ++i) {
        conv_mat(inp(c, I_FW1) + (size_t)i * D * FF, D, FF, (bf16_t*)(ws + WS_W13D) + (size_t)i * 2 * FF * D, 1, base, gw, NGW, scr, c.lane);
        conv_mat(inp(c, I_FW3) + (size_t)i * D * FF, D, FF, (bf16_t*)(ws + WS_W13D) + (size_t)i * 2 * FF * D, 2, base, gw, NGW, scr, c.lane);
        conv_mat(inp(c, I_FW2) + (size_t)i * FF * D, FF, D, (bf16_t*)(ws + WS_W2D) + (size_t)i * D * FF, 0, base, gw, NGW, scr, c.lane);
    }
    for (int ie = 0; ie < 2 * NE; ++ie) {
        conv_mat(inp(c, I_MW1) + (size_t)ie * D * FF, D, FF, (bf16_t*)(ws + WS_W13M) + (size_t)ie * 2 * FF * D, 1, base, gw, NGW, scr, c.lane);
        conv_mat(inp(c, I_MW3) + (size_t)ie * D * FF, D, FF, (bf16_t*)(ws + WS_W13M) + (size_t)ie * 2 * FF * D, 2, base, gw, NGW, scr, c.lane);
        conv_mat(inp(c, I_MW2) + (size_t)ie * FF * D, FF, D, (bf16_t*)(ws + WS_W2M) + (size_t)ie * D * FF, 0, base, gw, NGW, scr, c.lane);
    }
}

__device__ __forceinline__ void ph_mod(const Ctx& c0) {
    const Ctx c = mk_ctx(c0.lds, c0.ws);
    float* mod = (float*)(c.ws + WS_MOD);
    LAS float* s = (LAS float*)c.lds; LAS float* part = s + 5 * 1024;
    const float* cin = inp(c, I_C); const float* cctx = inp(c, I_CCTX); const float* wmod = inp(c, I_WMOD); const float* bmod = inp(c, I_BMOD);
    for (int i = c.tid; i < 5 * 1024; i += NTHR) { const int r = i >> 10, k = i & 1023; const float v = r < 4 ? cin[r * 1024 + k] : cctx[k]; s[i] = v * sigmoidf_(v); }
    __syncthreads();
    for (int unit = c.bid; unit < DEPTH * 96; unit += c.G) {
        const int l = unit / 96, j0 = (unit % 96) * 64;
        const float* w = wmod + (size_t)l * D * 6144 + j0 + c.lane;
        float acc[5] = {0.f, 0.f, 0.f, 0.f, 0.f};
        const int kb = c.wave * 128;
#pragma unroll 32
        for (int k = 0; k < 128; ++k) { const float wv = w[(size_t)(kb + k) * 6144];
#pragma unroll
            for (int r = 0; r < 5; ++r) acc[r] += s[r * 1024 + kb + k] * wv; }
#pragma unroll
        for (int r = 0; r < 5; ++r) part[(c.wave * 5 + r) * 64 + c.lane] = acc[r];
        __syncthreads();
        if (c.tid < 320) { const int r = c.tid >> 6, ln = c.tid & 63; float sum = 0.f;
#pragma unroll
            for (int w8 = 0; w8 < 8; ++w8) sum += part[(w8 * 5 + r) * 64 + ln];
            mod[(size_t)(l * 5 + r) * 6144 + j0 + ln] = sum + bmod[l * 6144 + j0 + ln]; }
        __syncthreads();
    }
}

__device__ __forceinline__ void ph_filt(const Ctx& c0) {
    const Ctx c = mk_ctx(c0.lds, c0.ws);
    const float* hb1 = inp(c, I_HB1); const float* hw1 = inp(c, I_HW1); const float* hb2 = inp(c, I_HB2); const float* hw2 = inp(c, I_HW2); const float* hfreq = inp(c, I_HFREQ); const float* hw3 = inp(c, I_HW3);
    LAS float* zb = (LAS float*)c.lds;
    LAS float* a1 = zb + 16 * 36;
    LAS float* a2 = a1 + 16 * 64;
    const float MINDEC = -3.0701134573253945f, MAXDEC = -15.350567286626973f;
    for (int unit = c.bid; unit < DEPTH * 272; unit += c.G) {
        const int l = unit / 272, uu = unit % 272;
        const int L = uu < 256 ? 4096 : 256, p0 = uu < 256 ? uu * 16 : (uu - 256) * 16;
        for (int i = c.tid; i < 16 * 33; i += NTHR) { const int p = i / 33, q = i % 33; const int pos = p0 + p; float v;
            if (q == 0) v = (float)pos / (float)(L - 1);
            else { const int j = (q - 1) & 15; const double band = 1e-4 + (double)j * ((15.0 - 1e-4) / 15.0); double rev = (double)pos * band / (double)L; rev -= floor(rev);
                v = q <= 16 ? __builtin_amdgcn_cosf((float)rev) : -__builtin_amdgcn_sinf((float)rev); }
            zb[p * 36 + q] = v; }
        __syncthreads();
        for (int i = c.tid; i < 16 * 64; i += NTHR) { const int p = i >> 6, j = i & 63; float s = hb1[l * 64 + j];
            const float* w = hw1 + (size_t)l * 33 * 64 + j;
            for (int q = 0; q < 33; ++q) s += zb[p * 36 + q] * w[q * 64];
            a1[p * 64 + j] = sin_rad(hfreq[l * 128 + j] * s); }
        __syncthreads();
        for (int i = c.tid; i < 16 * 64; i += NTHR) { const int p = i >> 6, j = i & 63; float s = hb2[l * 64 + j];
            const float* w = hw2 + (size_t)l * 64 * 64 + j;
            for (int q = 0; q < 64; ++q) s += a1[p * 64 + q] * w[q * 64];
            a2[p * 64 + j] = sin_rad(hfreq[l * 128 + 64 + j] * s); }
        __syncthreads();
        {
            float acc0[16], acc1[16];
#pragma unroll
            for (int p = 0; p < 16; ++p) { acc0[p] = 0.f; acc1[p] = 0.f; }
            const float* w3 = hw3 + (size_t)l * 64 * 1024 + c.tid;
            for (int k = 0; k < 64; ++k) { const float wa = w3[k * 1024], wb = w3[k * 1024 + 512];
#pragma unroll
                for (int p = 0; p < 16; ++p) { const float av = a2[p * 64 + k]; acc0[p] += av * wa; acc1[p] += av * wb; } }
            bf16_t* hro = uu < 256 ? (bf16_t*)(c.ws + WS_HRL) + ((size_t)(l * 2) * 512 + c.tid) * (4096 + 64) : (bf16_t*)(c.ws + WS_HRC) + ((size_t)(l * 2) * 512 + c.tid) * (256 + 64);
            const size_t ostride = (size_t)512 * (L + 64);
            float f0[16], f1[16];
            const float r0 = fabsf(MINDEC + (float)c.tid * ((MAXDEC - MINDEC) / 1023.f)), r1 = fabsf(MINDEC + (float)(c.tid + 512) * ((MAXDEC - MINDEC) / 1023.f));
#pragma unroll
            for (int p = 0; p < 16; ++p) { const int pos = p0 + p; const float dist = fabsf((float)(pos - L / 2)) * (2.f / (float)L);
                f0[p] = acc0[p] * (__expf(-dist * r0) + 0.05f); f1[p] = acc1[p] * (__expf(-dist * r1) + 0.05f); }
            {   u32x4 w0, w1, v0, v1;
                w0.x = cvt_pk_bf16(f0[15], f0[14]); w0.y = cvt_pk_bf16(f0[13], f0[12]); w0.z = cvt_pk_bf16(f0[11], f0[10]); w0.w = cvt_pk_bf16(f0[9], f0[8]);
                w1.x = cvt_pk_bf16(f0[7], f0[6]); w1.y = cvt_pk_bf16(f0[5], f0[4]); w1.z = cvt_pk_bf16(f0[3], f0[2]); w1.w = cvt_pk_bf16(f0[1], f0[0]);
                v0.x = cvt_pk_bf16(f1[15], f1[14]); v0.y = cvt_pk_bf16(f1[13], f1[12]); v0.z = cvt_pk_bf16(f1[11], f1[10]); v0.w = cvt_pk_bf16(f1[9], f1[8]);
                v1.x = cvt_pk_bf16(f1[7], f1[6]); v1.y = cvt_pk_bf16(f1[5], f1[4]); v1.z = cvt_pk_bf16(f1[3], f1[2]); v1.w = cvt_pk_bf16(f1[1], f1[0]);
                bf16_t* d0 = hro + (L + 16 - p0); bf16_t* d1 = d0 + ostride;
                *(u32x4*)d0 = w0; *(u32x4*)(d0 + 8) = w1; *(u32x4*)d1 = v0; *(u32x4*)(d1 + 8) = v1;
                const u32x4 z4 = (u32x4){0u, 0u, 0u, 0u};
                if (p0 == 0) { for (int k = 0; k < 4; ++k) { *(u32x4*)(hro + L + 32 + 8 * k) = z4; *(u32x4*)(hro + ostride + L + 32 + 8 * k) = z4; } }
                if (p0 == L - 16) { for (int k = 0; k < 4; ++k) { *(u32x4*)(hro + 8 * k) = z4; *(u32x4*)(hro + ostride + 8 * k) = z4; } } }
        }
        __syncthreads();
    }
}

struct MoeComb { const int* route; const float* rwt; const bf16_t* y; const float* gate; };
__device__ __forceinline__ void moe_combine_row(const MoeComb& mc, const LAS unsigned* offs, int row, int b, int lane, f32x4 (&v)[4]) {
    const int e1 = mc.route[(size_t)row * 4 + 0], p1 = mc.route[(size_t)row * 4 + 1], e2 = mc.route[(size_t)row * 4 + 2], p2 = mc.route[(size_t)row * 4 + 3];
    const float w1 = mc.rwt[(size_t)row * 2], w2 = mc.rwt[(size_t)row * 2 + 1];
    const size_t s1 = (size_t)offs[e1] + p1, s2 = (size_t)offs[e2] + p2;
    const float* gt = mc.gate + (size_t)b * 6144;
#pragma unroll
    for (int j = 0; j < 4; ++j) { const int k0 = 4 * (lane + 64 * j);
        const u32x2 a = *(const u32x2*)(mc.y + s1 * D + k0), bq = *(const u32x2*)(mc.y + s2 * D + k0); const f32x4 g4 = *(const f32x4*)(gt + k0);
        v[j][0] += g4[0] * (w1 * bflo(a.x) + w2 * bflo(bq.x)); v[j][1] += g4[1] * (w1 * bfhi(a.x) + w2 * bfhi(bq.x));
        v[j][2] += g4[2] * (w1 * bflo(a.y) + w2 * bflo(bq.y)); v[j][3] += g4[3] * (w1 * bfhi(a.y) + w2 * bfhi(bq.y)); }
}
__device__ __forceinline__ void moe_offsets(const Ctx& c, int i, LAS unsigned* offs) {
    if (c.tid == 0) { const unsigned* cnt = (const unsigned*)(c.ws + WS_CTL) + CW_CNT + 64 * i; unsigned o = 0;
        for (int e = 0; e < 8; ++e) { offs[e] = o; o += (cnt[e] + 255u) & ~255u; } offs[8] = o; }
}
__device__ __forceinline__ void ph_norm(const Ctx& c0, int l, int which) {
    const Ctx c = mk_ctx(c0.lds, c0.ws);
    float* xres = (float*)(c.ws + WS_X); bf16_t* h = (bf16_t*)(c.ws + WS_H);
    const float* mod = (const float*)(c.ws + WS_MOD) + (size_t)l * 5 * 6144;
    const float* gp = (which == 0 ? inp(c, I_N1G) : inp(c, I_N2G)) + l * D;
    const bool first = (l == 0 && which == 0), route = (which == 1 && (l & 1));
    const int comb = (which == 0 && l >= 1 && ((l - 1) & 1)) ? ((l - 1) >> 1) : -1;
    const float* router = inp(c, I_ROUTER) + (size_t)(l >> 1) * D * NE;
    int* routeb = (int*)(c.ws + WS_ROUTE); float* rwt = (float*)(c.ws + WS_RWT); int* tokenof = (int*)(c.ws + WS_TOK);
    const MoeComb mc{routeb, rwt, (const bf16_t*)(c.ws + WS_Y), (const float*)(c.ws + WS_MOD) + (size_t)(l > 0 ? l - 1 : 0) * 5 * 6144 + 5 * 1024};
    LAS unsigned* lcnt = (LAS unsigned*)c.lds; LAS unsigned* gbase = lcnt + 16; LAS unsigned* offs = lcnt + 32; LAS int* pend = (LAS int*)(c.lds + 256);
    if (c.tid < 8) lcnt[c.tid] = 0u;
    if (comb >= 0) moe_offsets(c, comb, offs);
    __syncthreads();
    const float* xin = inp(c, I_X); const float* ctxin = inp(c, I_CTX);
    int nrows = 0;
    const int nrow_all = (which == 1 && l == DEPTH - 1) ? TL : T;
    for (int row = c.bid * NWAVES + c.wave; row < nrow_all; row += c.G * NWAVES, ++nrows) {
        const float* src = first ? (row < TL ? xin + (size_t)row * D : ctxin + (size_t)(row - TL) * D) : xres + (size_t)row * D;
        const int b = row < TL ? (row >> 12) : 4;
        const float* sh = mod + (size_t)b * 6144 + (which == 0 ? 0 : 3) * 1024; const float* sc = sh + 1024;
        f32x4 v[4]; float ss = 0.f;
#pragma unroll
        for (int j = 0; j < 4; ++j) v[j] = *(const f32x4*)(src + 4 * (c.lane + 64 * j));
        if (comb >= 0) moe_combine_row(mc, offs, row, b, c.lane, v);
#pragma unroll
        for (int j = 0; j < 4; ++j) ss += (v[j][0] * v[j][0] + v[j][1] * v[j][1]) + (v[j][2] * v[j][2] + v[j][3] * v[j][3]);
        ss = wave_sum(ss, c.lane);
        const float rstd = 1.f / sqrtf(ss * (1.f / D) + EPS);
        if (first || comb >= 0) {
#pragma unroll
            for (int j = 0; j < 4; ++j) *(f32x4*)(xres + (size_t)row * D + 4 * (c.lane + 64 * j)) = v[j];
        }
        float lg[8] = {0.f, 0.f, 0.f, 0.f, 0.f, 0.f, 0.f, 0.f};
#pragma unroll
        for (int j = 0; j < 4; ++j) { const int k0 = 4 * (c.lane + 64 * j);
            const f32x4 g4 = *(const f32x4*)(gp + k0), s4 = *(const f32x4*)(sc + k0), h4 = *(const f32x4*)(sh + k0);
            f32x4 o;
#pragma unroll
            for (int q = 0; q < 4; ++q) o[q] = v[j][q] * rstd * g4[q] * (1.f + s4[q]) + h4[q];
            u32x2 w; w.x = cvt_pk_bf16(o[0], o[1]); w.y = cvt_pk_bf16(o[2], o[3]);
            *(u32x2*)(h + (size_t)row * D + k0) = w;
            if (route) {
#pragma unroll
                for (int q = 0; q < 4; ++q) { const f32x4 ra = *(const f32x4*)(router + (size_t)(k0 + q) * 8), rb = *(const f32x4*)(router + (size_t)(k0 + q) * 8 + 4);
                    lg[0] += o[q] * ra[0]; lg[1] += o[q] * ra[1]; lg[2] += o[q] * ra[2]; lg[3] += o[q] * ra[3];
                    lg[4] += o[q] * rb[0]; lg[5] += o[q] * rb[1]; lg[6] += o[q] * rb[2]; lg[7] += o[q] * rb[3]; }
            }
        }
        if (route) {
#pragma unroll
            for (int e = 0; e < 8; ++e) lg[e] = wave_sum(lg[e], c.lane);
            int i1 = 0; float v1 = lg[0];
#pragma unroll
            for (int e = 1; e < 8; ++e) if (lg[e] > v1) { v1 = lg[e]; i1 = e; }
            int i2 = -1; float v2 = -3.0e38f;
#pragma unroll
            for (int e = 0; e < 8; ++e) if (e != i1 && lg[e] > v2) { v2 = lg[e]; i2 = e; }
            const float w1 = 1.f / (1.f + __expf(v2 - v1)), w2 = 1.f - w1;
            if (c.lane == 0) {
                const unsigned lp1 = __hip_atomic_fetch_add(lcnt + i1, 1u, __ATOMIC_RELAXED, __HIP_MEMORY_SCOPE_WORKGROUP), lp2 = __hip_atomic_fetch_add(lcnt + i2, 1u, __ATOMIC_RELAXED, __HIP_MEMORY_SCOPE_WORKGROUP);
                LAS int* pe = pend + (c.wave * 16 + nrows) * 4; pe[0] = row; pe[1] = i1 | (i2 << 8); pe[2] = (int)lp1; pe[3] = (int)lp2;
                rwt[(size_t)row * 2] = w1; rwt[(size_t)row * 2 + 1] = w2; }
        }
    }
    if (route) {
        __syncthreads();
        if (c.tid < 8) gbase[c.tid] = __hip_atomic_fetch_add((unsigned*)(c.ws + WS_CTL) + CW_CNT + 64 * (l >> 1) + c.tid, lcnt[c.tid], __ATOMIC_RELAXED, __HIP_MEMORY_SCOPE_AGENT);
        __syncthreads();
        if (c.lane < nrows) { const LAS int* pe = pend + (c.wave * 16 + c.lane) * 4; const int row = pe[0], e1 = pe[1] & 255, e2 = pe[1] >> 8;
            const int p1 = (int)gbase[e1] + pe[2], p2 = (int)gbase[e2] + pe[3];
            tokenof[(size_t)e1 * T + p1] = row; tokenof[(size_t)e2 * T + p2] = row;
            routeb[(size_t)row * 4 + 0] = e1; routeb[(size_t)row * 4 + 1] = p1; routeb[(size_t)row * 4 + 2] = e2; routeb[(size_t)row * 4 + 3] = p2; }
    }
    __syncthreads();
}

__device__ __forceinline__ void ph_sc(const Ctx& c0, int l) {
    const Ctx c = mk_ctx(c0.lds, c0.ws);
    const bf16_t* P = (const bf16_t*)(c.ws + WS_P); bf16_t* uT = (bf16_t*)(c.ws + WS_B); bf16_t* VT = (bf16_t*)(c.ws + WS_VT);
    const float* cw = inp(c, I_HCW) + (size_t)l * 3 * 1536; const float* cb = inp(c, I_HCB) + (size_t)l * 1536;
    LAS unsigned char* scr = c.lds + c.wave * 16384;
    for (int tile = c.bid * NWAVES + c.wave; tile < (T / 64) * 32; tile += c.G * NWAVES) {
        const int rt = tile / 32, row0 = rt * 64, ct = tile % 32; const bool isv = ct >= 24;
        const int ch0 = isv ? (ct - 24) * 64 : ct * 64, scol = isv ? PV + ch0 : PHY + ch0; bf16_t* dst = isv ? VT : uT;
        const int tpos = row0 < TL ? (row0 & 4095) : ((row0 - TL) & 255), Ls = row0 < TL ? 4096 : 256;
        for (int idx = c.lane; idx < 66 * 8; idx += 64) { const int rr = idx >> 3, ck = idx & 7; const int grow = row0 - 1 + rr;
            const bool ok = !((rr == 0 && tpos == 0) || (rr == 65 && tpos + 64 == Ls));
            u32x4 v = (u32x4){0u, 0u, 0u, 0u};
            if (ok) v = *(const u32x4*)(P + (size_t)grow * PW + scol + ck * 8);
            LAS unsigned* d = (LAS unsigned*)(scr + rr * 132 + ck * 16); d[0] = v.x; d[1] = v.y; d[2] = v.z; d[3] = v.w; }
        LDS_WAIT(); asm volatile("" ::: "memory");
        const int ch = ch0 + c.lane; const float w0 = isv ? 0.f : cw[ch], w1 = isv ? 1.f : cw[1536 + ch], w2 = isv ? 0.f : cw[3072 + ch], bb = isv ? 0.f : cb[ch];
        unsigned ow[32];
        { float prev = bf2f(*(const LAS unsigned short*)(scr + 0 * 132 + c.lane * 2)), cur = bf2f(*(const LAS unsigned short*)(scr + 1 * 132 + c.lane * 2)); float o0 = 0.f;
#pragma unroll
          for (int r = 0; r < 64; ++r) { const float nxt = bf2f(*(const LAS unsigned short*)(scr + (r + 2) * 132 + c.lane * 2));
              const float o = w0 * prev + w1 * cur + w2 * nxt + bb; prev = cur; cur = nxt;
              if (r & 1) ow[r >> 1] = cvt_pk_bf16(o0, o); else o0 = o; } }
        LDS_WAIT(); asm volatile("" ::: "memory");
#pragma unroll
        for (int k = 0; k < 8; ++k) { u32x4 v; v.x = ow[4 * k]; v.y = ow[4 * k + 1]; v.z = ow[4 * k + 2]; v.w = ow[4 * k + 3]; *(LAS u32x4*)(scr + c.lane * 144 + k * 16) = v; }
        LDS_WAIT(); asm volatile("" ::: "memory");
#pragma unroll
        for (int k = 0; k < 8; ++k) { const int cc = (c.lane >> 3) + 8 * k, ck = c.lane & 7; const u32x4 v = *(const LAS u32x4*)(scr + cc * 144 + ck * 16);
            *(u32x4*)(dst + (size_t)(ch0 + cc) * T + row0 + ck * 8) = v; }
        LDS_WAIT(); asm volatile("" ::: "memory");
    }
}

constexpr int HY_HR_OFF = 512, HY_U_OFF = HY_HR_OFF + 66560, HY_ZB_OFF = HY_U_OFF + 4 * 8208;
template <int L, bool DUAL>
__device__ __forceinline__ void hy_span(LAS unsigned char* lds, int nsteps, int aaddr, int ubase, int sX, int sY, f32x16& accX, f32x16& accY) {
#define HY_BADDR(sv) (((unsigned)(sv) <= (unsigned)(L - 16)) ? ubase + 2 * (sv) : HY_ZB_OFF)
#define HY_LD(av, xv, yv, kk) do { av = *(const LAS bf16x8*)(lds + aaddr - 256 * (kk)); xv = *(const LAS bf16x8*)(lds + HY_BADDR(sX - 16 * (kk))); \
        if (DUAL) yv = *(const LAS bf16x8*)(lds + HY_BADDR(sY - 16 * (kk))); } while (0)
    bf16x8 a0, a1, x0, x1, y0 = {}, y1 = {}, pa0, pa1, px0, px1, py0 = {}, py1 = {};
    HY_LD(a0, x0, y0, 0); HY_LD(a1, x1, y1, 1);
    int k = 0;
    for (; k + 2 <= nsteps; k += 2) {
        aaddr -= 512; sX -= 32; sY -= 32;
        HY_LD(pa0, px0, py0, 0);
        accX = __builtin_amdgcn_mfma_f32_32x32x16_bf16(a0, x0, accX, 0, 0, 0); if (DUAL) accY = __builtin_amdgcn_mfma_f32_32x32x16_bf16(a0, y0, accY, 0, 0, 0);
        HY_LD(pa1, px1, py1, 1);
        accX = __builtin_amdgcn_mfma_f32_32x32x16_bf16(a1, x1, accX, 0, 0, 0); if (DUAL) accY = __builtin_amdgcn_mfma_f32_32x32x16_bf16(a1, y1, accY, 0, 0, 0);
        a0 = pa0; x0 = px0; y0 = py0; a1 = pa1; x1 = px1; y1 = py1;
    }
    if (k < nsteps) { accX = __builtin_amdgcn_mfma_f32_32x32x16_bf16(a0, x0, accX, 0, 0, 0); if (DUAL) accY = __builtin_amdgcn_mfma_f32_32x32x16_bf16(a0, y0, accY, 0, 0, 0); }
#undef HY_LD
#undef HY_BADDR
}
template <int L>
__device__ __forceinline__ void hy_unit(const Ctx& c, int l, int ch, const float* hbias) {
    constexpr int H = L / 2, NG = L / 256, LP = L + 64, NW = L / 8 + 8, ROWB = 2 * L + 16;
    LAS unsigned char* lds = c.lds;
    const bf16_t* uT = (const bf16_t*)(c.ws + WS_B); bf16_t* ohy = (bf16_t*)(c.ws + WS_OHY);
    const int seq0 = (L == 4096) ? 0 : TL;
    const bf16_t* hrbase = (L == 4096) ? (const bf16_t*)(c.ws + WS_HRL) : (const bf16_t*)(c.ws + WS_HRC);
    int gA, gB;
    if (NG == 16) { gA = c.wave < 4 ? c.wave : 4 + c.wave; gB = c.wave < 4 ? 7 - c.wave : 19 - c.wave; } else { gA = c.wave == 0 ? 0 : -1; gB = -1; }
    const int n = c.lane & 31, g = c.lane >> 5, tbl = n >> 2, b = n & 3;
    const int loA = gA < 0 ? 1 << 30 : max(-H - 16, 256 * gA - (L - 16)), hiA = gA < 0 ? -(1 << 30) : min(H, 256 * gA + 224);
    const int loB = gB < 0 ? 1 << 30 : max(-H - 16, 256 * gB - (L - 16)), hiB = gB < 0 ? -(1 << 30) : min(H, 256 * gB + 224);
    const int dlo = min(loA, loB), dhi = max(hiA, hiB);
    unsigned zreg[2][4][2];
    for (int o = 0; o < 2; ++o) {
        const bf16_t* hr = hrbase + ((size_t)(l * 2 + o) * 512 + ch) * LP;
        for (int w = c.tid; w < NW; w += NTHR) {
            u32x4 A4 = (u32x4){0u, 0u, 0u, 0u}; if (w > 0) A4 = *(const u32x4*)(hr + 8 * (w - 1));
            const u32x4 B4 = *(const u32x4*)(hr + 8 * w);
            const unsigned Dd[8] = {A4.x, A4.y, A4.z, A4.w, B4.x, B4.y, B4.z, B4.w};
#pragma unroll
            for (int q = 0; q < 8; ++q) { u32x4 ov;
                if ((q & 1) == 0) { const int j = (8 - q) / 2; ov.x = Dd[j]; ov.y = Dd[j + 1]; ov.z = Dd[j + 2]; ov.w = Dd[j + 3]; }
                else { const int j = (7 - q) / 2; ov.x = __builtin_amdgcn_alignbit(Dd[j + 1], Dd[j], 16); ov.y = __builtin_amdgcn_alignbit(Dd[j + 2], Dd[j + 1], 16);
                       ov.z = __builtin_amdgcn_alignbit(Dd[j + 3], Dd[j + 2], 16); ov.w = __builtin_amdgcn_alignbit(Dd[j + 4], Dd[j + 3], 16); }
                *(LAS u32x4*)(lds + HY_HR_OFF + (8 * w + q) * 16) = ov; }
        }
        if (o == 0) {
            for (int idx = c.tid; idx < 4 * (L / 8); idx += NTHR) { const int bb = idx / (L / 8), wq = idx % (L / 8);
                *(LAS u32x4*)(lds + HY_U_OFF + bb * ROWB + wq * 16) = *(const u32x4*)(uT + (size_t)ch * T + seq0 + bb * L + wq * 8); }
            if (c.tid < 16) *(LAS unsigned*)(lds + HY_ZB_OFF + c.tid * 4) = 0u;
        } else {
#pragma unroll
            for (int gi = 0; gi < 2; ++gi) { const int G = gi == 0 ? gA : gB; if (G >= 0) {
#pragma unroll
                for (int rq = 0; rq < 4; ++rq) { const int t = 32 * (8 * G + tbl) + 8 * rq + 4 * g;
                    u32x2 zz; zz.x = zreg[gi][rq][0]; zz.y = zreg[gi][rq][1]; *(LAS u32x2*)(lds + HY_U_OFF + b * ROWB + 2 * t) = zz; } } }
        }
        __syncthreads();
        f32x16 accA, accB;
#pragma unroll
        for (int r = 0; r < 16; ++r) { accA[r] = 0.f; accB[r] = 0.f; }
        {
            const int qq = (n + 1) & 7, ubase = HY_U_OFF + b * ROWB + 16 * g;
#define HY_AADDR(d) (HY_HR_OFF + (8 * ((H + 31 - (d) - n + 8 * g + qq) >> 3) + qq) * 16)
#define HY_S0(G, d) (32 * (8 * (G) + tbl) - (d))
            if (gB < 0) { if (gA >= 0) hy_span<L, false>(lds, (hiA - loA) / 16 + 1, HY_AADDR(loA), ubase, HY_S0(gA, loA), 0, accA, accB); }
            else {
                const int dS = max(loA, loB), dE = min(hiA, hiB);
                if (loA < dS) hy_span<L, false>(lds, (dS - loA) / 16, HY_AADDR(loA), ubase, HY_S0(gA, loA), 0, accA, accB);
                else if (loB < dS) hy_span<L, false>(lds, (dS - loB) / 16, HY_AADDR(loB), ubase, HY_S0(gB, loB), 0, accB, accA);
                hy_span<L, true>(lds, (dE - dS) / 16 + 1, HY_AADDR(dS), ubase, HY_S0(gA, dS), HY_S0(gB, dS), accA, accB);
                if (hiA > dE) hy_span<L, false>(lds, (hiA - dE) / 16, HY_AADDR(dE + 16), ubase, HY_S0(gA, dE + 16), 0, accA, accB);
                else if (hiB > dE) hy_span<L, false>(lds, (hiB - dE) / 16, HY_AADDR(dE + 16), ubase, HY_S0(gB, dE + 16), 0, accB, accA);
            }
#undef HY_AADDR
#undef HY_S0
        }
        const float bias = hbias[(l * 2 + o) * 512 + ch];
#pragma unroll
        for (int gi = 0; gi < 2; ++gi) { const int G = gi == 0 ? gA : gB; if (G >= 0) {
#pragma unroll
            for (int rq = 0; rq < 4; ++rq) { const int t = 32 * (8 * G + tbl) + 8 * rq + 4 * g;
                const u32x2 uv = *(const LAS u32x2*)(lds + HY_U_OFF + b * ROWB + 2 * t);
                const size_t grow = (size_t)seq0 + b * L + t;
                const u32x2 xv = *(const u32x2*)(uT + (size_t)((o == 0 ? 512 : 1024) + ch) * T + grow);
                float y[4];
#pragma unroll
                for (int k = 0; k < 4; ++k) y[k] = gi == 0 ? accA[4 * rq + k] : accB[4 * rq + k];
                const float r0 = bflo(xv.x) * (y[0] + bias * bflo(uv.x)), r1 = bfhi(xv.x) * (y[1] + bias * bfhi(uv.x));
                const float r2 = bflo(xv.y) * (y[2] + bias * bflo(uv.y)), r3 = bfhi(xv.y) * (y[3] + bias * bfhi(uv.y));
                const unsigned p0 = cvt_pk_bf16(r0, r1), p1 = cvt_pk_bf16(r2, r3);
                if (o == 0) { zreg[gi][rq][0] = p0; zreg[gi][rq][1] = p1; }
                else { bf16_t* op = ohy + grow * 512 + ch; op[0] = (bf16_t)(p0 & 0xffffu); op[512] = (bf16_t)(p0 >> 16); op[1024] = (bf16_t)(p1 & 0xffffu); op[1536] = (bf16_t)(p1 >> 16); } } } }
        __syncthreads();
    }
}
__device__ __forceinline__ void ph_hyena(const Ctx& c0, int l) {
    const Ctx c = mk_ctx(c0.lds, c0.ws);
    const float* hbias = inp(c, I_HBIAS);
    for (int unit = c.bid; unit < HYW; unit += c.G) { hy_unit<4096>(c, l, unit, hbias); if (l < DEPTH - 1) hy_unit<256>(c, l, unit, hbias); }
}

constexpr int ATT_RPB_OFF = 1024, ATT_VT_OFF = ATT_RPB_OFF + 8 * 15 * 32 * 4, ATT_VT_BYTES = 64 * 72;
template <int MODE>
__device__ __forceinline__ void att_block(const bf16_t* P, const bf16_t* VT, LAS unsigned char* lds, LAS unsigned char* vt, int lane, int n, int h, int head,
                                          int tokk, int ctok, int tabaddr, int vb, const bf16x8 (&qf)[4], f32x16& ot0, f32x16& ot1, float& m, float& lsum) {
    bf16x8 kf[4];
#pragma unroll
    for (int ks = 0; ks < 4; ++ks) kf[ks] = *(const bf16x8*)(P + (size_t)tokk * PW + PK + head * 64 + 16 * ks + 8 * h);
    u32x2 vr[8];
#pragma unroll
    for (int it = 0; it < 8; ++it) vr[it] = *(const u32x2*)(VT + (size_t)(head * 64 + it * 8 + (lane >> 3)) * T + ctok);
    f32x16 st;
#pragma unroll
    for (int r = 0; r < 16; ++r) st[r] = 0.f;
#pragma unroll
    for (int ks = 0; ks < 4; ++ks) st = __builtin_amdgcn_mfma_f32_32x32x16_bf16(kf[ks], qf[ks], st, 0, 0, 0);
    const float SC = 0.18033688011112042f;
    float sv[16];
#pragma unroll
    for (int r = 0; r < 16; ++r) {
        if (MODE == 2) sv[r] = st[r] * SC;
        else { const int cr = MODE == 0 ? 8 * (r >> 2) + (r & 3) : (r & 3), imm = MODE == 0 ? cr * 4 : ((r >> 2) * 32 + (r & 3)) * 4;
            const float bias = *(const LAS float*)(lds + tabaddr + imm);
            const bool ok = (unsigned)(vb + cr) < 16u;
            sv[r] = ok ? st[r] * SC + bias : -1.0e30f; }
    }
    float bm = sv[0];
#pragma unroll
    for (int r = 1; r < 16; ++r) bm = fmaxf(bm, sv[r]);
    bm = fmaxf(bm, __int_as_float(__builtin_amdgcn_ds_bpermute((lane ^ 32) << 2, __float_as_int(bm))));
    const float mn = fmaxf(m, bm), alpha = __builtin_amdgcn_exp2f(m - mn); m = mn;
    float psum = 0.f;
#pragma unroll
    for (int r = 0; r < 16; ++r) { const float pv = __builtin_amdgcn_exp2f(sv[r] - mn); psum += pv; sv[r] = pv; }
    lsum = lsum * alpha + psum;
#pragma unroll
    for (int r = 0; r < 16; ++r) { ot0[r] *= alpha; ot1[r] *= alpha; }
    bf16x8 pb[2];
#pragma unroll
    for (int s2 = 0; s2 < 2; ++s2) { u32x4 w; w.x = cvt_pk_bf16(sv[8 * s2], sv[8 * s2 + 1]); w.y = cvt_pk_bf16(sv[8 * s2 + 2], sv[8 * s2 + 3]);
        w.z = cvt_pk_bf16(sv[8 * s2 + 4], sv[8 * s2 + 5]); w.w = cvt_pk_bf16(sv[8 * s2 + 6], sv[8 * s2 + 7]); pb[s2] = __builtin_bit_cast(bf16x8, w); }
#pragma unroll
    for (int it = 0; it < 8; ++it) *(LAS u32x2*)(vt + (it * 8 + (lane >> 3)) * 72 + (lane & 7) * 8) = vr[it];
#pragma unroll
    for (int s2 = 0; s2 < 2; ++s2) {
        { const u32x2 a = *(const LAS u32x2*)(vt + n * 72 + (4 * s2 + h) * 8), bq = *(const LAS u32x2*)(vt + n * 72 + (4 * s2 + 2 + h) * 8);
          u32x4 w; w.x = a.x; w.y = a.y; w.z = bq.x; w.w = bq.y; ot0 = __builtin_amdgcn_mfma_f32_32x32x16_bf16(__builtin_bit_cast(bf16x8, w), pb[s2], ot0, 0, 0, 0); }
        { const u32x2 a = *(const LAS u32x2*)(vt + (32 + n) * 72 + (4 * s2 + h) * 8), bq = *(const LAS u32x2*)(vt + (32 + n) * 72 + (4 * s2 + 2 + h) * 8);
          u32x4 w; w.x = a.x; w.y = a.y; w.z = bq.x; w.w = bq.y; ot1 = __builtin_amdgcn_mfma_f32_32x32x16_bf16(__builtin_bit_cast(bf16x8, w), pb[s2], ot1, 0, 0, 0); }
    }
}
constexpr int ATT_UNITS = 4096 + 256;
__device__ __forceinline__ void ph_attn(const Ctx& c0, int l) {
    const Ctx c = mk_ctx(c0.lds, c0.ws);
    const bf16_t* P = (const bf16_t*)(c.ws + WS_P); const bf16_t* VT = (const bf16_t*)(c.ws + WS_VT); bf16_t* oatt = (bf16_t*)(c.ws + WS_OATT);
    const float* rpb = inp(c, I_RPB) + (size_t)l * 8 * 15 * 31;
    LAS unsigned char* lds = c.lds;
    for (int i = c.tid; i < 8 * 15 * 32; i += NTHR) { const int hd = i / 480, rem = i % 480, dr = rem >> 5, dc = rem & 31;
        *(LAS float*)(lds + ATT_RPB_OFF + i * 4) = dc < 31 ? rpb[(hd * 15 + dr) * 31 + dc] * 1.4426950408889634f : 0.f; }
    __syncthreads();
    LAS unsigned char* vt = lds + ATT_VT_OFF + c.wave * ATT_VT_BYTES;
    const int lane = c.lane, n = lane & 31, h = lane >> 5;
    const int natt = l < DEPTH - 1 ? ATT_UNITS : 4096;
    for (int u = c.bid * NWAVES + c.wave; u < natt; u += c.G * NWAVES) {
        const bool lat = u < 4096;
        int b, head, r = 0, hf = 0, tokq;
        if (lat) { hf = u & 1; r = (u >> 1) & 63; head = (u >> 7) & 7; b = u >> 10; tokq = b * 4096 + r * 64 + 32 * hf + n; }
        else { const int uu = u - 4096; head = (uu >> 3) & 7; b = uu >> 6; tokq = TL + b * 256 + 32 * (uu & 7) + n; }
        bf16x8 qf[4];
#pragma unroll
        for (int ks = 0; ks < 4; ++ks) qf[ks] = *(const bf16x8*)(P + (size_t)tokq * PW + PQ + head * 64 + 16 * ks + 8 * h);
        f32x16 ot0, ot1;
#pragma unroll
        for (int q = 0; q < 16; ++q) { ot0[q] = 0.f; ot1[q] = 0.f; }
        float m = -1.0e30f, lsum = 0.f;
        if (lat) {
            const int r0 = min(max(r - 4, 0), 56), lo = hf ? 24 : 0, qc = 32 * hf + n, c0q = min(max(qc - 8, 0), 48);
            for (int kb = 0; kb < 8; ++kb) {
                const int base = b * 4096 + (r0 + kb) * 64 + lo, kx = lo + 4 * h;
                const int tabaddr = ATT_RPB_OFF + (((head * 15 + (r0 + kb - r + 7)) * 32) + kx - qc + 15) * 4;
                att_block<0>(P, VT, lds, vt, lane, n, h, head, base + n, base + 4 * (lane & 7), tabaddr, kx - c0q, qf, ot0, ot1, m, lsum);
            }
            for (int kb = 0; kb < 2; ++kb) {
                const int rowb = b * 4096 + (r0 + 4 * kb) * 64 + lo + 32, kx = lo + 32 + 4 * h, cc = lane & 7;
                const int tabaddr = ATT_RPB_OFF + (((head * 15 + (r0 + 4 * kb - r + 7)) * 32) + kx - qc + 15) * 4;
                att_block<1>(P, VT, lds, vt, lane, n, h, head, rowb + (n >> 3) * 64 + (n & 7), rowb + (cc >> 1) * 64 + 4 * (cc & 1), tabaddr, kx - c0q, qf, ot0, ot1, m, lsum);
            }
        }
        for (int kb = 0; kb < 8; ++kb) { const int base = TL + b * 256 + 32 * kb;
            att_block<2>(P, VT, lds, vt, lane, n, h, head, base + n, base + 4 * (lane & 7), 0, 0, qf, ot0, ot1, m, lsum); }
        const float ltot = lsum + __int_as_float(__builtin_amdgcn_ds_bpermute((lane ^ 32) << 2, __float_as_int(lsum)));
        const float inv = 1.f / ltot;
        bf16_t* op = oatt + (size_t)tokq * 512 + head * 64 + 4 * h;
#pragma unroll
        for (int rq = 0; rq < 4; ++rq) {
            u32x2 w0, w1; w0.x = cvt_pk_bf16(ot0[4 * rq] * inv, ot0[4 * rq + 1] * inv); w0.y = cvt_pk_bf16(ot0[4 * rq + 2] * inv, ot0[4 * rq + 3] * inv);
            w1.x = cvt_pk_bf16(ot1[4 * rq] * inv, ot1[4 * rq + 1] * inv); w1.y = cvt_pk_bf16(ot1[4 * rq + 2] * inv, ot1[4 * rq + 3] * inv);
            *(u32x2*)(op + 8 * rq) = w0; *(u32x2*)(op + 32 + 8 * rq) = w1; }
    }
    __syncthreads();
}

__device__ __forceinline__ void ph_final(const Ctx& c0) {
    const Ctx c = mk_ctx(c0.lds, c0.ws);
    const float* xres = (const float*)(c.ws + WS_X); const float* gp = inp(c, I_FINALG); float* outp = (float*)inp(c, 30);
    const MoeComb mc{(const int*)(c.ws + WS_ROUTE), (const float*)(c.ws + WS_RWT), (const bf16_t*)(c.ws + WS_Y), (const float*)(c.ws + WS_MOD) + (size_t)(DEPTH - 1) * 5 * 6144 + 5 * 1024};
    LAS unsigned* offs = (LAS unsigned*)c.lds + 32;
    moe_offsets(c, 1, offs);
    __syncthreads();
    for (int row = c.bid * NWAVES + c.wave; row < TL; row += c.G * NWAVES) {
        const float* src = xres + (size_t)row * D; f32x4 v[4]; float ss = 0.f;
#pragma unroll
        for (int j = 0; j < 4; ++j) v[j] = *(const f32x4*)(src + 4 * (c.lane + 64 * j));
        moe_combine_row(mc, offs, row, row >> 12, c.lane, v);
#pragma unroll
        for (int j = 0; j < 4; ++j) ss += (v[j][0] * v[j][0] + v[j][1] * v[j][1]) + (v[j][2] * v[j][2] + v[j][3] * v[j][3]);
        ss = wave_sum(ss, c.lane);
        const float rstd = 1.f / sqrtf(ss * (1.f / D) + EPS);
#pragma unroll
        for (int j = 0; j < 4; ++j) { const int k0 = 4 * (c.lane + 64 * j); const f32x4 g4 = *(const f32x4*)(gp + k0); *(f32x4*)(outp + (size_t)row * D + k0) = v[j] * rstd * g4; }
    }
}

constexpr int MOE_OFF = 132096;
template <bool GATHER_> struct MoeOrder {
    static constexpr bool GATHER = GATHER_;
    int nM, nN, nwg, G, c; const char* A; const char* B; size_t astep, bstep, estep; const int* tokenof; const LAS unsigned* tab;
    __device__ void init(const void* A_, int lda, const void* B_, int ldb, size_t estep_bytes, int N, int G_, int c_, const int* tok, const LAS unsigned* tab_) {
        tab = tab_; nM = (int)((unsigned)__builtin_amdgcn_readfirstlane(tab[8]) >> 8); nN = N / pg8::BM; nwg = nM * nN; G = G_; c = c_; A = (const char*)A_; B = (const char*)B_;
        astep = (size_t)pg8::BM * lda * 2; bstep = (size_t)pg8::BM * ldb * 2; estep = estep_bytes; tokenof = tok; }
    __device__ bool next(int i, pg8::Unit& u) const {
        const long L = (long)i * G + c; if (L >= nwg) return false;
        int wgid = (int)L; { const int q = nwg / pg8::NXCD, r = nwg % pg8::NXCD, xcd = wgid % pg8::NXCD, off = wgid / pg8::NXCD; wgid = (xcd < r ? xcd * (q + 1) : r * (q + 1) + (xcd - r) * q) + off; }
        const int nig = pg8::WGM * nN, gid = wgid / nig, fm = gid * pg8::WGM, gsz = (nM - fm) < pg8::WGM ? (nM - fm) : pg8::WGM;
        u.pm = fm + ((wgid % nig) % gsz); u.pn = (wgid % nig) / gsz;
        const unsigned slot0 = (unsigned)u.pm << 8; int e = 0;
#pragma unroll
        for (int j = 1; j < 8; ++j) e += (slot0 >= (unsigned)__builtin_amdgcn_readfirstlane(tab[j])) ? 1 : 0;
        const unsigned pos0 = slot0 - (unsigned)__builtin_amdgcn_readfirstlane(tab[e]), cnt = (unsigned)__builtin_amdgcn_readfirstlane(tab[16 + e]);
        u.nvalid = cnt > pos0 ? (int)(cnt - pos0) : 0; u.tk = tokenof + (size_t)e * T + pos0;
        u.a = GATHER ? A : A + (size_t)u.pm * astep; u.b = B + (size_t)e * estep + (size_t)u.pn * bstep; return true;
    }
    __device__ __forceinline__ int arow(const pg8::Unit& u, int r) const { return r < u.nvalid ? u.tk[r] : 0; }
    __device__ __forceinline__ void a_ready(const pg8::Unit&) const {}
    __device__ __forceinline__ void done(const pg8::Unit&) const {}
};
__device__ __forceinline__ void moe_table(const Ctx& c, int i) {
    LAS unsigned* tab = (LAS unsigned*)(c.lds + MOE_OFF);
    if (c.tid == 0) { const unsigned* cnt = (const unsigned*)(c.ws + WS_CTL) + CW_CNT + 64 * i; unsigned o = 0;
        for (int e = 0; e < 8; ++e) { const unsigned ce = cnt[e]; tab[e] = o; tab[16 + e] = ce; o += (ce + 255u) & ~255u; } tab[8] = o; }
    __syncthreads();
}

#define XB_TMO      128
#define XB_XCNT(j)  (256  + 64 * (j))
#define XB_XSUB(j)  (1280 + 64 * (j))
#define XB_XGEN(j)  (2304 + 64 * (j))
#define XB_TOP      3328
#define XB_TOPGEN   3392
#define XCD_BAR_WORDS 3456
#define XB_SPIN_CAP (1u << 18)
__device__ __forceinline__ unsigned xb_ld(unsigned* p)              { return __hip_atomic_load(p, __ATOMIC_RELAXED, __HIP_MEMORY_SCOPE_AGENT); }
__device__ __forceinline__ unsigned xb_add(unsigned* p, unsigned v) { return __hip_atomic_fetch_add(p, v, __ATOMIC_RELAXED, __HIP_MEMORY_SCOPE_AGENT); }
__device__ __forceinline__ unsigned xb_xcc_id() { return (unsigned)__builtin_amdgcn_s_getreg((3 << 11) | 20) & 0xFu; }
#define XB_SPIN(cond, bar) do { unsigned _sp = 0; while (cond) { __builtin_amdgcn_s_sleep(1); \
    if ((++_sp & 255u) == 0u) { if (xb_ld(&(bar)[XB_TMO])) break; if (_sp > XB_SPIN_CAP) { atomicAdd(&(bar)[XB_TMO], 1u); break; } } } } while (0)
struct XcdBarrier { unsigned* bar; unsigned x; volatile LAS unsigned* st; };
__device__ __forceinline__ XcdBarrier xcd_barrier_post(unsigned* bar, volatile LAS unsigned* st) {
    XcdBarrier b; b.bar = bar; b.x = xb_xcc_id(); b.st = st;
    if (threadIdx.x == 0) (void)xb_add(&bar[XB_XCNT(b.x)], 1u);
    return b;
}
__device__ __forceinline__ void xcd_barrier_complete(unsigned* bar, unsigned x, unsigned& nloc, unsigned& nx) {
    const unsigned G = gridDim.x * gridDim.y * gridDim.z;
    unsigned sum, cnt, mine, sp = 0u;
    for (;;) {
        sum = 0u; cnt = 0u; mine = 0u;
#pragma unroll
        for (unsigned j = 0; j < 16; ++j) { const unsigned c = xb_ld(&bar[XB_XCNT(j)]); sum += c; cnt += (c > 0u) ? 1u : 0u; mine = (j == x) ? c : mine; }
        if (sum == G) break;
        __builtin_amdgcn_s_sleep(1);
        if ((++sp & 255u) == 0u) { if (xb_ld(&bar[XB_TMO])) break; if (sp > XB_SPIN_CAP) { atomicAdd(&bar[XB_TMO], 1u); break; } }
    }
    nloc = mine > 0u ? mine : 1u; nx = cnt > 0u ? cnt : 1u;
}
__device__ __forceinline__ void xcd_barrier(const XcdBarrier& b) {
    asm volatile("s_waitcnt vmcnt(0)" ::: "memory");
    __syncthreads();
    if (threadIdx.x == 0) {
        unsigned* bar = b.bar; const unsigned bx = xb_xcc_id();
        __builtin_amdgcn_s_waitcnt(0);
        unsigned nloc = b.st[0], nx = b.st[1];
        if (nloc == 0u) { xcd_barrier_complete(bar, bx, nloc, nx); b.st[0] = nloc; b.st[1] = nx; }
        const unsigned old = xb_add(&bar[XB_XSUB(bx)], 1u);
        const unsigned gen = old / nloc;
        if (old + 1u == (gen + 1u) * nloc) {
            __builtin_amdgcn_fence(__ATOMIC_RELEASE, "agent");
            asm volatile("s_waitcnt vmcnt(0)" ::: "memory");
            const unsigned og = xb_add(&bar[XB_TOP], 1u);
            const unsigned tg = og / nx;
            if (og + 1u == (tg + 1u) * nx) xb_add(&bar[XB_TOPGEN], 1u);
            else XB_SPIN(xb_ld(&bar[XB_TOPGEN]) == tg, bar);
            __builtin_amdgcn_fence(__ATOMIC_ACQUIRE, "agent");
            xb_add(&bar[XB_XGEN(bx)], 1u);
            asm volatile("s_waitcnt vmcnt(0)" ::: "memory");
        } else {
            XB_SPIN(xb_ld(&bar[XB_XGEN(bx)]) == gen, bar);
            __builtin_amdgcn_fence(__ATOMIC_ACQUIRE, "agent");
            asm volatile("s_waitcnt vmcnt(0)" ::: "memory");
        }
    }
    __syncthreads();
}

constexpr int CW_BAR = 4096;

__global__ void __launch_bounds__(NTHR, 2) fwd(Args args) {
    extern __shared__ __attribute__((aligned(16))) unsigned char lds_raw[];
    Ctx c; c.lds = (LAS unsigned char*)lds_raw; c.tid = threadIdx.x; c.lane = c.tid & 63; c.wave = __builtin_amdgcn_readfirstlane(c.tid >> 6); c.G = gridDim.x; c.bid = blockIdx.x; c.ws = args.ws;
    unsigned char* ws = args.ws;
    volatile LAS unsigned* MISC = (volatile LAS unsigned*)(c.lds + MISC_OFF);
    if (c.tid < 32) MISC[c.tid] = 0u;
    if (c.tid < 31) { const unsigned long long pv = c.tid < 30 ? (unsigned long long)args.in[c.tid] : (unsigned long long)args.out;
        volatile LAS unsigned* pt = (volatile LAS unsigned*)(c.lds + PTR_OFF) + 2 * c.tid; pt[0] = (unsigned)pv; pt[1] = (unsigned)(pv >> 32); }
    __syncthreads();
    XcdBarrier bar = xcd_barrier_post((unsigned*)(ws + WS_CTL) + CW_BAR, MISC + 8);
#define GRID_BAR() xcd_barrier(bar)

    ph_convert(c); __syncthreads(); ph_mod(c); __syncthreads(); ph_filt(c);
    GRID_BAR();
    for (int l = 0; l < DEPTH; ++l) {
        ph_norm(c, l, 0);
        GRID_BAR();
        {   unsigned char* ws = c.ws; asm volatile("" : "+s"(ws));
            pg8::Gemm g{D, D, D}; pg8::StaticOrder S; S.init(ws + WS_H, D, (bf16_t*)(ws + WS_WIN) + (size_t)l * PW * D, D, T, PW, c.G, c.bid);
            EpiStoreBf16 E{(bf16_t*)(ws + WS_P), PW};
            pg8::gemm_phase(c.lds, g, S, E); }
        GRID_BAR();
        ph_sc(c, l);
        GRID_BAR();
        ph_hyena(c, l); ph_attn(c, l);
        GRID_BAR();
        {   unsigned char* ws = c.ws; asm volatile("" : "+s"(ws));
            pg8::Gemm g{512, 512, 512};
            { pg8::StaticOrder S; S.init(ws + WS_OATT, 512, (bf16_t*)(ws + WS_WPA) + (size_t)l * D * 512, 512, TL, D, c.G, c.bid);
              EpiMerge1 E{(float*)(ws + WS_B), (const bf16_t*)(ws + WS_P)};
              pg8::gemm_phase(c.lds, g, S, E); }
            if (l < DEPTH - 1) ctx_gemm((const bf16_t*)(ws + WS_OATT), 512, (const bf16_t*)(ws + WS_WPA) + (size_t)l * D * 512, 512, 512, CEpiMerge1{(float*)(ws + WS_B), (const bf16_t*)(ws + WS_P)});
            { pg8::StaticOrder S; S.init(ws + WS_OHY, 512, (bf16_t*)(ws + WS_WPB) + (size_t)l * D * 512, 512, TL, D, c.G, c.bid);
              EpiMerge2 E{(const float*)(ws + WS_B), (const bf16_t*)(ws + WS_P), (bf16_t*)(ws + WS_H)};
              pg8::gemm_phase(c.lds, g, S, E); }
            if (l < DEPTH - 1) ctx_gemm((const bf16_t*)(ws + WS_OHY), 512, (const bf16_t*)(ws + WS_WPB) + (size_t)l * D * 512, 512, 512, CEpiMerge2{(const float*)(ws + WS_B), (const bf16_t*)(ws + WS_P), (bf16_t*)(ws + WS_H)}); }
        GRID_BAR();
        {   unsigned char* ws = c.ws; asm volatile("" : "+s"(ws));
            const float* modl = (const float*)(ws + WS_MOD) + (size_t)l * 5 * 6144;
            pg8::Gemm g{D, D, D}; pg8::StaticOrder S; S.init(ws + WS_H, D, (bf16_t*)(ws + WS_WO) + (size_t)l * D * D, D, TL, D, c.G, c.bid);
            EpiResid E{(float*)(ws + WS_X), modl + 2 * 1024};
            pg8::gemm_phase(c.lds, g, S, E);
            if (l < DEPTH - 1) ctx_gemm((const bf16_t*)(ws + WS_H), D, (const bf16_t*)(ws + WS_WO) + (size_t)l * D * D, D, D, CEpiResid{(float*)(ws + WS_X), modl + 4 * 6144 + 2 * 1024}); }
        GRID_BAR();
        ph_norm(c, l, 1);
        GRID_BAR();
        if ((l & 1) == 0) {
            {   unsigned char* ws = c.ws; asm volatile("" : "+s"(ws));
                const bf16_t* w = (const bf16_t*)(ws + WS_W13D) + (size_t)(l >> 1) * 2 * FF * D;
                pg8::Gemm g{D, D, D}; pg8::StaticOrder S; S.init(ws + WS_H, D, w, D, T, 2 * FF, c.G, c.bid);
                EpiSwiglu E{(bf16_t*)(ws + WS_P)};
                pg8::gemm_phase(c.lds, g, S, E); }
            GRID_BAR();
            {   unsigned char* ws = c.ws; asm volatile("" : "+s"(ws));
                const float* modl = (const float*)(ws + WS_MOD) + (size_t)l * 5 * 6144;
                const bf16_t* w = (const bf16_t*)(ws + WS_W2D) + (size_t)(l >> 1) * D * FF;
                pg8::Gemm g{FF, FF, FF}; pg8::StaticOrder S; S.init(ws + WS_P, FF, w, FF, TL, D, c.G, c.bid);
                EpiResid E{(float*)(ws + WS_X), modl + 5 * 1024};
                pg8::gemm_phase(c.lds, g, S, E);
                ctx_gemm((const bf16_t*)(ws + WS_P), FF, w, FF, FF, CEpiResid{(float*)(ws + WS_X), modl + 4 * 6144 + 5 * 1024}); }
            GRID_BAR();
        } else {
            const Ctx cm = mk_ctx(c.lds, c.ws);
            moe_table(cm, l >> 1);
            {   unsigned char* ws = c.ws; asm volatile("" : "+s"(ws));
                const bf16_t* w = (const bf16_t*)(ws + WS_W13M) + (size_t)((l >> 1) * NE) * 2 * FF * D;
                pg8::Gemm g{D, D, D}; MoeOrder<true> S; S.init(ws + WS_H, D, w, D, (size_t)2 * FF * D * 2, 2 * FF, c.G, c.bid, (const int*)(ws + WS_TOK), (const LAS unsigned*)(c.lds + MOE_OFF));
                EpiSwiglu E{(bf16_t*)(ws + WS_P)};
                pg8::gemm_phase(c.lds, g, S, E); }
            GRID_BAR();
            {   unsigned char* ws = c.ws; asm volatile("" : "+s"(ws));
                const bf16_t* w = (const bf16_t*)(ws + WS_W2M) + (size_t)((l >> 1) * NE) * D * FF;
                pg8::Gemm g{FF, FF, FF}; MoeOrder<false> S; S.init(ws + WS_P, FF, w, FF, (size_t)D * FF * 2, D, c.G, c.bid, (const int*)(ws + WS_TOK), (const LAS unsigned*)(c.lds + MOE_OFF));
                EpiStoreBf16 E{(bf16_t*)(ws + WS_Y), D};
                pg8::gemm_phase(c.lds, g, S, E); }
            GRID_BAR();
        }
    }
    ph_final(c);
}

extern "C" void kernel_launch(void* const* d_in, const int* in_sizes, int n_in, void* d_out, int out_size, void* d_ws, size_t ws_size, hipStream_t stream) {
    static int grid = 0;
    if (grid == 0) {
        if (n_in != 30 || out_size != TL * D || ws_size < WS_END) { fprintf(stderr, "kernel_launch: unexpected shapes (n_in %d out %d ws %zu)\n", n_in, out_size, ws_size); grid = -1; return; }
        int dev = 0, cus = 0, per_cu = 0; (void)hipGetDevice(&dev); (void)hipDeviceGetAttribute(&cus, hipDeviceAttributeMultiprocessorCount, dev);
        if (hipFuncSetAttribute((const void*)fwd, hipFuncAttributeMaxDynamicSharedMemorySize, LDS_BYTES) != hipSuccess) { fprintf(stderr, "kernel_launch: hipFuncSetAttribute failed\n"); grid = -1; return; }
        if (hipOccupancyMaxActiveBlocksPerMultiprocessor(&per_cu, (const void*)fwd, NTHR, LDS_BYTES) != hipSuccess || per_cu < 1) fprintf(stderr, "kernel_launch: occupancy query reports %d\n", per_cu);
        (void)hipGetLastError();
        grid = cus > 0 ? cus : 256;
    }
    if (grid < 0) return;
    (void)hipMemsetAsync((char*)d_ws + WS_CTL, 0, CTL_ZERO_BYTES, stream);
    Args a{};
    for (int i = 0; i < 30; ++i) a.in[i] = (const float*)d_in[i];
    a.out = (float*)d_out; a.ws = (unsigned char*)d_ws;
    hipLaunchKernelGGL(fwd, dim3(grid), dim3(NTHR), LDS_BYTES, stream, a);
}
```

```cpp
#include <hip/hip_runtime.h>
#include <cstdio>
#include <cstdint>

#define LAS __attribute__((address_space(3)))
#define GAS __attribute__((address_space(1)))
typedef unsigned short bf16_t;
typedef short bf16x8 __attribute__((ext_vector_type(8)));
typedef float f32x4 __attribute__((ext_vector_type(4)));
typedef float f32x2 __attribute__((ext_vector_type(2)));
typedef float f32x16 __attribute__((ext_vector_type(16)));
typedef unsigned u32x4 __attribute__((ext_vector_type(4)));
typedef unsigned u32x2 __attribute__((ext_vector_type(2)));

constexpr int D = 1024, NB = 4, SEQ = 4096, DEPTH = 4, CTX = 256;
constexpr int TL = NB * SEQ, TC = NB * CTX, T = TL + TC;
constexpr int PW = 5120, FF = 2816, NE = 8, HYW = 512;
constexpr int PQ = 0, PK = 512, PV = 1024, PHY = 1536, PGA = 3072, PGB = 4096;
constexpr float EPS = 1e-6f;

constexpr size_t MiB = 1u << 20;
constexpr size_t WS_CTL = 0, CTL_ZERO_BYTES = 1 * MiB;
constexpr size_t WS_MOD = 1 * MiB;
constexpr size_t WS_ROUTE = 2 * MiB;
constexpr size_t WS_RWT = 2 * MiB + 512 * 1024;
constexpr size_t WS_TOK = 3 * MiB;
constexpr int CW_CNT = 8192;
constexpr int MAXSLOT = 36864;
constexpr size_t WS_Y = 660 * MiB;
constexpr size_t WS_WIN = 4 * MiB;
constexpr size_t WS_WPAB = 44 * MiB;
constexpr size_t WS_WO = 52 * MiB;
constexpr size_t WS_W13D = 60 * MiB;
constexpr size_t WS_W2D = 82 * MiB;
constexpr size_t WS_W13M = 93 * MiB;
constexpr size_t WS_W2M = 269 * MiB;
constexpr size_t WS_X = 357 * MiB;
constexpr size_t WS_H = 425 * MiB;
constexpr size_t WS_P = 459 * MiB;
constexpr size_t WS_OAH = 629 * MiB;
constexpr size_t WS_B = 663 * MiB;
constexpr size_t WS_Z = WS_B + 51 * MiB;
constexpr size_t WS_VT = 748 * MiB;
constexpr size_t WS_HRL = 816 * MiB;
constexpr size_t WS_HRC = 850 * MiB;
constexpr size_t WS_END = 853 * MiB;

constexpr int LDS_BYTES = 147456;
constexpr int NWAVES = 8, NTHR = 512;

#define LDS_WAIT() asm volatile("s_waitcnt lgkmcnt(0)" ::: "memory")
#define VM_WAIT() asm volatile("s_waitcnt vmcnt(0)" ::: "memory")
__device__ __forceinline__ float bf2f(unsigned b) { return __uint_as_float(b << 16); }
__device__ __forceinline__ float bflo(unsigned w) { return __uint_as_float(w << 16); }
__device__ __forceinline__ float bfhi(unsigned w) { return __uint_as_float(w & 0xffff0000u); }
__device__ __forceinline__ unsigned cvt_pk_bf16(float lo, float hi) { unsigned r; asm volatile("v_cvt_pk_bf16_f32 %0, %1, %2" : "=v"(r) : "v"(lo), "v"(hi)); return r; }
__device__ __forceinline__ float wave_sum(float v, int lane) {
#pragma unroll
    for (int o = 1; o < 64; o <<= 1) v += __int_as_float(__builtin_amdgcn_ds_bpermute((lane ^ o) << 2, __float_as_int(v)));
    return v;
}
__device__ __forceinline__ float sigmoidf_(float x) { return 1.f / (1.f + __expf(-x)); }
__device__ __forceinline__ float sin_rev(float r) { return __builtin_amdgcn_sinf(__builtin_amdgcn_fractf(r)); }
__device__ __forceinline__ float sin_rad(float x) { return sin_rev(x * 0.15915494309189535f); }

namespace pg8 {
constexpr int BM = 256, BK = 64, HALF = 128, HTB = HALF * BK * 2, STAGE_BYTES = 8 * HTB, NXCD = 8, WGM = 8;
__host__ __device__ __forceinline__ int lds_byte(int r, int c) { const int st = (r >> 4) * 2 + (c >> 5), rr = r & 15, cc = c & 31, ob = rr * 64 + cc * 2; return st * 1024 + (ob ^ (((ob >> 9) & 1) << 5)); }
__host__ __device__ __forceinline__ void stage_rc(int b, int& R, int& C) { const int st = b / 1024, sb = b % 1024, swz = sb ^ (((sb >> 9) & 1) << 5); R = (st >> 1) * 16 + swz / 64; C = (st & 1) * 32 + (swz % 64) / 2; }
__host__ __device__ __forceinline__ int perm32(int rho) { const int n = rho >> 4, i = rho & 15; return 8 * (i >> 2) + 4 * n + (i & 3); }

struct Unit { int pm, pn; const char* a; const char* b; const int* tk; int nvalid; };
struct Gemm { int K, lda, ldb; };

struct StaticOrder {
    int nM, nN, nwg, G, c; const char* A; const char* B; size_t astep, bstep;
    __device__ void init(const void* A_, int lda, const void* B_, int ldb, int M, int N, int G_, int c_) {
        nM = M / BM; nN = N / BM; nwg = nM * nN; G = G_; c = c_; A = (const char*)A_; B = (const char*)B_; astep = (size_t)BM * lda * 2; bstep = (size_t)BM * ldb * 2; }
    __device__ bool next(int i, Unit& u) const {
        const long L = (long)i * G + c; if (L >= nwg) return false;
        int wgid = (int)L; { const int q = nwg / NXCD, r = nwg % NXCD, xcd = wgid % NXCD, off = wgid / NXCD; wgid = (xcd < r ? xcd * (q + 1) : r * (q + 1) + (xcd - r) * q) + off; }
        const int nig = WGM * nN, gid = wgid / nig, fm = gid * WGM, gsz = (nM - fm) < WGM ? (nM - fm) : WGM;
        u.pm = fm + ((wgid % nig) % gsz); u.pn = (wgid % nig) / gsz; u.a = A + (size_t)u.pm * astep; u.b = B + (size_t)u.pn * bstep; return true;
    }
    static constexpr bool GATHER = false;
    __device__ __forceinline__ int arow(const Unit&, int) const { return 0; }
    __device__ __forceinline__ void a_ready(const Unit&) const {}
    __device__ __forceinline__ void done(const Unit&) const {}
};

template <class Epi, class Sched, bool ALIGN_EPI = true>
__device__ __forceinline__ void gemm_phase(LAS unsigned char* lds, const Gemm g, const Sched& S, const Epi& E) {
    int tid = threadIdx.x; asm volatile("" : "+v"(tid));
    const int wid = __builtin_amdgcn_readfirstlane(tid >> 6), lane = tid & 63, wr = wid >> 2, wc = wid & 3, fr = lane & 15, fq = lane >> 4;
    const int K = g.K, nt = K / BK;
    constexpr bool GATHER = Sched::GATHER;
    unsigned voffB[2]; unsigned cA0[2], cA1[2], nA0[2], nA1[2]; int RA[2], CA[2];
    const size_t hstepA = (size_t)HALF * g.lda * 2, hstepB = (size_t)HALF * g.ldb * 2;
#pragma unroll
    for (int i = 0; i < 2; ++i) { int R, C; stage_rc(tid * 16 + i * 8192, R, C); const int Rb = Epi::PERM ? ((R & ~31) + perm32(R & 31)) : R;
        RA[i] = R; CA[i] = C; voffB[i] = (unsigned)(Rb * g.ldb + C) * 2u;
        cA0[i] = (unsigned)(R * g.lda + C) * 2u; cA1[i] = cA0[i]; nA0[i] = cA0[i]; nA1[i] = cA0[i]; }
    const size_t h1A = GATHER ? 0 : hstepA;
    const size_t kstep = (size_t)(BK * 2);
    const unsigned ldsw = (unsigned)wid * 1024u;
    const int aoff = lds_byte(wr * 64 + fr, fq * 8), boff = lds_byte(wc * 32 + fr, fq * 8);
#define PG8_SA(b, h) (((b) * 2 + (h)) * HTB)
#define PG8_SB(b, h) ((4 + (b) * 2 + (h)) * HTB)
#define PG8_STAGE(bufoff, gbase, voff) do { _Pragma("unroll") for (int _i = 0; _i < 2; ++_i) \
        __builtin_amdgcn_global_load_lds((const unsigned*)((const char*)(gbase) + (voff)[_i]), (LAS unsigned*)(lds + (bufoff) + ldsw + _i * 8192), 16, 0, 0); } while (0)
#define PG8_LDA(dst, b, h) do { _Pragma("unroll") for (int m = 0; m < 4; ++m) _Pragma("unroll") for (int k = 0; k < 2; ++k) dst[m][k] = *(const LAS bf16x8*)(lds + PG8_SA(b, h) + aoff + m * 2048 + k * 1024); } while (0)
#define PG8_LDB(dst, b, h) do { _Pragma("unroll") for (int n = 0; n < 2; ++n) _Pragma("unroll") for (int k = 0; k < 2; ++k) dst[n][k] = *(const LAS bf16x8*)(lds + PG8_SB(b, h) + boff + n * 2048 + k * 1024); } while (0)
#define PG8_MMA(ai, bj, At, Bt) do { __builtin_amdgcn_s_setprio(1); _Pragma("unroll") for (int m = 0; m < 4; ++m) _Pragma("unroll") for (int n = 0; n < 2; ++n) _Pragma("unroll") for (int k = 0; k < 2; ++k) \
        acc[ai][bj][m][n] = __builtin_amdgcn_mfma_f32_16x16x32_bf16(Bt[n][k], At[m][k], acc[ai][bj][m][n], 0, 0, 0); __builtin_amdgcn_s_setprio(0); } while (0)
#define PG8_WAIT_V(n) asm volatile("s_waitcnt vmcnt(" #n ")" ::: "memory")
#define PG8_WAIT_L(n) asm volatile("s_waitcnt lgkmcnt(" #n ")" ::: "memory")
#define PG8_BAR __builtin_amdgcn_s_barrier()
#define PG8_SCHED __builtin_amdgcn_sched_barrier(0)
    Unit cur, nxt; int ui = 0;
    if (!S.next(0, cur)) return;
    if constexpr (GATHER) {
#pragma unroll
        for (int i = 0; i < 2; ++i) { cA0[i] = (unsigned)(S.arow(cur, RA[i]) * g.lda + CA[i]) * 2u; cA1[i] = (unsigned)(S.arow(cur, HALF + RA[i]) * g.lda + CA[i]) * 2u; }
    }
    f32x4 acc[2][2][4][2];
#pragma unroll
    for (int a = 0; a < 2; ++a)
#pragma unroll
        for (int b = 0; b < 2; ++b)
#pragma unroll
            for (int m = 0; m < 4; ++m)
#pragma unroll
                for (int n = 0; n < 2; ++n) acc[a][b][m][n] = (f32x4){0.f, 0.f, 0.f, 0.f};
    bf16x8 At[4][2], B0[2][2], B1[2][2];
    const char* cA = cur.a; const char* cB = cur.b;
    S.a_ready(cur);
    PG8_STAGE(PG8_SB(0, 0), cB, voffB); PG8_STAGE(PG8_SB(0, 1), cB + hstepB, voffB); PG8_STAGE(PG8_SA(0, 0), cA, cA0); PG8_STAGE(PG8_SA(0, 1), cA + h1A, cA1);
    if (wr == 1) PG8_BAR;
    PG8_WAIT_V(2); PG8_BAR;
    PG8_STAGE(PG8_SB(1, 0), cB + kstep, voffB); PG8_STAGE(PG8_SA(1, 0), cA + kstep, cA0); PG8_STAGE(PG8_SB(1, 1), cB + hstepB + kstep, voffB);
    PG8_WAIT_V(6); PG8_BAR;
    for (;;) {
        const bool has_next = S.next(ui + 1, nxt);
        const char* nA = has_next ? nxt.a : cA; const char* nB = has_next ? nxt.b : cB;
        if constexpr (GATHER) {
#pragma unroll
            for (int i = 0; i < 2; ++i) { nA0[i] = has_next ? (unsigned)(S.arow(nxt, RA[i]) * g.lda + CA[i]) * 2u : cA0[i]; nA1[i] = has_next ? (unsigned)(S.arow(nxt, HALF + RA[i]) * g.lda + CA[i]) * 2u : cA1[i]; }
        }
        for (int kh = 0; kh < (Epi::MIDK ? 2 : 1); ++kh) {
        const int tb = Epi::MIDK ? kh * (nt / 2) : 0, te = Epi::MIDK ? tb + nt / 2 : nt;
        for (int t = tb; t < te; t += 2) {
            const bool last = (t == nt - 2);
            const char* a1 = cA + (size_t)(t + 1) * kstep;
            const char* a2 = last ? nA : cA + (size_t)(t + 2) * kstep; const char* b2 = last ? nB : cB + (size_t)(t + 2) * kstep;
            const char* a3 = a2 + kstep; const char* b3 = b2 + kstep;
            unsigned x0[2], x1[2];
#pragma unroll
            for (int i = 0; i < 2; ++i) { x0[i] = (GATHER && last) ? nA0[i] : cA0[i]; x1[i] = GATHER ? (last ? nA1[i] : cA1[i]) : cA0[i]; }
            if (last && has_next) S.a_ready(nxt);
            PG8_LDB(B0, 0, 0); PG8_LDB(B1, 0, 1); PG8_SCHED; PG8_LDA(At, 0, 0); PG8_STAGE(PG8_SA(1, 1), a1 + h1A, cA1);
            PG8_WAIT_V(8); PG8_WAIT_L(0); PG8_BAR; PG8_MMA(0, 0, At, B0); PG8_MMA(0, 1, At, B1); PG8_BAR; PG8_SCHED;
            PG8_LDA(At, 0, 1); PG8_STAGE(PG8_SB(0, 0), b2, voffB); PG8_STAGE(PG8_SB(0, 1), b2 + hstepB, voffB); PG8_STAGE(PG8_SA(0, 0), a2, x0);
            PG8_WAIT_V(8); PG8_WAIT_L(0); PG8_BAR; PG8_MMA(1, 0, At, B0); PG8_MMA(1, 1, At, B1); PG8_BAR; PG8_SCHED;
            PG8_LDB(B0, 1, 0); PG8_LDB(B1, 1, 1); PG8_SCHED; PG8_LDA(At, 1, 0); PG8_STAGE(PG8_SA(0, 1), a2 + h1A, x1);
            PG8_WAIT_V(8); PG8_WAIT_L(0); PG8_BAR; PG8_MMA(0, 0, At, B0); PG8_MMA(0, 1, At, B1); PG8_BAR; PG8_SCHED;
            PG8_LDA(At, 1, 1); PG8_STAGE(PG8_SB(1, 0), b3, voffB); PG8_STAGE(PG8_SB(1, 1), b3 + hstepB, voffB); PG8_STAGE(PG8_SA(1, 0), a3, x0);
            PG8_WAIT_V(8); PG8_WAIT_L(0); PG8_BAR; PG8_MMA(1, 0, At, B0); PG8_MMA(1, 1, At, B1); PG8_BAR; PG8_SCHED;
        }
        if constexpr (Epi::MIDK) { if (kh == 0) E.mid(acc, cur, wr, wc, fr, fq); }
        }
        if constexpr (ALIGN_EPI) { if (wr == 0) PG8_BAR; }
        E(acc, cur, wr, wc, fr, fq); S.done(cur);
        if (!has_next) break;
#pragma unroll
        for (int a = 0; a < 2; ++a)
#pragma unroll
            for (int b = 0; b < 2; ++b)
#pragma unroll
                for (int m = 0; m < 4; ++m)
#pragma unroll
                    for (int n = 0; n < 2; ++n) acc[a][b][m][n] = (f32x4){0.f, 0.f, 0.f, 0.f};
        cur = nxt; cA = nA; cB = nB; ++ui;
        if constexpr (GATHER) {
#pragma unroll
            for (int i = 0; i < 2; ++i) { cA0[i] = nA0[i]; cA1[i] = nA1[i]; }
        }
        if constexpr (ALIGN_EPI) { if (wr == 1) PG8_BAR; }
    }
    PG8_WAIT_V(0);
    if constexpr (!ALIGN_EPI) { if (wr == 0) PG8_BAR; }
    PG8_BAR;
#undef PG8_SA
#undef PG8_SB
#undef PG8_STAGE
#undef PG8_LDA
#undef PG8_LDB
#undef PG8_MMA
#undef PG8_WAIT_V
#undef PG8_WAIT_L
#undef PG8_BAR
#undef PG8_SCHED
}
}

typedef f32x4 AccT[2][2][4][2];
struct EpiStoreBf16 {
    static constexpr bool PERM = true, MIDK = false;
    bf16_t* O; int ldc;
    __device__ __forceinline__ void operator()(const AccT& acc, const pg8::Unit& u, int wr, int wc, int fr, int fq) const {
        const int row0 = u.pm * 256 + wr * 64 + fr, col0 = u.pn * 256 + wc * 32 + 8 * fq;
#pragma unroll
        for (int ai = 0; ai < 2; ++ai)
#pragma unroll
            for (int m = 0; m < 4; ++m) { bf16_t* rowp = O + (size_t)(row0 + ai * 128 + m * 16) * ldc + col0;
#pragma unroll
                for (int bj = 0; bj < 2; ++bj) { const f32x4 v0 = acc[ai][bj][m][0], v1 = acc[ai][bj][m][1];
                    u32x4 w; w.x = cvt_pk_bf16(v0[0], v0[1]); w.y = cvt_pk_bf16(v0[2], v0[3]); w.z = cvt_pk_bf16(v1[0], v1[1]); w.w = cvt_pk_bf16(v1[2], v1[3]);
                    *(u32x4*)(rowp + bj * 128) = w; } }
    }
};
__device__ __forceinline__ float merge_ratio(float ga, float gb) { return (1.f + __expf(-fmaxf(gb, -80.f))) / (1.f + __expf(-ga)); }
__device__ __forceinline__ float merge_final(float gb) { return 1.f / (1.f + __expf(-fmaxf(gb, -80.f))); }
struct EpiMergeK {
    static constexpr bool PERM = true, MIDK = true;
    const bf16_t* P; bf16_t* O;
    __device__ __forceinline__ void mid(AccT& acc, const pg8::Unit& u, int wr, int wc, int fr, int fq) const {
        asm volatile("" : "+v"(fr), "+v"(fq));
        const int row0 = u.pm * 256 + wr * 64 + fr, col0 = u.pn * 256 + wc * 32 + 8 * fq;
#pragma unroll
        for (int ai = 0; ai < 2; ++ai)
#pragma unroll
            for (int m = 0; m < 4; ++m) { const int r = row0 + ai * 128 + m * 16;
#pragma unroll
                for (int bj = 0; bj < 2; ++bj) { const int c = col0 + bj * 128;
                    const u32x4 a = *(const u32x4*)(P + (size_t)r * PW + PGA + c), b = *(const u32x4*)(P + (size_t)r * PW + PGB + c);
                    acc[ai][bj][m][0][0] *= merge_ratio(bflo(a.x), bflo(b.x)); acc[ai][bj][m][0][1] *= merge_ratio(bfhi(a.x), bfhi(b.x));
                    acc[ai][bj][m][0][2] *= merge_ratio(bflo(a.y), bflo(b.y)); acc[ai][bj][m][0][3] *= merge_ratio(bfhi(a.y), bfhi(b.y));
                    acc[ai][bj][m][1][0] *= merge_ratio(bflo(a.z), bflo(b.z)); acc[ai][bj][m][1][1] *= merge_ratio(bfhi(a.z), bfhi(b.z));
                    acc[ai][bj][m][1][2] *= merge_ratio(bflo(a.w), bflo(b.w)); acc[ai][bj][m][1][3] *= merge_ratio(bfhi(a.w), bfhi(b.w)); } }
    }
    __device__ __forceinline__ void operator()(const AccT& acc, const pg8::Unit& u, int wr, int wc, int fr, int fq) const {
        asm volatile("" : "+v"(fr), "+v"(fq));
        const int row0 = u.pm * 256 + wr * 64 + fr, col0 = u.pn * 256 + wc * 32 + 8 * fq;
#pragma unroll
        for (int ai = 0; ai < 2; ++ai)
#pragma unroll
            for (int m = 0; m < 4; ++m) { const int r = row0 + ai * 128 + m * 16;
#pragma unroll
                for (int bj = 0; bj < 2; ++bj) { const int c = col0 + bj * 128;
                    const u32x4 b = *(const u32x4*)(P + (size_t)r * PW + PGB + c);
                    const f32x4 v0 = acc[ai][bj][m][0], v1 = acc[ai][bj][m][1];
                    u32x4 w; w.x = cvt_pk_bf16(v0[0] * merge_final(bflo(b.x)), v0[1] * merge_final(bfhi(b.x))); w.y = cvt_pk_bf16(v0[2] * merge_final(bflo(b.y)), v0[3] * merge_final(bfhi(b.y)));
                    w.z = cvt_pk_bf16(v1[0] * merge_final(bflo(b.z)), v1[1] * merge_final(bfhi(b.z))); w.w = cvt_pk_bf16(v1[2] * merge_final(bflo(b.w)), v1[3] * merge_final(bfhi(b.w)));
                    *(u32x4*)(O + (size_t)r * D + c) = w; } }
    }
};
struct EpiResid {
    static constexpr bool PERM = false, MIDK = false;
    float* x; const float* gate;
    __device__ __forceinline__ void operator()(const AccT& acc, const pg8::Unit& u, int wr, int wc, int fr, int fq) const {
        const int row0 = u.pm * 256 + wr * 64 + fr, col0 = u.pn * 256 + wc * 32 + 4 * fq;
        const int b = (u.pm < 64) ? (u.pm >> 4) : 4;
        const float* gp = gate + (size_t)b * 6144 + col0;
        f32x4 gv[2][2];
#pragma unroll
        for (int bj = 0; bj < 2; ++bj)
#pragma unroll
            for (int n = 0; n < 2; ++n) gv[bj][n] = *(const f32x4*)(gp + bj * 128 + n * 16);
#pragma unroll
        for (int ai = 0; ai < 2; ++ai)
#pragma unroll
            for (int m = 0; m < 4; ++m) { const int r = row0 + ai * 128 + m * 16; float* rowp = x + (size_t)r * D + col0;
#pragma unroll
                for (int bj = 0; bj < 2; ++bj)
#pragma unroll
                    for (int n = 0; n < 2; ++n) { float* p = rowp + bj * 128 + n * 16; *(f32x4*)p = *(const f32x4*)p + gv[bj][n] * acc[ai][bj][m][n]; } }
    }
};
struct EpiSwiglu {
    static constexpr bool PERM = true, MIDK = false;
    bf16_t* O;
    __device__ __forceinline__ void operator()(const AccT& acc, const pg8::Unit& u, int wr, int wc, int fr, int fq) const {
        const int row0 = u.pm * 256 + wr * 64 + fr, col0 = u.pn * 128 + wc * 32 + 8 * fq;
#pragma unroll
        for (int ai = 0; ai < 2; ++ai)
#pragma unroll
            for (int m = 0; m < 4; ++m) { const int r = row0 + ai * 128 + m * 16;
                float o[8];
#pragma unroll
                for (int n = 0; n < 2; ++n)
#pragma unroll
                    for (int j = 0; j < 4; ++j) { const float a = acc[ai][0][m][n][j], g = acc[ai][1][m][n][j]; o[n * 4 + j] = a * sigmoidf_(a) * g; }
                u32x4 w; w.x = cvt_pk_bf16(o[0], o[1]); w.y = cvt_pk_bf16(o[2], o[3]); w.z = cvt_pk_bf16(o[4], o[5]); w.w = cvt_pk_bf16(o[6], o[7]);
                *(u32x4*)(O + (size_t)r * FF + col0) = w; }
    }
};

struct CEpiMergeK { const bf16_t* P; bf16_t* O; static constexpr bool MIDK = true;
    __device__ __forceinline__ void mid(f32x4& acc, int r, int c) const { const u32x2 a = *(const u32x2*)(P + (size_t)r * PW + PGA + c), b = *(const u32x2*)(P + (size_t)r * PW + PGB + c);
        acc[0] *= merge_ratio(bflo(a.x), bflo(b.x)); acc[1] *= merge_ratio(bfhi(a.x), bfhi(b.x)); acc[2] *= merge_ratio(bflo(a.y), bflo(b.y)); acc[3] *= merge_ratio(bfhi(a.y), bfhi(b.y)); }
    __device__ __forceinline__ void operator()(const f32x4& acc, int r, int c) const { const u32x2 b = *(const u32x2*)(P + (size_t)r * PW + PGB + c);
        u32x2 w; w.x = cvt_pk_bf16(acc[0] * merge_final(bflo(b.x)), acc[1] * merge_final(bfhi(b.x))); w.y = cvt_pk_bf16(acc[2] * merge_final(bflo(b.y)), acc[3] * merge_final(bfhi(b.y)));
        *(u32x2*)(O + (size_t)r * D + c) = w; } };
struct CEpiResid { float* x; const float* gate; static constexpr bool MIDK = false;
    __device__ __forceinline__ void mid(f32x4&, int, int) const {}
    __device__ __forceinline__ void operator()(const f32x4& acc, int r, int c) const { float* p = x + (size_t)r * D + c; *(f32x4*)p = *(const f32x4*)p + *(const f32x4*)(gate + c) * acc; } };
template <class Epi>
__device__ __forceinline__ void ctx_gemm(const bf16_t* X, int ldx, const bf16_t* Wt, int ldw, int K, const Epi& E) {
    int tid = threadIdx.x; asm volatile("" : "+v"(tid));
    const int wave = tid >> 6, lane = tid & 63, li = lane & 15, kg = lane >> 4;
    for (int tile = blockIdx.x; tile < 256; tile += gridDim.x) {
        const int row0 = TL + (tile >> 2) * 16, col0 = (tile & 3) * 256 + wave * 32;
        const bf16_t* xp = X + (size_t)(row0 + li) * ldx + 8 * kg;
        const bf16_t* w0 = Wt + (size_t)(col0 + li) * ldw + 8 * kg; const bf16_t* w1 = w0 + (size_t)16 * ldw;
        f32x4 acc0 = (f32x4){0.f, 0.f, 0.f, 0.f}, acc1 = acc0;
        const int Kh = Epi::MIDK ? K / 2 : K;
#pragma unroll 8
        for (int k0 = 0; k0 < Kh; k0 += 32) {
            const bf16x8 xf = *(const bf16x8*)(xp + k0), b0 = *(const bf16x8*)(w0 + k0), b1 = *(const bf16x8*)(w1 + k0);
            acc0 = __builtin_amdgcn_mfma_f32_16x16x32_bf16(b0, xf, acc0, 0, 0, 0);
            acc1 = __builtin_amdgcn_mfma_f32_16x16x32_bf16(b1, xf, acc1, 0, 0, 0);
        }
        if constexpr (Epi::MIDK) {
            E.mid(acc0, row0 + li, col0 + 4 * kg); E.mid(acc1, row0 + li, col0 + 16 + 4 * kg);
#pragma unroll 8
            for (int k0 = Kh; k0 < K; k0 += 32) {
                const bf16x8 xf = *(const bf16x8*)(xp + k0), b0 = *(const bf16x8*)(w0 + k0), b1 = *(const bf16x8*)(w1 + k0);
                acc0 = __builtin_amdgcn_mfma_f32_16x16x32_bf16(b0, xf, acc0, 0, 0, 0);
                acc1 = __builtin_amdgcn_mfma_f32_16x16x32_bf16(b1, xf, acc1, 0, 0, 0);
            }
        }
        E(acc0, row0 + li, col0 + 4 * kg); E(acc1, row0 + li, col0 + 16 + 4 * kg);
    }
}

struct Args { const float* in[30]; float* out; unsigned char* ws; int l, e, ph, pad; };
enum { I_X = 0, I_C, I_CTX, I_CCTX, I_WMOD, I_BMOD, I_N1G, I_N2G, I_WIN, I_RPB, I_HCW, I_HCB, I_HW1, I_HB1, I_HW2, I_HB2, I_HW3, I_HFREQ, I_HBIAS,
       I_WPA, I_WPB, I_WO, I_FW1, I_FW3, I_FW2, I_ROUTER, I_MW1, I_MW3, I_MW2, I_FINALG };

constexpr int MISC_OFF = 131072 + 320;
constexpr int PTR_OFF = MISC_OFF + 128;
struct Ctx {
    LAS unsigned char* lds; int tid, lane, wave, G, bid; unsigned char* ws;
};
__device__ __forceinline__ Ctx mk_ctx(LAS unsigned char* lds, unsigned char* ws) {
    Ctx c; int t = threadIdx.x; asm volatile("" : "+v"(t)); asm volatile("" : "+s"(ws)); c.lds = lds; c.tid = t; c.lane = t & 63; c.wave = __builtin_amdgcn_readfirstlane(t >> 6); c.G = gridDim.x; c.bid = blockIdx.x; c.ws = ws; return c;
}
__device__ __forceinline__ const float* inp(const Ctx& c, int i) {
    unsigned ao = (unsigned)(PTR_OFF + 8 * i); asm volatile("" : "+v"(ao));
    const volatile LAS unsigned* p = (const volatile LAS unsigned*)(c.lds + ao);
    const unsigned lo = __builtin_amdgcn_readfirstlane(p[0]), hi = __builtin_amdgcn_readfirstlane(p[1]);
    return (const float*)(((unsigned long long)hi << 32) | (unsigned long long)lo);
}

__device__ __forceinline__ void transpose_item(const float* W, int N, bf16_t* WT, int ldk, int k0, int n0, int drow0, LAS float* scr, int lane) {
    float wv[32];
    const float* wp = W + (size_t)(k0 + (lane >> 5)) * N + n0 + (lane & 31);
#pragma unroll
    for (int i = 0; i < 32; ++i) wv[i] = wp[(size_t)(2 * i) * N];
#pragma unroll
    for (int i = 0; i < 32; ++i) scr[(2 * i + (lane >> 5)) * 33 + (lane & 31)] = wv[i];
    LDS_WAIT(); asm volatile("" ::: "memory");
    const int c = lane & 7;
#pragma unroll
    for (int j = 0; j < 4; ++j) { const int n = (lane >> 3) + 8 * j; const LAS float* s = scr + (8 * c) * 33 + n;
        u32x4 o; o.x = cvt_pk_bf16(s[0 * 33], s[1 * 33]); o.y = cvt_pk_bf16(s[2 * 33], s[3 * 33]); o.z = cvt_pk_bf16(s[4 * 33], s[5 * 33]); o.w = cvt_pk_bf16(s[6 * 33], s[7 * 33]);
        *(u32x4*)(WT + (size_t)(drow0 + n) * ldk + k0 + 8 * c) = o; }
    LDS_WAIT(); asm volatile("" ::: "memory");
}
__device__ __forceinline__ void conv_mat(const float* W, int K, int N, bf16_t* WT, int mode, int& base, int gw, int NGW, LAS float* scr, int lane, int ldk = 0) {
    if (ldk == 0) ldk = K;
    const int nblk = N / 32, nitems = (K / 64) * nblk;
    const int start = (gw - (base % NGW) + NGW) % NGW;
    for (int it = start; it < nitems; it += NGW) {
        const int kb = it / nblk, nb = it % nblk, n0 = nb * 32;
        const int drow0 = mode == 0 ? n0 : ((n0 >> 7) * 256 + (n0 & 127) + (mode == 2 ? 128 : 0));
        transpose_item(W, N, WT, ldk, kb * 64, n0, drow0, scr, lane);
    }
    base += nitems;
}
__device__ __forceinline__ void ph_convert(const Ctx& c0) {
    const Ctx c = mk_ctx(c0.lds, c0.ws);
    unsigned char* ws = c.ws;
    LAS float* scr = (LAS float*)(c.lds + c.wave * 16384);
    const int gw = c.bid * NWAVES + c.wave, NGW = c.G * NWAVES; int base = 0;
    for (int l = 0; l < DEPTH; ++l) {
        conv_mat(inp(c, I_WIN) + (size_t)l * D * PW, D, PW, (bf16_t*)(ws + WS_WIN) + (size_t)l * PW * D, 0, base, gw, NGW, scr, c.lane);
        conv_mat(inp(c, I_WPA) + (size_t)l * 512 * D, 512, D, (bf16_t*)(ws + WS_WPAB) + (size_t)l * D * D, 0, base, gw, NGW, scr, c.lane, D);
        conv_mat(inp(c, I_WPB) + (size_t)l * 512 * D, 512, D, (bf16_t*)(ws + WS_WPAB) + (size_t)l * D * D + 512, 0, base, gw, NGW, scr, c.lane, D);
        conv_mat(inp(c, I_WO) + (size_t)l * D * D, D, D, (bf16_t*)(ws + WS_WO) + (size_t)l * D * D, 0, base, gw, NGW, scr, c.lane);
    }
    for (int i = 0; i < 2; ++i) {
        conv_mat(inp(c, I_FW1) + (size_t)i * D * FF, D, FF, (bf16_t*)(ws + WS_W13D) + (size_t)i * 2 * FF * D, 1, base, gw, NGW, scr, c.lane);
        conv_mat(inp(c, I_FW3) + (size_t)i * D * FF, D, FF, (bf16_t*)(ws + WS_W13D) + (size_t)i * 2 * FF * D, 2, base, gw, NGW, scr, c.lane);
        conv_mat(inp(c, I_FW2) + (size_t)i * FF * D, FF, D, (bf16_t*)(ws + WS_W2D) + (size_t)i * D * FF, 0, base, gw, NGW, scr, c.lane);
    }
    for (int ie = 0; ie < 2 * NE; ++ie) {
        conv_mat(inp(c, I_MW1) + (size_t)ie * D * FF, D, FF, (bf16_t*)(ws + WS_W13M) + (size_t)ie * 2 * FF * D, 1, base, gw, NGW, scr, c.lane);
        conv_mat(inp(c, I_MW3) + (size_t)ie * D * FF, D, FF, (bf16_t*)(ws + WS_W13M) + (size_t)ie * 2 * FF * D, 2, base, gw, NGW, scr, c.lane);
        conv_mat(inp(c, I_MW2) + (size_t)ie * FF * D, FF, D, (bf16_t*)(ws + WS_W2M) + (size_t)ie * D * FF, 0, base, gw, NGW, scr, c.lane);
    }
}

__device__ __forceinline__ void ph_mod(const Ctx& c0) {
    const Ctx c = mk_ctx(c0.lds, c0.ws);
    float* mod = (float*)(c.ws + WS_MOD);
    LAS float* s = (LAS float*)c.lds; LAS float* part = s + 5 * 1024;
    const float* cin = inp(c, I_C); const float* cctx = inp(c, I_CCTX); const float* wmod = inp(c, I_WMOD); const float* bmod = inp(c, I_BMOD);
    for (int i = c.tid; i < 5 * 1024; i += NTHR) { const int r = i >> 10, k = i & 1023; const float v = r < 4 ? cin[r * 1024 + k] : cctx[k]; s[i] = v * sigmoidf_(v); }
    __syncthreads();
    for (int unit = c.bid; unit < DEPTH * 96; unit += c.G) {
        const int l = unit / 96, j0 = (unit % 96) * 64;
        const float* w = wmod + (size_t)l * D * 6144 + j0 + c.lane;
        float acc[5] = {0.f, 0.f, 0.f, 0.f, 0.f};
        const int kb = c.wave * 128;
#pragma unroll 32
        for (int k = 0; k < 128; ++k) { const float wv = w[(size_t)(kb + k) * 6144];
#pragma unroll
            for (int r = 0; r < 5; ++r) acc[r] += s[r * 1024 + kb + k] * wv; }
#pragma unroll
        for (int r = 0; r < 5; ++r) part[(c.wave * 5 + r) * 64 + c.lane] = acc[r];
        __syncthreads();
        if (c.tid < 320) { const int r = c.tid >> 6, ln = c.tid & 63; float sum = 0.f;
#pragma unroll
            for (int w8 = 0; w8 < 8; ++w8) sum += part[(w8 * 5 + r) * 64 + ln];
            mod[(size_t)(l * 5 + r) * 6144 + j0 + ln] = sum + bmod[l * 6144 + j0 + ln]; }
        __syncthreads();
    }
}

__device__ __forceinline__ void ph_filt(const Ctx& c0) {
    const Ctx c = mk_ctx(c0.lds, c0.ws);
    const float* hb1 = inp(c, I_HB1); const float* hw1 = inp(c, I_HW1); const float* hb2 = inp(c, I_HB2); const float* hw2 = inp(c, I_HW2); const float* hfreq = inp(c, I_HFREQ); const float* hw3 = inp(c, I_HW3);
    LAS float* zb = (LAS float*)c.lds;
    LAS float* a1 = zb + 16 * 36;
    LAS float* a2 = a1 + 16 * 64;
    const float MINDEC = -3.0701134573253945f, MAXDEC = -15.350567286626973f;
    for (int unit = c.bid; unit < DEPTH * 272; unit += c.G) {
        const int l = unit / 272, uu = unit % 272;
        const int L = uu < 256 ? 4096 : 256, p0 = uu < 256 ? uu * 16 : (uu - 256) * 16;
        for (int i = c.tid; i < 16 * 33; i += NTHR) { const int p = i / 33, q = i % 33; const int pos = p0 + p; float v;
            if (q == 0) v = (float)pos / (float)(L - 1);
            else { const int j = (q - 1) & 15; const double band = 1e-4 + (double)j * ((15.0 - 1e-4) / 15.0); double rev = (double)pos * band / (double)L; rev -= floor(rev);
                v = q <= 16 ? __builtin_amdgcn_cosf((float)rev) : -__builtin_amdgcn_sinf((float)rev); }
            zb[p * 36 + q] = v; }
        __syncthreads();
        for (int i = c.tid; i < 16 * 64; i += NTHR) { const int p = i >> 6, j = i & 63; float s = hb1[l * 64 + j];
            const float* w = hw1 + (size_t)l * 33 * 64 + j;
            for (int q = 0; q < 33; ++q) s += zb[p * 36 + q] * w[q * 64];
            a1[p * 64 + j] = sin_rad(hfreq[l * 128 + j] * s); }
        __syncthreads();
        for (int i = c.tid; i < 16 * 64; i += NTHR) { const int p = i >> 6, j = i & 63; float s = hb2[l * 64 + j];
            const float* w = hw2 + (size_t)l * 64 * 64 + j;
            for (int q = 0; q < 64; ++q) s += a1[p * 64 + q] * w[q * 64];
            a2[p * 64 + j] = sin_rad(hfreq[l * 128 + 64 + j] * s); }
        __syncthreads();
        {
            float acc0[16], acc1[16];
#pragma unroll
            for (int p = 0; p < 16; ++p) { acc0[p] = 0.f; acc1[p] = 0.f; }
            const float* w3 = hw3 + (size_t)l * 64 * 1024 + c.tid;
            for (int k = 0; k < 64; ++k) { const float wa = w3[k * 1024], wb = w3[k * 1024 + 512];
#pragma unroll
                for (int p = 0; p < 16; ++p) { const float av = a2[p * 64 + k]; acc0[p] += av * wa; acc1[p] += av * wb; } }
            bf16_t* hro = uu < 256 ? (bf16_t*)(c.ws + WS_HRL) + ((size_t)(l * 2) * 512 + c.tid) * (4096 + 64) : (bf16_t*)(c.ws + WS_HRC) + ((size_t)(l * 2) * 512 + c.tid) * (256 + 64);
            const size_t ostride = (size_t)512 * (L + 64);
            float f0[16], f1[16];
            const float r0 = fabsf(MINDEC + (float)c.tid * ((MAXDEC - MINDEC) / 1023.f)), r1 = fabsf(MINDEC + (float)(c.tid + 512) * ((MAXDEC - MINDEC) / 1023.f));
#pragma unroll
            for (int p = 0; p < 16; ++p) { const int pos = p0 + p; const float dist = fabsf((float)(pos - L / 2)) * (2.f / (float)L);
                f0[p] = acc0[p] * (__expf(-dist * r0) + 0.05f); f1[p] = acc1[p] * (__expf(-dist * r1) + 0.05f); }
            {   u32x4 w0, w1, v0, v1;
                w0.x = cvt_pk_bf16(f0[15], f0[14]); w0.y = cvt_pk_bf16(f0[13], f0[12]); w0.z = cvt_pk_bf16(f0[11], f0[10]); w0.w = cvt_pk_bf16(f0[9], f0[8]);
                w1.x = cvt_pk_bf16(f0[7], f0[6]); w1.y = cvt_pk_bf16(f0[5], f0[4]); w1.z = cvt_pk_bf16(f0[3], f0[2]); w1.w = cvt_pk_bf16(f0[1], f0[0]);
                v0.x = cvt_pk_bf16(f1[15], f1[14]); v0.y = cvt_pk_bf16(f1[13], f1[12]); v0.z = cvt_pk_bf16(f1[11], f1[10]); v0.w = cvt_pk_bf16(f1[9], f1[8]);
                v1.x = cvt_pk_bf16(f1[7], f1[6]); v1.y = cvt_pk_bf16(f1[5], f1[4]); v1.z = cvt_pk_bf16(f1[3], f1[2]); v1.w = cvt_pk_bf16(f1[1], f1[0]);
                bf16_t* d0 = hro + (L + 16 - p0); bf16_t* d1 = d0 + ostride;
                *(u32x4*)d0 = w0; *(u32x4*)(d0 + 8) = w1; *(u32x4*)d1 = v0; *(u32x4*)(d1 + 8) = v1;
                const u32x4 z4 = (u32x4){0u, 0u, 0u, 0u};
                if (p0 == 0) { for (int k = 0; k < 4; ++k) { *(u32x4*)(hro + L + 32 + 8 * k) = z4; *(u32x4*)(hro + ostride + L + 32 + 8 * k) = z4; } }
                if (p0 == L - 16) { for (int k = 0; k < 4; ++k) { *(u32x4*)(hro + 8 * k) = z4; *(u32x4*)(hro + ostride + 8 * k) = z4; } } }
        }
        __syncthreads();
    }
}

struct MoeComb { const int* route; const float* rwt; const bf16_t* y; const float* gate; };
__device__ __forceinline__ void moe_combine_row(const MoeComb& mc, const LAS unsigned* offs, int row, int b, int lane, f32x4 (&v)[4]) {
    const int e1 = mc.route[(size_t)row * 4 + 0], p1 = mc.route[(size_t)row * 4 + 1], e2 = mc.route[(size_t)row * 4 + 2], p2 = mc.route[(size_t)row * 4 + 3];
    const float w1 = mc.rwt[(size_t)row * 2], w2 = mc.rwt[(size_t)row * 2 + 1];
    const size_t s1 = (size_t)offs[e1] + p1, s2 = (size_t)offs[e2] + p2;
    const float* gt = mc.gate + (size_t)b * 6144;
#pragma unroll
    for (int j = 0; j < 4; ++j) { const int k0 = 4 * (lane + 64 * j);
        const u32x2 a = *(const u32x2*)(mc.y + s1 * D + k0), bq = *(const u32x2*)(mc.y + s2 * D + k0); const f32x4 g4 = *(const f32x4*)(gt + k0);
        v[j][0] += g4[0] * (w1 * bflo(a.x) + w2 * bflo(bq.x)); v[j][1] += g4[1] * (w1 * bfhi(a.x) + w2 * bfhi(bq.x));
        v[j][2] += g4[2] * (w1 * bflo(a.y) + w2 * bflo(bq.y)); v[j][3] += g4[3] * (w1 * bfhi(a.y) + w2 * bfhi(bq.y)); }
}
__device__ __forceinline__ void moe_offsets(const Ctx& c, int i, LAS unsigned* offs) {
    if (c.tid == 0) { const unsigned* cnt = (const unsigned*)(c.ws + WS_CTL) + CW_CNT + 64 * i; unsigned o = 0;
        for (int e = 0; e < 8; ++e) { offs[e] = o; o += (cnt[e] + 255u) & ~255u; } offs[8] = o; }
}
__device__ __forceinline__ void ph_norm(const Ctx& c0, int l, int which) {
    const Ctx c = mk_ctx(c0.lds, c0.ws);
    float* xres = (float*)(c.ws + WS_X); bf16_t* h = (bf16_t*)(c.ws + WS_H);
    const float* mod = (const float*)(c.ws + WS_MOD) + (size_t)l * 5 * 6144;
    const float* gp = (which == 0 ? inp(c, I_N1G) : inp(c, I_N2G)) + l * D;
    const bool first = (l == 0 && which == 0), route = (which == 1 && (l & 1));
    const int comb = (which == 0 && l >= 1 && ((l - 1) & 1)) ? ((l - 1) >> 1) : -1;
    const float* router = inp(c, I_ROUTER) + (size_t)(l >> 1) * D * NE;
    int* routeb = (int*)(c.ws + WS_ROUTE); float* rwt = (float*)(c.ws + WS_RWT); int* tokenof = (int*)(c.ws + WS_TOK);
    const MoeComb mc{routeb, rwt, (const bf16_t*)(c.ws + WS_Y), (const float*)(c.ws + WS_MOD) + (size_t)(l > 0 ? l - 1 : 0) * 5 * 6144 + 5 * 1024};
    LAS unsigned* lcnt = (LAS unsigned*)c.lds; LAS unsigned* gbase = lcnt + 16; LAS unsigned* offs = lcnt + 32; LAS int* pend = (LAS int*)(c.lds + 256);
    if (c.tid < 8) lcnt[c.tid] = 0u;
    if (comb >= 0) moe_offsets(c, comb, offs);
    __syncthreads();
    const float* xin = inp(c, I_X); const float* ctxin = inp(c, I_CTX);
    int nrows = 0;
    const int nrow_all = (which == 1 && l == DEPTH - 1) ? TL : T;
    for (int row = c.bid * NWAVES + c.wave; row < nrow_all; row += c.G * NWAVES, ++nrows) {
        const float* src = first ? (row < TL ? xin + (size_t)row * D : ctxin + (size_t)(row - TL) * D) : xres + (size_t)row * D;
        const int b = row < TL ? (row >> 12) : 4;
        const float* sh = mod + (size_t)b * 6144 + (which == 0 ? 0 : 3) * 1024; const float* sc = sh + 1024;
        f32x4 v[4]; float ss = 0.f;
#pragma unroll
        for (int j = 0; j < 4; ++j) v[j] = *(const f32x4*)(src + 4 * (c.lane + 64 * j));
        if (comb >= 0) moe_combine_row(mc, offs, row, b, c.lane, v);
#pragma unroll
        for (int j = 0; j < 4; ++j) ss += (v[j][0] * v[j][0] + v[j][1] * v[j][1]) + (v[j][2] * v[j][2] + v[j][3] * v[j][3]);
        ss = wave_sum(ss, c.lane);
        const float rstd = 1.f / sqrtf(ss * (1.f / D) + EPS);
        if (first || comb >= 0) {
#pragma unroll
            for (int j = 0; j < 4; ++j) *(f32x4*)(xres + (size_t)row * D + 4 * (c.lane + 64 * j)) = v[j];
        }
        float lg[8] = {0.f, 0.f, 0.f, 0.f, 0.f, 0.f, 0.f, 0.f};
#pragma unroll
        for (int j = 0; j < 4; ++j) { const int k0 = 4 * (c.lane + 64 * j);
            const f32x4 g4 = *(const f32x4*)(gp + k0), s4 = *(const f32x4*)(sc + k0), h4 = *(const f32x4*)(sh + k0);
            f32x4 o;
#pragma unroll
            for (int q = 0; q < 4; ++q) o[q] = v[j][q] * rstd * g4[q] * (1.f + s4[q]) + h4[q];
            u32x2 w; w.x = cvt_pk_bf16(o[0], o[1]); w.y = cvt_pk_bf16(o[2], o[3]);
            *(u32x2*)(h + (size_t)row * D + k0) = w;
            if (route) {
#pragma unroll
                for (int q = 0; q < 4; ++q) { const f32x4 ra = *(const f32x4*)(router + (size_t)(k0 + q) * 8), rb = *(const f32x4*)(router + (size_t)(k0 + q) * 8 + 4);
                    lg[0] += o[q] * ra[0]; lg[1] += o[q] * ra[1]; lg[2] += o[q] * ra[2]; lg[3] += o[q] * ra[3];
                    lg[4] += o[q] * rb[0]; lg[5] += o[q] * rb[1]; lg[6] += o[q] * rb[2]; lg[7] += o[q] * rb[3]; }
            }
        }
        if (route) {
#pragma unroll
            for (int e = 0; e < 8; ++e) lg[e] = wave_sum(lg[e], c.lane);
            int i1 = 0; float v1 = lg[0];
#pragma unroll
            for (int e = 1; e < 8; ++e) if (lg[e] > v1) { v1 = lg[e]; i1 = e; }
            int i2 = -1; float v2 = -3.0e38f;
#pragma unroll
            for (int e = 0; e < 8; ++e) if (e != i1 && lg[e] > v2) { v2 = lg[e]; i2 = e; }
            const float w1 = 1.f / (1.f + __expf(v2 - v1)), w2 = 1.f - w1;
            if (c.lane == 0) {
                const unsigned lp1 = __hip_atomic_fetch_add(lcnt + i1, 1u, __ATOMIC_RELAXED, __HIP_MEMORY_SCOPE_WORKGROUP), lp2 = __hip_atomic_fetch_add(lcnt + i2, 1u, __ATOMIC_RELAXED, __HIP_MEMORY_SCOPE_WORKGROUP);
                LAS int* pe = pend + (c.wave * 16 + nrows) * 4; pe[0] = row; pe[1] = i1 | (i2 << 8); pe[2] = (int)lp1; pe[3] = (int)lp2;
                rwt[(size_t)row * 2] = w1; rwt[(size_t)row * 2 + 1] = w2; }
        }
    }
    if (route) {
        __syncthreads();
        if (c.tid < 8) gbase[c.tid] = __hip_atomic_fetch_add((unsigned*)(c.ws + WS_CTL) + CW_CNT + 64 * (l >> 1) + c.tid, lcnt[c.tid], __ATOMIC_RELAXED, __HIP_MEMORY_SCOPE_AGENT);
        __syncthreads();
        if (c.lane < nrows) { const LAS int* pe = pend + (c.wave * 16 + c.lane) * 4; const int row = pe[0], e1 = pe[1] & 255, e2 = pe[1] >> 8;
            const int p1 = (int)gbase[e1] + pe[2], p2 = (int)gbase[e2] + pe[3];
            tokenof[(size_t)e1 * T + p1] = row; tokenof[(size_t)e2 * T + p2] = row;
            routeb[(size_t)row * 4 + 0] = e1; routeb[(size_t)row * 4 + 1] = p1; routeb[(size_t)row * 4 + 2] = e2; routeb[(size_t)row * 4 + 3] = p2; }
    }
    __syncthreads();
}

__device__ __forceinline__ void ph_sc(const Ctx& c0, int l) {
    const Ctx c = mk_ctx(c0.lds, c0.ws);
    const bf16_t* P = (const bf16_t*)(c.ws + WS_P); bf16_t* uT = (bf16_t*)(c.ws + WS_B); bf16_t* VT = (bf16_t*)(c.ws + WS_VT);
    const float* cw = inp(c, I_HCW) + (size_t)l * 3 * 1536; const float* cb = inp(c, I_HCB) + (size_t)l * 1536;
    LAS unsigned char* scr = c.lds + c.wave * 16384;
    for (int tile = c.bid * NWAVES + c.wave; tile < (T / 64) * 32; tile += c.G * NWAVES) {
        const int rt = tile / 32, row0 = rt * 64, ct = tile % 32; const bool isv = ct >= 24;
        const int ch0 = isv ? (ct - 24) * 64 : ct * 64, scol = isv ? PV + ch0 : PHY + ch0; bf16_t* dst = isv ? VT : uT;
        const int tpos = row0 < TL ? (row0 & 4095) : ((row0 - TL) & 255), Ls = row0 < TL ? 4096 : 256;
        for (int idx = c.lane; idx < 66 * 8; idx += 64) { const int rr = idx >> 3, ck = idx & 7; const int grow = row0 - 1 + rr;
            const bool ok = !((rr == 0 && tpos == 0) || (rr == 65 && tpos + 64 == Ls));
            u32x4 v = (u32x4){0u, 0u, 0u, 0u};
            if (ok) v = *(const u32x4*)(P + (size_t)grow * PW + scol + ck * 8);
            LAS unsigned* d = (LAS unsigned*)(scr + rr * 132 + ck * 16); d[0] = v.x; d[1] = v.y; d[2] = v.z; d[3] = v.w; }
        LDS_WAIT(); asm volatile("" ::: "memory");
        const int ch = ch0 + c.lane; const float w0 = isv ? 0.f : cw[ch], w1 = isv ? 1.f : cw[1536 + ch], w2 = isv ? 0.f : cw[3072 + ch], bb = isv ? 0.f : cb[ch];
        unsigned ow[32];
        { float prev = bf2f(*(const LAS unsigned short*)(scr + 0 * 132 + c.lane * 2)), cur = bf2f(*(const LAS unsigned short*)(scr + 1 * 132 + c.lane * 2)); float o0 = 0.f;
#pragma unroll
          for (int r = 0; r < 64; ++r) { const float nxt = bf2f(*(const LAS unsigned short*)(scr + (r + 2) * 132 + c.lane * 2));
              const float o = w0 * prev + w1 * cur + w2 * nxt + bb; prev = cur; cur = nxt;
              if (r & 1) ow[r >> 1] = cvt_pk_bf16(o0, o); else o0 = o; } }
        LDS_WAIT(); asm volatile("" ::: "memory");
#pragma unroll
        for (int k = 0; k < 8; ++k) { u32x4 v; v.x = ow[4 * k]; v.y = ow[4 * k + 1]; v.z = ow[4 * k + 2]; v.w = ow[4 * k + 3]; *(LAS u32x4*)(scr + c.lane * 144 + k * 16) = v; }
        LDS_WAIT(); asm volatile("" ::: "memory");
#pragma unroll
        for (int k = 0; k < 8; ++k) { const int cc = (c.lane >> 3) + 8 * k, ck = c.lane & 7; const u32x4 v = *(const LAS u32x4*)(scr + cc * 144 + ck * 16);
            *(u32x4*)(dst + (size_t)(ch0 + cc) * T + row0 + ck * 8) = v; }
        LDS_WAIT(); asm volatile("" ::: "memory");
    }
}

constexpr int HY_HR_OFF = 512, HY_U_OFF = HY_HR_OFF + 66560, HY_ZB_OFF = HY_U_OFF + 4 * 8208;
template <int L, bool DUAL>
__device__ __forceinline__ void hy_span(LAS unsigned char* lds, int nsteps, int aaddr, int ubase, int sX, int sY, f32x16& accX, f32x16& accY) {
#define HY_BADDR(sv) (((unsigned)(sv) <= (unsigned)(L - 16)) ? ubase + 2 * (sv) : HY_ZB_OFF)
#define HY_LD(av, xv, yv, kk) do { av = *(const LAS bf16x8*)(lds + aaddr - 256 * (kk)); xv = *(const LAS bf16x8*)(lds + HY_BADDR(sX - 16 * (kk))); \
        if (DUAL) yv = *(const LAS bf16x8*)(lds + HY_BADDR(sY - 16 * (kk))); } while (0)
    bf16x8 a0, a1, x0, x1, y0 = {}, y1 = {}, pa0, pa1, px0, px1, py0 = {}, py1 = {};
    HY_LD(a0, x0, y0, 0); HY_LD(a1, x1, y1, 1);
    int k = 0;
    for (; k + 2 <= nsteps; k += 2) {
        aaddr -= 512; sX -= 32; sY -= 32;
        HY_LD(pa0, px0, py0, 0);
        accX = __builtin_amdgcn_mfma_f32_32x32x16_bf16(a0, x0, accX, 0, 0, 0); if (DUAL) accY = __builtin_amdgcn_mfma_f32_32x32x16_bf16(a0, y0, accY, 0, 0, 0);
        HY_LD(pa1, px1, py1, 1);
        accX = __builtin_amdgcn_mfma_f32_32x32x16_bf16(a1, x1, accX, 0, 0, 0); if (DUAL) accY = __builtin_amdgcn_mfma_f32_32x32x16_bf16(a1, y1, accY, 0, 0, 0);
        a0 = pa0; x0 = px0; y0 = py0; a1 = pa1; x1 = px1; y1 = py1;
    }
    if (k < nsteps) { accX = __builtin_amdgcn_mfma_f32_32x32x16_bf16(a0, x0, accX, 0, 0, 0); if (DUAL) accY = __builtin_amdgcn_mfma_f32_32x32x16_bf16(a0, y0, accY, 0, 0, 0); }
#undef HY_LD
#undef HY_BADDR
}
template <int L>
__device__ __forceinline__ void hy_unit(const Ctx& c, int l, int ch, const float* hbias) {
    constexpr int H = L / 2, NG = L / 256, LP = L + 64, NW = L / 8 + 8, ROWB = 2 * L + 16;
    LAS unsigned char* lds = c.lds;
    const bf16_t* uT = (const bf16_t*)(c.ws + WS_B); bf16_t* ohy = (bf16_t*)(c.ws + WS_OAH) + 512;
    const int seq0 = (L == 4096) ? 0 : TL;
    const bf16_t* hrbase = (L == 4096) ? (const bf16_t*)(c.ws + WS_HRL) : (const bf16_t*)(c.ws + WS_HRC);
    int gA, gB;
    if (NG == 16) { gA = c.wave < 4 ? c.wave : 4 + c.wave; gB = c.wave < 4 ? 7 - c.wave : 19 - c.wave; } else { gA = c.wave == 0 ? 0 : -1; gB = -1; }
    const int n = c.lane & 31, g = c.lane >> 5, tbl = n >> 2, b = n & 3;
    const int loA = gA < 0 ? 1 << 30 : max(-H - 16, 256 * gA - (L - 16)), hiA = gA < 0 ? -(1 << 30) : min(H, 256 * gA + 224);
    const int loB = gB < 0 ? 1 << 30 : max(-H - 16, 256 * gB - (L - 16)), hiB = gB < 0 ? -(1 << 30) : min(H, 256 * gB + 224);
    const int dlo = min(loA, loB), dhi = max(hiA, hiB);
    unsigned zreg[2][4][2];
    for (int o = 0; o < 2; ++o) {
        const bf16_t* hr = hrbase + ((size_t)(l * 2 + o) * 512 + ch) * LP;
        for (int w = c.tid; w < NW; w += NTHR) {
            u32x4 A4 = (u32x4){0u, 0u, 0u, 0u}; if (w > 0) A4 = *(const u32x4*)(hr + 8 * (w - 1));
            const u32x4 B4 = *(const u32x4*)(hr + 8 * w);
            const unsigned Dd[8] = {A4.x, A4.y, A4.z, A4.w, B4.x, B4.y, B4.z, B4.w};
#pragma unroll
            for (int q = 0; q < 8; ++q) { u32x4 ov;
                if ((q & 1) == 0) { const int j = (8 - q) / 2; ov.x = Dd[j]; ov.y = Dd[j + 1]; ov.z = Dd[j + 2]; ov.w = Dd[j + 3]; }
                else { const int j = (7 - q) / 2; ov.x = __builtin_amdgcn_alignbit(Dd[j + 1], Dd[j], 16); ov.y = __builtin_amdgcn_alignbit(Dd[j + 2], Dd[j + 1], 16);
                       ov.z = __builtin_amdgcn_alignbit(Dd[j + 3], Dd[j + 2], 16); ov.w = __builtin_amdgcn_alignbit(Dd[j + 4], Dd[j + 3], 16); }
                *(LAS u32x4*)(lds + HY_HR_OFF + (8 * w + q) * 16) = ov; }
        }
        if (o == 0) {
            for (int idx = c.tid; idx < 4 * (L / 8); idx += NTHR) { const int bb = idx / (L / 8), wq = idx % (L / 8);
                *(LAS u32x4*)(lds + HY_U_OFF + bb * ROWB + wq * 16) = *(const u32x4*)(uT + (size_t)ch * T + seq0 + bb * L + wq * 8); }
            if (c.tid < 16) *(LAS unsigned*)(lds + HY_ZB_OFF + c.tid * 4) = 0u;
        } else {
#pragma unroll
            for (int gi = 0; gi < 2; ++gi) { const int G = gi == 0 ? gA : gB; if (G >= 0) {
#pragma unroll
                for (int rq = 0; rq < 4; ++rq) { const int t = 32 * (8 * G + tbl) + 8 * rq + 4 * g;
                    u32x2 zz; zz.x = zreg[gi][rq][0]; zz.y = zreg[gi][rq][1]; *(LAS u32x2*)(lds + HY_U_OFF + b * ROWB + 2 * t) = zz; } } }
        }
        __syncthreads();
        f32x16 accA, accB;
#pragma unroll
        for (int r = 0; r < 16; ++r) { accA[r] = 0.f; accB[r] = 0.f; }
        {
            const int qq = (n + 1) & 7, ubase = HY_U_OFF + b * ROWB + 16 * g;
#define HY_AADDR(d) (HY_HR_OFF + (8 * ((H + 31 - (d) - n + 8 * g + qq) >> 3) + qq) * 16)
#define HY_S0(G, d) (32 * (8 * (G) + tbl) - (d))
            if (gB < 0) { if (gA >= 0) hy_span<L, false>(lds, (hiA - loA) / 16 + 1, HY_AADDR(loA), ubase, HY_S0(gA, loA), 0, accA, accB); }
            else {
                const int dS = max(loA, loB), dE = min(hiA, hiB);
                if (loA < dS) hy_span<L, false>(lds, (dS - loA) / 16, HY_AADDR(loA), ubase, HY_S0(gA, loA), 0, accA, accB);
                else if (loB < dS) hy_span<L, false>(lds, (dS - loB) / 16, HY_AADDR(loB), ubase, HY_S0(gB, loB), 0, accB, accA);
                hy_span<L, true>(lds, (dE - dS) / 16 + 1, HY_AADDR(dS), ubase, HY_S0(gA, dS), HY_S0(gB, dS), accA, accB);
                if (hiA > dE) hy_span<L, false>(lds, (hiA - dE) / 16, HY_AADDR(dE + 16), ubase, HY_S0(gA, dE + 16), 0, accA, accB);
                else if (hiB > dE) hy_span<L, false>(lds, (hiB - dE) / 16, HY_AADDR(dE + 16), ubase, HY_S0(gB, dE + 16), 0, accB, accA);
            }
#undef HY_AADDR
#undef HY_S0
        }
        const float bias = hbias[(l * 2 + o) * 512 + ch];
#pragma unroll
        for (int gi = 0; gi < 2; ++gi) { const int G = gi == 0 ? gA : gB; if (G >= 0) {
#pragma unroll
            for (int rq = 0; rq < 4; ++rq) { const int t = 32 * (8 * G + tbl) + 8 * rq + 4 * g;
                const u32x2 uv = *(const LAS u32x2*)(lds + HY_U_OFF + b * ROWB + 2 * t);
                const size_t grow = (size_t)seq0 + b * L + t;
                const u32x2 xv = *(const u32x2*)(uT + (size_t)((o == 0 ? 512 : 1024) + ch) * T + grow);
                float y[4];
#pragma unroll
                for (int k = 0; k < 4; ++k) y[k] = gi == 0 ? accA[4 * rq + k] : accB[4 * rq + k];
                const float r0 = bflo(xv.x) * (y[0] + bias * bflo(uv.x)), r1 = bfhi(xv.x) * (y[1] + bias * bfhi(uv.x));
                const float r2 = bflo(xv.y) * (y[2] + bias * bflo(uv.y)), r3 = bfhi(xv.y) * (y[3] + bias * bfhi(uv.y));
                const unsigned p0 = cvt_pk_bf16(r0, r1), p1 = cvt_pk_bf16(r2, r3);
                if (o == 0) { zreg[gi][rq][0] = p0; zreg[gi][rq][1] = p1; }
                else { bf16_t* op = ohy + grow * 1024 + ch; op[0] = (bf16_t)(p0 & 0xffffu); op[1024] = (bf16_t)(p0 >> 16); op[2048] = (bf16_t)(p1 & 0xffffu); op[3072] = (bf16_t)(p1 >> 16); } } } }
        __syncthreads();
    }
}
__device__ __forceinline__ void ph_hyena(const Ctx& c0, int l) {
    const Ctx c = mk_ctx(c0.lds, c0.ws);
    const float* hbias = inp(c, I_HBIAS);
    for (int unit = c.bid; unit < HYW; unit += c.G) { hy_unit<4096>(c, l, unit, hbias); if (l < DEPTH - 1) hy_unit<256>(c, l, unit, hbias); }
}

constexpr int ATT_RPB_OFF = 1024, ATT_VT_OFF = ATT_RPB_OFF + 8 * 15 * 32 * 4, ATT_VT_BYTES = 64 * 72;
template <int MODE>
__device__ __forceinline__ void att_block(const bf16_t* P, const bf16_t* VT, LAS unsigned char* lds, LAS unsigned char* vt, int lane, int n, int h, int head,
                                          int tokk, int ctok, int tabaddr, int vb, const bf16x8 (&qf)[4], f32x16& ot0, f32x16& ot1, float& m, float& lsum) {
    bf16x8 kf[4];
#pragma unroll
    for (int ks = 0; ks < 4; ++ks) kf[ks] = *(const bf16x8*)(P + (size_t)tokk * PW + PK + head * 64 + 16 * ks + 8 * h);
    u32x2 vr[8];
#pragma unroll
    for (int it = 0; it < 8; ++it) vr[it] = *(const u32x2*)(VT + (size_t)(head * 64 + it * 8 + (lane >> 3)) * T + ctok);
    f32x16 st;
#pragma unroll
    for (int r = 0; r < 16; ++r) st[r] = 0.f;
#pragma unroll
    for (int ks = 0; ks < 4; ++ks) st = __builtin_amdgcn_mfma_f32_32x32x16_bf16(kf[ks], qf[ks], st, 0, 0, 0);
    const float SC = 0.18033688011112042f;
    float sv[16];
#pragma unroll
    for (int r = 0; r < 16; ++r) {
        if (MODE == 2) sv[r] = st[r] * SC;
        else { const int cr = MODE == 0 ? 8 * (r >> 2) + (r & 3) : (r & 3), imm = MODE == 0 ? cr * 4 : ((r >> 2) * 32 + (r & 3)) * 4;
            const float bias = *(const LAS float*)(lds + tabaddr + imm);
            const bool ok = (unsigned)(vb + cr) < 16u;
            sv[r] = ok ? st[r] * SC + bias : -1.0e30f; }
    }
    float bm = sv[0];
#pragma unroll
    for (int r = 1; r < 16; ++r) bm = fmaxf(bm, sv[r]);
    bm = fmaxf(bm, __int_as_float(__builtin_amdgcn_ds_bpermute((lane ^ 32) << 2, __float_as_int(bm))));
    const float mn = fmaxf(m, bm), alpha = __builtin_amdgcn_exp2f(m - mn); m = mn;
    float psum = 0.f;
#pragma unroll
    for (int r = 0; r < 16; ++r) { const float pv = __builtin_amdgcn_exp2f(sv[r] - mn); psum += pv; sv[r] = pv; }
    lsum = lsum * alpha + psum;
#pragma unroll
    for (int r = 0; r < 16; ++r) { ot0[r] *= alpha; ot1[r] *= alpha; }
    bf16x8 pb[2];
#pragma unroll
    for (int s2 = 0; s2 < 2; ++s2) { u32x4 w; w.x = cvt_pk_bf16(sv[8 * s2], sv[8 * s2 + 1]); w.y = cvt_pk_bf16(sv[8 * s2 + 2], sv[8 * s2 + 3]);
        w.z = cvt_pk_bf16(sv[8 * s2 + 4], sv[8 * s2 + 5]); w.w = cvt_pk_bf16(sv[8 * s2 + 6], sv[8 * s2 + 7]); pb[s2] = __builtin_bit_cast(bf16x8, w); }
#pragma unroll
    for (int it = 0; it < 8; ++it) *(LAS u32x2*)(vt + (it * 8 + (lane >> 3)) * 72 + (lane & 7) * 8) = vr[it];
#pragma unroll
    for (int s2 = 0; s2 < 2; ++s2) {
        { const u32x2 a = *(const LAS u32x2*)(vt + n * 72 + (4 * s2 + h) * 8), bq = *(const LAS u32x2*)(vt + n * 72 + (4 * s2 + 2 + h) * 8);
          u32x4 w; w.x = a.x; w.y = a.y; w.z = bq.x; w.w = bq.y; ot0 = __builtin_amdgcn_mfma_f32_32x32x16_bf16(__builtin_bit_cast(bf16x8, w), pb[s2], ot0, 0, 0, 0); }
        { const u32x2 a = *(const LAS u32x2*)(vt + (32 + n) * 72 + (4 * s2 + h) * 8), bq = *(const LAS u32x2*)(vt + (32 + n) * 72 + (4 * s2 + 2 + h) * 8);
          u32x4 w; w.x = a.x; w.y = a.y; w.z = bq.x; w.w = bq.y; ot1 = __builtin_amdgcn_mfma_f32_32x32x16_bf16(__builtin_bit_cast(bf16x8, w), pb[s2], ot1, 0, 0, 0); }
    }
}
constexpr int ATT_UNITS = 4096 + 256;
__device__ __forceinline__ void ph_attn(const Ctx& c0, int l) {
    const Ctx c = mk_ctx(c0.lds, c0.ws);
    const bf16_t* P = (const bf16_t*)(c.ws + WS_P); const bf16_t* VT = (const bf16_t*)(c.ws + WS_VT); bf16_t* oatt = (bf16_t*)(c.ws + WS_OAH);
    const float* rpb = inp(c, I_RPB) + (size_t)l * 8 * 15 * 31;
    LAS unsigned char* lds = c.lds;
    for (int i = c.tid; i < 8 * 15 * 32; i += NTHR) { const int hd = i / 480, rem = i % 480, dr = rem >> 5, dc = rem & 31;
        *(LAS float*)(lds + ATT_RPB_OFF + i * 4) = dc < 31 ? rpb[(hd * 15 + dr) * 31 + dc] * 1.4426950408889634f : 0.f; }
    __syncthreads();
    LAS unsigned char* vt = lds + ATT_VT_OFF + c.wave * ATT_VT_BYTES;
    const int lane = c.lane, n = lane & 31, h = lane >> 5;
    const int natt = l < DEPTH - 1 ? ATT_UNITS : 4096;
    for (int u = c.bid * NWAVES + c.wave; u < natt; u += c.G * NWAVES) {
        const bool lat = u < 4096;
        int b, head, r = 0, hf = 0, tokq;
        if (lat) { hf = u & 1; r = (u >> 1) & 63; head = (u >> 7) & 7; b = u >> 10; tokq = b * 4096 + r * 64 + 32 * hf + n; }
        else { const int uu = u - 4096; head = (uu >> 3) & 7; b = uu >> 6; tokq = TL + b * 256 + 32 * (uu & 7) + n; }
        bf16x8 qf[4];
#pragma unroll
        for (int ks = 0; ks < 4; ++ks) qf[ks] = *(const bf16x8*)(P + (size_t)tokq * PW + PQ + head * 64 + 16 * ks + 8 * h);
        f32x16 ot0, ot1;
#pragma unroll
        for (int q = 0; q < 16; ++q) { ot0[q] = 0.f; ot1[q] = 0.f; }
        float m = -1.0e30f, lsum = 0.f;
        if (lat) {
            const int r0 = min(max(r - 4, 0), 56), lo = hf ? 24 : 0, qc = 32 * hf + n, c0q = min(max(qc - 8, 0), 48);
            for (int kb = 0; kb < 8; ++kb) {
                const int base = b * 4096 + (r0 + kb) * 64 + lo, kx = lo + 4 * h;
                const int tabaddr = ATT_RPB_OFF + (((head * 15 + (r0 + kb - r + 7)) * 32) + kx - qc + 15) * 4;
                att_block<0>(P, VT, lds, vt, lane, n, h, head, base + n, base + 4 * (lane & 7), tabaddr, kx - c0q, qf, ot0, ot1, m, lsum);
            }
            for (int kb = 0; kb < 2; ++kb) {
                const int rowb = b * 4096 + (r0 + 4 * kb) * 64 + lo + 32, kx = lo + 32 + 4 * h, cc = lane & 7;
                const int tabaddr = ATT_RPB_OFF + (((head * 15 + (r0 + 4 * kb - r + 7)) * 32) + kx - qc + 15) * 4;
                att_block<1>(P, VT, lds, vt, lane, n, h, head, rowb + (n >> 3) * 64 + (n & 7), rowb + (cc >> 1) * 64 + 4 * (cc & 1), tabaddr, kx - c0q, qf, ot0, ot1, m, lsum);
            }
        }
        for (int kb = 0; kb < 8; ++kb) { const int base = TL + b * 256 + 32 * kb;
            att_block<2>(P, VT, lds, vt, lane, n, h, head, base + n, base + 4 * (lane & 7), 0, 0, qf, ot0, ot1, m, lsum); }
        const float ltot = lsum + __int_as_float(__builtin_amdgcn_ds_bpermute((lane ^ 32) << 2, __float_as_int(lsum)));
        const float inv = 1.f / ltot;
        bf16_t* op = oatt + (size_t)tokq * 1024 + head * 64 + 4 * h;
#pragma unroll
        for (int rq = 0; rq < 4; ++rq) {
            u32x2 w0, w1; w0.x = cvt_pk_bf16(ot0[4 * rq] * inv, ot0[4 * rq + 1] * inv); w0.y = cvt_pk_bf16(ot0[4 * rq + 2] * inv, ot0[4 * rq + 3] * inv);
            w1.x = cvt_pk_bf16(ot1[4 * rq] * inv, ot1[4 * rq + 1] * inv); w1.y = cvt_pk_bf16(ot1[4 * rq + 2] * inv, ot1[4 * rq + 3] * inv);
            *(u32x2*)(op + 8 * rq) = w0; *(u32x2*)(op + 32 + 8 * rq) = w1; }
    }
    __syncthreads();
}

__device__ __forceinline__ void ph_final(const Ctx& c0) {
    const Ctx c = mk_ctx(c0.lds, c0.ws);
    const float* xres = (const float*)(c.ws + WS_X); const float* gp = inp(c, I_FINALG); float* outp = (float*)inp(c, 30);
    const MoeComb mc{(const int*)(c.ws + WS_ROUTE), (const float*)(c.ws + WS_RWT), (const bf16_t*)(c.ws + WS_Y), (const float*)(c.ws + WS_MOD) + (size_t)(DEPTH - 1) * 5 * 6144 + 5 * 1024};
    LAS unsigned* offs = (LAS unsigned*)c.lds + 32;
    moe_offsets(c, 1, offs);
    __syncthreads();
    for (int row = c.bid * NWAVES + c.wave; row < TL; row += c.G * NWAVES) {
        const float* src = xres + (size_t)row * D; f32x4 v[4]; float ss = 0.f;
#pragma unroll
        for (int j = 0; j < 4; ++j) v[j] = *(const f32x4*)(src + 4 * (c.lane + 64 * j));
        moe_combine_row(mc, offs, row, row >> 12, c.lane, v);
#pragma unroll
        for (int j = 0; j < 4; ++j) ss += (v[j][0] * v[j][0] + v[j][1] * v[j][1]) + (v[j][2] * v[j][2] + v[j][3] * v[j][3]);
        ss = wave_sum(ss, c.lane);
        const float rstd = 1.f / sqrtf(ss * (1.f / D) + EPS);
#pragma unroll
        for (int j = 0; j < 4; ++j) { const int k0 = 4 * (c.lane + 64 * j); const f32x4 g4 = *(const f32x4*)(gp + k0); *(f32x4*)(outp + (size_t)row * D + k0) = v[j] * rstd * g4; }
    }
}

constexpr int MOE_OFF = 132096;
template <bool GATHER_> struct MoeOrder {
    static constexpr bool GATHER = GATHER_;
    int nM, nN, nwg, G, c; const char* A; const char* B; size_t astep, bstep, estep; const int* tokenof; const LAS unsigned* tab;
    __device__ void init(const void* A_, int lda, const void* B_, int ldb, size_t estep_bytes, int N, int G_, int c_, const int* tok, const LAS unsigned* tab_) {
        tab = tab_; nM = (int)((unsigned)__builtin_amdgcn_readfirstlane(tab[8]) >> 8); nN = N / pg8::BM; nwg = nM * nN; G = G_; c = c_; A = (const char*)A_; B = (const char*)B_;
        astep = (size_t)pg8::BM * lda * 2; bstep = (size_t)pg8::BM * ldb * 2; estep = estep_bytes; tokenof = tok; }
    __device__ bool next(int i, pg8::Unit& u) const {
        const long L = (long)i * G + c; if (L >= nwg) return false;
        int wgid = (int)L; { const int q = nwg / pg8::NXCD, r = nwg % pg8::NXCD, xcd = wgid % pg8::NXCD, off = wgid / pg8::NXCD; wgid = (xcd < r ? xcd * (q + 1) : r * (q + 1) + (xcd - r) * q) + off; }
        const int nig = pg8::WGM * nN, gid = wgid / nig, fm = gid * pg8::WGM, gsz = (nM - fm) < pg8::WGM ? (nM - fm) : pg8::WGM;
        u.pm = fm + ((wgid % nig) % gsz); u.pn = (wgid % nig) / gsz;
        const unsigned slot0 = (unsigned)u.pm << 8; int e = 0;
#pragma unroll
        for (int j = 1; j < 8; ++j) e += (slot0 >= (unsigned)__builtin_amdgcn_readfirstlane(tab[j])) ? 1 : 0;
        const unsigned pos0 = slot0 - (unsigned)__builtin_amdgcn_readfirstlane(tab[e]), cnt = (unsigned)__builtin_amdgcn_readfirstlane(tab[16 + e]);
        u.nvalid = cnt > pos0 ? (int)(cnt - pos0) : 0; u.tk = tokenof + (size_t)e * T + pos0;
        u.a = GATHER ? A : A + (size_t)u.pm * astep; u.b = B + (size_t)e * estep + (size_t)u.pn * bstep; return true;
    }
    __device__ __forceinline__ int arow(const pg8::Unit& u, int r) const { return r < u.nvalid ? u.tk[r] : 0; }
    __device__ __forceinline__ void a_ready(const pg8::Unit&) const {}
    __device__ __forceinline__ void done(const pg8::Unit&) const {}
};
__device__ __forceinline__ void moe_table(const Ctx& c, int i) {
    LAS unsigned* tab = (LAS unsigned*)(c.lds + MOE_OFF);
    if (c.tid == 0) { const unsigned* cnt = (const unsigned*)(c.ws + WS_CTL) + CW_CNT + 64 * i; unsigned o = 0;
        for (int e = 0; e < 8; ++e) { const unsigned ce = cnt[e]; tab[e] = o; tab[16 + e] = ce; o += (ce + 255u) & ~255u; } tab[8] = o; }
    __syncthreads();
}

#define XB_TMO      128
#define XB_XCNT(j)  (256  + 64 * (j))
#define XB_XSUB(j)  (1280 + 64 * (j))
#define XB_XGEN(j)  (2304 + 64 * (j))
#define XB_TOP      3328
#define XB_TOPGEN   3392
#define XCD_BAR_WORDS 3456
#define XB_SPIN_CAP (1u << 18)
__device__ __forceinline__ unsigned xb_ld(unsigned* p)              { return __hip_atomic_load(p, __ATOMIC_RELAXED, __HIP_MEMORY_SCOPE_AGENT); }
__device__ __forceinline__ unsigned xb_add(unsigned* p, unsigned v) { return __hip_atomic_fetch_add(p, v, __ATOMIC_RELAXED, __HIP_MEMORY_SCOPE_AGENT); }
__device__ __forceinline__ unsigned xb_xcc_id() { return (unsigned)__builtin_amdgcn_s_getreg((3 << 11) | 20) & 0xFu; }
#define XB_SPIN(cond, bar) do { unsigned _sp = 0; while (cond) { __builtin_amdgcn_s_sleep(1); \
    if ((++_sp & 255u) == 0u) { if (xb_ld(&(bar)[XB_TMO])) break; if (_sp > XB_SPIN_CAP) { atomicAdd(&(bar)[XB_TMO], 1u); break; } } } } while (0)
struct XcdBarrier { unsigned* bar; unsigned x; volatile LAS unsigned* st; };
__device__ __forceinline__ XcdBarrier xcd_barrier_post(unsigned* bar, volatile LAS unsigned* st) {
    XcdBarrier b; b.bar = bar; b.x = xb_xcc_id(); b.st = st;
    if (threadIdx.x == 0) (void)xb_add(&bar[XB_XCNT(b.x)], 1u);
    return b;
}
__device__ __forceinline__ void xcd_barrier_complete(unsigned* bar, unsigned x, unsigned& nloc, unsigned& nx) {
    const unsigned G = gridDim.x * gridDim.y * gridDim.z;
    unsigned sum, cnt, mine, sp = 0u;
    for (;;) {
        sum = 0u; cnt = 0u; mine = 0u;
#pragma unroll
        for (unsigned j = 0; j < 16; ++j) { const unsigned c = xb_ld(&bar[XB_XCNT(j)]); sum += c; cnt += (c > 0u) ? 1u : 0u; mine = (j == x) ? c : mine; }
        if (sum == G) break;
        __builtin_amdgcn_s_sleep(1);
        if ((++sp & 255u) == 0u) { if (xb_ld(&bar[XB_TMO])) break; if (sp > XB_SPIN_CAP) { atomicAdd(&bar[XB_TMO], 1u); break; } }
    }
    nloc = mine > 0u ? mine : 1u; nx = cnt > 0u ? cnt : 1u;
}
__device__ __forceinline__ void xcd_barrier(const XcdBarrier& b) {
    asm volatile("s_waitcnt vmcnt(0)" ::: "memory");
    __syncthreads();
    if (threadIdx.x == 0) {
        unsigned* bar = b.bar; asm volatile("" : "+s"(bar));     const unsigned bx = xb_xcc_id();
        __builtin_amdgcn_s_waitcnt(0);
        unsigned nloc = b.st[0], nx = b.st[1];
        if (nloc == 0u) { xcd_barrier_complete(bar, bx, nloc, nx); b.st[0] = nloc; b.st[1] = nx; }
        const unsigned old = xb_add(&bar[XB_XSUB(bx)], 1u);
        const unsigned gen = old / nloc;
        if (old + 1u == (gen + 1u) * nloc) {
            __builtin_amdgcn_fence(__ATOMIC_RELEASE, "agent");
            asm volatile("s_waitcnt vmcnt(0)" ::: "memory");
            const unsigned og = xb_add(&bar[XB_TOP], 1u);
            const unsigned tg = og / nx;
            if (og + 1u == (tg + 1u) * nx) xb_add(&bar[XB_TOPGEN], 1u);
            else XB_SPIN(xb_ld(&bar[XB_TOPGEN]) == tg, bar);
            __builtin_amdgcn_fence(__ATOMIC_ACQUIRE, "agent");
            xb_add(&bar[XB_XGEN(bx)], 1u);
            asm volatile("s_waitcnt vmcnt(0)" ::: "memory");
        } else {
            XB_SPIN(xb_ld(&bar[XB_XGEN(bx)]) == gen, bar);
            __builtin_amdgcn_fence(__ATOMIC_ACQUIRE, "agent");
            asm volatile("s_waitcnt vmcnt(0)" ::: "memory");
        }
    }
    __syncthreads();
}

constexpr int CW_BAR = 4096;

__global__ void __launch_bounds__(NTHR, 2) fwd(Args args) {
    extern __shared__ __attribute__((aligned(16))) unsigned char lds_raw[];
    Ctx c; c.lds = (LAS unsigned char*)lds_raw; c.tid = threadIdx.x; c.lane = c.tid & 63; c.wave = __builtin_amdgcn_readfirstlane(c.tid >> 6); c.G = gridDim.x; c.bid = blockIdx.x; c.ws = args.ws;
    unsigned char* ws = args.ws;
    volatile LAS unsigned* MISC = (volatile LAS unsigned*)(c.lds + MISC_OFF);
    if (c.tid < 32) MISC[c.tid] = 0u;
    if (c.tid < 31) { const unsigned long long pv = c.tid < 30 ? (unsigned long long)args.in[c.tid] : (unsigned long long)args.out;
        volatile LAS unsigned* pt = (volatile LAS unsigned*)(c.lds + PTR_OFF) + 2 * c.tid; pt[0] = (unsigned)pv; pt[1] = (unsigned)(pv >> 32); }
    __syncthreads();
    XcdBarrier bar = xcd_barrier_post((unsigned*)(ws + WS_CTL) + CW_BAR, MISC + 8);
#define GRID_BAR() xcd_barrier(bar)

    ph_convert(c); __syncthreads(); ph_mod(c); __syncthreads(); ph_filt(c);
    GRID_BAR();
    for (int l = 0; l < DEPTH; ++l) {
        ph_norm(c, l, 0);
        GRID_BAR();
        {   unsigned char* ws = c.ws; asm volatile("" : "+s"(ws));
            pg8::Gemm g{D, D, D}; pg8::StaticOrder S; S.init(ws + WS_H, D, (bf16_t*)(ws + WS_WIN) + (size_t)l * PW * D, D, T, PW, c.G, c.bid);
            EpiStoreBf16 E{(bf16_t*)(ws + WS_P), PW};
            pg8::gemm_phase(c.lds, g, S, E); }
        GRID_BAR();
        ph_sc(c, l);
        GRID_BAR();
        ph_hyena(c, l); ph_attn(c, l);
        GRID_BAR();
        {   unsigned char* ws = c.ws; asm volatile("" : "+s"(ws));
            const bf16_t* wab = (const bf16_t*)(ws + WS_WPAB) + (size_t)l * D * D;
            pg8::Gemm g{D, D, D}; pg8::StaticOrder S; S.init(ws + WS_OAH, D, wab, D, TL, D, c.G, c.bid);
            EpiMergeK E{(const bf16_t*)(ws + WS_P), (bf16_t*)(ws + WS_H)};
            pg8::gemm_phase(c.lds, g, S, E);
            if (l < DEPTH - 1) ctx_gemm((const bf16_t*)(ws + WS_OAH), D, wab, D, D, CEpiMergeK{(const bf16_t*)(ws + WS_P), (bf16_t*)(ws + WS_H)}); }
        GRID_BAR();
        {   unsigned char* ws = c.ws; asm volatile("" : "+s"(ws));
            const float* modl = (const float*)(ws + WS_MOD) + (size_t)l * 5 * 6144;
            pg8::Gemm g{D, D, D}; pg8::StaticOrder S; S.init(ws + WS_H, D, (bf16_t*)(ws + WS_WO) + (size_t)l * D * D, D, TL, D, c.G, c.bid);
            EpiResid E{(float*)(ws + WS_X), modl + 2 * 1024};
            pg8::gemm_phase(c.lds, g, S, E);
            if (l < DEPTH - 1) ctx_gemm((const bf16_t*)(ws + WS_H), D, (const bf16_t*)(ws + WS_WO) + (size_t)l * D * D, D, D, CEpiResid{(float*)(ws + WS_X), modl + 4 * 6144 + 2 * 1024}); }
        GRID_BAR();
        ph_norm(c, l, 1);
        GRID_BAR();
        if ((l & 1) == 0) {
            {   unsigned char* ws = c.ws; asm volatile("" : "+s"(ws));
                const bf16_t* w = (const bf16_t*)(ws + WS_W13D) + (size_t)(l >> 1) * 2 * FF * D;
                pg8::Gemm g{D, D, D}; pg8::StaticOrder S; S.init(ws + WS_H, D, w, D, T, 2 * FF, c.G, c.bid);
                EpiSwiglu E{(bf16_t*)(ws + WS_P)};
                pg8::gemm_phase(c.lds, g, S, E); }
            GRID_BAR();
            {   unsigned char* ws = c.ws; asm volatile("" : "+s"(ws));
                const float* modl = (const float*)(ws + WS_MOD) + (size_t)l * 5 * 6144;
                const bf16_t* w = (const bf16_t*)(ws + WS_W2D) + (size_t)(l >> 1) * D * FF;
                pg8::Gemm g{FF, FF, FF}; pg8::StaticOrder S; S.init(ws + WS_P, FF, w, FF, TL, D, c.G, c.bid);
                EpiResid E{(float*)(ws + WS_X), modl + 5 * 1024};
                pg8::gemm_phase(c.lds, g, S, E);
                ctx_gemm((const bf16_t*)(ws + WS_P), FF, w, FF, FF, CEpiResid{(float*)(ws + WS_X), modl + 4 * 6144 + 5 * 1024}); }
            GRID_BAR();
        } else {
            const Ctx cm = mk_ctx(c.lds, c.ws);
            moe_table(cm, l >> 1);
            {   unsigned char* ws = c.ws; asm volatile("" : "+s"(ws));
                const bf16_t* w = (const bf16_t*)(ws + WS_W13M) + (size_t)((l >> 1) * NE) * 2 * FF * D;
                pg8::Gemm g{D, D, D}; MoeOrder<true> S; S.init(ws + WS_H, D, w, D, (size_t)2 * FF * D * 2, 2 * FF, c.G, c.bid, (const int*)(ws + WS_TOK), (const LAS unsigned*)(c.lds + MOE_OFF));
                EpiSwiglu E{(bf16_t*)(ws + WS_P)};
                pg8::gemm_phase(c.lds, g, S, E); }
            GRID_BAR();
            {   unsigned char* ws = c.ws; asm volatile("" : "+s"(ws));
                const bf16_t* w = (const bf16_t*)(ws + WS_W2M) + (size_t)((l >> 1) * NE) * D * FF;
                pg8::Gemm g{FF, FF, FF}; MoeOrder<false> S; S.init(ws + WS_P, FF, w, FF, (size_t)D * FF * 2, D, c.G, c.bid, (const int*)(ws + WS_TOK), (const LAS unsigned*)(c.lds + MOE_OFF));
                EpiStoreBf16 E{(bf16_t*)(ws + WS_Y), D};
                pg8::gemm_phase(c.lds, g, S, E); }
            GRID_BAR();
        }
    }
    ph_final(c);
}

extern "C" void kernel_launch(void* const* d_in, const int* in_sizes, int n_in, void* d_out, int out_size, void* d_ws, size_t ws_size, hipStream_t stream) {
    static int grid = 0;
    if (grid == 0) {
        if (n_in != 30 || out_size != TL * D || ws_size < WS_END) { fprintf(stderr, "kernel_launch: unexpected shapes (n_in %d out %d ws %zu)\n", n_in, out_size, ws_size); grid = -1; return; }
        int dev = 0, cus = 0, per_cu = 0; (void)hipGetDevice(&dev); (void)hipDeviceGetAttribute(&cus, hipDeviceAttributeMultiprocessorCount, dev);
        if (hipFuncSetAttribute((const void*)fwd, hipFuncAttributeMaxDynamicSharedMemorySize, LDS_BYTES) != hipSuccess) { fprintf(stderr, "kernel_launch: hipFuncSetAttribute failed\n"); grid = -1; return; }
        if (hipOccupancyMaxActiveBlocksPerMultiprocessor(&per_cu, (const void*)fwd, NTHR, LDS_BYTES) != hipSuccess || per_cu < 1) fprintf(stderr, "kernel_launch: occupancy query reports %d\n", per_cu);
        (void)hipGetLastError();
        grid = cus > 0 ? cus : 256;
    }
    if (grid < 0) return;
    (void)hipMemsetAsync((char*)d_ws + WS_CTL, 0, CTL_ZERO_BYTES, stream);
    Args a{};
    for (int i = 0; i < 30; ++i) a.in[i] = (const float*)d_in[i];
    a.out = (float*)d_out; a.ws = (unsigned char*)d_ws;
    hipLaunchKernelGGL(fwd, dim3(grid), dim3(NTHR), LDS_BYTES, stream, a);
}
```

```cpp
#include <hip/hip_runtime.h>
#include <cstdio>
#include <cstdint>

#define LAS __attribute__((address_space(3)))
#define GAS __attribute__((address_space(1)))
typedef unsigned short bf16_t;
typedef short bf16x8 __attribute__((ext_vector_type(8)));
typedef float f32x4 __attribute__((ext_vector_type(4)));
typedef float f32x2 __attribute__((ext_vector_type(2)));
typedef float f32x16 __attribute__((ext_vector_type(16)));
typedef unsigned u32x4 __attribute__((ext_vector_type(4)));
typedef unsigned u32x2 __attribute__((ext_vector_type(2)));

constexpr int D = 1024, NB = 4, SEQ = 4096, DEPTH = 4, CTX = 256;
constexpr int TL = NB * SEQ, TC = NB * CTX, T = TL + TC;
constexpr int PW = 5120, FF = 2816, NE = 8, HYW = 512;
constexpr int PQ = 0, PK = 512, PV = 1024, PHY = 1536, PGA = 3072, PGB = 4096;
constexpr float EPS = 1e-6f;

constexpr size_t MiB = 1u << 20;
constexpr size_t WS_CTL = 0, CTL_ZERO_BYTES = 1 * MiB;
constexpr size_t WS_MOD = 1 * MiB;
constexpr size_t WS_ROUTE = 2 * MiB;
constexpr size_t WS_RWT = 2 * MiB + 512 * 1024;
constexpr size_t WS_TOK = 3 * MiB;
constexpr int CW_CNT = 8192;
constexpr int MAXSLOT = 36864;
constexpr size_t WS_Y = 660 * MiB;
constexpr size_t WS_WIN = 4 * MiB;
constexpr size_t WS_WPAB = 44 * MiB;
constexpr size_t WS_WO = 52 * MiB;
constexpr size_t WS_W13D = 60 * MiB;
constexpr size_t WS_W2D = 82 * MiB;
constexpr size_t WS_W13M = 93 * MiB;
constexpr size_t WS_W2M = 269 * MiB;
constexpr size_t WS_X = 357 * MiB;
constexpr size_t WS_H = 425 * MiB;
constexpr size_t WS_P = 459 * MiB;
constexpr size_t WS_OAH = 629 * MiB;
constexpr size_t WS_B = 663 * MiB;
constexpr size_t WS_OHT = WS_B + 51 * MiB;
constexpr size_t WS_VT = 748 * MiB;
constexpr size_t WS_HRL = 816 * MiB;
constexpr size_t WS_HRC = 850 * MiB;
constexpr size_t WS_END = 853 * MiB;

constexpr int LDS_BYTES = 147456;
constexpr int NWAVES = 8, NTHR = 512;

#define LDS_WAIT() asm volatile("s_waitcnt lgkmcnt(0)" ::: "memory")
#define VM_WAIT() asm volatile("s_waitcnt vmcnt(0)" ::: "memory")
__device__ __forceinline__ float bf2f(unsigned b) { return __uint_as_float(b << 16); }
__device__ __forceinline__ float bflo(unsigned w) { return __uint_as_float(w << 16); }
__device__ __forceinline__ float bfhi(unsigned w) { return __uint_as_float(w & 0xffff0000u); }
__device__ __forceinline__ unsigned cvt_pk_bf16(float lo, float hi) { unsigned r; asm volatile("v_cvt_pk_bf16_f32 %0, %1, %2" : "=v"(r) : "v"(lo), "v"(hi)); return r; }
__device__ __forceinline__ float wave_sum(float v, int lane) {
#pragma unroll
    for (int o = 1; o < 64; o <<= 1) v += __int_as_float(__builtin_amdgcn_ds_bpermute((lane ^ o) << 2, __float_as_int(v)));
    return v;
}
__device__ __forceinline__ float sigmoidf_(float x) { return 1.f / (1.f + __expf(-x)); }
__device__ __forceinline__ float sin_rev(float r) { return __builtin_amdgcn_sinf(__builtin_amdgcn_fractf(r)); }
__device__ __forceinline__ float sin_rad(float x) { return sin_rev(x * 0.15915494309189535f); }

namespace pg8 {
constexpr int BM = 256, BK = 64, HALF = 128, HTB = HALF * BK * 2, STAGE_BYTES = 8 * HTB, NXCD = 8, WGM = 8;
__host__ __device__ __forceinline__ int lds_byte(int r, int c) { const int st = (r >> 4) * 2 + (c >> 5), rr = r & 15, cc = c & 31, ob = rr * 64 + cc * 2; return st * 1024 + (ob ^ (((ob >> 9) & 1) << 5)); }
__host__ __device__ __forceinline__ void stage_rc(int b, int& R, int& C) { const int st = b / 1024, sb = b % 1024, swz = sb ^ (((sb >> 9) & 1) << 5); R = (st >> 1) * 16 + swz / 64; C = (st & 1) * 32 + (swz % 64) / 2; }
__host__ __device__ __forceinline__ int perm32(int rho) { const int n = rho >> 4, i = rho & 15; return 8 * (i >> 2) + 4 * n + (i & 3); }

struct Unit { int pm, pn; const char* a; const char* b; const int* tk; int nvalid; };
struct Gemm { int K, lda, ldb; };

struct StaticOrder {
    int nM, nN, nwg, G, c; const char* A; const char* B; size_t astep, bstep;
    __device__ void init(const void* A_, int lda, const void* B_, int ldb, int M, int N, int G_, int c_) {
        nM = M / BM; nN = N / BM; nwg = nM * nN; G = G_; c = c_; A = (const char*)A_; B = (const char*)B_; astep = (size_t)BM * lda * 2; bstep = (size_t)BM * ldb * 2; }
    __device__ bool next(int i, Unit& u) const {
        const long L = (long)i * G + c; if (L >= nwg) return false;
        int wgid = (int)L; { const int q = nwg / NXCD, r = nwg % NXCD, xcd = wgid % NXCD, off = wgid / NXCD; wgid = (xcd < r ? xcd * (q + 1) : r * (q + 1) + (xcd - r) * q) + off; }
        const int nig = WGM * nN, gid = wgid / nig, fm = gid * WGM, gsz = (nM - fm) < WGM ? (nM - fm) : WGM;
        u.pm = fm + ((wgid % nig) % gsz); u.pn = (wgid % nig) / gsz; u.a = A + (size_t)u.pm * astep; u.b = B + (size_t)u.pn * bstep; return true;
    }
    static constexpr bool GATHER = false;
    __device__ __forceinline__ int arow(const Unit&, int) const { return 0; }
    __device__ __forceinline__ void a_ready(const Unit&) const {}
    __device__ __forceinline__ void done(const Unit&) const {}
};

template <class Epi, class Sched, bool ALIGN_EPI = true>
__device__ __forceinline__ void gemm_phase(LAS unsigned char* lds, const Gemm g, const Sched& S, const Epi& E) {
    int tid = threadIdx.x; asm volatile("" : "+v"(tid));
    const int wid = __builtin_amdgcn_readfirstlane(tid >> 6), lane = tid & 63, wr = wid >> 2, wc = wid & 3, fr = lane & 15, fq = lane >> 4;
    const int K = g.K, nt = K / BK;
    constexpr bool GATHER = Sched::GATHER;
    unsigned voffB[2]; unsigned cA0[2], cA1[2], nA0[2], nA1[2]; int RA[2], CA[2];
    const size_t hstepA = (size_t)HALF * g.lda * 2, hstepB = (size_t)HALF * g.ldb * 2;
#pragma unroll
    for (int i = 0; i < 2; ++i) { int R, C; stage_rc(tid * 16 + i * 8192, R, C); const int Rb = Epi::PERM ? ((R & ~31) + perm32(R & 31)) : R;
        RA[i] = R; CA[i] = C; voffB[i] = (unsigned)(Rb * g.ldb + C) * 2u;
        cA0[i] = (unsigned)(R * g.lda + C) * 2u; cA1[i] = cA0[i]; nA0[i] = cA0[i]; nA1[i] = cA0[i]; }
    const size_t h1A = GATHER ? 0 : hstepA;
    const size_t kstep = (size_t)(BK * 2);
    const unsigned ldsw = (unsigned)wid * 1024u;
    const int aoff = lds_byte(wr * 64 + fr, fq * 8), boff = lds_byte(wc * 32 + fr, fq * 8);
#define PG8_SA(b, h) (((b) * 2 + (h)) * HTB)
#define PG8_SB(b, h) ((4 + (b) * 2 + (h)) * HTB)
#define PG8_STAGE(bufoff, gbase, voff) do { _Pragma("unroll") for (int _i = 0; _i < 2; ++_i) \
        __builtin_amdgcn_global_load_lds((const unsigned*)((const char*)(gbase) + (voff)[_i]), (LAS unsigned*)(lds + (bufoff) + ldsw + _i * 8192), 16, 0, 0); } while (0)
#define PG8_LDA(dst, b, h) do { _Pragma("unroll") for (int m = 0; m < 4; ++m) _Pragma("unroll") for (int k = 0; k < 2; ++k) dst[m][k] = *(const LAS bf16x8*)(lds + PG8_SA(b, h) + aoff + m * 2048 + k * 1024); } while (0)
#define PG8_LDB(dst, b, h) do { _Pragma("unroll") for (int n = 0; n < 2; ++n) _Pragma("unroll") for (int k = 0; k < 2; ++k) dst[n][k] = *(const LAS bf16x8*)(lds + PG8_SB(b, h) + boff + n * 2048 + k * 1024); } while (0)
#define PG8_MMA(ai, bj, At, Bt) do { __builtin_amdgcn_s_setprio(1); _Pragma("unroll") for (int m = 0; m < 4; ++m) _Pragma("unroll") for (int n = 0; n < 2; ++n) _Pragma("unroll") for (int k = 0; k < 2; ++k) \
        acc[ai][bj][m][n] = __builtin_amdgcn_mfma_f32_16x16x32_bf16(Bt[n][k], At[m][k], acc[ai][bj][m][n], 0, 0, 0); __builtin_amdgcn_s_setprio(0); } while (0)
#define PG8_WAIT_V(n) asm volatile("s_waitcnt vmcnt(" #n ")" ::: "memory")
#define PG8_WAIT_L(n) asm volatile("s_waitcnt lgkmcnt(" #n ")" ::: "memory")
#define PG8_BAR __builtin_amdgcn_s_barrier()
#define PG8_SCHED __builtin_amdgcn_sched_barrier(0)
    Unit cur, nxt; int ui = 0;
    if (!S.next(0, cur)) return;
    if constexpr (GATHER) {
#pragma unroll
        for (int i = 0; i < 2; ++i) { cA0[i] = (unsigned)(S.arow(cur, RA[i]) * g.lda + CA[i]) * 2u; cA1[i] = (unsigned)(S.arow(cur, HALF + RA[i]) * g.lda + CA[i]) * 2u; }
    }
    f32x4 acc[2][2][4][2];
#pragma unroll
    for (int a = 0; a < 2; ++a)
#pragma unroll
        for (int b = 0; b < 2; ++b)
#pragma unroll
            for (int m = 0; m < 4; ++m)
#pragma unroll
                for (int n = 0; n < 2; ++n) acc[a][b][m][n] = (f32x4){0.f, 0.f, 0.f, 0.f};
    bf16x8 At[4][2], B0[2][2], B1[2][2];
    const char* cA = cur.a; const char* cB = cur.b;
    S.a_ready(cur);
    PG8_STAGE(PG8_SB(0, 0), cB, voffB); PG8_STAGE(PG8_SB(0, 1), cB + hstepB, voffB); PG8_STAGE(PG8_SA(0, 0), cA, cA0); PG8_STAGE(PG8_SA(0, 1), cA + h1A, cA1);
    if (wr == 1) PG8_BAR;
    PG8_WAIT_V(2); PG8_BAR;
    PG8_STAGE(PG8_SB(1, 0), cB + kstep, voffB); PG8_STAGE(PG8_SA(1, 0), cA + kstep, cA0); PG8_STAGE(PG8_SB(1, 1), cB + hstepB + kstep, voffB);
    PG8_WAIT_V(6); PG8_BAR;
    for (;;) {
        const bool has_next = S.next(ui + 1, nxt);
        const char* nA = has_next ? nxt.a : cA; const char* nB = has_next ? nxt.b : cB;
        if constexpr (GATHER) {
#pragma unroll
            for (int i = 0; i < 2; ++i) { nA0[i] = has_next ? (unsigned)(S.arow(nxt, RA[i]) * g.lda + CA[i]) * 2u : cA0[i]; nA1[i] = has_next ? (unsigned)(S.arow(nxt, HALF + RA[i]) * g.lda + CA[i]) * 2u : cA1[i]; }
        }
        for (int kh = 0; kh < (Epi::MIDK ? 2 : 1); ++kh) {
        const int tb = Epi::MIDK ? kh * (nt / 2) : 0, te = Epi::MIDK ? tb + nt / 2 : nt;
        for (int t = tb; t < te; t += 2) {
            const bool last = (t == nt - 2);
            const char* a1 = cA + (size_t)(t + 1) * kstep;
            const char* a2 = last ? nA : cA + (size_t)(t + 2) * kstep; const char* b2 = last ? nB : cB + (size_t)(t + 2) * kstep;
            const char* a3 = a2 + kstep; const char* b3 = b2 + kstep;
            unsigned x0[2], x1[2];
#pragma unroll
            for (int i = 0; i < 2; ++i) { x0[i] = (GATHER && last) ? nA0[i] : cA0[i]; x1[i] = GATHER ? (last ? nA1[i] : cA1[i]) : cA0[i]; }
            if (last && has_next) S.a_ready(nxt);
            PG8_LDB(B0, 0, 0); PG8_LDB(B1, 0, 1); PG8_SCHED; PG8_LDA(At, 0, 0); PG8_STAGE(PG8_SA(1, 1), a1 + h1A, cA1);
            PG8_WAIT_V(8); PG8_WAIT_L(0); PG8_BAR; PG8_MMA(0, 0, At, B0); PG8_MMA(0, 1, At, B1); PG8_BAR; PG8_SCHED;
            PG8_LDA(At, 0, 1); PG8_STAGE(PG8_SB(0, 0), b2, voffB); PG8_STAGE(PG8_SB(0, 1), b2 + hstepB, voffB); PG8_STAGE(PG8_SA(0, 0), a2, x0);
            PG8_WAIT_V(8); PG8_WAIT_L(0); PG8_BAR; PG8_MMA(1, 0, At, B0); PG8_MMA(1, 1, At, B1); PG8_BAR; PG8_SCHED;
            PG8_LDB(B0, 1, 0); PG8_LDB(B1, 1, 1); PG8_SCHED; PG8_LDA(At, 1, 0); PG8_STAGE(PG8_SA(0, 1), a2 + h1A, x1);
            PG8_WAIT_V(8); PG8_WAIT_L(0); PG8_BAR; PG8_MMA(0, 0, At, B0); PG8_MMA(0, 1, At, B1); PG8_BAR; PG8_SCHED;
            PG8_LDA(At, 1, 1); PG8_STAGE(PG8_SB(1, 0), b3, voffB); PG8_STAGE(PG8_SB(1, 1), b3 + hstepB, voffB); PG8_STAGE(PG8_SA(1, 0), a3, x0);
            PG8_WAIT_V(8); PG8_WAIT_L(0); PG8_BAR; PG8_MMA(1, 0, At, B0); PG8_MMA(1, 1, At, B1); PG8_BAR; PG8_SCHED;
        }
        if constexpr (Epi::MIDK) { if (kh == 0) E.mid(acc, cur, wr, wc, fr, fq); }
        }
        if constexpr (ALIGN_EPI) { if (wr == 0) PG8_BAR; }
        E(acc, cur, wr, wc, fr, fq); S.done(cur);
        if (!has_next) break;
#pragma unroll
        for (int a = 0; a < 2; ++a)
#pragma unroll
            for (int b = 0; b < 2; ++b)
#pragma unroll
                for (int m = 0; m < 4; ++m)
#pragma unroll
                    for (int n = 0; n < 2; ++n) acc[a][b][m][n] = (f32x4){0.f, 0.f, 0.f, 0.f};
        cur = nxt; cA = nA; cB = nB; ++ui;
        if constexpr (GATHER) {
#pragma unroll
            for (int i = 0; i < 2; ++i) { cA0[i] = nA0[i]; cA1[i] = nA1[i]; }
        }
        if constexpr (ALIGN_EPI) { if (wr == 1) PG8_BAR; }
    }
    PG8_WAIT_V(0);
    if constexpr (!ALIGN_EPI) { if (wr == 0) PG8_BAR; }
    PG8_BAR;
#undef PG8_SA
#undef PG8_SB
#undef PG8_STAGE
#undef PG8_LDA
#undef PG8_LDB
#undef PG8_MMA
#undef PG8_WAIT_V
#undef PG8_WAIT_L
#undef PG8_BAR
#undef PG8_SCHED
}
}

typedef f32x4 AccT[2][2][4][2];
struct EpiStoreBf16 {
    static constexpr bool PERM = true, MIDK = false;
    bf16_t* O; int ldc;
    __device__ __forceinline__ void operator()(const AccT& acc, const pg8::Unit& u, int wr, int wc, int fr, int fq) const {
        const int row0 = u.pm * 256 + wr * 64 + fr, col0 = u.pn * 256 + wc * 32 + 8 * fq;
#pragma unroll
        for (int ai = 0; ai < 2; ++ai)
#pragma unroll
            for (int m = 0; m < 4; ++m) { bf16_t* rowp = O + (size_t)(row0 + ai * 128 + m * 16) * ldc + col0;
#pragma unroll
                for (int bj = 0; bj < 2; ++bj) { const f32x4 v0 = acc[ai][bj][m][0], v1 = acc[ai][bj][m][1];
                    u32x4 w; w.x = cvt_pk_bf16(v0[0], v0[1]); w.y = cvt_pk_bf16(v0[2], v0[3]); w.z = cvt_pk_bf16(v1[0], v1[1]); w.w = cvt_pk_bf16(v1[2], v1[3]);
                    *(u32x4*)(rowp + bj * 128) = w; } }
    }
};
__device__ __forceinline__ float merge_ratio(float ga, float gb) { return (1.f + __expf(-fmaxf(gb, -80.f))) / (1.f + __expf(-ga)); }
__device__ __forceinline__ float merge_final(float gb) { return 1.f / (1.f + __expf(-fmaxf(gb, -80.f))); }
struct EpiMergeK {
    static constexpr bool PERM = true, MIDK = true;
    const bf16_t* P; bf16_t* O;
    __device__ __forceinline__ void mid(AccT& acc, const pg8::Unit& u, int wr, int wc, int fr, int fq) const {
        asm volatile("" : "+v"(fr), "+v"(fq));
        const int row0 = u.pm * 256 + wr * 64 + fr, col0 = u.pn * 256 + wc * 32 + 8 * fq;
#pragma unroll
        for (int ai = 0; ai < 2; ++ai)
#pragma unroll
            for (int m = 0; m < 4; ++m) { const int r = row0 + ai * 128 + m * 16;
#pragma unroll
                for (int bj = 0; bj < 2; ++bj) { const int c = col0 + bj * 128;
                    const u32x4 a = *(const u32x4*)(P + (size_t)r * PW + PGA + c), b = *(const u32x4*)(P + (size_t)r * PW + PGB + c);
                    acc[ai][bj][m][0][0] *= merge_ratio(bflo(a.x), bflo(b.x)); acc[ai][bj][m][0][1] *= merge_ratio(bfhi(a.x), bfhi(b.x));
                    acc[ai][bj][m][0][2] *= merge_ratio(bflo(a.y), bflo(b.y)); acc[ai][bj][m][0][3] *= merge_ratio(bfhi(a.y), bfhi(b.y));
                    acc[ai][bj][m][1][0] *= merge_ratio(bflo(a.z), bflo(b.z)); acc[ai][bj][m][1][1] *= merge_ratio(bfhi(a.z), bfhi(b.z));
                    acc[ai][bj][m][1][2] *= merge_ratio(bflo(a.w), bflo(b.w)); acc[ai][bj][m][1][3] *= merge_ratio(bfhi(a.w), bfhi(b.w)); } }
    }
    __device__ __forceinline__ void operator()(const AccT& acc, const pg8::Unit& u, int wr, int wc, int fr, int fq) const {
        asm volatile("" : "+v"(fr), "+v"(fq));
        const int row0 = u.pm * 256 + wr * 64 + fr, col0 = u.pn * 256 + wc * 32 + 8 * fq;
#pragma unroll
        for (int ai = 0; ai < 2; ++ai)
#pragma unroll
            for (int m = 0; m < 4; ++m) { const int r = row0 + ai * 128 + m * 16;
#pragma unroll
                for (int bj = 0; bj < 2; ++bj) { const int c = col0 + bj * 128;
                    const u32x4 b = *(const u32x4*)(P + (size_t)r * PW + PGB + c);
                    const f32x4 v0 = acc[ai][bj][m][0], v1 = acc[ai][bj][m][1];
                    u32x4 w; w.x = cvt_pk_bf16(v0[0] * merge_final(bflo(b.x)), v0[1] * merge_final(bfhi(b.x))); w.y = cvt_pk_bf16(v0[2] * merge_final(bflo(b.y)), v0[3] * merge_final(bfhi(b.y)));
                    w.z = cvt_pk_bf16(v1[0] * merge_final(bflo(b.z)), v1[1] * merge_final(bfhi(b.z))); w.w = cvt_pk_bf16(v1[2] * merge_final(bflo(b.w)), v1[3] * merge_final(bfhi(b.w)));
                    *(u32x4*)(O + (size_t)r * D + c) = w; } }
    }
};
struct EpiResid {
    static constexpr bool PERM = false, MIDK = false;
    float* x; const float* gate;
    __device__ __forceinline__ void operator()(const AccT& acc, const pg8::Unit& u, int wr, int wc, int fr, int fq) const {
        const int row0 = u.pm * 256 + wr * 64 + fr, col0 = u.pn * 256 + wc * 32 + 4 * fq;
        const int b = (u.pm < 64) ? (u.pm >> 4) : 4;
        const float* gp = gate + (size_t)b * 6144 + col0;
        f32x4 gv[2][2];
#pragma unroll
        for (int bj = 0; bj < 2; ++bj)
#pragma unroll
            for (int n = 0; n < 2; ++n) gv[bj][n] = *(const f32x4*)(gp + bj * 128 + n * 16);
#pragma unroll
        for (int ai = 0; ai < 2; ++ai)
#pragma unroll
            for (int m = 0; m < 4; ++m) { const int r = row0 + ai * 128 + m * 16; float* rowp = x + (size_t)r * D + col0;
#pragma unroll
                for (int bj = 0; bj < 2; ++bj)
#pragma unroll
                    for (int n = 0; n < 2; ++n) { float* p = rowp + bj * 128 + n * 16; *(f32x4*)p = *(const f32x4*)p + gv[bj][n] * acc[ai][bj][m][n]; } }
    }
};
struct EpiSwiglu {
    static constexpr bool PERM = true, MIDK = false;
    bf16_t* O;
    __device__ __forceinline__ void operator()(const AccT& acc, const pg8::Unit& u, int wr, int wc, int fr, int fq) const {
        const int row0 = u.pm * 256 + wr * 64 + fr, col0 = u.pn * 128 + wc * 32 + 8 * fq;
#pragma unroll
        for (int ai = 0; ai < 2; ++ai)
#pragma unroll
            for (int m = 0; m < 4; ++m) { const int r = row0 + ai * 128 + m * 16;
                float o[8];
#pragma unroll
                for (int n = 0; n < 2; ++n)
#pragma unroll
                    for (int j = 0; j < 4; ++j) { const float a = acc[ai][0][m][n][j], g = acc[ai][1][m][n][j]; o[n * 4 + j] = a * sigmoidf_(a) * g; }
                u32x4 w; w.x = cvt_pk_bf16(o[0], o[1]); w.y = cvt_pk_bf16(o[2], o[3]); w.z = cvt_pk_bf16(o[4], o[5]); w.w = cvt_pk_bf16(o[6], o[7]);
                *(u32x4*)(O + (size_t)r * FF + col0) = w; }
    }
};

struct CEpiMergeK { const bf16_t* P; bf16_t* O; static constexpr bool MIDK = true;
    __device__ __forceinline__ void mid(f32x4& acc, int r, int c) const { const u32x2 a = *(const u32x2*)(P + (size_t)r * PW + PGA + c), b = *(const u32x2*)(P + (size_t)r * PW + PGB + c);
        acc[0] *= merge_ratio(bflo(a.x), bflo(b.x)); acc[1] *= merge_ratio(bfhi(a.x), bfhi(b.x)); acc[2] *= merge_ratio(bflo(a.y), bflo(b.y)); acc[3] *= merge_ratio(bfhi(a.y), bfhi(b.y)); }
    __device__ __forceinline__ void operator()(const f32x4& acc, int r, int c) const { const u32x2 b = *(const u32x2*)(P + (size_t)r * PW + PGB + c);
        u32x2 w; w.x = cvt_pk_bf16(acc[0] * merge_final(bflo(b.x)), acc[1] * merge_final(bfhi(b.x))); w.y = cvt_pk_bf16(acc[2] * merge_final(bflo(b.y)), acc[3] * merge_final(bfhi(b.y)));
        *(u32x2*)(O + (size_t)r * D + c) = w; } };
struct CEpiResid { float* x; const float* gate; static constexpr bool MIDK = false;
    __device__ __forceinline__ void mid(f32x4&, int, int) const {}
    __device__ __forceinline__ void operator()(const f32x4& acc, int r, int c) const { float* p = x + (size_t)r * D + c; *(f32x4*)p = *(const f32x4*)p + *(const f32x4*)(gate + c) * acc; } };
template <class Epi>
__device__ __forceinline__ void ctx_gemm(const bf16_t* X, int ldx, const bf16_t* Wt, int ldw, int K, const Epi& E) {
    int tid = threadIdx.x; asm volatile("" : "+v"(tid));
    const int wave = tid >> 6, lane = tid & 63, li = lane & 15, kg = lane >> 4;
    for (int tile = blockIdx.x; tile < 256; tile += gridDim.x) {
        const int row0 = TL + (tile >> 2) * 16, col0 = (tile & 3) * 256 + wave * 32;
        const bf16_t* xp = X + (size_t)(row0 + li) * ldx + 8 * kg;
        const bf16_t* w0 = Wt + (size_t)(col0 + li) * ldw + 8 * kg; const bf16_t* w1 = w0 + (size_t)16 * ldw;
        f32x4 acc0 = (f32x4){0.f, 0.f, 0.f, 0.f}, acc1 = acc0;
        const int Kh = Epi::MIDK ? K / 2 : K;
#pragma unroll 8
        for (int k0 = 0; k0 < Kh; k0 += 32) {
            const bf16x8 xf = *(const bf16x8*)(xp + k0), b0 = *(const bf16x8*)(w0 + k0), b1 = *(const bf16x8*)(w1 + k0);
            acc0 = __builtin_amdgcn_mfma_f32_16x16x32_bf16(b0, xf, acc0, 0, 0, 0);
            acc1 = __builtin_amdgcn_mfma_f32_16x16x32_bf16(b1, xf, acc1, 0, 0, 0);
        }
        if constexpr (Epi::MIDK) {
            E.mid(acc0, row0 + li, col0 + 4 * kg); E.mid(acc1, row0 + li, col0 + 16 + 4 * kg);
#pragma unroll 8
            for (int k0 = Kh; k0 < K; k0 += 32) {
                const bf16x8 xf = *(const bf16x8*)(xp + k0), b0 = *(const bf16x8*)(w0 + k0), b1 = *(const bf16x8*)(w1 + k0);
                acc0 = __builtin_amdgcn_mfma_f32_16x16x32_bf16(b0, xf, acc0, 0, 0, 0);
                acc1 = __builtin_amdgcn_mfma_f32_16x16x32_bf16(b1, xf, acc1, 0, 0, 0);
            }
        }
        E(acc0, row0 + li, col0 + 4 * kg); E(acc1, row0 + li, col0 + 16 + 4 * kg);
    }
}

struct Args { const float* in[30]; float* out; unsigned char* ws; int l, e, ph, pad; };
enum { I_X = 0, I_C, I_CTX, I_CCTX, I_WMOD, I_BMOD, I_N1G, I_N2G, I_WIN, I_RPB, I_HCW, I_HCB, I_HW1, I_HB1, I_HW2, I_HB2, I_HW3, I_HFREQ, I_HBIAS,
       I_WPA, I_WPB, I_WO, I_FW1, I_FW3, I_FW2, I_ROUTER, I_MW1, I_MW3, I_MW2, I_FINALG };

constexpr int MISC_OFF = 131072 + 320;
constexpr int PTR_OFF = MISC_OFF + 128;
struct Ctx {
    LAS unsigned char* lds; int tid, lane, wave, G, bid; unsigned char* ws;
};
__device__ __forceinline__ Ctx mk_ctx(LAS unsigned char* lds, unsigned char* ws) {
    Ctx c; int t = threadIdx.x; asm volatile("" : "+v"(t)); asm volatile("" : "+s"(ws)); c.lds = lds; c.tid = t; c.lane = t & 63; c.wave = __builtin_amdgcn_readfirstlane(t >> 6); c.G = gridDim.x; c.bid = blockIdx.x; c.ws = ws; return c;
}
__device__ __forceinline__ const float* inp(const Ctx& c, int i) {
    unsigned ao = (unsigned)(PTR_OFF + 8 * i); asm volatile("" : "+v"(ao));
    const volatile LAS unsigned* p = (const volatile LAS unsigned*)(c.lds + ao);
    const unsigned lo = __builtin_amdgcn_readfirstlane(p[0]), hi = __builtin_amdgcn_readfirstlane(p[1]);
    return (const float*)(((unsigned long long)hi << 32) | (unsigned long long)lo);
}

__device__ __forceinline__ void transpose_item(const float* W, int N, bf16_t* WT, int ldk, int k0, int n0, int drow0, LAS float* scr, int lane) {
    float wv[32];
    const float* wp = W + (size_t)(k0 + (lane >> 5)) * N + n0 + (lane & 31);
#pragma unroll
    for (int i = 0; i < 32; ++i) wv[i] = wp[(size_t)(2 * i) * N];
#pragma unroll
    for (int i = 0; i < 32; ++i) scr[(2 * i + (lane >> 5)) * 33 + (lane & 31)] = wv[i];
    LDS_WAIT(); asm volatile("" ::: "memory");
    const int c = lane & 7;
#pragma unroll
    for (int j = 0; j < 4; ++j) { const int n = (lane >> 3) + 8 * j; const LAS float* s = scr + (8 * c) * 33 + n;
        u32x4 o; o.x = cvt_pk_bf16(s[0 * 33], s[1 * 33]); o.y = cvt_pk_bf16(s[2 * 33], s[3 * 33]); o.z = cvt_pk_bf16(s[4 * 33], s[5 * 33]); o.w = cvt_pk_bf16(s[6 * 33], s[7 * 33]);
        *(u32x4*)(WT + (size_t)(drow0 + n) * ldk + k0 + 8 * c) = o; }
    LDS_WAIT(); asm volatile("" ::: "memory");
}
__device__ __forceinline__ void conv_mat(const float* W, int K, int N, bf16_t* WT, int mode, int& base, int gw, int NGW, LAS float* scr, int lane, int ldk = 0) {
    if (ldk == 0) ldk = K;
    const int nblk = N / 32, nitems = (K / 64) * nblk;
    const int start = (gw - (base % NGW) + NGW) % NGW;
    for (int it = start; it < nitems; it += NGW) {
        const int kb = it / nblk, nb = it % nblk, n0 = nb * 32;
        const int drow0 = mode == 0 ? n0 : ((n0 >> 7) * 256 + (n0 & 127) + (mode == 2 ? 128 : 0));
        transpose_item(W, N, WT, ldk, kb * 64, n0, drow0, scr, lane);
    }
    base += nitems;
}
__device__ __forceinline__ void ph_convert(const Ctx& c0) {
    const Ctx c = mk_ctx(c0.lds, c0.ws);
    unsigned char* ws = c.ws;
    LAS float* scr = (LAS float*)(c.lds + c.wave * 16384);
    const int gw = c.bid * NWAVES + c.wave, NGW = c.G * NWAVES; int base = 0;
    for (int l = 0; l < DEPTH; ++l) {
        conv_mat(inp(c, I_WIN) + (size_t)l * D * PW, D, PW, (bf16_t*)(ws + WS_WIN) + (size_t)l * PW * D, 0, base, gw, NGW, scr, c.lane);
        conv_mat(inp(c, I_WPA) + (size_t)l * 512 * D, 512, D, (bf16_t*)(ws + WS_WPAB) + (size_t)l * D * D, 0, base, gw, NGW, scr, c.lane, D);
        conv_mat(inp(c, I_WPB) + (size_t)l * 512 * D, 512, D, (bf16_t*)(ws + WS_WPAB) + (size_t)l * D * D + 512, 0, base, gw, NGW, scr, c.lane, D);
        conv_mat(inp(c, I_WO) + (size_t)l * D * D, D, D, (bf16_t*)(ws + WS_WO) + (size_t)l * D * D, 0, base, gw, NGW, scr, c.lane);
    }
    for (int i = 0; i < 2; ++i) {
        conv_mat(inp(c, I_FW1) + (size_t)i * D * FF, D, FF, (bf16_t*)(ws + WS_W13D) + (size_t)i * 2 * FF * D, 1, base, gw, NGW, scr, c.lane);
        conv_mat(inp(c, I_FW3) + (size_t)i * D * FF, D, FF, (bf16_t*)(ws + WS_W13D) + (size_t)i * 2 * FF * D, 2, base, gw, NGW, scr, c.lane);
        conv_mat(inp(c, I_FW2) + (size_t)i * FF * D, FF, D, (bf16_t*)(ws + WS_W2D) + (size_t)i * D * FF, 0, base, gw, NGW, scr, c.lane);
    }
    for (int ie = 0; ie < 2 * NE; ++ie) {
        conv_mat(inp(c, I_MW1) + (size_t)ie * D * FF, D, FF, (bf16_t*)(ws + WS_W13M) + (size_t)ie * 2 * FF * D, 1, base, gw, NGW, scr, c.lane);
        conv_mat(inp(c, I_MW3) + (size_t)ie * D * FF, D, FF, (bf16_t*)(ws + WS_W13M) + (size_t)ie * 2 * FF * D, 2, base, gw, NGW, scr, c.lane);
        conv_mat(inp(c, I_MW2) + (size_t)ie * FF * D, FF, D, (bf16_t*)(ws + WS_W2M) + (size_t)ie * D * FF, 0, base, gw, NGW, scr, c.lane);
    }
}

__device__ __forceinline__ void ph_mod(const Ctx& c0) {
    const Ctx c = mk_ctx(c0.lds, c0.ws);
    float* mod = (float*)(c.ws + WS_MOD);
    LAS float* s = (LAS float*)c.lds; LAS float* part = s + 5 * 1024;
    const float* cin = inp(c, I_C); const float* cctx = inp(c, I_CCTX); const float* wmod = inp(c, I_WMOD); const float* bmod = inp(c, I_BMOD);
    for (int i = c.tid; i < 5 * 1024; i += NTHR) { const int r = i >> 10, k = i & 1023; const float v = r < 4 ? cin[r * 1024 + k] : cctx[k]; s[i] = v * sigmoidf_(v); }
    __syncthreads();
    for (int unit = c.bid; unit < DEPTH * 96; unit += c.G) {
        const int l = unit / 96, j0 = (unit % 96) * 64;
        const float* w = wmod + (size_t)l * D * 6144 + j0 + c.lane;
        float acc[5] = {0.f, 0.f, 0.f, 0.f, 0.f};
        const int kb = c.wave * 128;
#pragma unroll 32
        for (int k = 0; k < 128; ++k) { const float wv = w[(size_t)(kb + k) * 6144];
#pragma unroll
            for (int r = 0; r < 5; ++r) acc[r] += s[r * 1024 + kb + k] * wv; }
#pragma unroll
        for (int r = 0; r < 5; ++r) part[(c.wave * 5 + r) * 64 + c.lane] = acc[r];
        __syncthreads();
        if (c.tid < 320) { const int r = c.tid >> 6, ln = c.tid & 63; float sum = 0.f;
#pragma unroll
            for (int w8 = 0; w8 < 8; ++w8) sum += part[(w8 * 5 + r) * 64 + ln];
            mod[(size_t)(l * 5 + r) * 6144 + j0 + ln] = sum + bmod[l * 6144 + j0 + ln]; }
        __syncthreads();
    }
}

__device__ __forceinline__ void ph_filt(const Ctx& c0) {
    const Ctx c = mk_ctx(c0.lds, c0.ws);
    const float* hb1 = inp(c, I_HB1); const float* hw1 = inp(c, I_HW1); const float* hb2 = inp(c, I_HB2); const float* hw2 = inp(c, I_HW2); const float* hfreq = inp(c, I_HFREQ); const float* hw3 = inp(c, I_HW3);
    LAS float* zb = (LAS float*)c.lds;
    LAS float* a1 = zb + 16 * 36;
    LAS float* a2 = a1 + 16 * 64;
    const float MINDEC = -3.0701134573253945f, MAXDEC = -15.350567286626973f;
    for (int unit = c.bid; unit < DEPTH * 272; unit += c.G) {
        const int l = unit / 272, uu = unit % 272;
        const int L = uu < 256 ? 4096 : 256, p0 = uu < 256 ? uu * 16 : (uu - 256) * 16;
        for (int i = c.tid; i < 16 * 33; i += NTHR) { const int p = i / 33, q = i % 33; const int pos = p0 + p; float v;
            if (q == 0) v = (float)pos / (float)(L - 1);
            else { const int j = (q - 1) & 15; const double band = 1e-4 + (double)j * ((15.0 - 1e-4) / 15.0); double rev = (double)pos * band / (double)L; rev -= floor(rev);
                v = q <= 16 ? __builtin_amdgcn_cosf((float)rev) : -__builtin_amdgcn_sinf((float)rev); }
            zb[p * 36 + q] = v; }
        __syncthreads();
        for (int i = c.tid; i < 16 * 64; i += NTHR) { const int p = i >> 6, j = i & 63; float s = hb1[l * 64 + j];
            const float* w = hw1 + (size_t)l * 33 * 64 + j;
            for (int q = 0; q < 33; ++q) s += zb[p * 36 + q] * w[q * 64];
            a1[p * 64 + j] = sin_rad(hfreq[l * 128 + j] * s); }
        __syncthreads();
        for (int i = c.tid; i < 16 * 64; i += NTHR) { const int p = i >> 6, j = i & 63; float s = hb2[l * 64 + j];
            const float* w = hw2 + (size_t)l * 64 * 64 + j;
            for (int q = 0; q < 64; ++q) s += a1[p * 64 + q] * w[q * 64];
            a2[p * 64 + j] = sin_rad(hfreq[l * 128 + 64 + j] * s); }
        __syncthreads();
        {
            float acc0[16], acc1[16];
#pragma unroll
            for (int p = 0; p < 16; ++p) { acc0[p] = 0.f; acc1[p] = 0.f; }
            const float* w3 = hw3 + (size_t)l * 64 * 1024 + c.tid;
            for (int k = 0; k < 64; ++k) { const float wa = w3[k * 1024], wb = w3[k * 1024 + 512];
#pragma unroll
                for (int p = 0; p < 16; ++p) { const float av = a2[p * 64 + k]; acc0[p] += av * wa; acc1[p] += av * wb; } }
            bf16_t* hro = uu < 256 ? (bf16_t*)(c.ws + WS_HRL) + ((size_t)(l * 2) * 512 + c.tid) * (4096 + 64) : (bf16_t*)(c.ws + WS_HRC) + ((size_t)(l * 2) * 512 + c.tid) * (256 + 64);
            const size_t ostride = (size_t)512 * (L + 64);
            float f0[16], f1[16];
            const float r0 = fabsf(MINDEC + (float)c.tid * ((MAXDEC - MINDEC) / 1023.f)), r1 = fabsf(MINDEC + (float)(c.tid + 512) * ((MAXDEC - MINDEC) / 1023.f));
#pragma unroll
            for (int p = 0; p < 16; ++p) { const int pos = p0 + p; const float dist = fabsf((float)(pos - L / 2)) * (2.f / (float)L);
                f0[p] = acc0[p] * (__expf(-dist * r0) + 0.05f); f1[p] = acc1[p] * (__expf(-dist * r1) + 0.05f); }
            {   u32x4 w0, w1, v0, v1;
                w0.x = cvt_pk_bf16(f0[15], f0[14]); w0.y = cvt_pk_bf16(f0[13], f0[12]); w0.z = cvt_pk_bf16(f0[11], f0[10]); w0.w = cvt_pk_bf16(f0[9], f0[8]);
                w1.x = cvt_pk_bf16(f0[7], f0[6]); w1.y = cvt_pk_bf16(f0[5], f0[4]); w1.z = cvt_pk_bf16(f0[3], f0[2]); w1.w = cvt_pk_bf16(f0[1], f0[0]);
                v0.x = cvt_pk_bf16(f1[15], f1[14]); v0.y = cvt_pk_bf16(f1[13], f1[12]); v0.z = cvt_pk_bf16(f1[11], f1[10]); v0.w = cvt_pk_bf16(f1[9], f1[8]);
                v1.x = cvt_pk_bf16(f1[7], f1[6]); v1.y = cvt_pk_bf16(f1[5], f1[4]); v1.z = cvt_pk_bf16(f1[3], f1[2]); v1.w = cvt_pk_bf16(f1[1], f1[0]);
                bf16_t* d0 = hro + (L + 16 - p0); bf16_t* d1 = d0 + ostride;
                *(u32x4*)d0 = w0; *(u32x4*)(d0 + 8) = w1; *(u32x4*)d1 = v0; *(u32x4*)(d1 + 8) = v1;
                const u32x4 z4 = (u32x4){0u, 0u, 0u, 0u};
                if (p0 == 0) { for (int k = 0; k < 4; ++k) { *(u32x4*)(hro + L + 32 + 8 * k) = z4; *(u32x4*)(hro + ostride + L + 32 + 8 * k) = z4; } }
                if (p0 == L - 16) { for (int k = 0; k < 4; ++k) { *(u32x4*)(hro + 8 * k) = z4; *(u32x4*)(hro + ostride + 8 * k) = z4; } } }
        }
        __syncthreads();
    }
}

struct MoeComb { const int* route; const float* rwt; const bf16_t* y; const float* gate; };
__device__ __forceinline__ void moe_combine_row(const MoeComb& mc, const LAS unsigned* offs, int row, int b, int lane, f32x4 (&v)[4]) {
    const int e1 = mc.route[(size_t)row * 4 + 0], p1 = mc.route[(size_t)row * 4 + 1], e2 = mc.route[(size_t)row * 4 + 2], p2 = mc.route[(size_t)row * 4 + 3];
    const float w1 = mc.rwt[(size_t)row * 2], w2 = mc.rwt[(size_t)row * 2 + 1];
    const size_t s1 = (size_t)offs[e1] + p1, s2 = (size_t)offs[e2] + p2;
    const float* gt = mc.gate + (size_t)b * 6144;
#pragma unroll
    for (int j = 0; j < 4; ++j) { const int k0 = 4 * (lane + 64 * j);
        const u32x2 a = *(const u32x2*)(mc.y + s1 * D + k0), bq = *(const u32x2*)(mc.y + s2 * D + k0); const f32x4 g4 = *(const f32x4*)(gt + k0);
        v[j][0] += g4[0] * (w1 * bflo(a.x) + w2 * bflo(bq.x)); v[j][1] += g4[1] * (w1 * bfhi(a.x) + w2 * bfhi(bq.x));
        v[j][2] += g4[2] * (w1 * bflo(a.y) + w2 * bflo(bq.y)); v[j][3] += g4[3] * (w1 * bfhi(a.y) + w2 * bfhi(bq.y)); }
}
__device__ __forceinline__ void moe_offsets(const Ctx& c, int i, LAS unsigned* offs) {
    if (c.tid == 0) { const unsigned* cnt = (const unsigned*)(c.ws + WS_CTL) + CW_CNT + 64 * i; unsigned o = 0;
        for (int e = 0; e < 8; ++e) { offs[e] = o; o += (cnt[e] + 255u) & ~255u; } offs[8] = o; }
}
__device__ __forceinline__ void ph_norm(const Ctx& c0, int l, int which) {
    const Ctx c = mk_ctx(c0.lds, c0.ws);
    float* xres = (float*)(c.ws + WS_X); bf16_t* h = (bf16_t*)(c.ws + WS_H);
    const float* mod = (const float*)(c.ws + WS_MOD) + (size_t)l * 5 * 6144;
    const float* gp = (which == 0 ? inp(c, I_N1G) : inp(c, I_N2G)) + l * D;
    const bool first = (l == 0 && which == 0), route = (which == 1 && (l & 1));
    const int comb = (which == 0 && l >= 1 && ((l - 1) & 1)) ? ((l - 1) >> 1) : -1;
    const float* router = inp(c, I_ROUTER) + (size_t)(l >> 1) * D * NE;
    int* routeb = (int*)(c.ws + WS_ROUTE); float* rwt = (float*)(c.ws + WS_RWT); int* tokenof = (int*)(c.ws + WS_TOK);
    const MoeComb mc{routeb, rwt, (const bf16_t*)(c.ws + WS_Y), (const float*)(c.ws + WS_MOD) + (size_t)(l > 0 ? l - 1 : 0) * 5 * 6144 + 5 * 1024};
    LAS unsigned* lcnt = (LAS unsigned*)c.lds; LAS unsigned* gbase = lcnt + 16; LAS unsigned* offs = lcnt + 32; LAS int* pend = (LAS int*)(c.lds + 256);
    if (c.tid < 8) lcnt[c.tid] = 0u;
    if (comb >= 0) moe_offsets(c, comb, offs);
    __syncthreads();
    const float* xin = inp(c, I_X); const float* ctxin = inp(c, I_CTX);
    int nrows = 0;
    const int nrow_all = (which == 1 && l == DEPTH - 1) ? TL : T;
    for (int row = c.bid * NWAVES + c.wave; row < nrow_all; row += c.G * NWAVES, ++nrows) {
        const float* src = first ? (row < TL ? xin + (size_t)row * D : ctxin + (size_t)(row - TL) * D) : xres + (size_t)row * D;
        const int b = row < TL ? (row >> 12) : 4;
        const float* sh = mod + (size_t)b * 6144 + (which == 0 ? 0 : 3) * 1024; const float* sc = sh + 1024;
        f32x4 v[4]; float ss = 0.f;
#pragma unroll
        for (int j = 0; j < 4; ++j) v[j] = *(const f32x4*)(src + 4 * (c.lane + 64 * j));
        if (comb >= 0) moe_combine_row(mc, offs, row, b, c.lane, v);
#pragma unroll
        for (int j = 0; j < 4; ++j) ss += (v[j][0] * v[j][0] + v[j][1] * v[j][1]) + (v[j][2] * v[j][2] + v[j][3] * v[j][3]);
        ss = wave_sum(ss, c.lane);
        const float rstd = 1.f / sqrtf(ss * (1.f / D) + EPS);
        if (first || comb >= 0) {
#pragma unroll
            for (int j = 0; j < 4; ++j) *(f32x4*)(xres + (size_t)row * D + 4 * (c.lane + 64 * j)) = v[j];
        }
        float lg[8] = {0.f, 0.f, 0.f, 0.f, 0.f, 0.f, 0.f, 0.f};
#pragma unroll
        for (int j = 0; j < 4; ++j) { const int k0 = 4 * (c.lane + 64 * j);
            const f32x4 g4 = *(const f32x4*)(gp + k0), s4 = *(const f32x4*)(sc + k0), h4 = *(const f32x4*)(sh + k0);
            f32x4 o;
#pragma unroll
            for (int q = 0; q < 4; ++q) o[q] = v[j][q] * rstd * g4[q] * (1.f + s4[q]) + h4[q];
            u32x2 w; w.x = cvt_pk_bf16(o[0], o[1]); w.y = cvt_pk_bf16(o[2], o[3]);
            *(u32x2*)(h + (size_t)row * D + k0) = w;
            if (route) {
#pragma unroll
                for (int q = 0; q < 4; ++q) { const f32x4 ra = *(const f32x4*)(router + (size_t)(k0 + q) * 8), rb = *(const f32x4*)(router + (size_t)(k0 + q) * 8 + 4);
                    lg[0] += o[q] * ra[0]; lg[1] += o[q] * ra[1]; lg[2] += o[q] * ra[2]; lg[3] += o[q] * ra[3];
                    lg[4] += o[q] * rb[0]; lg[5] += o[q] * rb[1]; lg[6] += o[q] * rb[2]; lg[7] += o[q] * rb[3]; }
            }
        }
        if (route) {
#pragma unroll
            for (int e = 0; e < 8; ++e) lg[e] = wave_sum(lg[e], c.lane);
            int i1 = 0; float v1 = lg[0];
#pragma unroll
            for (int e = 1; e < 8; ++e) if (lg[e] > v1) { v1 = lg[e]; i1 = e; }
            int i2 = -1; float v2 = -3.0e38f;
#pragma unroll
            for (int e = 0; e < 8; ++e) if (e != i1 && lg[e] > v2) { v2 = lg[e]; i2 = e; }
            const float w1 = 1.f / (1.f + __expf(v2 - v1)), w2 = 1.f - w1;
            if (c.lane == 0) {
                const unsigned lp1 = __hip_atomic_fetch_add(lcnt + i1, 1u, __ATOMIC_RELAXED, __HIP_MEMORY_SCOPE_WORKGROUP), lp2 = __hip_atomic_fetch_add(lcnt + i2, 1u, __ATOMIC_RELAXED, __HIP_MEMORY_SCOPE_WORKGROUP);
                LAS int* pe = pend + (c.wave * 16 + nrows) * 4; pe[0] = row; pe[1] = i1 | (i2 << 8); pe[2] = (int)lp1; pe[3] = (int)lp2;
                rwt[(size_t)row * 2] = w1; rwt[(size_t)row * 2 + 1] = w2; }
        }
    }
    if (route) {
        __syncthreads();
        if (c.tid < 8) gbase[c.tid] = __hip_atomic_fetch_add((unsigned*)(c.ws + WS_CTL) + CW_CNT + 64 * (l >> 1) + c.tid, lcnt[c.tid], __ATOMIC_RELAXED, __HIP_MEMORY_SCOPE_AGENT);
        __syncthreads();
        if (c.lane < nrows) { const LAS int* pe = pend + (c.wave * 16 + c.lane) * 4; const int row = pe[0], e1 = pe[1] & 255, e2 = pe[1] >> 8;
            const int p1 = (int)gbase[e1] + pe[2], p2 = (int)gbase[e2] + pe[3];
            tokenof[(size_t)e1 * T + p1] = row; tokenof[(size_t)e2 * T + p2] = row;
            routeb[(size_t)row * 4 + 0] = e1; routeb[(size_t)row * 4 + 1] = p1; routeb[(size_t)row * 4 + 2] = e2; routeb[(size_t)row * 4 + 3] = p2; }
    }
    __syncthreads();
}

__device__ __forceinline__ void ph_sc(const Ctx& c0, int l) {
    const Ctx c = mk_ctx(c0.lds, c0.ws);
    const bf16_t* P = (const bf16_t*)(c.ws + WS_P); bf16_t* uT = (bf16_t*)(c.ws + WS_B); bf16_t* VT = (bf16_t*)(c.ws + WS_VT);
    const float* cw = inp(c, I_HCW) + (size_t)l * 3 * 1536; const float* cb = inp(c, I_HCB) + (size_t)l * 1536;
    LAS unsigned char* scr = c.lds + c.wave * 16384;
    for (int tile = c.bid * NWAVES + c.wave; tile < (T / 64) * 32; tile += c.G * NWAVES) {
        const int rt = tile / 32, row0 = rt * 64, ct = tile % 32; const bool isv = ct >= 24;
        const int ch0 = isv ? (ct - 24) * 64 : ct * 64, scol = isv ? PV + ch0 : PHY + ch0; bf16_t* dst = isv ? VT : uT;
        const int tpos = row0 < TL ? (row0 & 4095) : ((row0 - TL) & 255), Ls = row0 < TL ? 4096 : 256;
        for (int idx = c.lane; idx < 66 * 8; idx += 64) { const int rr = idx >> 3, ck = idx & 7; const int grow = row0 - 1 + rr;
            const bool ok = !((rr == 0 && tpos == 0) || (rr == 65 && tpos + 64 == Ls));
            u32x4 v = (u32x4){0u, 0u, 0u, 0u};
            if (ok) v = *(const u32x4*)(P + (size_t)grow * PW + scol + ck * 8);
            LAS unsigned* d = (LAS unsigned*)(scr + rr * 132 + ck * 16); d[0] = v.x; d[1] = v.y; d[2] = v.z; d[3] = v.w; }
        LDS_WAIT(); asm volatile("" ::: "memory");
        const int ch = ch0 + c.lane; const float w0 = isv ? 0.f : cw[ch], w1 = isv ? 1.f : cw[1536 + ch], w2 = isv ? 0.f : cw[3072 + ch], bb = isv ? 0.f : cb[ch];
        unsigned ow[32];
        { float prev = bf2f(*(const LAS unsigned short*)(scr + 0 * 132 + c.lane * 2)), cur = bf2f(*(const LAS unsigned short*)(scr + 1 * 132 + c.lane * 2)); float o0 = 0.f;
#pragma unroll
          for (int r = 0; r < 64; ++r) { const float nxt = bf2f(*(const LAS unsigned short*)(scr + (r + 2) * 132 + c.lane * 2));
              const float o = w0 * prev + w1 * cur + w2 * nxt + bb; prev = cur; cur = nxt;
              if (r & 1) ow[r >> 1] = cvt_pk_bf16(o0, o); else o0 = o; } }
        LDS_WAIT(); asm volatile("" ::: "memory");
#pragma unroll
        for (int k = 0; k < 8; ++k) { u32x4 v; v.x = ow[4 * k]; v.y = ow[4 * k + 1]; v.z = ow[4 * k + 2]; v.w = ow[4 * k + 3]; *(LAS u32x4*)(scr + c.lane * 144 + k * 16) = v; }
        LDS_WAIT(); asm volatile("" ::: "memory");
#pragma unroll
        for (int k = 0; k < 8; ++k) { const int cc = (c.lane >> 3) + 8 * k, ck = c.lane & 7; const u32x4 v = *(const LAS u32x4*)(scr + cc * 144 + ck * 16);
            *(u32x4*)(dst + (size_t)(ch0 + cc) * T + row0 + ck * 8) = v; }
        LDS_WAIT(); asm volatile("" ::: "memory");
    }
}

constexpr int HY_HR_OFF = 512, HY_U_OFF = HY_HR_OFF + 66560, HY_ZB_OFF = HY_U_OFF + 4 * 8208;
template <int L, bool DUAL>
__device__ __forceinline__ void hy_span(LAS unsigned char* lds, int nsteps, int aaddr, int ubase, int sX, int sY, f32x16& accX, f32x16& accY) {
#define HY_BADDR(sv) (((unsigned)(sv) <= (unsigned)(L - 16)) ? ubase + 2 * (sv) : HY_ZB_OFF)
    int k = 0;
    for (; k + 4 <= nsteps; k += 4) {
        const int pa = aaddr - 768;
        const int px0 = HY_BADDR(sX), px1 = HY_BADDR(sX - 16), px2 = HY_BADDR(sX - 32), px3 = HY_BADDR(sX - 48);
        bf16x8 a0, a1, a2, a3, x0, x1, x2, x3;
        if (DUAL) {
            const int py0 = HY_BADDR(sY), py1 = HY_BADDR(sY - 16), py2 = HY_BADDR(sY - 32), py3 = HY_BADDR(sY - 48);
            bf16x8 y0, y1, y2, y3;
            asm volatile(
                "ds_read_b128 %[a0], %[pa] offset:768\n\tds_read_b128 %[x0], %[px0]\n\tds_read_b128 %[y0], %[py0]\n\t"
                "ds_read_b128 %[a1], %[pa] offset:512\n\tds_read_b128 %[x1], %[px1]\n\tds_read_b128 %[y1], %[py1]\n\t"
                "ds_read_b128 %[a2], %[pa] offset:256\n\tds_read_b128 %[x2], %[px2]\n\tds_read_b128 %[y2], %[py2]\n\t"
                "ds_read_b128 %[a3], %[pa]\n\tds_read_b128 %[x3], %[px3]\n\tds_read_b128 %[y3], %[py3]\n\t"
                "s_waitcnt lgkmcnt(9)\n\tv_mfma_f32_32x32x16_bf16 %[cx], %[a0], %[x0], %[cx]\n\tv_mfma_f32_32x32x16_bf16 %[cy], %[a0], %[y0], %[cy]\n\t"
                "s_waitcnt lgkmcnt(6)\n\tv_mfma_f32_32x32x16_bf16 %[cx], %[a1], %[x1], %[cx]\n\tv_mfma_f32_32x32x16_bf16 %[cy], %[a1], %[y1], %[cy]\n\t"
                "s_waitcnt lgkmcnt(3)\n\tv_mfma_f32_32x32x16_bf16 %[cx], %[a2], %[x2], %[cx]\n\tv_mfma_f32_32x32x16_bf16 %[cy], %[a2], %[y2], %[cy]\n\t"
                "s_waitcnt lgkmcnt(0)\n\tv_mfma_f32_32x32x16_bf16 %[cx], %[a3], %[x3], %[cx]\n\tv_mfma_f32_32x32x16_bf16 %[cy], %[a3], %[y3], %[cy]\n\t"
                : [cx] "+v"(accX), [cy] "+v"(accY), [a0] "=&v"(a0), [a1] "=&v"(a1), [a2] "=&v"(a2), [a3] "=&v"(a3), [x0] "=&v"(x0), [x1] "=&v"(x1), [x2] "=&v"(x2), [x3] "=&v"(x3),
                  [y0] "=&v"(y0), [y1] "=&v"(y1), [y2] "=&v"(y2), [y3] "=&v"(y3)
                : [pa] "v"(pa), [px0] "v"(px0), [px1] "v"(px1), [px2] "v"(px2), [px3] "v"(px3), [py0] "v"(py0), [py1] "v"(py1), [py2] "v"(py2), [py3] "v"(py3));
        } else {
            asm volatile(
                "ds_read_b128 %[a0], %[pa] offset:768\n\tds_read_b128 %[x0], %[px0]\n\t"
                "ds_read_b128 %[a1], %[pa] offset:512\n\tds_read_b128 %[x1], %[px1]\n\t"
                "ds_read_b128 %[a2], %[pa] offset:256\n\tds_read_b128 %[x2], %[px2]\n\t"
                "ds_read_b128 %[a3], %[pa]\n\tds_read_b128 %[x3], %[px3]\n\t"
                "s_waitcnt lgkmcnt(6)\n\tv_mfma_f32_32x32x16_bf16 %[cx], %[a0], %[x0], %[cx]\n\t"
                "s_waitcnt lgkmcnt(4)\n\tv_mfma_f32_32x32x16_bf16 %[cx], %[a1], %[x1], %[cx]\n\t"
                "s_waitcnt lgkmcnt(2)\n\tv_mfma_f32_32x32x16_bf16 %[cx], %[a2], %[x2], %[cx]\n\t"
                "s_waitcnt lgkmcnt(0)\n\tv_mfma_f32_32x32x16_bf16 %[cx], %[a3], %[x3], %[cx]\n\t"
                : [cx] "+v"(accX), [a0] "=&v"(a0), [a1] "=&v"(a1), [a2] "=&v"(a2), [a3] "=&v"(a3), [x0] "=&v"(x0), [x1] "=&v"(x1), [x2] "=&v"(x2), [x3] "=&v"(x3)
                : [pa] "v"(pa), [px0] "v"(px0), [px1] "v"(px1), [px2] "v"(px2), [px3] "v"(px3));
        }
        aaddr -= 1024; sX -= 64; sY -= 64;
    }
    for (; k < nsteps; ++k) {
        const bf16x8 af = *(const LAS bf16x8*)(lds + aaddr), xf = *(const LAS bf16x8*)(lds + HY_BADDR(sX));
        accX = __builtin_amdgcn_mfma_f32_32x32x16_bf16(af, xf, accX, 0, 0, 0);
        if (DUAL) { const bf16x8 yf = *(const LAS bf16x8*)(lds + HY_BADDR(sY)); accY = __builtin_amdgcn_mfma_f32_32x32x16_bf16(af, yf, accY, 0, 0, 0); }
        aaddr -= 256; sX -= 16; sY -= 16;
    }
#undef HY_BADDR
}
template <int L>
__device__ __forceinline__ void hy_unit(const Ctx& c, int l, int ch, const float* hbias) {
    constexpr int H = L / 2, NG = L / 256, LP = L + 64, NW = L / 8 + 8, ROWB = 2 * L + 16;
    LAS unsigned char* lds = c.lds;
    const bf16_t* uT = (const bf16_t*)(c.ws + WS_B); bf16_t* oht = (bf16_t*)(c.ws + WS_OHT);
    const int seq0 = (L == 4096) ? 0 : TL;
    const bf16_t* hrbase = (L == 4096) ? (const bf16_t*)(c.ws + WS_HRL) : (const bf16_t*)(c.ws + WS_HRC);
    int gA, gB;
    if (NG == 16) { gA = c.wave < 4 ? c.wave : 4 + c.wave; gB = c.wave < 4 ? 7 - c.wave : 19 - c.wave; } else { gA = c.wave == 0 ? 0 : -1; gB = -1; }
    const int n = c.lane & 31, g = c.lane >> 5, tbl = n >> 2, b = n & 3;
    const int loA = gA < 0 ? 1 << 30 : max(-H - 16, 256 * gA - (L - 16)), hiA = gA < 0 ? -(1 << 30) : min(H, 256 * gA + 224);
    const int loB = gB < 0 ? 1 << 30 : max(-H - 16, 256 * gB - (L - 16)), hiB = gB < 0 ? -(1 << 30) : min(H, 256 * gB + 224);
    const int dlo = min(loA, loB), dhi = max(hiA, hiB);
    unsigned zreg[2][4][2];
    for (int o = 0; o < 2; ++o) {
        const bf16_t* hr = hrbase + ((size_t)(l * 2 + o) * 512 + ch) * LP;
        for (int w = c.tid; w < NW; w += NTHR) {
            u32x4 A4 = (u32x4){0u, 0u, 0u, 0u}; if (w > 0) A4 = *(const u32x4*)(hr + 8 * (w - 1));
            const u32x4 B4 = *(const u32x4*)(hr + 8 * w);
            const unsigned Dd[8] = {A4.x, A4.y, A4.z, A4.w, B4.x, B4.y, B4.z, B4.w};
#pragma unroll
            for (int q = 0; q < 8; ++q) { u32x4 ov;
                if ((q & 1) == 0) { const int j = (8 - q) / 2; ov.x = Dd[j]; ov.y = Dd[j + 1]; ov.z = Dd[j + 2]; ov.w = Dd[j + 3]; }
                else { const int j = (7 - q) / 2; ov.x = __builtin_amdgcn_alignbit(Dd[j + 1], Dd[j], 16); ov.y = __builtin_amdgcn_alignbit(Dd[j + 2], Dd[j + 1], 16);
                       ov.z = __builtin_amdgcn_alignbit(Dd[j + 3], Dd[j + 2], 16); ov.w = __builtin_amdgcn_alignbit(Dd[j + 4], Dd[j + 3], 16); }
                *(LAS u32x4*)(lds + HY_HR_OFF + (8 * w + q) * 16) = ov; }
        }
        if (o == 0) {
            for (int idx = c.tid; idx < 4 * (L / 8); idx += NTHR) { const int bb = idx / (L / 8), wq = idx % (L / 8);
                *(LAS u32x4*)(lds + HY_U_OFF + bb * ROWB + wq * 16) = *(const u32x4*)(uT + (size_t)ch * T + seq0 + bb * L + wq * 8); }
            if (c.tid < 16) *(LAS unsigned*)(lds + HY_ZB_OFF + c.tid * 4) = 0u;
        } else {
#pragma unroll
            for (int gi = 0; gi < 2; ++gi) { const int G = gi == 0 ? gA : gB; if (G >= 0) {
#pragma unroll
                for (int rq = 0; rq < 4; ++rq) { const int t = 32 * (8 * G + tbl) + 8 * rq + 4 * g;
                    u32x2 zz; zz.x = zreg[gi][rq][0]; zz.y = zreg[gi][rq][1]; *(LAS u32x2*)(lds + HY_U_OFF + b * ROWB + 2 * t) = zz; } } }
        }
        __syncthreads();
        f32x16 accA, accB;
#pragma unroll
        for (int r = 0; r < 16; ++r) { accA[r] = 0.f; accB[r] = 0.f; }
        {
            const int qq = (n + 1) & 7, ubase = HY_U_OFF + b * ROWB + 16 * g;
#define HY_AADDR(d) (HY_HR_OFF + (8 * ((H + 31 - (d) - n + 8 * g + qq) >> 3) + qq) * 16)
#define HY_S0(G, d) (32 * (8 * (G) + tbl) - (d))
            if (gB < 0) { if (gA >= 0) hy_span<L, false>(lds, (hiA - loA) / 16 + 1, HY_AADDR(loA), ubase, HY_S0(gA, loA), 0, accA, accB); }
            else {
                const int dS = max(loA, loB), dE = min(hiA, hiB);
                if (loA < dS) hy_span<L, false>(lds, (dS - loA) / 16, HY_AADDR(loA), ubase, HY_S0(gA, loA), 0, accA, accB);
                else if (loB < dS) hy_span<L, false>(lds, (dS - loB) / 16, HY_AADDR(loB), ubase, HY_S0(gB, loB), 0, accB, accA);
                hy_span<L, true>(lds, (dE - dS) / 16 + 1, HY_AADDR(dS), ubase, HY_S0(gA, dS), HY_S0(gB, dS), accA, accB);
                if (hiA > dE) hy_span<L, false>(lds, (hiA - dE) / 16, HY_AADDR(dE + 16), ubase, HY_S0(gA, dE + 16), 0, accA, accB);
                else if (hiB > dE) hy_span<L, false>(lds, (hiB - dE) / 16, HY_AADDR(dE + 16), ubase, HY_S0(gB, dE + 16), 0, accB, accA);
            }
#undef HY_AADDR
#undef HY_S0
        }
        const float bias = hbias[(l * 2 + o) * 512 + ch];
        int tbl_e = tbl, b_e = b, g_e = g; asm volatile("" : "+v"(tbl_e), "+v"(b_e), "+v"(g_e));
#pragma unroll
        for (int gi = 0; gi < 2; ++gi) { const int G = gi == 0 ? gA : gB; if (G >= 0) {
#pragma unroll
            for (int rq = 0; rq < 4; ++rq) { const int t = 32 * (8 * G + tbl_e) + 8 * rq + 4 * g_e;
                const u32x2 uv = *(const LAS u32x2*)(lds + HY_U_OFF + b_e * ROWB + 2 * t);
                const size_t grow = (size_t)seq0 + b_e * L + t;
                const u32x2 xv = *(const u32x2*)(uT + (size_t)((o == 0 ? 512 : 1024) + ch) * T + grow);
                float y[4];
#pragma unroll
                for (int k = 0; k < 4; ++k) y[k] = gi == 0 ? accA[4 * rq + k] : accB[4 * rq + k];
                const float r0 = bflo(xv.x) * (y[0] + bias * bflo(uv.x)), r1 = bfhi(xv.x) * (y[1] + bias * bfhi(uv.x));
                const float r2 = bflo(xv.y) * (y[2] + bias * bflo(uv.y)), r3 = bfhi(xv.y) * (y[3] + bias * bfhi(uv.y));
                const unsigned p0 = cvt_pk_bf16(r0, r1), p1 = cvt_pk_bf16(r2, r3);
                if (o == 0) { zreg[gi][rq][0] = p0; zreg[gi][rq][1] = p1; }
                else { u32x2 ov; ov.x = p0; ov.y = p1; *(u32x2*)(oht + (size_t)ch * T + grow) = ov;   } } } }
        __syncthreads();
    }
}
__device__ __forceinline__ void ph_hyena(const Ctx& c0, int l) {
    const Ctx c = mk_ctx(c0.lds, c0.ws);
    const float* hbias = inp(c, I_HBIAS);
    for (int unit = c.bid; unit < HYW; unit += c.G) { hy_unit<4096>(c, l, unit, hbias); if (l < DEPTH - 1) hy_unit<256>(c, l, unit, hbias); }
}

__device__ __forceinline__ void ph_ohy_t(const Ctx& c0) {
    const Ctx c = mk_ctx(c0.lds, c0.ws);
    const bf16_t* src = (const bf16_t*)(c.ws + WS_OHT); bf16_t* dst = (bf16_t*)(c.ws + WS_OAH) + 512;
    LAS unsigned char* scr = c.lds + c.wave * 16384;
    for (int tile = c.bid * NWAVES + c.wave; tile < (T / 64) * 8; tile += c.G * NWAVES) {
        const int row0 = (tile >> 3) * 64, ch0 = (tile & 7) * 64;
#pragma unroll
        for (int k = 0; k < 8; ++k) { const int cc = (c.lane >> 3) + 8 * k, ck = c.lane & 7;
            const u32x4 v = *(const u32x4*)(src + (size_t)(ch0 + cc) * T + row0 + ck * 8);
            LAS unsigned* d = (LAS unsigned*)(scr + cc * 132 + ck * 16); d[0] = v.x; d[1] = v.y; d[2] = v.z; d[3] = v.w; }
        LDS_WAIT(); asm volatile("" ::: "memory");
        unsigned ow[32];
#pragma unroll
        for (int j = 0; j < 32; ++j) { const unsigned lo = *(const LAS unsigned short*)(scr + (2 * j) * 132 + c.lane * 2), hi = *(const LAS unsigned short*)(scr + (2 * j + 1) * 132 + c.lane * 2); ow[j] = lo | (hi << 16); }
        LDS_WAIT(); asm volatile("" ::: "memory");
#pragma unroll
        for (int k = 0; k < 8; ++k) { u32x4 v; v.x = ow[4 * k]; v.y = ow[4 * k + 1]; v.z = ow[4 * k + 2]; v.w = ow[4 * k + 3]; *(LAS u32x4*)(scr + c.lane * 144 + k * 16) = v; }
        LDS_WAIT(); asm volatile("" ::: "memory");
#pragma unroll
        for (int k = 0; k < 8; ++k) { const int rr = (c.lane >> 3) + 8 * k, ck = c.lane & 7; const u32x4 v = *(const LAS u32x4*)(scr + rr * 144 + ck * 16);
            *(u32x4*)(dst + (size_t)(row0 + rr) * 1024 + ch0 + ck * 8) = v; }
        LDS_WAIT(); asm volatile("" ::: "memory");
    }
}

constexpr int ATT_RPB_OFF = 1024, ATT_VT_OFF = ATT_RPB_OFF + 8 * 15 * 32 * 4, ATT_VT_BYTES = 64 * 72;
template <int MODE>
__device__ __forceinline__ void att_block(const bf16_t* P, const bf16_t* VT, LAS unsigned char* lds, LAS unsigned char* vt, int lane, int n, int h, int head,
                                          int tokk, int ctok, int tabaddr, int vb, const bf16x8 (&qf)[4], f32x16& ot0, f32x16& ot1, float& m, float& lsum) {
    bf16x8 kf[4];
#pragma unroll
    for (int ks = 0; ks < 4; ++ks) kf[ks] = *(const bf16x8*)(P + (size_t)tokk * PW + PK + head * 64 + 16 * ks + 8 * h);
    u32x2 vr[8];
#pragma unroll
    for (int it = 0; it < 8; ++it) vr[it] = *(const u32x2*)(VT + (size_t)(head * 64 + it * 8 + (lane >> 3)) * T + ctok);
    f32x16 st;
#pragma unroll
    for (int r = 0; r < 16; ++r) st[r] = 0.f;
#pragma unroll
    for (int ks = 0; ks < 4; ++ks) st = __builtin_amdgcn_mfma_f32_32x32x16_bf16(kf[ks], qf[ks], st, 0, 0, 0);
    const float SC = 0.18033688011112042f;
    float sv[16];
#pragma unroll
    for (int r = 0; r < 16; ++r) {
        if (MODE == 2) sv[r] = st[r] * SC;
        else { const int cr = MODE == 0 ? 8 * (r >> 2) + (r & 3) : (r & 3), imm = MODE == 0 ? cr * 4 : ((r >> 2) * 32 + (r & 3)) * 4;
            const float bias = *(const LAS float*)(lds + tabaddr + imm);
            const bool ok = (unsigned)(vb + cr) < 16u;
            sv[r] = ok ? st[r] * SC + bias : -1.0e30f; }
    }
    float bm = sv[0];
#pragma unroll
    for (int r = 1; r < 16; ++r) bm = fmaxf(bm, sv[r]);
    bm = fmaxf(bm, __int_as_float(__builtin_amdgcn_ds_bpermute((lane ^ 32) << 2, __float_as_int(bm))));
    const float mn = fmaxf(m, bm), alpha = __builtin_amdgcn_exp2f(m - mn); m = mn;
    float psum = 0.f;
#pragma unroll
    for (int r = 0; r < 16; ++r) { const float pv = __builtin_amdgcn_exp2f(sv[r] - mn); psum += pv; sv[r] = pv; }
    lsum = lsum * alpha + psum;
#pragma unroll
    for (int r = 0; r < 16; ++r) { ot0[r] *= alpha; ot1[r] *= alpha; }
    bf16x8 pb[2];
#pragma unroll
    for (int s2 = 0; s2 < 2; ++s2) { u32x4 w; w.x = cvt_pk_bf16(sv[8 * s2], sv[8 * s2 + 1]); w.y = cvt_pk_bf16(sv[8 * s2 + 2], sv[8 * s2 + 3]);
        w.z = cvt_pk_bf16(sv[8 * s2 + 4], sv[8 * s2 + 5]); w.w = cvt_pk_bf16(sv[8 * s2 + 6], sv[8 * s2 + 7]); pb[s2] = __builtin_bit_cast(bf16x8, w); }
#pragma unroll
    for (int it = 0; it < 8; ++it) *(LAS u32x2*)(vt + (it * 8 + (lane >> 3)) * 72 + (lane & 7) * 8) = vr[it];
#pragma unroll
    for (int s2 = 0; s2 < 2; ++s2) {
        { const u32x2 a = *(const LAS u32x2*)(vt + n * 72 + (4 * s2 + h) * 8), bq = *(const LAS u32x2*)(vt + n * 72 + (4 * s2 + 2 + h) * 8);
          u32x4 w; w.x = a.x; w.y = a.y; w.z = bq.x; w.w = bq.y; ot0 = __builtin_amdgcn_mfma_f32_32x32x16_bf16(__builtin_bit_cast(bf16x8, w), pb[s2], ot0, 0, 0, 0); }
        { const u32x2 a = *(const LAS u32x2*)(vt + (32 + n) * 72 + (4 * s2 + h) * 8), bq = *(const LAS u32x2*)(vt + (32 + n) * 72 + (4 * s2 + 2 + h) * 8);
          u32x4 w; w.x = a.x; w.y = a.y; w.z = bq.x; w.w = bq.y; ot1 = __builtin_amdgcn_mfma_f32_32x32x16_bf16(__builtin_bit_cast(bf16x8, w), pb[s2], ot1, 0, 0, 0); }
    }
}
constexpr int ATT_UNITS = 4096 + 256;
__device__ __forceinline__ void ph_attn(const Ctx& c0, int l) {
    const Ctx c = mk_ctx(c0.lds, c0.ws);
    const bf16_t* P = (const bf16_t*)(c.ws + WS_P); const bf16_t* VT = (const bf16_t*)(c.ws + WS_VT); bf16_t* oatt = (bf16_t*)(c.ws + WS_OAH);
    const float* rpb = inp(c, I_RPB) + (size_t)l * 8 * 15 * 31;
    LAS unsigned char* lds = c.lds;
    for (int i = c.tid; i < 8 * 15 * 32; i += NTHR) { const int hd = i / 480, rem = i % 480, dr = rem >> 5, dc = rem & 31;
        *(LAS float*)(lds + ATT_RPB_OFF + i * 4) = dc < 31 ? rpb[(hd * 15 + dr) * 31 + dc] * 1.4426950408889634f : 0.f; }
    __syncthreads();
    LAS unsigned char* vt = lds + ATT_VT_OFF + c.wave * ATT_VT_BYTES;
    const int lane = c.lane, n = lane & 31, h = lane >> 5;
    const int natt = l < DEPTH - 1 ? ATT_UNITS : 4096;
    for (int u = c.bid * NWAVES + c.wave; u < natt; u += c.G * NWAVES) {
        const bool lat = u < 4096;
        int b, head, r = 0, hf = 0, tokq;
        if (lat) { hf = u & 1; r = (u >> 1) & 63; head = (u >> 7) & 7; b = u >> 10; tokq = b * 4096 + r * 64 + 32 * hf + n; }
        else { const int uu = u - 4096; head = (uu >> 3) & 7; b = uu >> 6; tokq = TL + b * 256 + 32 * (uu & 7) + n; }
        bf16x8 qf[4];
#pragma unroll
        for (int ks = 0; ks < 4; ++ks) qf[ks] = *(const bf16x8*)(P + (size_t)tokq * PW + PQ + head * 64 + 16 * ks + 8 * h);
        f32x16 ot0, ot1;
#pragma unroll
        for (int q = 0; q < 16; ++q) { ot0[q] = 0.f; ot1[q] = 0.f; }
        float m = -1.0e30f, lsum = 0.f;
        if (lat) {
            const int r0 = min(max(r - 4, 0), 56), lo = hf ? 24 : 0, qc = 32 * hf + n, c0q = min(max(qc - 8, 0), 48);
            for (int kb = 0; kb < 8; ++kb) {
                const int base = b * 4096 + (r0 + kb) * 64 + lo, kx = lo + 4 * h;
                const int tabaddr = ATT_RPB_OFF + (((head * 15 + (r0 + kb - r + 7)) * 32) + kx - qc + 15) * 4;
                att_block<0>(P, VT, lds, vt, lane, n, h, head, base + n, base + 4 * (lane & 7), tabaddr, kx - c0q, qf, ot0, ot1, m, lsum);
            }
            for (int kb = 0; kb < 2; ++kb) {
                const int rowb = b * 4096 + (r0 + 4 * kb) * 64 + lo + 32, kx = lo + 32 + 4 * h, cc = lane & 7;
                const int tabaddr = ATT_RPB_OFF + (((head * 15 + (r0 + 4 * kb - r + 7)) * 32) + kx - qc + 15) * 4;
                att_block<1>(P, VT, lds, vt, lane, n, h, head, rowb + (n >> 3) * 64 + (n & 7), rowb + (cc >> 1) * 64 + 4 * (cc & 1), tabaddr, kx - c0q, qf, ot0, ot1, m, lsum);
            }
        }
        for (int kb = 0; kb < 8; ++kb) { const int base = TL + b * 256 + 32 * kb;
            att_block<2>(P, VT, lds, vt, lane, n, h, head, base + n, base + 4 * (lane & 7), 0, 0, qf, ot0, ot1, m, lsum); }
        const float ltot = lsum + __int_as_float(__builtin_amdgcn_ds_bpermute((lane ^ 32) << 2, __float_as_int(lsum)));
        const float inv = 1.f / ltot;
        bf16_t* op = oatt + (size_t)tokq * 1024 + head * 64 + 4 * h;
#pragma unroll
        for (int rq = 0; rq < 4; ++rq) {
            u32x2 w0, w1; w0.x = cvt_pk_bf16(ot0[4 * rq] * inv, ot0[4 * rq + 1] * inv); w0.y = cvt_pk_bf16(ot0[4 * rq + 2] * inv, ot0[4 * rq + 3] * inv);
            w1.x = cvt_pk_bf16(ot1[4 * rq] * inv, ot1[4 * rq + 1] * inv); w1.y = cvt_pk_bf16(ot1[4 * rq + 2] * inv, ot1[4 * rq + 3] * inv);
            *(u32x2*)(op + 8 * rq) = w0; *(u32x2*)(op + 32 + 8 * rq) = w1; }
    }
    __syncthreads();
}

__device__ __forceinline__ void ph_final(const Ctx& c0) {
    const Ctx c = mk_ctx(c0.lds, c0.ws);
    const float* xres = (const float*)(c.ws + WS_X); const float* gp = inp(c, I_FINALG); float* outp = (float*)inp(c, 30);
    const MoeComb mc{(const int*)(c.ws + WS_ROUTE), (const float*)(c.ws + WS_RWT), (const bf16_t*)(c.ws + WS_Y), (const float*)(c.ws + WS_MOD) + (size_t)(DEPTH - 1) * 5 * 6144 + 5 * 1024};
    LAS unsigned* offs = (LAS unsigned*)c.lds + 32;
    moe_offsets(c, 1, offs);
    __syncthreads();
    for (int row = c.bid * NWAVES + c.wave; row < TL; row += c.G * NWAVES) {
        const float* src = xres + (size_t)row * D; f32x4 v[4]; float ss = 0.f;
#pragma unroll
        for (int j = 0; j < 4; ++j) v[j] = *(const f32x4*)(src + 4 * (c.lane + 64 * j));
        moe_combine_row(mc, offs, row, row >> 12, c.lane, v);
#pragma unroll
        for (int j = 0; j < 4; ++j) ss += (v[j][0] * v[j][0] + v[j][1] * v[j][1]) + (v[j][2] * v[j][2] + v[j][3] * v[j][3]);
        ss = wave_sum(ss, c.lane);
        const float rstd = 1.f / sqrtf(ss * (1.f / D) + EPS);
#pragma unroll
        for (int j = 0; j < 4; ++j) { const int k0 = 4 * (c.lane + 64 * j); const f32x4 g4 = *(const f32x4*)(gp + k0); *(f32x4*)(outp + (size_t)row * D + k0) = v[j] * rstd * g4; }
    }
}

constexpr int MOE_OFF = 132096;
template <bool GATHER_> struct MoeOrder {
    static constexpr bool GATHER = GATHER_;
    int nM, nN, nwg, G, c; const char* A; const char* B; size_t astep, bstep, estep; const int* tokenof; const LAS unsigned* tab;
    __device__ void init(const void* A_, int lda, const void* B_, int ldb, size_t estep_bytes, int N, int G_, int c_, const int* tok, const LAS unsigned* tab_) {
        tab = tab_; nM = (int)((unsigned)__builtin_amdgcn_readfirstlane(tab[8]) >> 8); nN = N / pg8::BM; nwg = nM * nN; G = G_; c = c_; A = (const char*)A_; B = (const char*)B_;
        astep = (size_t)pg8::BM * lda * 2; bstep = (size_t)pg8::BM * ldb * 2; estep = estep_bytes; tokenof = tok; }
    __device__ bool next(int i, pg8::Unit& u) const {
        const long L = (long)i * G + c; if (L >= nwg) return false;
        int wgid = (int)L; { const int q = nwg / pg8::NXCD, r = nwg % pg8::NXCD, xcd = wgid % pg8::NXCD, off = wgid / pg8::NXCD; wgid = (xcd < r ? xcd * (q + 1) : r * (q + 1) + (xcd - r) * q) + off; }
        const int nig = pg8::WGM * nN, gid = wgid / nig, fm = gid * pg8::WGM, gsz = (nM - fm) < pg8::WGM ? (nM - fm) : pg8::WGM;
        u.pm = fm + ((wgid % nig) % gsz); u.pn = (wgid % nig) / gsz;
        const unsigned slot0 = (unsigned)u.pm << 8; int e = 0;
#pragma unroll
        for (int j = 1; j < 8; ++j) e += (slot0 >= (unsigned)__builtin_amdgcn_readfirstlane(tab[j])) ? 1 : 0;
        const unsigned pos0 = slot0 - (unsigned)__builtin_amdgcn_readfirstlane(tab[e]), cnt = (unsigned)__builtin_amdgcn_readfirstlane(tab[16 + e]);
        u.nvalid = cnt > pos0 ? (int)(cnt - pos0) : 0; u.tk = tokenof + (size_t)e * T + pos0;
        u.a = GATHER ? A : A + (size_t)u.pm * astep; u.b = B + (size_t)e * estep + (size_t)u.pn * bstep; return true;
    }
    __device__ __forceinline__ int arow(const pg8::Unit& u, int r) const { return r < u.nvalid ? u.tk[r] : 0; }
    __device__ __forceinline__ void a_ready(const pg8::Unit&) const {}
    __device__ __forceinline__ void done(const pg8::Unit&) const {}
};
__device__ __forceinline__ void moe_table(const Ctx& c, int i) {
    LAS unsigned* tab = (LAS unsigned*)(c.lds + MOE_OFF);
    if (c.tid == 0) { const unsigned* cnt = (const unsigned*)(c.ws + WS_CTL) + CW_CNT + 64 * i; unsigned o = 0;
        for (int e = 0; e < 8; ++e) { const unsigned ce = cnt[e]; tab[e] = o; tab[16 + e] = ce; o += (ce + 255u) & ~255u; } tab[8] = o; }
    __syncthreads();
}

#define XB_TMO      128
#define XB_XCNT(j)  (256  + 64 * (j))
#define XB_XSUB(j)  (1280 + 64 * (j))
#define XB_XGEN(j)  (2304 + 64 * (j))
#define XB_TOP      3328
#define XB_TOPGEN   3392
#define XCD_BAR_WORDS 3456
#define XB_SPIN_CAP (1u << 18)
__device__ __forceinline__ unsigned xb_ld(unsigned* p)              { return __hip_atomic_load(p, __ATOMIC_RELAXED, __HIP_MEMORY_SCOPE_AGENT); }
__device__ __forceinline__ unsigned xb_add(unsigned* p, unsigned v) { return __hip_atomic_fetch_add(p, v, __ATOMIC_RELAXED, __HIP_MEMORY_SCOPE_AGENT); }
__device__ __forceinline__ unsigned xb_xcc_id() { return (unsigned)__builtin_amdgcn_s_getreg((3 << 11) | 20) & 0xFu; }
#define XB_SPIN(cond, bar) do { unsigned _sp = 0; while (cond) { __builtin_amdgcn_s_sleep(1); \
    if ((++_sp & 255u) == 0u) { if (xb_ld(&(bar)[XB_TMO])) break; if (_sp > XB_SPIN_CAP) { atomicAdd(&(bar)[XB_TMO], 1u); break; } } } } while (0)
struct XcdBarrier { unsigned* bar; unsigned x; volatile LAS unsigned* st; };
__device__ __forceinline__ XcdBarrier xcd_barrier_post(unsigned* bar, volatile LAS unsigned* st) {
    XcdBarrier b; b.bar = bar; b.x = xb_xcc_id(); b.st = st;
    if (threadIdx.x == 0) (void)xb_add(&bar[XB_XCNT(b.x)], 1u);
    return b;
}
__device__ __forceinline__ void xcd_barrier_complete(unsigned* bar, unsigned x, unsigned& nloc, unsigned& nx) {
    const unsigned G = gridDim.x * gridDim.y * gridDim.z;
    unsigned sum, cnt, mine, sp = 0u;
    for (;;) {
        sum = 0u; cnt = 0u; mine = 0u;
#pragma unroll
        for (unsigned j = 0; j < 16; ++j) { const unsigned c = xb_ld(&bar[XB_XCNT(j)]); sum += c; cnt += (c > 0u) ? 1u : 0u; mine = (j == x) ? c : mine; }
        if (sum == G) break;
        __builtin_amdgcn_s_sleep(1);
        if ((++sp & 255u) == 0u) { if (xb_ld(&bar[XB_TMO])) break; if (sp > XB_SPIN_CAP) { atomicAdd(&bar[XB_TMO], 1u); break; } }
    }
    nloc = mine > 0u ? mine : 1u; nx = cnt > 0u ? cnt : 1u;
}
__device__ __forceinline__ void xcd_barrier(const XcdBarrier& b) {
    asm volatile("s_waitcnt vmcnt(0)" ::: "memory");
    __syncthreads();
    if (threadIdx.x == 0) {
        unsigned* bar = b.bar; asm volatile("" : "+s"(bar));     const unsigned bx = xb_xcc_id();
        __builtin_amdgcn_s_waitcnt(0);
        unsigned nloc = b.st[0], nx = b.st[1];
        if (nloc == 0u) { xcd_barrier_complete(bar, bx, nloc, nx); b.st[0] = nloc; b.st[1] = nx; }
        const unsigned old = xb_add(&bar[XB_XSUB(bx)], 1u);
        const unsigned gen = old / nloc;
        if (old + 1u == (gen + 1u) * nloc) {
            __builtin_amdgcn_fence(__ATOMIC_RELEASE, "agent");
            asm volatile("s_waitcnt vmcnt(0)" ::: "memory");
            const unsigned og = xb_add(&bar[XB_TOP], 1u);
            const unsigned tg = og / nx;
            if (og + 1u == (tg + 1u) * nx) xb_add(&bar[XB_TOPGEN], 1u);
            else XB_SPIN(xb_ld(&bar[XB_TOPGEN]) == tg, bar);
            __builtin_amdgcn_fence(__ATOMIC_ACQUIRE, "agent");
            xb_add(&bar[XB_XGEN(bx)], 1u);
            asm volatile("s_waitcnt vmcnt(0)" ::: "memory");
        } else {
            XB_SPIN(xb_ld(&bar[XB_XGEN(bx)]) == gen, bar);
            __builtin_amdgcn_fence(__ATOMIC_ACQUIRE, "agent");
            asm volatile("s_waitcnt vmcnt(0)" ::: "memory");
        }
    }
    __syncthreads();
}

constexpr int CW_BAR = 4096;

__global__ void __launch_bounds__(NTHR, 2) fwd(Args args) {
    extern __shared__ __attribute__((aligned(16))) unsigned char lds_raw[];
    Ctx c; c.lds = (LAS unsigned char*)lds_raw; c.tid = threadIdx.x; c.lane = c.tid & 63; c.wave = __builtin_amdgcn_readfirstlane(c.tid >> 6); c.G = gridDim.x; c.bid = blockIdx.x; c.ws = args.ws;
    unsigned char* ws = args.ws;
    volatile LAS unsigned* MISC = (volatile LAS unsigned*)(c.lds + MISC_OFF);
    if (c.tid < 32) MISC[c.tid] = 0u;
    if (c.tid < 31) { const unsigned long long pv = c.tid < 30 ? (unsigned long long)args.in[c.tid] : (unsigned long long)args.out;
        volatile LAS unsigned* pt = (volatile LAS unsigned*)(c.lds + PTR_OFF) + 2 * c.tid; pt[0] = (unsigned)pv; pt[1] = (unsigned)(pv >> 32); }
    __syncthreads();
    XcdBarrier bar = xcd_barrier_post((unsigned*)(ws + WS_CTL) + CW_BAR, MISC + 8);
#define GRID_BAR() xcd_barrier(bar)

    ph_convert(c); __syncthreads(); ph_mod(c); __syncthreads(); ph_filt(c);
    GRID_BAR();
    for (int l = 0; l < DEPTH; ++l) {
        ph_norm(c, l, 0);
        GRID_BAR();
        {   unsigned char* ws = c.ws; asm volatile("" : "+s"(ws));
            pg8::Gemm g{D, D, D}; pg8::StaticOrder S; S.init(ws + WS_H, D, (bf16_t*)(ws + WS_WIN) + (size_t)l * PW * D, D, T, PW, c.G, c.bid);
            EpiStoreBf16 E{(bf16_t*)(ws + WS_P), PW};
            pg8::gemm_phase(c.lds, g, S, E); }
        GRID_BAR();
        ph_sc(c, l);
        GRID_BAR();
        ph_hyena(c, l); ph_attn(c, l);
        GRID_BAR();
        ph_ohy_t(c);
        GRID_BAR();
        {   unsigned char* ws = c.ws; asm volatile("" : "+s"(ws));
            const bf16_t* wab = (const bf16_t*)(ws + WS_WPAB) + (size_t)l * D * D;
            pg8::Gemm g{D, D, D}; pg8::StaticOrder S; S.init(ws + WS_OAH, D, wab, D, TL, D, c.G, c.bid);
            EpiMergeK E{(const bf16_t*)(ws + WS_P), (bf16_t*)(ws + WS_H)};
            pg8::gemm_phase(c.lds, g, S, E);
            if (l < DEPTH - 1) ctx_gemm((const bf16_t*)(ws + WS_OAH), D, wab, D, D, CEpiMergeK{(const bf16_t*)(ws + WS_P), (bf16_t*)(ws + WS_H)}); }
        GRID_BAR();
        {   unsigned char* ws = c.ws; asm volatile("" : "+s"(ws));
            const float* modl = (const float*)(ws + WS_MOD) + (size_t)l * 5 * 6144;
            pg8::Gemm g{D, D, D}; pg8::StaticOrder S; S.init(ws + WS_H, D, (bf16_t*)(ws + WS_WO) + (size_t)l * D * D, D, TL, D, c.G, c.bid);
            EpiResid E{(float*)(ws + WS_X), modl + 2 * 1024};
            pg8::gemm_phase(c.lds, g, S, E);
            if (l < DEPTH - 1) ctx_gemm((const bf16_t*)(ws + WS_H), D, (const bf16_t*)(ws + WS_WO) + (size_t)l * D * D, D, D, CEpiResid{(float*)(ws + WS_X), modl + 4 * 6144 + 2 * 1024}); }
        GRID_BAR();
        ph_norm(c, l, 1);
        GRID_BAR();
        if ((l & 1) == 0) {
            {   unsigned char* ws = c.ws; asm volatile("" : "+s"(ws));
                const bf16_t* w = (const bf16_t*)(ws + WS_W13D) + (size_t)(l >> 1) * 2 * FF * D;
                pg8::Gemm g{D, D, D}; pg8::StaticOrder S; S.init(ws + WS_H, D, w, D, T, 2 * FF, c.G, c.bid);
                EpiSwiglu E{(bf16_t*)(ws + WS_P)};
                pg8::gemm_phase(c.lds, g, S, E); }
            GRID_BAR();
            {   unsigned char* ws = c.ws; asm volatile("" : "+s"(ws));
                const float* modl = (const float*)(ws + WS_MOD) + (size_t)l * 5 * 6144;
                const bf16_t* w = (const bf16_t*)(ws + WS_W2D) + (size_t)(l >> 1) * D * FF;
                pg8::Gemm g{FF, FF, FF}; pg8::StaticOrder S; S.init(ws + WS_P, FF, w, FF, TL, D, c.G, c.bid);
                EpiResid E{(float*)(ws + WS_X), modl + 5 * 1024};
                pg8::gemm_phase(c.lds, g, S, E);
                ctx_gemm((const bf16_t*)(ws + WS_P), FF, w, FF, FF, CEpiResid{(float*)(ws + WS_X), modl + 4 * 6144 + 5 * 1024}); }
            GRID_BAR();
        } else {
            const Ctx cm = mk_ctx(c.lds, c.ws);
            moe_table(cm, l >> 1);
            {   unsigned char* ws = c.ws; asm volatile("" : "+s"(ws));
                const bf16_t* w = (const bf16_t*)(ws + WS_W13M) + (size_t)((l >> 1) * NE) * 2 * FF * D;
                pg8::Gemm g{D, D, D}; MoeOrder<true> S; S.init(ws + WS_H, D, w, D, (size_t)2 * FF * D * 2, 2 * FF, c.G, c.bid, (const int*)(ws + WS_TOK), (const LAS unsigned*)(c.lds + MOE_OFF));
                EpiSwiglu E{(bf16_t*)(ws + WS_P)};
                pg8::gemm_phase(c.lds, g, S, E); }
            GRID_BAR();
            {   unsigned char* ws = c.ws; asm volatile("" : "+s"(ws));
                const bf16_t* w = (const bf16_t*)(ws + WS_W2M) + (size_t)((l >> 1) * NE) * D * FF;
                pg8::Gemm g{FF, FF, FF}; MoeOrder<false> S; S.init(ws + WS_P, FF, w, FF, (size_t)D * FF * 2, D, c.G, c.bid, (const int*)(ws + WS_TOK), (const LAS unsigned*)(c.lds + MOE_OFF));
                EpiStoreBf16 E{(bf16_t*)(ws + WS_Y), D};
                pg8::gemm_phase(c.lds, g, S, E); }
            GRID_BAR();
        }
    }
    ph_final(c);
}

extern "C" void kernel_launch(void* const* d_in, const int* in_sizes, int n_in, void* d_out, int out_size, void* d_ws, size_t ws_size, hipStream_t stream) {
    static int grid = 0;
    if (grid == 0) {
        if (n_in != 30 || out_size != TL * D || ws_size < WS_END) { fprintf(stderr, "kernel_launch: unexpected shapes (n_in %d out %d ws %zu)\n", n_in, out_size, ws_size); grid = -1; return; }
        int dev = 0, cus = 0, per_cu = 0; (void)hipGetDevice(&dev); (void)hipDeviceGetAttribute(&cus, hipDeviceAttributeMultiprocessorCount, dev);
        if (hipFuncSetAttribute((const void*)fwd, hipFuncAttributeMaxDynamicSharedMemorySize, LDS_BYTES) != hipSuccess) { fprintf(stderr, "kernel_launch: hipFuncSetAttribute failed\n"); grid = -1; return; }
        if (hipOccupancyMaxActiveBlocksPerMultiprocessor(&per_cu, (const void*)fwd, NTHR, LDS_BYTES) != hipSuccess || per_cu < 1) fprintf(stderr, "kernel_launch: occupancy query reports %d\n", per_cu);
        (void)hipGetLastError();
        grid = cus > 0 ? cus : 256;
    }
    if (grid < 0) return;
    (void)hipMemsetAsync((char*)d_ws + WS_CTL, 0, CTL_ZERO_BYTES, stream);
    Args a{};
    for (int i = 0; i < 30; ++i) a.in[i] = (const float*)d_in[i];
    a.out = (float*)d_out; a.ws = (unsigned char*)d_ws;
    hipLaunchKernelGGL(fwd, dim3(grid), dim3(NTHR), LDS_BYTES, stream, a);
}
```

```cpp
#include <hip/hip_runtime.h>
#include <cstdio>
#include <cstdint>

#define LAS __attribute__((address_space(3)))
#define GAS __attribute__((address_space(1)))
typedef unsigned short bf16_t;
typedef short bf16x8 __attribute__((ext_vector_type(8)));
typedef float f32x4 __attribute__((ext_vector_type(4)));
typedef float f32x2 __attribute__((ext_vector_type(2)));
typedef float f32x16 __attribute__((ext_vector_type(16)));
typedef unsigned u32x4 __attribute__((ext_vector_type(4)));
typedef unsigned u32x2 __attribute__((ext_vector_type(2)));

constexpr int D = 1024, NB = 4, SEQ = 4096, DEPTH = 4, CTX = 256;
constexpr int TL = NB * SEQ, TC = NB * CTX, T = TL + TC;
constexpr int PW = 5120, FF = 2816, NE = 8, HYW = 512;
constexpr int PQ = 0, PK = 512, PV = 1024, PHY = 1536, PGA = 3072, PGB = 4096;
constexpr float EPS = 1e-6f;

constexpr size_t MiB = 1u << 20;
constexpr size_t WS_CTL = 0, CTL_ZERO_BYTES = 1 * MiB;
constexpr size_t WS_MOD = 1 * MiB;
constexpr size_t WS_ROUTE = 2 * MiB;
constexpr size_t WS_RWT = 2 * MiB + 512 * 1024;
constexpr size_t WS_TOK = 3 * MiB;
constexpr int CW_CNT = 8192;
constexpr int MAXSLOT = 36864;
constexpr size_t WS_Y = 660 * MiB;
constexpr size_t WS_WIN = 4 * MiB;
constexpr size_t WS_WPAB = 44 * MiB;
constexpr size_t WS_WO = 52 * MiB;
constexpr size_t WS_W13D = 60 * MiB;
constexpr size_t WS_W2D = 82 * MiB;
constexpr size_t WS_W13M = 93 * MiB;
constexpr size_t WS_W2M = 269 * MiB;
constexpr size_t WS_X = 357 * MiB;
constexpr size_t WS_H = 425 * MiB;
constexpr size_t WS_P = 459 * MiB;
constexpr size_t WS_OAH = 629 * MiB;
constexpr size_t WS_B = 663 * MiB;
constexpr size_t WS_OHT = WS_B + 51 * MiB;
constexpr size_t WS_VT = 748 * MiB;
constexpr size_t WS_HRL = 816 * MiB;
constexpr size_t WS_HRC = 850 * MiB;
constexpr size_t WS_END = 853 * MiB;

constexpr int STAG = 3;
constexpr int LDS_BYTES = 147456;
constexpr int NWAVES = 8, NTHR = 512;

#define LDS_WAIT() asm volatile("s_waitcnt lgkmcnt(0)" ::: "memory")
#define VM_WAIT() asm volatile("s_waitcnt vmcnt(0)" ::: "memory")
__device__ __forceinline__ float bf2f(unsigned b) { return __uint_as_float(b << 16); }
__device__ __forceinline__ float bflo(unsigned w) { return __uint_as_float(w << 16); }
__device__ __forceinline__ float bfhi(unsigned w) { return __uint_as_float(w & 0xffff0000u); }
__device__ __forceinline__ unsigned cvt_pk_bf16(float lo, float hi) { unsigned r; asm volatile("v_cvt_pk_bf16_f32 %0, %1, %2" : "=v"(r) : "v"(lo), "v"(hi)); return r; }
__device__ __forceinline__ float wave_sum(float v, int lane) {
#pragma unroll
    for (int o = 1; o < 64; o <<= 1) v += __int_as_float(__builtin_amdgcn_ds_bpermute((lane ^ o) << 2, __float_as_int(v)));
    return v;
}
__device__ __forceinline__ float sigmoidf_(float x) { return 1.f / (1.f + __expf(-x)); }
__device__ __forceinline__ float sin_rev(float r) { return __builtin_amdgcn_sinf(__builtin_amdgcn_fractf(r)); }
__device__ __forceinline__ float sin_rad(float x) { return sin_rev(x * 0.15915494309189535f); }

namespace pg8 {
constexpr int BM = 256, BK = 64, HALF = 128, HTB = HALF * BK * 2, STAGE_BYTES = 8 * HTB, NXCD = 8, WGM = 8;
__host__ __device__ __forceinline__ int lds_byte(int r, int c) { const int st = (r >> 4) * 2 + (c >> 5), rr = r & 15, cc = c & 31, ob = rr * 64 + cc * 2; return st * 1024 + (ob ^ (((ob >> 9) & 1) << 5)); }
__host__ __device__ __forceinline__ void stage_rc(int b, int& R, int& C) { const int st = b / 1024, sb = b % 1024, swz = sb ^ (((sb >> 9) & 1) << 5); R = (st >> 1) * 16 + swz / 64; C = (st & 1) * 32 + (swz % 64) / 2; }
__host__ __device__ __forceinline__ int perm32(int rho) { const int n = rho >> 4, i = rho & 15; return 8 * (i >> 2) + 4 * n + (i & 3); }

struct Unit { int pm, pn; const GAS char* a; const GAS char* b; const GAS int* tk; int nvalid; };
struct Gemm { int K, lda, ldb; int stagger = 0; };

struct StaticOrder {
    int nM, nN, nwg, G, c; const GAS char* A; const GAS char* B; size_t astep, bstep;
    __device__ void init(const GAS void* A_, int lda, const GAS void* B_, int ldb, int M, int N, int G_, int c_) {
        nM = M / BM; nN = N / BM; nwg = nM * nN; G = G_; c = c_; A = (const GAS char*)A_; B = (const GAS char*)B_; astep = (size_t)BM * lda * 2; bstep = (size_t)BM * ldb * 2; }
    __device__ bool next(int i, Unit& u) const {
        const long L = (long)i * G + c; if (L >= nwg) return false;
        int wgid = (int)L; { const int q = nwg / NXCD, r = nwg % NXCD, xcd = wgid % NXCD, off = wgid / NXCD; wgid = (xcd < r ? xcd * (q + 1) : r * (q + 1) + (xcd - r) * q) + off; }
        const int nig = WGM * nN, gid = wgid / nig, fm = gid * WGM, gsz = (nM - fm) < WGM ? (nM - fm) : WGM;
        u.pm = fm + ((wgid % nig) % gsz); u.pn = (wgid % nig) / gsz; u.a = A + (size_t)u.pm * astep; u.b = B + (size_t)u.pn * bstep; return true;
    }
    static constexpr bool GATHER = false;
    __device__ __forceinline__ int arow(const Unit&, int) const { return 0; }
    __device__ __forceinline__ void a_ready(const Unit&) const {}
    __device__ __forceinline__ void done(const Unit&) const {}
};

template <class Epi, class Sched, bool ALIGN_EPI = true>
__device__ __forceinline__ void gemm_phase(LAS unsigned char* lds, const Gemm g, const Sched& S, const Epi& E) {
    int tid = threadIdx.x; asm volatile("" : "+v"(tid));
    const int wid = __builtin_amdgcn_readfirstlane(tid >> 6), lane = tid & 63, wr = wid >> 2, wc = wid & 3, fr = lane & 15, fq = lane >> 4;
    const int K = g.K, nt = K / BK;
    constexpr bool GATHER = Sched::GATHER;
    unsigned voffB[2]; unsigned cA0[2], cA1[2], nA0[2], nA1[2]; int RA[2], CA[2];
    const size_t hstepA = (size_t)HALF * g.lda * 2, hstepB = (size_t)HALF * g.ldb * 2;
#pragma unroll
    for (int i = 0; i < 2; ++i) { int R, C; stage_rc(tid * 16 + i * 8192, R, C); const int Rb = Epi::PERM ? ((R & ~31) + perm32(R & 31)) : R;
        RA[i] = R; CA[i] = C; voffB[i] = (unsigned)(Rb * g.ldb + C) * 2u;
        cA0[i] = (unsigned)(R * g.lda + C) * 2u; cA1[i] = cA0[i]; nA0[i] = cA0[i]; nA1[i] = cA0[i]; }
    const size_t h1A = GATHER ? 0 : hstepA;
    const size_t kstep = (size_t)(BK * 2);
    const unsigned ldsw = (unsigned)wid * 1024u;
    const int aoff = lds_byte(wr * 64 + fr, fq * 8), boff = lds_byte(wc * 32 + fr, fq * 8);
#define PG8_SA(b, h) (((b) * 2 + (h)) * HTB)
#define PG8_SB(b, h) ((4 + (b) * 2 + (h)) * HTB)
#define PG8_STAGE(bufoff, gbase, voff) do { _Pragma("unroll") for (int _i = 0; _i < 2; ++_i) \
        __builtin_amdgcn_global_load_lds((const GAS unsigned*)((const GAS char*)(gbase) + (voff)[_i]), (LAS unsigned*)(lds + (bufoff) + ldsw + _i * 8192), 16, 0, 0); } while (0)
#define PG8_LDA(dst, b, h) do { _Pragma("unroll") for (int m = 0; m < 4; ++m) _Pragma("unroll") for (int k = 0; k < 2; ++k) dst[m][k] = *(const LAS bf16x8*)(lds + PG8_SA(b, h) + aoff + m * 2048 + k * 1024); } while (0)
#define PG8_LDB(dst, b, h) do { _Pragma("unroll") for (int n = 0; n < 2; ++n) _Pragma("unroll") for (int k = 0; k < 2; ++k) dst[n][k] = *(const LAS bf16x8*)(lds + PG8_SB(b, h) + boff + n * 2048 + k * 1024); } while (0)
#define PG8_MMA(ai, bj, At, Bt) do { __builtin_amdgcn_s_setprio(1); _Pragma("unroll") for (int m = 0; m < 4; ++m) _Pragma("unroll") for (int n = 0; n < 2; ++n) _Pragma("unroll") for (int k = 0; k < 2; ++k) \
        acc[ai][bj][m][n] = __builtin_amdgcn_mfma_f32_16x16x32_bf16(Bt[n][k], At[m][k], acc[ai][bj][m][n], 0, 0, 0); __builtin_amdgcn_s_setprio(0); } while (0)
#define PG8_WAIT_V(n) asm volatile("s_waitcnt vmcnt(" #n ")" ::: "memory")
#define PG8_WAIT_L(n) asm volatile("s_waitcnt lgkmcnt(" #n ")" ::: "memory")
#define PG8_BAR __builtin_amdgcn_s_barrier()
#define PG8_SCHED __builtin_amdgcn_sched_barrier(0)
    Unit cur, nxt; int ui = 0;
    if (!S.next(0, cur)) return;
    if (g.stagger > 0) {
        const int slot = (blockIdx.x >> 3) & 7;
        int steps = slot * g.stagger;
        for (int i = 0; i < steps; ++i) __builtin_amdgcn_s_sleep(16);
    }
    if constexpr (GATHER) {
#pragma unroll
        for (int i = 0; i < 2; ++i) { cA0[i] = (unsigned)(S.arow(cur, RA[i]) * g.lda + CA[i]) * 2u; cA1[i] = (unsigned)(S.arow(cur, HALF + RA[i]) * g.lda + CA[i]) * 2u; }
    }
    f32x4 acc[2][2][4][2];
#pragma unroll
    for (int a = 0; a < 2; ++a)
#pragma unroll
        for (int b = 0; b < 2; ++b)
#pragma unroll
            for (int m = 0; m < 4; ++m)
#pragma unroll
                for (int n = 0; n < 2; ++n) acc[a][b][m][n] = (f32x4){0.f, 0.f, 0.f, 0.f};
    bf16x8 At[4][2], B0[2][2], B1[2][2];
    const GAS char* cA = cur.a; const GAS char* cB = cur.b;
    S.a_ready(cur);
    PG8_STAGE(PG8_SB(0, 0), cB, voffB); PG8_STAGE(PG8_SB(0, 1), cB + hstepB, voffB); PG8_STAGE(PG8_SA(0, 0), cA, cA0); PG8_STAGE(PG8_SA(0, 1), cA + h1A, cA1);
    if (wr == 1) PG8_BAR;
    PG8_WAIT_V(2); PG8_BAR;
    PG8_STAGE(PG8_SB(1, 0), cB + kstep, voffB); PG8_STAGE(PG8_SA(1, 0), cA + kstep, cA0); PG8_STAGE(PG8_SB(1, 1), cB + hstepB + kstep, voffB);
    PG8_WAIT_V(6); PG8_BAR;
    for (;;) {
        const bool has_next = S.next(ui + 1, nxt);
        const GAS char* nA = has_next ? nxt.a : cA; const GAS char* nB = has_next ? nxt.b : cB;
        if constexpr (GATHER) {
#pragma unroll
            for (int i = 0; i < 2; ++i) { nA0[i] = has_next ? (unsigned)(S.arow(nxt, RA[i]) * g.lda + CA[i]) * 2u : cA0[i]; nA1[i] = has_next ? (unsigned)(S.arow(nxt, HALF + RA[i]) * g.lda + CA[i]) * 2u : cA1[i]; }
        }
        for (int kh = 0; kh < (Epi::MIDK ? 2 : 1); ++kh) {
        const int tb = Epi::MIDK ? kh * (nt / 2) : 0, te = Epi::MIDK ? tb + nt / 2 : nt;
        for (int t = tb; t < te; t += 2) {
            const bool last = (t == nt - 2);
            const GAS char* a1 = cA + (size_t)(t + 1) * kstep;
            const GAS char* a2 = last ? nA : cA + (size_t)(t + 2) * kstep; const GAS char* b2 = last ? nB : cB + (size_t)(t + 2) * kstep;
            const GAS char* a3 = a2 + kstep; const GAS char* b3 = b2 + kstep;
            unsigned x0[2], x1[2];
#pragma unroll
            for (int i = 0; i < 2; ++i) { x0[i] = (GATHER && last) ? nA0[i] : cA0[i]; x1[i] = GATHER ? (last ? nA1[i] : cA1[i]) : cA0[i]; }
            if (last && has_next) S.a_ready(nxt);
            PG8_LDB(B0, 0, 0); PG8_LDB(B1, 0, 1); PG8_SCHED; PG8_LDA(At, 0, 0); PG8_STAGE(PG8_SA(1, 1), a1 + h1A, cA1);
            PG8_WAIT_V(8); PG8_WAIT_L(0); PG8_BAR; PG8_MMA(0, 0, At, B0); PG8_MMA(0, 1, At, B1); PG8_BAR; PG8_SCHED;
            PG8_LDA(At, 0, 1); PG8_STAGE(PG8_SB(0, 0), b2, voffB); PG8_STAGE(PG8_SB(0, 1), b2 + hstepB, voffB); PG8_STAGE(PG8_SA(0, 0), a2, x0);
            PG8_WAIT_V(8); PG8_WAIT_L(0); PG8_BAR; PG8_MMA(1, 0, At, B0); PG8_MMA(1, 1, At, B1); PG8_BAR; PG8_SCHED;
            PG8_LDB(B0, 1, 0); PG8_LDB(B1, 1, 1); PG8_SCHED; PG8_LDA(At, 1, 0); PG8_STAGE(PG8_SA(0, 1), a2 + h1A, x1);
            PG8_WAIT_V(8); PG8_WAIT_L(0); PG8_BAR; PG8_MMA(0, 0, At, B0); PG8_MMA(0, 1, At, B1); PG8_BAR; PG8_SCHED;
            PG8_LDA(At, 1, 1); PG8_STAGE(PG8_SB(1, 0), b3, voffB); PG8_STAGE(PG8_SB(1, 1), b3 + hstepB, voffB); PG8_STAGE(PG8_SA(1, 0), a3, x0);
            PG8_WAIT_V(8); PG8_WAIT_L(0); PG8_BAR; PG8_MMA(1, 0, At, B0); PG8_MMA(1, 1, At, B1); PG8_BAR; PG8_SCHED;
        }
        if constexpr (Epi::MIDK) { if (kh == 0) E.mid(acc, cur, wr, wc, fr, fq); }
        }
        if constexpr (ALIGN_EPI) { if (wr == 0) PG8_BAR; }
        E(acc, cur, wr, wc, fr, fq); S.done(cur);
        if (!has_next) break;
#pragma unroll
        for (int a = 0; a < 2; ++a)
#pragma unroll
            for (int b = 0; b < 2; ++b)
#pragma unroll
                for (int m = 0; m < 4; ++m)
#pragma unroll
                    for (int n = 0; n < 2; ++n) acc[a][b][m][n] = (f32x4){0.f, 0.f, 0.f, 0.f};
        cur = nxt; cA = nA; cB = nB; ++ui;
        if constexpr (GATHER) {
#pragma unroll
            for (int i = 0; i < 2; ++i) { cA0[i] = nA0[i]; cA1[i] = nA1[i]; }
        }
        if constexpr (ALIGN_EPI) { if (wr == 1) PG8_BAR; }
    }
    PG8_WAIT_V(0);
    if constexpr (!ALIGN_EPI) { if (wr == 0) PG8_BAR; }
    PG8_BAR;
#undef PG8_SA
#undef PG8_SB
#undef PG8_STAGE
#undef PG8_LDA
#undef PG8_LDB
#undef PG8_MMA
#undef PG8_WAIT_V
#undef PG8_WAIT_L
#undef PG8_BAR
#undef PG8_SCHED
}
}

typedef f32x4 AccT[2][2][4][2];
struct EpiStoreBf16 {
    static constexpr bool PERM = true, MIDK = false;
    GAS bf16_t* O; int ldc;
    __device__ __forceinline__ void operator()(const AccT& acc, const pg8::Unit& u, int wr, int wc, int fr, int fq) const {
        const int row0 = u.pm * 256 + wr * 64 + fr, col0 = u.pn * 256 + wc * 32 + 8 * fq;
#pragma unroll
        for (int ai = 0; ai < 2; ++ai)
#pragma unroll
            for (int m = 0; m < 4; ++m) { GAS bf16_t* rowp = O + (size_t)(row0 + ai * 128 + m * 16) * ldc + col0;
#pragma unroll
                for (int bj = 0; bj < 2; ++bj) { const f32x4 v0 = acc[ai][bj][m][0], v1 = acc[ai][bj][m][1];
                    u32x4 w; w.x = cvt_pk_bf16(v0[0], v0[1]); w.y = cvt_pk_bf16(v0[2], v0[3]); w.z = cvt_pk_bf16(v1[0], v1[1]); w.w = cvt_pk_bf16(v1[2], v1[3]);
                    *(GAS u32x4*)(rowp + bj * 128) = w; } }
    }
};
__device__ __forceinline__ float merge_ratio(float ga, float gb) { return (1.f + __expf(-fmaxf(gb, -80.f))) / (1.f + __expf(-ga)); }
__device__ __forceinline__ float merge_final(float gb) { return 1.f / (1.f + __expf(-fmaxf(gb, -80.f))); }
struct EpiMergeK {
    static constexpr bool PERM = true, MIDK = true;
    const GAS bf16_t* P; GAS bf16_t* O;
    __device__ __forceinline__ void mid(AccT& acc, const pg8::Unit& u, int wr, int wc, int fr, int fq) const {
        asm volatile("" : "+v"(fr), "+v"(fq));
        const int row0 = u.pm * 256 + wr * 64 + fr, col0 = u.pn * 256 + wc * 32 + 8 * fq;
#pragma unroll
        for (int ai = 0; ai < 2; ++ai)
#pragma unroll
            for (int m = 0; m < 4; ++m) { const int r = row0 + ai * 128 + m * 16;
#pragma unroll
                for (int bj = 0; bj < 2; ++bj) { const int c = col0 + bj * 128;
                    const u32x4 a = *(const GAS u32x4*)(P + (size_t)r * PW + PGA + c), b = *(const GAS u32x4*)(P + (size_t)r * PW + PGB + c);
                    acc[ai][bj][m][0][0] *= merge_ratio(bflo(a.x), bflo(b.x)); acc[ai][bj][m][0][1] *= merge_ratio(bfhi(a.x), bfhi(b.x));
                    acc[ai][bj][m][0][2] *= merge_ratio(bflo(a.y), bflo(b.y)); acc[ai][bj][m][0][3] *= merge_ratio(bfhi(a.y), bfhi(b.y));
                    acc[ai][bj][m][1][0] *= merge_ratio(bflo(a.z), bflo(b.z)); acc[ai][bj][m][1][1] *= merge_ratio(bfhi(a.z), bfhi(b.z));
                    acc[ai][bj][m][1][2] *= merge_ratio(bflo(a.w), bflo(b.w)); acc[ai][bj][m][1][3] *= merge_ratio(bfhi(a.w), bfhi(b.w)); } }
    }
    __device__ __forceinline__ void operator()(const AccT& acc, const pg8::Unit& u, int wr, int wc, int fr, int fq) const {
        asm volatile("" : "+v"(fr), "+v"(fq));
        const int row0 = u.pm * 256 + wr * 64 + fr, col0 = u.pn * 256 + wc * 32 + 8 * fq;
#pragma unroll
        for (int ai = 0; ai < 2; ++ai)
#pragma unroll
            for (int m = 0; m < 4; ++m) { const int r = row0 + ai * 128 + m * 16;
#pragma unroll
                for (int bj = 0; bj < 2; ++bj) { const int c = col0 + bj * 128;
                    const u32x4 b = *(const GAS u32x4*)(P + (size_t)r * PW + PGB + c);
                    const f32x4 v0 = acc[ai][bj][m][0], v1 = acc[ai][bj][m][1];
                    u32x4 w; w.x = cvt_pk_bf16(v0[0] * merge_final(bflo(b.x)), v0[1] * merge_final(bfhi(b.x))); w.y = cvt_pk_bf16(v0[2] * merge_final(bflo(b.y)), v0[3] * merge_final(bfhi(b.y)));
                    w.z = cvt_pk_bf16(v1[0] * merge_final(bflo(b.z)), v1[1] * merge_final(bfhi(b.z))); w.w = cvt_pk_bf16(v1[2] * merge_final(bflo(b.w)), v1[3] * merge_final(bfhi(b.w)));
                    *(GAS u32x4*)(O + (size_t)r * D + c) = w; } }
    }
};
struct EpiResid {
    static constexpr bool PERM = false, MIDK = false;
    GAS float* x; const GAS float* gate;
    __device__ __forceinline__ void operator()(const AccT& acc, const pg8::Unit& u, int wr, int wc, int fr, int fq) const {
        const int row0 = u.pm * 256 + wr * 64 + fr, col0 = u.pn * 256 + wc * 32 + 4 * fq;
        const int b = (u.pm < 64) ? (u.pm >> 4) : 4;
        const GAS float* gp = gate + (size_t)b * 6144 + col0;
        f32x4 gv[2][2];
#pragma unroll
        for (int bj = 0; bj < 2; ++bj)
#pragma unroll
            for (int n = 0; n < 2; ++n) gv[bj][n] = *(const GAS f32x4*)(gp + bj * 128 + n * 16);
#pragma unroll
        for (int ai = 0; ai < 2; ++ai)
#pragma unroll
            for (int m = 0; m < 4; ++m) { const int r = row0 + ai * 128 + m * 16; GAS float* rowp = x + (size_t)r * D + col0;
#pragma unroll
                for (int bj = 0; bj < 2; ++bj)
#pragma unroll
                    for (int n = 0; n < 2; ++n) { GAS float* p = rowp + bj * 128 + n * 16; *(GAS f32x4*)p = *(const GAS f32x4*)p + gv[bj][n] * acc[ai][bj][m][n]; } }
    }
};
struct EpiSwiglu {
    static constexpr bool PERM = true, MIDK = false;
    GAS bf16_t* O;
    __device__ __forceinline__ void operator()(const AccT& acc, const pg8::Unit& u, int wr, int wc, int fr, int fq) const {
        const int row0 = u.pm * 256 + wr * 64 + fr, col0 = u.pn * 128 + wc * 32 + 8 * fq;
#pragma unroll
        for (int ai = 0; ai < 2; ++ai)
#pragma unroll
            for (int m = 0; m < 4; ++m) { const int r = row0 + ai * 128 + m * 16;
                float o[8];
#pragma unroll
                for (int n = 0; n < 2; ++n)
#pragma unroll
                    for (int j = 0; j < 4; ++j) { const float a = acc[ai][0][m][n][j], g = acc[ai][1][m][n][j]; o[n * 4 + j] = a * sigmoidf_(a) * g; }
                u32x4 w; w.x = cvt_pk_bf16(o[0], o[1]); w.y = cvt_pk_bf16(o[2], o[3]); w.z = cvt_pk_bf16(o[4], o[5]); w.w = cvt_pk_bf16(o[6], o[7]);
                *(GAS u32x4*)(O + (size_t)r * FF + col0) = w; }
    }
};

struct CEpiMergeK { const GAS bf16_t* P; GAS bf16_t* O; static constexpr bool MIDK = true;
    __device__ __forceinline__ void mid(f32x4& acc, int r, int c) const { const u32x2 a = *(const GAS u32x2*)(P + (size_t)r * PW + PGA + c), b = *(const GAS u32x2*)(P + (size_t)r * PW + PGB + c);
        acc[0] *= merge_ratio(bflo(a.x), bflo(b.x)); acc[1] *= merge_ratio(bfhi(a.x), bfhi(b.x)); acc[2] *= merge_ratio(bflo(a.y), bflo(b.y)); acc[3] *= merge_ratio(bfhi(a.y), bfhi(b.y)); }
    __device__ __forceinline__ void operator()(const f32x4& acc, int r, int c) const { const u32x2 b = *(const GAS u32x2*)(P + (size_t)r * PW + PGB + c);
        u32x2 w; w.x = cvt_pk_bf16(acc[0] * merge_final(bflo(b.x)), acc[1] * merge_final(bfhi(b.x))); w.y = cvt_pk_bf16(acc[2] * merge_final(bflo(b.y)), acc[3] * merge_final(bfhi(b.y)));
        *(GAS u32x2*)(O + (size_t)r * D + c) = w; } };
struct CEpiResid { GAS float* x; const GAS float* gate; static constexpr bool MIDK = false;
    __device__ __forceinline__ void mid(f32x4&, int, int) const {}
    __device__ __forceinline__ void operator()(const f32x4& acc, int r, int c) const { GAS float* p = x + (size_t)r * D + c; *(GAS f32x4*)p = *(const GAS f32x4*)p + *(const GAS f32x4*)(gate + c) * acc; } };
template <class Epi>
__device__ __forceinline__ void ctx_gemm(const GAS bf16_t* X, int ldx, const GAS bf16_t* Wt, int ldw, int K, const Epi& E) {
    int tid = threadIdx.x; asm volatile("" : "+v"(tid));
    const int wave = tid >> 6, lane = tid & 63, li = lane & 15, kg = lane >> 4;
    for (int tile = blockIdx.x; tile < 256; tile += gridDim.x) {
        const int row0 = TL + (tile >> 2) * 16, col0 = (tile & 3) * 256 + wave * 32;
        const GAS bf16_t* xp = X + (size_t)(row0 + li) * ldx + 8 * kg;
        const GAS bf16_t* w0 = Wt + (size_t)(col0 + li) * ldw + 8 * kg; const GAS bf16_t* w1 = w0 + (size_t)16 * ldw;
        f32x4 acc0 = (f32x4){0.f, 0.f, 0.f, 0.f}, acc1 = acc0;
        const int Kh = Epi::MIDK ? K / 2 : K;
#pragma unroll 8
        for (int k0 = 0; k0 < Kh; k0 += 32) {
            const bf16x8 xf = *(const GAS bf16x8*)(xp + k0), b0 = *(const GAS bf16x8*)(w0 + k0), b1 = *(const GAS bf16x8*)(w1 + k0);
            acc0 = __builtin_amdgcn_mfma_f32_16x16x32_bf16(b0, xf, acc0, 0, 0, 0);
            acc1 = __builtin_amdgcn_mfma_f32_16x16x32_bf16(b1, xf, acc1, 0, 0, 0);
        }
        if constexpr (Epi::MIDK) {
            E.mid(acc0, row0 + li, col0 + 4 * kg); E.mid(acc1, row0 + li, col0 + 16 + 4 * kg);
#pragma unroll 8
            for (int k0 = Kh; k0 < K; k0 += 32) {
                const bf16x8 xf = *(const GAS bf16x8*)(xp + k0), b0 = *(const GAS bf16x8*)(w0 + k0), b1 = *(const GAS bf16x8*)(w1 + k0);
                acc0 = __builtin_amdgcn_mfma_f32_16x16x32_bf16(b0, xf, acc0, 0, 0, 0);
                acc1 = __builtin_amdgcn_mfma_f32_16x16x32_bf16(b1, xf, acc1, 0, 0, 0);
            }
        }
        E(acc0, row0 + li, col0 + 4 * kg); E(acc1, row0 + li, col0 + 16 + 4 * kg);
    }
}

struct Args { const float* in[30]; float* out; unsigned char* ws; int l, e, ph, pad; };
enum { I_X = 0, I_C, I_CTX, I_CCTX, I_WMOD, I_BMOD, I_N1G, I_N2G, I_WIN, I_RPB, I_HCW, I_HCB, I_HW1, I_HB1, I_HW2, I_HB2, I_HW3, I_HFREQ, I_HBIAS,
       I_WPA, I_WPB, I_WO, I_FW1, I_FW3, I_FW2, I_ROUTER, I_MW1, I_MW3, I_MW2, I_FINALG };

constexpr int MISC_OFF = 131072 + 320;
constexpr int PTR_OFF = MISC_OFF + 128;
struct Ctx {
    LAS unsigned char* lds; int tid, lane, wave, G, bid; GAS unsigned char* ws;
};
__device__ __forceinline__ Ctx mk_ctx(LAS unsigned char* lds, GAS unsigned char* ws) {
    Ctx c; int t = threadIdx.x; asm volatile("" : "+v"(t)); asm volatile("" : "+s"(ws)); c.lds = lds; c.tid = t; c.lane = t & 63; c.wave = __builtin_amdgcn_readfirstlane(t >> 6); c.G = gridDim.x; c.bid = blockIdx.x; c.ws = ws; return c;
}
__device__ __forceinline__ const GAS float* inp(const Ctx& c, int i) {
    unsigned ao = (unsigned)(PTR_OFF + 8 * i); asm volatile("" : "+v"(ao));
    const volatile LAS unsigned* p = (const volatile LAS unsigned*)(c.lds + ao);
    const unsigned lo = __builtin_amdgcn_readfirstlane(p[0]), hi = __builtin_amdgcn_readfirstlane(p[1]);
    return (const GAS float*)(((unsigned long long)hi << 32) | (unsigned long long)lo);
}

__device__ __forceinline__ void transpose_item(const GAS float* W, int N, GAS bf16_t* WT, int ldk, int k0, int n0, int drow0, LAS float* scr, int lane) {
    float wv[32];
    const GAS float* wp = W + (size_t)(k0 + (lane >> 5)) * N + n0 + (lane & 31);
#pragma unroll
    for (int i = 0; i < 32; ++i) wv[i] = wp[(size_t)(2 * i) * N];
#pragma unroll
    for (int i = 0; i < 32; ++i) scr[(2 * i + (lane >> 5)) * 33 + (lane & 31)] = wv[i];
    LDS_WAIT(); asm volatile("" ::: "memory");
    const int c = lane & 7;
#pragma unroll
    for (int j = 0; j < 4; ++j) { const int n = (lane >> 3) + 8 * j; const LAS float* s = scr + (8 * c) * 33 + n;
        u32x4 o; o.x = cvt_pk_bf16(s[0 * 33], s[1 * 33]); o.y = cvt_pk_bf16(s[2 * 33], s[3 * 33]); o.z = cvt_pk_bf16(s[4 * 33], s[5 * 33]); o.w = cvt_pk_bf16(s[6 * 33], s[7 * 33]);
        *(GAS u32x4*)(WT + (size_t)(drow0 + n) * ldk + k0 + 8 * c) = o; }
    LDS_WAIT(); asm volatile("" ::: "memory");
}
__device__ __forceinline__ void conv_mat(const GAS float* W, int K, int N, GAS bf16_t* WT, int mode, int& base, int gw, int NGW, LAS float* scr, int lane, int ldk = 0) {
    if (ldk == 0) ldk = K;
    const int nblk = N / 32, nitems = (K / 64) * nblk;
    const int start = (gw - (base % NGW) + NGW) % NGW;
    for (int it = start; it < nitems; it += NGW) {
        const int kb = it / nblk, nb = it % nblk, n0 = nb * 32;
        const int drow0 = mode == 0 ? n0 : ((n0 >> 7) * 256 + (n0 & 127) + (mode == 2 ? 128 : 0));
        transpose_item(W, N, WT, ldk, kb * 64, n0, drow0, scr, lane);
    }
    base += nitems;
}
__device__ __forceinline__ void ph_convert(const Ctx& c0) {
    const Ctx c = mk_ctx(c0.lds, c0.ws);
    GAS unsigned char* ws = c.ws;
    LAS float* scr = (LAS float*)(c.lds + c.wave * 16384);
    const int gw = c.bid * NWAVES + c.wave, NGW = c.G * NWAVES; int base = 0;
    for (int l = 0; l < DEPTH; ++l) {
        conv_mat(inp(c, I_WIN) + (size_t)l * D * PW, D, PW, (GAS bf16_t*)(ws + WS_WIN) + (size_t)l * PW * D, 0, base, gw, NGW, scr, c.lane);
        conv_mat(inp(c, I_WPA) + (size_t)l * 512 * D, 512, D, (GAS bf16_t*)(ws + WS_WPAB) + (size_t)l * D * D, 0, base, gw, NGW, scr, c.lane, D);
        conv_mat(inp(c, I_WPB) + (size_t)l * 512 * D, 512, D, (GAS bf16_t*)(ws + WS_WPAB) + (size_t)l * D * D + 512, 0, base, gw, NGW, scr, c.lane, D);
        conv_mat(inp(c, I_WO) + (size_t)l * D * D, D, D, (GAS bf16_t*)(ws + WS_WO) + (size_t)l * D * D, 0, base, gw, NGW, scr, c.lane);
    }
    for (int i = 0; i < 2; ++i) {
        conv_mat(inp(c, I_FW1) + (size_t)i * D * FF, D, FF, (GAS bf16_t*)(ws + WS_W13D) + (size_t)i * 2 * FF * D, 1, base, gw, NGW, scr, c.lane);
        conv_mat(inp(c, I_FW3) + (size_t)i * D * FF, D, FF, (GAS bf16_t*)(ws + WS_W13D) + (size_t)i * 2 * FF * D, 2, base, gw, NGW, scr, c.lane);
        conv_mat(inp(c, I_FW2) + (size_t)i * FF * D, FF, D, (GAS bf16_t*)(ws + WS_W2D) + (size_t)i * D * FF, 0, base, gw, NGW, scr, c.lane);
    }
    for (int ie = 0; ie < 2 * NE; ++ie) {
        conv_mat(inp(c, I_MW1) + (size_t)ie * D * FF, D, FF, (GAS bf16_t*)(ws + WS_W13M) + (size_t)ie * 2 * FF * D, 1, base, gw, NGW, scr, c.lane);
        conv_mat(inp(c, I_MW3) + (size_t)ie * D * FF, D, FF, (GAS bf16_t*)(ws + WS_W13M) + (size_t)ie * 2 * FF * D, 2, base, gw, NGW, scr, c.lane);
        conv_mat(inp(c, I_MW2) + (size_t)ie * FF * D, FF, D, (GAS bf16_t*)(ws + WS_W2M) + (size_t)ie * D * FF, 0, base, gw, NGW, scr, c.lane);
    }
}

__device__ __forceinline__ void ph_mod(const Ctx& c0) {
    const Ctx c = mk_ctx(c0.lds, c0.ws);
    GAS float* mod = (GAS float*)(c.ws + WS_MOD);
    LAS float* s = (LAS float*)c.lds; LAS float* part = s + 5 * 1024;
    const GAS float* cin = inp(c, I_C); const GAS float* cctx = inp(c, I_CCTX); const GAS float* wmod = inp(c, I_WMOD); const GAS float* bmod = inp(c, I_BMOD);
    for (int i = c.tid; i < 5 * 1024; i += NTHR) { const int r = i >> 10, k = i & 1023; const float v = r < 4 ? cin[r * 1024 + k] : cctx[k]; s[i] = v * sigmoidf_(v); }
    __syncthreads();
    for (int unit = c.bid; unit < DEPTH * 96; unit += c.G) {
        const int l = unit / 96, j0 = (unit % 96) * 64;
        const GAS float* w = wmod + (size_t)l * D * 6144 + j0 + c.lane;
        float acc[5] = {0.f, 0.f, 0.f, 0.f, 0.f};
        const int kb = c.wave * 128;
#pragma unroll 32
        for (int k = 0; k < 128; ++k) { const float wv = w[(size_t)(kb + k) * 6144];
#pragma unroll
            for (int r = 0; r < 5; ++r) acc[r] += s[r * 1024 + kb + k] * wv; }
#pragma unroll
        for (int r = 0; r < 5; ++r) part[(c.wave * 5 + r) * 64 + c.lane] = acc[r];
        __syncthreads();
        if (c.tid < 320) { const int r = c.tid >> 6, ln = c.tid & 63; float sum = 0.f;
#pragma unroll
            for (int w8 = 0; w8 < 8; ++w8) sum += part[(w8 * 5 + r) * 64 + ln];
            mod[(size_t)(l * 5 + r) * 6144 + j0 + ln] = sum + bmod[l * 6144 + j0 + ln]; }
        __syncthreads();
    }
}

__device__ __forceinline__ void ph_filt(const Ctx& c0) {
    const Ctx c = mk_ctx(c0.lds, c0.ws);
    const GAS float* hb1 = inp(c, I_HB1); const GAS float* hw1 = inp(c, I_HW1); const GAS float* hb2 = inp(c, I_HB2); const GAS float* hw2 = inp(c, I_HW2); const GAS float* hfreq = inp(c, I_HFREQ); const GAS float* hw3 = inp(c, I_HW3);
    LAS float* zb = (LAS float*)c.lds;
    LAS float* a1 = zb + 16 * 36;
    LAS float* a2 = a1 + 16 * 64;
    const float MINDEC = -3.0701134573253945f, MAXDEC = -15.350567286626973f;
    for (int unit = c.bid; unit < DEPTH * 272; unit += c.G) {
        const int l = unit / 272, uu = unit % 272;
        const int L = uu < 256 ? 4096 : 256, p0 = uu < 256 ? uu * 16 : (uu - 256) * 16;
        for (int i = c.tid; i < 16 * 33; i += NTHR) { const int p = i / 33, q = i % 33; const int pos = p0 + p; float v;
            if (q == 0) v = (float)pos / (float)(L - 1);
            else { const int j = (q - 1) & 15; const double band = 1e-4 + (double)j * ((15.0 - 1e-4) / 15.0); double rev = (double)pos * band / (double)L; rev -= floor(rev);
                v = q <= 16 ? __builtin_amdgcn_cosf((float)rev) : -__builtin_amdgcn_sinf((float)rev); }
            zb[p * 36 + q] = v; }
        __syncthreads();
        for (int i = c.tid; i < 16 * 64; i += NTHR) { const int p = i >> 6, j = i & 63; float s = hb1[l * 64 + j];
            const GAS float* w = hw1 + (size_t)l * 33 * 64 + j;
            for (int q = 0; q < 33; ++q) s += zb[p * 36 + q] * w[q * 64];
            a1[p * 64 + j] = sin_rad(hfreq[l * 128 + j] * s); }
        __syncthreads();
        for (int i = c.tid; i < 16 * 64; i += NTHR) { const int p = i >> 6, j = i & 63; float s = hb2[l * 64 + j];
            const GAS float* w = hw2 + (size_t)l * 64 * 64 + j;
            for (int q = 0; q < 64; ++q) s += a1[p * 64 + q] * w[q * 64];
            a2[p * 64 + j] = sin_rad(hfreq[l * 128 + 64 + j] * s); }
        __syncthreads();
        {
            float acc0[16], acc1[16];
#pragma unroll
            for (int p = 0; p < 16; ++p) { acc0[p] = 0.f; acc1[p] = 0.f; }
            const GAS float* w3 = hw3 + (size_t)l * 64 * 1024 + c.tid;
            for (int k = 0; k < 64; ++k) { const float wa = w3[k * 1024], wb = w3[k * 1024 + 512];
#pragma unroll
                for (int p = 0; p < 16; ++p) { const float av = a2[p * 64 + k]; acc0[p] += av * wa; acc1[p] += av * wb; } }
            GAS bf16_t* hro = uu < 256 ? (GAS bf16_t*)(c.ws + WS_HRL) + ((size_t)(l * 2) * 512 + c.tid) * (4096 + 64) : (GAS bf16_t*)(c.ws + WS_HRC) + ((size_t)(l * 2) * 512 + c.tid) * (256 + 64);
            const size_t ostride = (size_t)512 * (L + 64);
            float f0[16], f1[16];
            const float r0 = fabsf(MINDEC + (float)c.tid * ((MAXDEC - MINDEC) / 1023.f)), r1 = fabsf(MINDEC + (float)(c.tid + 512) * ((MAXDEC - MINDEC) / 1023.f));
#pragma unroll
            for (int p = 0; p < 16; ++p) { const int pos = p0 + p; const float dist = fabsf((float)(pos - L / 2)) * (2.f / (float)L);
                f0[p] = acc0[p] * (__expf(-dist * r0) + 0.05f); f1[p] = acc1[p] * (__expf(-dist * r1) + 0.05f); }
            {   u32x4 w0, w1, v0, v1;
                w0.x = cvt_pk_bf16(f0[15], f0[14]); w0.y = cvt_pk_bf16(f0[13], f0[12]); w0.z = cvt_pk_bf16(f0[11], f0[10]); w0.w = cvt_pk_bf16(f0[9], f0[8]);
                w1.x = cvt_pk_bf16(f0[7], f0[6]); w1.y = cvt_pk_bf16(f0[5], f0[4]); w1.z = cvt_pk_bf16(f0[3], f0[2]); w1.w = cvt_pk_bf16(f0[1], f0[0]);
                v0.x = cvt_pk_bf16(f1[15], f1[14]); v0.y = cvt_pk_bf16(f1[13], f1[12]); v0.z = cvt_pk_bf16(f1[11], f1[10]); v0.w = cvt_pk_bf16(f1[9], f1[8]);
                v1.x = cvt_pk_bf16(f1[7], f1[6]); v1.y = cvt_pk_bf16(f1[5], f1[4]); v1.z = cvt_pk_bf16(f1[3], f1[2]); v1.w = cvt_pk_bf16(f1[1], f1[0]);
                GAS bf16_t* d0 = hro + (L + 16 - p0); GAS bf16_t* d1 = d0 + ostride;
                *(GAS u32x4*)d0 = w0; *(GAS u32x4*)(d0 + 8) = w1; *(GAS u32x4*)d1 = v0; *(GAS u32x4*)(d1 + 8) = v1;
                const u32x4 z4 = (u32x4){0u, 0u, 0u, 0u};
                if (p0 == 0) { for (int k = 0; k < 4; ++k) { *(GAS u32x4*)(hro + L + 32 + 8 * k) = z4; *(GAS u32x4*)(hro + ostride + L + 32 + 8 * k) = z4; } }
                if (p0 == L - 16) { for (int k = 0; k < 4; ++k) { *(GAS u32x4*)(hro + 8 * k) = z4; *(GAS u32x4*)(hro + ostride + 8 * k) = z4; } } }
        }
        __syncthreads();
    }
}

struct MoeComb { const GAS int* route; const GAS float* rwt; const GAS bf16_t* y; const GAS float* gate; };
__device__ __forceinline__ void moe_combine_row(const MoeComb& mc, const LAS unsigned* offs, int row, int b, int lane, f32x4 (&v)[4]) {
    const int e1 = mc.route[(size_t)row * 4 + 0], p1 = mc.route[(size_t)row * 4 + 1], e2 = mc.route[(size_t)row * 4 + 2], p2 = mc.route[(size_t)row * 4 + 3];
    const float w1 = mc.rwt[(size_t)row * 2], w2 = mc.rwt[(size_t)row * 2 + 1];
    const size_t s1 = (size_t)offs[e1] + p1, s2 = (size_t)offs[e2] + p2;
    const GAS float* gt = mc.gate + (size_t)b * 6144;
#pragma unroll
    for (int j = 0; j < 4; ++j) { const int k0 = 4 * (lane + 64 * j);
        const u32x2 a = *(const GAS u32x2*)(mc.y + s1 * D + k0), bq = *(const GAS u32x2*)(mc.y + s2 * D + k0); const f32x4 g4 = *(const GAS f32x4*)(gt + k0);
        v[j][0] += g4[0] * (w1 * bflo(a.x) + w2 * bflo(bq.x)); v[j][1] += g4[1] * (w1 * bfhi(a.x) + w2 * bfhi(bq.x));
        v[j][2] += g4[2] * (w1 * bflo(a.y) + w2 * bflo(bq.y)); v[j][3] += g4[3] * (w1 * bfhi(a.y) + w2 * bfhi(bq.y)); }
}
__device__ __forceinline__ void moe_offsets(const Ctx& c, int i, LAS unsigned* offs) {
    if (c.tid == 0) { const GAS unsigned* cnt = (const GAS unsigned*)(c.ws + WS_CTL) + CW_CNT + 64 * i; unsigned o = 0;
        for (int e = 0; e < 8; ++e) { offs[e] = o; o += (cnt[e] + 255u) & ~255u; } offs[8] = o; }
}
__device__ __forceinline__ void ph_norm(const Ctx& c0, int l, int which) {
    const Ctx c = mk_ctx(c0.lds, c0.ws);
    GAS float* xres = (GAS float*)(c.ws + WS_X); GAS bf16_t* h = (GAS bf16_t*)(c.ws + WS_H);
    const GAS float* mod = (const GAS float*)(c.ws + WS_MOD) + (size_t)l * 5 * 6144;
    const GAS float* gp = (which == 0 ? inp(c, I_N1G) : inp(c, I_N2G)) + l * D;
    const bool first = (l == 0 && which == 0), route = (which == 1 && (l & 1));
    const int comb = (which == 0 && l >= 1 && ((l - 1) & 1)) ? ((l - 1) >> 1) : -1;
    const GAS float* router = inp(c, I_ROUTER) + (size_t)(l >> 1) * D * NE;
    GAS int* routeb = (GAS int*)(c.ws + WS_ROUTE); GAS float* rwt = (GAS float*)(c.ws + WS_RWT); GAS int* tokenof = (GAS int*)(c.ws + WS_TOK);
    const MoeComb mc{routeb, rwt, (const GAS bf16_t*)(c.ws + WS_Y), (const GAS float*)(c.ws + WS_MOD) + (size_t)(l > 0 ? l - 1 : 0) * 5 * 6144 + 5 * 1024};
    LAS unsigned* lcnt = (LAS unsigned*)c.lds; LAS unsigned* gbase = lcnt + 16; LAS unsigned* offs = lcnt + 32; LAS int* pend = (LAS int*)(c.lds + 256);
    if (c.tid < 8) lcnt[c.tid] = 0u;
    if (comb >= 0) moe_offsets(c, comb, offs);
    __syncthreads();
    const GAS float* xin = inp(c, I_X); const GAS float* ctxin = inp(c, I_CTX);
    int nrows = 0;
    const int nrow_all = (which == 1 && l == DEPTH - 1) ? TL : T;
#define NORM_SRC(rw) (first ? ((rw) < TL ? xin + (size_t)(rw) * D : ctxin + (size_t)((rw) - TL) * D) : xres + (size_t)(rw) * D)
    const int rstride = c.G * NWAVES;
    f32x4 vnx[4];
    { const int row = c.bid * NWAVES + c.wave; if (row < nrow_all) { const GAS float* src = NORM_SRC(row);
#pragma unroll
        for (int j = 0; j < 4; ++j) vnx[j] = *(const GAS f32x4*)(src + 4 * (c.lane + 64 * j)); } }
    for (int row = c.bid * NWAVES + c.wave; row < nrow_all; row += rstride, ++nrows) {
        const int b = row < TL ? (row >> 12) : 4;
        const GAS float* sh = mod + (size_t)b * 6144 + (which == 0 ? 0 : 3) * 1024; const GAS float* sc = sh + 1024;
        f32x4 v[4]; float ss = 0.f;
#pragma unroll
        for (int j = 0; j < 4; ++j) v[j] = vnx[j];
        if (row + rstride < nrow_all) { const GAS float* srcn = NORM_SRC(row + rstride);
#pragma unroll
            for (int j = 0; j < 4; ++j) vnx[j] = *(const GAS f32x4*)(srcn + 4 * (c.lane + 64 * j)); }
        if (comb >= 0) moe_combine_row(mc, offs, row, b, c.lane, v);
#pragma unroll
        for (int j = 0; j < 4; ++j) ss += (v[j][0] * v[j][0] + v[j][1] * v[j][1]) + (v[j][2] * v[j][2] + v[j][3] * v[j][3]);
        ss = wave_sum(ss, c.lane);
        const float rstd = 1.f / sqrtf(ss * (1.f / D) + EPS);
        if (first || comb >= 0) {
#pragma unroll
            for (int j = 0; j < 4; ++j) *(GAS f32x4*)(xres + (size_t)row * D + 4 * (c.lane + 64 * j)) = v[j];
        }
        float lg[8] = {0.f, 0.f, 0.f, 0.f, 0.f, 0.f, 0.f, 0.f};
#pragma unroll
        for (int j = 0; j < 4; ++j) { const int k0 = 4 * (c.lane + 64 * j);
            const f32x4 g4 = *(const GAS f32x4*)(gp + k0), s4 = *(const GAS f32x4*)(sc + k0), h4 = *(const GAS f32x4*)(sh + k0);
            f32x4 o;
#pragma unroll
            for (int q = 0; q < 4; ++q) o[q] = v[j][q] * rstd * g4[q] * (1.f + s4[q]) + h4[q];
            u32x2 w; w.x = cvt_pk_bf16(o[0], o[1]); w.y = cvt_pk_bf16(o[2], o[3]);
            *(GAS u32x2*)(h + (size_t)row * D + k0) = w;
            if (route) {
#pragma unroll
                for (int q = 0; q < 4; ++q) { const f32x4 ra = *(const GAS f32x4*)(router + (size_t)(k0 + q) * 8), rb = *(const GAS f32x4*)(router + (size_t)(k0 + q) * 8 + 4);
                    lg[0] += o[q] * ra[0]; lg[1] += o[q] * ra[1]; lg[2] += o[q] * ra[2]; lg[3] += o[q] * ra[3];
                    lg[4] += o[q] * rb[0]; lg[5] += o[q] * rb[1]; lg[6] += o[q] * rb[2]; lg[7] += o[q] * rb[3]; }
            }
        }
        if (route) {
#pragma unroll
            for (int e = 0; e < 8; ++e) lg[e] = wave_sum(lg[e], c.lane);
            int i1 = 0; float v1 = lg[0];
#pragma unroll
            for (int e = 1; e < 8; ++e) if (lg[e] > v1) { v1 = lg[e]; i1 = e; }
            int i2 = -1; float v2 = -3.0e38f;
#pragma unroll
            for (int e = 0; e < 8; ++e) if (e != i1 && lg[e] > v2) { v2 = lg[e]; i2 = e; }
            const float w1 = 1.f / (1.f + __expf(v2 - v1)), w2 = 1.f - w1;
            if (c.lane == 0) {
                const unsigned lp1 = __hip_atomic_fetch_add(lcnt + i1, 1u, __ATOMIC_RELAXED, __HIP_MEMORY_SCOPE_WORKGROUP), lp2 = __hip_atomic_fetch_add(lcnt + i2, 1u, __ATOMIC_RELAXED, __HIP_MEMORY_SCOPE_WORKGROUP);
                LAS int* pe = pend + (c.wave * 16 + nrows) * 4; pe[0] = row; pe[1] = i1 | (i2 << 8); pe[2] = (int)lp1; pe[3] = (int)lp2;
                rwt[(size_t)row * 2] = w1; rwt[(size_t)row * 2 + 1] = w2; }
        }
    }
    if (route) {
        __syncthreads();
        if (c.tid < 8) gbase[c.tid] = __hip_atomic_fetch_add((GAS unsigned*)(c.ws + WS_CTL) + CW_CNT + 64 * (l >> 1) + c.tid, lcnt[c.tid], __ATOMIC_RELAXED, __HIP_MEMORY_SCOPE_AGENT);
        __syncthreads();
        if (c.lane < nrows) { const LAS int* pe = pend + (c.wave * 16 + c.lane) * 4; const int row = pe[0], e1 = pe[1] & 255, e2 = pe[1] >> 8;
            const int p1 = (int)gbase[e1] + pe[2], p2 = (int)gbase[e2] + pe[3];
            tokenof[(size_t)e1 * T + p1] = row; tokenof[(size_t)e2 * T + p2] = row;
            routeb[(size_t)row * 4 + 0] = e1; routeb[(size_t)row * 4 + 1] = p1; routeb[(size_t)row * 4 + 2] = e2; routeb[(size_t)row * 4 + 3] = p2; }
    }
    __syncthreads();
}

__device__ __forceinline__ void ph_sc(const Ctx& c0, int l) {
    const Ctx c = mk_ctx(c0.lds, c0.ws);
    const GAS bf16_t* P = (const GAS bf16_t*)(c.ws + WS_P); GAS bf16_t* uT = (GAS bf16_t*)(c.ws + WS_B); GAS bf16_t* VT = (GAS bf16_t*)(c.ws + WS_VT);
    const GAS float* cw = inp(c, I_HCW) + (size_t)l * 3 * 1536; const GAS float* cb = inp(c, I_HCB) + (size_t)l * 1536;
    LAS unsigned char* scr = c.lds + c.wave * 16384;
    for (int tile = c.bid * NWAVES + c.wave; tile < (T / 64) * 32; tile += c.G * NWAVES) {
        const int rt = tile / 32, row0 = rt * 64, ct = tile % 32; const bool isv = ct >= 24;
        const int ch0 = isv ? (ct - 24) * 64 : ct * 64, scol = isv ? PV + ch0 : PHY + ch0; GAS bf16_t* dst = isv ? VT : uT;
        const int tpos = row0 < TL ? (row0 & 4095) : ((row0 - TL) & 255), Ls = row0 < TL ? 4096 : 256;
        for (int idx = c.lane; idx < 66 * 8; idx += 64) { const int rr = idx >> 3, ck = idx & 7; const int grow = row0 - 1 + rr;
            const bool ok = !((rr == 0 && tpos == 0) || (rr == 65 && tpos + 64 == Ls));
            u32x4 v = (u32x4){0u, 0u, 0u, 0u};
            if (ok) v = *(const GAS u32x4*)(P + (size_t)grow * PW + scol + ck * 8);
            LAS unsigned* d = (LAS unsigned*)(scr + rr * 132 + ck * 16); d[0] = v.x; d[1] = v.y; d[2] = v.z; d[3] = v.w; }
        LDS_WAIT(); asm volatile("" ::: "memory");
        const int ch = ch0 + c.lane; const float w0 = isv ? 0.f : cw[ch], w1 = isv ? 1.f : cw[1536 + ch], w2 = isv ? 0.f : cw[3072 + ch], bb = isv ? 0.f : cb[ch];
        unsigned ow[32];
        { float prev = bf2f(*(const LAS unsigned short*)(scr + 0 * 132 + c.lane * 2)), cur = bf2f(*(const LAS unsigned short*)(scr + 1 * 132 + c.lane * 2)); float o0 = 0.f;
#pragma unroll
          for (int r = 0; r < 64; ++r) { const float nxt = bf2f(*(const LAS unsigned short*)(scr + (r + 2) * 132 + c.lane * 2));
              const float o = w0 * prev + w1 * cur + w2 * nxt + bb; prev = cur; cur = nxt;
              if (r & 1) ow[r >> 1] = cvt_pk_bf16(o0, o); else o0 = o; } }
        LDS_WAIT(); asm volatile("" ::: "memory");
#pragma unroll
        for (int k = 0; k < 8; ++k) { u32x4 v; v.x = ow[4 * k]; v.y = ow[4 * k + 1]; v.z = ow[4 * k + 2]; v.w = ow[4 * k + 3]; *(LAS u32x4*)(scr + c.lane * 144 + k * 16) = v; }
        LDS_WAIT(); asm volatile("" ::: "memory");
#pragma unroll
        for (int k = 0; k < 8; ++k) { const int cc = (c.lane >> 3) + 8 * k, ck = c.lane & 7; const u32x4 v = *(const LAS u32x4*)(scr + cc * 144 + ck * 16);
            *(GAS u32x4*)(dst + (size_t)(ch0 + cc) * T + row0 + ck * 8) = v; }
        LDS_WAIT(); asm volatile("" ::: "memory");
    }
}

constexpr int HY_HR_OFF = 512, HY_U_OFF = HY_HR_OFF + 66560, HY_ZB_OFF = HY_U_OFF + 4 * 8208;
template <int L, bool DUAL>
__device__ __forceinline__ void hy_span(LAS unsigned char* lds, int nsteps, int aaddr, int ubase, int sX, int sY, f32x16& accX, f32x16& accY) {
#define HY_BADDR(sv) (((unsigned)(sv) <= (unsigned)(L - 16)) ? ubase + 2 * (sv) : HY_ZB_OFF)
    int k = 0;
    for (; k + 4 <= nsteps; k += 4) {
        const int pa = aaddr - 768;
        const int px0 = HY_BADDR(sX), px1 = HY_BADDR(sX - 16), px2 = HY_BADDR(sX - 32), px3 = HY_BADDR(sX - 48);
        bf16x8 a0, a1, a2, a3, x0, x1, x2, x3;
        if (DUAL) {
            const int py0 = HY_BADDR(sY), py1 = HY_BADDR(sY - 16), py2 = HY_BADDR(sY - 32), py3 = HY_BADDR(sY - 48);
            bf16x8 y0, y1, y2, y3;
            asm volatile(
                "ds_read_b128 %[a0], %[pa] offset:768\n\tds_read_b128 %[x0], %[px0]\n\tds_read_b128 %[y0], %[py0]\n\t"
                "ds_read_b128 %[a1], %[pa] offset:512\n\tds_read_b128 %[x1], %[px1]\n\tds_read_b128 %[y1], %[py1]\n\t"
                "ds_read_b128 %[a2], %[pa] offset:256\n\tds_read_b128 %[x2], %[px2]\n\tds_read_b128 %[y2], %[py2]\n\t"
                "ds_read_b128 %[a3], %[pa]\n\tds_read_b128 %[x3], %[px3]\n\tds_read_b128 %[y3], %[py3]\n\t"
                "s_waitcnt lgkmcnt(9)\n\tv_mfma_f32_32x32x16_bf16 %[cx], %[a0], %[x0], %[cx]\n\tv_mfma_f32_32x32x16_bf16 %[cy], %[a0], %[y0], %[cy]\n\t"
                "s_waitcnt lgkmcnt(6)\n\tv_mfma_f32_32x32x16_bf16 %[cx], %[a1], %[x1], %[cx]\n\tv_mfma_f32_32x32x16_bf16 %[cy], %[a1], %[y1], %[cy]\n\t"
                "s_waitcnt lgkmcnt(3)\n\tv_mfma_f32_32x32x16_bf16 %[cx], %[a2], %[x2], %[cx]\n\tv_mfma_f32_32x32x16_bf16 %[cy], %[a2], %[y2], %[cy]\n\t"
                "s_waitcnt lgkmcnt(0)\n\tv_mfma_f32_32x32x16_bf16 %[cx], %[a3], %[x3], %[cx]\n\tv_mfma_f32_32x32x16_bf16 %[cy], %[a3], %[y3], %[cy]\n\t"
                : [cx] "+v"(accX), [cy] "+v"(accY), [a0] "=&v"(a0), [a1] "=&v"(a1), [a2] "=&v"(a2), [a3] "=&v"(a3), [x0] "=&v"(x0), [x1] "=&v"(x1), [x2] "=&v"(x2), [x3] "=&v"(x3),
                  [y0] "=&v"(y0), [y1] "=&v"(y1), [y2] "=&v"(y2), [y3] "=&v"(y3)
                : [pa] "v"(pa), [px0] "v"(px0), [px1] "v"(px1), [px2] "v"(px2), [px3] "v"(px3), [py0] "v"(py0), [py1] "v"(py1), [py2] "v"(py2), [py3] "v"(py3));
        } else {
            asm volatile(
                "ds_read_b128 %[a0], %[pa] offset:768\n\tds_read_b128 %[x0], %[px0]\n\t"
                "ds_read_b128 %[a1], %[pa] offset:512\n\tds_read_b128 %[x1], %[px1]\n\t"
                "ds_read_b128 %[a2], %[pa] offset:256\n\tds_read_b128 %[x2], %[px2]\n\t"
                "ds_read_b128 %[a3], %[pa]\n\tds_read_b128 %[x3], %[px3]\n\t"
                "s_waitcnt lgkmcnt(6)\n\tv_mfma_f32_32x32x16_bf16 %[cx], %[a0], %[x0], %[cx]\n\t"
                "s_waitcnt lgkmcnt(4)\n\tv_mfma_f32_32x32x16_bf16 %[cx], %[a1], %[x1], %[cx]\n\t"
                "s_waitcnt lgkmcnt(2)\n\tv_mfma_f32_32x32x16_bf16 %[cx], %[a2], %[x2], %[cx]\n\t"
                "s_waitcnt lgkmcnt(0)\n\tv_mfma_f32_32x32x16_bf16 %[cx], %[a3], %[x3], %[cx]\n\t"
                : [cx] "+v"(accX), [a0] "=&v"(a0), [a1] "=&v"(a1), [a2] "=&v"(a2), [a3] "=&v"(a3), [x0] "=&v"(x0), [x1] "=&v"(x1), [x2] "=&v"(x2), [x3] "=&v"(x3)
                : [pa] "v"(pa), [px0] "v"(px0), [px1] "v"(px1), [px2] "v"(px2), [px3] "v"(px3));
        }
        aaddr -= 1024; sX -= 64; sY -= 64;
    }
    for (; k < nsteps; ++k) {
        const bf16x8 af = *(const LAS bf16x8*)(lds + aaddr), xf = *(const LAS bf16x8*)(lds + HY_BADDR(sX));
        accX = __builtin_amdgcn_mfma_f32_32x32x16_bf16(af, xf, accX, 0, 0, 0);
        if (DUAL) { const bf16x8 yf = *(const LAS bf16x8*)(lds + HY_BADDR(sY)); accY = __builtin_amdgcn_mfma_f32_32x32x16_bf16(af, yf, accY, 0, 0, 0); }
        aaddr -= 256; sX -= 16; sY -= 16;
    }
#undef HY_BADDR
}
template <int L>
__device__ __forceinline__ void hy_unit(const Ctx& c, int l, int ch, const GAS float* hbias) {
    constexpr int H = L / 2, NG = L / 256, LP = L + 64, NW = L / 8 + 8, ROWB = 2 * L + 16;
    LAS unsigned char* lds = c.lds;
    const GAS bf16_t* uT = (const GAS bf16_t*)(c.ws + WS_B); GAS bf16_t* oht = (GAS bf16_t*)(c.ws + WS_OHT);
    const int seq0 = (L == 4096) ? 0 : TL;
    const GAS bf16_t* hrbase = (L == 4096) ? (const GAS bf16_t*)(c.ws + WS_HRL) : (const GAS bf16_t*)(c.ws + WS_HRC);
    int gA, gB;
    if (NG == 16) { gA = c.wave < 4 ? c.wave : 4 + c.wave; gB = c.wave < 4 ? 7 - c.wave : 19 - c.wave; } else { gA = c.wave == 0 ? 0 : -1; gB = -1; }
    const int n = c.lane & 31, g = c.lane >> 5, tbl = n >> 2, b = n & 3;
    const int loA = gA < 0 ? 1 << 30 : max(-H - 16, 256 * gA - (L - 16)), hiA = gA < 0 ? -(1 << 30) : min(H, 256 * gA + 224);
    const int loB = gB < 0 ? 1 << 30 : max(-H - 16, 256 * gB - (L - 16)), hiB = gB < 0 ? -(1 << 30) : min(H, 256 * gB + 224);
    const int dlo = min(loA, loB), dhi = max(hiA, hiB);
    unsigned zreg[2][4][2];
    for (int o = 0; o < 2; ++o) {
        const GAS bf16_t* hr = hrbase + ((size_t)(l * 2 + o) * 512 + ch) * LP;
        for (int w = c.tid; w < NW; w += NTHR) {
            u32x4 A4 = (u32x4){0u, 0u, 0u, 0u}; if (w > 0) A4 = *(const GAS u32x4*)(hr + 8 * (w - 1));
            const u32x4 B4 = *(const GAS u32x4*)(hr + 8 * w);
            const unsigned Dd[8] = {A4.x, A4.y, A4.z, A4.w, B4.x, B4.y, B4.z, B4.w};
#pragma unroll
            for (int q = 0; q < 8; ++q) { u32x4 ov;
                if ((q & 1) == 0) { const int j = (8 - q) / 2; ov.x = Dd[j]; ov.y = Dd[j + 1]; ov.z = Dd[j + 2]; ov.w = Dd[j + 3]; }
                else { const int j = (7 - q) / 2; ov.x = __builtin_amdgcn_alignbit(Dd[j + 1], Dd[j], 16); ov.y = __builtin_amdgcn_alignbit(Dd[j + 2], Dd[j + 1], 16);
                       ov.z = __builtin_amdgcn_alignbit(Dd[j + 3], Dd[j + 2], 16); ov.w = __builtin_amdgcn_alignbit(Dd[j + 4], Dd[j + 3], 16); }
                *(LAS u32x4*)(lds + HY_HR_OFF + (8 * w + q) * 16) = ov; }
        }
        if (o == 0) {
            for (int idx = c.tid; idx < 4 * (L / 8); idx += NTHR) { const int bb = idx / (L / 8), wq = idx % (L / 8);
                *(LAS u32x4*)(lds + HY_U_OFF + bb * ROWB + wq * 16) = *(const GAS u32x4*)(uT + (size_t)ch * T + seq0 + bb * L + wq * 8); }
            if (c.tid < 16) *(LAS unsigned*)(lds + HY_ZB_OFF + c.tid * 4) = 0u;
        } else {
#pragma unroll
            for (int gi = 0; gi < 2; ++gi) { const int G = gi == 0 ? gA : gB; if (G >= 0) {
#pragma unroll
                for (int rq = 0; rq < 4; ++rq) { const int t = 32 * (8 * G + tbl) + 8 * rq + 4 * g;
                    u32x2 zz; zz.x = zreg[gi][rq][0]; zz.y = zreg[gi][rq][1]; *(LAS u32x2*)(lds + HY_U_OFF + b * ROWB + 2 * t) = zz; } } }
        }
        __syncthreads();
        f32x16 accA, accB;
#pragma unroll
        for (int r = 0; r < 16; ++r) { accA[r] = 0.f; accB[r] = 0.f; }
        {
            const int qq = (n + 1) & 7, ubase = HY_U_OFF + b * ROWB + 16 * g;
#define HY_AADDR(d) (HY_HR_OFF + (8 * ((H + 31 - (d) - n + 8 * g + qq) >> 3) + qq) * 16)
#define HY_S0(G, d) (32 * (8 * (G) + tbl) - (d))
            if (gB < 0) { if (gA >= 0) hy_span<L, false>(lds, (hiA - loA) / 16 + 1, HY_AADDR(loA), ubase, HY_S0(gA, loA), 0, accA, accB); }
            else {
                const int dS = max(loA, loB), dE = min(hiA, hiB);
                if (loA < dS) hy_span<L, false>(lds, (dS - loA) / 16, HY_AADDR(loA), ubase, HY_S0(gA, loA), 0, accA, accB);
                else if (loB < dS) hy_span<L, false>(lds, (dS - loB) / 16, HY_AADDR(loB), ubase, HY_S0(gB, loB), 0, accB, accA);
                hy_span<L, true>(lds, (dE - dS) / 16 + 1, HY_AADDR(dS), ubase, HY_S0(gA, dS), HY_S0(gB, dS), accA, accB);
                if (hiA > dE) hy_span<L, false>(lds, (hiA - dE) / 16, HY_AADDR(dE + 16), ubase, HY_S0(gA, dE + 16), 0, accA, accB);
                else if (hiB > dE) hy_span<L, false>(lds, (hiB - dE) / 16, HY_AADDR(dE + 16), ubase, HY_S0(gB, dE + 16), 0, accB, accA);
            }
#undef HY_AADDR
#undef HY_S0
        }
        const float bias = hbias[(l * 2 + o) * 512 + ch];
        int tbl_e = tbl, b_e = b, g_e = g; asm volatile("" : "+v"(tbl_e), "+v"(b_e), "+v"(g_e));
#pragma unroll
        for (int gi = 0; gi < 2; ++gi) { const int G = gi == 0 ? gA : gB; if (G >= 0) {
#pragma unroll
            for (int rq = 0; rq < 4; ++rq) { const int t = 32 * (8 * G + tbl_e) + 8 * rq + 4 * g_e;
                const u32x2 uv = *(const LAS u32x2*)(lds + HY_U_OFF + b_e * ROWB + 2 * t);
                const size_t grow = (size_t)seq0 + b_e * L + t;
                const u32x2 xv = *(const GAS u32x2*)(uT + (size_t)((o == 0 ? 512 : 1024) + ch) * T + grow);
                float y[4];
#pragma unroll
                for (int k = 0; k < 4; ++k) y[k] = gi == 0 ? accA[4 * rq + k] : accB[4 * rq + k];
                const float r0 = bflo(xv.x) * (y[0] + bias * bflo(uv.x)), r1 = bfhi(xv.x) * (y[1] + bias * bfhi(uv.x));
                const float r2 = bflo(xv.y) * (y[2] + bias * bflo(uv.y)), r3 = bfhi(xv.y) * (y[3] + bias * bfhi(uv.y));
                const unsigned p0 = cvt_pk_bf16(r0, r1), p1 = cvt_pk_bf16(r2, r3);
                if (o == 0) { zreg[gi][rq][0] = p0; zreg[gi][rq][1] = p1; }
                else { u32x2 ov; ov.x = p0; ov.y = p1; *(GAS u32x2*)(oht + (size_t)ch * T + grow) = ov;   } } } }
        __syncthreads();
    }
}
__device__ __forceinline__ void ph_hyena(const Ctx& c0, int l) {
    const Ctx c = mk_ctx(c0.lds, c0.ws);
    const GAS float* hbias = inp(c, I_HBIAS);
    for (int unit = c.bid; unit < HYW; unit += c.G) { hy_unit<4096>(c, l, unit, hbias); if (l < DEPTH - 1) hy_unit<256>(c, l, unit, hbias); }
}

__device__ __forceinline__ void ph_ohy_t(const Ctx& c0) {
    const Ctx c = mk_ctx(c0.lds, c0.ws);
    const GAS bf16_t* src = (const GAS bf16_t*)(c.ws + WS_OHT); GAS bf16_t* dst = (GAS bf16_t*)(c.ws + WS_OAH) + 512;
    LAS unsigned char* scr = c.lds + c.wave * 16384;
    for (int tile = c.bid * NWAVES + c.wave; tile < (T / 64) * 8; tile += c.G * NWAVES) {
        const int row0 = (tile >> 3) * 64, ch0 = (tile & 7) * 64;
#pragma unroll
        for (int k = 0; k < 8; ++k) { const int cc = (c.lane >> 3) + 8 * k, ck = c.lane & 7;
            const u32x4 v = *(const GAS u32x4*)(src + (size_t)(ch0 + cc) * T + row0 + ck * 8);
            LAS unsigned* d = (LAS unsigned*)(scr + cc * 132 + ck * 16); d[0] = v.x; d[1] = v.y; d[2] = v.z; d[3] = v.w; }
        LDS_WAIT(); asm volatile("" ::: "memory");
        unsigned ow[32];
#pragma unroll
        for (int j = 0; j < 32; ++j) { const unsigned lo = *(const LAS unsigned short*)(scr + (2 * j) * 132 + c.lane * 2), hi = *(const LAS unsigned short*)(scr + (2 * j + 1) * 132 + c.lane * 2); ow[j] = lo | (hi << 16); }
        LDS_WAIT(); asm volatile("" ::: "memory");
#pragma unroll
        for (int k = 0; k < 8; ++k) { u32x4 v; v.x = ow[4 * k]; v.y = ow[4 * k + 1]; v.z = ow[4 * k + 2]; v.w = ow[4 * k + 3]; *(LAS u32x4*)(scr + c.lane * 144 + k * 16) = v; }
        LDS_WAIT(); asm volatile("" ::: "memory");
#pragma unroll
        for (int k = 0; k < 8; ++k) { const int rr = (c.lane >> 3) + 8 * k, ck = c.lane & 7; const u32x4 v = *(const LAS u32x4*)(scr + rr * 144 + ck * 16);
            *(GAS u32x4*)(dst + (size_t)(row0 + rr) * 1024 + ch0 + ck * 8) = v; }
        LDS_WAIT(); asm volatile("" ::: "memory");
    }
}

constexpr int ATT_RPB_OFF = 1024, ATT_VT_OFF = ATT_RPB_OFF + 8 * 15 * 32 * 4, ATT_VT_BYTES = 64 * 72;
template <int MODE>
__device__ __forceinline__ void att_block(const GAS bf16_t* P, const GAS bf16_t* VT, LAS unsigned char* lds, LAS unsigned char* vt, int lane, int n, int h, int head,
                                          int tokk, int ctok, int tabaddr, int vb, const bf16x8 (&qf)[4], f32x16& ot0, f32x16& ot1, float& m, float& lsum) {
    bf16x8 kf[4];
#pragma unroll
    for (int ks = 0; ks < 4; ++ks) kf[ks] = *(const GAS bf16x8*)(P + (size_t)tokk * PW + PK + head * 64 + 16 * ks + 8 * h);
    u32x2 vr[8];
#pragma unroll
    for (int it = 0; it < 8; ++it) vr[it] = *(const GAS u32x2*)(VT + (size_t)(head * 64 + it * 8 + (lane >> 3)) * T + ctok);
    f32x16 st;
#pragma unroll
    for (int r = 0; r < 16; ++r) st[r] = 0.f;
#pragma unroll
    for (int ks = 0; ks < 4; ++ks) st = __builtin_amdgcn_mfma_f32_32x32x16_bf16(kf[ks], qf[ks], st, 0, 0, 0);
    const float SC = 0.18033688011112042f;
    float sv[16];
#pragma unroll
    for (int r = 0; r < 16; ++r) {
        if (MODE == 2) sv[r] = st[r] * SC;
        else { const int cr = MODE == 0 ? 8 * (r >> 2) + (r & 3) : (r & 3), imm = MODE == 0 ? cr * 4 : ((r >> 2) * 32 + (r & 3)) * 4;
            const float bias = *(const LAS float*)(lds + tabaddr + imm);
            const bool ok = (unsigned)(vb + cr) < 16u;
            sv[r] = ok ? st[r] * SC + bias : -1.0e30f; }
    }
    float bm = sv[0];
#pragma unroll
    for (int r = 1; r < 16; ++r) bm = fmaxf(bm, sv[r]);
    bm = fmaxf(bm, __int_as_float(__builtin_amdgcn_ds_bpermute((lane ^ 32) << 2, __float_as_int(bm))));
    const float mn = fmaxf(m, bm), alpha = __builtin_amdgcn_exp2f(m - mn); m = mn;
    float psum = 0.f;
#pragma unroll
    for (int r = 0; r < 16; ++r) { const float pv = __builtin_amdgcn_exp2f(sv[r] - mn); psum += pv; sv[r] = pv; }
    lsum = lsum * alpha + psum;
#pragma unroll
    for (int r = 0; r < 16; ++r) { ot0[r] *= alpha; ot1[r] *= alpha; }
    bf16x8 pb[2];
#pragma unroll
    for (int s2 = 0; s2 < 2; ++s2) { u32x4 w; w.x = cvt_pk_bf16(sv[8 * s2], sv[8 * s2 + 1]); w.y = cvt_pk_bf16(sv[8 * s2 + 2], sv[8 * s2 + 3]);
        w.z = cvt_pk_bf16(sv[8 * s2 + 4], sv[8 * s2 + 5]); w.w = cvt_pk_bf16(sv[8 * s2 + 6], sv[8 * s2 + 7]); pb[s2] = __builtin_bit_cast(bf16x8, w); }
#pragma unroll
    for (int it = 0; it < 8; ++it) *(LAS u32x2*)(vt + (it * 8 + (lane >> 3)) * 72 + (lane & 7) * 8) = vr[it];
#pragma unroll
    for (int s2 = 0; s2 < 2; ++s2) {
        { const u32x2 a = *(const LAS u32x2*)(vt + n * 72 + (4 * s2 + h) * 8), bq = *(const LAS u32x2*)(vt + n * 72 + (4 * s2 + 2 + h) * 8);
          u32x4 w; w.x = a.x; w.y = a.y; w.z = bq.x; w.w = bq.y; ot0 = __builtin_amdgcn_mfma_f32_32x32x16_bf16(__builtin_bit_cast(bf16x8, w), pb[s2], ot0, 0, 0, 0); }
        { const u32x2 a = *(const LAS u32x2*)(vt + (32 + n) * 72 + (4 * s2 + h) * 8), bq = *(const LAS u32x2*)(vt + (32 + n) * 72 + (4 * s2 + 2 + h) * 8);
          u32x4 w; w.x = a.x; w.y = a.y; w.z = bq.x; w.w = bq.y; ot1 = __builtin_amdgcn_mfma_f32_32x32x16_bf16(__builtin_bit_cast(bf16x8, w), pb[s2], ot1, 0, 0, 0); }
    }
}
constexpr int ATT_UNITS = 4096 + 256;
__device__ __forceinline__ void ph_attn(const Ctx& c0, int l) {
    const Ctx c = mk_ctx(c0.lds, c0.ws);
    const GAS bf16_t* P = (const GAS bf16_t*)(c.ws + WS_P); const GAS bf16_t* VT = (const GAS bf16_t*)(c.ws + WS_VT); GAS bf16_t* oatt = (GAS bf16_t*)(c.ws + WS_OAH);
    const GAS float* rpb = inp(c, I_RPB) + (size_t)l * 8 * 15 * 31;
    LAS unsigned char* lds = c.lds;
    for (int i = c.tid; i < 8 * 15 * 32; i += NTHR) { const int hd = i / 480, rem = i % 480, dr = rem >> 5, dc = rem & 31;
        *(LAS float*)(lds + ATT_RPB_OFF + i * 4) = dc < 31 ? rpb[(hd * 15 + dr) * 31 + dc] * 1.4426950408889634f : 0.f; }
    __syncthreads();
    LAS unsigned char* vt = lds + ATT_VT_OFF + c.wave * ATT_VT_BYTES;
    const int lane = c.lane, n = lane & 31, h = lane >> 5;
    const int natt = l < DEPTH - 1 ? ATT_UNITS : 4096;
    for (int u = c.bid * NWAVES + c.wave; u < natt; u += c.G * NWAVES) {
        const bool lat = u < 4096;
        int b, head, r = 0, hf = 0, tokq;
        if (lat) { hf = u & 1; r = (u >> 1) & 63; head = (u >> 7) & 7; b = u >> 10; tokq = b * 4096 + r * 64 + 32 * hf + n; }
        else { const int uu = u - 4096; head = (uu >> 3) & 7; b = uu >> 6; tokq = TL + b * 256 + 32 * (uu & 7) + n; }
        bf16x8 qf[4];
#pragma unroll
        for (int ks = 0; ks < 4; ++ks) qf[ks] = *(const GAS bf16x8*)(P + (size_t)tokq * PW + PQ + head * 64 + 16 * ks + 8 * h);
        f32x16 ot0, ot1;
#pragma unroll
        for (int q = 0; q < 16; ++q) { ot0[q] = 0.f; ot1[q] = 0.f; }
        float m = -1.0e30f, lsum = 0.f;
        if (lat) {
            const int r0 = min(max(r - 4, 0), 56), lo = hf ? 24 : 0, qc = 32 * hf + n, c0q = min(max(qc - 8, 0), 48);
            for (int kb = 0; kb < 8; ++kb) {
                const int base = b * 4096 + (r0 + kb) * 64 + lo, kx = lo + 4 * h;
                const int tabaddr = ATT_RPB_OFF + (((head * 15 + (r0 + kb - r + 7)) * 32) + kx - qc + 15) * 4;
                att_block<0>(P, VT, lds, vt, lane, n, h, head, base + n, base + 4 * (lane & 7), tabaddr, kx - c0q, qf, ot0, ot1, m, lsum);
            }
            for (int kb = 0; kb < 2; ++kb) {
                const int rowb = b * 4096 + (r0 + 4 * kb) * 64 + lo + 32, kx = lo + 32 + 4 * h, cc = lane & 7;
                const int tabaddr = ATT_RPB_OFF + (((head * 15 + (r0 + 4 * kb - r + 7)) * 32) + kx - qc + 15) * 4;
                att_block<1>(P, VT, lds, vt, lane, n, h, head, rowb + (n >> 3) * 64 + (n & 7), rowb + (cc >> 1) * 64 + 4 * (cc & 1), tabaddr, kx - c0q, qf, ot0, ot1, m, lsum);
            }
        }
        for (int kb = 0; kb < 8; ++kb) { const int base = TL + b * 256 + 32 * kb;
            att_block<2>(P, VT, lds, vt, lane, n, h, head, base + n, base + 4 * (lane & 7), 0, 0, qf, ot0, ot1, m, lsum); }
        const float ltot = lsum + __int_as_float(__builtin_amdgcn_ds_bpermute((lane ^ 32) << 2, __float_as_int(lsum)));
        const float inv = 1.f / ltot;
        GAS bf16_t* op = oatt + (size_t)tokq * 1024 + head * 64 + 4 * h;
#pragma unroll
        for (int rq = 0; rq < 4; ++rq) {
            u32x2 w0, w1; w0.x = cvt_pk_bf16(ot0[4 * rq] * inv, ot0[4 * rq + 1] * inv); w0.y = cvt_pk_bf16(ot0[4 * rq + 2] * inv, ot0[4 * rq + 3] * inv);
            w1.x = cvt_pk_bf16(ot1[4 * rq] * inv, ot1[4 * rq + 1] * inv); w1.y = cvt_pk_bf16(ot1[4 * rq + 2] * inv, ot1[4 * rq + 3] * inv);
            *(GAS u32x2*)(op + 8 * rq) = w0; *(GAS u32x2*)(op + 32 + 8 * rq) = w1; }
    }
    __syncthreads();
}

__device__ __forceinline__ void ph_final(const Ctx& c0) {
    const Ctx c = mk_ctx(c0.lds, c0.ws);
    const GAS float* xres = (const GAS float*)(c.ws + WS_X); const GAS float* gp = inp(c, I_FINALG); GAS float* outp = (GAS float*)inp(c, 30);
    const MoeComb mc{(const GAS int*)(c.ws + WS_ROUTE), (const GAS float*)(c.ws + WS_RWT), (const GAS bf16_t*)(c.ws + WS_Y), (const GAS float*)(c.ws + WS_MOD) + (size_t)(DEPTH - 1) * 5 * 6144 + 5 * 1024};
    LAS unsigned* offs = (LAS unsigned*)c.lds + 32;
    moe_offsets(c, 1, offs);
    __syncthreads();
    for (int row = c.bid * NWAVES + c.wave; row < TL; row += c.G * NWAVES) {
        const GAS float* src = xres + (size_t)row * D; f32x4 v[4]; float ss = 0.f;
#pragma unroll
        for (int j = 0; j < 4; ++j) v[j] = *(const GAS f32x4*)(src + 4 * (c.lane + 64 * j));
        moe_combine_row(mc, offs, row, row >> 12, c.lane, v);
#pragma unroll
        for (int j = 0; j < 4; ++j) ss += (v[j][0] * v[j][0] + v[j][1] * v[j][1]) + (v[j][2] * v[j][2] + v[j][3] * v[j][3]);
        ss = wave_sum(ss, c.lane);
        const float rstd = 1.f / sqrtf(ss * (1.f / D) + EPS);
#pragma unroll
        for (int j = 0; j < 4; ++j) { const int k0 = 4 * (c.lane + 64 * j); const f32x4 g4 = *(const GAS f32x4*)(gp + k0); *(GAS f32x4*)(outp + (size_t)row * D + k0) = v[j] * rstd * g4; }
    }
}

constexpr int MOE_OFF = 132096;
template <bool GATHER_> struct MoeOrder {
    static constexpr bool GATHER = GATHER_;
    int nM, nN, nwg, G, c; const GAS char* A; const GAS char* B; size_t astep, bstep, estep; const GAS int* tokenof; const LAS unsigned* tab;
    __device__ void init(const GAS void* A_, int lda, const GAS void* B_, int ldb, size_t estep_bytes, int N, int G_, int c_, const GAS int* tok, const LAS unsigned* tab_) {
        tab = tab_; nM = (int)((unsigned)__builtin_amdgcn_readfirstlane(tab[8]) >> 8); nN = N / pg8::BM; nwg = nM * nN; G = G_; c = c_; A = (const GAS char*)A_; B = (const GAS char*)B_;
        astep = (size_t)pg8::BM * lda * 2; bstep = (size_t)pg8::BM * ldb * 2; estep = estep_bytes; tokenof = tok; }
    __device__ bool next(int i, pg8::Unit& u) const {
        const long L = (long)i * G + c; if (L >= nwg) return false;
        int wgid = (int)L; { const int q = nwg / pg8::NXCD, r = nwg % pg8::NXCD, xcd = wgid % pg8::NXCD, off = wgid / pg8::NXCD; wgid = (xcd < r ? xcd * (q + 1) : r * (q + 1) + (xcd - r) * q) + off; }
        const int nig = pg8::WGM * nN, gid = wgid / nig, fm = gid * pg8::WGM, gsz = (nM - fm) < pg8::WGM ? (nM - fm) : pg8::WGM;
        u.pm = fm + ((wgid % nig) % gsz); u.pn = (wgid % nig) / gsz;
        const unsigned slot0 = (unsigned)u.pm << 8; int e = 0;
#pragma unroll
        for (int j = 1; j < 8; ++j) e += (slot0 >= (unsigned)__builtin_amdgcn_readfirstlane(tab[j])) ? 1 : 0;
        const unsigned pos0 = slot0 - (unsigned)__builtin_amdgcn_readfirstlane(tab[e]), cnt = (unsigned)__builtin_amdgcn_readfirstlane(tab[16 + e]);
        u.nvalid = cnt > pos0 ? (int)(cnt - pos0) : 0; u.tk = tokenof + (size_t)e * T + pos0;
        u.a = GATHER ? A : A + (size_t)u.pm * astep; u.b = B + (size_t)e * estep + (size_t)u.pn * bstep; return true;
    }
    __device__ __forceinline__ int arow(const pg8::Unit& u, int r) const { return r < u.nvalid ? u.tk[r] : 0; }
    __device__ __forceinline__ void a_ready(const pg8::Unit&) const {}
    __device__ __forceinline__ void done(const pg8::Unit&) const {}
};
__device__ __forceinline__ void moe_table(const Ctx& c, int i) {
    LAS unsigned* tab = (LAS unsigned*)(c.lds + MOE_OFF);
    if (c.tid == 0) { const GAS unsigned* cnt = (const GAS unsigned*)(c.ws + WS_CTL) + CW_CNT + 64 * i; unsigned o = 0;
        for (int e = 0; e < 8; ++e) { const unsigned ce = cnt[e]; tab[e] = o; tab[16 + e] = ce; o += (ce + 255u) & ~255u; } tab[8] = o; }
    __syncthreads();
}

#define XB_TMO      128
#define XB_XCNT(j)  (256  + 64 * (j))
#define XB_XSUB(j)  (1280 + 64 * (j))
#define XB_XGEN(j)  (2304 + 64 * (j))
#define XB_TOP      3328
#define XB_TOPGEN   3392
#define XCD_BAR_WORDS 3456
#define XB_SPIN_CAP (1u << 18)
__device__ __forceinline__ unsigned xb_ld(GAS unsigned* p)              { return __hip_atomic_load(p, __ATOMIC_RELAXED, __HIP_MEMORY_SCOPE_AGENT); }
__device__ __forceinline__ unsigned xb_add(GAS unsigned* p, unsigned v) { return __hip_atomic_fetch_add(p, v, __ATOMIC_RELAXED, __HIP_MEMORY_SCOPE_AGENT); }
__device__ __forceinline__ unsigned xb_xcc_id() { return (unsigned)__builtin_amdgcn_s_getreg((3 << 11) | 20) & 0xFu; }
#define XB_SPIN(cond, bar) do { unsigned _sp = 0; while (cond) { __builtin_amdgcn_s_sleep(1); \
    if ((++_sp & 255u) == 0u) { if (xb_ld(&(bar)[XB_TMO])) break; if (_sp > XB_SPIN_CAP) { (void)xb_add(&(bar)[XB_TMO], 1u); break; } } } } while (0)
struct XcdBarrier { GAS unsigned* bar; unsigned x; volatile LAS unsigned* st; };
__device__ __forceinline__ XcdBarrier xcd_barrier_post(GAS unsigned* bar, volatile LAS unsigned* st) {
    XcdBarrier b; b.bar = bar; b.x = xb_xcc_id(); b.st = st;
    if (threadIdx.x == 0) (void)xb_add(&bar[XB_XCNT(b.x)], 1u);
    return b;
}
__device__ __forceinline__ void xcd_barrier_complete(GAS unsigned* bar, unsigned x, unsigned& nloc, unsigned& nx) {
    const unsigned G = gridDim.x * gridDim.y * gridDim.z;
    unsigned sum, cnt, mine, sp = 0u;
    for (;;) {
        sum = 0u; cnt = 0u; mine = 0u;
#pragma unroll
        for (unsigned j = 0; j < 16; ++j) { const unsigned c = xb_ld(&bar[XB_XCNT(j)]); sum += c; cnt += (c > 0u) ? 1u : 0u; mine = (j == x) ? c : mine; }
        if (sum == G) break;
        __builtin_amdgcn_s_sleep(1);
        if ((++sp & 255u) == 0u) { if (xb_ld(&bar[XB_TMO])) break; if (sp > XB_SPIN_CAP) { (void)xb_add(&bar[XB_TMO], 1u); break; } }
    }
    nloc = mine > 0u ? mine : 1u; nx = cnt > 0u ? cnt : 1u;
}
__device__ __forceinline__ void xcd_barrier(const XcdBarrier& b) {
    asm volatile("s_waitcnt vmcnt(0)" ::: "memory");
    __syncthreads();
    if (threadIdx.x == 0) {
        GAS unsigned* bar = b.bar; asm volatile("" : "+s"(bar));     const unsigned bx = xb_xcc_id();
        __builtin_amdgcn_s_waitcnt(0);
        unsigned nloc = b.st[0], nx = b.st[1];
        if (nloc == 0u) { xcd_barrier_complete(bar, bx, nloc, nx); b.st[0] = nloc; b.st[1] = nx; }
        const unsigned old = xb_add(&bar[XB_XSUB(bx)], 1u);
        const unsigned gen = old / nloc;
        if (old + 1u == (gen + 1u) * nloc) {
            __builtin_amdgcn_fence(__ATOMIC_RELEASE, "agent");
            asm volatile("s_waitcnt vmcnt(0)" ::: "memory");
            const unsigned og = xb_add(&bar[XB_TOP], 1u);
            const unsigned tg = og / nx;
            if (og + 1u == (tg + 1u) * nx) xb_add(&bar[XB_TOPGEN], 1u);
            else XB_SPIN(xb_ld(&bar[XB_TOPGEN]) == tg, bar);
            __builtin_amdgcn_fence(__ATOMIC_ACQUIRE, "agent");
            xb_add(&bar[XB_XGEN(bx)], 1u);
            asm volatile("s_waitcnt vmcnt(0)" ::: "memory");
        } else {
            XB_SPIN(xb_ld(&bar[XB_XGEN(bx)]) == gen, bar);
            __builtin_amdgcn_fence(__ATOMIC_ACQUIRE, "agent");
            asm volatile("s_waitcnt vmcnt(0)" ::: "memory");
        }
    }
    __syncthreads();
}

constexpr int CW_BAR = 4096;

__global__ void __launch_bounds__(NTHR, 2) fwd(Args args) {
    extern __shared__ __attribute__((aligned(16))) unsigned char lds_raw[];
    Ctx c; c.lds = (LAS unsigned char*)lds_raw; c.tid = threadIdx.x; c.lane = c.tid & 63; c.wave = __builtin_amdgcn_readfirstlane(c.tid >> 6); c.G = gridDim.x; c.bid = blockIdx.x; c.ws = (GAS unsigned char*)args.ws;
    GAS unsigned char* ws = (GAS unsigned char*)args.ws;
    volatile LAS unsigned* MISC = (volatile LAS unsigned*)(c.lds + MISC_OFF);
    if (c.tid < 32) MISC[c.tid] = 0u;
    if (c.tid < 31) { const unsigned long long pv = c.tid < 30 ? (unsigned long long)args.in[c.tid] : (unsigned long long)args.out;
        volatile LAS unsigned* pt = (volatile LAS unsigned*)(c.lds + PTR_OFF) + 2 * c.tid; pt[0] = (unsigned)pv; pt[1] = (unsigned)(pv >> 32); }
    __syncthreads();
    XcdBarrier bar = xcd_barrier_post((GAS unsigned*)(ws + WS_CTL) + CW_BAR, MISC + 8);
#define GRID_BAR() xcd_barrier(bar)

    ph_convert(c); __syncthreads(); ph_mod(c); __syncthreads(); ph_filt(c);
    GRID_BAR();
    for (int l = 0; l < DEPTH; ++l) {
        ph_norm(c, l, 0);
        GRID_BAR();
        {   GAS unsigned char* ws = c.ws; asm volatile("" : "+s"(ws));
            pg8::Gemm g{D, D, D, STAG}; pg8::StaticOrder S; S.init(ws + WS_H, D, (GAS bf16_t*)(ws + WS_WIN) + (size_t)l * PW * D, D, T, PW, c.G, c.bid);
            EpiStoreBf16 E{(GAS bf16_t*)(ws + WS_P), PW};
            pg8::gemm_phase(c.lds, g, S, E); }
        GRID_BAR();
        ph_sc(c, l);
        GRID_BAR();
        ph_hyena(c, l); ph_attn(c, l);
        GRID_BAR();
        ph_ohy_t(c);
        GRID_BAR();
        {   GAS unsigned char* ws = c.ws; asm volatile("" : "+s"(ws));
            const GAS bf16_t* wab = (const GAS bf16_t*)(ws + WS_WPAB) + (size_t)l * D * D;
            pg8::Gemm g{D, D, D}; pg8::StaticOrder S; S.init(ws + WS_OAH, D, wab, D, TL, D, c.G, c.bid);
            EpiMergeK E{(const GAS bf16_t*)(ws + WS_P), (GAS bf16_t*)(ws + WS_H)};
            pg8::gemm_phase(c.lds, g, S, E);
            if (l < DEPTH - 1) ctx_gemm((const GAS bf16_t*)(ws + WS_OAH), D, wab, D, D, CEpiMergeK{(const GAS bf16_t*)(ws + WS_P), (GAS bf16_t*)(ws + WS_H)}); }
        GRID_BAR();
        {   GAS unsigned char* ws = c.ws; asm volatile("" : "+s"(ws));
            const GAS float* modl = (const GAS float*)(ws + WS_MOD) + (size_t)l * 5 * 6144;
            pg8::Gemm g{D, D, D}; pg8::StaticOrder S; S.init(ws + WS_H, D, (GAS bf16_t*)(ws + WS_WO) + (size_t)l * D * D, D, TL, D, c.G, c.bid);
            EpiResid E{(GAS float*)(ws + WS_X), modl + 2 * 1024};
            pg8::gemm_phase(c.lds, g, S, E);
            if (l < DEPTH - 1) ctx_gemm((const GAS bf16_t*)(ws + WS_H), D, (const GAS bf16_t*)(ws + WS_WO) + (size_t)l * D * D, D, D, CEpiResid{(GAS float*)(ws + WS_X), modl + 4 * 6144 + 2 * 1024}); }
        GRID_BAR();
        ph_norm(c, l, 1);
        GRID_BAR();
        if ((l & 1) == 0) {
            {   GAS unsigned char* ws = c.ws; asm volatile("" : "+s"(ws));
                const GAS bf16_t* w = (const GAS bf16_t*)(ws + WS_W13D) + (size_t)(l >> 1) * 2 * FF * D;
                pg8::Gemm g{D, D, D, STAG}; pg8::StaticOrder S; S.init(ws + WS_H, D, w, D, T, 2 * FF, c.G, c.bid);
                EpiSwiglu E{(GAS bf16_t*)(ws + WS_P)};
                pg8::gemm_phase(c.lds, g, S, E); }
            GRID_BAR();
            {   GAS unsigned char* ws = c.ws; asm volatile("" : "+s"(ws));
                const GAS float* modl = (const GAS float*)(ws + WS_MOD) + (size_t)l * 5 * 6144;
                const GAS bf16_t* w = (const GAS bf16_t*)(ws + WS_W2D) + (size_t)(l >> 1) * D * FF;
                pg8::Gemm g{FF, FF, FF}; pg8::StaticOrder S; S.init(ws + WS_P, FF, w, FF, TL, D, c.G, c.bid);
                EpiResid E{(GAS float*)(ws + WS_X), modl + 5 * 1024};
                pg8::gemm_phase(c.lds, g, S, E);
                ctx_gemm((const GAS bf16_t*)(ws + WS_P), FF, w, FF, FF, CEpiResid{(GAS float*)(ws + WS_X), modl + 4 * 6144 + 5 * 1024}); }
            GRID_BAR();
        } else {
            const Ctx cm = mk_ctx(c.lds, c.ws);
            moe_table(cm, l >> 1);
            {   GAS unsigned char* ws = c.ws; asm volatile("" : "+s"(ws));
                const GAS bf16_t* w = (const GAS bf16_t*)(ws + WS_W13M) + (size_t)((l >> 1) * NE) * 2 * FF * D;
                pg8::Gemm g{D, D, D, STAG}; MoeOrder<true> S; S.init(ws + WS_H, D, w, D, (size_t)2 * FF * D * 2, 2 * FF, c.G, c.bid, (const GAS int*)(ws + WS_TOK), (const LAS unsigned*)(c.lds + MOE_OFF));
                EpiSwiglu E{(GAS bf16_t*)(ws + WS_P)};
                pg8::gemm_phase(c.lds, g, S, E); }
            GRID_BAR();
            {   GAS unsigned char* ws = c.ws; asm volatile("" : "+s"(ws));
                const GAS bf16_t* w = (const GAS bf16_t*)(ws + WS_W2M) + (size_t)((l >> 1) * NE) * D * FF;
                pg8::Gemm g{FF, FF, FF, STAG}; MoeOrder<false> S; S.init(ws + WS_P, FF, w, FF, (size_t)D * FF * 2, D, c.G, c.bid, (const GAS int*)(ws + WS_TOK), (const LAS unsigned*)(c.lds + MOE_OFF));
                EpiStoreBf16 E{(GAS bf16_t*)(ws + WS_Y), D};
                pg8::gemm_phase(c.lds, g, S, E); }
            GRID_BAR();
        }
    }
    ph_final(c);
}

extern "C" void kernel_launch(void* const* d_in, const int* in_sizes, int n_in, void* d_out, int out_size, void* d_ws, size_t ws_size, hipStream_t stream) {
    static int grid = 0;
    if (grid == 0) {
        if (n_in != 30 || out_size != TL * D || ws_size < WS_END) { fprintf(stderr, "kernel_launch: unexpected shapes (n_in %d out %d ws %zu)\n", n_in, out_size, ws_size); grid = -1; return; }
        int dev = 0, cus = 0, per_cu = 0; (void)hipGetDevice(&dev); (void)hipDeviceGetAttribute(&cus, hipDeviceAttributeMultiprocessorCount, dev);
        if (hipFuncSetAttribute((const void*)fwd, hipFuncAttributeMaxDynamicSharedMemorySize, LDS_BYTES) != hipSuccess) { fprintf(stderr, "kernel_launch: hipFuncSetAttribute failed\n"); grid = -1; return; }
        if (hipOccupancyMaxActiveBlocksPerMultiprocessor(&per_cu, (const void*)fwd, NTHR, LDS_BYTES) != hipSuccess || per_cu < 1) fprintf(stderr, "kernel_launch: occupancy query reports %d\n", per_cu);
        (void)hipGetLastError();
        grid = cus > 0 ? cus : 256;
    }
    if (grid < 0) return;
    (void)hipMemsetAsync((char*)d_ws + WS_CTL, 0, CTL_ZERO_BYTES, stream);
    Args a{};
    for (int i = 0; i < 30; ++i) a.in[i] = (const float*)d_in[i];
    a.out = (float*)d_out; a.ws = (unsigned char*)d_ws;
    hipLaunchKernelGGL(fwd, dim3(grid), dim3(NTHR), LDS_BYTES, stream, a);
}
```

```cpp
#include <hip/hip_runtime.h>
#include <cstdio>
#include <cstdint>

#define LAS __attribute__((address_space(3)))
#define GAS __attribute__((address_space(1)))
typedef unsigned short bf16_t;
typedef short bf16x8 __attribute__((ext_vector_type(8)));
typedef float f32x4 __attribute__((ext_vector_type(4)));
typedef float f32x2 __attribute__((ext_vector_type(2)));
typedef float f32x16 __attribute__((ext_vector_type(16)));
typedef unsigned u32x4 __attribute__((ext_vector_type(4)));
typedef unsigned u32x2 __attribute__((ext_vector_type(2)));

constexpr int D = 1024, NB = 4, SEQ = 4096, DEPTH = 4, CTX = 256;
constexpr int TL = NB * SEQ, TC = NB * CTX, T = TL + TC;
constexpr int PW = 5120, FF = 2816, NE = 8, HYW = 512;
constexpr int PQ = 0, PK = 512, PV = 1024, PHY = 1536, PGA = 3072, PGB = 4096;
constexpr float EPS = 1e-6f;

constexpr size_t MiB = 1u << 20;
constexpr size_t WS_CTL = 0, CTL_ZERO_BYTES = 1 * MiB;
constexpr size_t WS_MOD = 1 * MiB;
constexpr size_t WS_ROUTE = 2 * MiB;
constexpr size_t WS_RWT = 2 * MiB + 512 * 1024;
constexpr size_t WS_TOK = 3 * MiB;
constexpr int CW_CNT = 8192;
constexpr int MAXSLOT = 36864;
constexpr size_t WS_Y = 660 * MiB;
constexpr size_t WS_WIN = 4 * MiB;
constexpr size_t WS_WPAB = 44 * MiB;
constexpr size_t WS_WO = 52 * MiB;
constexpr size_t WS_W13D = 60 * MiB;
constexpr size_t WS_W2D = 82 * MiB;
constexpr size_t WS_W13M = 93 * MiB;
constexpr size_t WS_W2M = 269 * MiB;
constexpr size_t WS_X = 357 * MiB;
constexpr size_t WS_H = 425 * MiB;
constexpr size_t WS_P = 459 * MiB;
constexpr size_t WS_OAH = 629 * MiB;
constexpr size_t WS_B = 663 * MiB;
constexpr size_t WS_OHT = WS_B + 51 * MiB;
constexpr size_t WS_VT = 748 * MiB;
constexpr size_t WS_HRL = 816 * MiB;
constexpr size_t WS_HRC = 850 * MiB;
constexpr size_t WS_END = 853 * MiB;

constexpr int STAG = 3;
constexpr int LDS_BYTES = 147456;
constexpr int NWAVES = 8, NTHR = 512;

#define LDS_WAIT() asm volatile("s_waitcnt lgkmcnt(0)" ::: "memory")
#define VM_WAIT() asm volatile("s_waitcnt vmcnt(0)" ::: "memory")
__device__ __forceinline__ float bf2f(unsigned b) { return __uint_as_float(b << 16); }
__device__ __forceinline__ float bflo(unsigned w) { return __uint_as_float(w << 16); }
__device__ __forceinline__ float bfhi(unsigned w) { return __uint_as_float(w & 0xffff0000u); }
__device__ __forceinline__ unsigned cvt_pk_bf16(float lo, float hi) { unsigned r; asm volatile("v_cvt_pk_bf16_f32 %0, %1, %2" : "=v"(r) : "v"(lo), "v"(hi)); return r; }
__device__ __forceinline__ float wave_sum(float v, int lane) {
#pragma unroll
    for (int o = 1; o < 64; o <<= 1) v += __int_as_float(__builtin_amdgcn_ds_bpermute((lane ^ o) << 2, __float_as_int(v)));
    return v;
}
__device__ __forceinline__ float sigmoidf_(float x) { return 1.f / (1.f + __expf(-x)); }
__device__ __forceinline__ float sin_rev(float r) { return __builtin_amdgcn_sinf(__builtin_amdgcn_fractf(r)); }
__device__ __forceinline__ float sin_rad(float x) { return sin_rev(x * 0.15915494309189535f); }

namespace pg8 {
constexpr int BM = 256, BK = 64, HALF = 128, HTB = HALF * BK * 2, STAGE_BYTES = 8 * HTB, NXCD = 8, WGM = 8;
__host__ __device__ __forceinline__ int lds_byte(int r, int c) { const int st = (r >> 4) * 2 + (c >> 5), rr = r & 15, cc = c & 31, ob = rr * 64 + cc * 2; return st * 1024 + (ob ^ (((ob >> 9) & 1) << 5)); }
__host__ __device__ __forceinline__ void stage_rc(int b, int& R, int& C) { const int st = b / 1024, sb = b % 1024, swz = sb ^ (((sb >> 9) & 1) << 5); R = (st >> 1) * 16 + swz / 64; C = (st & 1) * 32 + (swz % 64) / 2; }
__host__ __device__ __forceinline__ int perm32(int rho) { const int n = rho >> 4, i = rho & 15; return 8 * (i >> 2) + 4 * n + (i & 3); }

struct Unit { int pm, pn; const GAS char* a; const GAS char* b; const GAS int* tk; int nvalid; };
struct Gemm { int K, lda, ldb; int stagger = 0; };

struct StaticOrder {
    int nM, nN, nwg, G, c; const GAS char* A; const GAS char* B; size_t astep, bstep;
    __device__ void init(const GAS void* A_, int lda, const GAS void* B_, int ldb, int M, int N, int G_, int c_) {
        nM = M / BM; nN = N / BM; nwg = nM * nN; G = G_; c = c_; A = (const GAS char*)A_; B = (const GAS char*)B_; astep = (size_t)BM * lda * 2; bstep = (size_t)BM * ldb * 2; }
    __device__ bool next(int i, Unit& u) const {
        const long L = (long)i * G + c; if (L >= nwg) return false;
        int wgid = (int)L; { const int q = nwg / NXCD, r = nwg % NXCD, xcd = wgid % NXCD, off = wgid / NXCD; wgid = (xcd < r ? xcd * (q + 1) : r * (q + 1) + (xcd - r) * q) + off; }
        const int nig = WGM * nN, gid = wgid / nig, fm = gid * WGM, gsz = (nM - fm) < WGM ? (nM - fm) : WGM;
        u.pm = fm + ((wgid % nig) % gsz); u.pn = (wgid % nig) / gsz; u.a = A + (size_t)u.pm * astep; u.b = B + (size_t)u.pn * bstep; return true;
    }
    static constexpr bool GATHER = false;
    __device__ __forceinline__ int arow(const Unit&, int) const { return 0; }
    __device__ __forceinline__ void a_ready(const Unit&) const {}
    __device__ __forceinline__ void done(const Unit&) const {}
};

template <class Epi, class Sched, bool ALIGN_EPI = true>
__device__ __forceinline__ void gemm_phase(LAS unsigned char* lds, const Gemm g, const Sched& S, const Epi& E) {
    int tid = threadIdx.x; asm volatile("" : "+v"(tid));
    const int wid = __builtin_amdgcn_readfirstlane(tid >> 6), lane = tid & 63, wr = wid >> 2, wc = wid & 3, fr = lane & 15, fq = lane >> 4;
    const int K = g.K, nt = K / BK;
    constexpr bool GATHER = Sched::GATHER;
    unsigned voffB[2]; unsigned cA0[2], cA1[2], nA0[2], nA1[2]; int RA[2], CA[2];
    const size_t hstepA = (size_t)HALF * g.lda * 2, hstepB = (size_t)HALF * g.ldb * 2;
#pragma unroll
    for (int i = 0; i < 2; ++i) { int R, C; stage_rc(tid * 16 + i * 8192, R, C); const int Rb = Epi::PERM ? ((R & ~31) + perm32(R & 31)) : R;
        RA[i] = R; CA[i] = C; voffB[i] = (unsigned)(Rb * g.ldb + C) * 2u;
        cA0[i] = (unsigned)(R * g.lda + C) * 2u; cA1[i] = cA0[i]; nA0[i] = cA0[i]; nA1[i] = cA0[i]; }
    const size_t h1A = GATHER ? 0 : hstepA;
    const size_t kstep = (size_t)(BK * 2);
    const unsigned ldsw = (unsigned)wid * 1024u;
    const int aoff = lds_byte(wr * 64 + fr, fq * 8), boff = lds_byte(wc * 32 + fr, fq * 8);
#define PG8_SA(b, h) (((b) * 2 + (h)) * HTB)
#define PG8_SB(b, h) ((4 + (b) * 2 + (h)) * HTB)
#define PG8_STAGE(bufoff, gbase, voff) do { _Pragma("unroll") for (int _i = 0; _i < 2; ++_i) \
        __builtin_amdgcn_global_load_lds((const GAS unsigned*)((const GAS char*)(gbase) + (voff)[_i]), (LAS unsigned*)(lds + (bufoff) + ldsw + _i * 8192), 16, 0, 0); } while (0)
#define PG8_LDA(dst, b, h) do { _Pragma("unroll") for (int m = 0; m < 4; ++m) _Pragma("unroll") for (int k = 0; k < 2; ++k) dst[m][k] = *(const LAS bf16x8*)(lds + PG8_SA(b, h) + aoff + m * 2048 + k * 1024); } while (0)
#define PG8_LDB(dst, b, h) do { _Pragma("unroll") for (int n = 0; n < 2; ++n) _Pragma("unroll") for (int k = 0; k < 2; ++k) dst[n][k] = *(const LAS bf16x8*)(lds + PG8_SB(b, h) + boff + n * 2048 + k * 1024); } while (0)
#define PG8_MMA(ai, bj, At, Bt) do { __builtin_amdgcn_s_setprio(1); _Pragma("unroll") for (int m = 0; m < 4; ++m) _Pragma("unroll") for (int n = 0; n < 2; ++n) _Pragma("unroll") for (int k = 0; k < 2; ++k) \
        acc[ai][bj][m][n] = __builtin_amdgcn_mfma_f32_16x16x32_bf16(Bt[n][k], At[m][k], acc[ai][bj][m][n], 0, 0, 0); __builtin_amdgcn_s_setprio(0); } while (0)
#define PG8_WAIT_V(n) asm volatile("s_waitcnt vmcnt(" #n ")" ::: "memory")
#define PG8_WAIT_L(n) asm volatile("s_waitcnt lgkmcnt(" #n ")" ::: "memory")
#define PG8_BAR __builtin_amdgcn_s_barrier()
#define PG8_SCHED __builtin_amdgcn_sched_barrier(0)
    Unit cur, nxt; int ui = 0;
    if (!S.next(0, cur)) return;
    if (g.stagger > 0) {
        const int slot = (blockIdx.x >> 3) & 7;
        int steps = slot * g.stagger;
        for (int i = 0; i < steps; ++i) __builtin_amdgcn_s_sleep(16);
    }
    if constexpr (GATHER) {
#pragma unroll
        for (int i = 0; i < 2; ++i) { cA0[i] = (unsigned)(S.arow(cur, RA[i]) * g.lda + CA[i]) * 2u; cA1[i] = (unsigned)(S.arow(cur, HALF + RA[i]) * g.lda + CA[i]) * 2u; }
    }
    f32x4 acc[2][2][4][2];
#pragma unroll
    for (int a = 0; a < 2; ++a)
#pragma unroll
        for (int b = 0; b < 2; ++b)
#pragma unroll
            for (int m = 0; m < 4; ++m)
#pragma unroll
                for (int n = 0; n < 2; ++n) acc[a][b][m][n] = (f32x4){0.f, 0.f, 0.f, 0.f};
    bf16x8 At[4][2], B0[2][2], B1[2][2];
    const GAS char* cA = cur.a; const GAS char* cB = cur.b;
    S.a_ready(cur);
    PG8_STAGE(PG8_SB(0, 0), cB, voffB); PG8_STAGE(PG8_SB(0, 1), cB + hstepB, voffB); PG8_STAGE(PG8_SA(0, 0), cA, cA0); PG8_STAGE(PG8_SA(0, 1), cA + h1A, cA1);
    if (wr == 1) PG8_BAR;
    PG8_WAIT_V(2); PG8_BAR;
    PG8_STAGE(PG8_SB(1, 0), cB + kstep, voffB); PG8_STAGE(PG8_SA(1, 0), cA + kstep, cA0); PG8_STAGE(PG8_SB(1, 1), cB + hstepB + kstep, voffB);
    PG8_WAIT_V(6); PG8_BAR;
    for (;;) {
        const bool has_next = S.next(ui + 1, nxt);
        const GAS char* nA = has_next ? nxt.a : cA; const GAS char* nB = has_next ? nxt.b : cB;
        if constexpr (GATHER) {
#pragma unroll
            for (int i = 0; i < 2; ++i) { nA0[i] = has_next ? (unsigned)(S.arow(nxt, RA[i]) * g.lda + CA[i]) * 2u : cA0[i]; nA1[i] = has_next ? (unsigned)(S.arow(nxt, HALF + RA[i]) * g.lda + CA[i]) * 2u : cA1[i]; }
        }
        for (int kh = 0; kh < (Epi::MIDK ? 2 : 1); ++kh) {
        const int tb = Epi::MIDK ? kh * (nt / 2) : 0, te = Epi::MIDK ? tb + nt / 2 : nt;
        for (int t = tb; t < te; t += 2) {
            const bool last = (t == nt - 2);
            const GAS char* a1 = cA + (size_t)(t + 1) * kstep;
            const GAS char* a2 = last ? nA : cA + (size_t)(t + 2) * kstep; const GAS char* b2 = last ? nB : cB + (size_t)(t + 2) * kstep;
            const GAS char* a3 = a2 + kstep; const GAS char* b3 = b2 + kstep;
            unsigned x0[2], x1[2];
#pragma unroll
            for (int i = 0; i < 2; ++i) { x0[i] = (GATHER && last) ? nA0[i] : cA0[i]; x1[i] = GATHER ? (last ? nA1[i] : cA1[i]) : cA0[i]; }
            if (last && has_next) S.a_ready(nxt);
            PG8_LDB(B0, 0, 0); PG8_LDB(B1, 0, 1); PG8_SCHED; PG8_LDA(At, 0, 0); PG8_STAGE(PG8_SA(1, 1), a1 + h1A, cA1);
            PG8_WAIT_V(8); PG8_WAIT_L(0); PG8_BAR; PG8_MMA(0, 0, At, B0); PG8_MMA(0, 1, At, B1); PG8_BAR; PG8_SCHED;
            PG8_LDA(At, 0, 1); PG8_STAGE(PG8_SB(0, 0), b2, voffB); PG8_STAGE(PG8_SB(0, 1), b2 + hstepB, voffB); PG8_STAGE(PG8_SA(0, 0), a2, x0);
            PG8_WAIT_V(8); PG8_WAIT_L(0); PG8_BAR; PG8_MMA(1, 0, At, B0); PG8_MMA(1, 1, At, B1); PG8_BAR; PG8_SCHED;
            PG8_LDB(B0, 1, 0); PG8_LDB(B1, 1, 1); PG8_SCHED; PG8_LDA(At, 1, 0); PG8_STAGE(PG8_SA(0, 1), a2 + h1A, x1);
            PG8_WAIT_V(8); PG8_WAIT_L(0); PG8_BAR; PG8_MMA(0, 0, At, B0); PG8_MMA(0, 1, At, B1); PG8_BAR; PG8_SCHED;
            PG8_LDA(At, 1, 1); PG8_STAGE(PG8_SB(1, 0), b3, voffB); PG8_STAGE(PG8_SB(1, 1), b3 + hstepB, voffB); PG8_STAGE(PG8_SA(1, 0), a3, x0);
            PG8_WAIT_V(8); PG8_WAIT_L(0); PG8_BAR; PG8_MMA(1, 0, At, B0); PG8_MMA(1, 1, At, B1); PG8_BAR; PG8_SCHED;
        }
        if constexpr (Epi::MIDK) { if (kh == 0) E.mid(acc, cur, wr, wc, fr, fq); }
        }
        if constexpr (ALIGN_EPI) { if (wr == 0) PG8_BAR; }
        E(acc, cur, wr, wc, fr, fq); S.done(cur);
        if (!has_next) break;
#pragma unroll
        for (int a = 0; a < 2; ++a)
#pragma unroll
            for (int b = 0; b < 2; ++b)
#pragma unroll
                for (int m = 0; m < 4; ++m)
#pragma unroll
                    for (int n = 0; n < 2; ++n) acc[a][b][m][n] = (f32x4){0.f, 0.f, 0.f, 0.f};
        cur = nxt; cA = nA; cB = nB; ++ui;
        if constexpr (GATHER) {
#pragma unroll
            for (int i = 0; i < 2; ++i) { cA0[i] = nA0[i]; cA1[i] = nA1[i]; }
        }
        if constexpr (ALIGN_EPI) { if (wr == 1) PG8_BAR; }
    }
    PG8_WAIT_V(0);
    if constexpr (!ALIGN_EPI) { if (wr == 0) PG8_BAR; }
    PG8_BAR;
#undef PG8_SA
#undef PG8_SB
#undef PG8_STAGE
#undef PG8_LDA
#undef PG8_LDB
#undef PG8_MMA
#undef PG8_WAIT_V
#undef PG8_WAIT_L
#undef PG8_BAR
#undef PG8_SCHED
}
}

typedef f32x4 AccT[2][2][4][2];
struct EpiStoreBf16 {
    static constexpr bool PERM = true, MIDK = false;
    GAS bf16_t* O; int ldc;
    __device__ __forceinline__ void operator()(const AccT& acc, const pg8::Unit& u, int wr, int wc, int fr, int fq) const {
        const int row0 = u.pm * 256 + wr * 64 + fr, col0 = u.pn * 256 + wc * 32 + 8 * fq;
#pragma unroll
        for (int ai = 0; ai < 2; ++ai)
#pragma unroll
            for (int m = 0; m < 4; ++m) { GAS bf16_t* rowp = O + (size_t)(row0 + ai * 128 + m * 16) * ldc + col0;
#pragma unroll
                for (int bj = 0; bj < 2; ++bj) { const f32x4 v0 = acc[ai][bj][m][0], v1 = acc[ai][bj][m][1];
                    u32x4 w; w.x = cvt_pk_bf16(v0[0], v0[1]); w.y = cvt_pk_bf16(v0[2], v0[3]); w.z = cvt_pk_bf16(v1[0], v1[1]); w.w = cvt_pk_bf16(v1[2], v1[3]);
                    *(GAS u32x4*)(rowp + bj * 128) = w; } }
    }
};
__device__ __forceinline__ float merge_ratio(float ga, float gb) { return (1.f + __expf(-fmaxf(gb, -80.f))) / (1.f + __expf(-ga)); }
__device__ __forceinline__ float merge_final(float gb) { return 1.f / (1.f + __expf(-fmaxf(gb, -80.f))); }
struct EpiMergeK {
    static constexpr bool PERM = true, MIDK = true;
    const GAS bf16_t* P; GAS bf16_t* O;
    __device__ __forceinline__ void mid(AccT& acc, const pg8::Unit& u, int wr, int wc, int fr, int fq) const {
        asm volatile("" : "+v"(fr), "+v"(fq));
        const int row0 = u.pm * 256 + wr * 64 + fr, col0 = u.pn * 256 + wc * 32 + 8 * fq;
#pragma unroll
        for (int ai = 0; ai < 2; ++ai)
#pragma unroll
            for (int m = 0; m < 4; ++m) { const int r = row0 + ai * 128 + m * 16;
#pragma unroll
                for (int bj = 0; bj < 2; ++bj) { const int c = col0 + bj * 128;
                    const u32x4 a = *(const GAS u32x4*)(P + (size_t)r * PW + PGA + c), b = *(const GAS u32x4*)(P + (size_t)r * PW + PGB + c);
                    acc[ai][bj][m][0][0] *= merge_ratio(bflo(a.x), bflo(b.x)); acc[ai][bj][m][0][1] *= merge_ratio(bfhi(a.x), bfhi(b.x));
                    acc[ai][bj][m][0][2] *= merge_ratio(bflo(a.y), bflo(b.y)); acc[ai][bj][m][0][3] *= merge_ratio(bfhi(a.y), bfhi(b.y));
                    acc[ai][bj][m][1][0] *= merge_ratio(bflo(a.z), bflo(b.z)); acc[ai][bj][m][1][1] *= merge_ratio(bfhi(a.z), bfhi(b.z));
                    acc[ai][bj][m][1][2] *= merge_ratio(bflo(a.w), bflo(b.w)); acc[ai][bj][m][1][3] *= merge_ratio(bfhi(a.w), bfhi(b.w)); } }
    }
    __device__ __forceinline__ void operator()(const AccT& acc, const pg8::Unit& u, int wr, int wc, int fr, int fq) const {
        asm volatile("" : "+v"(fr), "+v"(fq));
        const int row0 = u.pm * 256 + wr * 64 + fr, col0 = u.pn * 256 + wc * 32 + 8 * fq;
#pragma unroll
        for (int ai = 0; ai < 2; ++ai)
#pragma unroll
            for (int m = 0; m < 4; ++m) { const int r = row0 + ai * 128 + m * 16;
#pragma unroll
                for (int bj = 0; bj < 2; ++bj) { const int c = col0 + bj * 128;
                    const u32x4 b = *(const GAS u32x4*)(P + (size_t)r * PW + PGB + c);
                    const f32x4 v0 = acc[ai][bj][m][0], v1 = acc[ai][bj][m][1];
                    u32x4 w; w.x = cvt_pk_bf16(v0[0] * merge_final(bflo(b.x)), v0[1] * merge_final(bfhi(b.x))); w.y = cvt_pk_bf16(v0[2] * merge_final(bflo(b.y)), v0[3] * merge_final(bfhi(b.y)));
                    w.z = cvt_pk_bf16(v1[0] * merge_final(bflo(b.z)), v1[1] * merge_final(bfhi(b.z))); w.w = cvt_pk_bf16(v1[2] * merge_final(bflo(b.w)), v1[3] * merge_final(bfhi(b.w)));
                    *(GAS u32x4*)(O + (size_t)r * D + c) = w; } }
    }
};
struct EpiResid {
    static constexpr bool PERM = false, MIDK = false;
    GAS float* x; const GAS float* gate;
    __device__ __forceinline__ void operator()(const AccT& acc, const pg8::Unit& u, int wr, int wc, int fr, int fq) const {
        const int row0 = u.pm * 256 + wr * 64 + fr, col0 = u.pn * 256 + wc * 32 + 4 * fq;
        const int b = (u.pm < 64) ? (u.pm >> 4) : 4;
        const GAS float* gp = gate + (size_t)b * 6144 + col0;
        f32x4 gv[2][2];
#pragma unroll
        for (int bj = 0; bj < 2; ++bj)
#pragma unroll
            for (int n = 0; n < 2; ++n) gv[bj][n] = *(const GAS f32x4*)(gp + bj * 128 + n * 16);
#pragma unroll
        for (int ai = 0; ai < 2; ++ai)
#pragma unroll
            for (int m = 0; m < 4; ++m) { const int r = row0 + ai * 128 + m * 16; GAS float* rowp = x + (size_t)r * D + col0;
#pragma unroll
                for (int bj = 0; bj < 2; ++bj)
#pragma unroll
                    for (int n = 0; n < 2; ++n) { GAS float* p = rowp + bj * 128 + n * 16; *(GAS f32x4*)p = *(const GAS f32x4*)p + gv[bj][n] * acc[ai][bj][m][n]; } }
    }
};
struct EpiSwiglu {
    static constexpr bool PERM = true, MIDK = false;
    GAS bf16_t* O;
    __device__ __forceinline__ void operator()(const AccT& acc, const pg8::Unit& u, int wr, int wc, int fr, int fq) const {
        const int row0 = u.pm * 256 + wr * 64 + fr, col0 = u.pn * 128 + wc * 32 + 8 * fq;
#pragma unroll
        for (int ai = 0; ai < 2; ++ai)
#pragma unroll
            for (int m = 0; m < 4; ++m) { const int r = row0 + ai * 128 + m * 16;
                float o[8];
#pragma unroll
                for (int n = 0; n < 2; ++n)
#pragma unroll
                    for (int j = 0; j < 4; ++j) { const float a = acc[ai][0][m][n][j], g = acc[ai][1][m][n][j]; o[n * 4 + j] = a * sigmoidf_(a) * g; }
                u32x4 w; w.x = cvt_pk_bf16(o[0], o[1]); w.y = cvt_pk_bf16(o[2], o[3]); w.z = cvt_pk_bf16(o[4], o[5]); w.w = cvt_pk_bf16(o[6], o[7]);
                *(GAS u32x4*)(O + (size_t)r * FF + col0) = w; }
    }
};

struct CEpiMergeK { const GAS bf16_t* P; GAS bf16_t* O; static constexpr bool MIDK = true;
    __device__ __forceinline__ void mid(f32x4& acc, int r, int c) const { const u32x2 a = *(const GAS u32x2*)(P + (size_t)r * PW + PGA + c), b = *(const GAS u32x2*)(P + (size_t)r * PW + PGB + c);
        acc[0] *= merge_ratio(bflo(a.x), bflo(b.x)); acc[1] *= merge_ratio(bfhi(a.x), bfhi(b.x)); acc[2] *= merge_ratio(bflo(a.y), bflo(b.y)); acc[3] *= merge_ratio(bfhi(a.y), bfhi(b.y)); }
    __device__ __forceinline__ void operator()(const f32x4& acc, int r, int c) const { const u32x2 b = *(const GAS u32x2*)(P + (size_t)r * PW + PGB + c);
        u32x2 w; w.x = cvt_pk_bf16(acc[0] * merge_final(bflo(b.x)), acc[1] * merge_final(bfhi(b.x))); w.y = cvt_pk_bf16(acc[2] * merge_final(bflo(b.y)), acc[3] * merge_final(bfhi(b.y)));
        *(GAS u32x2*)(O + (size_t)r * D + c) = w; } };
struct CEpiResid { GAS float* x; const GAS float* gate; static constexpr bool MIDK = false;
    __device__ __forceinline__ void mid(f32x4&, int, int) const {}
    __device__ __forceinline__ void operator()(const f32x4& acc, int r, int c) const { GAS float* p = x + (size_t)r * D + c; *(GAS f32x4*)p = *(const GAS f32x4*)p + *(const GAS f32x4*)(gate + c) * acc; } };
template <class Epi>
__device__ __forceinline__ void ctx_gemm(LAS unsigned char* lds, const GAS bf16_t* X, int ldx, const GAS bf16_t* Wt, int ldw, int K, const Epi& E) {
    int tid = threadIdx.x; asm volatile("" : "+v"(tid));
    const int wave = tid >> 6, lane = tid & 63, li = lane & 15, kg = lane >> 4, kp = wave >> 1, ch = wave & 1;
    LAS float* part = (LAS float*)lds;
    for (int tile = blockIdx.x; tile < 256; tile += gridDim.x) {
        const int row0 = TL + (tile >> 2) * 16, colb = (tile & 3) * 256, col0 = colb + ch * 128;
        const int kq = K >> 2, kbeg = kp * kq;
        const GAS bf16_t* xp = X + (size_t)(row0 + li) * ldx + 8 * kg + kbeg;
        const GAS bf16_t* wp = Wt + (size_t)(col0 + li) * ldw + 8 * kg + kbeg;
        f32x4 acc[8];
#pragma unroll
        for (int cb = 0; cb < 8; ++cb) acc[cb] = (f32x4){0.f, 0.f, 0.f, 0.f};
#pragma unroll 2
        for (int k0 = 0; k0 < kq; k0 += 32) {
            const bf16x8 xf = *(const GAS bf16x8*)(xp + k0);
#pragma unroll
            for (int cb = 0; cb < 8; ++cb) { const bf16x8 wf = *(const GAS bf16x8*)(wp + (size_t)(16 * cb) * ldw + k0); acc[cb] = __builtin_amdgcn_mfma_f32_16x16x32_bf16(wf, xf, acc[cb], 0, 0, 0); }
        }
        if constexpr (Epi::MIDK) { if (kp < 2) {
#pragma unroll
            for (int cb = 0; cb < 8; ++cb) E.mid(acc[cb], row0 + li, col0 + 16 * cb + 4 * kg); } }
#pragma unroll
        for (int cb = 0; cb < 8; ++cb) *(LAS f32x4*)(part + (kp * 16 + li) * 260 + ch * 128 + 16 * cb + 4 * kg) = acc[cb];
        __syncthreads();
        { const int r = tid >> 5, cc = (tid & 31) * 8;
          f32x4 o0 = (f32x4){0.f, 0.f, 0.f, 0.f}, o1 = o0;
#pragma unroll
          for (int q = 0; q < 4; ++q) { o0 += *(const LAS f32x4*)(part + (q * 16 + r) * 260 + cc); o1 += *(const LAS f32x4*)(part + (q * 16 + r) * 260 + cc + 4); }
          E(o0, row0 + r, colb + cc); E(o1, row0 + r, colb + cc + 4); }
        __syncthreads();
    }
}

struct Args { const float* in[30]; float* out; unsigned char* ws; int l, e, ph, pad; };
enum { I_X = 0, I_C, I_CTX, I_CCTX, I_WMOD, I_BMOD, I_N1G, I_N2G, I_WIN, I_RPB, I_HCW, I_HCB, I_HW1, I_HB1, I_HW2, I_HB2, I_HW3, I_HFREQ, I_HBIAS,
       I_WPA, I_WPB, I_WO, I_FW1, I_FW3, I_FW2, I_ROUTER, I_MW1, I_MW3, I_MW2, I_FINALG };

constexpr int MISC_OFF = 131072 + 320;
constexpr int PTR_OFF = MISC_OFF + 128;
struct Ctx {
    LAS unsigned char* lds; int tid, lane, wave, G, bid; GAS unsigned char* ws;
};
__device__ __forceinline__ Ctx mk_ctx(LAS unsigned char* lds, GAS unsigned char* ws) {
    Ctx c; int t = threadIdx.x; asm volatile("" : "+v"(t)); asm volatile("" : "+s"(ws)); c.lds = lds; c.tid = t; c.lane = t & 63; c.wave = __builtin_amdgcn_readfirstlane(t >> 6); c.G = gridDim.x; c.bid = blockIdx.x; c.ws = ws; return c;
}
__device__ __forceinline__ const GAS float* inp(const Ctx& c, int i) {
    unsigned ao = (unsigned)(PTR_OFF + 8 * i); asm volatile("" : "+v"(ao));
    const volatile LAS unsigned* p = (const volatile LAS unsigned*)(c.lds + ao);
    const unsigned lo = __builtin_amdgcn_readfirstlane(p[0]), hi = __builtin_amdgcn_readfirstlane(p[1]);
    return (const GAS float*)(((unsigned long long)hi << 32) | (unsigned long long)lo);
}

__device__ __forceinline__ void transpose_item(const GAS float* W, int N, GAS bf16_t* WT, int ldk, int k0, int n0, int drow0, LAS float* scr, int lane) {
    float wv[32];
    const GAS float* wp = W + (size_t)(k0 + (lane >> 5)) * N + n0 + (lane & 31);
#pragma unroll
    for (int i = 0; i < 32; ++i) wv[i] = wp[(size_t)(2 * i) * N];
#pragma unroll
    for (int i = 0; i < 32; ++i) scr[(2 * i + (lane >> 5)) * 33 + (lane & 31)] = wv[i];
    LDS_WAIT(); asm volatile("" ::: "memory");
    const int c = lane & 7;
#pragma unroll
    for (int j = 0; j < 4; ++j) { const int n = (lane >> 3) + 8 * j; const LAS float* s = scr + (8 * c) * 33 + n;
        u32x4 o; o.x = cvt_pk_bf16(s[0 * 33], s[1 * 33]); o.y = cvt_pk_bf16(s[2 * 33], s[3 * 33]); o.z = cvt_pk_bf16(s[4 * 33], s[5 * 33]); o.w = cvt_pk_bf16(s[6 * 33], s[7 * 33]);
        *(GAS u32x4*)(WT + (size_t)(drow0 + n) * ldk + k0 + 8 * c) = o; }
    LDS_WAIT(); asm volatile("" ::: "memory");
}
__device__ __forceinline__ void conv_mat(const GAS float* W, int K, int N, GAS bf16_t* WT, int mode, int& base, int gw, int NGW, LAS float* scr, int lane, int ldk = 0) {
    if (ldk == 0) ldk = K;
    const int nblk = N / 32, nitems = (K / 64) * nblk;
    const int start = (gw - (base % NGW) + NGW) % NGW;
    for (int it = start; it < nitems; it += NGW) {
        const int kb = it / nblk, nb = it % nblk, n0 = nb * 32;
        const int drow0 = mode == 0 ? n0 : ((n0 >> 7) * 256 + (n0 & 127) + (mode == 2 ? 128 : 0));
        transpose_item(W, N, WT, ldk, kb * 64, n0, drow0, scr, lane);
    }
    base += nitems;
}
__device__ __forceinline__ void ph_convert(const Ctx& c0) {
    const Ctx c = mk_ctx(c0.lds, c0.ws);
    GAS unsigned char* ws = c.ws;
    LAS float* scr = (LAS float*)(c.lds + c.wave * 16384);
    const int gw = c.bid * NWAVES + c.wave, NGW = c.G * NWAVES; int base = 0;
    for (int l = 0; l < DEPTH; ++l) {
        conv_mat(inp(c, I_WIN) + (size_t)l * D * PW, D, PW, (GAS bf16_t*)(ws + WS_WIN) + (size_t)l * PW * D, 0, base, gw, NGW, scr, c.lane);
        conv_mat(inp(c, I_WPA) + (size_t)l * 512 * D, 512, D, (GAS bf16_t*)(ws + WS_WPAB) + (size_t)l * D * D, 0, base, gw, NGW, scr, c.lane, D);
        conv_mat(inp(c, I_WPB) + (size_t)l * 512 * D, 512, D, (GAS bf16_t*)(ws + WS_WPAB) + (size_t)l * D * D + 512, 0, base, gw, NGW, scr, c.lane, D);
        conv_mat(inp(c, I_WO) + (size_t)l * D * D, D, D, (GAS bf16_t*)(ws + WS_WO) + (size_t)l * D * D, 0, base, gw, NGW, scr, c.lane);
    }
    for (int i = 0; i < 2; ++i) {
        conv_mat(inp(c, I_FW1) + (size_t)i * D * FF, D, FF, (GAS bf16_t*)(ws + WS_W13D) + (size_t)i * 2 * FF * D, 1, base, gw, NGW, scr, c.lane);
        conv_mat(inp(c, I_FW3) + (size_t)i * D * FF, D, FF, (GAS bf16_t*)(ws + WS_W13D) + (size_t)i * 2 * FF * D, 2, base, gw, NGW, scr, c.lane);
        conv_mat(inp(c, I_FW2) + (size_t)i * FF * D, FF, D, (GAS bf16_t*)(ws + WS_W2D) + (size_t)i * D * FF, 0, base, gw, NGW, scr, c.lane);
    }
    for (int ie = 0; ie < 2 * NE; ++ie) {
        conv_mat(inp(c, I_MW1) + (size_t)ie * D * FF, D, FF, (GAS bf16_t*)(ws + WS_W13M) + (size_t)ie * 2 * FF * D, 1, base, gw, NGW, scr, c.lane);
        conv_mat(inp(c, I_MW3) + (size_t)ie * D * FF, D, FF, (GAS bf16_t*)(ws + WS_W13M) + (size_t)ie * 2 * FF * D, 2, base, gw, NGW, scr, c.lane);
        conv_mat(inp(c, I_MW2) + (size_t)ie * FF * D, FF, D, (GAS bf16_t*)(ws + WS_W2M) + (size_t)ie * D * FF, 0, base, gw, NGW, scr, c.lane);
    }
}

__device__ __forceinline__ void ph_mod(const Ctx& c0) {
    const Ctx c = mk_ctx(c0.lds, c0.ws);
    GAS float* mod = (GAS float*)(c.ws + WS_MOD);
    LAS float* s = (LAS float*)c.lds; LAS float* part = s + 5 * 1024;
    const GAS float* cin = inp(c, I_C); const GAS float* cctx = inp(c, I_CCTX); const GAS float* wmod = inp(c, I_WMOD); const GAS float* bmod = inp(c, I_BMOD);
    for (int i = c.tid; i < 5 * 1024; i += NTHR) { const int r = i >> 10, k = i & 1023; const float v = r < 4 ? cin[r * 1024 + k] : cctx[k]; s[i] = v * sigmoidf_(v); }
    __syncthreads();
    for (int unit = c.bid; unit < DEPTH * 96; unit += c.G) {
        const int l = unit / 96, j0 = (unit % 96) * 64;
        const GAS float* w = wmod + (size_t)l * D * 6144 + j0 + c.lane;
        float acc[5] = {0.f, 0.f, 0.f, 0.f, 0.f};
        const int kb = c.wave * 128;
#pragma unroll 32
        for (int k = 0; k < 128; ++k) { const float wv = w[(size_t)(kb + k) * 6144];
#pragma unroll
            for (int r = 0; r < 5; ++r) acc[r] += s[r * 1024 + kb + k] * wv; }
#pragma unroll
        for (int r = 0; r < 5; ++r) part[(c.wave * 5 + r) * 64 + c.lane] = acc[r];
        __syncthreads();
        if (c.tid < 320) { const int r = c.tid >> 6, ln = c.tid & 63; float sum = 0.f;
#pragma unroll
            for (int w8 = 0; w8 < 8; ++w8) sum += part[(w8 * 5 + r) * 64 + ln];
            mod[(size_t)(l * 5 + r) * 6144 + j0 + ln] = sum + bmod[l * 6144 + j0 + ln]; }
        __syncthreads();
    }
}

__device__ __forceinline__ void ph_filt(const Ctx& c0) {
    const Ctx c = mk_ctx(c0.lds, c0.ws);
    const GAS float* hb1 = inp(c, I_HB1); const GAS float* hw1 = inp(c, I_HW1); const GAS float* hb2 = inp(c, I_HB2); const GAS float* hw2 = inp(c, I_HW2); const GAS float* hfreq = inp(c, I_HFREQ); const GAS float* hw3 = inp(c, I_HW3);
    LAS float* zb = (LAS float*)c.lds;
    LAS float* a1 = zb + 16 * 36;
    LAS float* a2 = a1 + 16 * 64;
    const float MINDEC = -3.0701134573253945f, MAXDEC = -15.350567286626973f;
    for (int unit = c.bid; unit < DEPTH * 272; unit += c.G) {
        const int l = unit / 272, uu = unit % 272;
        const int L = uu < 256 ? 4096 : 256, p0 = uu < 256 ? uu * 16 : (uu - 256) * 16;
        for (int i = c.tid; i < 16 * 33; i += NTHR) { const int p = i / 33, q = i % 33; const int pos = p0 + p; float v;
            if (q == 0) v = (float)pos / (float)(L - 1);
            else { const int j = (q - 1) & 15; const double band = 1e-4 + (double)j * ((15.0 - 1e-4) / 15.0); double rev = (double)pos * band / (double)L; rev -= floor(rev);
                v = q <= 16 ? __builtin_amdgcn_cosf((float)rev) : -__builtin_amdgcn_sinf((float)rev); }
            zb[p * 36 + q] = v; }
        __syncthreads();
        for (int i = c.tid; i < 16 * 64; i += NTHR) { const int p = i >> 6, j = i & 63; float s = hb1[l * 64 + j];
            const GAS float* w = hw1 + (size_t)l * 33 * 64 + j;
            for (int q = 0; q < 33; ++q) s += zb[p * 36 + q] * w[q * 64];
            a1[p * 64 + j] = sin_rad(hfreq[l * 128 + j] * s); }
        __syncthreads();
        for (int i = c.tid; i < 16 * 64; i += NTHR) { const int p = i >> 6, j = i & 63; float s = hb2[l * 64 + j];
            const GAS float* w = hw2 + (size_t)l * 64 * 64 + j;
            for (int q = 0; q < 64; ++q) s += a1[p * 64 + q] * w[q * 64];
            a2[p * 64 + j] = sin_rad(hfreq[l * 128 + 64 + j] * s); }
        __syncthreads();
        {
            float acc0[16], acc1[16];
#pragma unroll
            for (int p = 0; p < 16; ++p) { acc0[p] = 0.f; acc1[p] = 0.f; }
            const GAS float* w3 = hw3 + (size_t)l * 64 * 1024 + c.tid;
            for (int k = 0; k < 64; k += 4) { float wa[4], wb[4];
#pragma unroll
                for (int q = 0; q < 4; ++q) { wa[q] = w3[(k + q) * 1024]; wb[q] = w3[(k + q) * 1024 + 512]; }
#pragma unroll
                for (int p = 0; p < 16; ++p) { const f32x4 av = *(const LAS f32x4*)(a2 + p * 64 + k);
#pragma unroll
                    for (int q = 0; q < 4; ++q) { acc0[p] += av[q] * wa[q]; acc1[p] += av[q] * wb[q]; } } }
            GAS bf16_t* hro = uu < 256 ? (GAS bf16_t*)(c.ws + WS_HRL) + ((size_t)(l * 2) * 512 + c.tid) * (4096 + 64) : (GAS bf16_t*)(c.ws + WS_HRC) + ((size_t)(l * 2) * 512 + c.tid) * (256 + 64);
            const size_t ostride = (size_t)512 * (L + 64);
            float f0[16], f1[16];
            const float r0 = fabsf(MINDEC + (float)c.tid * ((MAXDEC - MINDEC) / 1023.f)), r1 = fabsf(MINDEC + (float)(c.tid + 512) * ((MAXDEC - MINDEC) / 1023.f));
#pragma unroll
            for (int p = 0; p < 16; ++p) { const int pos = p0 + p; const float dist = fabsf((float)(pos - L / 2)) * (2.f / (float)L);
                f0[p] = acc0[p] * (__expf(-dist * r0) + 0.05f); f1[p] = acc1[p] * (__expf(-dist * r1) + 0.05f); }
            {   u32x4 w0, w1, v0, v1;
                w0.x = cvt_pk_bf16(f0[15], f0[14]); w0.y = cvt_pk_bf16(f0[13], f0[12]); w0.z = cvt_pk_bf16(f0[11], f0[10]); w0.w = cvt_pk_bf16(f0[9], f0[8]);
                w1.x = cvt_pk_bf16(f0[7], f0[6]); w1.y = cvt_pk_bf16(f0[5], f0[4]); w1.z = cvt_pk_bf16(f0[3], f0[2]); w1.w = cvt_pk_bf16(f0[1], f0[0]);
                v0.x = cvt_pk_bf16(f1[15], f1[14]); v0.y = cvt_pk_bf16(f1[13], f1[12]); v0.z = cvt_pk_bf16(f1[11], f1[10]); v0.w = cvt_pk_bf16(f1[9], f1[8]);
                v1.x = cvt_pk_bf16(f1[7], f1[6]); v1.y = cvt_pk_bf16(f1[5], f1[4]); v1.z = cvt_pk_bf16(f1[3], f1[2]); v1.w = cvt_pk_bf16(f1[1], f1[0]);
                GAS bf16_t* d0 = hro + (L + 16 - p0); GAS bf16_t* d1 = d0 + ostride;
                *(GAS u32x4*)d0 = w0; *(GAS u32x4*)(d0 + 8) = w1; *(GAS u32x4*)d1 = v0; *(GAS u32x4*)(d1 + 8) = v1;
                const u32x4 z4 = (u32x4){0u, 0u, 0u, 0u};
                if (p0 == 0) { for (int k = 0; k < 4; ++k) { *(GAS u32x4*)(hro + L + 32 + 8 * k) = z4; *(GAS u32x4*)(hro + ostride + L + 32 + 8 * k) = z4; } }
                if (p0 == L - 16) { for (int k = 0; k < 4; ++k) { *(GAS u32x4*)(hro + 8 * k) = z4; *(GAS u32x4*)(hro + ostride + 8 * k) = z4; } } }
        }
        __syncthreads();
    }
}

struct MoeComb { const GAS int* route; const GAS float* rwt; const GAS bf16_t* y; const GAS float* gate; };
__device__ __forceinline__ void moe_combine_row(const MoeComb& mc, const LAS unsigned* offs, int row, int b, int lane, f32x4 (&v)[4]) {
    const int e1 = mc.route[(size_t)row * 4 + 0], p1 = mc.route[(size_t)row * 4 + 1], e2 = mc.route[(size_t)row * 4 + 2], p2 = mc.route[(size_t)row * 4 + 3];
    const float w1 = mc.rwt[(size_t)row * 2], w2 = mc.rwt[(size_t)row * 2 + 1];
    const size_t s1 = (size_t)offs[e1] + p1, s2 = (size_t)offs[e2] + p2;
    const GAS float* gt = mc.gate + (size_t)b * 6144;
#pragma unroll
    for (int j = 0; j < 4; ++j) { const int k0 = 4 * (lane + 64 * j);
        const u32x2 a = *(const GAS u32x2*)(mc.y + s1 * D + k0), bq = *(const GAS u32x2*)(mc.y + s2 * D + k0); const f32x4 g4 = *(const GAS f32x4*)(gt + k0);
        v[j][0] += g4[0] * (w1 * bflo(a.x) + w2 * bflo(bq.x)); v[j][1] += g4[1] * (w1 * bfhi(a.x) + w2 * bfhi(bq.x));
        v[j][2] += g4[2] * (w1 * bflo(a.y) + w2 * bflo(bq.y)); v[j][3] += g4[3] * (w1 * bfhi(a.y) + w2 * bfhi(bq.y)); }
}
__device__ __forceinline__ void moe_offsets(const Ctx& c, int i, LAS unsigned* offs) {
    if (c.tid == 0) { const GAS unsigned* cnt = (const GAS unsigned*)(c.ws + WS_CTL) + CW_CNT + 64 * i; unsigned o = 0;
        for (int e = 0; e < 8; ++e) { offs[e] = o; o += (cnt[e] + 255u) & ~255u; } offs[8] = o; }
}
__device__ __forceinline__ void ph_norm(const Ctx& c0, int l, int which) {
    const Ctx c = mk_ctx(c0.lds, c0.ws);
    GAS float* xres = (GAS float*)(c.ws + WS_X); GAS bf16_t* h = (GAS bf16_t*)(c.ws + WS_H);
    const GAS float* mod = (const GAS float*)(c.ws + WS_MOD) + (size_t)l * 5 * 6144;
    const GAS float* gp = (which == 0 ? inp(c, I_N1G) : inp(c, I_N2G)) + l * D;
    const bool first = (l == 0 && which == 0), route = (which == 1 && (l & 1));
    const int comb = (which == 0 && l >= 1 && ((l - 1) & 1)) ? ((l - 1) >> 1) : -1;
    const GAS float* router = inp(c, I_ROUTER) + (size_t)(l >> 1) * D * NE;
    GAS int* routeb = (GAS int*)(c.ws + WS_ROUTE); GAS float* rwt = (GAS float*)(c.ws + WS_RWT); GAS int* tokenof = (GAS int*)(c.ws + WS_TOK);
    const MoeComb mc{routeb, rwt, (const GAS bf16_t*)(c.ws + WS_Y), (const GAS float*)(c.ws + WS_MOD) + (size_t)(l > 0 ? l - 1 : 0) * 5 * 6144 + 5 * 1024};
    LAS unsigned* lcnt = (LAS unsigned*)c.lds; LAS unsigned* gbase = lcnt + 16; LAS unsigned* offs = lcnt + 32; LAS int* pend = (LAS int*)(c.lds + 256);
    if (c.tid < 8) lcnt[c.tid] = 0u;
    if (comb >= 0) moe_offsets(c, comb, offs);
    LAS float* rlds = (LAS float*)(c.lds + 4096);
    if (route) { for (int i = c.tid; i < D * NE / 4; i += NTHR) *(LAS f32x4*)(rlds + 4 * i) = *(const GAS f32x4*)(router + 4 * i); }
    __syncthreads();
    const GAS float* xin = inp(c, I_X); const GAS float* ctxin = inp(c, I_CTX);
    int nrows = 0;
    const int nrow_all = (which == 1 && l == DEPTH - 1) ? TL : T;
#define NORM_SRC(rw) (first ? ((rw) < TL ? xin + (size_t)(rw) * D : ctxin + (size_t)((rw) - TL) * D) : xres + (size_t)(rw) * D)
    const int rstride = c.G * NWAVES;
    f32x4 vnx[4];
    { const int row = c.bid * NWAVES + c.wave; if (row < nrow_all) { const GAS float* src = NORM_SRC(row);
#pragma unroll
        for (int j = 0; j < 4; ++j) vnx[j] = *(const GAS f32x4*)(src + 4 * (c.lane + 64 * j)); } }
    for (int row = c.bid * NWAVES + c.wave; row < nrow_all; row += rstride, ++nrows) {
        const int b = row < TL ? (row >> 12) : 4;
        const GAS float* sh = mod + (size_t)b * 6144 + (which == 0 ? 0 : 3) * 1024; const GAS float* sc = sh + 1024;
        f32x4 v[4]; float ss = 0.f;
#pragma unroll
        for (int j = 0; j < 4; ++j) v[j] = vnx[j];
        if (row + rstride < nrow_all) { const GAS float* srcn = NORM_SRC(row + rstride);
#pragma unroll
            for (int j = 0; j < 4; ++j) vnx[j] = *(const GAS f32x4*)(srcn + 4 * (c.lane + 64 * j)); }
        if (comb >= 0) moe_combine_row(mc, offs, row, b, c.lane, v);
#pragma unroll
        for (int j = 0; j < 4; ++j) ss += (v[j][0] * v[j][0] + v[j][1] * v[j][1]) + (v[j][2] * v[j][2] + v[j][3] * v[j][3]);
        ss = wave_sum(ss, c.lane);
        const float rstd = 1.f / sqrtf(ss * (1.f / D) + EPS);
        if (first || comb >= 0) {
#pragma unroll
            for (int j = 0; j < 4; ++j) *(GAS f32x4*)(xres + (size_t)row * D + 4 * (c.lane + 64 * j)) = v[j];
        }
        float lg[8] = {0.f, 0.f, 0.f, 0.f, 0.f, 0.f, 0.f, 0.f};
#pragma unroll
        for (int j = 0; j < 4; ++j) { const int k0 = 4 * (c.lane + 64 * j);
            const f32x4 g4 = *(const GAS f32x4*)(gp + k0), s4 = *(const GAS f32x4*)(sc + k0), h4 = *(const GAS f32x4*)(sh + k0);
            f32x4 o;
#pragma unroll
            for (int q = 0; q < 4; ++q) o[q] = v[j][q] * rstd * g4[q] * (1.f + s4[q]) + h4[q];
            u32x2 w; w.x = cvt_pk_bf16(o[0], o[1]); w.y = cvt_pk_bf16(o[2], o[3]);
            *(GAS u32x2*)(h + (size_t)row * D + k0) = w;
            if (route) {
#pragma unroll
                for (int q = 0; q < 4; ++q) { const f32x4 ra = *(const LAS f32x4*)(rlds + (k0 + q) * 8), rb = *(const LAS f32x4*)(rlds + (k0 + q) * 8 + 4);
                    lg[0] += o[q] * ra[0]; lg[1] += o[q] * ra[1]; lg[2] += o[q] * ra[2]; lg[3] += o[q] * ra[3];
                    lg[4] += o[q] * rb[0]; lg[5] += o[q] * rb[1]; lg[6] += o[q] * rb[2]; lg[7] += o[q] * rb[3]; }
            }
        }
        if (route) {
#pragma unroll
            for (int e = 0; e < 8; ++e) lg[e] = wave_sum(lg[e], c.lane);
            int i1 = 0; float v1 = lg[0];
#pragma unroll
            for (int e = 1; e < 8; ++e) if (lg[e] > v1) { v1 = lg[e]; i1 = e; }
            int i2 = -1; float v2 = -3.0e38f;
#pragma unroll
            for (int e = 0; e < 8; ++e) if (e != i1 && lg[e] > v2) { v2 = lg[e]; i2 = e; }
            const float w1 = 1.f / (1.f + __expf(v2 - v1)), w2 = 1.f - w1;
            if (c.lane == 0) {
                const unsigned lp1 = __hip_atomic_fetch_add(lcnt + i1, 1u, __ATOMIC_RELAXED, __HIP_MEMORY_SCOPE_WORKGROUP), lp2 = __hip_atomic_fetch_add(lcnt + i2, 1u, __ATOMIC_RELAXED, __HIP_MEMORY_SCOPE_WORKGROUP);
                LAS int* pe = pend + (c.wave * 16 + nrows) * 4; pe[0] = row; pe[1] = i1 | (i2 << 8); pe[2] = (int)lp1; pe[3] = (int)lp2;
                rwt[(size_t)row * 2] = w1; rwt[(size_t)row * 2 + 1] = w2; }
        }
    }
    if (route) {
        __syncthreads();
        if (c.tid < 8) gbase[c.tid] = __hip_atomic_fetch_add((GAS unsigned*)(c.ws + WS_CTL) + CW_CNT + 64 * (l >> 1) + c.tid, lcnt[c.tid], __ATOMIC_RELAXED, __HIP_MEMORY_SCOPE_AGENT);
        __syncthreads();
        if (c.lane < nrows) { const LAS int* pe = pend + (c.wave * 16 + c.lane) * 4; const int row = pe[0], e1 = pe[1] & 255, e2 = pe[1] >> 8;
            const int p1 = (int)gbase[e1] + pe[2], p2 = (int)gbase[e2] + pe[3];
            tokenof[(size_t)e1 * T + p1] = row; tokenof[(size_t)e2 * T + p2] = row;
            routeb[(size_t)row * 4 + 0] = e1; routeb[(size_t)row * 4 + 1] = p1; routeb[(size_t)row * 4 + 2] = e2; routeb[(size_t)row * 4 + 3] = p2; }
    }
    __syncthreads();
}

__device__ __forceinline__ void ph_sc(const Ctx& c0, int l) {
    const Ctx c = mk_ctx(c0.lds, c0.ws);
    const GAS bf16_t* P = (const GAS bf16_t*)(c.ws + WS_P); GAS bf16_t* uT = (GAS bf16_t*)(c.ws + WS_B); GAS bf16_t* VT = (GAS bf16_t*)(c.ws + WS_VT);
    const GAS float* cw = inp(c, I_HCW) + (size_t)l * 3 * 1536; const GAS float* cb = inp(c, I_HCB) + (size_t)l * 1536;
    LAS unsigned char* scr = c.lds + c.wave * 16384;
    for (int tile = c.bid * NWAVES + c.wave; tile < (T / 64) * 32; tile += c.G * NWAVES) {
        const int rt = tile / 32, row0 = rt * 64, ct = tile % 32; const bool isv = ct >= 24;
        const int ch0 = isv ? (ct - 24) * 64 : ct * 64, scol = isv ? PV + ch0 : PHY + ch0; GAS bf16_t* dst = isv ? VT : uT;
        const int tpos = row0 < TL ? (row0 & 4095) : ((row0 - TL) & 255), Ls = row0 < TL ? 4096 : 256;
        for (int idx = c.lane; idx < 66 * 8; idx += 64) { const int rr = idx >> 3, ck = idx & 7; const int grow = row0 - 1 + rr;
            const bool ok = !((rr == 0 && tpos == 0) || (rr == 65 && tpos + 64 == Ls));
            u32x4 v = (u32x4){0u, 0u, 0u, 0u};
            if (ok) v = *(const GAS u32x4*)(P + (size_t)grow * PW + scol + ck * 8);
            LAS unsigned* d = (LAS unsigned*)(scr + rr * 132 + ck * 16); d[0] = v.x; d[1] = v.y; d[2] = v.z; d[3] = v.w; }
        LDS_WAIT(); asm volatile("" ::: "memory");
        const int ch = ch0 + c.lane; const float w0 = isv ? 0.f : cw[ch], w1 = isv ? 1.f : cw[1536 + ch], w2 = isv ? 0.f : cw[3072 + ch], bb = isv ? 0.f : cb[ch];
        unsigned ow[32];
        { float prev = bf2f(*(const LAS unsigned short*)(scr + 0 * 132 + c.lane * 2)), cur = bf2f(*(const LAS unsigned short*)(scr + 1 * 132 + c.lane * 2)); float o0 = 0.f;
#pragma unroll
          for (int r = 0; r < 64; ++r) { const float nxt = bf2f(*(const LAS unsigned short*)(scr + (r + 2) * 132 + c.lane * 2));
              const float o = w0 * prev + w1 * cur + w2 * nxt + bb; prev = cur; cur = nxt;
              if (r & 1) ow[r >> 1] = cvt_pk_bf16(o0, o); else o0 = o; } }
        LDS_WAIT(); asm volatile("" ::: "memory");
#pragma unroll
        for (int k = 0; k < 8; ++k) { u32x4 v; v.x = ow[4 * k]; v.y = ow[4 * k + 1]; v.z = ow[4 * k + 2]; v.w = ow[4 * k + 3]; *(LAS u32x4*)(scr + c.lane * 144 + k * 16) = v; }
        LDS_WAIT(); asm volatile("" ::: "memory");
#pragma unroll
        for (int k = 0; k < 8; ++k) { const int cc = (c.lane >> 3) + 8 * k, ck = c.lane & 7; const u32x4 v = *(const LAS u32x4*)(scr + cc * 144 + ck * 16);
            *(GAS u32x4*)(dst + (size_t)(ch0 + cc) * T + row0 + ck * 8) = v; }
        LDS_WAIT(); asm volatile("" ::: "memory");
    }
}

constexpr int HY_HR_OFF = 512, HY_U_OFF = HY_HR_OFF + 66560, HY_ZB_OFF = HY_U_OFF + 4 * 8208;
template <int L, bool DUAL>
__device__ __forceinline__ void hy_span(LAS unsigned char* lds, int nsteps, int aaddr, int ubase, int sX, int sY, f32x16& accX, f32x16& accY) {
#define HY_BADDR(sv) (((unsigned)(sv) <= (unsigned)(L - 16)) ? ubase + 2 * (sv) : HY_ZB_OFF)
    int k = 0;
    for (; k + 4 <= nsteps; k += 4) {
        const int pa = aaddr - 768;
        const int px0 = HY_BADDR(sX), px1 = HY_BADDR(sX - 16), px2 = HY_BADDR(sX - 32), px3 = HY_BADDR(sX - 48);
        bf16x8 a0, a1, a2, a3, x0, x1, x2, x3;
        if (DUAL) {
            const int py0 = HY_BADDR(sY), py1 = HY_BADDR(sY - 16), py2 = HY_BADDR(sY - 32), py3 = HY_BADDR(sY - 48);
            bf16x8 y0, y1, y2, y3;
            asm volatile(
                "ds_read_b128 %[a0], %[pa] offset:768\n\tds_read_b128 %[x0], %[px0]\n\tds_read_b128 %[y0], %[py0]\n\t"
                "ds_read_b128 %[a1], %[pa] offset:512\n\tds_read_b128 %[x1], %[px1]\n\tds_read_b128 %[y1], %[py1]\n\t"
                "ds_read_b128 %[a2], %[pa] offset:256\n\tds_read_b128 %[x2], %[px2]\n\tds_read_b128 %[y2], %[py2]\n\t"
                "ds_read_b128 %[a3], %[pa]\n\tds_read_b128 %[x3], %[px3]\n\tds_read_b128 %[y3], %[py3]\n\t"
                "s_waitcnt lgkmcnt(9)\n\tv_mfma_f32_32x32x16_bf16 %[cx], %[a0], %[x0], %[cx]\n\tv_mfma_f32_32x32x16_bf16 %[cy], %[a0], %[y0], %[cy]\n\t"
                "s_waitcnt lgkmcnt(6)\n\tv_mfma_f32_32x32x16_bf16 %[cx], %[a1], %[x1], %[cx]\n\tv_mfma_f32_32x32x16_bf16 %[cy], %[a1], %[y1], %[cy]\n\t"
                "s_waitcnt lgkmcnt(3)\n\tv_mfma_f32_32x32x16_bf16 %[cx], %[a2], %[x2], %[cx]\n\tv_mfma_f32_32x32x16_bf16 %[cy], %[a2], %[y2], %[cy]\n\t"
                "s_waitcnt lgkmcnt(0)\n\tv_mfma_f32_32x32x16_bf16 %[cx], %[a3], %[x3], %[cx]\n\tv_mfma_f32_32x32x16_bf16 %[cy], %[a3], %[y3], %[cy]\n\t"
                : [cx] "+v"(accX), [cy] "+v"(accY), [a0] "=&v"(a0), [a1] "=&v"(a1), [a2] "=&v"(a2), [a3] "=&v"(a3), [x0] "=&v"(x0), [x1] "=&v"(x1), [x2] "=&v"(x2), [x3] "=&v"(x3),
                  [y0] "=&v"(y0), [y1] "=&v"(y1), [y2] "=&v"(y2), [y3] "=&v"(y3)
                : [pa] "v"(pa), [px0] "v"(px0), [px1] "v"(px1), [px2] "v"(px2), [px3] "v"(px3), [py0] "v"(py0), [py1] "v"(py1), [py2] "v"(py2), [py3] "v"(py3));
        } else {
            asm volatile(
                "ds_read_b128 %[a0], %[pa] offset:768\n\tds_read_b128 %[x0], %[px0]\n\t"
                "ds_read_b128 %[a1], %[pa] offset:512\n\tds_read_b128 %[x1], %[px1]\n\t"
                "ds_read_b128 %[a2], %[pa] offset:256\n\tds_read_b128 %[x2], %[px2]\n\t"
                "ds_read_b128 %[a3], %[pa]\n\tds_read_b128 %[x3], %[px3]\n\t"
                "s_waitcnt lgkmcnt(6)\n\tv_mfma_f32_32x32x16_bf16 %[cx], %[a0], %[x0], %[cx]\n\t"
                "s_waitcnt lgkmcnt(4)\n\tv_mfma_f32_32x32x16_bf16 %[cx], %[a1], %[x1], %[cx]\n\t"
                "s_waitcnt lgkmcnt(2)\n\tv_mfma_f32_32x32x16_bf16 %[cx], %[a2], %[x2], %[cx]\n\t"
                "s_waitcnt lgkmcnt(0)\n\tv_mfma_f32_32x32x16_bf16 %[cx], %[a3], %[x3], %[cx]\n\t"
                : [cx] "+v"(accX), [a0] "=&v"(a0), [a1] "=&v"(a1), [a2] "=&v"(a2), [a3] "=&v"(a3), [x0] "=&v"(x0), [x1] "=&v"(x1), [x2] "=&v"(x2), [x3] "=&v"(x3)
                : [pa] "v"(pa), [px0] "v"(px0), [px1] "v"(px1), [px2] "v"(px2), [px3] "v"(px3));
        }
        aaddr -= 1024; sX -= 64; sY -= 64;
    }
    for (; k < nsteps; ++k) {
        const bf16x8 af = *(const LAS bf16x8*)(lds + aaddr), xf = *(const LAS bf16x8*)(lds + HY_BADDR(sX));
        accX = __builtin_amdgcn_mfma_f32_32x32x16_bf16(af, xf, accX, 0, 0, 0);
        if (DUAL) { const bf16x8 yf = *(const LAS bf16x8*)(lds + HY_BADDR(sY)); accY = __builtin_amdgcn_mfma_f32_32x32x16_bf16(af, yf, accY, 0, 0, 0); }
        aaddr -= 256; sX -= 16; sY -= 16;
    }
#undef HY_BADDR
}
template <int L>
__device__ __forceinline__ void hy_unit(const Ctx& c, int l, int ch, const GAS float* hbias) {
    constexpr int H = L / 2, NG = L / 256, LP = L + 64, NW = L / 8 + 8, ROWB = 2 * L + 16;
    LAS unsigned char* lds = c.lds;
    const GAS bf16_t* uT = (const GAS bf16_t*)(c.ws + WS_B); GAS bf16_t* oht = (GAS bf16_t*)(c.ws + WS_OHT);
    const int seq0 = (L == 4096) ? 0 : TL;
    const GAS bf16_t* hrbase = (L == 4096) ? (const GAS bf16_t*)(c.ws + WS_HRL) : (const GAS bf16_t*)(c.ws + WS_HRC);
    int gA, gB;
    if (NG == 16) { gA = c.wave < 4 ? c.wave : 4 + c.wave; gB = c.wave < 4 ? 7 - c.wave : 19 - c.wave; } else { gA = c.wave == 0 ? 0 : -1; gB = -1; }
    const int n = c.lane & 31, g = c.lane >> 5, tbl = n >> 2, b = n & 3;
    const int loA = gA < 0 ? 1 << 30 : max(-H - 16, 256 * gA - (L - 16)), hiA = gA < 0 ? -(1 << 30) : min(H, 256 * gA + 224);
    const int loB = gB < 0 ? 1 << 30 : max(-H - 16, 256 * gB - (L - 16)), hiB = gB < 0 ? -(1 << 30) : min(H, 256 * gB + 224);
    const int dlo = min(loA, loB), dhi = max(hiA, hiB);
    unsigned zreg[2][4][2];
    for (int o = 0; o < 2; ++o) {
        const GAS bf16_t* hr = hrbase + ((size_t)(l * 2 + o) * 512 + ch) * LP;
        for (int w = c.tid; w < NW; w += NTHR) {
            u32x4 A4 = (u32x4){0u, 0u, 0u, 0u}; if (w > 0) A4 = *(const GAS u32x4*)(hr + 8 * (w - 1));
            const u32x4 B4 = *(const GAS u32x4*)(hr + 8 * w);
            const unsigned Dd[8] = {A4.x, A4.y, A4.z, A4.w, B4.x, B4.y, B4.z, B4.w};
#pragma unroll
            for (int q = 0; q < 8; ++q) { u32x4 ov;
                if ((q & 1) == 0) { const int j = (8 - q) / 2; ov.x = Dd[j]; ov.y = Dd[j + 1]; ov.z = Dd[j + 2]; ov.w = Dd[j + 3]; }
                else { const int j = (7 - q) / 2; ov.x = __builtin_amdgcn_alignbit(Dd[j + 1], Dd[j], 16); ov.y = __builtin_amdgcn_alignbit(Dd[j + 2], Dd[j + 1], 16);
                       ov.z = __builtin_amdgcn_alignbit(Dd[j + 3], Dd[j + 2], 16); ov.w = __builtin_amdgcn_alignbit(Dd[j + 4], Dd[j + 3], 16); }
                *(LAS u32x4*)(lds + HY_HR_OFF + (8 * w + q) * 16) = ov; }
        }
        if (o == 0) {
            for (int idx = c.tid; idx < 4 * (L / 8); idx += NTHR) { const int bb = idx / (L / 8), wq = idx % (L / 8);
                *(LAS u32x4*)(lds + HY_U_OFF + bb * ROWB + wq * 16) = *(const GAS u32x4*)(uT + (size_t)ch * T + seq0 + bb * L + wq * 8); }
            if (c.tid < 16) *(LAS unsigned*)(lds + HY_ZB_OFF + c.tid * 4) = 0u;
        } else {
#pragma unroll
            for (int gi = 0; gi < 2; ++gi) { const int G = gi == 0 ? gA : gB; if (G >= 0) {
#pragma unroll
                for (int rq = 0; rq < 4; ++rq) { const int t = 32 * (8 * G + tbl) + 8 * rq + 4 * g;
                    u32x2 zz; zz.x = zreg[gi][rq][0]; zz.y = zreg[gi][rq][1]; *(LAS u32x2*)(lds + HY_U_OFF + b * ROWB + 2 * t) = zz; } } }
        }
        __syncthreads();
        f32x16 accA, accB;
#pragma unroll
        for (int r = 0; r < 16; ++r) { accA[r] = 0.f; accB[r] = 0.f; }
        {
            const int qq = (n + 1) & 7, ubase = HY_U_OFF + b * ROWB + 16 * g;
#define HY_AADDR(d) (HY_HR_OFF + (8 * ((H + 31 - (d) - n + 8 * g + qq) >> 3) + qq) * 16)
#define HY_S0(G, d) (32 * (8 * (G) + tbl) - (d))
            if (gB < 0) { if (gA >= 0) hy_span<L, false>(lds, (hiA - loA) / 16 + 1, HY_AADDR(loA), ubase, HY_S0(gA, loA), 0, accA, accB); }
            else {
                const int dS = max(loA, loB), dE = min(hiA, hiB);
                if (loA < dS) hy_span<L, false>(lds, (dS - loA) / 16, HY_AADDR(loA), ubase, HY_S0(gA, loA), 0, accA, accB);
                else if (loB < dS) hy_span<L, false>(lds, (dS - loB) / 16, HY_AADDR(loB), ubase, HY_S0(gB, loB), 0, accB, accA);
                hy_span<L, true>(lds, (dE - dS) / 16 + 1, HY_AADDR(dS), ubase, HY_S0(gA, dS), HY_S0(gB, dS), accA, accB);
                if (hiA > dE) hy_span<L, false>(lds, (hiA - dE) / 16, HY_AADDR(dE + 16), ubase, HY_S0(gA, dE + 16), 0, accA, accB);
                else if (hiB > dE) hy_span<L, false>(lds, (hiB - dE) / 16, HY_AADDR(dE + 16), ubase, HY_S0(gB, dE + 16), 0, accB, accA);
            }
#undef HY_AADDR
#undef HY_S0
        }
        const float bias = hbias[(l * 2 + o) * 512 + ch];
        int tbl_e = tbl, b_e = b, g_e = g; asm volatile("" : "+v"(tbl_e), "+v"(b_e), "+v"(g_e));
#pragma unroll
        for (int gi = 0; gi < 2; ++gi) { const int G = gi == 0 ? gA : gB; if (G >= 0) {
#pragma unroll
            for (int rq = 0; rq < 4; ++rq) { const int t = 32 * (8 * G + tbl_e) + 8 * rq + 4 * g_e;
                const u32x2 uv = *(const LAS u32x2*)(lds + HY_U_OFF + b_e * ROWB + 2 * t);
                const size_t grow = (size_t)seq0 + b_e * L + t;
                const u32x2 xv = *(const GAS u32x2*)(uT + (size_t)((o == 0 ? 512 : 1024) + ch) * T + grow);
                float y[4];
#pragma unroll
                for (int k = 0; k < 4; ++k) y[k] = gi == 0 ? accA[4 * rq + k] : accB[4 * rq + k];
                const float r0 = bflo(xv.x) * (y[0] + bias * bflo(uv.x)), r1 = bfhi(xv.x) * (y[1] + bias * bfhi(uv.x));
                const float r2 = bflo(xv.y) * (y[2] + bias * bflo(uv.y)), r3 = bfhi(xv.y) * (y[3] + bias * bfhi(uv.y));
                const unsigned p0 = cvt_pk_bf16(r0, r1), p1 = cvt_pk_bf16(r2, r3);
                if (o == 0) { zreg[gi][rq][0] = p0; zreg[gi][rq][1] = p1; }
                else { u32x2 ov; ov.x = p0; ov.y = p1; *(GAS u32x2*)(oht + (size_t)ch * T + grow) = ov;   } } } }
        __syncthreads();
    }
}
__device__ __forceinline__ void ph_hyena(const Ctx& c0, int l) {
    const Ctx c = mk_ctx(c0.lds, c0.ws);
    const GAS float* hbias = inp(c, I_HBIAS);
    for (int unit = c.bid; unit < HYW; unit += c.G) { hy_unit<4096>(c, l, unit, hbias); if (l < DEPTH - 1) hy_unit<256>(c, l, unit, hbias); }
}

__device__ __forceinline__ void ph_ohy_t(const Ctx& c0) {
    const Ctx c = mk_ctx(c0.lds, c0.ws);
    const GAS bf16_t* src = (const GAS bf16_t*)(c.ws + WS_OHT); GAS bf16_t* dst = (GAS bf16_t*)(c.ws + WS_OAH) + 512;
    LAS unsigned char* scr = c.lds + c.wave * 16384;
    for (int tile = c.bid * NWAVES + c.wave; tile < (T / 64) * 8; tile += c.G * NWAVES) {
        const int row0 = (tile >> 3) * 64, ch0 = (tile & 7) * 64;
#pragma unroll
        for (int k = 0; k < 8; ++k) { const int cc = (c.lane >> 3) + 8 * k, ck = c.lane & 7;
            const u32x4 v = *(const GAS u32x4*)(src + (size_t)(ch0 + cc) * T + row0 + ck * 8);
            LAS unsigned* d = (LAS unsigned*)(scr + cc * 132 + ck * 16); d[0] = v.x; d[1] = v.y; d[2] = v.z; d[3] = v.w; }
        LDS_WAIT(); asm volatile("" ::: "memory");
        unsigned ow[32];
#pragma unroll
        for (int j = 0; j < 32; ++j) { const unsigned lo = *(const LAS unsigned short*)(scr + (2 * j) * 132 + c.lane * 2), hi = *(const LAS unsigned short*)(scr + (2 * j + 1) * 132 + c.lane * 2); ow[j] = lo | (hi << 16); }
        LDS_WAIT(); asm volatile("" ::: "memory");
#pragma unroll
        for (int k = 0; k < 8; ++k) { u32x4 v; v.x = ow[4 * k]; v.y = ow[4 * k + 1]; v.z = ow[4 * k + 2]; v.w = ow[4 * k + 3]; *(LAS u32x4*)(scr + c.lane * 144 + k * 16) = v; }
        LDS_WAIT(); asm volatile("" ::: "memory");
#pragma unroll
        for (int k = 0; k < 8; ++k) { const int rr = (c.lane >> 3) + 8 * k, ck = c.lane & 7; const u32x4 v = *(const LAS u32x4*)(scr + rr * 144 + ck * 16);
            *(GAS u32x4*)(dst + (size_t)(row0 + rr) * 1024 + ch0 + ck * 8) = v; }
        LDS_WAIT(); asm volatile("" ::: "memory");
    }
}

constexpr int ATT_RPB_OFF = 1024, ATT_VT_OFF = ATT_RPB_OFF + 8 * 15 * 32 * 4, ATT_VT_BYTES = 64 * 72;
template <int MODE>
__device__ __forceinline__ void att_block(const GAS bf16_t* P, const GAS bf16_t* VT, LAS unsigned char* lds, LAS unsigned char* vt, int lane, int n, int h, int head,
                                          int tokk, int ctok, int tabaddr, int vb, const bf16x8 (&qf)[4], f32x16& ot0, f32x16& ot1, float& m, float& lsum) {
    bf16x8 kf[4];
#pragma unroll
    for (int ks = 0; ks < 4; ++ks) kf[ks] = *(const GAS bf16x8*)(P + (size_t)tokk * PW + PK + head * 64 + 16 * ks + 8 * h);
    u32x2 vr[8];
#pragma unroll
    for (int it = 0; it < 8; ++it) vr[it] = *(const GAS u32x2*)(VT + (size_t)(head * 64 + it * 8 + (lane >> 3)) * T + ctok);
    f32x16 st;
#pragma unroll
    for (int r = 0; r < 16; ++r) st[r] = 0.f;
#pragma unroll
    for (int ks = 0; ks < 4; ++ks) st = __builtin_amdgcn_mfma_f32_32x32x16_bf16(kf[ks], qf[ks], st, 0, 0, 0);
    const float SC = 0.18033688011112042f;
    float sv[16];
#pragma unroll
    for (int r = 0; r < 16; ++r) {
        if (MODE == 2) sv[r] = st[r] * SC;
        else { const int cr = MODE == 0 ? 8 * (r >> 2) + (r & 3) : (r & 3), imm = MODE == 0 ? cr * 4 : ((r >> 2) * 32 + (r & 3)) * 4;
            const float bias = *(const LAS float*)(lds + tabaddr + imm);
            const bool ok = (unsigned)(vb + cr) < 16u;
            sv[r] = ok ? st[r] * SC + bias : -1.0e30f; }
    }
    float bm = sv[0];
#pragma unroll
    for (int r = 1; r < 16; ++r) bm = fmaxf(bm, sv[r]);
    bm = fmaxf(bm, __int_as_float(__builtin_amdgcn_ds_bpermute((lane ^ 32) << 2, __float_as_int(bm))));
    const float mn = fmaxf(m, bm), alpha = __builtin_amdgcn_exp2f(m - mn); m = mn;
    float psum = 0.f;
#pragma unroll
    for (int r = 0; r < 16; ++r) { const float pv = __builtin_amdgcn_exp2f(sv[r] - mn); psum += pv; sv[r] = pv; }
    lsum = lsum * alpha + psum;
#pragma unroll
    for (int r = 0; r < 16; ++r) { ot0[r] *= alpha; ot1[r] *= alpha; }
    bf16x8 pb[2];
#pragma unroll
    for (int s2 = 0; s2 < 2; ++s2) { u32x4 w; w.x = cvt_pk_bf16(sv[8 * s2], sv[8 * s2 + 1]); w.y = cvt_pk_bf16(sv[8 * s2 + 2], sv[8 * s2 + 3]);
        w.z = cvt_pk_bf16(sv[8 * s2 + 4], sv[8 * s2 + 5]); w.w = cvt_pk_bf16(sv[8 * s2 + 6], sv[8 * s2 + 7]); pb[s2] = __builtin_bit_cast(bf16x8, w); }
#pragma unroll
    for (int it = 0; it < 8; ++it) *(LAS u32x2*)(vt + (it * 8 + (lane >> 3)) * 72 + (lane & 7) * 8) = vr[it];
#pragma unroll
    for (int s2 = 0; s2 < 2; ++s2) {
        { const u32x2 a = *(const LAS u32x2*)(vt + n * 72 + (4 * s2 + h) * 8), bq = *(const LAS u32x2*)(vt + n * 72 + (4 * s2 + 2 + h) * 8);
          u32x4 w; w.x = a.x; w.y = a.y; w.z = bq.x; w.w = bq.y; ot0 = __builtin_amdgcn_mfma_f32_32x32x16_bf16(__builtin_bit_cast(bf16x8, w), pb[s2], ot0, 0, 0, 0); }
        { const u32x2 a = *(const LAS u32x2*)(vt + (32 + n) * 72 + (4 * s2 + h) * 8), bq = *(const LAS u32x2*)(vt + (32 + n) * 72 + (4 * s2 + 2 + h) * 8);
          u32x4 w; w.x = a.x; w.y = a.y; w.z = bq.x; w.w = bq.y; ot1 = __builtin_amdgcn_mfma_f32_32x32x16_bf16(__builtin_bit_cast(bf16x8, w), pb[s2], ot1, 0, 0, 0); }
    }
}
constexpr int ATT_UNITS = 4096 + 256;
__device__ __forceinline__ void ph_attn(const Ctx& c0, int l) {
    const Ctx c = mk_ctx(c0.lds, c0.ws);
    const GAS bf16_t* P = (const GAS bf16_t*)(c.ws + WS_P); const GAS bf16_t* VT = (const GAS bf16_t*)(c.ws + WS_VT); GAS bf16_t* oatt = (GAS bf16_t*)(c.ws + WS_OAH);
    const GAS float* rpb = inp(c, I_RPB) + (size_t)l * 8 * 15 * 31;
    LAS unsigned char* lds = c.lds;
    for (int i = c.tid; i < 8 * 15 * 32; i += NTHR) { const int hd = i / 480, rem = i % 480, dr = rem >> 5, dc = rem & 31;
        *(LAS float*)(lds + ATT_RPB_OFF + i * 4) = dc < 31 ? rpb[(hd * 15 + dr) * 31 + dc] * 1.4426950408889634f : 0.f; }
    __syncthreads();
    LAS unsigned char* vt = lds + ATT_VT_OFF + c.wave * ATT_VT_BYTES;
    const int lane = c.lane, n = lane & 31, h = lane >> 5;
    const int natt = l < DEPTH - 1 ? ATT_UNITS : 4096;
    for (int u = c.bid * NWAVES + c.wave; u < natt; u += c.G * NWAVES) {
        const bool lat = u < 4096;
        int b, head, r = 0, hf = 0, tokq;
        if (lat) { hf = u & 1; r = (u >> 1) & 63; head = (u >> 7) & 7; b = u >> 10; tokq = b * 4096 + r * 64 + 32 * hf + n; }
        else { const int uu = u - 4096; head = (uu >> 3) & 7; b = uu >> 6; tokq = TL + b * 256 + 32 * (uu & 7) + n; }
        bf16x8 qf[4];
#pragma unroll
        for (int ks = 0; ks < 4; ++ks) qf[ks] = *(const GAS bf16x8*)(P + (size_t)tokq * PW + PQ + head * 64 + 16 * ks + 8 * h);
        f32x16 ot0, ot1;
#pragma unroll
        for (int q = 0; q < 16; ++q) { ot0[q] = 0.f; ot1[q] = 0.f; }
        float m = -1.0e30f, lsum = 0.f;
        if (lat) {
            const int r0 = min(max(r - 4, 0), 56), lo = hf ? 24 : 0, qc = 32 * hf + n, c0q = min(max(qc - 8, 0), 48);
            for (int kb = 0; kb < 8; ++kb) {
                const int base = b * 4096 + (r0 + kb) * 64 + lo, kx = lo + 4 * h;
                const int tabaddr = ATT_RPB_OFF + (((head * 15 + (r0 + kb - r + 7)) * 32) + kx - qc + 15) * 4;
                att_block<0>(P, VT, lds, vt, lane, n, h, head, base + n, base + 4 * (lane & 7), tabaddr, kx - c0q, qf, ot0, ot1, m, lsum);
            }
            for (int kb = 0; kb < 2; ++kb) {
                const int rowb = b * 4096 + (r0 + 4 * kb) * 64 + lo + 32, kx = lo + 32 + 4 * h, cc = lane & 7;
                const int tabaddr = ATT_RPB_OFF + (((head * 15 + (r0 + 4 * kb - r + 7)) * 32) + kx - qc + 15) * 4;
                att_block<1>(P, VT, lds, vt, lane, n, h, head, rowb + (n >> 3) * 64 + (n & 7), rowb + (cc >> 1) * 64 + 4 * (cc & 1), tabaddr, kx - c0q, qf, ot0, ot1, m, lsum);
            }
        }
        for (int kb = 0; kb < 8; ++kb) { const int base = TL + b * 256 + 32 * kb;
            att_block<2>(P, VT, lds, vt, lane, n, h, head, base + n, base + 4 * (lane & 7), 0, 0, qf, ot0, ot1, m, lsum); }
        const float ltot = lsum + __int_as_float(__builtin_amdgcn_ds_bpermute((lane ^ 32) << 2, __float_as_int(lsum)));
        const float inv = 1.f / ltot;
        GAS bf16_t* op = oatt + (size_t)tokq * 1024 + head * 64 + 4 * h;
#pragma unroll
        for (int rq = 0; rq < 4; ++rq) {
            u32x2 w0, w1; w0.x = cvt_pk_bf16(ot0[4 * rq] * inv, ot0[4 * rq + 1] * inv); w0.y = cvt_pk_bf16(ot0[4 * rq + 2] * inv, ot0[4 * rq + 3] * inv);
            w1.x = cvt_pk_bf16(ot1[4 * rq] * inv, ot1[4 * rq + 1] * inv); w1.y = cvt_pk_bf16(ot1[4 * rq + 2] * inv, ot1[4 * rq + 3] * inv);
            *(GAS u32x2*)(op + 8 * rq) = w0; *(GAS u32x2*)(op + 32 + 8 * rq) = w1; }
    }
    __syncthreads();
}

__device__ __forceinline__ void ph_final(const Ctx& c0) {
    const Ctx c = mk_ctx(c0.lds, c0.ws);
    const GAS float* xres = (const GAS float*)(c.ws + WS_X); const GAS float* gp = inp(c, I_FINALG); GAS float* outp = (GAS float*)inp(c, 30);
    const MoeComb mc{(const GAS int*)(c.ws + WS_ROUTE), (const GAS float*)(c.ws + WS_RWT), (const GAS bf16_t*)(c.ws + WS_Y), (const GAS float*)(c.ws + WS_MOD) + (size_t)(DEPTH - 1) * 5 * 6144 + 5 * 1024};
    LAS unsigned* offs = (LAS unsigned*)c.lds + 32;
    moe_offsets(c, 1, offs);
    __syncthreads();
    for (int row = c.bid * NWAVES + c.wave; row < TL; row += c.G * NWAVES) {
        const GAS float* src = xres + (size_t)row * D; f32x4 v[4]; float ss = 0.f;
#pragma unroll
        for (int j = 0; j < 4; ++j) v[j] = *(const GAS f32x4*)(src + 4 * (c.lane + 64 * j));
        moe_combine_row(mc, offs, row, row >> 12, c.lane, v);
#pragma unroll
        for (int j = 0; j < 4; ++j) ss += (v[j][0] * v[j][0] + v[j][1] * v[j][1]) + (v[j][2] * v[j][2] + v[j][3] * v[j][3]);
        ss = wave_sum(ss, c.lane);
        const float rstd = 1.f / sqrtf(ss * (1.f / D) + EPS);
#pragma unroll
        for (int j = 0; j < 4; ++j) { const int k0 = 4 * (c.lane + 64 * j); const f32x4 g4 = *(const GAS f32x4*)(gp + k0); *(GAS f32x4*)(outp + (size_t)row * D + k0) = v[j] * rstd * g4; }
    }
}

constexpr int MOE_OFF = 132096;
template <bool GATHER_> struct MoeOrder {
    static constexpr bool GATHER = GATHER_;
    int nM, nN, nwg, G, c; const GAS char* A; const GAS char* B; size_t astep, bstep, estep; const GAS int* tokenof; const LAS unsigned* tab;
    __device__ void init(const GAS void* A_, int lda, const GAS void* B_, int ldb, size_t estep_bytes, int N, int G_, int c_, const GAS int* tok, const LAS unsigned* tab_) {
        tab = tab_; nM = (int)((unsigned)__builtin_amdgcn_readfirstlane(tab[8]) >> 8); nN = N / pg8::BM; nwg = nM * nN; G = G_; c = c_; A = (const GAS char*)A_; B = (const GAS char*)B_;
        astep = (size_t)pg8::BM * lda * 2; bstep = (size_t)pg8::BM * ldb * 2; estep = estep_bytes; tokenof = tok; }
    __device__ bool next(int i, pg8::Unit& u) const {
        const long L = (long)i * G + c; if (L >= nwg) return false;
        int wgid = (int)L; { const int q = nwg / pg8::NXCD, r = nwg % pg8::NXCD, xcd = wgid % pg8::NXCD, off = wgid / pg8::NXCD; wgid = (xcd < r ? xcd * (q + 1) : r * (q + 1) + (xcd - r) * q) + off; }
        const int nig = pg8::WGM * nN, gid = wgid / nig, fm = gid * pg8::WGM, gsz = (nM - fm) < pg8::WGM ? (nM - fm) : pg8::WGM;
        u.pm = fm + ((wgid % nig) % gsz); u.pn = (wgid % nig) / gsz;
        const unsigned slot0 = (unsigned)u.pm << 8; int e = 0;
#pragma unroll
        for (int j = 1; j < 8; ++j) e += (slot0 >= (unsigned)__builtin_amdgcn_readfirstlane(tab[j])) ? 1 : 0;
        const unsigned pos0 = slot0 - (unsigned)__builtin_amdgcn_readfirstlane(tab[e]), cnt = (unsigned)__builtin_amdgcn_readfirstlane(tab[16 + e]);
        u.nvalid = cnt > pos0 ? (int)(cnt - pos0) : 0; u.tk = tokenof + (size_t)e * T + pos0;
        u.a = GATHER ? A : A + (size_t)u.pm * astep; u.b = B + (size_t)e * estep + (size_t)u.pn * bstep; return true;
    }
    __device__ __forceinline__ int arow(const pg8::Unit& u, int r) const { return r < u.nvalid ? u.tk[r] : 0; }
    __device__ __forceinline__ void a_ready(const pg8::Unit&) const {}
    __device__ __forceinline__ void done(const pg8::Unit&) const {}
};
__device__ __forceinline__ void moe_table(const Ctx& c, int i) {
    LAS unsigned* tab = (LAS unsigned*)(c.lds + MOE_OFF);
    if (c.tid == 0) { const GAS unsigned* cnt = (const GAS unsigned*)(c.ws + WS_CTL) + CW_CNT + 64 * i; unsigned o = 0;
        for (int e = 0; e < 8; ++e) { const unsigned ce = cnt[e]; tab[e] = o; tab[16 + e] = ce; o += (ce + 255u) & ~255u; } tab[8] = o; }
    __syncthreads();
}

#define XB_TMO      128
#define XB_XCNT(j)  (256  + 64 * (j))
#define XB_XSUB(j)  (1280 + 64 * (j))
#define XB_XGEN(j)  (2304 + 64 * (j))
#define XB_TOP      3328
#define XB_TOPGEN   3392
#define XCD_BAR_WORDS 3456
#define XB_SPIN_CAP (1u << 18)
__device__ __forceinline__ unsigned xb_ld(GAS unsigned* p)              { return __hip_atomic_load(p, __ATOMIC_RELAXED, __HIP_MEMORY_SCOPE_AGENT); }
__device__ __forceinline__ unsigned xb_add(GAS unsigned* p, unsigned v) { return __hip_atomic_fetch_add(p, v, __ATOMIC_RELAXED, __HIP_MEMORY_SCOPE_AGENT); }
__device__ __forceinline__ unsigned xb_xcc_id() { return (unsigned)__builtin_amdgcn_s_getreg((3 << 11) | 20) & 0xFu; }
#define XB_SPIN(cond, bar) do { unsigned _sp = 0; while (cond) { __builtin_amdgcn_s_sleep(1); \
    if ((++_sp & 255u) == 0u) { if (xb_ld(&(bar)[XB_TMO])) break; if (_sp > XB_SPIN_CAP) { (void)xb_add(&(bar)[XB_TMO], 1u); break; } } } } while (0)
struct XcdBarrier { GAS unsigned* bar; unsigned x; volatile LAS unsigned* st; };
__device__ __forceinline__ XcdBarrier xcd_barrier_post(GAS unsigned* bar, volatile LAS unsigned* st) {
    XcdBarrier b; b.bar = bar; b.x = xb_xcc_id(); b.st = st;
    if (threadIdx.x == 0) (void)xb_add(&bar[XB_XCNT(b.x)], 1u);
    return b;
}
__device__ __forceinline__ void xcd_barrier_complete(GAS unsigned* bar, unsigned x, unsigned& nloc, unsigned& nx) {
    const unsigned G = gridDim.x * gridDim.y * gridDim.z;
    unsigned sum, cnt, mine, sp = 0u;
    for (;;) {
        sum = 0u; cnt = 0u; mine = 0u;
#pragma unroll
        for (unsigned j = 0; j < 16; ++j) { const unsigned c = xb_ld(&bar[XB_XCNT(j)]); sum += c; cnt += (c > 0u) ? 1u : 0u; mine = (j == x) ? c : mine; }
        if (sum == G) break;
        __builtin_amdgcn_s_sleep(1);
        if ((++sp & 255u) == 0u) { if (xb_ld(&bar[XB_TMO])) break; if (sp > XB_SPIN_CAP) { (void)xb_add(&bar[XB_TMO], 1u); break; } }
    }
    nloc = mine > 0u ? mine : 1u; nx = cnt > 0u ? cnt : 1u;
}
__device__ __forceinline__ void xcd_barrier(const XcdBarrier& b) {
    asm volatile("s_waitcnt vmcnt(0)" ::: "memory");
    __syncthreads();
    if (threadIdx.x == 0) {
        GAS unsigned* bar = b.bar; asm volatile("" : "+s"(bar));     const unsigned bx = xb_xcc_id();
        __builtin_amdgcn_s_waitcnt(0);
        unsigned nloc = b.st[0], nx = b.st[1];
        if (nloc == 0u) { xcd_barrier_complete(bar, bx, nloc, nx); b.st[0] = nloc; b.st[1] = nx; }
        const unsigned old = xb_add(&bar[XB_XSUB(bx)], 1u);
        const unsigned gen = old / nloc;
        if (old + 1u == (gen + 1u) * nloc) {
            __builtin_amdgcn_fence(__ATOMIC_RELEASE, "agent");
            asm volatile("s_waitcnt vmcnt(0)" ::: "memory");
            const unsigned og = xb_add(&bar[XB_TOP], 1u);
            const unsigned tg = og / nx;
            if (og + 1u == (tg + 1u) * nx) xb_add(&bar[XB_TOPGEN], 1u);
            else XB_SPIN(xb_ld(&bar[XB_TOPGEN]) == tg, bar);
            __builtin_amdgcn_fence(__ATOMIC_ACQUIRE, "agent");
            xb_add(&bar[XB_XGEN(bx)], 1u);
            asm volatile("s_waitcnt vmcnt(0)" ::: "memory");
        } else {
            XB_SPIN(xb_ld(&bar[XB_XGEN(bx)]) == gen, bar);
            __builtin_amdgcn_fence(__ATOMIC_ACQUIRE, "agent");
            asm volatile("s_waitcnt vmcnt(0)" ::: "memory");
        }
    }
    __syncthreads();
}

constexpr int CW_BAR = 4096;

__global__ void __launch_bounds__(NTHR, 2) fwd(Args args) {
    extern __shared__ __attribute__((aligned(16))) unsigned char lds_raw[];
    Ctx c; c.lds = (LAS unsigned char*)lds_raw; c.tid = threadIdx.x; c.lane = c.tid & 63; c.wave = __builtin_amdgcn_readfirstlane(c.tid >> 6); c.G = gridDim.x; c.bid = blockIdx.x; c.ws = (GAS unsigned char*)args.ws;
    GAS unsigned char* ws = (GAS unsigned char*)args.ws;
    volatile LAS unsigned* MISC = (volatile LAS unsigned*)(c.lds + MISC_OFF);
    if (c.tid < 32) MISC[c.tid] = 0u;
    if (c.tid < 31) { const unsigned long long pv = c.tid < 30 ? (unsigned long long)args.in[c.tid] : (unsigned long long)args.out;
        volatile LAS unsigned* pt = (volatile LAS unsigned*)(c.lds + PTR_OFF) + 2 * c.tid; pt[0] = (unsigned)pv; pt[1] = (unsigned)(pv >> 32); }
    __syncthreads();
    XcdBarrier bar = xcd_barrier_post((GAS unsigned*)(ws + WS_CTL) + CW_BAR, MISC + 8);
#define GRID_BAR() xcd_barrier(bar)

    ph_convert(c); __syncthreads(); ph_mod(c); __syncthreads(); ph_filt(c);
    GRID_BAR();
    for (int l = 0; l < DEPTH; ++l) {
        ph_norm(c, l, 0);
        GRID_BAR();
        {   GAS unsigned char* ws = c.ws; asm volatile("" : "+s"(ws));
            pg8::Gemm g{D, D, D, STAG}; pg8::StaticOrder S; S.init(ws + WS_H, D, (GAS bf16_t*)(ws + WS_WIN) + (size_t)l * PW * D, D, T, PW, c.G, c.bid);
            EpiStoreBf16 E{(GAS bf16_t*)(ws + WS_P), PW};
            pg8::gemm_phase(c.lds, g, S, E); }
        GRID_BAR();
        ph_sc(c, l);
        GRID_BAR();
        ph_hyena(c, l); ph_attn(c, l);
        GRID_BAR();
        ph_ohy_t(c);
        GRID_BAR();
        {   GAS unsigned char* ws = c.ws; asm volatile("" : "+s"(ws));
            const GAS bf16_t* wab = (const GAS bf16_t*)(ws + WS_WPAB) + (size_t)l * D * D;
            pg8::Gemm g{D, D, D}; pg8::StaticOrder S; S.init(ws + WS_OAH, D, wab, D, TL, D, c.G, c.bid);
            EpiMergeK E{(const GAS bf16_t*)(ws + WS_P), (GAS bf16_t*)(ws + WS_H)};
            pg8::gemm_phase(c.lds, g, S, E);
            if (l < DEPTH - 1) ctx_gemm(c.lds, (const GAS bf16_t*)(ws + WS_OAH), D, wab, D, D, CEpiMergeK{(const GAS bf16_t*)(ws + WS_P), (GAS bf16_t*)(ws + WS_H)}); }
        GRID_BAR();
        {   GAS unsigned char* ws = c.ws; asm volatile("" : "+s"(ws));
            const GAS float* modl = (const GAS float*)(ws + WS_MOD) + (size_t)l * 5 * 6144;
            pg8::Gemm g{D, D, D}; pg8::StaticOrder S; S.init(ws + WS_H, D, (GAS bf16_t*)(ws + WS_WO) + (size_t)l * D * D, D, TL, D, c.G, c.bid);
            EpiResid E{(GAS float*)(ws + WS_X), modl + 2 * 1024};
            pg8::gemm_phase(c.lds, g, S, E);
            if (l < DEPTH - 1) ctx_gemm(c.lds, (const GAS bf16_t*)(ws + WS_H), D, (const GAS bf16_t*)(ws + WS_WO) + (size_t)l * D * D, D, D, CEpiResid{(GAS float*)(ws + WS_X), modl + 4 * 6144 + 2 * 1024}); }
        GRID_BAR();
        ph_norm(c, l, 1);
        GRID_BAR();
        if ((l & 1) == 0) {
            {   GAS unsigned char* ws = c.ws; asm volatile("" : "+s"(ws));
                const GAS bf16_t* w = (const GAS bf16_t*)(ws + WS_W13D) + (size_t)(l >> 1) * 2 * FF * D;
                pg8::Gemm g{D, D, D, STAG}; pg8::StaticOrder S; S.init(ws + WS_H, D, w, D, T, 2 * FF, c.G, c.bid);
                EpiSwiglu E{(GAS bf16_t*)(ws + WS_P)};
                pg8::gemm_phase(c.lds, g, S, E); }
            GRID_BAR();
            {   GAS unsigned char* ws = c.ws; asm volatile("" : "+s"(ws));
                const GAS float* modl = (const GAS float*)(ws + WS_MOD) + (size_t)l * 5 * 6144;
                const GAS bf16_t* w = (const GAS bf16_t*)(ws + WS_W2D) + (size_t)(l >> 1) * D * FF;
                pg8::Gemm g{FF, FF, FF}; pg8::StaticOrder S; S.init(ws + WS_P, FF, w, FF, TL, D, c.G, c.bid);
                EpiResid E{(GAS float*)(ws + WS_X), modl + 5 * 1024};
                pg8::gemm_phase(c.lds, g, S, E);
                ctx_gemm(c.lds, (const GAS bf16_t*)(ws + WS_P), FF, w, FF, FF, CEpiResid{(GAS float*)(ws + WS_X), modl + 4 * 6144 + 5 * 1024}); }
            GRID_BAR();
        } else {
            const Ctx cm = mk_ctx(c.lds, c.ws);
            moe_table(cm, l >> 1);
            {   GAS unsigned char* ws = c.ws; asm volatile("" : "+s"(ws));
                const GAS bf16_t* w = (const GAS bf16_t*)(ws + WS_W13M) + (size_t)((l >> 1) * NE) * 2 * FF * D;
                pg8::Gemm g{D, D, D, STAG}; MoeOrder<true> S; S.init(ws + WS_H, D, w, D, (size_t)2 * FF * D * 2, 2 * FF, c.G, c.bid, (const GAS int*)(ws + WS_TOK), (const LAS unsigned*)(c.lds + MOE_OFF));
                EpiSwiglu E{(GAS bf16_t*)(ws + WS_P)};
                pg8::gemm_phase(c.lds, g, S, E); }
            GRID_BAR();
            {   GAS unsigned char* ws = c.ws; asm volatile("" : "+s"(ws));
                const GAS bf16_t* w = (const GAS bf16_t*)(ws + WS_W2M) + (size_t)((l >> 1) * NE) * D * FF;
                pg8::Gemm g{FF, FF, FF, STAG}; MoeOrder<false> S; S.init(ws + WS_P, FF, w, FF, (size_t)D * FF * 2, D, c.G, c.bid, (const GAS int*)(ws + WS_TOK), (const LAS unsigned*)(c.lds + MOE_OFF));
                EpiStoreBf16 E{(GAS bf16_t*)(ws + WS_Y), D};
                pg8::gemm_phase(c.lds, g, S, E); }
            GRID_BAR();
        }
    }
    ph_final(c);
}

extern "C" void kernel_launch(void* const* d_in, const int* in_sizes, int n_in, void* d_out, int out_size, void* d_ws, size_t ws_size, hipStream_t stream) {
    static int grid = 0;
    if (grid == 0) {
        if (n_in != 30 || out_size != TL * D || ws_size < WS_END) { fprintf(stderr, "kernel_launch: unexpected shapes (n_in %d out %d ws %zu)\n", n_in, out_size, ws_size); grid = -1; return; }
        int dev = 0, cus = 0, per_cu = 0; (void)hipGetDevice(&dev); (void)hipDeviceGetAttribute(&cus, hipDeviceAttributeMultiprocessorCount, dev);
        if (hipFuncSetAttribute((const void*)fwd, hipFuncAttributeMaxDynamicSharedMemorySize, LDS_BYTES) != hipSuccess) { fprintf(stderr, "kernel_launch: hipFuncSetAttribute failed\n"); grid = -1; return; }
        if (hipOccupancyMaxActiveBlocksPerMultiprocessor(&per_cu, (const void*)fwd, NTHR, LDS_BYTES) != hipSuccess || per_cu < 1) fprintf(stderr, "kernel_launch: occupancy query reports %d\n", per_cu);
        (void)hipGetLastError();
        grid = cus > 0 ? cus : 256;
    }
    if (grid < 0) return;
    (void)hipMemsetAsync((char*)d_ws + WS_CTL, 0, CTL_ZERO_BYTES, stream);
    Args a{};
    for (int i = 0; i < 30; ++i) a.in[i] = (const float*)d_in[i];
    a.out = (float*)d_out; a.ws = (unsigned char*)d_ws;
    hipLaunchKernelGGL(fwd, dim3(grid), dim3(NTHR), LDS_BYTES, stream, a);
}
```

```cpp
#include <hip/hip_runtime.h>
#include <cstdio>
#include <cstdint>

#define LAS __attribute__((address_space(3)))
#define GAS __attribute__((address_space(1)))
typedef unsigned short bf16_t;
typedef short bf16x8 __attribute__((ext_vector_type(8)));
typedef float f32x4 __attribute__((ext_vector_type(4)));
typedef float f32x2 __attribute__((ext_vector_type(2)));
typedef float f32x16 __attribute__((ext_vector_type(16)));
typedef unsigned u32x4 __attribute__((ext_vector_type(4)));
typedef unsigned u32x2 __attribute__((ext_vector_type(2)));

constexpr int D = 1024, NB = 4, SEQ = 4096, DEPTH = 4, CTX = 256;
constexpr int TL = NB * SEQ, TC = NB * CTX, T = TL + TC;
constexpr int PW = 5120, FF = 2816, NE = 8, HYW = 512;
constexpr int PQ = 0, PK = 512, PV = 1024, PHY = 1536, PGA = 3072, PGB = 4096;
constexpr float EPS = 1e-6f;

constexpr size_t MiB = 1u << 20;
constexpr size_t WS_CTL = 0, CTL_ZERO_BYTES = 1 * MiB;
constexpr size_t WS_MOD = 1 * MiB;
constexpr size_t WS_ROUTE = 2 * MiB;
constexpr size_t WS_RWT = 2 * MiB + 512 * 1024;
constexpr size_t WS_TOK = 3 * MiB;
constexpr int CW_CNT = 8192;
constexpr int MAXSLOT = 36864;
constexpr size_t WS_Y = 660 * MiB;
constexpr size_t WS_WIN = 4 * MiB;
constexpr size_t WS_WPAB = 44 * MiB;
constexpr size_t WS_WO = 52 * MiB;
constexpr size_t WS_W13D = 60 * MiB;
constexpr size_t WS_W2D = 82 * MiB;
constexpr size_t WS_W13M = 93 * MiB;
constexpr size_t WS_W2M = 269 * MiB;
constexpr size_t WS_X = 357 * MiB;
constexpr size_t WS_H = 425 * MiB;
constexpr size_t WS_P = 459 * MiB;
constexpr size_t WS_OAH = 629 * MiB;
constexpr size_t WS_B = 663 * MiB;
constexpr size_t WS_OHT = WS_B + 51 * MiB;
constexpr size_t WS_VT = 748 * MiB;
constexpr size_t WS_HRL = 816 * MiB;
constexpr size_t WS_HRC = 850 * MiB;
constexpr size_t WS_END = 853 * MiB;

constexpr int STAG = 3;
constexpr int LDS_BYTES = 147456;
constexpr int NWAVES = 8, NTHR = 512;

#define LDS_WAIT() asm volatile("s_waitcnt lgkmcnt(0)" ::: "memory")
#define VM_WAIT() asm volatile("s_waitcnt vmcnt(0)" ::: "memory")
__device__ __forceinline__ float bf2f(unsigned b) { return __uint_as_float(b << 16); }
__device__ __forceinline__ float bflo(unsigned w) { return __uint_as_float(w << 16); }
__device__ __forceinline__ float bfhi(unsigned w) { return __uint_as_float(w & 0xffff0000u); }
__device__ __forceinline__ unsigned cvt_pk_bf16(float lo, float hi) { unsigned r; asm volatile("v_cvt_pk_bf16_f32 %0, %1, %2" : "=v"(r) : "v"(lo), "v"(hi)); return r; }
__device__ __forceinline__ float wave_sum(float v, int lane) {
#pragma unroll
    for (int o = 1; o < 64; o <<= 1) v += __int_as_float(__builtin_amdgcn_ds_bpermute((lane ^ o) << 2, __float_as_int(v)));
    return v;
}
__device__ __forceinline__ float sigmoidf_(float x) { return __builtin_amdgcn_rcpf(1.f + __expf(-x)); }
__device__ __forceinline__ float sin_rev(float r) { return __builtin_amdgcn_sinf(__builtin_amdgcn_fractf(r)); }
__device__ __forceinline__ float sin_rad(float x) { return sin_rev(x * 0.15915494309189535f); }

namespace pg8 {
constexpr int BM = 256, BK = 64, HALF = 128, HTB = HALF * BK * 2, STAGE_BYTES = 8 * HTB, NXCD = 8, WGM = 8;
__host__ __device__ __forceinline__ int lds_byte(int r, int c) { const int st = (r >> 4) * 2 + (c >> 5), rr = r & 15, cc = c & 31, ob = rr * 64 + cc * 2; return st * 1024 + (ob ^ (((ob >> 9) & 1) << 5)); }
__host__ __device__ __forceinline__ void stage_rc(int b, int& R, int& C) { const int st = b / 1024, sb = b % 1024, swz = sb ^ (((sb >> 9) & 1) << 5); R = (st >> 1) * 16 + swz / 64; C = (st & 1) * 32 + (swz % 64) / 2; }
__host__ __device__ __forceinline__ int perm32(int rho) { const int n = rho >> 4, i = rho & 15; return 8 * (i >> 2) + 4 * n + (i & 3); }

struct Unit { int pm, pn; const GAS char* a; const GAS char* b; const GAS int* tk; int nvalid; };
struct Gemm { int K, lda, ldb; int stagger = 0; };

struct StaticOrder {
    int nM, nN, nwg, G, c; const GAS char* A; const GAS char* B; size_t astep, bstep;
    __device__ void init(const GAS void* A_, int lda, const GAS void* B_, int ldb, int M, int N, int G_, int c_) {
        nM = M / BM; nN = N / BM; nwg = nM * nN; G = G_; c = c_; A = (const GAS char*)A_; B = (const GAS char*)B_; astep = (size_t)BM * lda * 2; bstep = (size_t)BM * ldb * 2; }
    __device__ bool next(int i, Unit& u) const {
        const long L = (long)i * G + c; if (L >= nwg) return false;
        int wgid = (int)L; { const int q = nwg / NXCD, r = nwg % NXCD, xcd = wgid % NXCD, off = wgid / NXCD; wgid = (xcd < r ? xcd * (q + 1) : r * (q + 1) + (xcd - r) * q) + off; }
        const int nig = WGM * nN, gid = wgid / nig, fm = gid * WGM, gsz = (nM - fm) < WGM ? (nM - fm) : WGM;
        u.pm = fm + ((wgid % nig) % gsz); u.pn = (wgid % nig) / gsz; u.a = A + (size_t)u.pm * astep; u.b = B + (size_t)u.pn * bstep; return true;
    }
    static constexpr bool GATHER = false;
    __device__ __forceinline__ int arow(const Unit&, int) const { return 0; }
    __device__ __forceinline__ void a_ready(const Unit&) const {}
    __device__ __forceinline__ void done(const Unit&) const {}
};

template <class Epi, class Sched, bool ALIGN_EPI = true>
__device__ __forceinline__ void gemm_phase(LAS unsigned char* lds, const Gemm g, const Sched& S, const Epi& E) {
    int tid = threadIdx.x; asm volatile("" : "+v"(tid));
    const int wid = __builtin_amdgcn_readfirstlane(tid >> 6), lane = tid & 63, wr = wid >> 2, wc = wid & 3, fr = lane & 15, fq = lane >> 4;
    const int K = g.K, nt = K / BK;
    constexpr bool GATHER = Sched::GATHER;
    unsigned voffB[2]; unsigned cA0[2], cA1[2], nA0[2], nA1[2]; int RA[2], CA[2];
    const size_t hstepA = (size_t)HALF * g.lda * 2, hstepB = (size_t)HALF * g.ldb * 2;
#pragma unroll
    for (int i = 0; i < 2; ++i) { int R, C; stage_rc(tid * 16 + i * 8192, R, C); const int Rb = Epi::PERM ? ((R & ~31) + perm32(R & 31)) : R;
        RA[i] = R; CA[i] = C; voffB[i] = (unsigned)(Rb * g.ldb + C) * 2u;
        cA0[i] = (unsigned)(R * g.lda + C) * 2u; cA1[i] = cA0[i]; nA0[i] = cA0[i]; nA1[i] = cA0[i]; }
    const size_t h1A = GATHER ? 0 : hstepA;
    const size_t kstep = (size_t)(BK * 2);
    const unsigned ldsw = (unsigned)wid * 1024u;
    const int aoff = lds_byte(wr * 64 + fr, fq * 8), boff = lds_byte(wc * 32 + fr, fq * 8);
#define PG8_SA(b, h) (((b) * 2 + (h)) * HTB)
#define PG8_SB(b, h) ((4 + (b) * 2 + (h)) * HTB)
#define PG8_STAGE(bufoff, gbase, voff) do { _Pragma("unroll") for (int _i = 0; _i < 2; ++_i) \
        __builtin_amdgcn_global_load_lds((const GAS unsigned*)((const GAS char*)(gbase) + (voff)[_i]), (LAS unsigned*)(lds + (bufoff) + ldsw + _i * 8192), 16, 0, 0); } while (0)
#define PG8_LDA(dst, b, h) do { _Pragma("unroll") for (int m = 0; m < 4; ++m) _Pragma("unroll") for (int k = 0; k < 2; ++k) dst[m][k] = *(const LAS bf16x8*)(lds + PG8_SA(b, h) + aoff + m * 2048 + k * 1024); } while (0)
#define PG8_LDB(dst, b, h) do { _Pragma("unroll") for (int n = 0; n < 2; ++n) _Pragma("unroll") for (int k = 0; k < 2; ++k) dst[n][k] = *(const LAS bf16x8*)(lds + PG8_SB(b, h) + boff + n * 2048 + k * 1024); } while (0)
#define PG8_MMA(ai, bj, At, Bt) do { __builtin_amdgcn_s_setprio(1); _Pragma("unroll") for (int m = 0; m < 4; ++m) _Pragma("unroll") for (int n = 0; n < 2; ++n) _Pragma("unroll") for (int k = 0; k < 2; ++k) \
        acc[ai][bj][m][n] = __builtin_amdgcn_mfma_f32_16x16x32_bf16(Bt[n][k], At[m][k], acc[ai][bj][m][n], 0, 0, 0); __builtin_amdgcn_s_setprio(0); } while (0)
#define PG8_WAIT_V(n) asm volatile("s_waitcnt vmcnt(" #n ")" ::: "memory")
#define PG8_WAIT_L(n) asm volatile("s_waitcnt lgkmcnt(" #n ")" ::: "memory")
#define PG8_BAR __builtin_amdgcn_s_barrier()
#define PG8_SCHED __builtin_amdgcn_sched_barrier(0)
    Unit cur, nxt; int ui = 0;
    if (!S.next(0, cur)) return;
    if (g.stagger > 0) {
        const int slot = (blockIdx.x >> 3) & 7;
        int steps = slot * g.stagger;
        for (int i = 0; i < steps; ++i) __builtin_amdgcn_s_sleep(16);
    }
    if constexpr (GATHER) {
#pragma unroll
        for (int i = 0; i < 2; ++i) { cA0[i] = (unsigned)(S.arow(cur, RA[i]) * g.lda + CA[i]) * 2u; cA1[i] = (unsigned)(S.arow(cur, HALF + RA[i]) * g.lda + CA[i]) * 2u; }
    }
    f32x4 acc[2][2][4][2];
#pragma unroll
    for (int a = 0; a < 2; ++a)
#pragma unroll
        for (int b = 0; b < 2; ++b)
#pragma unroll
            for (int m = 0; m < 4; ++m)
#pragma unroll
                for (int n = 0; n < 2; ++n) acc[a][b][m][n] = (f32x4){0.f, 0.f, 0.f, 0.f};
    bf16x8 At[4][2], B0[2][2], B1[2][2];
    const GAS char* cA = cur.a; const GAS char* cB = cur.b;
    S.a_ready(cur);
    PG8_STAGE(PG8_SB(0, 0), cB, voffB); PG8_STAGE(PG8_SB(0, 1), cB + hstepB, voffB); PG8_STAGE(PG8_SA(0, 0), cA, cA0); PG8_STAGE(PG8_SA(0, 1), cA + h1A, cA1);
    if (wr == 1) PG8_BAR;
    PG8_WAIT_V(2); PG8_BAR;
    PG8_STAGE(PG8_SB(1, 0), cB + kstep, voffB); PG8_STAGE(PG8_SA(1, 0), cA + kstep, cA0); PG8_STAGE(PG8_SB(1, 1), cB + hstepB + kstep, voffB);
    PG8_WAIT_V(6); PG8_BAR;
    for (;;) {
        const bool has_next = S.next(ui + 1, nxt);
        const GAS char* nA = has_next ? nxt.a : cA; const GAS char* nB = has_next ? nxt.b : cB;
        if constexpr (GATHER) {
#pragma unroll
            for (int i = 0; i < 2; ++i) { nA0[i] = has_next ? (unsigned)(S.arow(nxt, RA[i]) * g.lda + CA[i]) * 2u : cA0[i]; nA1[i] = has_next ? (unsigned)(S.arow(nxt, HALF + RA[i]) * g.lda + CA[i]) * 2u : cA1[i]; }
        }
        for (int kh = 0; kh < (Epi::MIDK ? 2 : 1); ++kh) {
        const int tb = Epi::MIDK ? kh * (nt / 2) : 0, te = Epi::MIDK ? tb + nt / 2 : nt;
        for (int t = tb; t < te; t += 2) {
            const bool last = (t == nt - 2);
            const GAS char* a1 = cA + (size_t)(t + 1) * kstep;
            const GAS char* a2 = last ? nA : cA + (size_t)(t + 2) * kstep; const GAS char* b2 = last ? nB : cB + (size_t)(t + 2) * kstep;
            const GAS char* a3 = a2 + kstep; const GAS char* b3 = b2 + kstep;
            unsigned x0[2], x1[2];
#pragma unroll
            for (int i = 0; i < 2; ++i) { x0[i] = (GATHER && last) ? nA0[i] : cA0[i]; x1[i] = GATHER ? (last ? nA1[i] : cA1[i]) : cA0[i]; }
            if (last && has_next) S.a_ready(nxt);
            PG8_LDB(B0, 0, 0); PG8_LDB(B1, 0, 1); PG8_SCHED; PG8_LDA(At, 0, 0); PG8_STAGE(PG8_SA(1, 1), a1 + h1A, cA1);
            PG8_WAIT_V(8); PG8_WAIT_L(0); PG8_BAR; PG8_MMA(0, 0, At, B0); PG8_MMA(0, 1, At, B1); PG8_BAR; PG8_SCHED;
            PG8_LDA(At, 0, 1); PG8_STAGE(PG8_SB(0, 0), b2, voffB); PG8_STAGE(PG8_SB(0, 1), b2 + hstepB, voffB); PG8_STAGE(PG8_SA(0, 0), a2, x0);
            PG8_WAIT_V(8); PG8_WAIT_L(0); PG8_BAR; PG8_MMA(1, 0, At, B0); PG8_MMA(1, 1, At, B1); PG8_BAR; PG8_SCHED;
            PG8_LDB(B0, 1, 0); PG8_LDB(B1, 1, 1); PG8_SCHED; PG8_LDA(At, 1, 0); PG8_STAGE(PG8_SA(0, 1), a2 + h1A, x1);
            PG8_WAIT_V(8); PG8_WAIT_L(0); PG8_BAR; PG8_MMA(0, 0, At, B0); PG8_MMA(0, 1, At, B1); PG8_BAR; PG8_SCHED;
            PG8_LDA(At, 1, 1); PG8_STAGE(PG8_SB(1, 0), b3, voffB); PG8_STAGE(PG8_SB(1, 1), b3 + hstepB, voffB); PG8_STAGE(PG8_SA(1, 0), a3, x0);
            PG8_WAIT_V(8); PG8_WAIT_L(0); PG8_BAR; PG8_MMA(1, 0, At, B0); PG8_MMA(1, 1, At, B1); PG8_BAR; PG8_SCHED;
        }
        if constexpr (Epi::MIDK) { if (kh == 0) E.mid(acc, cur, wr, wc, fr, fq); }
        }
        if constexpr (ALIGN_EPI) { if (wr == 0) PG8_BAR; }
        E(acc, cur, wr, wc, fr, fq); S.done(cur);
        if (!has_next) break;
#pragma unroll
        for (int a = 0; a < 2; ++a)
#pragma unroll
            for (int b = 0; b < 2; ++b)
#pragma unroll
                for (int m = 0; m < 4; ++m)
#pragma unroll
                    for (int n = 0; n < 2; ++n) acc[a][b][m][n] = (f32x4){0.f, 0.f, 0.f, 0.f};
        cur = nxt; cA = nA; cB = nB; ++ui;
        if constexpr (GATHER) {
#pragma unroll
            for (int i = 0; i < 2; ++i) { cA0[i] = nA0[i]; cA1[i] = nA1[i]; }
        }
        if constexpr (ALIGN_EPI) { if (wr == 1) PG8_BAR; }
    }
    PG8_WAIT_V(0);
    if constexpr (!ALIGN_EPI) { if (wr == 0) PG8_BAR; }
    PG8_BAR;
#undef PG8_SA
#undef PG8_SB
#undef PG8_STAGE
#undef PG8_LDA
#undef PG8_LDB
#undef PG8_MMA
#undef PG8_WAIT_V
#undef PG8_WAIT_L
#undef PG8_BAR
#undef PG8_SCHED
}
}

typedef f32x4 AccT[2][2][4][2];
struct EpiStoreBf16 {
    static constexpr bool PERM = true, MIDK = false;
    GAS bf16_t* O; int ldc;
    __device__ __forceinline__ void operator()(const AccT& acc, const pg8::Unit& u, int wr, int wc, int fr, int fq) const {
        const int row0 = u.pm * 256 + wr * 64 + fr, col0 = u.pn * 256 + wc * 32 + 8 * fq;
#pragma unroll
        for (int ai = 0; ai < 2; ++ai)
#pragma unroll
            for (int m = 0; m < 4; ++m) { GAS bf16_t* rowp = O + (size_t)(row0 + ai * 128 + m * 16) * ldc + col0;
#pragma unroll
                for (int bj = 0; bj < 2; ++bj) { const f32x4 v0 = acc[ai][bj][m][0], v1 = acc[ai][bj][m][1];
                    u32x4 w; w.x = cvt_pk_bf16(v0[0], v0[1]); w.y = cvt_pk_bf16(v0[2], v0[3]); w.z = cvt_pk_bf16(v1[0], v1[1]); w.w = cvt_pk_bf16(v1[2], v1[3]);
                    *(GAS u32x4*)(rowp + bj * 128) = w; } }
    }
};
__device__ __forceinline__ float merge_ratio(float ga, float gb) { return (1.f + __expf(-fmaxf(gb, -80.f))) * __builtin_amdgcn_rcpf(1.f + __expf(-ga)); }
__device__ __forceinline__ float merge_final(float gb) { return __builtin_amdgcn_rcpf(1.f + __expf(-fmaxf(gb, -80.f))); }
struct EpiMergeK {
    static constexpr bool PERM = true, MIDK = true;
    const GAS bf16_t* P; GAS bf16_t* O;
    __device__ __forceinline__ void mid(AccT& acc, const pg8::Unit& u, int wr, int wc, int fr, int fq) const {
        asm volatile("" : "+v"(fr), "+v"(fq));
        const int row0 = u.pm * 256 + wr * 64 + fr, col0 = u.pn * 256 + wc * 32 + 8 * fq;
#pragma unroll
        for (int ai = 0; ai < 2; ++ai)
#pragma unroll
            for (int m = 0; m < 4; ++m) { const int r = row0 + ai * 128 + m * 16;
#pragma unroll
                for (int bj = 0; bj < 2; ++bj) { const int c = col0 + bj * 128;
                    const u32x4 a = *(const GAS u32x4*)(P + (size_t)r * PW + PGA + c), b = *(const GAS u32x4*)(P + (size_t)r * PW + PGB + c);
                    acc[ai][bj][m][0][0] *= merge_ratio(bflo(a.x), bflo(b.x)); acc[ai][bj][m][0][1] *= merge_ratio(bfhi(a.x), bfhi(b.x));
                    acc[ai][bj][m][0][2] *= merge_ratio(bflo(a.y), bflo(b.y)); acc[ai][bj][m][0][3] *= merge_ratio(bfhi(a.y), bfhi(b.y));
                    acc[ai][bj][m][1][0] *= merge_ratio(bflo(a.z), bflo(b.z)); acc[ai][bj][m][1][1] *= merge_ratio(bfhi(a.z), bfhi(b.z));
                    acc[ai][bj][m][1][2] *= merge_ratio(bflo(a.w), bflo(b.w)); acc[ai][bj][m][1][3] *= merge_ratio(bfhi(a.w), bfhi(b.w)); } }
    }
    __device__ __forceinline__ void operator()(const AccT& acc, const pg8::Unit& u, int wr, int wc, int fr, int fq) const {
        asm volatile("" : "+v"(fr), "+v"(fq));
        const int row0 = u.pm * 256 + wr * 64 + fr, col0 = u.pn * 256 + wc * 32 + 8 * fq;
#pragma unroll
        for (int ai = 0; ai < 2; ++ai)
#pragma unroll
            for (int m = 0; m < 4; ++m) { const int r = row0 + ai * 128 + m * 16;
#pragma unroll
                for (int bj = 0; bj < 2; ++bj) { const int c = col0 + bj * 128;
                    const u32x4 b = *(const GAS u32x4*)(P + (size_t)r * PW + PGB + c);
                    const f32x4 v0 = acc[ai][bj][m][0], v1 = acc[ai][bj][m][1];
                    u32x4 w; w.x = cvt_pk_bf16(v0[0] * merge_final(bflo(b.x)), v0[1] * merge_final(bfhi(b.x))); w.y = cvt_pk_bf16(v0[2] * merge_final(bflo(b.y)), v0[3] * merge_final(bfhi(b.y)));
                    w.z = cvt_pk_bf16(v1[0] * merge_final(bflo(b.z)), v1[1] * merge_final(bfhi(b.z))); w.w = cvt_pk_bf16(v1[2] * merge_final(bflo(b.w)), v1[3] * merge_final(bfhi(b.w)));
                    *(GAS u32x4*)(O + (size_t)r * D + c) = w; } }
    }
};
struct EpiResid {
    static constexpr bool PERM = false, MIDK = false;
    GAS float* x; const GAS float* gate;
    __device__ __forceinline__ void operator()(const AccT& acc, const pg8::Unit& u, int wr, int wc, int fr, int fq) const {
        const int row0 = u.pm * 256 + wr * 64 + fr, col0 = u.pn * 256 + wc * 32 + 4 * fq;
        const int b = (u.pm < 64) ? (u.pm >> 4) : 4;
        const GAS float* gp = gate + (size_t)b * 6144 + col0;
        f32x4 gv[2][2];
#pragma unroll
        for (int bj = 0; bj < 2; ++bj)
#pragma unroll
            for (int n = 0; n < 2; ++n) gv[bj][n] = *(const GAS f32x4*)(gp + bj * 128 + n * 16);
#pragma unroll
        for (int ai = 0; ai < 2; ++ai)
#pragma unroll
            for (int m = 0; m < 4; ++m) { const int r = row0 + ai * 128 + m * 16; GAS float* rowp = x + (size_t)r * D + col0;
#pragma unroll
                for (int bj = 0; bj < 2; ++bj)
#pragma unroll
                    for (int n = 0; n < 2; ++n) { GAS float* p = rowp + bj * 128 + n * 16; *(GAS f32x4*)p = *(const GAS f32x4*)p + gv[bj][n] * acc[ai][bj][m][n]; } }
    }
};
struct EpiSwiglu {
    static constexpr bool PERM = true, MIDK = false;
    GAS bf16_t* O;
    __device__ __forceinline__ void operator()(const AccT& acc, const pg8::Unit& u, int wr, int wc, int fr, int fq) const {
        const int row0 = u.pm * 256 + wr * 64 + fr, col0 = u.pn * 128 + wc * 32 + 8 * fq;
#pragma unroll
        for (int ai = 0; ai < 2; ++ai)
#pragma unroll
            for (int m = 0; m < 4; ++m) { const int r = row0 + ai * 128 + m * 16;
                float o[8];
#pragma unroll
                for (int n = 0; n < 2; ++n)
#pragma unroll
                    for (int j = 0; j < 4; ++j) { const float a = acc[ai][0][m][n][j], g = acc[ai][1][m][n][j]; o[n * 4 + j] = a * sigmoidf_(a) * g; }
                u32x4 w; w.x = cvt_pk_bf16(o[0], o[1]); w.y = cvt_pk_bf16(o[2], o[3]); w.z = cvt_pk_bf16(o[4], o[5]); w.w = cvt_pk_bf16(o[6], o[7]);
                *(GAS u32x4*)(O + (size_t)r * FF + col0) = w; }
    }
};

struct CEpiMergeK { const GAS bf16_t* P; GAS bf16_t* O; static constexpr bool MIDK = true;
    __device__ __forceinline__ void mid(f32x4& acc, int r, int c) const { const u32x2 a = *(const GAS u32x2*)(P + (size_t)r * PW + PGA + c), b = *(const GAS u32x2*)(P + (size_t)r * PW + PGB + c);
        acc[0] *= merge_ratio(bflo(a.x), bflo(b.x)); acc[1] *= merge_ratio(bfhi(a.x), bfhi(b.x)); acc[2] *= merge_ratio(bflo(a.y), bflo(b.y)); acc[3] *= merge_ratio(bfhi(a.y), bfhi(b.y)); }
    __device__ __forceinline__ void operator()(const f32x4& acc, int r, int c) const { const u32x2 b = *(const GAS u32x2*)(P + (size_t)r * PW + PGB + c);
        u32x2 w; w.x = cvt_pk_bf16(acc[0] * merge_final(bflo(b.x)), acc[1] * merge_final(bfhi(b.x))); w.y = cvt_pk_bf16(acc[2] * merge_final(bflo(b.y)), acc[3] * merge_final(bfhi(b.y)));
        *(GAS u32x2*)(O + (size_t)r * D + c) = w; } };
struct CEpiResid { GAS float* x; const GAS float* gate; static constexpr bool MIDK = false;
    __device__ __forceinline__ void mid(f32x4&, int, int) const {}
    __device__ __forceinline__ void operator()(const f32x4& acc, int r, int c) const { GAS float* p = x + (size_t)r * D + c; *(GAS f32x4*)p = *(const GAS f32x4*)p + *(const GAS f32x4*)(gate + c) * acc; } };
template <class Epi>
__device__ __forceinline__ void ctx_gemm(LAS unsigned char* lds, const GAS bf16_t* X, int ldx, const GAS bf16_t* Wt, int ldw, int K, const Epi& E) {
    int tid = threadIdx.x; asm volatile("" : "+v"(tid));
    const int wave = tid >> 6, lane = tid & 63, li = lane & 15, kg = lane >> 4, kp = wave >> 1, ch = wave & 1;
    LAS float* part = (LAS float*)lds;
    for (int tile = blockIdx.x; tile < 256; tile += gridDim.x) {
        const int row0 = TL + (tile >> 2) * 16, colb = (tile & 3) * 256, col0 = colb + ch * 128;
        const int kq = K >> 2, kbeg = kp * kq;
        const GAS bf16_t* xp = X + (size_t)(row0 + li) * ldx + 8 * kg + kbeg;
        const GAS bf16_t* wp = Wt + (size_t)(col0 + li) * ldw + 8 * kg + kbeg;
        f32x4 acc[8];
#pragma unroll
        for (int cb = 0; cb < 8; ++cb) acc[cb] = (f32x4){0.f, 0.f, 0.f, 0.f};
#pragma unroll 2
        for (int k0 = 0; k0 < kq; k0 += 32) {
            const bf16x8 xf = *(const GAS bf16x8*)(xp + k0);
#pragma unroll
            for (int cb = 0; cb < 8; ++cb) { const bf16x8 wf = *(const GAS bf16x8*)(wp + (size_t)(16 * cb) * ldw + k0); acc[cb] = __builtin_amdgcn_mfma_f32_16x16x32_bf16(wf, xf, acc[cb], 0, 0, 0); }
        }
        if constexpr (Epi::MIDK) { if (kp < 2) {
#pragma unroll
            for (int cb = 0; cb < 8; ++cb) E.mid(acc[cb], row0 + li, col0 + 16 * cb + 4 * kg); } }
#pragma unroll
        for (int cb = 0; cb < 8; ++cb) *(LAS f32x4*)(part + (kp * 16 + li) * 260 + ch * 128 + 16 * cb + 4 * kg) = acc[cb];
        __syncthreads();
        { const int r = tid >> 5, cc = (tid & 31) * 8;
          f32x4 o0 = (f32x4){0.f, 0.f, 0.f, 0.f}, o1 = o0;
#pragma unroll
          for (int q = 0; q < 4; ++q) { o0 += *(const LAS f32x4*)(part + (q * 16 + r) * 260 + cc); o1 += *(const LAS f32x4*)(part + (q * 16 + r) * 260 + cc + 4); }
          E(o0, row0 + r, colb + cc); E(o1, row0 + r, colb + cc + 4); }
        __syncthreads();
    }
}

struct Args { const float* in[30]; float* out; unsigned char* ws; int l, e, ph, pad; };
enum { I_X = 0, I_C, I_CTX, I_CCTX, I_WMOD, I_BMOD, I_N1G, I_N2G, I_WIN, I_RPB, I_HCW, I_HCB, I_HW1, I_HB1, I_HW2, I_HB2, I_HW3, I_HFREQ, I_HBIAS,
       I_WPA, I_WPB, I_WO, I_FW1, I_FW3, I_FW2, I_ROUTER, I_MW1, I_MW3, I_MW2, I_FINALG };

constexpr int MISC_OFF = 131072 + 320;
constexpr int PTR_OFF = MISC_OFF + 128;
struct Ctx {
    LAS unsigned char* lds; int tid, lane, wave, G, bid; GAS unsigned char* ws;
};
__device__ __forceinline__ Ctx mk_ctx(LAS unsigned char* lds, GAS unsigned char* ws) {
    Ctx c; int t = threadIdx.x; asm volatile("" : "+v"(t)); asm volatile("" : "+s"(ws)); c.lds = lds; c.tid = t; c.lane = t & 63; c.wave = __builtin_amdgcn_readfirstlane(t >> 6); c.G = gridDim.x; c.bid = blockIdx.x; c.ws = ws; return c;
}
__device__ __forceinline__ const GAS float* inp(const Ctx& c, int i) {
    unsigned ao = (unsigned)(PTR_OFF + 8 * i); asm volatile("" : "+v"(ao));
    const volatile LAS unsigned* p = (const volatile LAS unsigned*)(c.lds + ao);
    const unsigned lo = __builtin_amdgcn_readfirstlane(p[0]), hi = __builtin_amdgcn_readfirstlane(p[1]);
    return (const GAS float*)(((unsigned long long)hi << 32) | (unsigned long long)lo);
}

__device__ __forceinline__ void transpose_item(const GAS float* W, int N, GAS bf16_t* WT, int ldk, int k0, int n0, int drow0, LAS float* scr, int lane) {
    float wv[32];
    const GAS float* wp = W + (size_t)(k0 + (lane >> 5)) * N + n0 + (lane & 31);
#pragma unroll
    for (int i = 0; i < 32; ++i) wv[i] = wp[(size_t)(2 * i) * N];
#pragma unroll
    for (int i = 0; i < 32; ++i) scr[(2 * i + (lane >> 5)) * 33 + (lane & 31)] = wv[i];
    LDS_WAIT(); asm volatile("" ::: "memory");
    const int c = lane & 7;
#pragma unroll
    for (int j = 0; j < 4; ++j) { const int n = (lane >> 3) + 8 * j; const LAS float* s = scr + (8 * c) * 33 + n;
        u32x4 o; o.x = cvt_pk_bf16(s[0 * 33], s[1 * 33]); o.y = cvt_pk_bf16(s[2 * 33], s[3 * 33]); o.z = cvt_pk_bf16(s[4 * 33], s[5 * 33]); o.w = cvt_pk_bf16(s[6 * 33], s[7 * 33]);
        *(GAS u32x4*)(WT + (size_t)(drow0 + n) * ldk + k0 + 8 * c) = o; }
    LDS_WAIT(); asm volatile("" ::: "memory");
}
__device__ __forceinline__ void conv_mat(const GAS float* W, int K, int N, GAS bf16_t* WT, int mode, int& base, int gw, int NGW, LAS float* scr, int lane, int ldk = 0) {
    if (ldk == 0) ldk = K;
    const int nblk = N / 32, nitems = (K / 64) * nblk;
    const int start = (gw - (base % NGW) + NGW) % NGW;
    for (int it = start; it < nitems; it += NGW) {
        const int kb = it / nblk, nb = it % nblk, n0 = nb * 32;
        const int drow0 = mode == 0 ? n0 : ((n0 >> 7) * 256 + (n0 & 127) + (mode == 2 ? 128 : 0));
        transpose_item(W, N, WT, ldk, kb * 64, n0, drow0, scr, lane);
    }
    base += nitems;
}
__device__ __forceinline__ void ph_convert(const Ctx& c0) {
    const Ctx c = mk_ctx(c0.lds, c0.ws);
    GAS unsigned char* ws = c.ws;
    LAS float* scr = (LAS float*)(c.lds + c.wave * 16384);
    const int gw = c.bid * NWAVES + c.wave, NGW = c.G * NWAVES; int base = 0;
    for (int l = 0; l < DEPTH; ++l) {
        conv_mat(inp(c, I_WIN) + (size_t)l * D * PW, D, PW, (GAS bf16_t*)(ws + WS_WIN) + (size_t)l * PW * D, 0, base, gw, NGW, scr, c.lane);
        conv_mat(inp(c, I_WPA) + (size_t)l * 512 * D, 512, D, (GAS bf16_t*)(ws + WS_WPAB) + (size_t)l * D * D, 0, base, gw, NGW, scr, c.lane, D);
        conv_mat(inp(c, I_WPB) + (size_t)l * 512 * D, 512, D, (GAS bf16_t*)(ws + WS_WPAB) + (size_t)l * D * D + 512, 0, base, gw, NGW, scr, c.lane, D);
        conv_mat(inp(c, I_WO) + (size_t)l * D * D, D, D, (GAS bf16_t*)(ws + WS_WO) + (size_t)l * D * D, 0, base, gw, NGW, scr, c.lane);
    }
    for (int i = 0; i < 2; ++i) {
        conv_mat(inp(c, I_FW1) + (size_t)i * D * FF, D, FF, (GAS bf16_t*)(ws + WS_W13D) + (size_t)i * 2 * FF * D, 1, base, gw, NGW, scr, c.lane);
        conv_mat(inp(c, I_FW3) + (size_t)i * D * FF, D, FF, (GAS bf16_t*)(ws + WS_W13D) + (size_t)i * 2 * FF * D, 2, base, gw, NGW, scr, c.lane);
        conv_mat(inp(c, I_FW2) + (size_t)i * FF * D, FF, D, (GAS bf16_t*)(ws + WS_W2D) + (size_t)i * D * FF, 0, base, gw, NGW, scr, c.lane);
    }
    for (int ie = 0; ie < 2 * NE; ++ie) {
        conv_mat(inp(c, I_MW1) + (size_t)ie * D * FF, D, FF, (GAS bf16_t*)(ws + WS_W13M) + (size_t)ie * 2 * FF * D, 1, base, gw, NGW, scr, c.lane);
        conv_mat(inp(c, I_MW3) + (size_t)ie * D * FF, D, FF, (GAS bf16_t*)(ws + WS_W13M) + (size_t)ie * 2 * FF * D, 2, base, gw, NGW, scr, c.lane);
        conv_mat(inp(c, I_MW2) + (size_t)ie * FF * D, FF, D, (GAS bf16_t*)(ws + WS_W2M) + (size_t)ie * D * FF, 0, base, gw, NGW, scr, c.lane);
    }
}

__device__ __forceinline__ void ph_mod(const Ctx& c0) {
    const Ctx c = mk_ctx(c0.lds, c0.ws);
    GAS float* mod = (GAS float*)(c.ws + WS_MOD);
    LAS float* s = (LAS float*)c.lds; LAS float* part = s + 5 * 1024;
    const GAS float* cin = inp(c, I_C); const GAS float* cctx = inp(c, I_CCTX); const GAS float* wmod = inp(c, I_WMOD); const GAS float* bmod = inp(c, I_BMOD);
    for (int i = c.tid; i < 5 * 1024; i += NTHR) { const int r = i >> 10, k = i & 1023; const float v = r < 4 ? cin[r * 1024 + k] : cctx[k]; s[i] = v * sigmoidf_(v); }
    __syncthreads();
    for (int unit = c.bid; unit < DEPTH * 96; unit += c.G) {
        const int l = unit / 96, j0 = (unit % 96) * 64;
        const GAS float* w = wmod + (size_t)l * D * 6144 + j0 + c.lane;
        float acc[5] = {0.f, 0.f, 0.f, 0.f, 0.f};
        const int kb = c.wave * 128;
#pragma unroll 32
        for (int k = 0; k < 128; ++k) { const float wv = w[(size_t)(kb + k) * 6144];
#pragma unroll
            for (int r = 0; r < 5; ++r) acc[r] += s[r * 1024 + kb + k] * wv; }
#pragma unroll
        for (int r = 0; r < 5; ++r) part[(c.wave * 5 + r) * 64 + c.lane] = acc[r];
        __syncthreads();
        if (c.tid < 320) { const int r = c.tid >> 6, ln = c.tid & 63; float sum = 0.f;
#pragma unroll
            for (int w8 = 0; w8 < 8; ++w8) sum += part[(w8 * 5 + r) * 64 + ln];
            mod[(size_t)(l * 5 + r) * 6144 + j0 + ln] = sum + bmod[l * 6144 + j0 + ln]; }
        __syncthreads();
    }
}

__device__ __forceinline__ void ph_filt(const Ctx& c0) {
    const Ctx c = mk_ctx(c0.lds, c0.ws);
    const GAS float* hb1 = inp(c, I_HB1); const GAS float* hw1 = inp(c, I_HW1); const GAS float* hb2 = inp(c, I_HB2); const GAS float* hw2 = inp(c, I_HW2); const GAS float* hfreq = inp(c, I_HFREQ); const GAS float* hw3 = inp(c, I_HW3);
    LAS float* zb = (LAS float*)c.lds;
    LAS float* a1 = zb + 16 * 36;
    LAS float* a2 = a1 + 16 * 64;
    const float MINDEC = -3.0701134573253945f, MAXDEC = -15.350567286626973f;
    for (int unit = c.bid; unit < DEPTH * 272; unit += c.G) {
        const int l = unit / 272, uu = unit % 272;
        const int L = uu < 256 ? 4096 : 256, p0 = uu < 256 ? uu * 16 : (uu - 256) * 16;
        for (int i = c.tid; i < 16 * 33; i += NTHR) { const int p = i / 33, q = i % 33; const int pos = p0 + p; float v;
            if (q == 0) v = (float)pos / (float)(L - 1);
            else { const int j = (q - 1) & 15; const double band = 1e-4 + (double)j * ((15.0 - 1e-4) / 15.0); double rev = (double)pos * band / (double)L; rev -= floor(rev);
                v = q <= 16 ? __builtin_amdgcn_cosf((float)rev) : -__builtin_amdgcn_sinf((float)rev); }
            zb[p * 36 + q] = v; }
        __syncthreads();
        for (int i = c.tid; i < 16 * 64; i += NTHR) { const int p = i >> 6, j = i & 63; float s = hb1[l * 64 + j];
            const GAS float* w = hw1 + (size_t)l * 33 * 64 + j;
            for (int q = 0; q < 33; ++q) s += zb[p * 36 + q] * w[q * 64];
            a1[p * 64 + j] = sin_rad(hfreq[l * 128 + j] * s); }
        __syncthreads();
        for (int i = c.tid; i < 16 * 64; i += NTHR) { const int p = i >> 6, j = i & 63; float s = hb2[l * 64 + j];
            const GAS float* w = hw2 + (size_t)l * 64 * 64 + j;
            for (int q = 0; q < 64; ++q) s += a1[p * 64 + q] * w[q * 64];
            a2[p * 64 + j] = sin_rad(hfreq[l * 128 + 64 + j] * s); }
        __syncthreads();
        {
            float acc0[16], acc1[16];
#pragma unroll
            for (int p = 0; p < 16; ++p) { acc0[p] = 0.f; acc1[p] = 0.f; }
            const GAS float* w3 = hw3 + (size_t)l * 64 * 1024 + c.tid;
            for (int k = 0; k < 64; k += 4) { float wa[4], wb[4];
#pragma unroll
                for (int q = 0; q < 4; ++q) { wa[q] = w3[(k + q) * 1024]; wb[q] = w3[(k + q) * 1024 + 512]; }
#pragma unroll
                for (int p = 0; p < 16; ++p) { const f32x4 av = *(const LAS f32x4*)(a2 + p * 64 + k);
#pragma unroll
                    for (int q = 0; q < 4; ++q) { acc0[p] += av[q] * wa[q]; acc1[p] += av[q] * wb[q]; } } }
            GAS bf16_t* hro = uu < 256 ? (GAS bf16_t*)(c.ws + WS_HRL) + ((size_t)(l * 2) * 512 + c.tid) * (4096 + 64) : (GAS bf16_t*)(c.ws + WS_HRC) + ((size_t)(l * 2) * 512 + c.tid) * (256 + 64);
            const size_t ostride = (size_t)512 * (L + 64);
            float f0[16], f1[16];
            const float r0 = fabsf(MINDEC + (float)c.tid * ((MAXDEC - MINDEC) / 1023.f)), r1 = fabsf(MINDEC + (float)(c.tid + 512) * ((MAXDEC - MINDEC) / 1023.f));
#pragma unroll
            for (int p = 0; p < 16; ++p) { const int pos = p0 + p; const float dist = fabsf((float)(pos - L / 2)) * (2.f / (float)L);
                f0[p] = acc0[p] * (__expf(-dist * r0) + 0.05f); f1[p] = acc1[p] * (__expf(-dist * r1) + 0.05f); }
            {   u32x4 w0, w1, v0, v1;
                w0.x = cvt_pk_bf16(f0[15], f0[14]); w0.y = cvt_pk_bf16(f0[13], f0[12]); w0.z = cvt_pk_bf16(f0[11], f0[10]); w0.w = cvt_pk_bf16(f0[9], f0[8]);
                w1.x = cvt_pk_bf16(f0[7], f0[6]); w1.y = cvt_pk_bf16(f0[5], f0[4]); w1.z = cvt_pk_bf16(f0[3], f0[2]); w1.w = cvt_pk_bf16(f0[1], f0[0]);
                v0.x = cvt_pk_bf16(f1[15], f1[14]); v0.y = cvt_pk_bf16(f1[13], f1[12]); v0.z = cvt_pk_bf16(f1[11], f1[10]); v0.w = cvt_pk_bf16(f1[9], f1[8]);
                v1.x = cvt_pk_bf16(f1[7], f1[6]); v1.y = cvt_pk_bf16(f1[5], f1[4]); v1.z = cvt_pk_bf16(f1[3], f1[2]); v1.w = cvt_pk_bf16(f1[1], f1[0]);
                GAS bf16_t* d0 = hro + (L + 16 - p0); GAS bf16_t* d1 = d0 + ostride;
                *(GAS u32x4*)d0 = w0; *(GAS u32x4*)(d0 + 8) = w1; *(GAS u32x4*)d1 = v0; *(GAS u32x4*)(d1 + 8) = v1;
                const u32x4 z4 = (u32x4){0u, 0u, 0u, 0u};
                if (p0 == 0) { for (int k = 0; k < 4; ++k) { *(GAS u32x4*)(hro + L + 32 + 8 * k) = z4; *(GAS u32x4*)(hro + ostride + L + 32 + 8 * k) = z4; } }
                if (p0 == L - 16) { for (int k = 0; k < 4; ++k) { *(GAS u32x4*)(hro + 8 * k) = z4; *(GAS u32x4*)(hro + ostride + 8 * k) = z4; } } }
        }
        __syncthreads();
    }
}

struct MoeComb { const GAS int* route; const GAS float* rwt; const GAS bf16_t* y; const GAS float* gate; };
__device__ __forceinline__ void moe_combine_row(const MoeComb& mc, const LAS unsigned* offs, int row, int b, int lane, f32x4 (&v)[4]) {
    const int e1 = mc.route[(size_t)row * 4 + 0], p1 = mc.route[(size_t)row * 4 + 1], e2 = mc.route[(size_t)row * 4 + 2], p2 = mc.route[(size_t)row * 4 + 3];
    const float w1 = mc.rwt[(size_t)row * 2], w2 = mc.rwt[(size_t)row * 2 + 1];
    const size_t s1 = (size_t)offs[e1] + p1, s2 = (size_t)offs[e2] + p2;
    const GAS float* gt = mc.gate + (size_t)b * 6144;
#pragma unroll
    for (int j = 0; j < 4; ++j) { const int k0 = 4 * (lane + 64 * j);
        const u32x2 a = *(const GAS u32x2*)(mc.y + s1 * D + k0), bq = *(const GAS u32x2*)(mc.y + s2 * D + k0); const f32x4 g4 = *(const GAS f32x4*)(gt + k0);
        v[j][0] += g4[0] * (w1 * bflo(a.x) + w2 * bflo(bq.x)); v[j][1] += g4[1] * (w1 * bfhi(a.x) + w2 * bfhi(bq.x));
        v[j][2] += g4[2] * (w1 * bflo(a.y) + w2 * bflo(bq.y)); v[j][3] += g4[3] * (w1 * bfhi(a.y) + w2 * bfhi(bq.y)); }
}
__device__ __forceinline__ void moe_offsets(const Ctx& c, int i, LAS unsigned* offs) {
    if (c.tid == 0) { const GAS unsigned* cnt = (const GAS unsigned*)(c.ws + WS_CTL) + CW_CNT + 64 * i; unsigned o = 0;
        for (int e = 0; e < 8; ++e) { offs[e] = o; o += (cnt[e] + 255u) & ~255u; } offs[8] = o; }
}
__device__ __forceinline__ void ph_norm(const Ctx& c0, int l, int which) {
    const Ctx c = mk_ctx(c0.lds, c0.ws);
    GAS float* xres = (GAS float*)(c.ws + WS_X); GAS bf16_t* h = (GAS bf16_t*)(c.ws + WS_H);
    const GAS float* mod = (const GAS float*)(c.ws + WS_MOD) + (size_t)l * 5 * 6144;
    const GAS float* gp = (which == 0 ? inp(c, I_N1G) : inp(c, I_N2G)) + l * D;
    const bool first = (l == 0 && which == 0), route = (which == 1 && (l & 1));
    const int comb = (which == 0 && l >= 1 && ((l - 1) & 1)) ? ((l - 1) >> 1) : -1;
    const GAS float* router = inp(c, I_ROUTER) + (size_t)(l >> 1) * D * NE;
    GAS int* routeb = (GAS int*)(c.ws + WS_ROUTE); GAS float* rwt = (GAS float*)(c.ws + WS_RWT); GAS int* tokenof = (GAS int*)(c.ws + WS_TOK);
    const MoeComb mc{routeb, rwt, (const GAS bf16_t*)(c.ws + WS_Y), (const GAS float*)(c.ws + WS_MOD) + (size_t)(l > 0 ? l - 1 : 0) * 5 * 6144 + 5 * 1024};
    LAS unsigned* lcnt = (LAS unsigned*)c.lds; LAS unsigned* gbase = lcnt + 16; LAS unsigned* offs = lcnt + 32; LAS int* pend = (LAS int*)(c.lds + 256);
    if (c.tid < 8) lcnt[c.tid] = 0u;
    if (comb >= 0) moe_offsets(c, comb, offs);
    LAS float* rlds = (LAS float*)(c.lds + 4096);
    if (route) { for (int i = c.tid; i < D * NE / 4; i += NTHR) *(LAS f32x4*)(rlds + 4 * i) = *(const GAS f32x4*)(router + 4 * i); }
    __syncthreads();
    const GAS float* xin = inp(c, I_X); const GAS float* ctxin = inp(c, I_CTX);
    int nrows = 0;
    const int nrow_all = (which == 1 && l == DEPTH - 1) ? TL : T;
#define NORM_SRC(rw) (first ? ((rw) < TL ? xin + (size_t)(rw) * D : ctxin + (size_t)((rw) - TL) * D) : xres + (size_t)(rw) * D)
    const int rstride = c.G * NWAVES;
    f32x4 vnx[4];
    { const int row = c.bid * NWAVES + c.wave; if (row < nrow_all) { const GAS float* src = NORM_SRC(row);
#pragma unroll
        for (int j = 0; j < 4; ++j) vnx[j] = *(const GAS f32x4*)(src + 4 * (c.lane + 64 * j)); } }
    for (int row = c.bid * NWAVES + c.wave; row < nrow_all; row += rstride, ++nrows) {
        const int b = row < TL ? (row >> 12) : 4;
        const GAS float* sh = mod + (size_t)b * 6144 + (which == 0 ? 0 : 3) * 1024; const GAS float* sc = sh + 1024;
        f32x4 v[4]; float ss = 0.f;
#pragma unroll
        for (int j = 0; j < 4; ++j) v[j] = vnx[j];
        if (row + rstride < nrow_all) { const GAS float* srcn = NORM_SRC(row + rstride);
#pragma unroll
            for (int j = 0; j < 4; ++j) vnx[j] = *(const GAS f32x4*)(srcn + 4 * (c.lane + 64 * j)); }
        if (comb >= 0) moe_combine_row(mc, offs, row, b, c.lane, v);
#pragma unroll
        for (int j = 0; j < 4; ++j) ss += (v[j][0] * v[j][0] + v[j][1] * v[j][1]) + (v[j][2] * v[j][2] + v[j][3] * v[j][3]);
        ss = wave_sum(ss, c.lane);
        const float rstd = 1.f / sqrtf(ss * (1.f / D) + EPS);
        if (first || comb >= 0) {
#pragma unroll
            for (int j = 0; j < 4; ++j) *(GAS f32x4*)(xres + (size_t)row * D + 4 * (c.lane + 64 * j)) = v[j];
        }
        float lg[8] = {0.f, 0.f, 0.f, 0.f, 0.f, 0.f, 0.f, 0.f};
#pragma unroll
        for (int j = 0; j < 4; ++j) { const int k0 = 4 * (c.lane + 64 * j);
            const f32x4 g4 = *(const GAS f32x4*)(gp + k0), s4 = *(const GAS f32x4*)(sc + k0), h4 = *(const GAS f32x4*)(sh + k0);
            f32x4 o;
#pragma unroll
            for (int q = 0; q < 4; ++q) o[q] = v[j][q] * rstd * g4[q] * (1.f + s4[q]) + h4[q];
            u32x2 w; w.x = cvt_pk_bf16(o[0], o[1]); w.y = cvt_pk_bf16(o[2], o[3]);
            *(GAS u32x2*)(h + (size_t)row * D + k0) = w;
            if (route) {
#pragma unroll
                for (int q = 0; q < 4; ++q) { const f32x4 ra = *(const LAS f32x4*)(rlds + (k0 + q) * 8), rb = *(const LAS f32x4*)(rlds + (k0 + q) * 8 + 4);
                    lg[0] += o[q] * ra[0]; lg[1] += o[q] * ra[1]; lg[2] += o[q] * ra[2]; lg[3] += o[q] * ra[3];
                    lg[4] += o[q] * rb[0]; lg[5] += o[q] * rb[1]; lg[6] += o[q] * rb[2]; lg[7] += o[q] * rb[3]; }
            }
        }
        if (route) {
#pragma unroll
            for (int e = 0; e < 8; ++e) lg[e] = wave_sum(lg[e], c.lane);
            int i1 = 0; float v1 = lg[0];
#pragma unroll
            for (int e = 1; e < 8; ++e) if (lg[e] > v1) { v1 = lg[e]; i1 = e; }
            int i2 = -1; float v2 = -3.0e38f;
#pragma unroll
            for (int e = 0; e < 8; ++e) if (e != i1 && lg[e] > v2) { v2 = lg[e]; i2 = e; }
            const float w1 = 1.f / (1.f + __expf(v2 - v1)), w2 = 1.f - w1;
            if (c.lane == 0) {
                const unsigned lp1 = __hip_atomic_fetch_add(lcnt + i1, 1u, __ATOMIC_RELAXED, __HIP_MEMORY_SCOPE_WORKGROUP), lp2 = __hip_atomic_fetch_add(lcnt + i2, 1u, __ATOMIC_RELAXED, __HIP_MEMORY_SCOPE_WORKGROUP);
                LAS int* pe = pend + (c.wave * 16 + nrows) * 4; pe[0] = row; pe[1] = i1 | (i2 << 8); pe[2] = (int)lp1; pe[3] = (int)lp2;
                rwt[(size_t)row * 2] = w1; rwt[(size_t)row * 2 + 1] = w2; }
        }
    }
    if (route) {
        __syncthreads();
        if (c.tid < 8) gbase[c.tid] = __hip_atomic_fetch_add((GAS unsigned*)(c.ws + WS_CTL) + CW_CNT + 64 * (l >> 1) + c.tid, lcnt[c.tid], __ATOMIC_RELAXED, __HIP_MEMORY_SCOPE_AGENT);
        __syncthreads();
        if (c.lane < nrows) { const LAS int* pe = pend + (c.wave * 16 + c.lane) * 4; const int row = pe[0], e1 = pe[1] & 255, e2 = pe[1] >> 8;
            const int p1 = (int)gbase[e1] + pe[2], p2 = (int)gbase[e2] + pe[3];
            tokenof[(size_t)e1 * T + p1] = row; tokenof[(size_t)e2 * T + p2] = row;
            routeb[(size_t)row * 4 + 0] = e1; routeb[(size_t)row * 4 + 1] = p1; routeb[(size_t)row * 4 + 2] = e2; routeb[(size_t)row * 4 + 3] = p2; }
    }
    __syncthreads();
}

__device__ __forceinline__ void ph_sc(const Ctx& c0, int l) {
    const Ctx c = mk_ctx(c0.lds, c0.ws);
    const GAS bf16_t* P = (const GAS bf16_t*)(c.ws + WS_P); GAS bf16_t* uT = (GAS bf16_t*)(c.ws + WS_B); GAS bf16_t* VT = (GAS bf16_t*)(c.ws + WS_VT);
    const GAS float* cw = inp(c, I_HCW) + (size_t)l * 3 * 1536; const GAS float* cb = inp(c, I_HCB) + (size_t)l * 1536;
    LAS unsigned char* scr = c.lds + c.wave * 16384;
    for (int tile = c.bid * NWAVES + c.wave; tile < (T / 64) * 32; tile += c.G * NWAVES) {
        const int rt = tile / 32, row0 = rt * 64, ct = tile % 32; const bool isv = ct >= 24;
        const int ch0 = isv ? (ct - 24) * 64 : ct * 64, scol = isv ? PV + ch0 : PHY + ch0; GAS bf16_t* dst = isv ? VT : uT;
        const int tpos = row0 < TL ? (row0 & 4095) : ((row0 - TL) & 255), Ls = row0 < TL ? 4096 : 256;
        for (int idx = c.lane; idx < 66 * 8; idx += 64) { const int rr = idx >> 3, ck = idx & 7; const int grow = row0 - 1 + rr;
            const bool ok = !((rr == 0 && tpos == 0) || (rr == 65 && tpos + 64 == Ls));
            u32x4 v = (u32x4){0u, 0u, 0u, 0u};
            if (ok) v = *(const GAS u32x4*)(P + (size_t)grow * PW + scol + ck * 8);
            LAS unsigned* d = (LAS unsigned*)(scr + rr * 132 + ck * 16); d[0] = v.x; d[1] = v.y; d[2] = v.z; d[3] = v.w; }
        LDS_WAIT(); asm volatile("" ::: "memory");
        const int ch = ch0 + c.lane; const float w0 = isv ? 0.f : cw[ch], w1 = isv ? 1.f : cw[1536 + ch], w2 = isv ? 0.f : cw[3072 + ch], bb = isv ? 0.f : cb[ch];
        unsigned ow[32];
        { float prev = bf2f(*(const LAS unsigned short*)(scr + 0 * 132 + c.lane * 2)), cur = bf2f(*(const LAS unsigned short*)(scr + 1 * 132 + c.lane * 2)); float o0 = 0.f;
#pragma unroll
          for (int r = 0; r < 64; ++r) { const float nxt = bf2f(*(const LAS unsigned short*)(scr + (r + 2) * 132 + c.lane * 2));
              const float o = w0 * prev + w1 * cur + w2 * nxt + bb; prev = cur; cur = nxt;
              if (r & 1) ow[r >> 1] = cvt_pk_bf16(o0, o); else o0 = o; } }
        LDS_WAIT(); asm volatile("" ::: "memory");
#pragma unroll
        for (int k = 0; k < 8; ++k) { u32x4 v; v.x = ow[4 * k]; v.y = ow[4 * k + 1]; v.z = ow[4 * k + 2]; v.w = ow[4 * k + 3]; *(LAS u32x4*)(scr + c.lane * 144 + k * 16) = v; }
        LDS_WAIT(); asm volatile("" ::: "memory");
#pragma unroll
        for (int k = 0; k < 8; ++k) { const int cc = (c.lane >> 3) + 8 * k, ck = c.lane & 7; const u32x4 v = *(const LAS u32x4*)(scr + cc * 144 + ck * 16);
            *(GAS u32x4*)(dst + (size_t)(ch0 + cc) * T + row0 + ck * 8) = v; }
        LDS_WAIT(); asm volatile("" ::: "memory");
    }
}

constexpr int HY_HR_OFF = 512, HY_U_OFF = HY_HR_OFF + 66560, HY_ZB_OFF = HY_U_OFF + 4 * 8208;
template <int L, bool DUAL>
__device__ __forceinline__ void hy_span(LAS unsigned char* lds, int nsteps, int aaddr, int ubase, int sX, int sY, f32x16& accX, f32x16& accY) {
#define HY_BADDR(sv) (((unsigned)(sv) <= (unsigned)(L - 16)) ? ubase + 2 * (sv) : HY_ZB_OFF)
    int k = 0;
    for (; k + 4 <= nsteps; k += 4) {
        const int pa = aaddr - 768;
        const int px0 = HY_BADDR(sX), px1 = HY_BADDR(sX - 16), px2 = HY_BADDR(sX - 32), px3 = HY_BADDR(sX - 48);
        bf16x8 a0, a1, a2, a3, x0, x1, x2, x3;
        if (DUAL) {
            const int py0 = HY_BADDR(sY), py1 = HY_BADDR(sY - 16), py2 = HY_BADDR(sY - 32), py3 = HY_BADDR(sY - 48);
            bf16x8 y0, y1, y2, y3;
            asm volatile(
                "ds_read_b128 %[a0], %[pa] offset:768\n\tds_read_b128 %[x0], %[px0]\n\tds_read_b128 %[y0], %[py0]\n\t"
                "ds_read_b128 %[a1], %[pa] offset:512\n\tds_read_b128 %[x1], %[px1]\n\tds_read_b128 %[y1], %[py1]\n\t"
                "ds_read_b128 %[a2], %[pa] offset:256\n\tds_read_b128 %[x2], %[px2]\n\tds_read_b128 %[y2], %[py2]\n\t"
                "ds_read_b128 %[a3], %[pa]\n\tds_read_b128 %[x3], %[px3]\n\tds_read_b128 %[y3], %[py3]\n\t"
                "s_waitcnt lgkmcnt(9)\n\tv_mfma_f32_32x32x16_bf16 %[cx], %[a0], %[x0], %[cx]\n\tv_mfma_f32_32x32x16_bf16 %[cy], %[a0], %[y0], %[cy]\n\t"
                "s_waitcnt lgkmcnt(6)\n\tv_mfma_f32_32x32x16_bf16 %[cx], %[a1], %[x1], %[cx]\n\tv_mfma_f32_32x32x16_bf16 %[cy], %[a1], %[y1], %[cy]\n\t"
                "s_waitcnt lgkmcnt(3)\n\tv_mfma_f32_32x32x16_bf16 %[cx], %[a2], %[x2], %[cx]\n\tv_mfma_f32_32x32x16_bf16 %[cy], %[a2], %[y2], %[cy]\n\t"
                "s_waitcnt lgkmcnt(0)\n\tv_mfma_f32_32x32x16_bf16 %[cx], %[a3], %[x3], %[cx]\n\tv_mfma_f32_32x32x16_bf16 %[cy], %[a3], %[y3], %[cy]\n\t"
                : [cx] "+v"(accX), [cy] "+v"(accY), [a0] "=&v"(a0), [a1] "=&v"(a1), [a2] "=&v"(a2), [a3] "=&v"(a3), [x0] "=&v"(x0), [x1] "=&v"(x1), [x2] "=&v"(x2), [x3] "=&v"(x3),
                  [y0] "=&v"(y0), [y1] "=&v"(y1), [y2] "=&v"(y2), [y3] "=&v"(y3)
                : [pa] "v"(pa), [px0] "v"(px0), [px1] "v"(px1), [px2] "v"(px2), [px3] "v"(px3), [py0] "v"(py0), [py1] "v"(py1), [py2] "v"(py2), [py3] "v"(py3));
        } else {
            asm volatile(
                "ds_read_b128 %[a0], %[pa] offset:768\n\tds_read_b128 %[x0], %[px0]\n\t"
                "ds_read_b128 %[a1], %[pa] offset:512\n\tds_read_b128 %[x1], %[px1]\n\t"
                "ds_read_b128 %[a2], %[pa] offset:256\n\tds_read_b128 %[x2], %[px2]\n\t"
                "ds_read_b128 %[a3], %[pa]\n\tds_read_b128 %[x3], %[px3]\n\t"
                "s_waitcnt lgkmcnt(6)\n\tv_mfma_f32_32x32x16_bf16 %[cx], %[a0], %[x0], %[cx]\n\t"
                "s_waitcnt lgkmcnt(4)\n\tv_mfma_f32_32x32x16_bf16 %[cx], %[a1], %[x1], %[cx]\n\t"
                "s_waitcnt lgkmcnt(2)\n\tv_mfma_f32_32x32x16_bf16 %[cx], %[a2], %[x2], %[cx]\n\t"
                "s_waitcnt lgkmcnt(0)\n\tv_mfma_f32_32x32x16_bf16 %[cx], %[a3], %[x3], %[cx]\n\t"
                : [cx] "+v"(accX), [a0] "=&v"(a0), [a1] "=&v"(a1), [a2] "=&v"(a2), [a3] "=&v"(a3), [x0] "=&v"(x0), [x1] "=&v"(x1), [x2] "=&v"(x2), [x3] "=&v"(x3)
                : [pa] "v"(pa), [px0] "v"(px0), [px1] "v"(px1), [px2] "v"(px2), [px3] "v"(px3));
        }
        aaddr -= 1024; sX -= 64; sY -= 64;
    }
    for (; k < nsteps; ++k) {
        const bf16x8 af = *(const LAS bf16x8*)(lds + aaddr), xf = *(const LAS bf16x8*)(lds + HY_BADDR(sX));
        accX = __builtin_amdgcn_mfma_f32_32x32x16_bf16(af, xf, accX, 0, 0, 0);
        if (DUAL) { const bf16x8 yf = *(const LAS bf16x8*)(lds + HY_BADDR(sY)); accY = __builtin_amdgcn_mfma_f32_32x32x16_bf16(af, yf, accY, 0, 0, 0); }
        aaddr -= 256; sX -= 16; sY -= 16;
    }
#undef HY_BADDR
}
template <int L>
__device__ __forceinline__ void hy_unit(const Ctx& c, int l, int ch, const GAS float* hbias) {
    constexpr int H = L / 2, NG = L / 256, LP = L + 64, NW = L / 8 + 8, ROWB = 2 * L + 16;
    LAS unsigned char* lds = c.lds;
    const GAS bf16_t* uT = (const GAS bf16_t*)(c.ws + WS_B); GAS bf16_t* oht = (GAS bf16_t*)(c.ws + WS_OHT);
    const int seq0 = (L == 4096) ? 0 : TL;
    const GAS bf16_t* hrbase = (L == 4096) ? (const GAS bf16_t*)(c.ws + WS_HRL) : (const GAS bf16_t*)(c.ws + WS_HRC);
    int gA, gB;
    if (NG == 16) { gA = c.wave < 4 ? c.wave : 4 + c.wave; gB = c.wave < 4 ? 7 - c.wave : 19 - c.wave; } else { gA = c.wave == 0 ? 0 : -1; gB = -1; }
    const int n = c.lane & 31, g = c.lane >> 5, tbl = n >> 2, b = n & 3;
    const int loA = gA < 0 ? 1 << 30 : max(-H - 16, 256 * gA - (L - 16)), hiA = gA < 0 ? -(1 << 30) : min(H, 256 * gA + 224);
    const int loB = gB < 0 ? 1 << 30 : max(-H - 16, 256 * gB - (L - 16)), hiB = gB < 0 ? -(1 << 30) : min(H, 256 * gB + 224);
    const int dlo = min(loA, loB), dhi = max(hiA, hiB);
    unsigned zreg[2][4][2];
    for (int o = 0; o < 2; ++o) {
        const GAS bf16_t* hr = hrbase + ((size_t)(l * 2 + o) * 512 + ch) * LP;
        for (int w = c.tid; w < NW; w += NTHR) {
            u32x4 A4 = (u32x4){0u, 0u, 0u, 0u}; if (w > 0) A4 = *(const GAS u32x4*)(hr + 8 * (w - 1));
            const u32x4 B4 = *(const GAS u32x4*)(hr + 8 * w);
            const unsigned Dd[8] = {A4.x, A4.y, A4.z, A4.w, B4.x, B4.y, B4.z, B4.w};
#pragma unroll
            for (int q = 0; q < 8; ++q) { u32x4 ov;
                if ((q & 1) == 0) { const int j = (8 - q) / 2; ov.x = Dd[j]; ov.y = Dd[j + 1]; ov.z = Dd[j + 2]; ov.w = Dd[j + 3]; }
                else { const int j = (7 - q) / 2; ov.x = __builtin_amdgcn_alignbit(Dd[j + 1], Dd[j], 16); ov.y = __builtin_amdgcn_alignbit(Dd[j + 2], Dd[j + 1], 16);
                       ov.z = __builtin_amdgcn_alignbit(Dd[j + 3], Dd[j + 2], 16); ov.w = __builtin_amdgcn_alignbit(Dd[j + 4], Dd[j + 3], 16); }
                *(LAS u32x4*)(lds + HY_HR_OFF + (8 * w + q) * 16) = ov; }
        }
        if (o == 0) {
            for (int idx = c.tid; idx < 4 * (L / 8); idx += NTHR) { const int bb = idx / (L / 8), wq = idx % (L / 8);
                *(LAS u32x4*)(lds + HY_U_OFF + bb * ROWB + wq * 16) = *(const GAS u32x4*)(uT + (size_t)ch * T + seq0 + bb * L + wq * 8); }
            if (c.tid < 16) *(LAS unsigned*)(lds + HY_ZB_OFF + c.tid * 4) = 0u;
        } else {
#pragma unroll
            for (int gi = 0; gi < 2; ++gi) { const int G = gi == 0 ? gA : gB; if (G >= 0) {
#pragma unroll
                for (int rq = 0; rq < 4; ++rq) { const int t = 32 * (8 * G + tbl) + 8 * rq + 4 * g;
                    u32x2 zz; zz.x = zreg[gi][rq][0]; zz.y = zreg[gi][rq][1]; *(LAS u32x2*)(lds + HY_U_OFF + b * ROWB + 2 * t) = zz; } } }
        }
        __syncthreads();
        f32x16 accA, accB;
#pragma unroll
        for (int r = 0; r < 16; ++r) { accA[r] = 0.f; accB[r] = 0.f; }
        {
            const int qq = (n + 1) & 7, ubase = HY_U_OFF + b * ROWB + 16 * g;
#define HY_AADDR(d) (HY_HR_OFF + (8 * ((H + 31 - (d) - n + 8 * g + qq) >> 3) + qq) * 16)
#define HY_S0(G, d) (32 * (8 * (G) + tbl) - (d))
            if (gB < 0) { if (gA >= 0) hy_span<L, false>(lds, (hiA - loA) / 16 + 1, HY_AADDR(loA), ubase, HY_S0(gA, loA), 0, accA, accB); }
            else {
                const int dS = max(loA, loB), dE = min(hiA, hiB);
                if (loA < dS) hy_span<L, false>(lds, (dS - loA) / 16, HY_AADDR(loA), ubase, HY_S0(gA, loA), 0, accA, accB);
                else if (loB < dS) hy_span<L, false>(lds, (dS - loB) / 16, HY_AADDR(loB), ubase, HY_S0(gB, loB), 0, accB, accA);
                hy_span<L, true>(lds, (dE - dS) / 16 + 1, HY_AADDR(dS), ubase, HY_S0(gA, dS), HY_S0(gB, dS), accA, accB);
                if (hiA > dE) hy_span<L, false>(lds, (hiA - dE) / 16, HY_AADDR(dE + 16), ubase, HY_S0(gA, dE + 16), 0, accA, accB);
                else if (hiB > dE) hy_span<L, false>(lds, (hiB - dE) / 16, HY_AADDR(dE + 16), ubase, HY_S0(gB, dE + 16), 0, accB, accA);
            }
#undef HY_AADDR
#undef HY_S0
        }
        const float bias = hbias[(l * 2 + o) * 512 + ch];
        int tbl_e = tbl, b_e = b, g_e = g; asm volatile("" : "+v"(tbl_e), "+v"(b_e), "+v"(g_e));
#pragma unroll
        for (int gi = 0; gi < 2; ++gi) { const int G = gi == 0 ? gA : gB; if (G >= 0) {
#pragma unroll
            for (int rq = 0; rq < 4; ++rq) { const int t = 32 * (8 * G + tbl_e) + 8 * rq + 4 * g_e;
                const u32x2 uv = *(const LAS u32x2*)(lds + HY_U_OFF + b_e * ROWB + 2 * t);
                const size_t grow = (size_t)seq0 + b_e * L + t;
                const u32x2 xv = *(const GAS u32x2*)(uT + (size_t)((o == 0 ? 512 : 1024) + ch) * T + grow);
                float y[4];
#pragma unroll
                for (int k = 0; k < 4; ++k) y[k] = gi == 0 ? accA[4 * rq + k] : accB[4 * rq + k];
                const float r0 = bflo(xv.x) * (y[0] + bias * bflo(uv.x)), r1 = bfhi(xv.x) * (y[1] + bias * bfhi(uv.x));
                const float r2 = bflo(xv.y) * (y[2] + bias * bflo(uv.y)), r3 = bfhi(xv.y) * (y[3] + bias * bfhi(uv.y));
                const unsigned p0 = cvt_pk_bf16(r0, r1), p1 = cvt_pk_bf16(r2, r3);
                if (o == 0) { zreg[gi][rq][0] = p0; zreg[gi][rq][1] = p1; }
                else { u32x2 ov; ov.x = p0; ov.y = p1; *(GAS u32x2*)(oht + (size_t)ch * T + grow) = ov;   } } } }
        __syncthreads();
    }
}
__device__ __forceinline__ void ph_hyena(const Ctx& c0, int l) {
    const Ctx c = mk_ctx(c0.lds, c0.ws);
    const GAS float* hbias = inp(c, I_HBIAS);
    for (int unit = c.bid; unit < HYW; unit += c.G) { hy_unit<4096>(c, l, unit, hbias); if (l < DEPTH - 1) hy_unit<256>(c, l, unit, hbias); }
}

__device__ __forceinline__ void ph_ohy_t(const Ctx& c0) {
    const Ctx c = mk_ctx(c0.lds, c0.ws);
    const GAS bf16_t* src = (const GAS bf16_t*)(c.ws + WS_OHT); GAS bf16_t* dst = (GAS bf16_t*)(c.ws + WS_OAH) + 512;
    LAS unsigned char* scr = c.lds + c.wave * 16384;
    for (int tile = c.bid * NWAVES + c.wave; tile < (T / 64) * 8; tile += c.G * NWAVES) {
        const int row0 = (tile >> 3) * 64, ch0 = (tile & 7) * 64;
#pragma unroll
        for (int k = 0; k < 8; ++k) { const int cc = (c.lane >> 3) + 8 * k, ck = c.lane & 7;
            const u32x4 v = *(const GAS u32x4*)(src + (size_t)(ch0 + cc) * T + row0 + ck * 8);
            LAS unsigned* d = (LAS unsigned*)(scr + cc * 132 + ck * 16); d[0] = v.x; d[1] = v.y; d[2] = v.z; d[3] = v.w; }
        LDS_WAIT(); asm volatile("" ::: "memory");
        unsigned ow[32];
#pragma unroll
        for (int j = 0; j < 32; ++j) { const unsigned lo = *(const LAS unsigned short*)(scr + (2 * j) * 132 + c.lane * 2), hi = *(const LAS unsigned short*)(scr + (2 * j + 1) * 132 + c.lane * 2); ow[j] = lo | (hi << 16); }
        LDS_WAIT(); asm volatile("" ::: "memory");
#pragma unroll
        for (int k = 0; k < 8; ++k) { u32x4 v; v.x = ow[4 * k]; v.y = ow[4 * k + 1]; v.z = ow[4 * k + 2]; v.w = ow[4 * k + 3]; *(LAS u32x4*)(scr + c.lane * 144 + k * 16) = v; }
        LDS_WAIT(); asm volatile("" ::: "memory");
#pragma unroll
        for (int k = 0; k < 8; ++k) { const int rr = (c.lane >> 3) + 8 * k, ck = c.lane & 7; const u32x4 v = *(const LAS u32x4*)(scr + rr * 144 + ck * 16);
            *(GAS u32x4*)(dst + (size_t)(row0 + rr) * 1024 + ch0 + ck * 8) = v; }
        LDS_WAIT(); asm volatile("" ::: "memory");
    }
}

constexpr int ATT_RPB_OFF = 1024, ATT_VT_OFF = ATT_RPB_OFF + 8 * 15 * 32 * 4, ATT_VT_BYTES = 64 * 72;
template <int MODE>
__device__ __forceinline__ void att_block(const GAS bf16_t* P, const GAS bf16_t* VT, LAS unsigned char* lds, LAS unsigned char* vt, int lane, int n, int h, int head,
                                          int tokk, int ctok, int tabaddr, int vb, const bf16x8 (&qf)[4], f32x16& ot0, f32x16& ot1, float& m, float& lsum) {
    bf16x8 kf[4];
#pragma unroll
    for (int ks = 0; ks < 4; ++ks) kf[ks] = *(const GAS bf16x8*)(P + (size_t)tokk * PW + PK + head * 64 + 16 * ks + 8 * h);
    u32x2 vr[8];
#pragma unroll
    for (int it = 0; it < 8; ++it) vr[it] = *(const GAS u32x2*)(VT + (size_t)(head * 64 + it * 8 + (lane >> 3)) * T + ctok);
    f32x16 st;
#pragma unroll
    for (int r = 0; r < 16; ++r) st[r] = 0.f;
#pragma unroll
    for (int ks = 0; ks < 4; ++ks) st = __builtin_amdgcn_mfma_f32_32x32x16_bf16(kf[ks], qf[ks], st, 0, 0, 0);
    const float SC = 0.18033688011112042f;
    float sv[16];
#pragma unroll
    for (int r = 0; r < 16; ++r) {
        if (MODE == 2) sv[r] = st[r] * SC;
        else { const int cr = MODE == 0 ? 8 * (r >> 2) + (r & 3) : (r & 3), imm = MODE == 0 ? cr * 4 : ((r >> 2) * 32 + (r & 3)) * 4;
            const float bias = *(const LAS float*)(lds + tabaddr + imm);
            const bool ok = (unsigned)(vb + cr) < 16u;
            sv[r] = ok ? st[r] * SC + bias : -1.0e30f; }
    }
    float bm = sv[0];
#pragma unroll
    for (int r = 1; r < 16; ++r) bm = fmaxf(bm, sv[r]);
    bm = fmaxf(bm, __int_as_float(__builtin_amdgcn_ds_bpermute((lane ^ 32) << 2, __float_as_int(bm))));
    const float mn = fmaxf(m, bm), alpha = __builtin_amdgcn_exp2f(m - mn); m = mn;
    float psum = 0.f;
#pragma unroll
    for (int r = 0; r < 16; ++r) { const float pv = __builtin_amdgcn_exp2f(sv[r] - mn); psum += pv; sv[r] = pv; }
    lsum = lsum * alpha + psum;
#pragma unroll
    for (int r = 0; r < 16; ++r) { ot0[r] *= alpha; ot1[r] *= alpha; }
    bf16x8 pb[2];
#pragma unroll
    for (int s2 = 0; s2 < 2; ++s2) { u32x4 w; w.x = cvt_pk_bf16(sv[8 * s2], sv[8 * s2 + 1]); w.y = cvt_pk_bf16(sv[8 * s2 + 2], sv[8 * s2 + 3]);
        w.z = cvt_pk_bf16(sv[8 * s2 + 4], sv[8 * s2 + 5]); w.w = cvt_pk_bf16(sv[8 * s2 + 6], sv[8 * s2 + 7]); pb[s2] = __builtin_bit_cast(bf16x8, w); }
#pragma unroll
    for (int it = 0; it < 8; ++it) *(LAS u32x2*)(vt + (it * 8 + (lane >> 3)) * 72 + (lane & 7) * 8) = vr[it];
#pragma unroll
    for (int s2 = 0; s2 < 2; ++s2) {
        { const u32x2 a = *(const LAS u32x2*)(vt + n * 72 + (4 * s2 + h) * 8), bq = *(const LAS u32x2*)(vt + n * 72 + (4 * s2 + 2 + h) * 8);
          u32x4 w; w.x = a.x; w.y = a.y; w.z = bq.x; w.w = bq.y; ot0 = __builtin_amdgcn_mfma_f32_32x32x16_bf16(__builtin_bit_cast(bf16x8, w), pb[s2], ot0, 0, 0, 0); }
        { const u32x2 a = *(const LAS u32x2*)(vt + (32 + n) * 72 + (4 * s2 + h) * 8), bq = *(const LAS u32x2*)(vt + (32 + n) * 72 + (4 * s2 + 2 + h) * 8);
          u32x4 w; w.x = a.x; w.y = a.y; w.z = bq.x; w.w = bq.y; ot1 = __builtin_amdgcn_mfma_f32_32x32x16_bf16(__builtin_bit_cast(bf16x8, w), pb[s2], ot1, 0, 0, 0); }
    }
}
constexpr int ATT_UNITS = 4096 + 256;
__device__ __forceinline__ void ph_attn(const Ctx& c0, int l) {
    const Ctx c = mk_ctx(c0.lds, c0.ws);
    const GAS bf16_t* P = (const GAS bf16_t*)(c.ws + WS_P); const GAS bf16_t* VT = (const GAS bf16_t*)(c.ws + WS_VT); GAS bf16_t* oatt = (GAS bf16_t*)(c.ws + WS_OAH);
    const GAS float* rpb = inp(c, I_RPB) + (size_t)l * 8 * 15 * 31;
    LAS unsigned char* lds = c.lds;
    for (int i = c.tid; i < 8 * 15 * 32; i += NTHR) { const int hd = i / 480, rem = i % 480, dr = rem >> 5, dc = rem & 31;
        *(LAS float*)(lds + ATT_RPB_OFF + i * 4) = dc < 31 ? rpb[(hd * 15 + dr) * 31 + dc] * 1.4426950408889634f : 0.f; }
    __syncthreads();
    LAS unsigned char* vt = lds + ATT_VT_OFF + c.wave * ATT_VT_BYTES;
    const int lane = c.lane, n = lane & 31, h = lane >> 5;
    const int natt = l < DEPTH - 1 ? ATT_UNITS : 4096;
    for (int u = c.bid * NWAVES + c.wave; u < natt; u += c.G * NWAVES) {
        const bool lat = u < 4096;
        int b, head, r = 0, hf = 0, tokq;
        if (lat) { hf = u & 1; r = (u >> 1) & 63; head = (u >> 7) & 7; b = u >> 10; tokq = b * 4096 + r * 64 + 32 * hf + n; }
        else { const int uu = u - 4096; head = (uu >> 3) & 7; b = uu >> 6; tokq = TL + b * 256 + 32 * (uu & 7) + n; }
        bf16x8 qf[4];
#pragma unroll
        for (int ks = 0; ks < 4; ++ks) qf[ks] = *(const GAS bf16x8*)(P + (size_t)tokq * PW + PQ + head * 64 + 16 * ks + 8 * h);
        f32x16 ot0, ot1;
#pragma unroll
        for (int q = 0; q < 16; ++q) { ot0[q] = 0.f; ot1[q] = 0.f; }
        float m = -1.0e30f, lsum = 0.f;
        if (lat) {
            const int r0 = min(max(r - 4, 0), 56), lo = hf ? 24 : 0, qc = 32 * hf + n, c0q = min(max(qc - 8, 0), 48);
            for (int kb = 0; kb < 8; ++kb) {
                const int base = b * 4096 + (r0 + kb) * 64 + lo, kx = lo + 4 * h;
                const int tabaddr = ATT_RPB_OFF + (((head * 15 + (r0 + kb - r + 7)) * 32) + kx - qc + 15) * 4;
                att_block<0>(P, VT, lds, vt, lane, n, h, head, base + n, base + 4 * (lane & 7), tabaddr, kx - c0q, qf, ot0, ot1, m, lsum);
            }
            for (int kb = 0; kb < 2; ++kb) {
                const int rowb = b * 4096 + (r0 + 4 * kb) * 64 + lo + 32, kx = lo + 32 + 4 * h, cc = lane & 7;
                const int tabaddr = ATT_RPB_OFF + (((head * 15 + (r0 + 4 * kb - r + 7)) * 32) + kx - qc + 15) * 4;
                att_block<1>(P, VT, lds, vt, lane, n, h, head, rowb + (n >> 3) * 64 + (n & 7), rowb + (cc >> 1) * 64 + 4 * (cc & 1), tabaddr, kx - c0q, qf, ot0, ot1, m, lsum);
            }
        }
        for (int kb = 0; kb < 8; ++kb) { const int base = TL + b * 256 + 32 * kb;
            att_block<2>(P, VT, lds, vt, lane, n, h, head, base + n, base + 4 * (lane & 7), 0, 0, qf, ot0, ot1, m, lsum); }
        const float ltot = lsum + __int_as_float(__builtin_amdgcn_ds_bpermute((lane ^ 32) << 2, __float_as_int(lsum)));
        const float inv = __builtin_amdgcn_rcpf(ltot);
        GAS bf16_t* op = oatt + (size_t)tokq * 1024 + head * 64 + 4 * h;
#pragma unroll
        for (int rq = 0; rq < 4; ++rq) {
            u32x2 w0, w1; w0.x = cvt_pk_bf16(ot0[4 * rq] * inv, ot0[4 * rq + 1] * inv); w0.y = cvt_pk_bf16(ot0[4 * rq + 2] * inv, ot0[4 * rq + 3] * inv);
            w1.x = cvt_pk_bf16(ot1[4 * rq] * inv, ot1[4 * rq + 1] * inv); w1.y = cvt_pk_bf16(ot1[4 * rq + 2] * inv, ot1[4 * rq + 3] * inv);
            *(GAS u32x2*)(op + 8 * rq) = w0; *(GAS u32x2*)(op + 32 + 8 * rq) = w1; }
    }
    __syncthreads();
}

__device__ __forceinline__ void ph_final(const Ctx& c0) {
    const Ctx c = mk_ctx(c0.lds, c0.ws);
    const GAS float* xres = (const GAS float*)(c.ws + WS_X); const GAS float* gp = inp(c, I_FINALG); GAS float* outp = (GAS float*)inp(c, 30);
    const MoeComb mc{(const GAS int*)(c.ws + WS_ROUTE), (const GAS float*)(c.ws + WS_RWT), (const GAS bf16_t*)(c.ws + WS_Y), (const GAS float*)(c.ws + WS_MOD) + (size_t)(DEPTH - 1) * 5 * 6144 + 5 * 1024};
    LAS unsigned* offs = (LAS unsigned*)c.lds + 32;
    moe_offsets(c, 1, offs);
    __syncthreads();
    for (int row = c.bid * NWAVES + c.wave; row < TL; row += c.G * NWAVES) {
        const GAS float* src = xres + (size_t)row * D; f32x4 v[4]; float ss = 0.f;
#pragma unroll
        for (int j = 0; j < 4; ++j) v[j] = *(const GAS f32x4*)(src + 4 * (c.lane + 64 * j));
        moe_combine_row(mc, offs, row, row >> 12, c.lane, v);
#pragma unroll
        for (int j = 0; j < 4; ++j) ss += (v[j][0] * v[j][0] + v[j][1] * v[j][1]) + (v[j][2] * v[j][2] + v[j][3] * v[j][3]);
        ss = wave_sum(ss, c.lane);
        const float rstd = 1.f / sqrtf(ss * (1.f / D) + EPS);
#pragma unroll
        for (int j = 0; j < 4; ++j) { const int k0 = 4 * (c.lane + 64 * j); const f32x4 g4 = *(const GAS f32x4*)(gp + k0); *(GAS f32x4*)(outp + (size_t)row * D + k0) = v[j] * rstd * g4; }
    }
}

constexpr int MOE_OFF = 132096;
template <bool GATHER_> struct MoeOrder {
    static constexpr bool GATHER = GATHER_;
    int nM, nN, nwg, G, c; const GAS char* A; const GAS char* B; size_t astep, bstep, estep; const GAS int* tokenof; const LAS unsigned* tab;
    __device__ void init(const GAS void* A_, int lda, const GAS void* B_, int ldb, size_t estep_bytes, int N, int G_, int c_, const GAS int* tok, const LAS unsigned* tab_) {
        tab = tab_; nM = (int)((unsigned)__builtin_amdgcn_readfirstlane(tab[8]) >> 8); nN = N / pg8::BM; nwg = nM * nN; G = G_; c = c_; A = (const GAS char*)A_; B = (const GAS char*)B_;
        astep = (size_t)pg8::BM * lda * 2; bstep = (size_t)pg8::BM * ldb * 2; estep = estep_bytes; tokenof = tok; }
    __device__ bool next(int i, pg8::Unit& u) const {
        const long L = (long)i * G + c; if (L >= nwg) return false;
        int wgid = (int)L; { const int q = nwg / pg8::NXCD, r = nwg % pg8::NXCD, xcd = wgid % pg8::NXCD, off = wgid / pg8::NXCD; wgid = (xcd < r ? xcd * (q + 1) : r * (q + 1) + (xcd - r) * q) + off; }
        const int nig = pg8::WGM * nN, gid = wgid / nig, fm = gid * pg8::WGM, gsz = (nM - fm) < pg8::WGM ? (nM - fm) : pg8::WGM;
        u.pm = fm + ((wgid % nig) % gsz); u.pn = (wgid % nig) / gsz;
        const unsigned slot0 = (unsigned)u.pm << 8; int e = 0;
#pragma unroll
        for (int j = 1; j < 8; ++j) e += (slot0 >= (unsigned)__builtin_amdgcn_readfirstlane(tab[j])) ? 1 : 0;
        const unsigned pos0 = slot0 - (unsigned)__builtin_amdgcn_readfirstlane(tab[e]), cnt = (unsigned)__builtin_amdgcn_readfirstlane(tab[16 + e]);
        u.nvalid = cnt > pos0 ? (int)(cnt - pos0) : 0; u.tk = tokenof + (size_t)e * T + pos0;
        u.a = GATHER ? A : A + (size_t)u.pm * astep; u.b = B + (size_t)e * estep + (size_t)u.pn * bstep; return true;
    }
    __device__ __forceinline__ int arow(const pg8::Unit& u, int r) const { return r < u.nvalid ? u.tk[r] : 0; }
    __device__ __forceinline__ void a_ready(const pg8::Unit&) const {}
    __device__ __forceinline__ void done(const pg8::Unit&) const {}
};
__device__ __forceinline__ void moe_table(const Ctx& c, int i) {
    LAS unsigned* tab = (LAS unsigned*)(c.lds + MOE_OFF);
    if (c.tid == 0) { const GAS unsigned* cnt = (const GAS unsigned*)(c.ws + WS_CTL) + CW_CNT + 64 * i; unsigned o = 0;
        for (int e = 0; e < 8; ++e) { const unsigned ce = cnt[e]; tab[e] = o; tab[16 + e] = ce; o += (ce + 255u) & ~255u; } tab[8] = o; }
    __syncthreads();
}

#define XB_TMO      128
#define XB_XCNT(j)  (256  + 64 * (j))
#define XB_XSUB(j)  (1280 + 64 * (j))
#define XB_XGEN(j)  (2304 + 64 * (j))
#define XB_TOP      3328
#define XB_TOPGEN   3392
#define XCD_BAR_WORDS 3456
#define XB_SPIN_CAP (1u << 18)
__device__ __forceinline__ unsigned xb_ld(GAS unsigned* p)              { return __hip_atomic_load(p, __ATOMIC_RELAXED, __HIP_MEMORY_SCOPE_AGENT); }
__device__ __forceinline__ unsigned xb_add(GAS unsigned* p, unsigned v) { return __hip_atomic_fetch_add(p, v, __ATOMIC_RELAXED, __HIP_MEMORY_SCOPE_AGENT); }
__device__ __forceinline__ unsigned xb_xcc_id() { return (unsigned)__builtin_amdgcn_s_getreg((3 << 11) | 20) & 0xFu; }
#define XB_SPIN(cond, bar) do { unsigned _sp = 0; while (cond) { __builtin_amdgcn_s_sleep(1); \
    if ((++_sp & 255u) == 0u) { if (xb_ld(&(bar)[XB_TMO])) break; if (_sp > XB_SPIN_CAP) { (void)xb_add(&(bar)[XB_TMO], 1u); break; } } } } while (0)
struct XcdBarrier { GAS unsigned* bar; unsigned x; volatile LAS unsigned* st; };
__device__ __forceinline__ XcdBarrier xcd_barrier_post(GAS unsigned* bar, volatile LAS unsigned* st) {
    XcdBarrier b; b.bar = bar; b.x = xb_xcc_id(); b.st = st;
    if (threadIdx.x == 0) (void)xb_add(&bar[XB_XCNT(b.x)], 1u);
    return b;
}
__device__ __forceinline__ void xcd_barrier_complete(GAS unsigned* bar, unsigned x, unsigned& nloc, unsigned& nx) {
    const unsigned G = gridDim.x * gridDim.y * gridDim.z;
    unsigned sum, cnt, mine, sp = 0u;
    for (;;) {
        sum = 0u; cnt = 0u; mine = 0u;
#pragma unroll
        for (unsigned j = 0; j < 16; ++j) { const unsigned c = xb_ld(&bar[XB_XCNT(j)]); sum += c; cnt += (c > 0u) ? 1u : 0u; mine = (j == x) ? c : mine; }
        if (sum == G) break;
        __builtin_amdgcn_s_sleep(1);
        if ((++sp & 255u) == 0u) { if (xb_ld(&bar[XB_TMO])) break; if (sp > XB_SPIN_CAP) { (void)xb_add(&bar[XB_TMO], 1u); break; } }
    }
    nloc = mine > 0u ? mine : 1u; nx = cnt > 0u ? cnt : 1u;
}
__device__ __forceinline__ void xcd_barrier(const XcdBarrier& b) {
    asm volatile("s_waitcnt vmcnt(0)" ::: "memory");
    __syncthreads();
    if (threadIdx.x == 0) {
        GAS unsigned* bar = b.bar; asm volatile("" : "+s"(bar));     const unsigned bx = xb_xcc_id();
        __builtin_amdgcn_s_waitcnt(0);
        unsigned nloc = b.st[0], nx = b.st[1];
        if (nloc == 0u) { xcd_barrier_complete(bar, bx, nloc, nx); b.st[0] = nloc; b.st[1] = nx; }
        const unsigned old = xb_add(&bar[XB_XSUB(bx)], 1u);
        const unsigned gen = old / nloc;
        if (old + 1u == (gen + 1u) * nloc) {
            __builtin_amdgcn_fence(__ATOMIC_RELEASE, "agent");
            asm volatile("s_waitcnt vmcnt(0)" ::: "memory");
            const unsigned og = xb_add(&bar[XB_TOP], 1u);
            const unsigned tg = og / nx;
            if (og + 1u == (tg + 1u) * nx) xb_add(&bar[XB_TOPGEN], 1u);
            else XB_SPIN(xb_ld(&bar[XB_TOPGEN]) == tg, bar);
            __builtin_amdgcn_fence(__ATOMIC_ACQUIRE, "agent");
            xb_add(&bar[XB_XGEN(bx)], 1u);
            asm volatile("s_waitcnt vmcnt(0)" ::: "memory");
        } else {
            XB_SPIN(xb_ld(&bar[XB_XGEN(bx)]) == gen, bar);
            __builtin_amdgcn_fence(__ATOMIC_ACQUIRE, "agent");
            asm volatile("s_waitcnt vmcnt(0)" ::: "memory");
        }
    }
    __syncthreads();
}

constexpr int CW_BAR = 4096;

__global__ void __launch_bounds__(NTHR, 2) fwd(Args args) {
    extern __shared__ __attribute__((aligned(16))) unsigned char lds_raw[];
    Ctx c; c.lds = (LAS unsigned char*)lds_raw; c.tid = threadIdx.x; c.lane = c.tid & 63; c.wave = __builtin_amdgcn_readfirstlane(c.tid >> 6); c.G = gridDim.x; c.bid = blockIdx.x; c.ws = (GAS unsigned char*)args.ws;
    GAS unsigned char* ws = (GAS unsigned char*)args.ws;
    volatile LAS unsigned* MISC = (volatile LAS unsigned*)(c.lds + MISC_OFF);
    if (c.tid < 32) MISC[c.tid] = 0u;
    if (c.tid < 31) { const unsigned long long pv = c.tid < 30 ? (unsigned long long)args.in[c.tid] : (unsigned long long)args.out;
        volatile LAS unsigned* pt = (volatile LAS unsigned*)(c.lds + PTR_OFF) + 2 * c.tid; pt[0] = (unsigned)pv; pt[1] = (unsigned)(pv >> 32); }
    __syncthreads();
    XcdBarrier bar = xcd_barrier_post((GAS unsigned*)(ws + WS_CTL) + CW_BAR, MISC + 8);
#define GRID_BAR() xcd_barrier(bar)
#ifndef PROFILE_ID
#define PROFILE_ID (-1)
#endif
#define PROF(id) do { if (PROFILE_ID >= 0 && blockIdx.x == 0 && threadIdx.x == 0) { const unsigned long long t_ = __builtin_amdgcn_s_memrealtime(); \
        volatile LAS unsigned* q_ = MISC + 16; const unsigned long long prev_ = ((unsigned long long)q_[1] << 32) | q_[0]; \
        if ((id) == PROFILE_ID) { const unsigned long long a_ = (((unsigned long long)q_[3] << 32) | q_[2]) + (t_ - prev_); q_[2] = (unsigned)a_; q_[3] = (unsigned)(a_ >> 32); } \
        q_[0] = (unsigned)t_; q_[1] = (unsigned)(t_ >> 32); } } while (0)
    PROF(99);

    ph_convert(c); __syncthreads(); ph_mod(c); __syncthreads(); ph_filt(c);
    GRID_BAR(); PROF(0);
    for (int l = 0; l < DEPTH; ++l) {
        ph_norm(c, l, 0);
        GRID_BAR(); PROF(1);
        {   GAS unsigned char* ws = c.ws; asm volatile("" : "+s"(ws));
            pg8::Gemm g{D, D, D, STAG}; pg8::StaticOrder S; S.init(ws + WS_H, D, (GAS bf16_t*)(ws + WS_WIN) + (size_t)l * PW * D, D, T, PW, c.G, c.bid);
            EpiStoreBf16 E{(GAS bf16_t*)(ws + WS_P), PW};
            pg8::gemm_phase(c.lds, g, S, E); }
        GRID_BAR(); PROF(2);
        ph_sc(c, l);
        GRID_BAR(); PROF(3);
        ph_hyena(c, l); ph_attn(c, l);
        GRID_BAR(); PROF(4);
        ph_ohy_t(c);
        GRID_BAR(); PROF(5);
        {   GAS unsigned char* ws = c.ws; asm volatile("" : "+s"(ws));
            const GAS bf16_t* wab = (const GAS bf16_t*)(ws + WS_WPAB) + (size_t)l * D * D;
            pg8::Gemm g{D, D, D}; pg8::StaticOrder S; S.init(ws + WS_OAH, D, wab, D, TL, D, c.G, c.bid);
            EpiMergeK E{(const GAS bf16_t*)(ws + WS_P), (GAS bf16_t*)(ws + WS_H)};
            pg8::gemm_phase(c.lds, g, S, E);
            if (l < DEPTH - 1) ctx_gemm(c.lds, (const GAS bf16_t*)(ws + WS_OAH), D, wab, D, D, CEpiMergeK{(const GAS bf16_t*)(ws + WS_P), (GAS bf16_t*)(ws + WS_H)}); }
        GRID_BAR(); PROF(6);
        {   GAS unsigned char* ws = c.ws; asm volatile("" : "+s"(ws));
            const GAS float* modl = (const GAS float*)(ws + WS_MOD) + (size_t)l * 5 * 6144;
            pg8::Gemm g{D, D, D}; pg8::StaticOrder S; S.init(ws + WS_H, D, (GAS bf16_t*)(ws + WS_WO) + (size_t)l * D * D, D, TL, D, c.G, c.bid);
            EpiResid E{(GAS float*)(ws + WS_X), modl + 2 * 1024};
            pg8::gemm_phase(c.lds, g, S, E);
            if (l < DEPTH - 1) ctx_gemm(c.lds, (const GAS bf16_t*)(ws + WS_H), D, (const GAS bf16_t*)(ws + WS_WO) + (size_t)l * D * D, D, D, CEpiResid{(GAS float*)(ws + WS_X), modl + 4 * 6144 + 2 * 1024}); }
        GRID_BAR(); PROF(7);
        ph_norm(c, l, 1);
        GRID_BAR(); PROF(8);
        if ((l & 1) == 0) {
            {   GAS unsigned char* ws = c.ws; asm volatile("" : "+s"(ws));
                const GAS bf16_t* w = (const GAS bf16_t*)(ws + WS_W13D) + (size_t)(l >> 1) * 2 * FF * D;
                pg8::Gemm g{D, D, D, STAG}; pg8::StaticOrder S; S.init(ws + WS_H, D, w, D, T, 2 * FF, c.G, c.bid);
                EpiSwiglu E{(GAS bf16_t*)(ws + WS_P)};
                pg8::gemm_phase(c.lds, g, S, E); }
            GRID_BAR(); PROF(9);
            {   GAS unsigned char* ws = c.ws; asm volatile("" : "+s"(ws));
                const GAS float* modl = (const GAS float*)(ws + WS_MOD) + (size_t)l * 5 * 6144;
                const GAS bf16_t* w = (const GAS bf16_t*)(ws + WS_W2D) + (size_t)(l >> 1) * D * FF;
                pg8::Gemm g{FF, FF, FF}; pg8::StaticOrder S; S.init(ws + WS_P, FF, w, FF, TL, D, c.G, c.bid);
                EpiResid E{(GAS float*)(ws + WS_X), modl + 5 * 1024};
                pg8::gemm_phase(c.lds, g, S, E);
                ctx_gemm(c.lds, (const GAS bf16_t*)(ws + WS_P), FF, w, FF, FF, CEpiResid{(GAS float*)(ws + WS_X), modl + 4 * 6144 + 5 * 1024}); }
            GRID_BAR(); PROF(10);
        } else {
            const Ctx cm = mk_ctx(c.lds, c.ws);
            moe_table(cm, l >> 1);
            {   GAS unsigned char* ws = c.ws; asm volatile("" : "+s"(ws));
                const GAS bf16_t* w = (const GAS bf16_t*)(ws + WS_W13M) + (size_t)((l >> 1) * NE) * 2 * FF * D;
                pg8::Gemm g{D, D, D, STAG}; MoeOrder<true> S; S.init(ws + WS_H, D, w, D, (size_t)2 * FF * D * 2, 2 * FF, c.G, c.bid, (const GAS int*)(ws + WS_TOK), (const LAS unsigned*)(c.lds + MOE_OFF));
                EpiSwiglu E{(GAS bf16_t*)(ws + WS_P)};
                pg8::gemm_phase(c.lds, g, S, E); }
            GRID_BAR(); PROF(11);
            {   GAS unsigned char* ws = c.ws; asm volatile("" : "+s"(ws));
                const GAS bf16_t* w = (const GAS bf16_t*)(ws + WS_W2M) + (size_t)((l >> 1) * NE) * D * FF;
                pg8::Gemm g{FF, FF, FF, STAG}; MoeOrder<false> S; S.init(ws + WS_P, FF, w, FF, (size_t)D * FF * 2, D, c.G, c.bid, (const GAS int*)(ws + WS_TOK), (const LAS unsigned*)(c.lds + MOE_OFF));
                EpiStoreBf16 E{(GAS bf16_t*)(ws + WS_Y), D};
                pg8::gemm_phase(c.lds, g, S, E); }
            GRID_BAR(); PROF(12);
        }
    }
    ph_final(c);
    if (PROFILE_ID >= 0 && blockIdx.x == 0) {
        if (threadIdx.x == 0) { PROF(13); volatile LAS unsigned* q_ = MISC + 16; const unsigned long long a_ = ((unsigned long long)q_[3] << 32) | q_[2], t0_ = __builtin_amdgcn_s_memrealtime();
            while (__builtin_amdgcn_s_memrealtime() - t0_ < a_) __builtin_amdgcn_s_sleep(8); }
        __syncthreads();
    }
}

extern "C" void kernel_launch(void* const* d_in, const int* in_sizes, int n_in, void* d_out, int out_size, void* d_ws, size_t ws_size, hipStream_t stream) {
    static int grid = 0;
    if (grid == 0) {
        if (n_in != 30 || out_size != TL * D || ws_size < WS_END) { fprintf(stderr, "kernel_launch: unexpected shapes (n_in %d out %d ws %zu)\n", n_in, out_size, ws_size); grid = -1; return; }
        int dev = 0, cus = 0, per_cu = 0; (void)hipGetDevice(&dev); (void)hipDeviceGetAttribute(&cus, hipDeviceAttributeMultiprocessorCount, dev);
        if (hipFuncSetAttribute((const void*)fwd, hipFuncAttributeMaxDynamicSharedMemorySize, LDS_BYTES) != hipSuccess) { fprintf(stderr, "kernel_launch: hipFuncSetAttribute failed\n"); grid = -1; return; }
        if (hipOccupancyMaxActiveBlocksPerMultiprocessor(&per_cu, (const void*)fwd, NTHR, LDS_BYTES) != hipSuccess || per_cu < 1) fprintf(stderr, "kernel_launch: occupancy query reports %d\n", per_cu);
        (void)hipGetLastError();
        grid = cus > 0 ? cus : 256;
    }
    if (grid < 0) return;
    (void)hipMemsetAsync((char*)d_ws + WS_CTL, 0, CTL_ZERO_BYTES, stream);
    Args a{};
    for (int i = 0; i < 30; ++i) a.in[i] = (const float*)d_in[i];
    a.out = (float*)d_out; a.ws = (unsigned char*)d_ws;
    hipLaunchKernelGGL(fwd, dim3(grid), dim3(NTHR), LDS_BYTES, stream, a);
}
```

```cpp
#include <hip/hip_runtime.h>
#include <cstdio>
#include <cstdint>

#define LAS __attribute__((address_space(3)))
#define GAS __attribute__((address_space(1)))
typedef unsigned short bf16_t;
typedef short bf16x8 __attribute__((ext_vector_type(8)));
typedef float f32x4 __attribute__((ext_vector_type(4)));
typedef float f32x2 __attribute__((ext_vector_type(2)));
typedef float f32x16 __attribute__((ext_vector_type(16)));
typedef unsigned u32x4 __attribute__((ext_vector_type(4)));
typedef unsigned u32x2 __attribute__((ext_vector_type(2)));

constexpr int D = 1024, NB = 4, SEQ = 4096, DEPTH = 4, CTX = 256;
constexpr int TL = NB * SEQ, TC = NB * CTX, T = TL + TC;
constexpr int PW = 5120, FF = 2816, NE = 8, HYW = 512;
constexpr int PQ = 0, PK = 512, PV = 1024, PHY = 1536, PGA = 3072, PGB = 4096;
constexpr float EPS = 1e-6f;

constexpr size_t MiB = 1u << 20;
constexpr size_t WS_CTL = 0, CTL_ZERO_BYTES = 1 * MiB;
constexpr size_t WS_MOD = 1 * MiB;
constexpr size_t WS_ROUTE = 2 * MiB;
constexpr size_t WS_RWT = 2 * MiB + 512 * 1024;
constexpr size_t WS_TOK = 3 * MiB;
constexpr int CW_CNT = 8192;
constexpr int MAXSLOT = 36864;
constexpr size_t WS_Y = 660 * MiB;
constexpr size_t WS_WIN = 4 * MiB;
constexpr size_t WS_WPAB = 44 * MiB;
constexpr size_t WS_WO = 52 * MiB;
constexpr size_t WS_W13D = 60 * MiB;
constexpr size_t WS_W2D = 82 * MiB;
constexpr size_t WS_W13M = 93 * MiB;
constexpr size_t WS_W2M = 269 * MiB;
constexpr size_t WS_X = 357 * MiB;
constexpr size_t WS_H = 425 * MiB;
constexpr size_t WS_P = 459 * MiB;
constexpr size_t WS_OAH = 629 * MiB;
constexpr size_t WS_B = 663 * MiB;
constexpr size_t WS_OHT = WS_B + 51 * MiB;
constexpr size_t WS_VT = 748 * MiB;
constexpr size_t WS_HRL = 816 * MiB;
constexpr size_t WS_HRC = 850 * MiB;
constexpr size_t WS_END = 853 * MiB;

constexpr int STAG = 3;
constexpr int LDS_BYTES = 147456;
constexpr int NWAVES = 8, NTHR = 512;

#define LDS_WAIT() asm volatile("s_waitcnt lgkmcnt(0)" ::: "memory")
#define VM_WAIT() asm volatile("s_waitcnt vmcnt(0)" ::: "memory")
__device__ __forceinline__ float bf2f(unsigned b) { return __uint_as_float(b << 16); }
__device__ __forceinline__ float bflo(unsigned w) { return __uint_as_float(w << 16); }
__device__ __forceinline__ float bfhi(unsigned w) { return __uint_as_float(w & 0xffff0000u); }
__device__ __forceinline__ unsigned cvt_pk_bf16(float lo, float hi) { unsigned r; asm volatile("v_cvt_pk_bf16_f32 %0, %1, %2" : "=v"(r) : "v"(lo), "v"(hi)); return r; }
__device__ __forceinline__ float wave_sum(float v, int lane) {
#pragma unroll
    for (int o = 1; o < 64; o <<= 1) v += __int_as_float(__builtin_amdgcn_ds_bpermute((lane ^ o) << 2, __float_as_int(v)));
    return v;
}
__device__ __forceinline__ float sigmoidf_(float x) { return __builtin_amdgcn_rcpf(1.f + __expf(-x)); }
__device__ __forceinline__ float sin_rev(float r) { return __builtin_amdgcn_sinf(__builtin_amdgcn_fractf(r)); }
__device__ __forceinline__ float sin_rad(float x) { return sin_rev(x * 0.15915494309189535f); }

namespace pg8 {
constexpr int BM = 256, BK = 64, HALF = 128, HTB = HALF * BK * 2, STAGE_BYTES = 8 * HTB, NXCD = 8, WGM = 8;
__host__ __device__ __forceinline__ int lds_byte(int r, int c) { const int st = (r >> 4) * 2 + (c >> 5), rr = r & 15, cc = c & 31, ob = rr * 64 + cc * 2; return st * 1024 + (ob ^ (((ob >> 9) & 1) << 5)); }
__host__ __device__ __forceinline__ void stage_rc(int b, int& R, int& C) { const int st = b / 1024, sb = b % 1024, swz = sb ^ (((sb >> 9) & 1) << 5); R = (st >> 1) * 16 + swz / 64; C = (st & 1) * 32 + (swz % 64) / 2; }
__host__ __device__ __forceinline__ int perm32(int rho) { const int n = rho >> 4, i = rho & 15; return 8 * (i >> 2) + 4 * n + (i & 3); }

struct Unit { int pm, pn; const GAS char* a; const GAS char* b; const GAS int* tk; int nvalid; };
struct Gemm { int K, lda, ldb; int stagger = 0; };

struct StaticOrder {
    int nM, nN, nwg, G, c; const GAS char* A; const GAS char* B; size_t astep, bstep;
    __device__ void init(const GAS void* A_, int lda, const GAS void* B_, int ldb, int M, int N, int G_, int c_) {
        nM = M / BM; nN = N / BM; nwg = nM * nN; G = G_; c = c_; A = (const GAS char*)A_; B = (const GAS char*)B_; astep = (size_t)BM * lda * 2; bstep = (size_t)BM * ldb * 2; }
    __device__ bool next(int i, Unit& u) const {
        const long L = (long)i * G + c; if (L >= nwg) return false;
        int wgid = (int)L; { const int q = nwg / NXCD, r = nwg % NXCD, xcd = wgid % NXCD, off = wgid / NXCD; wgid = (xcd < r ? xcd * (q + 1) : r * (q + 1) + (xcd - r) * q) + off; }
        const int nig = WGM * nN, gid = wgid / nig, fm = gid * WGM, gsz = (nM - fm) < WGM ? (nM - fm) : WGM;
        u.pm = fm + ((wgid % nig) % gsz); u.pn = (wgid % nig) / gsz; u.a = A + (size_t)u.pm * astep; u.b = B + (size_t)u.pn * bstep; return true;
    }
    static constexpr bool GATHER = false;
    __device__ __forceinline__ int arow(const Unit&, int) const { return 0; }
    __device__ __forceinline__ void a_ready(const Unit&) const {}
    __device__ __forceinline__ void done(const Unit&) const {}
};

template <class Epi, class Sched, bool ALIGN_EPI = true>
__device__ __forceinline__ void gemm_phase(LAS unsigned char* lds, const Gemm g, const Sched& S, const Epi& E) {
    int tid = threadIdx.x; asm volatile("" : "+v"(tid));
    const int wid = __builtin_amdgcn_readfirstlane(tid >> 6), lane = tid & 63, wr = wid >> 2, wc = wid & 3, fr = lane & 15, fq = lane >> 4;
    const int K = g.K, nt = K / BK;
    constexpr bool GATHER = Sched::GATHER;
    unsigned voffB[2]; unsigned cA0[2], cA1[2], nA0[2], nA1[2]; int RA[2], CA[2];
    const size_t hstepA = (size_t)HALF * g.lda * 2, hstepB = (size_t)HALF * g.ldb * 2;
#pragma unroll
    for (int i = 0; i < 2; ++i) { int R, C; stage_rc(tid * 16 + i * 8192, R, C); const int Rb = Epi::PERM ? ((R & ~31) + perm32(R & 31)) : R;
        RA[i] = R; CA[i] = C; voffB[i] = (unsigned)(Rb * g.ldb + C) * 2u;
        cA0[i] = (unsigned)(R * g.lda + C) * 2u; cA1[i] = cA0[i]; nA0[i] = cA0[i]; nA1[i] = cA0[i]; }
    const size_t h1A = GATHER ? 0 : hstepA;
    const size_t kstep = (size_t)(BK * 2);
    const unsigned ldsw = (unsigned)wid * 1024u;
    const int aoff = lds_byte(wr * 64 + fr, fq * 8), boff = lds_byte(wc * 32 + fr, fq * 8);
#define PG8_SA(b, h) (((b) * 2 + (h)) * HTB)
#define PG8_SB(b, h) ((4 + (b) * 2 + (h)) * HTB)
#define PG8_STAGE(bufoff, gbase, voff) do { _Pragma("unroll") for (int _i = 0; _i < 2; ++_i) \
        __builtin_amdgcn_global_load_lds((const GAS unsigned*)((const GAS char*)(gbase) + (voff)[_i]), (LAS unsigned*)(lds + (bufoff) + ldsw + _i * 8192), 16, 0, 0); } while (0)
#define PG8_LDA(dst, b, h) do { _Pragma("unroll") for (int m = 0; m < 4; ++m) _Pragma("unroll") for (int k = 0; k < 2; ++k) dst[m][k] = *(const LAS bf16x8*)(lds + PG8_SA(b, h) + aoff + m * 2048 + k * 1024); } while (0)
#define PG8_LDB(dst, b, h) do { _Pragma("unroll") for (int n = 0; n < 2; ++n) _Pragma("unroll") for (int k = 0; k < 2; ++k) dst[n][k] = *(const LAS bf16x8*)(lds + PG8_SB(b, h) + boff + n * 2048 + k * 1024); } while (0)
#define PG8_MMA(ai, bj, At, Bt) do { __builtin_amdgcn_s_setprio(1); _Pragma("unroll") for (int m = 0; m < 4; ++m) _Pragma("unroll") for (int n = 0; n < 2; ++n) _Pragma("unroll") for (int k = 0; k < 2; ++k) \
        acc[ai][bj][m][n] = __builtin_amdgcn_mfma_f32_16x16x32_bf16(Bt[n][k], At[m][k], acc[ai][bj][m][n], 0, 0, 0); __builtin_amdgcn_s_setprio(0); } while (0)
#define PG8_WAIT_V(n) asm volatile("s_waitcnt vmcnt(" #n ")" ::: "memory")
#define PG8_WAIT_L(n) asm volatile("s_waitcnt lgkmcnt(" #n ")" ::: "memory")
#define PG8_BAR __builtin_amdgcn_s_barrier()
#define PG8_SCHED __builtin_amdgcn_sched_barrier(0)
    Unit cur, nxt; int ui = 0;
    if (!S.next(0, cur)) return;
    if (g.stagger > 0) {
        const int slot = (blockIdx.x >> 3) & 7;
        int steps = slot * g.stagger;
        for (int i = 0; i < steps; ++i) __builtin_amdgcn_s_sleep(16);
    }
    if constexpr (GATHER) {
#pragma unroll
        for (int i = 0; i < 2; ++i) { cA0[i] = (unsigned)(S.arow(cur, RA[i]) * g.lda + CA[i]) * 2u; cA1[i] = (unsigned)(S.arow(cur, HALF + RA[i]) * g.lda + CA[i]) * 2u; }
    }
    f32x4 acc[2][2][4][2];
#pragma unroll
    for (int a = 0; a < 2; ++a)
#pragma unroll
        for (int b = 0; b < 2; ++b)
#pragma unroll
            for (int m = 0; m < 4; ++m)
#pragma unroll
                for (int n = 0; n < 2; ++n) acc[a][b][m][n] = (f32x4){0.f, 0.f, 0.f, 0.f};
    bf16x8 At[4][2], B0[2][2], B1[2][2];
    const GAS char* cA = cur.a; const GAS char* cB = cur.b;
    S.a_ready(cur);
    PG8_STAGE(PG8_SB(0, 0), cB, voffB); PG8_STAGE(PG8_SB(0, 1), cB + hstepB, voffB); PG8_STAGE(PG8_SA(0, 0), cA, cA0); PG8_STAGE(PG8_SA(0, 1), cA + h1A, cA1);
    if (wr == 1) PG8_BAR;
    PG8_WAIT_V(2); PG8_BAR;
    PG8_STAGE(PG8_SB(1, 0), cB + kstep, voffB); PG8_STAGE(PG8_SA(1, 0), cA + kstep, cA0); PG8_STAGE(PG8_SB(1, 1), cB + hstepB + kstep, voffB);
    PG8_WAIT_V(6); PG8_BAR;
    for (;;) {
        const bool has_next = S.next(ui + 1, nxt);
        const GAS char* nA = has_next ? nxt.a : cA; const GAS char* nB = has_next ? nxt.b : cB;
        if constexpr (GATHER) {
#pragma unroll
            for (int i = 0; i < 2; ++i) { nA0[i] = has_next ? (unsigned)(S.arow(nxt, RA[i]) * g.lda + CA[i]) * 2u : cA0[i]; nA1[i] = has_next ? (unsigned)(S.arow(nxt, HALF + RA[i]) * g.lda + CA[i]) * 2u : cA1[i]; }
        }
        for (int kh = 0; kh < (Epi::MIDK ? 2 : 1); ++kh) {
        const int tb = Epi::MIDK ? kh * (nt / 2) : 0, te = Epi::MIDK ? tb + nt / 2 : nt;
        for (int t = tb; t < te; t += 2) {
            const bool last = (t == nt - 2);
            const GAS char* a1 = cA + (size_t)(t + 1) * kstep;
            const GAS char* a2 = last ? nA : cA + (size_t)(t + 2) * kstep; const GAS char* b2 = last ? nB : cB + (size_t)(t + 2) * kstep;
            const GAS char* a3 = a2 + kstep; const GAS char* b3 = b2 + kstep;
            unsigned x0[2], x1[2];
#pragma unroll
            for (int i = 0; i < 2; ++i) { x0[i] = (GATHER && last) ? nA0[i] : cA0[i]; x1[i] = GATHER ? (last ? nA1[i] : cA1[i]) : cA0[i]; }
            if (last && has_next) S.a_ready(nxt);
            PG8_LDB(B0, 0, 0); PG8_LDB(B1, 0, 1); PG8_SCHED; PG8_LDA(At, 0, 0); PG8_STAGE(PG8_SA(1, 1), a1 + h1A, cA1);
            PG8_WAIT_V(8); PG8_WAIT_L(0); PG8_BAR; PG8_MMA(0, 0, At, B0); PG8_MMA(0, 1, At, B1); PG8_BAR; PG8_SCHED;
            PG8_LDA(At, 0, 1); PG8_STAGE(PG8_SB(0, 0), b2, voffB); PG8_STAGE(PG8_SB(0, 1), b2 + hstepB, voffB); PG8_STAGE(PG8_SA(0, 0), a2, x0);
            PG8_WAIT_V(8); PG8_WAIT_L(0); PG8_BAR; PG8_MMA(1, 0, At, B0); PG8_MMA(1, 1, At, B1); PG8_BAR; PG8_SCHED;
            PG8_LDB(B0, 1, 0); PG8_LDB(B1, 1, 1); PG8_SCHED; PG8_LDA(At, 1, 0); PG8_STAGE(PG8_SA(0, 1), a2 + h1A, x1);
            PG8_WAIT_V(8); PG8_WAIT_L(0); PG8_BAR; PG8_MMA(0, 0, At, B0); PG8_MMA(0, 1, At, B1); PG8_BAR; PG8_SCHED;
            PG8_LDA(At, 1, 1); PG8_STAGE(PG8_SB(1, 0), b3, voffB); PG8_STAGE(PG8_SB(1, 1), b3 + hstepB, voffB); PG8_STAGE(PG8_SA(1, 0), a3, x0);
            PG8_WAIT_V(8); PG8_WAIT_L(0); PG8_BAR; PG8_MMA(1, 0, At, B0); PG8_MMA(1, 1, At, B1); PG8_BAR; PG8_SCHED;
        }
        if constexpr (Epi::MIDK) { if (kh == 0) E.mid(acc, cur, wr, wc, fr, fq); }
        }
        if constexpr (ALIGN_EPI) { if (wr == 0) PG8_BAR; }
        E(acc, cur, wr, wc, fr, fq); S.done(cur);
        if (!has_next) break;
#pragma unroll
        for (int a = 0; a < 2; ++a)
#pragma unroll
            for (int b = 0; b < 2; ++b)
#pragma unroll
                for (int m = 0; m < 4; ++m)
#pragma unroll
                    for (int n = 0; n < 2; ++n) acc[a][b][m][n] = (f32x4){0.f, 0.f, 0.f, 0.f};
        cur = nxt; cA = nA; cB = nB; ++ui;
        if constexpr (GATHER) {
#pragma unroll
            for (int i = 0; i < 2; ++i) { cA0[i] = nA0[i]; cA1[i] = nA1[i]; }
        }
        if constexpr (ALIGN_EPI) { if (wr == 1) PG8_BAR; }
    }
    PG8_WAIT_V(0);
    if constexpr (!ALIGN_EPI) { if (wr == 0) PG8_BAR; }
    PG8_BAR;
#undef PG8_SA
#undef PG8_SB
#undef PG8_STAGE
#undef PG8_LDA
#undef PG8_LDB
#undef PG8_MMA
#undef PG8_WAIT_V
#undef PG8_WAIT_L
#undef PG8_BAR
#undef PG8_SCHED
}
}

typedef f32x4 AccT[2][2][4][2];
struct EpiStoreBf16 {
    static constexpr bool PERM = true, MIDK = false;
    GAS bf16_t* O; int ldc;
    __device__ __forceinline__ void operator()(const AccT& acc, const pg8::Unit& u, int wr, int wc, int fr, int fq) const {
        const int row0 = u.pm * 256 + wr * 64 + fr, col0 = u.pn * 256 + wc * 32 + 8 * fq;
#pragma unroll
        for (int ai = 0; ai < 2; ++ai)
#pragma unroll
            for (int m = 0; m < 4; ++m) { GAS bf16_t* rowp = O + (size_t)(row0 + ai * 128 + m * 16) * ldc + col0;
#pragma unroll
                for (int bj = 0; bj < 2; ++bj) { const f32x4 v0 = acc[ai][bj][m][0], v1 = acc[ai][bj][m][1];
                    u32x4 w; w.x = cvt_pk_bf16(v0[0], v0[1]); w.y = cvt_pk_bf16(v0[2], v0[3]); w.z = cvt_pk_bf16(v1[0], v1[1]); w.w = cvt_pk_bf16(v1[2], v1[3]);
                    *(GAS u32x4*)(rowp + bj * 128) = w; } }
    }
};
__device__ __forceinline__ float merge_ratio(float ga, float gb) { return (1.f + __expf(-fmaxf(gb, -80.f))) * __builtin_amdgcn_rcpf(1.f + __expf(-ga)); }
__device__ __forceinline__ float merge_final(float gb) { return __builtin_amdgcn_rcpf(1.f + __expf(-fmaxf(gb, -80.f))); }
struct EpiMergeK {
    static constexpr bool PERM = true, MIDK = true;
    const GAS bf16_t* P; GAS bf16_t* O;
    __device__ __forceinline__ void mid(AccT& acc, const pg8::Unit& u, int wr, int wc, int fr, int fq) const {
        asm volatile("" : "+v"(fr), "+v"(fq));
        const int row0 = u.pm * 256 + wr * 64 + fr, col0 = u.pn * 256 + wc * 32 + 8 * fq;
#pragma unroll
        for (int ai = 0; ai < 2; ++ai)
#pragma unroll
            for (int m = 0; m < 4; ++m) { const int r = row0 + ai * 128 + m * 16;
#pragma unroll
                for (int bj = 0; bj < 2; ++bj) { const int c = col0 + bj * 128;
                    const u32x4 a = *(const GAS u32x4*)(P + (size_t)r * PW + PGA + c), b = *(const GAS u32x4*)(P + (size_t)r * PW + PGB + c);
                    acc[ai][bj][m][0][0] *= merge_ratio(bflo(a.x), bflo(b.x)); acc[ai][bj][m][0][1] *= merge_ratio(bfhi(a.x), bfhi(b.x));
                    acc[ai][bj][m][0][2] *= merge_ratio(bflo(a.y), bflo(b.y)); acc[ai][bj][m][0][3] *= merge_ratio(bfhi(a.y), bfhi(b.y));
                    acc[ai][bj][m][1][0] *= merge_ratio(bflo(a.z), bflo(b.z)); acc[ai][bj][m][1][1] *= merge_ratio(bfhi(a.z), bfhi(b.z));
                    acc[ai][bj][m][1][2] *= merge_ratio(bflo(a.w), bflo(b.w)); acc[ai][bj][m][1][3] *= merge_ratio(bfhi(a.w), bfhi(b.w)); } }
    }
    __device__ __forceinline__ void operator()(const AccT& acc, const pg8::Unit& u, int wr, int wc, int fr, int fq) const {
        asm volatile("" : "+v"(fr), "+v"(fq));
        const int row0 = u.pm * 256 + wr * 64 + fr, col0 = u.pn * 256 + wc * 32 + 8 * fq;
#pragma unroll
        for (int ai = 0; ai < 2; ++ai)
#pragma unroll
            for (int m = 0; m < 4; ++m) { const int r = row0 + ai * 128 + m * 16;
#pragma unroll
                for (int bj = 0; bj < 2; ++bj) { const int c = col0 + bj * 128;
                    const u32x4 b = *(const GAS u32x4*)(P + (size_t)r * PW + PGB + c);
                    const f32x4 v0 = acc[ai][bj][m][0], v1 = acc[ai][bj][m][1];
                    u32x4 w; w.x = cvt_pk_bf16(v0[0] * merge_final(bflo(b.x)), v0[1] * merge_final(bfhi(b.x))); w.y = cvt_pk_bf16(v0[2] * merge_final(bflo(b.y)), v0[3] * merge_final(bfhi(b.y)));
                    w.z = cvt_pk_bf16(v1[0] * merge_final(bflo(b.z)), v1[1] * merge_final(bfhi(b.z))); w.w = cvt_pk_bf16(v1[2] * merge_final(bflo(b.w)), v1[3] * merge_final(bfhi(b.w)));
                    *(GAS u32x4*)(O + (size_t)r * D + c) = w; } }
    }
};
struct EpiResid {
    static constexpr bool PERM = false, MIDK = false;
    GAS float* x; const GAS float* gate;
    __device__ __forceinline__ void operator()(const AccT& acc, const pg8::Unit& u, int wr, int wc, int fr, int fq) const {
        const int row0 = u.pm * 256 + wr * 64 + fr, col0 = u.pn * 256 + wc * 32 + 4 * fq;
        const int b = (u.pm < 64) ? (u.pm >> 4) : 4;
        const GAS float* gp = gate + (size_t)b * 6144 + col0;
        f32x4 gv[2][2];
#pragma unroll
        for (int bj = 0; bj < 2; ++bj)
#pragma unroll
            for (int n = 0; n < 2; ++n) gv[bj][n] = *(const GAS f32x4*)(gp + bj * 128 + n * 16);
#pragma unroll
        for (int ai = 0; ai < 2; ++ai)
#pragma unroll
            for (int m = 0; m < 4; ++m) { const int r = row0 + ai * 128 + m * 16; GAS float* rowp = x + (size_t)r * D + col0;
#pragma unroll
                for (int bj = 0; bj < 2; ++bj)
#pragma unroll
                    for (int n = 0; n < 2; ++n) { GAS float* p = rowp + bj * 128 + n * 16; *(GAS f32x4*)p = *(const GAS f32x4*)p + gv[bj][n] * acc[ai][bj][m][n]; } }
    }
};
struct EpiSwiglu {
    static constexpr bool PERM = true, MIDK = false;
    GAS bf16_t* O;
    __device__ __forceinline__ void operator()(const AccT& acc, const pg8::Unit& u, int wr, int wc, int fr, int fq) const {
        const int row0 = u.pm * 256 + wr * 64 + fr, col0 = u.pn * 128 + wc * 32 + 8 * fq;
#pragma unroll
        for (int ai = 0; ai < 2; ++ai)
#pragma unroll
            for (int m = 0; m < 4; ++m) { const int r = row0 + ai * 128 + m * 16;
                float o[8];
#pragma unroll
                for (int n = 0; n < 2; ++n)
#pragma unroll
                    for (int j = 0; j < 4; ++j) { const float a = acc[ai][0][m][n][j], g = acc[ai][1][m][n][j]; o[n * 4 + j] = a * sigmoidf_(a) * g; }
                u32x4 w; w.x = cvt_pk_bf16(o[0], o[1]); w.y = cvt_pk_bf16(o[2], o[3]); w.z = cvt_pk_bf16(o[4], o[5]); w.w = cvt_pk_bf16(o[6], o[7]);
                *(GAS u32x4*)(O + (size_t)r * FF + col0) = w; }
    }
};

struct CEpiMergeK { const GAS bf16_t* P; GAS bf16_t* O; static constexpr bool MIDK = true;
    __device__ __forceinline__ void mid(f32x4& acc, int r, int c) const { const u32x2 a = *(const GAS u32x2*)(P + (size_t)r * PW + PGA + c), b = *(const GAS u32x2*)(P + (size_t)r * PW + PGB + c);
        acc[0] *= merge_ratio(bflo(a.x), bflo(b.x)); acc[1] *= merge_ratio(bfhi(a.x), bfhi(b.x)); acc[2] *= merge_ratio(bflo(a.y), bflo(b.y)); acc[3] *= merge_ratio(bfhi(a.y), bfhi(b.y)); }
    __device__ __forceinline__ void operator()(const f32x4& acc, int r, int c) const { const u32x2 b = *(const GAS u32x2*)(P + (size_t)r * PW + PGB + c);
        u32x2 w; w.x = cvt_pk_bf16(acc[0] * merge_final(bflo(b.x)), acc[1] * merge_final(bfhi(b.x))); w.y = cvt_pk_bf16(acc[2] * merge_final(bflo(b.y)), acc[3] * merge_final(bfhi(b.y)));
        *(GAS u32x2*)(O + (size_t)r * D + c) = w; } };
struct CEpiResid { GAS float* x; const GAS float* gate; static constexpr bool MIDK = false;
    __device__ __forceinline__ void mid(f32x4&, int, int) const {}
    __device__ __forceinline__ void operator()(const f32x4& acc, int r, int c) const { GAS float* p = x + (size_t)r * D + c; *(GAS f32x4*)p = *(const GAS f32x4*)p + *(const GAS f32x4*)(gate + c) * acc; } };
template <class Epi>
__device__ __forceinline__ void ctx_gemm(LAS unsigned char* lds, const GAS bf16_t* X, int ldx, const GAS bf16_t* Wt, int ldw, int K, const Epi& E) {
    int tid = threadIdx.x; asm volatile("" : "+v"(tid));
    const int wave = tid >> 6, lane = tid & 63, li = lane & 15, kg = lane >> 4, kp = wave >> 1, ch = wave & 1;
    LAS float* part = (LAS float*)lds;
    for (int tile = blockIdx.x; tile < 256; tile += gridDim.x) {
        const int row0 = TL + (tile >> 2) * 16, colb = (tile & 3) * 256, col0 = colb + ch * 128;
        const int kq = K >> 2, kbeg = kp * kq;
        const GAS bf16_t* xp = X + (size_t)(row0 + li) * ldx + 8 * kg + kbeg;
        const GAS bf16_t* wp = Wt + (size_t)(col0 + li) * ldw + 8 * kg + kbeg;
        f32x4 acc[8];
#pragma unroll
        for (int cb = 0; cb < 8; ++cb) acc[cb] = (f32x4){0.f, 0.f, 0.f, 0.f};
#pragma unroll 2
        for (int k0 = 0; k0 < kq; k0 += 32) {
            const bf16x8 xf = *(const GAS bf16x8*)(xp + k0);
#pragma unroll
            for (int cb = 0; cb < 8; ++cb) { const bf16x8 wf = *(const GAS bf16x8*)(wp + (size_t)(16 * cb) * ldw + k0); acc[cb] = __builtin_amdgcn_mfma_f32_16x16x32_bf16(wf, xf, acc[cb], 0, 0, 0); }
        }
        if constexpr (Epi::MIDK) { if (kp < 2) {
#pragma unroll
            for (int cb = 0; cb < 8; ++cb) E.mid(acc[cb], row0 + li, col0 + 16 * cb + 4 * kg); } }
#pragma unroll
        for (int cb = 0; cb < 8; ++cb) *(LAS f32x4*)(part + (kp * 16 + li) * 260 + ch * 128 + 16 * cb + 4 * kg) = acc[cb];
        __syncthreads();
        { const int r = tid >> 5, cc = (tid & 31) * 8;
          f32x4 o0 = (f32x4){0.f, 0.f, 0.f, 0.f}, o1 = o0;
#pragma unroll
          for (int q = 0; q < 4; ++q) { o0 += *(const LAS f32x4*)(part + (q * 16 + r) * 260 + cc); o1 += *(const LAS f32x4*)(part + (q * 16 + r) * 260 + cc + 4); }
          E(o0, row0 + r, colb + cc); E(o1, row0 + r, colb + cc + 4); }
        __syncthreads();
    }
}

struct Args { const float* in[30]; float* out; unsigned char* ws; int l, e, ph, pad; };
enum { I_X = 0, I_C, I_CTX, I_CCTX, I_WMOD, I_BMOD, I_N1G, I_N2G, I_WIN, I_RPB, I_HCW, I_HCB, I_HW1, I_HB1, I_HW2, I_HB2, I_HW3, I_HFREQ, I_HBIAS,
       I_WPA, I_WPB, I_WO, I_FW1, I_FW3, I_FW2, I_ROUTER, I_MW1, I_MW3, I_MW2, I_FINALG };

constexpr int MISC_OFF = 131072 + 320;
constexpr int PTR_OFF = MISC_OFF + 128;
struct Ctx {
    LAS unsigned char* lds; int tid, lane, wave, G, bid; GAS unsigned char* ws;
};
__device__ __forceinline__ Ctx mk_ctx(LAS unsigned char* lds, GAS unsigned char* ws) {
    Ctx c; int t = threadIdx.x; asm volatile("" : "+v"(t)); asm volatile("" : "+s"(ws)); c.lds = lds; c.tid = t; c.lane = t & 63; c.wave = __builtin_amdgcn_readfirstlane(t >> 6); c.G = gridDim.x; c.bid = blockIdx.x; c.ws = ws; return c;
}
__device__ __forceinline__ const GAS float* inp(const Ctx& c, int i) {
    unsigned ao = (unsigned)(PTR_OFF + 8 * i); asm volatile("" : "+v"(ao));
    const volatile LAS unsigned* p = (const volatile LAS unsigned*)(c.lds + ao);
    const unsigned lo = __builtin_amdgcn_readfirstlane(p[0]), hi = __builtin_amdgcn_readfirstlane(p[1]);
    return (const GAS float*)(((unsigned long long)hi << 32) | (unsigned long long)lo);
}

__device__ __forceinline__ void transpose_item(const GAS float* W, int N, GAS bf16_t* WT, int ldk, int k0, int n0, int drow0, LAS float* scr, int lane) {
    float wv[32];
    const GAS float* wp = W + (size_t)(k0 + (lane >> 5)) * N + n0 + (lane & 31);
#pragma unroll
    for (int i = 0; i < 32; ++i) wv[i] = wp[(size_t)(2 * i) * N];
#pragma unroll
    for (int i = 0; i < 32; ++i) scr[(2 * i + (lane >> 5)) * 33 + (lane & 31)] = wv[i];
    LDS_WAIT(); asm volatile("" ::: "memory");
    const int c = lane & 7;
#pragma unroll
    for (int j = 0; j < 4; ++j) { const int n = (lane >> 3) + 8 * j; const LAS float* s = scr + (8 * c) * 33 + n;
        u32x4 o; o.x = cvt_pk_bf16(s[0 * 33], s[1 * 33]); o.y = cvt_pk_bf16(s[2 * 33], s[3 * 33]); o.z = cvt_pk_bf16(s[4 * 33], s[5 * 33]); o.w = cvt_pk_bf16(s[6 * 33], s[7 * 33]);
        *(GAS u32x4*)(WT + (size_t)(drow0 + n) * ldk + k0 + 8 * c) = o; }
    LDS_WAIT(); asm volatile("" ::: "memory");
}
__device__ __forceinline__ void conv_mat(const GAS float* W, int K, int N, GAS bf16_t* WT, int mode, int& base, int gw, int NGW, LAS float* scr, int lane, int ldk = 0) {
    if (ldk == 0) ldk = K;
    const int nblk = N / 32, nitems = (K / 64) * nblk;
    const int start = (gw - (base % NGW) + NGW) % NGW;
    for (int it = start; it < nitems; it += NGW) {
        const int kb = it / nblk, nb = it % nblk, n0 = nb * 32;
        const int drow0 = mode == 0 ? n0 : ((n0 >> 7) * 256 + (n0 & 127) + (mode == 2 ? 128 : 0));
        transpose_item(W, N, WT, ldk, kb * 64, n0, drow0, scr, lane);
    }
    base += nitems;
}
__device__ __forceinline__ void ph_convert(const Ctx& c0) {
    const Ctx c = mk_ctx(c0.lds, c0.ws);
    GAS unsigned char* ws = c.ws;
    LAS float* scr = (LAS float*)(c.lds + c.wave * 16384);
    const int gw = c.bid * NWAVES + c.wave, NGW = c.G * NWAVES; int base = 0;
    for (int l = 0; l < DEPTH; ++l) {
        conv_mat(inp(c, I_WIN) + (size_t)l * D * PW, D, PW, (GAS bf16_t*)(ws + WS_WIN) + (size_t)l * PW * D, 0, base, gw, NGW, scr, c.lane);
        conv_mat(inp(c, I_WPA) + (size_t)l * 512 * D, 512, D, (GAS bf16_t*)(ws + WS_WPAB) + (size_t)l * D * D, 0, base, gw, NGW, scr, c.lane, D);
        conv_mat(inp(c, I_WPB) + (size_t)l * 512 * D, 512, D, (GAS bf16_t*)(ws + WS_WPAB) + (size_t)l * D * D + 512, 0, base, gw, NGW, scr, c.lane, D);
        conv_mat(inp(c, I_WO) + (size_t)l * D * D, D, D, (GAS bf16_t*)(ws + WS_WO) + (size_t)l * D * D, 0, base, gw, NGW, scr, c.lane);
    }
    for (int i = 0; i < 2; ++i) {
        conv_mat(inp(c, I_FW1) + (size_t)i * D * FF, D, FF, (GAS bf16_t*)(ws + WS_W13D) + (size_t)i * 2 * FF * D, 1, base, gw, NGW, scr, c.lane);
        conv_mat(inp(c, I_FW3) + (size_t)i * D * FF, D, FF, (GAS bf16_t*)(ws + WS_W13D) + (size_t)i * 2 * FF * D, 2, base, gw, NGW, scr, c.lane);
        conv_mat(inp(c, I_FW2) + (size_t)i * FF * D, FF, D, (GAS bf16_t*)(ws + WS_W2D) + (size_t)i * D * FF, 0, base, gw, NGW, scr, c.lane);
    }
    for (int ie = 0; ie < 2 * NE; ++ie) {
        conv_mat(inp(c, I_MW1) + (size_t)ie * D * FF, D, FF, (GAS bf16_t*)(ws + WS_W13M) + (size_t)ie * 2 * FF * D, 1, base, gw, NGW, scr, c.lane);
        conv_mat(inp(c, I_MW3) + (size_t)ie * D * FF, D, FF, (GAS bf16_t*)(ws + WS_W13M) + (size_t)ie * 2 * FF * D, 2, base, gw, NGW, scr, c.lane);
        conv_mat(inp(c, I_MW2) + (size_t)ie * FF * D, FF, D, (GAS bf16_t*)(ws + WS_W2M) + (size_t)ie * D * FF, 0, base, gw, NGW, scr, c.lane);
    }
}

__device__ __forceinline__ void ph_mod(const Ctx& c0) {
    const Ctx c = mk_ctx(c0.lds, c0.ws);
    GAS float* mod = (GAS float*)(c.ws + WS_MOD);
    LAS float* s = (LAS float*)c.lds; LAS float* part = s + 5 * 1024;
    const GAS float* cin = inp(c, I_C); const GAS float* cctx = inp(c, I_CCTX); const GAS float* wmod = inp(c, I_WMOD); const GAS float* bmod = inp(c, I_BMOD);
    for (int i = c.tid; i < 5 * 1024; i += NTHR) { const int r = i >> 10, k = i & 1023; const float v = r < 4 ? cin[r * 1024 + k] : cctx[k]; s[i] = v * sigmoidf_(v); }
    __syncthreads();
    for (int unit = c.bid; unit < DEPTH * 96; unit += c.G) {
        const int l = unit / 96, j0 = (unit % 96) * 64;
        const GAS float* w = wmod + (size_t)l * D * 6144 + j0 + c.lane;
        float acc[5] = {0.f, 0.f, 0.f, 0.f, 0.f};
        const int kb = c.wave * 128;
#pragma unroll 32
        for (int k = 0; k < 128; ++k) { const float wv = w[(size_t)(kb + k) * 6144];
#pragma unroll
            for (int r = 0; r < 5; ++r) acc[r] += s[r * 1024 + kb + k] * wv; }
#pragma unroll
        for (int r = 0; r < 5; ++r) part[(c.wave * 5 + r) * 64 + c.lane] = acc[r];
        __syncthreads();
        if (c.tid < 320) { const int r = c.tid >> 6, ln = c.tid & 63; float sum = 0.f;
#pragma unroll
            for (int w8 = 0; w8 < 8; ++w8) sum += part[(w8 * 5 + r) * 64 + ln];
            mod[(size_t)(l * 5 + r) * 6144 + j0 + ln] = sum + bmod[l * 6144 + j0 + ln]; }
        __syncthreads();
    }
}

__device__ __forceinline__ void ph_filt(const Ctx& c0) {
    const Ctx c = mk_ctx(c0.lds, c0.ws);
    const GAS float* hb1 = inp(c, I_HB1); const GAS float* hw1 = inp(c, I_HW1); const GAS float* hb2 = inp(c, I_HB2); const GAS float* hw2 = inp(c, I_HW2); const GAS float* hfreq = inp(c, I_HFREQ); const GAS float* hw3 = inp(c, I_HW3);
    LAS float* zb = (LAS float*)c.lds;
    LAS float* a1 = zb + 16 * 36;
    LAS float* a2 = a1 + 16 * 64;
    const float MINDEC = -3.0701134573253945f, MAXDEC = -15.350567286626973f;
    for (int unit = c.bid; unit < DEPTH * 272; unit += c.G) {
        const int l = unit / 272, uu = unit % 272;
        const int L = uu < 256 ? 4096 : 256, p0 = uu < 256 ? uu * 16 : (uu - 256) * 16;
        for (int i = c.tid; i < 16 * 33; i += NTHR) { const int p = i / 33, q = i % 33; const int pos = p0 + p; float v;
            if (q == 0) v = (float)pos / (float)(L - 1);
            else { const int j = (q - 1) & 15; const double band = 1e-4 + (double)j * ((15.0 - 1e-4) / 15.0); double rev = (double)pos * band / (double)L; rev -= floor(rev);
                v = q <= 16 ? __builtin_amdgcn_cosf((float)rev) : -__builtin_amdgcn_sinf((float)rev); }
            zb[p * 36 + q] = v; }
        __syncthreads();
        for (int i = c.tid; i < 16 * 64; i += NTHR) { const int p = i >> 6, j = i & 63; float s = hb1[l * 64 + j];
            const GAS float* w = hw1 + (size_t)l * 33 * 64 + j;
            for (int q = 0; q < 33; ++q) s += zb[p * 36 + q] * w[q * 64];
            a1[p * 64 + j] = sin_rad(hfreq[l * 128 + j] * s); }
        __syncthreads();
        for (int i = c.tid; i < 16 * 64; i += NTHR) { const int p = i >> 6, j = i & 63; float s = hb2[l * 64 + j];
            const GAS float* w = hw2 + (size_t)l * 64 * 64 + j;
            for (int q = 0; q < 64; ++q) s += a1[p * 64 + q] * w[q * 64];
            a2[p * 64 + j] = sin_rad(hfreq[l * 128 + 64 + j] * s); }
        __syncthreads();
        {
            float acc0[16], acc1[16];
#pragma unroll
            for (int p = 0; p < 16; ++p) { acc0[p] = 0.f; acc1[p] = 0.f; }
            const GAS float* w3 = hw3 + (size_t)l * 64 * 1024 + c.tid;
            for (int k = 0; k < 64; k += 4) { float wa[4], wb[4];
#pragma unroll
                for (int q = 0; q < 4; ++q) { wa[q] = w3[(k + q) * 1024]; wb[q] = w3[(k + q) * 1024 + 512]; }
#pragma unroll
                for (int p = 0; p < 16; ++p) { const f32x4 av = *(const LAS f32x4*)(a2 + p * 64 + k);
#pragma unroll
                    for (int q = 0; q < 4; ++q) { acc0[p] += av[q] * wa[q]; acc1[p] += av[q] * wb[q]; } } }
            GAS bf16_t* hro = uu < 256 ? (GAS bf16_t*)(c.ws + WS_HRL) + ((size_t)(l * 2) * 512 + c.tid) * (4096 + 64) : (GAS bf16_t*)(c.ws + WS_HRC) + ((size_t)(l * 2) * 512 + c.tid) * (256 + 64);
            const size_t ostride = (size_t)512 * (L + 64);
            float f0[16], f1[16];
            const float r0 = fabsf(MINDEC + (float)c.tid * ((MAXDEC - MINDEC) / 1023.f)), r1 = fabsf(MINDEC + (float)(c.tid + 512) * ((MAXDEC - MINDEC) / 1023.f));
#pragma unroll
            for (int p = 0; p < 16; ++p) { const int pos = p0 + p; const float dist = fabsf((float)(pos - L / 2)) * (2.f / (float)L);
                f0[p] = acc0[p] * (__expf(-dist * r0) + 0.05f); f1[p] = acc1[p] * (__expf(-dist * r1) + 0.05f); }
            {   u32x4 w0, w1, v0, v1;
                w0.x = cvt_pk_bf16(f0[15], f0[14]); w0.y = cvt_pk_bf16(f0[13], f0[12]); w0.z = cvt_pk_bf16(f0[11], f0[10]); w0.w = cvt_pk_bf16(f0[9], f0[8]);
                w1.x = cvt_pk_bf16(f0[7], f0[6]); w1.y = cvt_pk_bf16(f0[5], f0[4]); w1.z = cvt_pk_bf16(f0[3], f0[2]); w1.w = cvt_pk_bf16(f0[1], f0[0]);
                v0.x = cvt_pk_bf16(f1[15], f1[14]); v0.y = cvt_pk_bf16(f1[13], f1[12]); v0.z = cvt_pk_bf16(f1[11], f1[10]); v0.w = cvt_pk_bf16(f1[9], f1[8]);
                v1.x = cvt_pk_bf16(f1[7], f1[6]); v1.y = cvt_pk_bf16(f1[5], f1[4]); v1.z = cvt_pk_bf16(f1[3], f1[2]); v1.w = cvt_pk_bf16(f1[1], f1[0]);
                GAS bf16_t* d0 = hro + (L + 16 - p0); GAS bf16_t* d1 = d0 + ostride;
                *(GAS u32x4*)d0 = w0; *(GAS u32x4*)(d0 + 8) = w1; *(GAS u32x4*)d1 = v0; *(GAS u32x4*)(d1 + 8) = v1;
                const u32x4 z4 = (u32x4){0u, 0u, 0u, 0u};
                if (p0 == 0) { for (int k = 0; k < 4; ++k) { *(GAS u32x4*)(hro + L + 32 + 8 * k) = z4; *(GAS u32x4*)(hro + ostride + L + 32 + 8 * k) = z4; } }
                if (p0 == L - 16) { for (int k = 0; k < 4; ++k) { *(GAS u32x4*)(hro + 8 * k) = z4; *(GAS u32x4*)(hro + ostride + 8 * k) = z4; } } }
        }
        __syncthreads();
    }
}

struct MoeComb { const GAS int* route; const GAS float* rwt; const GAS bf16_t* y; const GAS float* gate; };
__device__ __forceinline__ void moe_combine_row(const MoeComb& mc, const LAS unsigned* offs, int row, int b, int lane, f32x4 (&v)[4]) {
    const int e1 = mc.route[(size_t)row * 4 + 0], p1 = mc.route[(size_t)row * 4 + 1], e2 = mc.route[(size_t)row * 4 + 2], p2 = mc.route[(size_t)row * 4 + 3];
    const float w1 = mc.rwt[(size_t)row * 2], w2 = mc.rwt[(size_t)row * 2 + 1];
    const size_t s1 = (size_t)offs[e1] + p1, s2 = (size_t)offs[e2] + p2;
    const GAS float* gt = mc.gate + (size_t)b * 6144;
#pragma unroll
    for (int j = 0; j < 4; ++j) { const int k0 = 4 * (lane + 64 * j);
        const u32x2 a = *(const GAS u32x2*)(mc.y + s1 * D + k0), bq = *(const GAS u32x2*)(mc.y + s2 * D + k0); const f32x4 g4 = *(const GAS f32x4*)(gt + k0);
        v[j][0] += g4[0] * (w1 * bflo(a.x) + w2 * bflo(bq.x)); v[j][1] += g4[1] * (w1 * bfhi(a.x) + w2 * bfhi(bq.x));
        v[j][2] += g4[2] * (w1 * bflo(a.y) + w2 * bflo(bq.y)); v[j][3] += g4[3] * (w1 * bfhi(a.y) + w2 * bfhi(bq.y)); }
}
__device__ __forceinline__ void moe_offsets(const Ctx& c, int i, LAS unsigned* offs) {
    if (c.tid == 0) { const GAS unsigned* cnt = (const GAS unsigned*)(c.ws + WS_CTL) + CW_CNT + 64 * i; unsigned o = 0;
        for (int e = 0; e < 8; ++e) { offs[e] = o; o += (cnt[e] + 255u) & ~255u; } offs[8] = o; }
}
__device__ __forceinline__ void ph_norm(const Ctx& c0, int l, int which) {
    const Ctx c = mk_ctx(c0.lds, c0.ws);
    GAS float* xres = (GAS float*)(c.ws + WS_X); GAS bf16_t* h = (GAS bf16_t*)(c.ws + WS_H);
    const GAS float* mod = (const GAS float*)(c.ws + WS_MOD) + (size_t)l * 5 * 6144;
    const GAS float* gp = (which == 0 ? inp(c, I_N1G) : inp(c, I_N2G)) + l * D;
    const bool first = (l == 0 && which == 0), route = (which == 1 && (l & 1));
    const int comb = (which == 0 && l >= 1 && ((l - 1) & 1)) ? ((l - 1) >> 1) : -1;
    const GAS float* router = inp(c, I_ROUTER) + (size_t)(l >> 1) * D * NE;
    GAS int* routeb = (GAS int*)(c.ws + WS_ROUTE); GAS float* rwt = (GAS float*)(c.ws + WS_RWT); GAS int* tokenof = (GAS int*)(c.ws + WS_TOK);
    const MoeComb mc{routeb, rwt, (const GAS bf16_t*)(c.ws + WS_Y), (const GAS float*)(c.ws + WS_MOD) + (size_t)(l > 0 ? l - 1 : 0) * 5 * 6144 + 5 * 1024};
    LAS unsigned* lcnt = (LAS unsigned*)c.lds; LAS unsigned* gbase = lcnt + 16; LAS unsigned* offs = lcnt + 32; LAS int* pend = (LAS int*)(c.lds + 256);
    if (c.tid < 8) lcnt[c.tid] = 0u;
    if (comb >= 0) moe_offsets(c, comb, offs);
    LAS float* rlds = (LAS float*)(c.lds + 4096);
    if (route) { for (int i = c.tid; i < D * NE / 4; i += NTHR) *(LAS f32x4*)(rlds + 4 * i) = *(const GAS f32x4*)(router + 4 * i); }
    __syncthreads();
    const GAS float* xin = inp(c, I_X); const GAS float* ctxin = inp(c, I_CTX);
    int nrows = 0;
    const int nrow_all = (which == 1 && l == DEPTH - 1) ? TL : T;
#define NORM_SRC(rw) (first ? ((rw) < TL ? xin + (size_t)(rw) * D : ctxin + (size_t)((rw) - TL) * D) : xres + (size_t)(rw) * D)
    const int rstride = c.G * NWAVES;
    f32x4 vnx[4];
    { const int row = c.bid * NWAVES + c.wave; if (row < nrow_all) { const GAS float* src = NORM_SRC(row);
#pragma unroll
        for (int j = 0; j < 4; ++j) vnx[j] = *(const GAS f32x4*)(src + 4 * (c.lane + 64 * j)); } }
    for (int row = c.bid * NWAVES + c.wave; row < nrow_all; row += rstride, ++nrows) {
        const int b = row < TL ? (row >> 12) : 4;
        const GAS float* sh = mod + (size_t)b * 6144 + (which == 0 ? 0 : 3) * 1024; const GAS float* sc = sh + 1024;
        f32x4 v[4]; float ss = 0.f;
#pragma unroll
        for (int j = 0; j < 4; ++j) v[j] = vnx[j];
        if (row + rstride < nrow_all) { const GAS float* srcn = NORM_SRC(row + rstride);
#pragma unroll
            for (int j = 0; j < 4; ++j) vnx[j] = *(const GAS f32x4*)(srcn + 4 * (c.lane + 64 * j)); }
        if (comb >= 0) moe_combine_row(mc, offs, row, b, c.lane, v);
#pragma unroll
        for (int j = 0; j < 4; ++j) ss += (v[j][0] * v[j][0] + v[j][1] * v[j][1]) + (v[j][2] * v[j][2] + v[j][3] * v[j][3]);
        ss = wave_sum(ss, c.lane);
        const float rstd = 1.f / sqrtf(ss * (1.f / D) + EPS);
        if (first || comb >= 0) {
#pragma unroll
            for (int j = 0; j < 4; ++j) *(GAS f32x4*)(xres + (size_t)row * D + 4 * (c.lane + 64 * j)) = v[j];
        }
        float lg[8] = {0.f, 0.f, 0.f, 0.f, 0.f, 0.f, 0.f, 0.f};
#pragma unroll
        for (int j = 0; j < 4; ++j) { const int k0 = 4 * (c.lane + 64 * j);
            const f32x4 g4 = *(const GAS f32x4*)(gp + k0), s4 = *(const GAS f32x4*)(sc + k0), h4 = *(const GAS f32x4*)(sh + k0);
            f32x4 o;
#pragma unroll
            for (int q = 0; q < 4; ++q) o[q] = v[j][q] * rstd * g4[q] * (1.f + s4[q]) + h4[q];
            u32x2 w; w.x = cvt_pk_bf16(o[0], o[1]); w.y = cvt_pk_bf16(o[2], o[3]);
            *(GAS u32x2*)(h + (size_t)row * D + k0) = w;
            if (route) {
#pragma unroll
                for (int q = 0; q < 4; ++q) { const f32x4 ra = *(const LAS f32x4*)(rlds + (k0 + q) * 8), rb = *(const LAS f32x4*)(rlds + (k0 + q) * 8 + 4);
                    lg[0] += o[q] * ra[0]; lg[1] += o[q] * ra[1]; lg[2] += o[q] * ra[2]; lg[3] += o[q] * ra[3];
                    lg[4] += o[q] * rb[0]; lg[5] += o[q] * rb[1]; lg[6] += o[q] * rb[2]; lg[7] += o[q] * rb[3]; }
            }
        }
        if (route) {
#pragma unroll
            for (int e = 0; e < 8; ++e) lg[e] = wave_sum(lg[e], c.lane);
            int i1 = 0; float v1 = lg[0];
#pragma unroll
            for (int e = 1; e < 8; ++e) if (lg[e] > v1) { v1 = lg[e]; i1 = e; }
            int i2 = -1; float v2 = -3.0e38f;
#pragma unroll
            for (int e = 0; e < 8; ++e) if (e != i1 && lg[e] > v2) { v2 = lg[e]; i2 = e; }
            const float w1 = 1.f / (1.f + __expf(v2 - v1)), w2 = 1.f - w1;
            if (c.lane == 0) {
                const unsigned lp1 = __hip_atomic_fetch_add(lcnt + i1, 1u, __ATOMIC_RELAXED, __HIP_MEMORY_SCOPE_WORKGROUP), lp2 = __hip_atomic_fetch_add(lcnt + i2, 1u, __ATOMIC_RELAXED, __HIP_MEMORY_SCOPE_WORKGROUP);
                LAS int* pe = pend + (c.wave * 16 + nrows) * 4; pe[0] = row; pe[1] = i1 | (i2 << 8); pe[2] = (int)lp1; pe[3] = (int)lp2;
                rwt[(size_t)row * 2] = w1; rwt[(size_t)row * 2 + 1] = w2; }
        }
    }
    if (route) {
        __syncthreads();
        if (c.tid < 8) gbase[c.tid] = __hip_atomic_fetch_add((GAS unsigned*)(c.ws + WS_CTL) + CW_CNT + 64 * (l >> 1) + c.tid, lcnt[c.tid], __ATOMIC_RELAXED, __HIP_MEMORY_SCOPE_AGENT);
        __syncthreads();
        if (c.lane < nrows) { const LAS int* pe = pend + (c.wave * 16 + c.lane) * 4; const int row = pe[0], e1 = pe[1] & 255, e2 = pe[1] >> 8;
            const int p1 = (int)gbase[e1] + pe[2], p2 = (int)gbase[e2] + pe[3];
            tokenof[(size_t)e1 * T + p1] = row; tokenof[(size_t)e2 * T + p2] = row;
            routeb[(size_t)row * 4 + 0] = e1; routeb[(size_t)row * 4 + 1] = p1; routeb[(size_t)row * 4 + 2] = e2; routeb[(size_t)row * 4 + 3] = p2; }
    }
    __syncthreads();
}

__device__ __forceinline__ void ph_sc(const Ctx& c0, int l) {
    const Ctx c = mk_ctx(c0.lds, c0.ws);
    const GAS bf16_t* P = (const GAS bf16_t*)(c.ws + WS_P); GAS bf16_t* uT = (GAS bf16_t*)(c.ws + WS_B); GAS bf16_t* VT = (GAS bf16_t*)(c.ws + WS_VT);
    const GAS float* cw = inp(c, I_HCW) + (size_t)l * 3 * 1536; const GAS float* cb = inp(c, I_HCB) + (size_t)l * 1536;
    LAS unsigned char* scr = c.lds + c.wave * 16384;
    for (int tile = c.bid * NWAVES + c.wave; tile < (T / 64) * 32; tile += c.G * NWAVES) {
        const int rt = tile / 32, row0 = rt * 64, ct = tile % 32; const bool isv = ct >= 24;
        const int ch0 = isv ? (ct - 24) * 64 : ct * 64, scol = isv ? PV + ch0 : PHY + ch0; GAS bf16_t* dst = isv ? VT : uT;
        const int tpos = row0 < TL ? (row0 & 4095) : ((row0 - TL) & 255), Ls = row0 < TL ? 4096 : 256;
        for (int idx = c.lane; idx < 66 * 8; idx += 64) { const int rr = idx >> 3, ck = idx & 7; const int grow = row0 - 1 + rr;
            const bool ok = !((rr == 0 && tpos == 0) || (rr == 65 && tpos + 64 == Ls));
            u32x4 v = (u32x4){0u, 0u, 0u, 0u};
            if (ok) v = *(const GAS u32x4*)(P + (size_t)grow * PW + scol + ck * 8);
            LAS unsigned* d = (LAS unsigned*)(scr + rr * 132 + ck * 16); d[0] = v.x; d[1] = v.y; d[2] = v.z; d[3] = v.w; }
        LDS_WAIT(); asm volatile("" ::: "memory");
        const int ch = ch0 + c.lane; const float w0 = isv ? 0.f : cw[ch], w1 = isv ? 1.f : cw[1536 + ch], w2 = isv ? 0.f : cw[3072 + ch], bb = isv ? 0.f : cb[ch];
        unsigned ow[32];
        { float prev = bf2f(*(const LAS unsigned short*)(scr + 0 * 132 + c.lane * 2)), cur = bf2f(*(const LAS unsigned short*)(scr + 1 * 132 + c.lane * 2)); float o0 = 0.f;
#pragma unroll
          for (int r = 0; r < 64; ++r) { const float nxt = bf2f(*(const LAS unsigned short*)(scr + (r + 2) * 132 + c.lane * 2));
              const float o = w0 * prev + w1 * cur + w2 * nxt + bb; prev = cur; cur = nxt;
              if (r & 1) ow[r >> 1] = cvt_pk_bf16(o0, o); else o0 = o; } }
        LDS_WAIT(); asm volatile("" ::: "memory");
#pragma unroll
        for (int k = 0; k < 8; ++k) { u32x4 v; v.x = ow[4 * k]; v.y = ow[4 * k + 1]; v.z = ow[4 * k + 2]; v.w = ow[4 * k + 3]; *(LAS u32x4*)(scr + c.lane * 144 + k * 16) = v; }
        LDS_WAIT(); asm volatile("" ::: "memory");
#pragma unroll
        for (int k = 0; k < 8; ++k) { const int cc = (c.lane >> 3) + 8 * k, ck = c.lane & 7; const u32x4 v = *(const LAS u32x4*)(scr + cc * 144 + ck * 16);
            *(GAS u32x4*)(dst + (size_t)(ch0 + cc) * T + row0 + ck * 8) = v; }
        LDS_WAIT(); asm volatile("" ::: "memory");
    }
}

constexpr int HY_HR_OFF = 512, HY_U_OFF = HY_HR_OFF + 66560, HY_ZB_OFF = HY_U_OFF + 4 * 8208;
template <int L, bool DUAL>
__device__ __forceinline__ void hy_span(LAS unsigned char* lds, int nsteps, int aaddr, int ubase, int sX, int sY, f32x16& accX, f32x16& accY) {
#define HY_BADDR(sv) (((unsigned)(sv) <= (unsigned)(L - 16)) ? ubase + 2 * (sv) : HY_ZB_OFF)
    int k = 0;
    for (; k + 4 <= nsteps; k += 4) {
        const int pa = aaddr - 768;
        const int px0 = HY_BADDR(sX), px1 = HY_BADDR(sX - 16), px2 = HY_BADDR(sX - 32), px3 = HY_BADDR(sX - 48);
        bf16x8 a0, a1, a2, a3, x0, x1, x2, x3;
        if (DUAL) {
            const int py0 = HY_BADDR(sY), py1 = HY_BADDR(sY - 16), py2 = HY_BADDR(sY - 32), py3 = HY_BADDR(sY - 48);
            bf16x8 y0, y1, y2, y3;
            asm volatile(
                "ds_read_b128 %[a0], %[pa] offset:768\n\tds_read_b128 %[x0], %[px0]\n\tds_read_b128 %[y0], %[py0]\n\t"
                "ds_read_b128 %[a1], %[pa] offset:512\n\tds_read_b128 %[x1], %[px1]\n\tds_read_b128 %[y1], %[py1]\n\t"
                "ds_read_b128 %[a2], %[pa] offset:256\n\tds_read_b128 %[x2], %[px2]\n\tds_read_b128 %[y2], %[py2]\n\t"
                "ds_read_b128 %[a3], %[pa]\n\tds_read_b128 %[x3], %[px3]\n\tds_read_b128 %[y3], %[py3]\n\t"
                "s_waitcnt lgkmcnt(9)\n\tv_mfma_f32_32x32x16_bf16 %[cx], %[a0], %[x0], %[cx]\n\tv_mfma_f32_32x32x16_bf16 %[cy], %[a0], %[y0], %[cy]\n\t"
                "s_waitcnt lgkmcnt(6)\n\tv_mfma_f32_32x32x16_bf16 %[cx], %[a1], %[x1], %[cx]\n\tv_mfma_f32_32x32x16_bf16 %[cy], %[a1], %[y1], %[cy]\n\t"
                "s_waitcnt lgkmcnt(3)\n\tv_mfma_f32_32x32x16_bf16 %[cx], %[a2], %[x2], %[cx]\n\tv_mfma_f32_32x32x16_bf16 %[cy], %[a2], %[y2], %[cy]\n\t"
                "s_waitcnt lgkmcnt(0)\n\tv_mfma_f32_32x32x16_bf16 %[cx], %[a3], %[x3], %[cx]\n\tv_mfma_f32_32x32x16_bf16 %[cy], %[a3], %[y3], %[cy]\n\t"
                : [cx] "+v"(accX), [cy] "+v"(accY), [a0] "=&v"(a0), [a1] "=&v"(a1), [a2] "=&v"(a2), [a3] "=&v"(a3), [x0] "=&v"(x0), [x1] "=&v"(x1), [x2] "=&v"(x2), [x3] "=&v"(x3),
                  [y0] "=&v"(y0), [y1] "=&v"(y1), [y2] "=&v"(y2), [y3] "=&v"(y3)
                : [pa] "v"(pa), [px0] "v"(px0), [px1] "v"(px1), [px2] "v"(px2), [px3] "v"(px3), [py0] "v"(py0), [py1] "v"(py1), [py2] "v"(py2), [py3] "v"(py3));
        } else {
            asm volatile(
                "ds_read_b128 %[a0], %[pa] offset:768\n\tds_read_b128 %[x0], %[px0]\n\t"
                "ds_read_b128 %[a1], %[pa] offset:512\n\tds_read_b128 %[x1], %[px1]\n\t"
                "ds_read_b128 %[a2], %[pa] offset:256\n\tds_read_b128 %[x2], %[px2]\n\t"
                "ds_read_b128 %[a3], %[pa]\n\tds_read_b128 %[x3], %[px3]\n\t"
                "s_waitcnt lgkmcnt(6)\n\tv_mfma_f32_32x32x16_bf16 %[cx], %[a0], %[x0], %[cx]\n\t"
                "s_waitcnt lgkmcnt(4)\n\tv_mfma_f32_32x32x16_bf16 %[cx], %[a1], %[x1], %[cx]\n\t"
                "s_waitcnt lgkmcnt(2)\n\tv_mfma_f32_32x32x16_bf16 %[cx], %[a2], %[x2], %[cx]\n\t"
                "s_waitcnt lgkmcnt(0)\n\tv_mfma_f32_32x32x16_bf16 %[cx], %[a3], %[x3], %[cx]\n\t"
                : [cx] "+v"(accX), [a0] "=&v"(a0), [a1] "=&v"(a1), [a2] "=&v"(a2), [a3] "=&v"(a3), [x0] "=&v"(x0), [x1] "=&v"(x1), [x2] "=&v"(x2), [x3] "=&v"(x3)
                : [pa] "v"(pa), [px0] "v"(px0), [px1] "v"(px1), [px2] "v"(px2), [px3] "v"(px3));
        }
        aaddr -= 1024; sX -= 64; sY -= 64;
    }
    for (; k < nsteps; ++k) {
        const bf16x8 af = *(const LAS bf16x8*)(lds + aaddr), xf = *(const LAS bf16x8*)(lds + HY_BADDR(sX));
        accX = __builtin_amdgcn_mfma_f32_32x32x16_bf16(af, xf, accX, 0, 0, 0);
        if (DUAL) { const bf16x8 yf = *(const LAS bf16x8*)(lds + HY_BADDR(sY)); accY = __builtin_amdgcn_mfma_f32_32x32x16_bf16(af, yf, accY, 0, 0, 0); }
        aaddr -= 256; sX -= 16; sY -= 16;
    }
#undef HY_BADDR
}
template <int L>
__device__ __forceinline__ void hy_unit(const Ctx& c, int l, int ch, const GAS float* hbias) {
    constexpr int H = L / 2, NG = L / 256, LP = L + 64, NW = L / 8 + 8, ROWB = 2 * L + 16;
    LAS unsigned char* lds = c.lds;
    const GAS bf16_t* uT = (const GAS bf16_t*)(c.ws + WS_B); GAS bf16_t* oht = (GAS bf16_t*)(c.ws + WS_OHT);
    const int seq0 = (L == 4096) ? 0 : TL;
    const GAS bf16_t* hrbase = (L == 4096) ? (const GAS bf16_t*)(c.ws + WS_HRL) : (const GAS bf16_t*)(c.ws + WS_HRC);
    int gA, gB;
    if (NG == 16) { gA = c.wave < 4 ? c.wave : 4 + c.wave; gB = c.wave < 4 ? 7 - c.wave : 19 - c.wave; } else { gA = c.wave == 0 ? 0 : -1; gB = -1; }
    const int n = c.lane & 31, g = c.lane >> 5, tbl = n >> 2, b = n & 3;
    const int loA = gA < 0 ? 1 << 30 : max(-H - 16, 256 * gA - (L - 16)), hiA = gA < 0 ? -(1 << 30) : min(H, 256 * gA + 224);
    const int loB = gB < 0 ? 1 << 30 : max(-H - 16, 256 * gB - (L - 16)), hiB = gB < 0 ? -(1 << 30) : min(H, 256 * gB + 224);
    const int dlo = min(loA, loB), dhi = max(hiA, hiB);
    unsigned zreg[2][4][2];
    u32x4 fwA[2], fwB[2];
#define HY_LOAD_FW(oo) do { const GAS bf16_t* hr_ = hrbase + ((size_t)(l * 2 + (oo)) * 512 + ch) * LP; _Pragma("unroll") for (int k_ = 0; k_ < 2; ++k_) { const int w_ = c.tid + NTHR * k_; \
        const int wc_ = w_ < NW ? w_ : 0; fwA[k_] = *(const GAS u32x4*)(hr_ + 8 * (wc_ > 0 ? wc_ - 1 : 0)); fwB[k_] = *(const GAS u32x4*)(hr_ + 8 * wc_); } } while (0)
    HY_LOAD_FW(0);
    for (int o = 0; o < 2; ++o) {
#pragma unroll
        for (int kf = 0; kf < 2; ++kf) { const int w = c.tid + NTHR * kf; if (w < NW) {
            const u32x4 A4 = w > 0 ? fwA[kf] : (u32x4){0u, 0u, 0u, 0u}, B4 = fwB[kf];
            const unsigned Dd[8] = {A4.x, A4.y, A4.z, A4.w, B4.x, B4.y, B4.z, B4.w};
#pragma unroll
            for (int q = 0; q < 8; ++q) { u32x4 ov;
                if ((q & 1) == 0) { const int j = (8 - q) / 2; ov.x = Dd[j]; ov.y = Dd[j + 1]; ov.z = Dd[j + 2]; ov.w = Dd[j + 3]; }
                else { const int j = (7 - q) / 2; ov.x = __builtin_amdgcn_alignbit(Dd[j + 1], Dd[j], 16); ov.y = __builtin_amdgcn_alignbit(Dd[j + 2], Dd[j + 1], 16);
                       ov.z = __builtin_amdgcn_alignbit(Dd[j + 3], Dd[j + 2], 16); ov.w = __builtin_amdgcn_alignbit(Dd[j + 4], Dd[j + 3], 16); }
                *(LAS u32x4*)(lds + HY_HR_OFF + (8 * w + q) * 16) = ov; }
        } }
        if (o == 0) {
            for (int idx = c.tid; idx < 4 * (L / 8); idx += NTHR) { const int bb = idx / (L / 8), wq = idx % (L / 8);
                *(LAS u32x4*)(lds + HY_U_OFF + bb * ROWB + wq * 16) = *(const GAS u32x4*)(uT + (size_t)ch * T + seq0 + bb * L + wq * 8); }
            if (c.tid < 16) *(LAS unsigned*)(lds + HY_ZB_OFF + c.tid * 4) = 0u;
        } else {
#pragma unroll
            for (int gi = 0; gi < 2; ++gi) { const int G = gi == 0 ? gA : gB; if (G >= 0) {
#pragma unroll
                for (int rq = 0; rq < 4; ++rq) { const int t = 32 * (8 * G + tbl) + 8 * rq + 4 * g;
                    u32x2 zz; zz.x = zreg[gi][rq][0]; zz.y = zreg[gi][rq][1]; *(LAS u32x2*)(lds + HY_U_OFF + b * ROWB + 2 * t) = zz; } } }
        }
        __syncthreads();
        u32x2 xv[2][4];
#pragma unroll
        for (int gi = 0; gi < 2; ++gi) { const int G = gi == 0 ? gA : gB;
#pragma unroll
            for (int rq = 0; rq < 4; ++rq)
                xv[gi][rq] = *(const GAS u32x2*)(uT + (size_t)((o == 0 ? 512 : 1024) + ch) * T + (size_t)seq0 + b * L + 32 * (8 * (G >= 0 ? G : 0) + tbl) + 8 * rq + 4 * g); }
        if (o == 0) HY_LOAD_FW(1);
        __builtin_amdgcn_sched_barrier(0);
        f32x16 accA, accB;
#pragma unroll
        for (int r = 0; r < 16; ++r) { accA[r] = 0.f; accB[r] = 0.f; }
        {
            const int qq = (n + 1) & 7, ubase = HY_U_OFF + b * ROWB + 16 * g;
#define HY_AADDR(d) (HY_HR_OFF + (8 * ((H + 31 - (d) - n + 8 * g + qq) >> 3) + qq) * 16)
#define HY_S0(G, d) (32 * (8 * (G) + tbl) - (d))
            if (gB < 0) { if (gA >= 0) hy_span<L, false>(lds, (hiA - loA) / 16 + 1, HY_AADDR(loA), ubase, HY_S0(gA, loA), 0, accA, accB); }
            else {
                const int dS = max(loA, loB), dE = min(hiA, hiB);
                if (loA < dS) hy_span<L, false>(lds, (dS - loA) / 16, HY_AADDR(loA), ubase, HY_S0(gA, loA), 0, accA, accB);
                else if (loB < dS) hy_span<L, false>(lds, (dS - loB) / 16, HY_AADDR(loB), ubase, HY_S0(gB, loB), 0, accB, accA);
                hy_span<L, true>(lds, (dE - dS) / 16 + 1, HY_AADDR(dS), ubase, HY_S0(gA, dS), HY_S0(gB, dS), accA, accB);
                if (hiA > dE) hy_span<L, false>(lds, (hiA - dE) / 16, HY_AADDR(dE + 16), ubase, HY_S0(gA, dE + 16), 0, accA, accB);
                else if (hiB > dE) hy_span<L, false>(lds, (hiB - dE) / 16, HY_AADDR(dE + 16), ubase, HY_S0(gB, dE + 16), 0, accB, accA);
            }
#undef HY_AADDR
#undef HY_S0
        }
        const float bias = hbias[(l * 2 + o) * 512 + ch];
        int tbl_e = tbl, b_e = b, g_e = g; asm volatile("" : "+v"(tbl_e), "+v"(b_e), "+v"(g_e));
#pragma unroll
        for (int gi = 0; gi < 2; ++gi) { const int G = gi == 0 ? gA : gB; if (G >= 0) {
#pragma unroll
            for (int rq = 0; rq < 4; ++rq) { const int t = 32 * (8 * G + tbl_e) + 8 * rq + 4 * g_e;
                const u32x2 uv = *(const LAS u32x2*)(lds + HY_U_OFF + b_e * ROWB + 2 * t);
                const size_t grow = (size_t)seq0 + b_e * L + t;
                const u32x2 xvv = xv[gi][rq];
                float y[4];
#pragma unroll
                for (int k = 0; k < 4; ++k) y[k] = gi == 0 ? accA[4 * rq + k] : accB[4 * rq + k];
                const float r0 = bflo(xvv.x) * (y[0] + bias * bflo(uv.x)), r1 = bfhi(xvv.x) * (y[1] + bias * bfhi(uv.x));
                const float r2 = bflo(xvv.y) * (y[2] + bias * bflo(uv.y)), r3 = bfhi(xvv.y) * (y[3] + bias * bfhi(uv.y));
                const unsigned p0 = cvt_pk_bf16(r0, r1), p1 = cvt_pk_bf16(r2, r3);
                if (o == 0) { zreg[gi][rq][0] = p0; zreg[gi][rq][1] = p1; }
                else { u32x2 ov; ov.x = p0; ov.y = p1; *(GAS u32x2*)(oht + (size_t)ch * T + grow) = ov;   } } } }
        __syncthreads();
    }
}
#undef HY_LOAD_FW
__device__ __forceinline__ void ph_hyena(const Ctx& c0, int l) {
    const Ctx c = mk_ctx(c0.lds, c0.ws);
    const GAS float* hbias = inp(c, I_HBIAS);
    for (int unit = c.bid; unit < HYW; unit += c.G) { hy_unit<4096>(c, l, unit, hbias); if (l < DEPTH - 1) hy_unit<256>(c, l, unit, hbias); }
}

__device__ __forceinline__ void ph_ohy_t(const Ctx& c0) {
    const Ctx c = mk_ctx(c0.lds, c0.ws);
    const GAS bf16_t* src = (const GAS bf16_t*)(c.ws + WS_OHT); GAS bf16_t* dst = (GAS bf16_t*)(c.ws + WS_OAH) + 512;
    LAS unsigned char* scr = c.lds + c.wave * 16384;
    for (int tile = c.bid * NWAVES + c.wave; tile < (T / 64) * 8; tile += c.G * NWAVES) {
        const int row0 = (tile >> 3) * 64, ch0 = (tile & 7) * 64;
#pragma unroll
        for (int k = 0; k < 8; ++k) { const int cc = (c.lane >> 3) + 8 * k, ck = c.lane & 7;
            const u32x4 v = *(const GAS u32x4*)(src + (size_t)(ch0 + cc) * T + row0 + ck * 8);
            LAS unsigned* d = (LAS unsigned*)(scr + cc * 132 + ck * 16); d[0] = v.x; d[1] = v.y; d[2] = v.z; d[3] = v.w; }
        LDS_WAIT(); asm volatile("" ::: "memory");
        unsigned ow[32];
#pragma unroll
        for (int j = 0; j < 32; ++j) { const unsigned lo = *(const LAS unsigned short*)(scr + (2 * j) * 132 + c.lane * 2), hi = *(const LAS unsigned short*)(scr + (2 * j + 1) * 132 + c.lane * 2); ow[j] = lo | (hi << 16); }
        LDS_WAIT(); asm volatile("" ::: "memory");
#pragma unroll
        for (int k = 0; k < 8; ++k) { u32x4 v; v.x = ow[4 * k]; v.y = ow[4 * k + 1]; v.z = ow[4 * k + 2]; v.w = ow[4 * k + 3]; *(LAS u32x4*)(scr + c.lane * 144 + k * 16) = v; }
        LDS_WAIT(); asm volatile("" ::: "memory");
#pragma unroll
        for (int k = 0; k < 8; ++k) { const int rr = (c.lane >> 3) + 8 * k, ck = c.lane & 7; const u32x4 v = *(const LAS u32x4*)(scr + rr * 144 + ck * 16);
            *(GAS u32x4*)(dst + (size_t)(row0 + rr) * 1024 + ch0 + ck * 8) = v; }
        LDS_WAIT(); asm volatile("" ::: "memory");
    }
}

constexpr int ATT_RPB_OFF = 1024, ATT_VT_OFF = ATT_RPB_OFF + 8 * 15 * 32 * 4, ATT_VT_BYTES = 64 * 72;
template <int MODE>
__device__ __forceinline__ void att_block(const GAS bf16_t* P, const GAS bf16_t* VT, LAS unsigned char* lds, LAS unsigned char* vt, int lane, int n, int h, int head,
                                          int tokk, int ctok, int tabaddr, int vb, const bf16x8 (&qf)[4], f32x16& ot0, f32x16& ot1, float& m, float& lsum) {
    bf16x8 kf[4];
#pragma unroll
    for (int ks = 0; ks < 4; ++ks) kf[ks] = *(const GAS bf16x8*)(P + (size_t)tokk * PW + PK + head * 64 + 16 * ks + 8 * h);
    u32x2 vr[8];
#pragma unroll
    for (int it = 0; it < 8; ++it) vr[it] = *(const GAS u32x2*)(VT + (size_t)(head * 64 + it * 8 + (lane >> 3)) * T + ctok);
    f32x16 st;
#pragma unroll
    for (int r = 0; r < 16; ++r) st[r] = 0.f;
#pragma unroll
    for (int ks = 0; ks < 4; ++ks) st = __builtin_amdgcn_mfma_f32_32x32x16_bf16(kf[ks], qf[ks], st, 0, 0, 0);
    const float SC = 0.18033688011112042f;
    float sv[16];
    if (MODE == 2) {
#pragma unroll
        for (int r = 0; r < 16; ++r) sv[r] = st[r] * SC;
    } else {
        float bias[16];
#pragma unroll
        for (int r = 0; r < 16; ++r) { const int imm = MODE == 0 ? (8 * (r >> 2) + (r & 3)) * 4 : ((r >> 2) * 32 + (r & 3)) * 4; bias[r] = *(const volatile LAS float*)(lds + tabaddr + imm); }
#pragma unroll
        for (int r = 0; r < 16; ++r) { const int cr = MODE == 0 ? 8 * (r >> 2) + (r & 3) : (r & 3);
            const float v = st[r] * SC + bias[r]; sv[r] = ((unsigned)(vb + cr) < 16u) ? v : -1.0e30f; }
    }
    float bm = sv[0];
#pragma unroll
    for (int r = 1; r < 16; ++r) bm = fmaxf(bm, sv[r]);
    bm = fmaxf(bm, __int_as_float(__builtin_amdgcn_ds_bpermute((lane ^ 32) << 2, __float_as_int(bm))));
    const float mn = fmaxf(m, bm), alpha = __builtin_amdgcn_exp2f(m - mn); m = mn;
    float psum = 0.f;
#pragma unroll
    for (int r = 0; r < 16; ++r) { const float pv = __builtin_amdgcn_exp2f(sv[r] - mn); psum += pv; sv[r] = pv; }
    lsum = lsum * alpha + psum;
#pragma unroll
    for (int r = 0; r < 16; ++r) { ot0[r] *= alpha; ot1[r] *= alpha; }
    bf16x8 pb[2];
#pragma unroll
    for (int s2 = 0; s2 < 2; ++s2) { u32x4 w; w.x = cvt_pk_bf16(sv[8 * s2], sv[8 * s2 + 1]); w.y = cvt_pk_bf16(sv[8 * s2 + 2], sv[8 * s2 + 3]);
        w.z = cvt_pk_bf16(sv[8 * s2 + 4], sv[8 * s2 + 5]); w.w = cvt_pk_bf16(sv[8 * s2 + 6], sv[8 * s2 + 7]); pb[s2] = __builtin_bit_cast(bf16x8, w); }
#pragma unroll
    for (int it = 0; it < 8; ++it) *(LAS u32x2*)(vt + (it * 8 + (lane >> 3)) * 72 + (lane & 7) * 8) = vr[it];
#pragma unroll
    for (int s2 = 0; s2 < 2; ++s2) {
        { const u32x2 a = *(const LAS u32x2*)(vt + n * 72 + (4 * s2 + h) * 8), bq = *(const LAS u32x2*)(vt + n * 72 + (4 * s2 + 2 + h) * 8);
          u32x4 w; w.x = a.x; w.y = a.y; w.z = bq.x; w.w = bq.y; ot0 = __builtin_amdgcn_mfma_f32_32x32x16_bf16(__builtin_bit_cast(bf16x8, w), pb[s2], ot0, 0, 0, 0); }
        { const u32x2 a = *(const LAS u32x2*)(vt + (32 + n) * 72 + (4 * s2 + h) * 8), bq = *(const LAS u32x2*)(vt + (32 + n) * 72 + (4 * s2 + 2 + h) * 8);
          u32x4 w; w.x = a.x; w.y = a.y; w.z = bq.x; w.w = bq.y; ot1 = __builtin_amdgcn_mfma_f32_32x32x16_bf16(__builtin_bit_cast(bf16x8, w), pb[s2], ot1, 0, 0, 0); }
    }
}
constexpr int ATT_UNITS = 4096 + 256;
__device__ __forceinline__ void ph_attn(const Ctx& c0, int l) {
    const Ctx c = mk_ctx(c0.lds, c0.ws);
    const GAS bf16_t* P = (const GAS bf16_t*)(c.ws + WS_P); const GAS bf16_t* VT = (const GAS bf16_t*)(c.ws + WS_VT); GAS bf16_t* oatt = (GAS bf16_t*)(c.ws + WS_OAH);
    const GAS float* rpb = inp(c, I_RPB) + (size_t)l * 8 * 15 * 31;
    LAS unsigned char* lds = c.lds;
    for (int i = c.tid; i < 8 * 15 * 32; i += NTHR) { const int hd = i / 480, rem = i % 480, dr = rem >> 5, dc = rem & 31;
        *(LAS float*)(lds + ATT_RPB_OFF + i * 4) = dc < 31 ? rpb[(hd * 15 + dr) * 31 + dc] * 1.4426950408889634f : 0.f; }
    __syncthreads();
    LAS unsigned char* vt = lds + ATT_VT_OFF + c.wave * ATT_VT_BYTES;
    const int lane = c.lane, n = lane & 31, h = lane >> 5;
    const int natt = l < DEPTH - 1 ? ATT_UNITS : 4096;
    for (int u = c.bid * NWAVES + c.wave; u < natt; u += c.G * NWAVES) {
        const bool lat = u < 4096;
        int b, head, r = 0, hf = 0, tokq;
        if (lat) { hf = u & 1; r = (u >> 1) & 63; head = (u >> 7) & 7; b = u >> 10; tokq = b * 4096 + r * 64 + 32 * hf + n; }
        else { const int uu = u - 4096; head = (uu >> 3) & 7; b = uu >> 6; tokq = TL + b * 256 + 32 * (uu & 7) + n; }
        bf16x8 qf[4];
#pragma unroll
        for (int ks = 0; ks < 4; ++ks) qf[ks] = *(const GAS bf16x8*)(P + (size_t)tokq * PW + PQ + head * 64 + 16 * ks + 8 * h);
        f32x16 ot0, ot1;
#pragma unroll
        for (int q = 0; q < 16; ++q) { ot0[q] = 0.f; ot1[q] = 0.f; }
        float m = -1.0e30f, lsum = 0.f;
        if (lat) {
            const int r0 = min(max(r - 4, 0), 56), lo = hf ? 24 : 0, qc = 32 * hf + n, c0q = min(max(qc - 8, 0), 48);
            for (int kb = 0; kb < 8; ++kb) {
                const int base = b * 4096 + (r0 + kb) * 64 + lo, kx = lo + 4 * h;
                const int tabaddr = ATT_RPB_OFF + (((head * 15 + (r0 + kb - r + 7)) * 32) + kx - qc + 15) * 4;
                att_block<0>(P, VT, lds, vt, lane, n, h, head, base + n, base + 4 * (lane & 7), tabaddr, kx - c0q, qf, ot0, ot1, m, lsum);
            }
            for (int kb = 0; kb < 2; ++kb) {
                const int rowb = b * 4096 + (r0 + 4 * kb) * 64 + lo + 32, kx = lo + 32 + 4 * h, cc = lane & 7;
                const int tabaddr = ATT_RPB_OFF + (((head * 15 + (r0 + 4 * kb - r + 7)) * 32) + kx - qc + 15) * 4;
                att_block<1>(P, VT, lds, vt, lane, n, h, head, rowb + (n >> 3) * 64 + (n & 7), rowb + (cc >> 1) * 64 + 4 * (cc & 1), tabaddr, kx - c0q, qf, ot0, ot1, m, lsum);
            }
        }
        for (int kb = 0; kb < 8; ++kb) { const int base = TL + b * 256 + 32 * kb;
            att_block<2>(P, VT, lds, vt, lane, n, h, head, base + n, base + 4 * (lane & 7), 0, 0, qf, ot0, ot1, m, lsum); }
        const float ltot = lsum + __int_as_float(__builtin_amdgcn_ds_bpermute((lane ^ 32) << 2, __float_as_int(lsum)));
        const float inv = __builtin_amdgcn_rcpf(ltot);
        GAS bf16_t* op = oatt + (size_t)tokq * 1024 + head * 64 + 4 * h;
#pragma unroll
        for (int rq = 0; rq < 4; ++rq) {
            u32x2 w0, w1; w0.x = cvt_pk_bf16(ot0[4 * rq] * inv, ot0[4 * rq + 1] * inv); w0.y = cvt_pk_bf16(ot0[4 * rq + 2] * inv, ot0[4 * rq + 3] * inv);
            w1.x = cvt_pk_bf16(ot1[4 * rq] * inv, ot1[4 * rq + 1] * inv); w1.y = cvt_pk_bf16(ot1[4 * rq + 2] * inv, ot1[4 * rq + 3] * inv);
            *(GAS u32x2*)(op + 8 * rq) = w0; *(GAS u32x2*)(op + 32 + 8 * rq) = w1; }
    }
    __syncthreads();
}

__device__ __forceinline__ void ph_final(const Ctx& c0) {
    const Ctx c = mk_ctx(c0.lds, c0.ws);
    const GAS float* xres = (const GAS float*)(c.ws + WS_X); const GAS float* gp = inp(c, I_FINALG); GAS float* outp = (GAS float*)inp(c, 30);
    const MoeComb mc{(const GAS int*)(c.ws + WS_ROUTE), (const GAS float*)(c.ws + WS_RWT), (const GAS bf16_t*)(c.ws + WS_Y), (const GAS float*)(c.ws + WS_MOD) + (size_t)(DEPTH - 1) * 5 * 6144 + 5 * 1024};
    LAS unsigned* offs = (LAS unsigned*)c.lds + 32;
    moe_offsets(c, 1, offs);
    __syncthreads();
    for (int row = c.bid * NWAVES + c.wave; row < TL; row += c.G * NWAVES) {
        const GAS float* src = xres + (size_t)row * D; f32x4 v[4]; float ss = 0.f;
#pragma unroll
        for (int j = 0; j < 4; ++j) v[j] = *(const GAS f32x4*)(src + 4 * (c.lane + 64 * j));
        moe_combine_row(mc, offs, row, row >> 12, c.lane, v);
#pragma unroll
        for (int j = 0; j < 4; ++j) ss += (v[j][0] * v[j][0] + v[j][1] * v[j][1]) + (v[j][2] * v[j][2] + v[j][3] * v[j][3]);
        ss = wave_sum(ss, c.lane);
        const float rstd = 1.f / sqrtf(ss * (1.f / D) + EPS);
#pragma unroll
        for (int j = 0; j < 4; ++j) { const int k0 = 4 * (c.lane + 64 * j); const f32x4 g4 = *(const GAS f32x4*)(gp + k0); *(GAS f32x4*)(outp + (size_t)row * D + k0) = v[j] * rstd * g4; }
    }
}

constexpr int MOE_OFF = 132096;
template <bool GATHER_> struct MoeOrder {
    static constexpr bool GATHER = GATHER_;
    int nM, nN, nwg, G, c; const GAS char* A; const GAS char* B; size_t astep, bstep, estep; const GAS int* tokenof; const LAS unsigned* tab;
    __device__ void init(const GAS void* A_, int lda, const GAS void* B_, int ldb, size_t estep_bytes, int N, int G_, int c_, const GAS int* tok, const LAS unsigned* tab_) {
        tab = tab_; nM = (int)((unsigned)__builtin_amdgcn_readfirstlane(tab[8]) >> 8); nN = N / pg8::BM; nwg = nM * nN; G = G_; c = c_; A = (const GAS char*)A_; B = (const GAS char*)B_;
        astep = (size_t)pg8::BM * lda * 2; bstep = (size_t)pg8::BM * ldb * 2; estep = estep_bytes; tokenof = tok; }
    __device__ bool next(int i, pg8::Unit& u) const {
        const long L = (long)i * G + c; if (L >= nwg) return false;
        int wgid = (int)L; { const int q = nwg / pg8::NXCD, r = nwg % pg8::NXCD, xcd = wgid % pg8::NXCD, off = wgid / pg8::NXCD; wgid = (xcd < r ? xcd * (q + 1) : r * (q + 1) + (xcd - r) * q) + off; }
        const int nig = pg8::WGM * nN, gid = wgid / nig, fm = gid * pg8::WGM, gsz = (nM - fm) < pg8::WGM ? (nM - fm) : pg8::WGM;
        u.pm = fm + ((wgid % nig) % gsz); u.pn = (wgid % nig) / gsz;
        const unsigned slot0 = (unsigned)u.pm << 8; int e = 0;
#pragma unroll
        for (int j = 1; j < 8; ++j) e += (slot0 >= (unsigned)__builtin_amdgcn_readfirstlane(tab[j])) ? 1 : 0;
        const unsigned pos0 = slot0 - (unsigned)__builtin_amdgcn_readfirstlane(tab[e]), cnt = (unsigned)__builtin_amdgcn_readfirstlane(tab[16 + e]);
        u.nvalid = cnt > pos0 ? (int)(cnt - pos0) : 0; u.tk = tokenof + (size_t)e * T + pos0;
        u.a = GATHER ? A : A + (size_t)u.pm * astep; u.b = B + (size_t)e * estep + (size_t)u.pn * bstep; return true;
    }
    __device__ __forceinline__ int arow(const pg8::Unit& u, int r) const { return r < u.nvalid ? u.tk[r] : 0; }
    __device__ __forceinline__ void a_ready(const pg8::Unit&) const {}
    __device__ __forceinline__ void done(const pg8::Unit&) const {}
};
__device__ __forceinline__ void moe_table(const Ctx& c, int i) {
    LAS unsigned* tab = (LAS unsigned*)(c.lds + MOE_OFF);
    if (c.tid == 0) { const GAS unsigned* cnt = (const GAS unsigned*)(c.ws + WS_CTL) + CW_CNT + 64 * i; unsigned o = 0;
        for (int e = 0; e < 8; ++e) { const unsigned ce = cnt[e]; tab[e] = o; tab[16 + e] = ce; o += (ce + 255u) & ~255u; } tab[8] = o; }
    __syncthreads();
}

#define XB_TMO      128
#define XB_XCNT(j)  (256  + 64 * (j))
#define XB_XSUB(j)  (1280 + 64 * (j))
#define XB_XGEN(j)  (2304 + 64 * (j))
#define XB_TOP      3328
#define XB_TOPGEN   3392
#define XCD_BAR_WORDS 3456
#define XB_SPIN_CAP (1u << 18)
__device__ __forceinline__ unsigned xb_ld(GAS unsigned* p)              { return __hip_atomic_load(p, __ATOMIC_RELAXED, __HIP_MEMORY_SCOPE_AGENT); }
__device__ __forceinline__ unsigned xb_add(GAS unsigned* p, unsigned v) { return __hip_atomic_fetch_add(p, v, __ATOMIC_RELAXED, __HIP_MEMORY_SCOPE_AGENT); }
__device__ __forceinline__ unsigned xb_xcc_id() { return (unsigned)__builtin_amdgcn_s_getreg((3 << 11) | 20) & 0xFu; }
#define XB_SPIN(cond, bar) do { unsigned _sp = 0; while (cond) { __builtin_amdgcn_s_sleep(1); \
    if ((++_sp & 255u) == 0u) { if (xb_ld(&(bar)[XB_TMO])) break; if (_sp > XB_SPIN_CAP) { (void)xb_add(&(bar)[XB_TMO], 1u); break; } } } } while (0)
struct XcdBarrier { GAS unsigned* bar; unsigned x; volatile LAS unsigned* st; };
__device__ __forceinline__ XcdBarrier xcd_barrier_post(GAS unsigned* bar, volatile LAS unsigned* st) {
    XcdBarrier b; b.bar = bar; b.x = xb_xcc_id(); b.st = st;
    if (threadIdx.x == 0) (void)xb_add(&bar[XB_XCNT(b.x)], 1u);
    return b;
}
__device__ __forceinline__ void xcd_barrier_complete(GAS unsigned* bar, unsigned x, unsigned& nloc, unsigned& nx) {
    const unsigned G = gridDim.x * gridDim.y * gridDim.z;
    unsigned sum, cnt, mine, sp = 0u;
    for (;;) {
        sum = 0u; cnt = 0u; mine = 0u;
#pragma unroll
        for (unsigned j = 0; j < 16; ++j) { const unsigned c = xb_ld(&bar[XB_XCNT(j)]); sum += c; cnt += (c > 0u) ? 1u : 0u; mine = (j == x) ? c : mine; }
        if (sum == G) break;
        __builtin_amdgcn_s_sleep(1);
        if ((++sp & 255u) == 0u) { if (xb_ld(&bar[XB_TMO])) break; if (sp > XB_SPIN_CAP) { (void)xb_add(&bar[XB_TMO], 1u); break; } }
    }
    nloc = mine > 0u ? mine : 1u; nx = cnt > 0u ? cnt : 1u;
}
__device__ __forceinline__ void xcd_barrier(const XcdBarrier& b) {
    asm volatile("s_waitcnt vmcnt(0)" ::: "memory");
    __syncthreads();
    if (threadIdx.x == 0) {
        GAS unsigned* bar = b.bar; asm volatile("" : "+s"(bar));     const unsigned bx = xb_xcc_id();
        __builtin_amdgcn_s_waitcnt(0);
        unsigned nloc = b.st[0], nx = b.st[1];
        if (nloc == 0u) { xcd_barrier_complete(bar, bx, nloc, nx); b.st[0] = nloc; b.st[1] = nx; }
        const unsigned old = xb_add(&bar[XB_XSUB(bx)], 1u);
        const unsigned gen = old / nloc;
        if (old + 1u == (gen + 1u) * nloc) {
            __builtin_amdgcn_fence(__ATOMIC_RELEASE, "agent");
            asm volatile("s_waitcnt vmcnt(0)" ::: "memory");
            const unsigned og = xb_add(&bar[XB_TOP], 1u);
            const unsigned tg = og / nx;
            if (og + 1u == (tg + 1u) * nx) xb_add(&bar[XB_TOPGEN], 1u);
            else XB_SPIN(xb_ld(&bar[XB_TOPGEN]) == tg, bar);
            __builtin_amdgcn_fence(__ATOMIC_ACQUIRE, "agent");
            xb_add(&bar[XB_XGEN(bx)], 1u);
            asm volatile("s_waitcnt vmcnt(0)" ::: "memory");
        } else {
            XB_SPIN(xb_ld(&bar[XB_XGEN(bx)]) == gen, bar);
            __builtin_amdgcn_fence(__ATOMIC_ACQUIRE, "agent");
            asm volatile("s_waitcnt vmcnt(0)" ::: "memory");
        }
    }
    __syncthreads();
}

constexpr int CW_BAR = 4096;

__global__ void __launch_bounds__(NTHR, 2) fwd(Args args) {
    extern __shared__ __attribute__((aligned(16))) unsigned char lds_raw[];
    Ctx c; c.lds = (LAS unsigned char*)lds_raw; c.tid = threadIdx.x; c.lane = c.tid & 63; c.wave = __builtin_amdgcn_readfirstlane(c.tid >> 6); c.G = gridDim.x; c.bid = blockIdx.x; c.ws = (GAS unsigned char*)args.ws;
    GAS unsigned char* ws = (GAS unsigned char*)args.ws;
    volatile LAS unsigned* MISC = (volatile LAS unsigned*)(c.lds + MISC_OFF);
    if (c.tid < 32) MISC[c.tid] = 0u;
    if (c.tid < 31) { const unsigned long long pv = c.tid < 30 ? (unsigned long long)args.in[c.tid] : (unsigned long long)args.out;
        volatile LAS unsigned* pt = (volatile LAS unsigned*)(c.lds + PTR_OFF) + 2 * c.tid; pt[0] = (unsigned)pv; pt[1] = (unsigned)(pv >> 32); }
    __syncthreads();
    XcdBarrier bar = xcd_barrier_post((GAS unsigned*)(ws + WS_CTL) + CW_BAR, MISC + 8);
#define GRID_BAR() xcd_barrier(bar)
#ifndef PROFILE_ID
#define PROFILE_ID (-1)
#endif
#define PROF(id) do { if (PROFILE_ID >= 0 && blockIdx.x == 0 && threadIdx.x == 0) { const unsigned long long t_ = __builtin_amdgcn_s_memrealtime(); \
        volatile LAS unsigned* q_ = MISC + 16; const unsigned long long prev_ = ((unsigned long long)q_[1] << 32) | q_[0]; \
        if ((id) == PROFILE_ID) { const unsigned long long a_ = (((unsigned long long)q_[3] << 32) | q_[2]) + (t_ - prev_); q_[2] = (unsigned)a_; q_[3] = (unsigned)(a_ >> 32); } \
        q_[0] = (unsigned)t_; q_[1] = (unsigned)(t_ >> 32); } } while (0)
    PROF(99);

    ph_convert(c); __syncthreads(); ph_mod(c); __syncthreads(); ph_filt(c);
    GRID_BAR(); PROF(0);
    for (int l = 0; l < DEPTH; ++l) {
        ph_norm(c, l, 0);
        GRID_BAR(); PROF(1);
        {   GAS unsigned char* ws = c.ws; asm volatile("" : "+s"(ws));
            pg8::Gemm g{D, D, D, STAG}; pg8::StaticOrder S; S.init(ws + WS_H, D, (GAS bf16_t*)(ws + WS_WIN) + (size_t)l * PW * D, D, T, PW, c.G, c.bid);
            EpiStoreBf16 E{(GAS bf16_t*)(ws + WS_P), PW};
            pg8::gemm_phase(c.lds, g, S, E); }
        GRID_BAR(); PROF(2);
        ph_sc(c, l);
        GRID_BAR(); PROF(3);
        ph_hyena(c, l); ph_attn(c, l);
        GRID_BAR(); PROF(4);
        ph_ohy_t(c);
        GRID_BAR(); PROF(5);
        {   GAS unsigned char* ws = c.ws; asm volatile("" : "+s"(ws));
            const GAS bf16_t* wab = (const GAS bf16_t*)(ws + WS_WPAB) + (size_t)l * D * D;
            pg8::Gemm g{D, D, D}; pg8::StaticOrder S; S.init(ws + WS_OAH, D, wab, D, TL, D, c.G, c.bid);
            EpiMergeK E{(const GAS bf16_t*)(ws + WS_P), (GAS bf16_t*)(ws + WS_H)};
            pg8::gemm_phase(c.lds, g, S, E);
            if (l < DEPTH - 1) ctx_gemm(c.lds, (const GAS bf16_t*)(ws + WS_OAH), D, wab, D, D, CEpiMergeK{(const GAS bf16_t*)(ws + WS_P), (GAS bf16_t*)(ws + WS_H)}); }
        GRID_BAR(); PROF(6);
        {   GAS unsigned char* ws = c.ws; asm volatile("" : "+s"(ws));
            const GAS float* modl = (const GAS float*)(ws + WS_MOD) + (size_t)l * 5 * 6144;
            pg8::Gemm g{D, D, D}; pg8::StaticOrder S; S.init(ws + WS_H, D, (GAS bf16_t*)(ws + WS_WO) + (size_t)l * D * D, D, TL, D, c.G, c.bid);
            EpiResid E{(GAS float*)(ws + WS_X), modl + 2 * 1024};
            pg8::gemm_phase(c.lds, g, S, E);
            if (l < DEPTH - 1) ctx_gemm(c.lds, (const GAS bf16_t*)(ws + WS_H), D, (const GAS bf16_t*)(ws + WS_WO) + (size_t)l * D * D, D, D, CEpiResid{(GAS float*)(ws + WS_X), modl + 4 * 6144 + 2 * 1024}); }
        GRID_BAR(); PROF(7);
        ph_norm(c, l, 1);
        GRID_BAR(); PROF(8);
        if ((l & 1) == 0) {
            {   GAS unsigned char* ws = c.ws; asm volatile("" : "+s"(ws));
                const GAS bf16_t* w = (const GAS bf16_t*)(ws + WS_W13D) + (size_t)(l >> 1) * 2 * FF * D;
                pg8::Gemm g{D, D, D, STAG}; pg8::StaticOrder S; S.init(ws + WS_H, D, w, D, T, 2 * FF, c.G, c.bid);
                EpiSwiglu E{(GAS bf16_t*)(ws + WS_P)};
                pg8::gemm_phase(c.lds, g, S, E); }
            GRID_BAR(); PROF(9);
            {   GAS unsigned char* ws = c.ws; asm volatile("" : "+s"(ws));
                const GAS float* modl = (const GAS float*)(ws + WS_MOD) + (size_t)l * 5 * 6144;
                const GAS bf16_t* w = (const GAS bf16_t*)(ws + WS_W2D) + (size_t)(l >> 1) * D * FF;
                pg8::Gemm g{FF, FF, FF}; pg8::StaticOrder S; S.init(ws + WS_P, FF, w, FF, TL, D, c.G, c.bid);
                EpiResid E{(GAS float*)(ws + WS_X), modl + 5 * 1024};
                pg8::gemm_phase(c.lds, g, S, E);
                ctx_gemm(c.lds, (const GAS bf16_t*)(ws + WS_P), FF, w, FF, FF, CEpiResid{(GAS float*)(ws + WS_X), modl + 4 * 6144 + 5 * 1024}); }
            GRID_BAR(); PROF(10);
        } else {
            const Ctx cm = mk_ctx(c.lds, c.ws);
            moe_table(cm, l >> 1);
            {   GAS unsigned char* ws = c.ws; asm volatile("" : "+s"(ws));
                const GAS bf16_t* w = (const GAS bf16_t*)(ws + WS_W13M) + (size_t)((l >> 1) * NE) * 2 * FF * D;
                pg8::Gemm g{D, D, D, STAG}; MoeOrder<true> S; S.init(ws + WS_H, D, w, D, (size_t)2 * FF * D * 2, 2 * FF, c.G, c.bid, (const GAS int*)(ws + WS_TOK), (const LAS unsigned*)(c.lds + MOE_OFF));
                EpiSwiglu E{(GAS bf16_t*)(ws + WS_P)};
                pg8::gemm_phase(c.lds, g, S, E); }
            GRID_BAR(); PROF(11);
            {   GAS unsigned char* ws = c.ws; asm volatile("" : "+s"(ws));
                const GAS bf16_t* w = (const GAS bf16_t*)(ws + WS_W2M) + (size_t)((l >> 1) * NE) * D * FF;
                pg8::Gemm g{FF, FF, FF, STAG}; MoeOrder<false> S; S.init(ws + WS_P, FF, w, FF, (size_t)D * FF * 2, D, c.G, c.bid, (const GAS int*)(ws + WS_TOK), (const LAS unsigned*)(c.lds + MOE_OFF));
                EpiStoreBf16 E{(GAS bf16_t*)(ws + WS_Y), D};
                pg8::gemm_phase(c.lds, g, S, E); }
            GRID_BAR(); PROF(12);
        }
    }
    ph_final(c);
    if (PROFILE_ID >= 0 && blockIdx.x == 0) {
        if (threadIdx.x == 0) { PROF(13); volatile LAS unsigned* q_ = MISC + 16; const unsigned long long a_ = ((unsigned long long)q_[3] << 32) | q_[2], t0_ = __builtin_amdgcn_s_memrealtime();
            while (__builtin_amdgcn_s_memrealtime() - t0_ < a_) __builtin_amdgcn_s_sleep(8); }
        __syncthreads();
    }
}

extern "C" void kernel_launch(void* const* d_in, const int* in_sizes, int n_in, void* d_out, int out_size, void* d_ws, size_t ws_size, hipStream_t stream) {
    static int grid = 0;
    if (grid == 0) {
        if (n_in != 30 || out_size != TL * D || ws_size < WS_END) { fprintf(stderr, "kernel_launch: unexpected shapes (n_in %d out %d ws %zu)\n", n_in, out_size, ws_size); grid = -1; return; }
        int dev = 0, cus = 0, per_cu = 0; (void)hipGetDevice(&dev); (void)hipDeviceGetAttribute(&cus, hipDeviceAttributeMultiprocessorCount, dev);
        if (hipFuncSetAttribute((const void*)fwd, hipFuncAttributeMaxDynamicSharedMemorySize, LDS_BYTES) != hipSuccess) { fprintf(stderr, "kernel_launch: hipFuncSetAttribute failed\n"); grid = -1; return; }
        if (hipOccupancyMaxActiveBlocksPerMultiprocessor(&per_cu, (const void*)fwd, NTHR, LDS_BYTES) != hipSuccess || per_cu < 1) fprintf(stderr, "kernel_launch: occupancy query reports %d\n", per_cu);
        (void)hipGetLastError();
        grid = cus > 0 ? cus : 256;
    }
    if (grid < 0) return;
    (void)hipMemsetAsync((char*)d_ws + WS_CTL, 0, CTL_ZERO_BYTES, stream);
    Args a{};
    for (int i = 0; i < 30; ++i) a.in[i] = (const float*)d_in[i];
    a.out = (float*)d_out; a.ws = (unsigned char*)d_ws;
    hipLaunchKernelGGL(fwd, dim3(grid), dim3(NTHR), LDS_BYTES, stream, a);
}
```

```cpp
#include <hip/hip_runtime.h>
#include <cstdio>
#include <cstdint>

#define LAS __attribute__((address_space(3)))
#define GAS __attribute__((address_space(1)))
typedef unsigned short bf16_t;
typedef short bf16x8 __attribute__((ext_vector_type(8)));
typedef float f32x4 __attribute__((ext_vector_type(4)));
typedef float f32x2 __attribute__((ext_vector_type(2)));
typedef float f32x16 __attribute__((ext_vector_type(16)));
typedef unsigned u32x4 __attribute__((ext_vector_type(4)));
typedef unsigned u32x2 __attribute__((ext_vector_type(2)));

constexpr int D = 1024, NB = 4, SEQ = 4096, DEPTH = 4, CTX = 256;
constexpr int TL = NB * SEQ, TC = NB * CTX, T = TL + TC;
constexpr int PW = 5120, FF = 2816, NE = 8, HYW = 512;
constexpr int PQ = 0, PK = 512, PV = 1024, PHY = 1536, PGA = 3072, PGB = 4096;
constexpr float EPS = 1e-6f;

constexpr size_t MiB = 1u << 20;
constexpr size_t WS_CTL = 0, CTL_ZERO_BYTES = 1 * MiB;
constexpr size_t WS_MOD = 1 * MiB;
constexpr size_t WS_ROUTE = 2 * MiB;
constexpr size_t WS_RWT = 2 * MiB + 512 * 1024;
constexpr size_t WS_TOK = 3 * MiB;
constexpr int CW_CNT = 8192;
constexpr int MAXSLOT = 36864;
constexpr size_t WS_Y = 660 * MiB;
constexpr size_t WS_WIN = 4 * MiB;
constexpr size_t WS_WPAB = 44 * MiB;
constexpr size_t WS_WO = 52 * MiB;
constexpr size_t WS_W13D = 60 * MiB;
constexpr size_t WS_W2D = 82 * MiB;
constexpr size_t WS_W13M = 93 * MiB;
constexpr size_t WS_W2M = 269 * MiB;
constexpr size_t WS_X = 357 * MiB;
constexpr size_t WS_H = 425 * MiB;
constexpr size_t WS_P = 459 * MiB;
constexpr size_t WS_OAH = 629 * MiB;
constexpr size_t WS_B = 663 * MiB;
constexpr size_t WS_OHT = WS_B + 51 * MiB;
constexpr size_t WS_VT = 748 * MiB;
constexpr size_t WS_HRL = 816 * MiB;
constexpr size_t WS_HRC = 850 * MiB;
constexpr size_t WS_END = 853 * MiB;

constexpr int STAG = 3;
constexpr int LDS_BYTES = 147456;
constexpr int NWAVES = 8, NTHR = 512;

#define LDS_WAIT() asm volatile("s_waitcnt lgkmcnt(0)" ::: "memory")
#define VM_WAIT() asm volatile("s_waitcnt vmcnt(0)" ::: "memory")
__device__ __forceinline__ float bf2f(unsigned b) { return __uint_as_float(b << 16); }
__device__ __forceinline__ float bflo(unsigned w) { return __uint_as_float(w << 16); }
__device__ __forceinline__ float bfhi(unsigned w) { return __uint_as_float(w & 0xffff0000u); }
__device__ __forceinline__ unsigned cvt_pk_bf16(float lo, float hi) { unsigned r; asm volatile("v_cvt_pk_bf16_f32 %0, %1, %2" : "=v"(r) : "v"(lo), "v"(hi)); return r; }
__device__ __forceinline__ float wave_sum(float v, int lane) {
#pragma unroll
    for (int o = 1; o < 64; o <<= 1) v += __int_as_float(__builtin_amdgcn_ds_bpermute((lane ^ o) << 2, __float_as_int(v)));
    return v;
}
__device__ __forceinline__ float sigmoidf_(float x) { return __builtin_amdgcn_rcpf(1.f + __expf(-x)); }
__device__ __forceinline__ float sin_rev(float r) { return __builtin_amdgcn_sinf(__builtin_amdgcn_fractf(r)); }
__device__ __forceinline__ float sin_rad(float x) { return sin_rev(x * 0.15915494309189535f); }

namespace pg8 {
constexpr int BM = 256, BK = 64, HALF = 128, HTB = HALF * BK * 2, STAGE_BYTES = 8 * HTB, NXCD = 8, WGM = 8;
__host__ __device__ __forceinline__ int lds_byte(int r, int c) { const int st = (r >> 4) * 2 + (c >> 5), rr = r & 15, cc = c & 31, ob = rr * 64 + cc * 2; return st * 1024 + (ob ^ (((ob >> 9) & 1) << 5)); }
__host__ __device__ __forceinline__ void stage_rc(int b, int& R, int& C) { const int st = b / 1024, sb = b % 1024, swz = sb ^ (((sb >> 9) & 1) << 5); R = (st >> 1) * 16 + swz / 64; C = (st & 1) * 32 + (swz % 64) / 2; }
__host__ __device__ __forceinline__ int perm32(int rho) { const int n = rho >> 4, i = rho & 15; return 8 * (i >> 2) + 4 * n + (i & 3); }

struct Unit { int pm, pn; const GAS char* a; const GAS char* b; const GAS int* tk; int nvalid; };
struct Gemm { int K, lda, ldb; int stagger = 0; };

struct StaticOrder {
    int nM, nN, nwg, G, c; const GAS char* A; const GAS char* B; size_t astep, bstep;
    __device__ void init(const GAS void* A_, int lda, const GAS void* B_, int ldb, int M, int N, int G_, int c_) {
        nM = M / BM; nN = N / BM; nwg = nM * nN; G = G_; c = c_; A = (const GAS char*)A_; B = (const GAS char*)B_; astep = (size_t)BM * lda * 2; bstep = (size_t)BM * ldb * 2; }
    __device__ bool next(int i, Unit& u) const {
        const long L = (long)i * G + c; if (L >= nwg) return false;
        int wgid = (int)L; { const int q = nwg / NXCD, r = nwg % NXCD, xcd = wgid % NXCD, off = wgid / NXCD; wgid = (xcd < r ? xcd * (q + 1) : r * (q + 1) + (xcd - r) * q) + off; }
        const int nig = WGM * nN, gid = wgid / nig, fm = gid * WGM, gsz = (nM - fm) < WGM ? (nM - fm) : WGM;
        u.pm = fm + ((wgid % nig) % gsz); u.pn = (wgid % nig) / gsz; u.a = A + (size_t)u.pm * astep; u.b = B + (size_t)u.pn * bstep; return true;
    }
    static constexpr bool GATHER = false;
    __device__ __forceinline__ int arow(const Unit&, int) const { return 0; }
    __device__ __forceinline__ void a_ready(const Unit&) const {}
    __device__ __forceinline__ void done(const Unit&) const {}
};

template <class Epi, class Sched, bool ALIGN_EPI = true>
__device__ __forceinline__ void gemm_phase(LAS unsigned char* lds, const Gemm g, const Sched& S, const Epi& E) {
    int tid = threadIdx.x; asm volatile("" : "+v"(tid));
    const int wid = __builtin_amdgcn_readfirstlane(tid >> 6), lane = tid & 63, wr = wid >> 2, wc = wid & 3, fr = lane & 15, fq = lane >> 4;
    const int K = g.K, nt = K / BK;
    constexpr bool GATHER = Sched::GATHER;
    unsigned voffB[2]; unsigned cA0[2], cA1[2], nA0[2], nA1[2]; int RA[2], CA[2];
    const size_t hstepA = (size_t)HALF * g.lda * 2, hstepB = (size_t)HALF * g.ldb * 2;
#pragma unroll
    for (int i = 0; i < 2; ++i) { int R, C; stage_rc(tid * 16 + i * 8192, R, C); const int Rb = Epi::PERM ? ((R & ~31) + perm32(R & 31)) : R;
        RA[i] = R; CA[i] = C; voffB[i] = (unsigned)(Rb * g.ldb + C) * 2u;
        cA0[i] = (unsigned)(R * g.lda + C) * 2u; cA1[i] = cA0[i]; nA0[i] = cA0[i]; nA1[i] = cA0[i]; }
    const size_t h1A = GATHER ? 0 : hstepA;
    const size_t kstep = (size_t)(BK * 2);
    const unsigned ldsw = (unsigned)wid * 1024u;
    const int aoff = lds_byte(wr * 64 + fr, fq * 8), boff = lds_byte(wc * 32 + fr, fq * 8);
#define PG8_SA(b, h) (((b) * 2 + (h)) * HTB)
#define PG8_SB(b, h) ((4 + (b) * 2 + (h)) * HTB)
#define PG8_STAGE(bufoff, gbase, voff) do { _Pragma("unroll") for (int _i = 0; _i < 2; ++_i) \
        __builtin_amdgcn_global_load_lds((const GAS unsigned*)((const GAS char*)(gbase) + (voff)[_i]), (LAS unsigned*)(lds + (bufoff) + ldsw + _i * 8192), 16, 0, 0); } while (0)
#define PG8_LDA(dst, b, h) do { _Pragma("unroll") for (int m = 0; m < 4; ++m) _Pragma("unroll") for (int k = 0; k < 2; ++k) dst[m][k] = *(const LAS bf16x8*)(lds + PG8_SA(b, h) + aoff + m * 2048 + k * 1024); } while (0)
#define PG8_LDB(dst, b, h) do { _Pragma("unroll") for (int n = 0; n < 2; ++n) _Pragma("unroll") for (int k = 0; k < 2; ++k) dst[n][k] = *(const LAS bf16x8*)(lds + PG8_SB(b, h) + boff + n * 2048 + k * 1024); } while (0)
#define PG8_MMA(ai, bj, At, Bt) do { __builtin_amdgcn_s_setprio(1); _Pragma("unroll") for (int m = 0; m < 4; ++m) _Pragma("unroll") for (int n = 0; n < 2; ++n) _Pragma("unroll") for (int k = 0; k < 2; ++k) \
        acc[ai][bj][m][n] = __builtin_amdgcn_mfma_f32_16x16x32_bf16(Bt[n][k], At[m][k], acc[ai][bj][m][n], 0, 0, 0); __builtin_amdgcn_s_setprio(0); } while (0)
#define PG8_WAIT_V(n) asm volatile("s_waitcnt vmcnt(" #n ")" ::: "memory")
#define PG8_WAIT_L(n) asm volatile("s_waitcnt lgkmcnt(" #n ")" ::: "memory")
#define PG8_BAR __builtin_amdgcn_s_barrier()
#define PG8_SCHED __builtin_amdgcn_sched_barrier(0)
    Unit cur, nxt; int ui = 0;
    if (!S.next(0, cur)) return;
    if (g.stagger > 0) {
        const int slot = (blockIdx.x >> 3) & 7;
        int steps = slot * g.stagger;
        for (int i = 0; i < steps; ++i) __builtin_amdgcn_s_sleep(16);
    }
    if constexpr (GATHER) {
#pragma unroll
        for (int i = 0; i < 2; ++i) { cA0[i] = (unsigned)(S.arow(cur, RA[i]) * g.lda + CA[i]) * 2u; cA1[i] = (unsigned)(S.arow(cur, HALF + RA[i]) * g.lda + CA[i]) * 2u; }
    }
    f32x4 acc[2][2][4][2];
#pragma unroll
    for (int a = 0; a < 2; ++a)
#pragma unroll
        for (int b = 0; b < 2; ++b)
#pragma unroll
            for (int m = 0; m < 4; ++m)
#pragma unroll
                for (int n = 0; n < 2; ++n) acc[a][b][m][n] = (f32x4){0.f, 0.f, 0.f, 0.f};
    bf16x8 At[4][2], B0[2][2], B1[2][2];
    const GAS char* cA = cur.a; const GAS char* cB = cur.b;
    S.a_ready(cur);
    PG8_STAGE(PG8_SB(0, 0), cB, voffB); PG8_STAGE(PG8_SB(0, 1), cB + hstepB, voffB); PG8_STAGE(PG8_SA(0, 0), cA, cA0); PG8_STAGE(PG8_SA(0, 1), cA + h1A, cA1);
    if (wr == 1) PG8_BAR;
    PG8_WAIT_V(2); PG8_BAR;
    PG8_STAGE(PG8_SB(1, 0), cB + kstep, voffB); PG8_STAGE(PG8_SA(1, 0), cA + kstep, cA0); PG8_STAGE(PG8_SB(1, 1), cB + hstepB + kstep, voffB);
    PG8_WAIT_V(6); PG8_BAR;
    for (;;) {
        const bool has_next = S.next(ui + 1, nxt);
        const GAS char* nA = has_next ? nxt.a : cA; const GAS char* nB = has_next ? nxt.b : cB;
        if constexpr (GATHER) {
#pragma unroll
            for (int i = 0; i < 2; ++i) { nA0[i] = has_next ? (unsigned)(S.arow(nxt, RA[i]) * g.lda + CA[i]) * 2u : cA0[i]; nA1[i] = has_next ? (unsigned)(S.arow(nxt, HALF + RA[i]) * g.lda + CA[i]) * 2u : cA1[i]; }
        }
        for (int kh = 0; kh < (Epi::MIDK ? 2 : 1); ++kh) {
        const int tb = Epi::MIDK ? kh * (nt / 2) : 0, te = Epi::MIDK ? tb + nt / 2 : nt;
        for (int t = tb; t < te; t += 2) {
            const bool last = (t == nt - 2);
            const GAS char* a1 = cA + (size_t)(t + 1) * kstep;
            const GAS char* a2 = last ? nA : cA + (size_t)(t + 2) * kstep; const GAS char* b2 = last ? nB : cB + (size_t)(t + 2) * kstep;
            const GAS char* a3 = a2 + kstep; const GAS char* b3 = b2 + kstep;
            unsigned x0[2], x1[2];
#pragma unroll
            for (int i = 0; i < 2; ++i) { x0[i] = (GATHER && last) ? nA0[i] : cA0[i]; x1[i] = GATHER ? (last ? nA1[i] : cA1[i]) : cA0[i]; }
            if (last && has_next) S.a_ready(nxt);
            PG8_LDB(B0, 0, 0); PG8_LDB(B1, 0, 1); PG8_SCHED; PG8_LDA(At, 0, 0); PG8_STAGE(PG8_SA(1, 1), a1 + h1A, cA1);
            PG8_WAIT_V(8); PG8_WAIT_L(0); PG8_BAR; PG8_MMA(0, 0, At, B0); PG8_MMA(0, 1, At, B1); PG8_BAR; PG8_SCHED;
            PG8_LDA(At, 0, 1); PG8_STAGE(PG8_SB(0, 0), b2, voffB); PG8_STAGE(PG8_SB(0, 1), b2 + hstepB, voffB); PG8_STAGE(PG8_SA(0, 0), a2, x0);
            PG8_WAIT_V(8); PG8_WAIT_L(0); PG8_BAR; PG8_MMA(1, 0, At, B0); PG8_MMA(1, 1, At, B1); PG8_BAR; PG8_SCHED;
            PG8_LDB(B0, 1, 0); PG8_LDB(B1, 1, 1); PG8_SCHED; PG8_LDA(At, 1, 0); PG8_STAGE(PG8_SA(0, 1), a2 + h1A, x1);
            PG8_WAIT_V(8); PG8_WAIT_L(0); PG8_BAR; PG8_MMA(0, 0, At, B0); PG8_MMA(0, 1, At, B1); PG8_BAR; PG8_SCHED;
            PG8_LDA(At, 1, 1); PG8_STAGE(PG8_SB(1, 0), b3, voffB); PG8_STAGE(PG8_SB(1, 1), b3 + hstepB, voffB); PG8_STAGE(PG8_SA(1, 0), a3, x0);
            PG8_WAIT_V(8); PG8_WAIT_L(0); PG8_BAR; PG8_MMA(1, 0, At, B0); PG8_MMA(1, 1, At, B1); PG8_BAR; PG8_SCHED;
        }
        if constexpr (Epi::MIDK) { if (kh == 0) E.mid(acc, cur, wr, wc, fr, fq); }
        }
        if constexpr (ALIGN_EPI) { if (wr == 0) PG8_BAR; }
        E(acc, cur, wr, wc, fr, fq); S.done(cur);
        if (!has_next) break;
#pragma unroll
        for (int a = 0; a < 2; ++a)
#pragma unroll
            for (int b = 0; b < 2; ++b)
#pragma unroll
                for (int m = 0; m < 4; ++m)
#pragma unroll
                    for (int n = 0; n < 2; ++n) acc[a][b][m][n] = (f32x4){0.f, 0.f, 0.f, 0.f};
        cur = nxt; cA = nA; cB = nB; ++ui;
        if constexpr (GATHER) {
#pragma unroll
            for (int i = 0; i < 2; ++i) { cA0[i] = nA0[i]; cA1[i] = nA1[i]; }
        }
        if constexpr (ALIGN_EPI) { if (wr == 1) PG8_BAR; }
    }
    PG8_WAIT_V(0);
    if constexpr (!ALIGN_EPI) { if (wr == 0) PG8_BAR; }
    PG8_BAR;
#undef PG8_SA
#undef PG8_SB
#undef PG8_STAGE
#undef PG8_LDA
#undef PG8_LDB
#undef PG8_MMA
#undef PG8_WAIT_V
#undef PG8_WAIT_L
#undef PG8_BAR
#undef PG8_SCHED
}
}

typedef f32x4 AccT[2][2][4][2];
struct EpiStoreBf16 {
    static constexpr bool PERM = true, MIDK = false;
    GAS bf16_t* O; int ldc;
    __device__ __forceinline__ void operator()(const AccT& acc, const pg8::Unit& u, int wr, int wc, int fr, int fq) const {
        const int row0 = u.pm * 256 + wr * 64 + fr, col0 = u.pn * 256 + wc * 32 + 8 * fq;
#pragma unroll
        for (int ai = 0; ai < 2; ++ai)
#pragma unroll
            for (int m = 0; m < 4; ++m) { GAS bf16_t* rowp = O + (size_t)(row0 + ai * 128 + m * 16) * ldc + col0;
#pragma unroll
                for (int bj = 0; bj < 2; ++bj) { const f32x4 v0 = acc[ai][bj][m][0], v1 = acc[ai][bj][m][1];
                    u32x4 w; w.x = cvt_pk_bf16(v0[0], v0[1]); w.y = cvt_pk_bf16(v0[2], v0[3]); w.z = cvt_pk_bf16(v1[0], v1[1]); w.w = cvt_pk_bf16(v1[2], v1[3]);
                    *(GAS u32x4*)(rowp + bj * 128) = w; } }
    }
};
__device__ __forceinline__ float merge_ratio(float ga, float gb) { return (1.f + __expf(-fmaxf(gb, -80.f))) * __builtin_amdgcn_rcpf(1.f + __expf(-ga)); }
__device__ __forceinline__ float merge_final(float gb) { return __builtin_amdgcn_rcpf(1.f + __expf(-fmaxf(gb, -80.f))); }
struct EpiMergeK {
    static constexpr bool PERM = true, MIDK = true;
    const GAS bf16_t* P; GAS bf16_t* O;
    __device__ __forceinline__ void mid(AccT& acc, const pg8::Unit& u, int wr, int wc, int fr, int fq) const {
        asm volatile("" : "+v"(fr), "+v"(fq));
        const int row0 = u.pm * 256 + wr * 64 + fr, col0 = u.pn * 256 + wc * 32 + 8 * fq;
#pragma unroll
        for (int ai = 0; ai < 2; ++ai)
#pragma unroll
            for (int m = 0; m < 4; ++m) { const int r = row0 + ai * 128 + m * 16;
#pragma unroll
                for (int bj = 0; bj < 2; ++bj) { const int c = col0 + bj * 128;
                    const u32x4 a = *(const GAS u32x4*)(P + (size_t)r * PW + PGA + c), b = *(const GAS u32x4*)(P + (size_t)r * PW + PGB + c);
                    acc[ai][bj][m][0][0] *= merge_ratio(bflo(a.x), bflo(b.x)); acc[ai][bj][m][0][1] *= merge_ratio(bfhi(a.x), bfhi(b.x));
                    acc[ai][bj][m][0][2] *= merge_ratio(bflo(a.y), bflo(b.y)); acc[ai][bj][m][0][3] *= merge_ratio(bfhi(a.y), bfhi(b.y));
                    acc[ai][bj][m][1][0] *= merge_ratio(bflo(a.z), bflo(b.z)); acc[ai][bj][m][1][1] *= merge_ratio(bfhi(a.z), bfhi(b.z));
                    acc[ai][bj][m][1][2] *= merge_ratio(bflo(a.w), bflo(b.w)); acc[ai][bj][m][1][3] *= merge_ratio(bfhi(a.w), bfhi(b.w)); } }
    }
    __device__ __forceinline__ void operator()(const AccT& acc, const pg8::Unit& u, int wr, int wc, int fr, int fq) const {
        asm volatile("" : "+v"(fr), "+v"(fq));
        const int row0 = u.pm * 256 + wr * 64 + fr, col0 = u.pn * 256 + wc * 32 + 8 * fq;
#pragma unroll
        for (int ai = 0; ai < 2; ++ai)
#pragma unroll
            for (int m = 0; m < 4; ++m) { const int r = row0 + ai * 128 + m * 16;
#pragma unroll
                for (int bj = 0; bj < 2; ++bj) { const int c = col0 + bj * 128;
                    const u32x4 b = *(const GAS u32x4*)(P + (size_t)r * PW + PGB + c);
                    const f32x4 v0 = acc[ai][bj][m][0], v1 = acc[ai][bj][m][1];
                    u32x4 w; w.x = cvt_pk_bf16(v0[0] * merge_final(bflo(b.x)), v0[1] * merge_final(bfhi(b.x))); w.y = cvt_pk_bf16(v0[2] * merge_final(bflo(b.y)), v0[3] * merge_final(bfhi(b.y)));
                    w.z = cvt_pk_bf16(v1[0] * merge_final(bflo(b.z)), v1[1] * merge_final(bfhi(b.z))); w.w = cvt_pk_bf16(v1[2] * merge_final(bflo(b.w)), v1[3] * merge_final(bfhi(b.w)));
                    *(GAS u32x4*)(O + (size_t)r * D + c) = w; } }
    }
};
struct EpiResid {
    static constexpr bool PERM = false, MIDK = false;
    GAS float* x; const GAS float* gate;
    __device__ __forceinline__ void operator()(const AccT& acc, const pg8::Unit& u, int wr, int wc, int fr, int fq) const {
        const int row0 = u.pm * 256 + wr * 64 + fr, col0 = u.pn * 256 + wc * 32 + 4 * fq;
        const int b = (u.pm < 64) ? (u.pm >> 4) : 4;
        const GAS float* gp = gate + (size_t)b * 6144 + col0;
        f32x4 gv[2][2];
#pragma unroll
        for (int bj = 0; bj < 2; ++bj)
#pragma unroll
            for (int n = 0; n < 2; ++n) gv[bj][n] = *(const GAS f32x4*)(gp + bj * 128 + n * 16);
#pragma unroll
        for (int ai = 0; ai < 2; ++ai)
#pragma unroll
            for (int m = 0; m < 4; ++m) { const int r = row0 + ai * 128 + m * 16; GAS float* rowp = x + (size_t)r * D + col0;
#pragma unroll
                for (int bj = 0; bj < 2; ++bj)
#pragma unroll
                    for (int n = 0; n < 2; ++n) { GAS float* p = rowp + bj * 128 + n * 16; *(GAS f32x4*)p = *(const GAS f32x4*)p + gv[bj][n] * acc[ai][bj][m][n]; } }
    }
};
struct EpiSwiglu {
    static constexpr bool PERM = true, MIDK = false;
    GAS bf16_t* O;
    __device__ __forceinline__ void operator()(const AccT& acc, const pg8::Unit& u, int wr, int wc, int fr, int fq) const {
        const int row0 = u.pm * 256 + wr * 64 + fr, col0 = u.pn * 128 + wc * 32 + 8 * fq;
#pragma unroll
        for (int ai = 0; ai < 2; ++ai)
#pragma unroll
            for (int m = 0; m < 4; ++m) { const int r = row0 + ai * 128 + m * 16;
                float o[8];
#pragma unroll
                for (int n = 0; n < 2; ++n)
#pragma unroll
                    for (int j = 0; j < 4; ++j) { const float a = acc[ai][0][m][n][j], g = acc[ai][1][m][n][j]; o[n * 4 + j] = a * sigmoidf_(a) * g; }
                u32x4 w; w.x = cvt_pk_bf16(o[0], o[1]); w.y = cvt_pk_bf16(o[2], o[3]); w.z = cvt_pk_bf16(o[4], o[5]); w.w = cvt_pk_bf16(o[6], o[7]);
                *(GAS u32x4*)(O + (size_t)r * FF + col0) = w; }
    }
};

struct CEpiMergeK { const GAS bf16_t* P; GAS bf16_t* O; static constexpr bool MIDK = true;
    __device__ __forceinline__ void mid(f32x4& acc, int r, int c) const { const u32x2 a = *(const GAS u32x2*)(P + (size_t)r * PW + PGA + c), b = *(const GAS u32x2*)(P + (size_t)r * PW + PGB + c);
        acc[0] *= merge_ratio(bflo(a.x), bflo(b.x)); acc[1] *= merge_ratio(bfhi(a.x), bfhi(b.x)); acc[2] *= merge_ratio(bflo(a.y), bflo(b.y)); acc[3] *= merge_ratio(bfhi(a.y), bfhi(b.y)); }
    __device__ __forceinline__ void operator()(const f32x4& acc, int r, int c) const { const u32x2 b = *(const GAS u32x2*)(P + (size_t)r * PW + PGB + c);
        u32x2 w; w.x = cvt_pk_bf16(acc[0] * merge_final(bflo(b.x)), acc[1] * merge_final(bfhi(b.x))); w.y = cvt_pk_bf16(acc[2] * merge_final(bflo(b.y)), acc[3] * merge_final(bfhi(b.y)));
        *(GAS u32x2*)(O + (size_t)r * D + c) = w; } };
struct CEpiResid { GAS float* x; const GAS float* gate; static constexpr bool MIDK = false;
    __device__ __forceinline__ void mid(f32x4&, int, int) const {}
    __device__ __forceinline__ void operator()(const f32x4& acc, int r, int c) const { GAS float* p = x + (size_t)r * D + c; *(GAS f32x4*)p = *(const GAS f32x4*)p + *(const GAS f32x4*)(gate + c) * acc; } };
template <class Epi>
__device__ __forceinline__ void ctx_gemm(LAS unsigned char* lds, const GAS bf16_t* X, int ldx, const GAS bf16_t* Wt, int ldw, int K, const Epi& E) {
    int tid = threadIdx.x; asm volatile("" : "+v"(tid));
    const int wave = tid >> 6, lane = tid & 63, li = lane & 15, kg = lane >> 4, kp = wave >> 1, ch = wave & 1;
    LAS float* part = (LAS float*)lds;
    for (int tile = blockIdx.x; tile < 256; tile += gridDim.x) {
        const int row0 = TL + (tile >> 2) * 16, colb = (tile & 3) * 256, col0 = colb + ch * 128;
        const int kq = K >> 2, kbeg = kp * kq;
        const GAS bf16_t* xp = X + (size_t)(row0 + li) * ldx + 8 * kg + kbeg;
        const GAS bf16_t* wp = Wt + (size_t)(col0 + li) * ldw + 8 * kg + kbeg;
        f32x4 acc[8];
#pragma unroll
        for (int cb = 0; cb < 8; ++cb) acc[cb] = (f32x4){0.f, 0.f, 0.f, 0.f};
#pragma unroll 2
        for (int k0 = 0; k0 < kq; k0 += 32) {
            const bf16x8 xf = *(const GAS bf16x8*)(xp + k0);
#pragma unroll
            for (int cb = 0; cb < 8; ++cb) { const bf16x8 wf = *(const GAS bf16x8*)(wp + (size_t)(16 * cb) * ldw + k0); acc[cb] = __builtin_amdgcn_mfma_f32_16x16x32_bf16(wf, xf, acc[cb], 0, 0, 0); }
        }
        if constexpr (Epi::MIDK) { if (kp < 2) {
#pragma unroll
            for (int cb = 0; cb < 8; ++cb) E.mid(acc[cb], row0 + li, col0 + 16 * cb + 4 * kg); } }
#pragma unroll
        for (int cb = 0; cb < 8; ++cb) *(LAS f32x4*)(part + (kp * 16 + li) * 260 + ch * 128 + 16 * cb + 4 * kg) = acc[cb];
        __syncthreads();
        { const int r = tid >> 5, cc = (tid & 31) * 8;
          f32x4 o0 = (f32x4){0.f, 0.f, 0.f, 0.f}, o1 = o0;
#pragma unroll
          for (int q = 0; q < 4; ++q) { o0 += *(const LAS f32x4*)(part + (q * 16 + r) * 260 + cc); o1 += *(const LAS f32x4*)(part + (q * 16 + r) * 260 + cc + 4); }
          E(o0, row0 + r, colb + cc); E(o1, row0 + r, colb + cc + 4); }
        __syncthreads();
    }
}

struct Args { const float* in[30]; float* out; unsigned char* ws; int l, e, ph, pad; };
enum { I_X = 0, I_C, I_CTX, I_CCTX, I_WMOD, I_BMOD, I_N1G, I_N2G, I_WIN, I_RPB, I_HCW, I_HCB, I_HW1, I_HB1, I_HW2, I_HB2, I_HW3, I_HFREQ, I_HBIAS,
       I_WPA, I_WPB, I_WO, I_FW1, I_FW3, I_FW2, I_ROUTER, I_MW1, I_MW3, I_MW2, I_FINALG };

constexpr int MISC_OFF = 131072 + 320;
constexpr int PTR_OFF = MISC_OFF + 128;
struct Ctx {
    LAS unsigned char* lds; int tid, lane, wave, G, bid; GAS unsigned char* ws;
};
__device__ __forceinline__ Ctx mk_ctx(LAS unsigned char* lds, GAS unsigned char* ws) {
    Ctx c; int t = threadIdx.x; asm volatile("" : "+v"(t)); asm volatile("" : "+s"(ws)); c.lds = lds; c.tid = t; c.lane = t & 63; c.wave = __builtin_amdgcn_readfirstlane(t >> 6); c.G = gridDim.x; c.bid = blockIdx.x; c.ws = ws; return c;
}
__device__ __forceinline__ const GAS float* inp(const Ctx& c, int i) {
    unsigned ao = (unsigned)(PTR_OFF + 8 * i); asm volatile("" : "+v"(ao));
    const volatile LAS unsigned* p = (const volatile LAS unsigned*)(c.lds + ao);
    const unsigned lo = __builtin_amdgcn_readfirstlane(p[0]), hi = __builtin_amdgcn_readfirstlane(p[1]);
    return (const GAS float*)(((unsigned long long)hi << 32) | (unsigned long long)lo);
}

__device__ __forceinline__ void transpose_item(const GAS float* W, int N, GAS bf16_t* WT, int ldk, int k0, int n0, int drow0, LAS float* scr, int lane) {
    float wv[32];
    const GAS float* wp = W + (size_t)(k0 + (lane >> 5)) * N + n0 + (lane & 31);
#pragma unroll
    for (int i = 0; i < 32; ++i) wv[i] = wp[(size_t)(2 * i) * N];
#pragma unroll
    for (int i = 0; i < 32; ++i) scr[(2 * i + (lane >> 5)) * 33 + (lane & 31)] = wv[i];
    LDS_WAIT(); asm volatile("" ::: "memory");
    const int c = lane & 7;
#pragma unroll
    for (int j = 0; j < 4; ++j) { const int n = (lane >> 3) + 8 * j; const LAS float* s = scr + (8 * c) * 33 + n;
        u32x4 o; o.x = cvt_pk_bf16(s[0 * 33], s[1 * 33]); o.y = cvt_pk_bf16(s[2 * 33], s[3 * 33]); o.z = cvt_pk_bf16(s[4 * 33], s[5 * 33]); o.w = cvt_pk_bf16(s[6 * 33], s[7 * 33]);
        *(GAS u32x4*)(WT + (size_t)(drow0 + n) * ldk + k0 + 8 * c) = o; }
    LDS_WAIT(); asm volatile("" ::: "memory");
}
__device__ __forceinline__ void conv_mat(const GAS float* W, int K, int N, GAS bf16_t* WT, int mode, int& base, int gw, int NGW, LAS float* scr, int lane, int ldk = 0) {
    if (ldk == 0) ldk = K;
    const int nblk = N / 32, nitems = (K / 64) * nblk;
    const int start = (gw - (base % NGW) + NGW) % NGW;
    for (int it = start; it < nitems; it += NGW) {
        const int kb = it / nblk, nb = it % nblk, n0 = nb * 32;
        const int drow0 = mode == 0 ? n0 : ((n0 >> 7) * 256 + (n0 & 127) + (mode == 2 ? 128 : 0));
        transpose_item(W, N, WT, ldk, kb * 64, n0, drow0, scr, lane);
    }
    base += nitems;
}
__device__ __forceinline__ void ph_convert(const Ctx& c0) {
    const Ctx c = mk_ctx(c0.lds, c0.ws);
    GAS unsigned char* ws = c.ws;
    LAS float* scr = (LAS float*)(c.lds + c.wave * 16384);
    const int gw = c.bid * NWAVES + c.wave, NGW = c.G * NWAVES; int base = 0;
    for (int l = 0; l < DEPTH; ++l) {
        conv_mat(inp(c, I_WIN) + (size_t)l * D * PW, D, PW, (GAS bf16_t*)(ws + WS_WIN) + (size_t)l * PW * D, 0, base, gw, NGW, scr, c.lane);
        conv_mat(inp(c, I_WPA) + (size_t)l * 512 * D, 512, D, (GAS bf16_t*)(ws + WS_WPAB) + (size_t)l * D * D, 0, base, gw, NGW, scr, c.lane, D);
        conv_mat(inp(c, I_WPB) + (size_t)l * 512 * D, 512, D, (GAS bf16_t*)(ws + WS_WPAB) + (size_t)l * D * D + 512, 0, base, gw, NGW, scr, c.lane, D);
        conv_mat(inp(c, I_WO) + (size_t)l * D * D, D, D, (GAS bf16_t*)(ws + WS_WO) + (size_t)l * D * D, 0, base, gw, NGW, scr, c.lane);
    }
    for (int i = 0; i < 2; ++i) {
        conv_mat(inp(c, I_FW1) + (size_t)i * D * FF, D, FF, (GAS bf16_t*)(ws + WS_W13D) + (size_t)i * 2 * FF * D, 1, base, gw, NGW, scr, c.lane);
        conv_mat(inp(c, I_FW3) + (size_t)i * D * FF, D, FF, (GAS bf16_t*)(ws + WS_W13D) + (size_t)i * 2 * FF * D, 2, base, gw, NGW, scr, c.lane);
        conv_mat(inp(c, I_FW2) + (size_t)i * FF * D, FF, D, (GAS bf16_t*)(ws + WS_W2D) + (size_t)i * D * FF, 0, base, gw, NGW, scr, c.lane);
    }
    for (int ie = 0; ie < 2 * NE; ++ie) {
        conv_mat(inp(c, I_MW1) + (size_t)ie * D * FF, D, FF, (GAS bf16_t*)(ws + WS_W13M) + (size_t)ie * 2 * FF * D, 1, base, gw, NGW, scr, c.lane);
        conv_mat(inp(c, I_MW3) + (size_t)ie * D * FF, D, FF, (GAS bf16_t*)(ws + WS_W13M) + (size_t)ie * 2 * FF * D, 2, base, gw, NGW, scr, c.lane);
        conv_mat(inp(c, I_MW2) + (size_t)ie * FF * D, FF, D, (GAS bf16_t*)(ws + WS_W2M) + (size_t)ie * D * FF, 0, base, gw, NGW, scr, c.lane);
    }
}

__device__ __forceinline__ void ph_mod(const Ctx& c0) {
    const Ctx c = mk_ctx(c0.lds, c0.ws);
    GAS float* mod = (GAS float*)(c.ws + WS_MOD);
    LAS float* s = (LAS float*)c.lds; LAS float* part = s + 5 * 1024;
    const GAS float* cin = inp(c, I_C); const GAS float* cctx = inp(c, I_CCTX); const GAS float* wmod = inp(c, I_WMOD); const GAS float* bmod = inp(c, I_BMOD);
    for (int i = c.tid; i < 5 * 1024; i += NTHR) { const int r = i >> 10, k = i & 1023; const float v = r < 4 ? cin[r * 1024 + k] : cctx[k]; s[i] = v * sigmoidf_(v); }
    __syncthreads();
    for (int unit = c.bid; unit < DEPTH * 96; unit += c.G) {
        const int l = unit / 96, j0 = (unit % 96) * 64;
        const GAS float* w = wmod + (size_t)l * D * 6144 + j0 + c.lane;
        float acc[5] = {0.f, 0.f, 0.f, 0.f, 0.f};
        const int kb = c.wave * 128;
#pragma unroll 32
        for (int k = 0; k < 128; ++k) { const float wv = w[(size_t)(kb + k) * 6144];
#pragma unroll
            for (int r = 0; r < 5; ++r) acc[r] += s[r * 1024 + kb + k] * wv; }
#pragma unroll
        for (int r = 0; r < 5; ++r) part[(c.wave * 5 + r) * 64 + c.lane] = acc[r];
        __syncthreads();
        if (c.tid < 320) { const int r = c.tid >> 6, ln = c.tid & 63; float sum = 0.f;
#pragma unroll
            for (int w8 = 0; w8 < 8; ++w8) sum += part[(w8 * 5 + r) * 64 + ln];
            mod[(size_t)(l * 5 + r) * 6144 + j0 + ln] = sum + bmod[l * 6144 + j0 + ln]; }
        __syncthreads();
    }
}

__device__ __forceinline__ void ph_filt(const Ctx& c0) {
    const Ctx c = mk_ctx(c0.lds, c0.ws);
    const GAS float* hb1 = inp(c, I_HB1); const GAS float* hw1 = inp(c, I_HW1); const GAS float* hb2 = inp(c, I_HB2); const GAS float* hw2 = inp(c, I_HW2); const GAS float* hfreq = inp(c, I_HFREQ); const GAS float* hw3 = inp(c, I_HW3);
    LAS float* zb = (LAS float*)c.lds;
    LAS float* a1 = zb + 16 * 36;
    LAS float* a2 = a1 + 16 * 64;
    const float MINDEC = -3.0701134573253945f, MAXDEC = -15.350567286626973f;
    for (int unit = c.bid; unit < DEPTH * 272; unit += c.G) {
        const int l = unit / 272, uu = unit % 272;
        const int L = uu < 256 ? 4096 : 256, p0 = uu < 256 ? uu * 16 : (uu - 256) * 16;
        for (int i = c.tid; i < 16 * 33; i += NTHR) { const int p = i / 33, q = i % 33; const int pos = p0 + p; float v;
            if (q == 0) v = (float)pos / (float)(L - 1);
            else { const int j = (q - 1) & 15; const double band = 1e-4 + (double)j * ((15.0 - 1e-4) / 15.0); double rev = (double)pos * band / (double)L; rev -= floor(rev);
                v = q <= 16 ? __builtin_amdgcn_cosf((float)rev) : -__builtin_amdgcn_sinf((float)rev); }
            zb[p * 36 + q] = v; }
        __syncthreads();
        for (int i = c.tid; i < 16 * 64; i += NTHR) { const int p = i >> 6, j = i & 63; float s = hb1[l * 64 + j];
            const GAS float* w = hw1 + (size_t)l * 33 * 64 + j;
            for (int q = 0; q < 33; ++q) s += zb[p * 36 + q] * w[q * 64];
            a1[p * 64 + j] = sin_rad(hfreq[l * 128 + j] * s); }
        __syncthreads();
        for (int i = c.tid; i < 16 * 64; i += NTHR) { const int p = i >> 6, j = i & 63; float s = hb2[l * 64 + j];
            const GAS float* w = hw2 + (size_t)l * 64 * 64 + j;
            for (int q = 0; q < 64; ++q) s += a1[p * 64 + q] * w[q * 64];
            a2[p * 64 + j] = sin_rad(hfreq[l * 128 + 64 + j] * s); }
        __syncthreads();
        {
            float acc0[16], acc1[16];
#pragma unroll
            for (int p = 0; p < 16; ++p) { acc0[p] = 0.f; acc1[p] = 0.f; }
            const GAS float* w3 = hw3 + (size_t)l * 64 * 1024 + c.tid;
            for (int k = 0; k < 64; k += 4) { float wa[4], wb[4];
#pragma unroll
                for (int q = 0; q < 4; ++q) { wa[q] = w3[(k + q) * 1024]; wb[q] = w3[(k + q) * 1024 + 512]; }
#pragma unroll
                for (int p = 0; p < 16; ++p) { const f32x4 av = *(const LAS f32x4*)(a2 + p * 64 + k);
#pragma unroll
                    for (int q = 0; q < 4; ++q) { acc0[p] += av[q] * wa[q]; acc1[p] += av[q] * wb[q]; } } }
            GAS bf16_t* hro = uu < 256 ? (GAS bf16_t*)(c.ws + WS_HRL) + ((size_t)(l * 2) * 512 + c.tid) * (4096 + 64) : (GAS bf16_t*)(c.ws + WS_HRC) + ((size_t)(l * 2) * 512 + c.tid) * (256 + 64);
            const size_t ostride = (size_t)512 * (L + 64);
            float f0[16], f1[16];
            const float r0 = fabsf(MINDEC + (float)c.tid * ((MAXDEC - MINDEC) / 1023.f)), r1 = fabsf(MINDEC + (float)(c.tid + 512) * ((MAXDEC - MINDEC) / 1023.f));
#pragma unroll
            for (int p = 0; p < 16; ++p) { const int pos = p0 + p; const float dist = fabsf((float)(pos - L / 2)) * (2.f / (float)L);
                f0[p] = acc0[p] * (__expf(-dist * r0) + 0.05f); f1[p] = acc1[p] * (__expf(-dist * r1) + 0.05f); }
            {   u32x4 w0, w1, v0, v1;
                w0.x = cvt_pk_bf16(f0[15], f0[14]); w0.y = cvt_pk_bf16(f0[13], f0[12]); w0.z = cvt_pk_bf16(f0[11], f0[10]); w0.w = cvt_pk_bf16(f0[9], f0[8]);
                w1.x = cvt_pk_bf16(f0[7], f0[6]); w1.y = cvt_pk_bf16(f0[5], f0[4]); w1.z = cvt_pk_bf16(f0[3], f0[2]); w1.w = cvt_pk_bf16(f0[1], f0[0]);
                v0.x = cvt_pk_bf16(f1[15], f1[14]); v0.y = cvt_pk_bf16(f1[13], f1[12]); v0.z = cvt_pk_bf16(f1[11], f1[10]); v0.w = cvt_pk_bf16(f1[9], f1[8]);
                v1.x = cvt_pk_bf16(f1[7], f1[6]); v1.y = cvt_pk_bf16(f1[5], f1[4]); v1.z = cvt_pk_bf16(f1[3], f1[2]); v1.w = cvt_pk_bf16(f1[1], f1[0]);
                GAS bf16_t* d0 = hro + (L + 16 - p0); GAS bf16_t* d1 = d0 + ostride;
                *(GAS u32x4*)d0 = w0; *(GAS u32x4*)(d0 + 8) = w1; *(GAS u32x4*)d1 = v0; *(GAS u32x4*)(d1 + 8) = v1;
                const u32x4 z4 = (u32x4){0u, 0u, 0u, 0u};
                if (p0 == 0) { for (int k = 0; k < 4; ++k) { *(GAS u32x4*)(hro + L + 32 + 8 * k) = z4; *(GAS u32x4*)(hro + ostride + L + 32 + 8 * k) = z4; } }
                if (p0 == L - 16) { for (int k = 0; k < 4; ++k) { *(GAS u32x4*)(hro + 8 * k) = z4; *(GAS u32x4*)(hro + ostride + 8 * k) = z4; } } }
        }
        __syncthreads();
    }
}

struct MoeComb { const GAS int* route; const GAS float* rwt; const GAS bf16_t* y; const GAS float* gate; };
__device__ __forceinline__ void moe_combine_row(const MoeComb& mc, const LAS unsigned* offs, int row, int b, int lane, f32x4 (&v)[4]) {
    const int e1 = mc.route[(size_t)row * 4 + 0], p1 = mc.route[(size_t)row * 4 + 1], e2 = mc.route[(size_t)row * 4 + 2], p2 = mc.route[(size_t)row * 4 + 3];
    const float w1 = mc.rwt[(size_t)row * 2], w2 = mc.rwt[(size_t)row * 2 + 1];
    const size_t s1 = (size_t)offs[e1] + p1, s2 = (size_t)offs[e2] + p2;
    const GAS float* gt = mc.gate + (size_t)b * 6144;
#pragma unroll
    for (int j = 0; j < 4; ++j) { const int k0 = 4 * (lane + 64 * j);
        const u32x2 a = *(const GAS u32x2*)(mc.y + s1 * D + k0), bq = *(const GAS u32x2*)(mc.y + s2 * D + k0); const f32x4 g4 = *(const GAS f32x4*)(gt + k0);
        v[j][0] += g4[0] * (w1 * bflo(a.x) + w2 * bflo(bq.x)); v[j][1] += g4[1] * (w1 * bfhi(a.x) + w2 * bfhi(bq.x));
        v[j][2] += g4[2] * (w1 * bflo(a.y) + w2 * bflo(bq.y)); v[j][3] += g4[3] * (w1 * bfhi(a.y) + w2 * bfhi(bq.y)); }
}
__device__ __forceinline__ void moe_offsets(const Ctx& c, int i, LAS unsigned* offs) {
    if (c.tid == 0) { const GAS unsigned* cnt = (const GAS unsigned*)(c.ws + WS_CTL) + CW_CNT + 64 * i; unsigned o = 0;
        for (int e = 0; e < 8; ++e) { offs[e] = o; o += (cnt[e] + 255u) & ~255u; } offs[8] = o; }
}
__device__ __forceinline__ void ph_norm(const Ctx& c0, int l, int which) {
    const Ctx c = mk_ctx(c0.lds, c0.ws);
    GAS float* xres = (GAS float*)(c.ws + WS_X); GAS bf16_t* h = (GAS bf16_t*)(c.ws + WS_H);
    const GAS float* mod = (const GAS float*)(c.ws + WS_MOD) + (size_t)l * 5 * 6144;
    const GAS float* gp = (which == 0 ? inp(c, I_N1G) : inp(c, I_N2G)) + l * D;
    const bool first = (l == 0 && which == 0), route = (which == 1 && (l & 1));
    const int comb = (which == 0 && l >= 1 && ((l - 1) & 1)) ? ((l - 1) >> 1) : -1;
    const GAS float* router = inp(c, I_ROUTER) + (size_t)(l >> 1) * D * NE;
    GAS int* routeb = (GAS int*)(c.ws + WS_ROUTE); GAS float* rwt = (GAS float*)(c.ws + WS_RWT); GAS int* tokenof = (GAS int*)(c.ws + WS_TOK);
    const MoeComb mc{routeb, rwt, (const GAS bf16_t*)(c.ws + WS_Y), (const GAS float*)(c.ws + WS_MOD) + (size_t)(l > 0 ? l - 1 : 0) * 5 * 6144 + 5 * 1024};
    LAS unsigned* lcnt = (LAS unsigned*)c.lds; LAS unsigned* gbase = lcnt + 16; LAS unsigned* offs = lcnt + 32; LAS int* pend = (LAS int*)(c.lds + 256);
    if (c.tid < 8) lcnt[c.tid] = 0u;
    if (comb >= 0) moe_offsets(c, comb, offs);
    LAS float* rlds = (LAS float*)(c.lds + 4096);
    if (route) { for (int i = c.tid; i < D * NE / 4; i += NTHR) *(LAS f32x4*)(rlds + 4 * i) = *(const GAS f32x4*)(router + 4 * i); }
    LAS float* gsl = (LAS float*)(c.lds + 40960); LAS float* shl = gsl + 5 * 1024;
    for (int i = c.tid; i < 5 * 256; i += NTHR) { const int bb = i >> 8, k0 = (i & 255) * 4; const GAS float* shp = mod + (size_t)bb * 6144 + (which == 0 ? 0 : 3) * 1024;
        const f32x4 g4 = *(const GAS f32x4*)(gp + k0), s4 = *(const GAS f32x4*)(shp + 1024 + k0), h4 = *(const GAS f32x4*)(shp + k0);
        *(LAS f32x4*)(gsl + bb * 1024 + k0) = g4 * (s4 + 1.f); *(LAS f32x4*)(shl + bb * 1024 + k0) = h4; }
    __syncthreads();
    const GAS float* xin = inp(c, I_X); const GAS float* ctxin = inp(c, I_CTX);
    int nrows = 0;
    const int nrow_all = (which == 1 && l == DEPTH - 1) ? TL : T;
#define NORM_SRC(rw) (first ? ((rw) < TL ? xin + (size_t)(rw) * D : ctxin + (size_t)((rw) - TL) * D) : xres + (size_t)(rw) * D)
    const int rstride = c.G * NWAVES;
    f32x4 vnx[4];
    { const int row = c.bid * NWAVES + c.wave; if (row < nrow_all) { const GAS float* src = NORM_SRC(row);
#pragma unroll
        for (int j = 0; j < 4; ++j) vnx[j] = *(const GAS f32x4*)(src + 4 * (c.lane + 64 * j)); } }
    for (int row = c.bid * NWAVES + c.wave; row < nrow_all; row += rstride, ++nrows) {
        const int b = row < TL ? (row >> 12) : 4;
        f32x4 v[4]; float ss = 0.f;
#pragma unroll
        for (int j = 0; j < 4; ++j) v[j] = vnx[j];
        if (row + rstride < nrow_all) { const GAS float* srcn = NORM_SRC(row + rstride);
#pragma unroll
            for (int j = 0; j < 4; ++j) vnx[j] = *(const GAS f32x4*)(srcn + 4 * (c.lane + 64 * j)); }
        if (comb >= 0) moe_combine_row(mc, offs, row, b, c.lane, v);
#pragma unroll
        for (int j = 0; j < 4; ++j) ss += (v[j][0] * v[j][0] + v[j][1] * v[j][1]) + (v[j][2] * v[j][2] + v[j][3] * v[j][3]);
        ss = wave_sum(ss, c.lane);
        const float rstd = 1.f / sqrtf(ss * (1.f / D) + EPS);
        if (first || comb >= 0) {
#pragma unroll
            for (int j = 0; j < 4; ++j) *(GAS f32x4*)(xres + (size_t)row * D + 4 * (c.lane + 64 * j)) = v[j];
        }
        float lg[8] = {0.f, 0.f, 0.f, 0.f, 0.f, 0.f, 0.f, 0.f};
#pragma unroll
        for (int j = 0; j < 4; ++j) { const int k0 = 4 * (c.lane + 64 * j);
            const f32x4 g4 = *(const LAS f32x4*)(gsl + b * 1024 + k0), h4 = *(const LAS f32x4*)(shl + b * 1024 + k0);
            f32x4 o;
#pragma unroll
            for (int q = 0; q < 4; ++q) o[q] = v[j][q] * rstd * g4[q] + h4[q];
            u32x2 w; w.x = cvt_pk_bf16(o[0], o[1]); w.y = cvt_pk_bf16(o[2], o[3]);
            *(GAS u32x2*)(h + (size_t)row * D + k0) = w;
            if (route) {
#pragma unroll
                for (int q = 0; q < 4; ++q) { const f32x4 ra = *(const LAS f32x4*)(rlds + (k0 + q) * 8), rb = *(const LAS f32x4*)(rlds + (k0 + q) * 8 + 4);
                    lg[0] += o[q] * ra[0]; lg[1] += o[q] * ra[1]; lg[2] += o[q] * ra[2]; lg[3] += o[q] * ra[3];
                    lg[4] += o[q] * rb[0]; lg[5] += o[q] * rb[1]; lg[6] += o[q] * rb[2]; lg[7] += o[q] * rb[3]; }
            }
        }
        if (route) {
#pragma unroll
            for (int e = 0; e < 8; ++e) lg[e] = wave_sum(lg[e], c.lane);
            int i1 = 0; float v1 = lg[0];
#pragma unroll
            for (int e = 1; e < 8; ++e) if (lg[e] > v1) { v1 = lg[e]; i1 = e; }
            int i2 = -1; float v2 = -3.0e38f;
#pragma unroll
            for (int e = 0; e < 8; ++e) if (e != i1 && lg[e] > v2) { v2 = lg[e]; i2 = e; }
            const float w1 = 1.f / (1.f + __expf(v2 - v1)), w2 = 1.f - w1;
            if (c.lane == 0) {
                const unsigned lp1 = __hip_atomic_fetch_add(lcnt + i1, 1u, __ATOMIC_RELAXED, __HIP_MEMORY_SCOPE_WORKGROUP), lp2 = __hip_atomic_fetch_add(lcnt + i2, 1u, __ATOMIC_RELAXED, __HIP_MEMORY_SCOPE_WORKGROUP);
                LAS int* pe = pend + (c.wave * 16 + nrows) * 4; pe[0] = row; pe[1] = i1 | (i2 << 8); pe[2] = (int)lp1; pe[3] = (int)lp2;
                rwt[(size_t)row * 2] = w1; rwt[(size_t)row * 2 + 1] = w2; }
        }
    }
    if (route) {
        __syncthreads();
        if (c.tid < 8) gbase[c.tid] = __hip_atomic_fetch_add((GAS unsigned*)(c.ws + WS_CTL) + CW_CNT + 64 * (l >> 1) + c.tid, lcnt[c.tid], __ATOMIC_RELAXED, __HIP_MEMORY_SCOPE_AGENT);
        __syncthreads();
        if (c.lane < nrows) { const LAS int* pe = pend + (c.wave * 16 + c.lane) * 4; const int row = pe[0], e1 = pe[1] & 255, e2 = pe[1] >> 8;
            const int p1 = (int)gbase[e1] + pe[2], p2 = (int)gbase[e2] + pe[3];
            tokenof[(size_t)e1 * T + p1] = row; tokenof[(size_t)e2 * T + p2] = row;
            routeb[(size_t)row * 4 + 0] = e1; routeb[(size_t)row * 4 + 1] = p1; routeb[(size_t)row * 4 + 2] = e2; routeb[(size_t)row * 4 + 3] = p2; }
    }
    __syncthreads();
}

__device__ __forceinline__ void ph_sc(const Ctx& c0, int l) {
    const Ctx c = mk_ctx(c0.lds, c0.ws);
    const GAS bf16_t* P = (const GAS bf16_t*)(c.ws + WS_P); GAS bf16_t* uT = (GAS bf16_t*)(c.ws + WS_B); GAS bf16_t* VT = (GAS bf16_t*)(c.ws + WS_VT);
    const GAS float* cw = inp(c, I_HCW) + (size_t)l * 3 * 1536; const GAS float* cb = inp(c, I_HCB) + (size_t)l * 1536;
    LAS unsigned char* scr = c.lds + c.wave * 16384;
    for (int tile = c.bid * NWAVES + c.wave; tile < (T / 64) * 32; tile += c.G * NWAVES) {
        const int rt = tile / 32, row0 = rt * 64, ct = tile % 32; const bool isv = ct >= 24;
        const int ch0 = isv ? (ct - 24) * 64 : ct * 64, scol = isv ? PV + ch0 : PHY + ch0; GAS bf16_t* dst = isv ? VT : uT;
        const int tpos = row0 < TL ? (row0 & 4095) : ((row0 - TL) & 255), Ls = row0 < TL ? 4096 : 256;
        for (int idx = c.lane; idx < 66 * 8; idx += 64) { const int rr = idx >> 3, ck = idx & 7; const int grow = row0 - 1 + rr;
            const bool ok = !((rr == 0 && tpos == 0) || (rr == 65 && tpos + 64 == Ls));
            u32x4 v = (u32x4){0u, 0u, 0u, 0u};
            if (ok) v = *(const GAS u32x4*)(P + (size_t)grow * PW + scol + ck * 8);
            LAS unsigned* d = (LAS unsigned*)(scr + rr * 132 + ck * 16); d[0] = v.x; d[1] = v.y; d[2] = v.z; d[3] = v.w; }
        LDS_WAIT(); asm volatile("" ::: "memory");
        const int ch = ch0 + c.lane; const float w0 = isv ? 0.f : cw[ch], w1 = isv ? 1.f : cw[1536 + ch], w2 = isv ? 0.f : cw[3072 + ch], bb = isv ? 0.f : cb[ch];
        unsigned ow[32];
        { float prev = bf2f(*(const LAS unsigned short*)(scr + 0 * 132 + c.lane * 2)), cur = bf2f(*(const LAS unsigned short*)(scr + 1 * 132 + c.lane * 2)); float o0 = 0.f;
#pragma unroll
          for (int r = 0; r < 64; ++r) { const float nxt = bf2f(*(const LAS unsigned short*)(scr + (r + 2) * 132 + c.lane * 2));
              const float o = w0 * prev + w1 * cur + w2 * nxt + bb; prev = cur; cur = nxt;
              if (r & 1) ow[r >> 1] = cvt_pk_bf16(o0, o); else o0 = o; } }
        LDS_WAIT(); asm volatile("" ::: "memory");
#pragma unroll
        for (int k = 0; k < 8; ++k) { u32x4 v; v.x = ow[4 * k]; v.y = ow[4 * k + 1]; v.z = ow[4 * k + 2]; v.w = ow[4 * k + 3]; *(LAS u32x4*)(scr + c.lane * 144 + k * 16) = v; }
        LDS_WAIT(); asm volatile("" ::: "memory");
#pragma unroll
        for (int k = 0; k < 8; ++k) { const int cc = (c.lane >> 3) + 8 * k, ck = c.lane & 7; const u32x4 v = *(const LAS u32x4*)(scr + cc * 144 + ck * 16);
            *(GAS u32x4*)(dst + (size_t)(ch0 + cc) * T + row0 + ck * 8) = v; }
        LDS_WAIT(); asm volatile("" ::: "memory");
    }
}

constexpr int HY_HR_OFF = 512, HY_U_OFF = HY_HR_OFF + 66560, HY_ZB_OFF = HY_U_OFF + 4 * 8208;
template <int L, bool DUAL>
__device__ __forceinline__ void hy_span(LAS unsigned char* lds, int nsteps, int aaddr, int ubase, int sX, int sY, f32x16& accX, f32x16& accY) {
#define HY_BADDR(sv) (((unsigned)(sv) <= (unsigned)(L - 16)) ? ubase + 2 * (sv) : HY_ZB_OFF)
    int k = 0;
    for (; k + 4 <= nsteps; k += 4) {
        const int pa = aaddr - 768;
        const int px0 = HY_BADDR(sX), px1 = HY_BADDR(sX - 16), px2 = HY_BADDR(sX - 32), px3 = HY_BADDR(sX - 48);
        bf16x8 a0, a1, a2, a3, x0, x1, x2, x3;
        if (DUAL) {
            const int py0 = HY_BADDR(sY), py1 = HY_BADDR(sY - 16), py2 = HY_BADDR(sY - 32), py3 = HY_BADDR(sY - 48);
            bf16x8 y0, y1, y2, y3;
            asm volatile(
                "ds_read_b128 %[a0], %[pa] offset:768\n\tds_read_b128 %[x0], %[px0]\n\tds_read_b128 %[y0], %[py0]\n\t"
                "ds_read_b128 %[a1], %[pa] offset:512\n\tds_read_b128 %[x1], %[px1]\n\tds_read_b128 %[y1], %[py1]\n\t"
                "ds_read_b128 %[a2], %[pa] offset:256\n\tds_read_b128 %[x2], %[px2]\n\tds_read_b128 %[y2], %[py2]\n\t"
                "ds_read_b128 %[a3], %[pa]\n\tds_read_b128 %[x3], %[px3]\n\tds_read_b128 %[y3], %[py3]\n\t"
                "s_waitcnt lgkmcnt(9)\n\tv_mfma_f32_32x32x16_bf16 %[cx], %[a0], %[x0], %[cx]\n\tv_mfma_f32_32x32x16_bf16 %[cy], %[a0], %[y0], %[cy]\n\t"
                "s_waitcnt lgkmcnt(6)\n\tv_mfma_f32_32x32x16_bf16 %[cx], %[a1], %[x1], %[cx]\n\tv_mfma_f32_32x32x16_bf16 %[cy], %[a1], %[y1], %[cy]\n\t"
                "s_waitcnt lgkmcnt(3)\n\tv_mfma_f32_32x32x16_bf16 %[cx], %[a2], %[x2], %[cx]\n\tv_mfma_f32_32x32x16_bf16 %[cy], %[a2], %[y2], %[cy]\n\t"
                "s_waitcnt lgkmcnt(0)\n\tv_mfma_f32_32x32x16_bf16 %[cx], %[a3], %[x3], %[cx]\n\tv_mfma_f32_32x32x16_bf16 %[cy], %[a3], %[y3], %[cy]\n\t"
                : [cx] "+v"(accX), [cy] "+v"(accY), [a0] "=&v"(a0), [a1] "=&v"(a1), [a2] "=&v"(a2), [a3] "=&v"(a3), [x0] "=&v"(x0), [x1] "=&v"(x1), [x2] "=&v"(x2), [x3] "=&v"(x3),
                  [y0] "=&v"(y0), [y1] "=&v"(y1), [y2] "=&v"(y2), [y3] "=&v"(y3)
                : [pa] "v"(pa), [px0] "v"(px0), [px1] "v"(px1), [px2] "v"(px2), [px3] "v"(px3), [py0] "v"(py0), [py1] "v"(py1), [py2] "v"(py2), [py3] "v"(py3));
        } else {
            asm volatile(
                "ds_read_b128 %[a0], %[pa] offset:768\n\tds_read_b128 %[x0], %[px0]\n\t"
                "ds_read_b128 %[a1], %[pa] offset:512\n\tds_read_b128 %[x1], %[px1]\n\t"
                "ds_read_b128 %[a2], %[pa] offset:256\n\tds_read_b128 %[x2], %[px2]\n\t"
                "ds_read_b128 %[a3], %[pa]\n\tds_read_b128 %[x3], %[px3]\n\t"
                "s_waitcnt lgkmcnt(6)\n\tv_mfma_f32_32x32x16_bf16 %[cx], %[a0], %[x0], %[cx]\n\t"
                "s_waitcnt lgkmcnt(4)\n\tv_mfma_f32_32x32x16_bf16 %[cx], %[a1], %[x1], %[cx]\n\t"
                "s_waitcnt lgkmcnt(2)\n\tv_mfma_f32_32x32x16_bf16 %[cx], %[a2], %[x2], %[cx]\n\t"
                "s_waitcnt lgkmcnt(0)\n\tv_mfma_f32_32x32x16_bf16 %[cx], %[a3], %[x3], %[cx]\n\t"
                : [cx] "+v"(accX), [a0] "=&v"(a0), [a1] "=&v"(a1), [a2] "=&v"(a2), [a3] "=&v"(a3), [x0] "=&v"(x0), [x1] "=&v"(x1), [x2] "=&v"(x2), [x3] "=&v"(x3)
                : [pa] "v"(pa), [px0] "v"(px0), [px1] "v"(px1), [px2] "v"(px2), [px3] "v"(px3));
        }
        aaddr -= 1024; sX -= 64; sY -= 64;
    }
    for (; k < nsteps; ++k) {
        const bf16x8 af = *(const LAS bf16x8*)(lds + aaddr), xf = *(const LAS bf16x8*)(lds + HY_BADDR(sX));
        accX = __builtin_amdgcn_mfma_f32_32x32x16_bf16(af, xf, accX, 0, 0, 0);
        if (DUAL) { const bf16x8 yf = *(const LAS bf16x8*)(lds + HY_BADDR(sY)); accY = __builtin_amdgcn_mfma_f32_32x32x16_bf16(af, yf, accY, 0, 0, 0); }
        aaddr -= 256; sX -= 16; sY -= 16;
    }
#undef HY_BADDR
}
template <int L>
__device__ __forceinline__ void hy_unit(const Ctx& c, int l, int ch, const GAS float* hbias) {
    constexpr int H = L / 2, NG = L / 256, LP = L + 64, NW = L / 8 + 8, ROWB = 2 * L + 16;
    LAS unsigned char* lds = c.lds;
    const GAS bf16_t* uT = (const GAS bf16_t*)(c.ws + WS_B); GAS bf16_t* oht = (GAS bf16_t*)(c.ws + WS_OHT);
    const int seq0 = (L == 4096) ? 0 : TL;
    const GAS bf16_t* hrbase = (L == 4096) ? (const GAS bf16_t*)(c.ws + WS_HRL) : (const GAS bf16_t*)(c.ws + WS_HRC);
    int gA, gB;
    if (NG == 16) { gA = c.wave < 4 ? c.wave : 4 + c.wave; gB = c.wave < 4 ? 7 - c.wave : 19 - c.wave; } else { gA = c.wave == 0 ? 0 : -1; gB = -1; }
    const int n = c.lane & 31, g = c.lane >> 5, tbl = n >> 2, b = n & 3;
    const int loA = gA < 0 ? 1 << 30 : max(-H - 16, 256 * gA - (L - 16)), hiA = gA < 0 ? -(1 << 30) : min(H, 256 * gA + 224);
    const int loB = gB < 0 ? 1 << 30 : max(-H - 16, 256 * gB - (L - 16)), hiB = gB < 0 ? -(1 << 30) : min(H, 256 * gB + 224);
    const int dlo = min(loA, loB), dhi = max(hiA, hiB);
    unsigned zreg[2][4][2];
    u32x4 fwA[2], fwB[2];
#define HY_LOAD_FW(oo) do { const GAS bf16_t* hr_ = hrbase + ((size_t)(l * 2 + (oo)) * 512 + ch) * LP; _Pragma("unroll") for (int k_ = 0; k_ < 2; ++k_) { const int w_ = c.tid + NTHR * k_; \
        const int wc_ = w_ < NW ? w_ : 0; fwA[k_] = *(const GAS u32x4*)(hr_ + 8 * (wc_ > 0 ? wc_ - 1 : 0)); fwB[k_] = *(const GAS u32x4*)(hr_ + 8 * wc_); } } while (0)
    HY_LOAD_FW(0);
    for (int o = 0; o < 2; ++o) {
#pragma unroll
        for (int kf = 0; kf < 2; ++kf) { const int w = c.tid + NTHR * kf; if (w < NW) {
            const u32x4 A4 = w > 0 ? fwA[kf] : (u32x4){0u, 0u, 0u, 0u}, B4 = fwB[kf];
            const unsigned Dd[8] = {A4.x, A4.y, A4.z, A4.w, B4.x, B4.y, B4.z, B4.w};
#pragma unroll
            for (int q = 0; q < 8; ++q) { u32x4 ov;
                if ((q & 1) == 0) { const int j = (8 - q) / 2; ov.x = Dd[j]; ov.y = Dd[j + 1]; ov.z = Dd[j + 2]; ov.w = Dd[j + 3]; }
                else { const int j = (7 - q) / 2; ov.x = __builtin_amdgcn_alignbit(Dd[j + 1], Dd[j], 16); ov.y = __builtin_amdgcn_alignbit(Dd[j + 2], Dd[j + 1], 16);
                       ov.z = __builtin_amdgcn_alignbit(Dd[j + 3], Dd[j + 2], 16); ov.w = __builtin_amdgcn_alignbit(Dd[j + 4], Dd[j + 3], 16); }
                *(LAS u32x4*)(lds + HY_HR_OFF + (8 * w + q) * 16) = ov; }
        } }
        if (o == 0) {
            for (int idx = c.tid; idx < 4 * (L / 8); idx += NTHR) { const int bb = idx / (L / 8), wq = idx % (L / 8);
                *(LAS u32x4*)(lds + HY_U_OFF + bb * ROWB + wq * 16) = *(const GAS u32x4*)(uT + (size_t)ch * T + seq0 + bb * L + wq * 8); }
            if (c.tid < 16) *(LAS unsigned*)(lds + HY_ZB_OFF + c.tid * 4) = 0u;
        } else {
#pragma unroll
            for (int gi = 0; gi < 2; ++gi) { const int G = gi == 0 ? gA : gB; if (G >= 0) {
#pragma unroll
                for (int rq = 0; rq < 4; ++rq) { const int t = 32 * (8 * G + tbl) + 8 * rq + 4 * g;
                    u32x2 zz; zz.x = zreg[gi][rq][0]; zz.y = zreg[gi][rq][1]; *(LAS u32x2*)(lds + HY_U_OFF + b * ROWB + 2 * t) = zz; } } }
        }
        __syncthreads();
        u32x2 xv[2][4];
#pragma unroll
        for (int gi = 0; gi < 2; ++gi) { const int G = gi == 0 ? gA : gB;
#pragma unroll
            for (int rq = 0; rq < 4; ++rq)
                xv[gi][rq] = *(const GAS u32x2*)(uT + (size_t)((o == 0 ? 512 : 1024) + ch) * T + (size_t)seq0 + b * L + 32 * (8 * (G >= 0 ? G : 0) + tbl) + 8 * rq + 4 * g); }
        if (o == 0) HY_LOAD_FW(1);
        __builtin_amdgcn_sched_barrier(0);
        f32x16 accA, accB;
#pragma unroll
        for (int r = 0; r < 16; ++r) { accA[r] = 0.f; accB[r] = 0.f; }
        {
            const int qq = (n + 1) & 7, ubase = HY_U_OFF + b * ROWB + 16 * g;
#define HY_AADDR(d) (HY_HR_OFF + (8 * ((H + 31 - (d) - n + 8 * g + qq) >> 3) + qq) * 16)
#define HY_S0(G, d) (32 * (8 * (G) + tbl) - (d))
            if (gB < 0) { if (gA >= 0) hy_span<L, false>(lds, (hiA - loA) / 16 + 1, HY_AADDR(loA), ubase, HY_S0(gA, loA), 0, accA, accB); }
            else {
                const int dS = max(loA, loB), dE = min(hiA, hiB);
                if (loA < dS) hy_span<L, false>(lds, (dS - loA) / 16, HY_AADDR(loA), ubase, HY_S0(gA, loA), 0, accA, accB);
                else if (loB < dS) hy_span<L, false>(lds, (dS - loB) / 16, HY_AADDR(loB), ubase, HY_S0(gB, loB), 0, accB, accA);
                hy_span<L, true>(lds, (dE - dS) / 16 + 1, HY_AADDR(dS), ubase, HY_S0(gA, dS), HY_S0(gB, dS), accA, accB);
                if (hiA > dE) hy_span<L, false>(lds, (hiA - dE) / 16, HY_AADDR(dE + 16), ubase, HY_S0(gA, dE + 16), 0, accA, accB);
                else if (hiB > dE) hy_span<L, false>(lds, (hiB - dE) / 16, HY_AADDR(dE + 16), ubase, HY_S0(gB, dE + 16), 0, accB, accA);
            }
#undef HY_AADDR
#undef HY_S0
        }
        const float bias = hbias[(l * 2 + o) * 512 + ch];
        int tbl_e = tbl, b_e = b, g_e = g; asm volatile("" : "+v"(tbl_e), "+v"(b_e), "+v"(g_e));
#pragma unroll
        for (int gi = 0; gi < 2; ++gi) { const int G = gi == 0 ? gA : gB; if (G >= 0) {
#pragma unroll
            for (int rq = 0; rq < 4; ++rq) { const int t = 32 * (8 * G + tbl_e) + 8 * rq + 4 * g_e;
                const u32x2 uv = *(const LAS u32x2*)(lds + HY_U_OFF + b_e * ROWB + 2 * t);
                const size_t grow = (size_t)seq0 + b_e * L + t;
                const u32x2 xvv = xv[gi][rq];
                float y[4];
#pragma unroll
                for (int k = 0; k < 4; ++k) y[k] = gi == 0 ? accA[4 * rq + k] : accB[4 * rq + k];
                const float r0 = bflo(xvv.x) * (y[0] + bias * bflo(uv.x)), r1 = bfhi(xvv.x) * (y[1] + bias * bfhi(uv.x));
                const float r2 = bflo(xvv.y) * (y[2] + bias * bflo(uv.y)), r3 = bfhi(xvv.y) * (y[3] + bias * bfhi(uv.y));
                const unsigned p0 = cvt_pk_bf16(r0, r1), p1 = cvt_pk_bf16(r2, r3);
                if (o == 0) { zreg[gi][rq][0] = p0; zreg[gi][rq][1] = p1; }
                else { u32x2 ov; ov.x = p0; ov.y = p1; *(GAS u32x2*)(oht + (size_t)ch * T + grow) = ov;   } } } }
        __syncthreads();
    }
}
#undef HY_LOAD_FW
__device__ __forceinline__ void ph_hyena(const Ctx& c0, int l) {
    const Ctx c = mk_ctx(c0.lds, c0.ws);
    const GAS float* hbias = inp(c, I_HBIAS);
    for (int unit = c.bid; unit < HYW; unit += c.G) { hy_unit<4096>(c, l, unit, hbias); if (l < DEPTH - 1) hy_unit<256>(c, l, unit, hbias); }
}

__device__ __forceinline__ void ph_ohy_t(const Ctx& c0) {
    const Ctx c = mk_ctx(c0.lds, c0.ws);
    const GAS bf16_t* src = (const GAS bf16_t*)(c.ws + WS_OHT); GAS bf16_t* dst = (GAS bf16_t*)(c.ws + WS_OAH) + 512;
    LAS unsigned char* scr = c.lds + c.wave * 16384;
    for (int tile = c.bid * NWAVES + c.wave; tile < (T / 64) * 8; tile += c.G * NWAVES) {
        const int row0 = (tile >> 3) * 64, ch0 = (tile & 7) * 64;
#pragma unroll
        for (int k = 0; k < 8; ++k) { const int cc = (c.lane >> 3) + 8 * k, ck = c.lane & 7;
            const u32x4 v = *(const GAS u32x4*)(src + (size_t)(ch0 + cc) * T + row0 + ck * 8);
            LAS unsigned* d = (LAS unsigned*)(scr + cc * 132 + ck * 16); d[0] = v.x; d[1] = v.y; d[2] = v.z; d[3] = v.w; }
        LDS_WAIT(); asm volatile("" ::: "memory");
        unsigned ow[32];
#pragma unroll
        for (int j = 0; j < 32; ++j) { const unsigned lo = *(const LAS unsigned short*)(scr + (2 * j) * 132 + c.lane * 2), hi = *(const LAS unsigned short*)(scr + (2 * j + 1) * 132 + c.lane * 2); ow[j] = lo | (hi << 16); }
        LDS_WAIT(); asm volatile("" ::: "memory");
#pragma unroll
        for (int k = 0; k < 8; ++k) { u32x4 v; v.x = ow[4 * k]; v.y = ow[4 * k + 1]; v.z = ow[4 * k + 2]; v.w = ow[4 * k + 3]; *(LAS u32x4*)(scr + c.lane * 144 + k * 16) = v; }
        LDS_WAIT(); asm volatile("" ::: "memory");
#pragma unroll
        for (int k = 0; k < 8; ++k) { const int rr = (c.lane >> 3) + 8 * k, ck = c.lane & 7; const u32x4 v = *(const LAS u32x4*)(scr + rr * 144 + ck * 16);
            *(GAS u32x4*)(dst + (size_t)(row0 + rr) * 1024 + ch0 + ck * 8) = v; }
        LDS_WAIT(); asm volatile("" ::: "memory");
    }
}

constexpr int ATT_RPB_OFF = 1024, ATT_VT_OFF = ATT_RPB_OFF + 8 * 15 * 32 * 4, ATT_VT_BYTES = 64 * 72;
template <int MODE>
__device__ __forceinline__ void att_block(const GAS bf16_t* P, const GAS bf16_t* VT, LAS unsigned char* lds, LAS unsigned char* vt, int lane, int n, int h, int head,
                                          int tokk, int ctok, int tabaddr, int vb, const bf16x8 (&qf)[4], f32x16& ot0, f32x16& ot1, float& m, float& lsum) {
    bf16x8 kf[4];
#pragma unroll
    for (int ks = 0; ks < 4; ++ks) kf[ks] = *(const GAS bf16x8*)(P + (size_t)tokk * PW + PK + head * 64 + 16 * ks + 8 * h);
    u32x2 vr[8];
#pragma unroll
    for (int it = 0; it < 8; ++it) vr[it] = *(const GAS u32x2*)(VT + (size_t)(head * 64 + it * 8 + (lane >> 3)) * T + ctok);
    f32x16 st;
#pragma unroll
    for (int r = 0; r < 16; ++r) st[r] = 0.f;
#pragma unroll
    for (int ks = 0; ks < 4; ++ks) st = __builtin_amdgcn_mfma_f32_32x32x16_bf16(kf[ks], qf[ks], st, 0, 0, 0);
    const float SC = 0.18033688011112042f;
    float sv[16];
    if (MODE == 2) {
#pragma unroll
        for (int r = 0; r < 16; ++r) sv[r] = st[r] * SC;
    } else {
        float bias[16];
#pragma unroll
        for (int r = 0; r < 16; ++r) { const int imm = MODE == 0 ? (8 * (r >> 2) + (r & 3)) * 4 : ((r >> 2) * 32 + (r & 3)) * 4; bias[r] = *(const volatile LAS float*)(lds + tabaddr + imm); }
#pragma unroll
        for (int r = 0; r < 16; ++r) { const int cr = MODE == 0 ? 8 * (r >> 2) + (r & 3) : (r & 3);
            const float v = st[r] * SC + bias[r]; sv[r] = ((unsigned)(vb + cr) < 16u) ? v : -1.0e30f; }
    }
    float bm = sv[0];
#pragma unroll
    for (int r = 1; r < 16; ++r) bm = fmaxf(bm, sv[r]);
    bm = fmaxf(bm, __int_as_float(__builtin_amdgcn_ds_bpermute((lane ^ 32) << 2, __float_as_int(bm))));
    const float mn = fmaxf(m, bm), alpha = __builtin_amdgcn_exp2f(m - mn); m = mn;
    float psum = 0.f;
#pragma unroll
    for (int r = 0; r < 16; ++r) { const float pv = __builtin_amdgcn_exp2f(sv[r] - mn); psum += pv; sv[r] = pv; }
    lsum = lsum * alpha + psum;
#pragma unroll
    for (int r = 0; r < 16; ++r) { ot0[r] *= alpha; ot1[r] *= alpha; }
    bf16x8 pb[2];
#pragma unroll
    for (int s2 = 0; s2 < 2; ++s2) { u32x4 w; w.x = cvt_pk_bf16(sv[8 * s2], sv[8 * s2 + 1]); w.y = cvt_pk_bf16(sv[8 * s2 + 2], sv[8 * s2 + 3]);
        w.z = cvt_pk_bf16(sv[8 * s2 + 4], sv[8 * s2 + 5]); w.w = cvt_pk_bf16(sv[8 * s2 + 6], sv[8 * s2 + 7]); pb[s2] = __builtin_bit_cast(bf16x8, w); }
#pragma unroll
    for (int it = 0; it < 8; ++it) *(LAS u32x2*)(vt + (it * 8 + (lane >> 3)) * 72 + (lane & 7) * 8) = vr[it];
#pragma unroll
    for (int s2 = 0; s2 < 2; ++s2) {
        { const u32x2 a = *(const LAS u32x2*)(vt + n * 72 + (4 * s2 + h) * 8), bq = *(const LAS u32x2*)(vt + n * 72 + (4 * s2 + 2 + h) * 8);
          u32x4 w; w.x = a.x; w.y = a.y; w.z = bq.x; w.w = bq.y; ot0 = __builtin_amdgcn_mfma_f32_32x32x16_bf16(__builtin_bit_cast(bf16x8, w), pb[s2], ot0, 0, 0, 0); }
        { const u32x2 a = *(const LAS u32x2*)(vt + (32 + n) * 72 + (4 * s2 + h) * 8), bq = *(const LAS u32x2*)(vt + (32 + n) * 72 + (4 * s2 + 2 + h) * 8);
          u32x4 w; w.x = a.x; w.y = a.y; w.z = bq.x; w.w = bq.y; ot1 = __builtin_amdgcn_mfma_f32_32x32x16_bf16(__builtin_bit_cast(bf16x8, w), pb[s2], ot1, 0, 0, 0); }
    }
}
constexpr int ATT_UNITS = 4096 + 256;
__device__ __forceinline__ void ph_attn(const Ctx& c0, int l) {
    const Ctx c = mk_ctx(c0.lds, c0.ws);
    const GAS bf16_t* P = (const GAS bf16_t*)(c.ws + WS_P); const GAS bf16_t* VT = (const GAS bf16_t*)(c.ws + WS_VT); GAS bf16_t* oatt = (GAS bf16_t*)(c.ws + WS_OAH);
    const GAS float* rpb = inp(c, I_RPB) + (size_t)l * 8 * 15 * 31;
    LAS unsigned char* lds = c.lds;
    for (int i = c.tid; i < 8 * 15 * 32; i += NTHR) { const int hd = i / 480, rem = i % 480, dr = rem >> 5, dc = rem & 31;
        *(LAS float*)(lds + ATT_RPB_OFF + i * 4) = dc < 31 ? rpb[(hd * 15 + dr) * 31 + dc] * 1.4426950408889634f : 0.f; }
    __syncthreads();
    LAS unsigned char* vt = lds + ATT_VT_OFF + c.wave * ATT_VT_BYTES;
    const int lane = c.lane, n = lane & 31, h = lane >> 5;
    const int natt = l < DEPTH - 1 ? ATT_UNITS : 4096;
    for (int u = c.bid * NWAVES + c.wave; u < natt; u += c.G * NWAVES) {
        const bool lat = u < 4096;
        int b, head, r = 0, hf = 0, tokq;
        if (lat) { hf = u & 1; r = (u >> 1) & 63; head = (u >> 7) & 7; b = u >> 10; tokq = b * 4096 + r * 64 + 32 * hf + n; }
        else { const int uu = u - 4096; head = (uu >> 3) & 7; b = uu >> 6; tokq = TL + b * 256 + 32 * (uu & 7) + n; }
        bf16x8 qf[4];
#pragma unroll
        for (int ks = 0; ks < 4; ++ks) qf[ks] = *(const GAS bf16x8*)(P + (size_t)tokq * PW + PQ + head * 64 + 16 * ks + 8 * h);
        f32x16 ot0, ot1;
#pragma unroll
        for (int q = 0; q < 16; ++q) { ot0[q] = 0.f; ot1[q] = 0.f; }
        float m = -1.0e30f, lsum = 0.f;
        if (lat) {
            const int r0 = min(max(r - 4, 0), 56), lo = hf ? 24 : 0, qc = 32 * hf + n, c0q = min(max(qc - 8, 0), 48);
            for (int kb = 0; kb < 8; ++kb) {
                const int base = b * 4096 + (r0 + kb) * 64 + lo, kx = lo + 4 * h;
                const int tabaddr = ATT_RPB_OFF + (((head * 15 + (r0 + kb - r + 7)) * 32) + kx - qc + 15) * 4;
                att_block<0>(P, VT, lds, vt, lane, n, h, head, base + n, base + 4 * (lane & 7), tabaddr, kx - c0q, qf, ot0, ot1, m, lsum);
            }
            for (int kb = 0; kb < 2; ++kb) {
                const int rowb = b * 4096 + (r0 + 4 * kb) * 64 + lo + 32, kx = lo + 32 + 4 * h, cc = lane & 7;
                const int tabaddr = ATT_RPB_OFF + (((head * 15 + (r0 + 4 * kb - r + 7)) * 32) + kx - qc + 15) * 4;
                att_block<1>(P, VT, lds, vt, lane, n, h, head, rowb + (n >> 3) * 64 + (n & 7), rowb + (cc >> 1) * 64 + 4 * (cc & 1), tabaddr, kx - c0q, qf, ot0, ot1, m, lsum);
            }
        }
        for (int kb = 0; kb < 8; ++kb) { const int base = TL + b * 256 + 32 * kb;
            att_block<2>(P, VT, lds, vt, lane, n, h, head, base + n, base + 4 * (lane & 7), 0, 0, qf, ot0, ot1, m, lsum); }
        const float ltot = lsum + __int_as_float(__builtin_amdgcn_ds_bpermute((lane ^ 32) << 2, __float_as_int(lsum)));
        const float inv = __builtin_amdgcn_rcpf(ltot);
        GAS bf16_t* op = oatt + (size_t)tokq * 1024 + head * 64 + 4 * h;
#pragma unroll
        for (int rq = 0; rq < 4; ++rq) {
            u32x2 w0, w1; w0.x = cvt_pk_bf16(ot0[4 * rq] * inv, ot0[4 * rq + 1] * inv); w0.y = cvt_pk_bf16(ot0[4 * rq + 2] * inv, ot0[4 * rq + 3] * inv);
            w1.x = cvt_pk_bf16(ot1[4 * rq] * inv, ot1[4 * rq + 1] * inv); w1.y = cvt_pk_bf16(ot1[4 * rq + 2] * inv, ot1[4 * rq + 3] * inv);
            *(GAS u32x2*)(op + 8 * rq) = w0; *(GAS u32x2*)(op + 32 + 8 * rq) = w1; }
    }
    __syncthreads();
}

__device__ __forceinline__ void ph_final(const Ctx& c0) {
    const Ctx c = mk_ctx(c0.lds, c0.ws);
    const GAS float* xres = (const GAS float*)(c.ws + WS_X); const GAS float* gp = inp(c, I_FINALG); GAS float* outp = (GAS float*)inp(c, 30);
    const MoeComb mc{(const GAS int*)(c.ws + WS_ROUTE), (const GAS float*)(c.ws + WS_RWT), (const GAS bf16_t*)(c.ws + WS_Y), (const GAS float*)(c.ws + WS_MOD) + (size_t)(DEPTH - 1) * 5 * 6144 + 5 * 1024};
    LAS unsigned* offs = (LAS unsigned*)c.lds + 32;
    moe_offsets(c, 1, offs);
    __syncthreads();
    for (int row = c.bid * NWAVES + c.wave; row < TL; row += c.G * NWAVES) {
        const GAS float* src = xres + (size_t)row * D; f32x4 v[4]; float ss = 0.f;
#pragma unroll
        for (int j = 0; j < 4; ++j) v[j] = *(const GAS f32x4*)(src + 4 * (c.lane + 64 * j));
        moe_combine_row(mc, offs, row, row >> 12, c.lane, v);
#pragma unroll
        for (int j = 0; j < 4; ++j) ss += (v[j][0] * v[j][0] + v[j][1] * v[j][1]) + (v[j][2] * v[j][2] + v[j][3] * v[j][3]);
        ss = wave_sum(ss, c.lane);
        const float rstd = 1.f / sqrtf(ss * (1.f / D) + EPS);
#pragma unroll
        for (int j = 0; j < 4; ++j) { const int k0 = 4 * (c.lane + 64 * j); const f32x4 g4 = *(const GAS f32x4*)(gp + k0); *(GAS f32x4*)(outp + (size_t)row * D + k0) = v[j] * rstd * g4; }
    }
}

constexpr int MOE_OFF = 132096;
template <bool GATHER_> struct MoeOrder {
    static constexpr bool GATHER = GATHER_;
    int nM, nN, nwg, G, c; const GAS char* A; const GAS char* B; size_t astep, bstep, estep; const GAS int* tokenof; const LAS unsigned* tab;
    __device__ void init(const GAS void* A_, int lda, const GAS void* B_, int ldb, size_t estep_bytes, int N, int G_, int c_, const GAS int* tok, const LAS unsigned* tab_) {
        tab = tab_; nM = (int)((unsigned)__builtin_amdgcn_readfirstlane(tab[8]) >> 8); nN = N / pg8::BM; nwg = nM * nN; G = G_; c = c_; A = (const GAS char*)A_; B = (const GAS char*)B_;
        astep = (size_t)pg8::BM * lda * 2; bstep = (size_t)pg8::BM * ldb * 2; estep = estep_bytes; tokenof = tok; }
    __device__ bool next(int i, pg8::Unit& u) const {
        const long L = (long)i * G + c; if (L >= nwg) return false;
        int wgid = (int)L; { const int q = nwg / pg8::NXCD, r = nwg % pg8::NXCD, xcd = wgid % pg8::NXCD, off = wgid / pg8::NXCD; wgid = (xcd < r ? xcd * (q + 1) : r * (q + 1) + (xcd - r) * q) + off; }
        const int nig = pg8::WGM * nN, gid = wgid / nig, fm = gid * pg8::WGM, gsz = (nM - fm) < pg8::WGM ? (nM - fm) : pg8::WGM;
        u.pm = fm + ((wgid % nig) % gsz); u.pn = (wgid % nig) / gsz;
        const unsigned slot0 = (unsigned)u.pm << 8; int e = 0;
#pragma unroll
        for (int j = 1; j < 8; ++j) e += (slot0 >= (unsigned)__builtin_amdgcn_readfirstlane(tab[j])) ? 1 : 0;
        const unsigned pos0 = slot0 - (unsigned)__builtin_amdgcn_readfirstlane(tab[e]), cnt = (unsigned)__builtin_amdgcn_readfirstlane(tab[16 + e]);
        u.nvalid = cnt > pos0 ? (int)(cnt - pos0) : 0; u.tk = tokenof + (size_t)e * T + pos0;
        u.a = GATHER ? A : A + (size_t)u.pm * astep; u.b = B + (size_t)e * estep + (size_t)u.pn * bstep; return true;
    }
    __device__ __forceinline__ int arow(const pg8::Unit& u, int r) const { return r < u.nvalid ? u.tk[r] : 0; }
    __device__ __forceinline__ void a_ready(const pg8::Unit&) const {}
    __device__ __forceinline__ void done(const pg8::Unit&) const {}
};
__device__ __forceinline__ void moe_table(const Ctx& c, int i) {
    LAS unsigned* tab = (LAS unsigned*)(c.lds + MOE_OFF);
    if (c.tid == 0) { const GAS unsigned* cnt = (const GAS unsigned*)(c.ws + WS_CTL) + CW_CNT + 64 * i; unsigned o = 0;
        for (int e = 0; e < 8; ++e) { const unsigned ce = cnt[e]; tab[e] = o; tab[16 + e] = ce; o += (ce + 255u) & ~255u; } tab[8] = o; }
    __syncthreads();
}

#define XB_TMO      128
#define XB_XCNT(j)  (256  + 64 * (j))
#define XB_XSUB(j)  (1280 + 64 * (j))
#define XB_XGEN(j)  (2304 + 64 * (j))
#define XB_TOP      3328
#define XB_TOPGEN   3392
#define XCD_BAR_WORDS 3456
#define XB_SPIN_CAP (1u << 18)
__device__ __forceinline__ unsigned xb_ld(GAS unsigned* p)              { return __hip_atomic_load(p, __ATOMIC_RELAXED, __HIP_MEMORY_SCOPE_AGENT); }
__device__ __forceinline__ unsigned xb_add(GAS unsigned* p, unsigned v) { return __hip_atomic_fetch_add(p, v, __ATOMIC_RELAXED, __HIP_MEMORY_SCOPE_AGENT); }
__device__ __forceinline__ unsigned xb_xcc_id() { return (unsigned)__builtin_amdgcn_s_getreg((3 << 11) | 20) & 0xFu; }
#define XB_SPIN(cond, bar) do { unsigned _sp = 0; while (cond) { __builtin_amdgcn_s_sleep(1); \
    if ((++_sp & 255u) == 0u) { if (xb_ld(&(bar)[XB_TMO])) break; if (_sp > XB_SPIN_CAP) { (void)xb_add(&(bar)[XB_TMO], 1u); break; } } } } while (0)
struct XcdBarrier { GAS unsigned* bar; unsigned x; volatile LAS unsigned* st; };
__device__ __forceinline__ XcdBarrier xcd_barrier_post(GAS unsigned* bar, volatile LAS unsigned* st) {
    XcdBarrier b; b.bar = bar; b.x = xb_xcc_id(); b.st = st;
    if (threadIdx.x == 0) (void)xb_add(&bar[XB_XCNT(b.x)], 1u);
    return b;
}
__device__ __forceinline__ void xcd_barrier_complete(GAS unsigned* bar, unsigned x, unsigned& nloc, unsigned& nx) {
    const unsigned G = gridDim.x * gridDim.y * gridDim.z;
    unsigned sum, cnt, mine, sp = 0u;
    for (;;) {
        sum = 0u; cnt = 0u; mine = 0u;
#pragma unroll
        for (unsigned j = 0; j < 16; ++j) { const unsigned c = xb_ld(&bar[XB_XCNT(j)]); sum += c; cnt += (c > 0u) ? 1u : 0u; mine = (j == x) ? c : mine; }
        if (sum == G) break;
        __builtin_amdgcn_s_sleep(1);
        if ((++sp & 255u) == 0u) { if (xb_ld(&bar[XB_TMO])) break; if (sp > XB_SPIN_CAP) { (void)xb_add(&bar[XB_TMO], 1u); break; } }
    }
    nloc = mine > 0u ? mine : 1u; nx = cnt > 0u ? cnt : 1u;
}
__device__ __forceinline__ void xcd_barrier(const XcdBarrier& b) {
    asm volatile("s_waitcnt vmcnt(0)" ::: "memory");
    __syncthreads();
    if (threadIdx.x == 0) {
        GAS unsigned* bar = b.bar; asm volatile("" : "+s"(bar));     const unsigned bx = xb_xcc_id();
        __builtin_amdgcn_s_waitcnt(0);
        unsigned nloc = b.st[0], nx = b.st[1];
        if (nloc == 0u) { xcd_barrier_complete(bar, bx, nloc, nx); b.st[0] = nloc; b.st[1] = nx; }
        const unsigned old = xb_add(&bar[XB_XSUB(bx)], 1u);
        const unsigned gen = old / nloc;
        if (old + 1u == (gen + 1u) * nloc) {
            __builtin_amdgcn_fence(__ATOMIC_RELEASE, "agent");
            asm volatile("s_waitcnt vmcnt(0)" ::: "memory");
            const unsigned og = xb_add(&bar[XB_TOP], 1u);
            const unsigned tg = og / nx;
            if (og + 1u == (tg + 1u) * nx) xb_add(&bar[XB_TOPGEN], 1u);
            else XB_SPIN(xb_ld(&bar[XB_TOPGEN]) == tg, bar);
            __builtin_amdgcn_fence(__ATOMIC_ACQUIRE, "agent");
            xb_add(&bar[XB_XGEN(bx)], 1u);
            asm volatile("s_waitcnt vmcnt(0)" ::: "memory");
        } else {
            XB_SPIN(xb_ld(&bar[XB_XGEN(bx)]) == gen, bar);
            __builtin_amdgcn_fence(__ATOMIC_ACQUIRE, "agent");
            asm volatile("s_waitcnt vmcnt(0)" ::: "memory");
        }
    }
    __syncthreads();
}

constexpr int CW_BAR = 4096;

__global__ void __launch_bounds__(NTHR, 2) fwd(Args args) {
    extern __shared__ __attribute__((aligned(16))) unsigned char lds_raw[];
    Ctx c; c.lds = (LAS unsigned char*)lds_raw; c.tid = threadIdx.x; c.lane = c.tid & 63; c.wave = __builtin_amdgcn_readfirstlane(c.tid >> 6); c.G = gridDim.x; c.bid = blockIdx.x; c.ws = (GAS unsigned char*)args.ws;
    GAS unsigned char* ws = (GAS unsigned char*)args.ws;
    volatile LAS unsigned* MISC = (volatile LAS unsigned*)(c.lds + MISC_OFF);
    if (c.tid < 32) MISC[c.tid] = 0u;
    if (c.tid < 31) { const unsigned long long pv = c.tid < 30 ? (unsigned long long)args.in[c.tid] : (unsigned long long)args.out;
        volatile LAS unsigned* pt = (volatile LAS unsigned*)(c.lds + PTR_OFF) + 2 * c.tid; pt[0] = (unsigned)pv; pt[1] = (unsigned)(pv >> 32); }
    __syncthreads();
    XcdBarrier bar = xcd_barrier_post((GAS unsigned*)(ws + WS_CTL) + CW_BAR, MISC + 8);
#define GRID_BAR() xcd_barrier(bar)
#ifndef PROFILE_ID
#define PROFILE_ID (-1)
#endif
#define PROF(id) do { if (PROFILE_ID >= 0 && blockIdx.x == 0 && threadIdx.x == 0) { const unsigned long long t_ = __builtin_amdgcn_s_memrealtime(); \
        volatile LAS unsigned* q_ = MISC + 16; const unsigned long long prev_ = ((unsigned long long)q_[1] << 32) | q_[0]; \
        if ((id) == PROFILE_ID) { const unsigned long long a_ = (((unsigned long long)q_[3] << 32) | q_[2]) + (t_ - prev_); q_[2] = (unsigned)a_; q_[3] = (unsigned)(a_ >> 32); } \
        q_[0] = (unsigned)t_; q_[1] = (unsigned)(t_ >> 32); } } while (0)
    PROF(99);

    ph_convert(c); __syncthreads(); ph_mod(c); __syncthreads(); ph_filt(c);
    GRID_BAR(); PROF(0);
    for (int l = 0; l < DEPTH; ++l) {
        ph_norm(c, l, 0);
        GRID_BAR(); PROF(1);
        {   GAS unsigned char* ws = c.ws; asm volatile("" : "+s"(ws));
            pg8::Gemm g{D, D, D, STAG}; pg8::StaticOrder S; S.init(ws + WS_H, D, (GAS bf16_t*)(ws + WS_WIN) + (size_t)l * PW * D, D, T, PW, c.G, c.bid);
            EpiStoreBf16 E{(GAS bf16_t*)(ws + WS_P), PW};
            pg8::gemm_phase(c.lds, g, S, E); }
        GRID_BAR(); PROF(2);
        ph_sc(c, l);
        GRID_BAR(); PROF(3);
        ph_hyena(c, l); ph_attn(c, l);
        GRID_BAR(); PROF(4);
        ph_ohy_t(c);
        GRID_BAR(); PROF(5);
        {   GAS unsigned char* ws = c.ws; asm volatile("" : "+s"(ws));
            const GAS bf16_t* wab = (const GAS bf16_t*)(ws + WS_WPAB) + (size_t)l * D * D;
            pg8::Gemm g{D, D, D}; pg8::StaticOrder S; S.init(ws + WS_OAH, D, wab, D, TL, D, c.G, c.bid);
            EpiMergeK E{(const GAS bf16_t*)(ws + WS_P), (GAS bf16_t*)(ws + WS_H)};
            pg8::gemm_phase(c.lds, g, S, E);
            if (l < DEPTH - 1) ctx_gemm(c.lds, (const GAS bf16_t*)(ws + WS_OAH), D, wab, D, D, CEpiMergeK{(const GAS bf16_t*)(ws + WS_P), (GAS bf16_t*)(ws + WS_H)}); }
        GRID_BAR(); PROF(6);
        {   GAS unsigned char* ws = c.ws; asm volatile("" : "+s"(ws));
            const GAS float* modl = (const GAS float*)(ws + WS_MOD) + (size_t)l * 5 * 6144;
            pg8::Gemm g{D, D, D}; pg8::StaticOrder S; S.init(ws + WS_H, D, (GAS bf16_t*)(ws + WS_WO) + (size_t)l * D * D, D, TL, D, c.G, c.bid);
            EpiResid E{(GAS float*)(ws + WS_X), modl + 2 * 1024};
            pg8::gemm_phase(c.lds, g, S, E);
            if (l < DEPTH - 1) ctx_gemm(c.lds, (const GAS bf16_t*)(ws + WS_H), D, (const GAS bf16_t*)(ws + WS_WO) + (size_t)l * D * D, D, D, CEpiResid{(GAS float*)(ws + WS_X), modl + 4 * 6144 + 2 * 1024}); }
        GRID_BAR(); PROF(7);
        ph_norm(c, l, 1);
        GRID_BAR(); PROF(8);
        if ((l & 1) == 0) {
            {   GAS unsigned char* ws = c.ws; asm volatile("" : "+s"(ws));
                const GAS bf16_t* w = (const GAS bf16_t*)(ws + WS_W13D) + (size_t)(l >> 1) * 2 * FF * D;
                pg8::Gemm g{D, D, D, STAG}; pg8::StaticOrder S; S.init(ws + WS_H, D, w, D, T, 2 * FF, c.G, c.bid);
                EpiSwiglu E{(GAS bf16_t*)(ws + WS_P)};
                pg8::gemm_phase(c.lds, g, S, E); }
            GRID_BAR(); PROF(9);
            {   GAS unsigned char* ws = c.ws; asm volatile("" : "+s"(ws));
                const GAS float* modl = (const GAS float*)(ws + WS_MOD) + (size_t)l * 5 * 6144;
                const GAS bf16_t* w = (const GAS bf16_t*)(ws + WS_W2D) + (size_t)(l >> 1) * D * FF;
                pg8::Gemm g{FF, FF, FF}; pg8::StaticOrder S; S.init(ws + WS_P, FF, w, FF, TL, D, c.G, c.bid);
                EpiResid E{(GAS float*)(ws + WS_X), modl + 5 * 1024};
                pg8::gemm_phase(c.lds, g, S, E);
                ctx_gemm(c.lds, (const GAS bf16_t*)(ws + WS_P), FF, w, FF, FF, CEpiResid{(GAS float*)(ws + WS_X), modl + 4 * 6144 + 5 * 1024}); }
            GRID_BAR(); PROF(10);
        } else {
            const Ctx cm = mk_ctx(c.lds, c.ws);
            moe_table(cm, l >> 1);
            {   GAS unsigned char* ws = c.ws; asm volatile("" : "+s"(ws));
                const GAS bf16_t* w = (const GAS bf16_t*)(ws + WS_W13M) + (size_t)((l >> 1) * NE) * 2 * FF * D;
                pg8::Gemm g{D, D, D, STAG}; MoeOrder<true> S; S.init(ws + WS_H, D, w, D, (size_t)2 * FF * D * 2, 2 * FF, c.G, c.bid, (const GAS int*)(ws + WS_TOK), (const LAS unsigned*)(c.lds + MOE_OFF));
                EpiSwiglu E{(GAS bf16_t*)(ws + WS_P)};
                pg8::gemm_phase(c.lds, g, S, E); }
            GRID_BAR(); PROF(11);
            {   GAS unsigned char* ws = c.ws; asm volatile("" : "+s"(ws));
                const GAS bf16_t* w = (const GAS bf16_t*)(ws + WS_W2M) + (size_t)((l >> 1) * NE) * D * FF;
                pg8::Gemm g{FF, FF, FF, STAG}; MoeOrder<false> S; S.init(ws + WS_P, FF, w, FF, (size_t)D * FF * 2, D, c.G, c.bid, (const GAS int*)(ws + WS_TOK), (const LAS unsigned*)(c.lds + MOE_OFF));
                EpiStoreBf16 E{(GAS bf16_t*)(ws + WS_Y), D};
                pg8::gemm_phase(c.lds, g, S, E); }
            GRID_BAR(); PROF(12);
        }
    }
    ph_final(c);
    if (PROFILE_ID >= 0 && blockIdx.x == 0) {
        if (threadIdx.x == 0) { PROF(13); volatile LAS unsigned* q_ = MISC + 16; const unsigned long long a_ = ((unsigned long long)q_[3] << 32) | q_[2], t0_ = __builtin_amdgcn_s_memrealtime();
            while (__builtin_amdgcn_s_memrealtime() - t0_ < a_) __builtin_amdgcn_s_sleep(8); }
        __syncthreads();
    }
}

extern "C" void kernel_launch(void* const* d_in, const int* in_sizes, int n_in, void* d_out, int out_size, void* d_ws, size_t ws_size, hipStream_t stream) {
    static int grid = 0;
    if (grid == 0) {
        if (n_in != 30 || out_size != TL * D || ws_size < WS_END) { fprintf(stderr, "kernel_launch: unexpected shapes (n_in %d out %d ws %zu)\n", n_in, out_size, ws_size); grid = -1; return; }
        int dev = 0, cus = 0, per_cu = 0; (void)hipGetDevice(&dev); (void)hipDeviceGetAttribute(&cus, hipDeviceAttributeMultiprocessorCount, dev);
        if (hipFuncSetAttribute((const void*)fwd, hipFuncAttributeMaxDynamicSharedMemorySize, LDS_BYTES) != hipSuccess) { fprintf(stderr, "kernel_launch: hipFuncSetAttribute failed\n"); grid = -1; return; }
        if (hipOccupancyMaxActiveBlocksPerMultiprocessor(&per_cu, (const void*)fwd, NTHR, LDS_BYTES) != hipSuccess || per_cu < 1) fprintf(stderr, "kernel_launch: occupancy query reports %d\n", per_cu);
        (void)hipGetLastError();
        grid = cus > 0 ? cus : 256;
    }
    if (grid < 0) return;
    (void)hipMemsetAsync((char*)d_ws + WS_CTL, 0, CTL_ZERO_BYTES, stream);
    Args a{};
    for (int i = 0; i < 30; ++i) a.in[i] = (const float*)d_in[i];
    a.out = (float*)d_out; a.ws = (unsigned char*)d_ws;
    hipLaunchKernelGGL(fwd, dim3(grid), dim3(NTHR), LDS_BYTES, stream, a);
}
```

```cpp
#include <hip/hip_runtime.h>
#include <cstdio>
#include <cstdint>

#define LAS __attribute__((address_space(3)))
#define GAS __attribute__((address_space(1)))
typedef unsigned short bf16_t;
typedef short bf16x8 __attribute__((ext_vector_type(8)));
typedef float f32x4 __attribute__((ext_vector_type(4)));
typedef float f32x2 __attribute__((ext_vector_type(2)));
typedef float f32x16 __attribute__((ext_vector_type(16)));
typedef unsigned u32x4 __attribute__((ext_vector_type(4)));
typedef unsigned u32x2 __attribute__((ext_vector_type(2)));

constexpr int D = 1024, NB = 4, SEQ = 4096, DEPTH = 4, CTX = 256;
constexpr int TL = NB * SEQ, TC = NB * CTX, T = TL + TC;
constexpr int PW = 5120, FF = 2816, NE = 8, HYW = 512;
constexpr int PQ = 0, PK = 512, PV = 1024, PHY = 1536, PGA = 3072, PGB = 4096;
constexpr float EPS = 1e-6f;

constexpr size_t MiB = 1u << 20;
constexpr size_t WS_CTL = 0, CTL_ZERO_BYTES = 1 * MiB;
constexpr size_t WS_MOD = 1 * MiB;
constexpr size_t WS_ROUTE = 2 * MiB;
constexpr size_t WS_RWT = 2 * MiB + 512 * 1024;
constexpr size_t WS_TOK = 3 * MiB;
constexpr int CW_CNT = 8192;
constexpr int MAXSLOT = 36864;
constexpr size_t WS_Y = 660 * MiB;
constexpr size_t WS_WIN = 4 * MiB;
constexpr size_t WS_WPAB = 44 * MiB;
constexpr size_t WS_WO = 52 * MiB;
constexpr size_t WS_W13D = 60 * MiB;
constexpr size_t WS_W2D = 82 * MiB;
constexpr size_t WS_W13M = 93 * MiB;
constexpr size_t WS_W2M = 269 * MiB;
constexpr size_t WS_X = 357 * MiB;
constexpr size_t WS_H = 425 * MiB;
constexpr size_t WS_P = 459 * MiB;
constexpr size_t WS_OAH = 629 * MiB;
constexpr size_t WS_B = 663 * MiB;
constexpr size_t WS_OHT = WS_B + 51 * MiB;
constexpr size_t WS_VT = 748 * MiB;
constexpr size_t WS_HRL = 816 * MiB;
constexpr size_t WS_HRC = 850 * MiB;
constexpr size_t WS_END = 853 * MiB;

constexpr int STAG = 3;
constexpr int LDS_BYTES = 147456;
constexpr int NWAVES = 8, NTHR = 512;

#define LDS_WAIT() asm volatile("s_waitcnt lgkmcnt(0)" ::: "memory")
#define VM_WAIT() asm volatile("s_waitcnt vmcnt(0)" ::: "memory")
__device__ __forceinline__ float bf2f(unsigned b) { return __uint_as_float(b << 16); }
__device__ __forceinline__ float bflo(unsigned w) { return __uint_as_float(w << 16); }
__device__ __forceinline__ float bfhi(unsigned w) { return __uint_as_float(w & 0xffff0000u); }
__device__ __forceinline__ unsigned cvt_pk_bf16(float lo, float hi) { unsigned r; asm volatile("v_cvt_pk_bf16_f32 %0, %1, %2" : "=v"(r) : "v"(lo), "v"(hi)); return r; }
__device__ __forceinline__ float wave_sum(float v, int lane) {
#pragma unroll
    for (int o = 1; o < 64; o <<= 1) v += __int_as_float(__builtin_amdgcn_ds_bpermute((lane ^ o) << 2, __float_as_int(v)));
    return v;
}
__device__ __forceinline__ float sigmoidf_(float x) { return __builtin_amdgcn_rcpf(1.f + __expf(-x)); }
__device__ __forceinline__ float sin_rev(float r) { return __builtin_amdgcn_sinf(__builtin_amdgcn_fractf(r)); }
__device__ __forceinline__ float sin_rad(float x) { return sin_rev(x * 0.15915494309189535f); }

namespace pg8 {
constexpr int BM = 256, BK = 64, HALF = 128, HTB = HALF * BK * 2, STAGE_BYTES = 8 * HTB, NXCD = 8, WGM = 8;
__host__ __device__ __forceinline__ int lds_byte(int r, int c) { const int st = (r >> 4) * 2 + (c >> 5), rr = r & 15, cc = c & 31, ob = rr * 64 + cc * 2; return st * 1024 + (ob ^ (((ob >> 9) & 1) << 5)); }
__host__ __device__ __forceinline__ void stage_rc(int b, int& R, int& C) { const int st = b / 1024, sb = b % 1024, swz = sb ^ (((sb >> 9) & 1) << 5); R = (st >> 1) * 16 + swz / 64; C = (st & 1) * 32 + (swz % 64) / 2; }
__host__ __device__ __forceinline__ int perm32(int rho) { const int n = rho >> 4, i = rho & 15; return 8 * (i >> 2) + 4 * n + (i & 3); }

struct Unit { int pm, pn; const GAS char* a; const GAS char* b; const GAS int* tk; int nvalid; };
struct Gemm { int K, lda, ldb; int stagger = 0; };

struct StaticOrder {
    int nM, nN, nwg, G, c; const GAS char* A; const GAS char* B; size_t astep, bstep;
    __device__ void init(const GAS void* A_, int lda, const GAS void* B_, int ldb, int M, int N, int G_, int c_) {
        nM = M / BM; nN = N / BM; nwg = nM * nN; G = G_; c = c_; A = (const GAS char*)A_; B = (const GAS char*)B_; astep = (size_t)BM * lda * 2; bstep = (size_t)BM * ldb * 2; }
    __device__ bool next(int i, Unit& u) const {
        const long L = (long)i * G + c; if (L >= nwg) return false;
        int wgid = (int)L; { const int q = nwg / NXCD, r = nwg % NXCD, xcd = wgid % NXCD, off = wgid / NXCD; wgid = (xcd < r ? xcd * (q + 1) : r * (q + 1) + (xcd - r) * q) + off; }
        const int nig = WGM * nN, gid = wgid / nig, fm = gid * WGM, gsz = (nM - fm) < WGM ? (nM - fm) : WGM;
        u.pm = fm + ((wgid % nig) % gsz); u.pn = (wgid % nig) / gsz; u.a = A + (size_t)u.pm * astep; u.b = B + (size_t)u.pn * bstep; return true;
    }
    static constexpr bool GATHER = false;
    __device__ __forceinline__ int arow(const Unit&, int) const { return 0; }
    __device__ __forceinline__ void a_ready(const Unit&) const {}
    __device__ __forceinline__ void done(const Unit&) const {}
};

template <class Epi, class Sched, bool ALIGN_EPI = true>
__device__ __forceinline__ void gemm_phase(LAS unsigned char* lds, const Gemm g, const Sched& S, const Epi& E) {
    int tid = threadIdx.x; asm volatile("" : "+v"(tid));
    const int wid = __builtin_amdgcn_readfirstlane(tid >> 6), lane = tid & 63, wr = wid >> 2, wc = wid & 3, fr = lane & 15, fq = lane >> 4;
    const int K = g.K, nt = K / BK;
    constexpr bool GATHER = Sched::GATHER;
    unsigned voffB[2]; unsigned cA0[2], cA1[2], nA0[2], nA1[2]; int RA[2], CA[2];
    const size_t hstepA = (size_t)HALF * g.lda * 2, hstepB = (size_t)HALF * g.ldb * 2;
#pragma unroll
    for (int i = 0; i < 2; ++i) { int R, C; stage_rc(tid * 16 + i * 8192, R, C); const int Rb = Epi::PERM ? ((R & ~31) + perm32(R & 31)) : R;
        RA[i] = R; CA[i] = C; voffB[i] = (unsigned)(Rb * g.ldb + C) * 2u;
        cA0[i] = (unsigned)(R * g.lda + C) * 2u; cA1[i] = cA0[i]; nA0[i] = cA0[i]; nA1[i] = cA0[i]; }
    const size_t h1A = GATHER ? 0 : hstepA;
    const size_t kstep = (size_t)(BK * 2);
    const unsigned ldsw = (unsigned)wid * 1024u;
    const int aoff = lds_byte(wr * 64 + fr, fq * 8), boff = lds_byte(wc * 32 + fr, fq * 8);
#define PG8_SA(b, h) (((b) * 2 + (h)) * HTB)
#define PG8_SB(b, h) ((4 + (b) * 2 + (h)) * HTB)
#define PG8_STAGE(bufoff, gbase, voff) do { _Pragma("unroll") for (int _i = 0; _i < 2; ++_i) \
        __builtin_amdgcn_global_load_lds((const GAS unsigned*)((const GAS char*)(gbase) + (voff)[_i]), (LAS unsigned*)(lds + (bufoff) + ldsw + _i * 8192), 16, 0, 0); } while (0)
#define PG8_LDA(dst, b, h) do { _Pragma("unroll") for (int m = 0; m < 4; ++m) _Pragma("unroll") for (int k = 0; k < 2; ++k) dst[m][k] = *(const LAS bf16x8*)(lds + PG8_SA(b, h) + aoff + m * 2048 + k * 1024); } while (0)
#define PG8_LDB(dst, b, h) do { _Pragma("unroll") for (int n = 0; n < 2; ++n) _Pragma("unroll") for (int k = 0; k < 2; ++k) dst[n][k] = *(const LAS bf16x8*)(lds + PG8_SB(b, h) + boff + n * 2048 + k * 1024); } while (0)
#define PG8_MMA(ai, bj, At, Bt) do { __builtin_amdgcn_s_setprio(1); _Pragma("unroll") for (int m = 0; m < 4; ++m) _Pragma("unroll") for (int n = 0; n < 2; ++n) _Pragma("unroll") for (int k = 0; k < 2; ++k) \
        acc[ai][bj][m][n] = __builtin_amdgcn_mfma_f32_16x16x32_bf16(Bt[n][k], At[m][k], acc[ai][bj][m][n], 0, 0, 0); __builtin_amdgcn_s_setprio(0); } while (0)
#define PG8_WAIT_V(n) asm volatile("s_waitcnt vmcnt(" #n ")" ::: "memory")
#define PG8_WAIT_L(n) asm volatile("s_waitcnt lgkmcnt(" #n ")" ::: "memory")
#define PG8_BAR __builtin_amdgcn_s_barrier()
#define PG8_SCHED __builtin_amdgcn_sched_barrier(0)
    Unit cur, nxt; int ui = 0;
    if (!S.next(0, cur)) return;
    if (g.stagger > 0) {
        const int slot = (blockIdx.x >> 3) & 7;
        int steps = slot * g.stagger;
        for (int i = 0; i < steps; ++i) __builtin_amdgcn_s_sleep(16);
    }
    if constexpr (GATHER) {
#pragma unroll
        for (int i = 0; i < 2; ++i) { cA0[i] = (unsigned)(S.arow(cur, RA[i]) * g.lda + CA[i]) * 2u; cA1[i] = (unsigned)(S.arow(cur, HALF + RA[i]) * g.lda + CA[i]) * 2u; }
    }
    f32x4 acc[2][2][4][2];
#pragma unroll
    for (int a = 0; a < 2; ++a)
#pragma unroll
        for (int b = 0; b < 2; ++b)
#pragma unroll
            for (int m = 0; m < 4; ++m)
#pragma unroll
                for (int n = 0; n < 2; ++n) acc[a][b][m][n] = (f32x4){0.f, 0.f, 0.f, 0.f};
    bf16x8 At[4][2], B0[2][2], B1[2][2];
    const GAS char* cA = cur.a; const GAS char* cB = cur.b;
    S.a_ready(cur);
    PG8_STAGE(PG8_SB(0, 0), cB, voffB); PG8_STAGE(PG8_SB(0, 1), cB + hstepB, voffB); PG8_STAGE(PG8_SA(0, 0), cA, cA0); PG8_STAGE(PG8_SA(0, 1), cA + h1A, cA1);
    if (wr == 1) PG8_BAR;
    PG8_WAIT_V(2); PG8_BAR;
    PG8_STAGE(PG8_SB(1, 0), cB + kstep, voffB); PG8_STAGE(PG8_SA(1, 0), cA + kstep, cA0); PG8_STAGE(PG8_SB(1, 1), cB + hstepB + kstep, voffB);
    PG8_WAIT_V(6); PG8_BAR;
    for (;;) {
        const bool has_next = S.next(ui + 1, nxt);
        const GAS char* nA = has_next ? nxt.a : cA; const GAS char* nB = has_next ? nxt.b : cB;
        if constexpr (GATHER) {
#pragma unroll
            for (int i = 0; i < 2; ++i) { nA0[i] = has_next ? (unsigned)(S.arow(nxt, RA[i]) * g.lda + CA[i]) * 2u : cA0[i]; nA1[i] = has_next ? (unsigned)(S.arow(nxt, HALF + RA[i]) * g.lda + CA[i]) * 2u : cA1[i]; }
        }
        for (int kh = 0; kh < (Epi::MIDK ? 2 : 1); ++kh) {
        const int tb = Epi::MIDK ? kh * (nt / 2) : 0, te = Epi::MIDK ? tb + nt / 2 : nt;
        for (int t = tb; t < te; t += 2) {
            const bool last = (t == nt - 2);
            const GAS char* a1 = cA + (size_t)(t + 1) * kstep;
            const GAS char* a2 = last ? nA : cA + (size_t)(t + 2) * kstep; const GAS char* b2 = last ? nB : cB + (size_t)(t + 2) * kstep;
            const GAS char* a3 = a2 + kstep; const GAS char* b3 = b2 + kstep;
            unsigned x0[2], x1[2];
#pragma unroll
            for (int i = 0; i < 2; ++i) { x0[i] = (GATHER && last) ? nA0[i] : cA0[i]; x1[i] = GATHER ? (last ? nA1[i] : cA1[i]) : cA0[i]; }
            if (last && has_next) S.a_ready(nxt);
            PG8_LDB(B0, 0, 0); PG8_LDB(B1, 0, 1); PG8_SCHED; PG8_LDA(At, 0, 0); PG8_STAGE(PG8_SA(1, 1), a1 + h1A, cA1);
            PG8_WAIT_V(8); PG8_WAIT_L(0); PG8_BAR; PG8_MMA(0, 0, At, B0); PG8_MMA(0, 1, At, B1); PG8_BAR; PG8_SCHED;
            PG8_LDA(At, 0, 1); PG8_STAGE(PG8_SB(0, 0), b2, voffB); PG8_STAGE(PG8_SB(0, 1), b2 + hstepB, voffB); PG8_STAGE(PG8_SA(0, 0), a2, x0);
            PG8_WAIT_V(8); PG8_WAIT_L(0); PG8_BAR; PG8_MMA(1, 0, At, B0); PG8_MMA(1, 1, At, B1); PG8_BAR; PG8_SCHED;
            PG8_LDB(B0, 1, 0); PG8_LDB(B1, 1, 1); PG8_SCHED; PG8_LDA(At, 1, 0); PG8_STAGE(PG8_SA(0, 1), a2 + h1A, x1);
            PG8_WAIT_V(8); PG8_WAIT_L(0); PG8_BAR; PG8_MMA(0, 0, At, B0); PG8_MMA(0, 1, At, B1); PG8_BAR; PG8_SCHED;
            PG8_LDA(At, 1, 1); PG8_STAGE(PG8_SB(1, 0), b3, voffB); PG8_STAGE(PG8_SB(1, 1), b3 + hstepB, voffB); PG8_STAGE(PG8_SA(1, 0), a3, x0);
            PG8_WAIT_V(8); PG8_WAIT_L(0); PG8_BAR; PG8_MMA(1, 0, At, B0); PG8_MMA(1, 1, At, B1); PG8_BAR; PG8_SCHED;
        }
        if constexpr (Epi::MIDK) { if (kh == 0) E.mid(acc, cur, wr, wc, fr, fq); }
        }
        if constexpr (ALIGN_EPI) { if (wr == 0) PG8_BAR; }
        E(acc, cur, wr, wc, fr, fq); S.done(cur);
        if (!has_next) break;
#pragma unroll
        for (int a = 0; a < 2; ++a)
#pragma unroll
            for (int b = 0; b < 2; ++b)
#pragma unroll
                for (int m = 0; m < 4; ++m)
#pragma unroll
                    for (int n = 0; n < 2; ++n) acc[a][b][m][n] = (f32x4){0.f, 0.f, 0.f, 0.f};
        cur = nxt; cA = nA; cB = nB; ++ui;
        if constexpr (GATHER) {
#pragma unroll
            for (int i = 0; i < 2; ++i) { cA0[i] = nA0[i]; cA1[i] = nA1[i]; }
        }
        if constexpr (ALIGN_EPI) { if (wr == 1) PG8_BAR; }
    }
    PG8_WAIT_V(0);
    if constexpr (!ALIGN_EPI) { if (wr == 0) PG8_BAR; }
    PG8_BAR;
#undef PG8_SA
#undef PG8_SB
#undef PG8_STAGE
#undef PG8_LDA
#undef PG8_LDB
#undef PG8_MMA
#undef PG8_WAIT_V
#undef PG8_WAIT_L
#undef PG8_BAR
#undef PG8_SCHED
}
}

typedef f32x4 AccT[2][2][4][2];
struct EpiStoreBf16 {
    static constexpr bool PERM = true, MIDK = false;
    GAS bf16_t* O; int ldc;
    __device__ __forceinline__ void operator()(const AccT& acc, const pg8::Unit& u, int wr, int wc, int fr, int fq) const {
        const int row0 = u.pm * 256 + wr * 64 + fr, col0 = u.pn * 256 + wc * 32 + 8 * fq;
#pragma unroll
        for (int ai = 0; ai < 2; ++ai)
#pragma unroll
            for (int m = 0; m < 4; ++m) { GAS bf16_t* rowp = O + (size_t)(row0 + ai * 128 + m * 16) * ldc + col0;
#pragma unroll
                for (int bj = 0; bj < 2; ++bj) { const f32x4 v0 = acc[ai][bj][m][0], v1 = acc[ai][bj][m][1];
                    u32x4 w; w.x = cvt_pk_bf16(v0[0], v0[1]); w.y = cvt_pk_bf16(v0[2], v0[3]); w.z = cvt_pk_bf16(v1[0], v1[1]); w.w = cvt_pk_bf16(v1[2], v1[3]);
                    *(GAS u32x4*)(rowp + bj * 128) = w; } }
    }
};
__device__ __forceinline__ float merge_ratio(float ga, float gb) { return (1.f + __expf(-fmaxf(gb, -80.f))) * __builtin_amdgcn_rcpf(1.f + __expf(-ga)); }
__device__ __forceinline__ float merge_final(float gb) { return __builtin_amdgcn_rcpf(1.f + __expf(-fmaxf(gb, -80.f))); }
struct EpiMergeK {
    static constexpr bool PERM = true, MIDK = true;
    const GAS bf16_t* P; GAS bf16_t* O;
    __device__ __forceinline__ void mid(AccT& acc, const pg8::Unit& u, int wr, int wc, int fr, int fq) const {
        asm volatile("" : "+v"(fr), "+v"(fq));
        const int row0 = u.pm * 256 + wr * 64 + fr, col0 = u.pn * 256 + wc * 32 + 8 * fq;
#pragma unroll
        for (int ai = 0; ai < 2; ++ai)
#pragma unroll
            for (int m = 0; m < 4; ++m) { const int r = row0 + ai * 128 + m * 16;
#pragma unroll
                for (int bj = 0; bj < 2; ++bj) { const int c = col0 + bj * 128;
                    const u32x4 a = *(const GAS u32x4*)(P + (size_t)r * PW + PGA + c), b = *(const GAS u32x4*)(P + (size_t)r * PW + PGB + c);
                    acc[ai][bj][m][0][0] *= merge_ratio(bflo(a.x), bflo(b.x)); acc[ai][bj][m][0][1] *= merge_ratio(bfhi(a.x), bfhi(b.x));
                    acc[ai][bj][m][0][2] *= merge_ratio(bflo(a.y), bflo(b.y)); acc[ai][bj][m][0][3] *= merge_ratio(bfhi(a.y), bfhi(b.y));
                    acc[ai][bj][m][1][0] *= merge_ratio(bflo(a.z), bflo(b.z)); acc[ai][bj][m][1][1] *= merge_ratio(bfhi(a.z), bfhi(b.z));
                    acc[ai][bj][m][1][2] *= merge_ratio(bflo(a.w), bflo(b.w)); acc[ai][bj][m][1][3] *= merge_ratio(bfhi(a.w), bfhi(b.w)); } }
    }
    __device__ __forceinline__ void operator()(const AccT& acc, const pg8::Unit& u, int wr, int wc, int fr, int fq) const {
        asm volatile("" : "+v"(fr), "+v"(fq));
        const int row0 = u.pm * 256 + wr * 64 + fr, col0 = u.pn * 256 + wc * 32 + 8 * fq;
#pragma unroll
        for (int ai = 0; ai < 2; ++ai)
#pragma unroll
            for (int m = 0; m < 4; ++m) { const int r = row0 + ai * 128 + m * 16;
#pragma unroll
                for (int bj = 0; bj < 2; ++bj) { const int c = col0 + bj * 128;
                    const u32x4 b = *(const GAS u32x4*)(P + (size_t)r * PW + PGB + c);
                    const f32x4 v0 = acc[ai][bj][m][0], v1 = acc[ai][bj][m][1];
                    u32x4 w; w.x = cvt_pk_bf16(v0[0] * merge_final(bflo(b.x)), v0[1] * merge_final(bfhi(b.x))); w.y = cvt_pk_bf16(v0[2] * merge_final(bflo(b.y)), v0[3] * merge_final(bfhi(b.y)));
                    w.z = cvt_pk_bf16(v1[0] * merge_final(bflo(b.z)), v1[1] * merge_final(bfhi(b.z))); w.w = cvt_pk_bf16(v1[2] * merge_final(bflo(b.w)), v1[3] * merge_final(bfhi(b.w)));
                    *(GAS u32x4*)(O + (size_t)r * D + c) = w; } }
    }
};
struct EpiResid {
    static constexpr bool PERM = false, MIDK = false;
    GAS float* x; const GAS float* gate;
    __device__ __forceinline__ void operator()(const AccT& acc, const pg8::Unit& u, int wr, int wc, int fr, int fq) const {
        const int row0 = u.pm * 256 + wr * 64 + fr, col0 = u.pn * 256 + wc * 32 + 4 * fq;
        const int b = (u.pm < 64) ? (u.pm >> 4) : 4;
        const GAS float* gp = gate + (size_t)b * 6144 + col0;
        f32x4 gv[2][2];
#pragma unroll
        for (int bj = 0; bj < 2; ++bj)
#pragma unroll
            for (int n = 0; n < 2; ++n) gv[bj][n] = *(const GAS f32x4*)(gp + bj * 128 + n * 16);
#pragma unroll
        for (int ai = 0; ai < 2; ++ai)
#pragma unroll
            for (int m = 0; m < 4; ++m) { const int r = row0 + ai * 128 + m * 16; GAS float* rowp = x + (size_t)r * D + col0;
#pragma unroll
                for (int bj = 0; bj < 2; ++bj)
#pragma unroll
                    for (int n = 0; n < 2; ++n) { GAS float* p = rowp + bj * 128 + n * 16; *(GAS f32x4*)p = *(const GAS f32x4*)p + gv[bj][n] * acc[ai][bj][m][n]; } }
    }
};
struct EpiSwiglu {
    static constexpr bool PERM = true, MIDK = false;
    GAS bf16_t* O;
    __device__ __forceinline__ void operator()(const AccT& acc, const pg8::Unit& u, int wr, int wc, int fr, int fq) const {
        const int row0 = u.pm * 256 + wr * 64 + fr, col0 = u.pn * 128 + wc * 32 + 8 * fq;
#pragma unroll
        for (int ai = 0; ai < 2; ++ai)
#pragma unroll
            for (int m = 0; m < 4; ++m) { const int r = row0 + ai * 128 + m * 16;
                float o[8];
#pragma unroll
                for (int n = 0; n < 2; ++n)
#pragma unroll
                    for (int j = 0; j < 4; ++j) { const float a = acc[ai][0][m][n][j], g = acc[ai][1][m][n][j]; o[n * 4 + j] = a * sigmoidf_(a) * g; }
                u32x4 w; w.x = cvt_pk_bf16(o[0], o[1]); w.y = cvt_pk_bf16(o[2], o[3]); w.z = cvt_pk_bf16(o[4], o[5]); w.w = cvt_pk_bf16(o[6], o[7]);
                *(GAS u32x4*)(O + (size_t)r * FF + col0) = w; }
    }
};

struct CEpiMergeK { const GAS bf16_t* P; GAS bf16_t* O; static constexpr bool MIDK = true;
    __device__ __forceinline__ void mid(f32x4& acc, int r, int c) const { const u32x2 a = *(const GAS u32x2*)(P + (size_t)r * PW + PGA + c), b = *(const GAS u32x2*)(P + (size_t)r * PW + PGB + c);
        acc[0] *= merge_ratio(bflo(a.x), bflo(b.x)); acc[1] *= merge_ratio(bfhi(a.x), bfhi(b.x)); acc[2] *= merge_ratio(bflo(a.y), bflo(b.y)); acc[3] *= merge_ratio(bfhi(a.y), bfhi(b.y)); }
    __device__ __forceinline__ void operator()(const f32x4& acc, int r, int c) const { const u32x2 b = *(const GAS u32x2*)(P + (size_t)r * PW + PGB + c);
        u32x2 w; w.x = cvt_pk_bf16(acc[0] * merge_final(bflo(b.x)), acc[1] * merge_final(bfhi(b.x))); w.y = cvt_pk_bf16(acc[2] * merge_final(bflo(b.y)), acc[3] * merge_final(bfhi(b.y)));
        *(GAS u32x2*)(O + (size_t)r * D + c) = w; } };
struct CEpiResid { GAS float* x; const GAS float* gate; static constexpr bool MIDK = false;
    __device__ __forceinline__ void mid(f32x4&, int, int) const {}
    __device__ __forceinline__ void operator()(const f32x4& acc, int r, int c) const { GAS float* p = x + (size_t)r * D + c; *(GAS f32x4*)p = *(const GAS f32x4*)p + *(const GAS f32x4*)(gate + c) * acc; } };
template <class Epi>
__device__ __forceinline__ void ctx_gemm(LAS unsigned char* lds, const GAS bf16_t* X, int ldx, const GAS bf16_t* Wt, int ldw, int K, const Epi& E) {
    int tid = threadIdx.x; asm volatile("" : "+v"(tid));
    const int wave = tid >> 6, lane = tid & 63, li = lane & 15, kg = lane >> 4, rb = wave & 3, ch = wave >> 2;
    constexpr int PITCH = 272, XB = 64 * PITCH, BUF = 2 * XB;
    const int nk = K >> 7;
    for (int tile = blockIdx.x; tile < 256; tile += gridDim.x) {
        const int row0 = TL + (tile >> 4) * 64, col0 = (tile & 15) * 64;
        const int pr0 = tid >> 4, pc = tid & 15, pr1 = pr0 + 32;
        const GAS bf16_t* xs0 = X + (size_t)(row0 + pr0) * ldx + 8 * pc; const GAS bf16_t* xs1 = X + (size_t)(row0 + pr1) * ldx + 8 * pc;
        const GAS bf16_t* ws0 = Wt + (size_t)(col0 + pr0) * ldw + 8 * pc; const GAS bf16_t* ws1 = Wt + (size_t)(col0 + pr1) * ldw + 8 * pc;
        const int so0 = pr0 * PITCH + pc * 16, so1 = pr1 * PITCH + pc * 16;
        f32x4 acc[2] = {(f32x4){0.f, 0.f, 0.f, 0.f}, (f32x4){0.f, 0.f, 0.f, 0.f}};
        u32x4 sx0 = *(const GAS u32x4*)xs0, sx1 = *(const GAS u32x4*)xs1, sw0 = *(const GAS u32x4*)ws0, sw1 = *(const GAS u32x4*)ws1;
        *(LAS u32x4*)(lds + so0) = sx0; *(LAS u32x4*)(lds + so1) = sx1; *(LAS u32x4*)(lds + XB + so0) = sw0; *(LAS u32x4*)(lds + XB + so1) = sw1;
        __syncthreads();
        for (int kt = 0; kt < nk; ++kt) {
            const bool more = kt + 1 < nk;
            if (more) { const int ko = (kt + 1) * 128; sx0 = *(const GAS u32x4*)(xs0 + ko); sx1 = *(const GAS u32x4*)(xs1 + ko); sw0 = *(const GAS u32x4*)(ws0 + ko); sw1 = *(const GAS u32x4*)(ws1 + ko); }
            LAS unsigned char* xb = lds + (kt & 1) * BUF; LAS unsigned char* wb = xb + XB;
#pragma unroll
            for (int ks = 0; ks < 4; ++ks) {
                const bf16x8 xf = *(const LAS bf16x8*)(xb + (16 * rb + li) * PITCH + (32 * ks + 8 * kg) * 2);
#pragma unroll
                for (int cb = 0; cb < 2; ++cb) { const bf16x8 wf = *(const LAS bf16x8*)(wb + (32 * ch + 16 * cb + li) * PITCH + (32 * ks + 8 * kg) * 2);
                    acc[cb] = __builtin_amdgcn_mfma_f32_16x16x32_bf16(wf, xf, acc[cb], 0, 0, 0); }
            }
            if constexpr (Epi::MIDK) { if (kt + 1 == (nk >> 1)) {
#pragma unroll
                for (int cb = 0; cb < 2; ++cb) E.mid(acc[cb], row0 + 16 * rb + li, col0 + 32 * ch + 16 * cb + 4 * kg); } }
            if (more) { LAS unsigned char* nb = lds + ((kt + 1) & 1) * BUF;
                *(LAS u32x4*)(nb + so0) = sx0; *(LAS u32x4*)(nb + so1) = sx1; *(LAS u32x4*)(nb + XB + so0) = sw0; *(LAS u32x4*)(nb + XB + so1) = sw1; }
            __syncthreads();
        }
#pragma unroll
        for (int cb = 0; cb < 2; ++cb) E(acc[cb], row0 + 16 * rb + li, col0 + 32 * ch + 16 * cb + 4 * kg);
        __syncthreads();
    }
}

struct Args { const float* in[30]; float* out; unsigned char* ws; int l, e, ph, pad; };
enum { I_X = 0, I_C, I_CTX, I_CCTX, I_WMOD, I_BMOD, I_N1G, I_N2G, I_WIN, I_RPB, I_HCW, I_HCB, I_HW1, I_HB1, I_HW2, I_HB2, I_HW3, I_HFREQ, I_HBIAS,
       I_WPA, I_WPB, I_WO, I_FW1, I_FW3, I_FW2, I_ROUTER, I_MW1, I_MW3, I_MW2, I_FINALG };

constexpr int MISC_OFF = 131072 + 320;
constexpr int PTR_OFF = MISC_OFF + 128;
struct Ctx {
    LAS unsigned char* lds; int tid, lane, wave, G, bid; GAS unsigned char* ws;
};
__device__ __forceinline__ Ctx mk_ctx(LAS unsigned char* lds, GAS unsigned char* ws) {
    Ctx c; int t = threadIdx.x; asm volatile("" : "+v"(t)); asm volatile("" : "+s"(ws)); c.lds = lds; c.tid = t; c.lane = t & 63; c.wave = __builtin_amdgcn_readfirstlane(t >> 6); c.G = gridDim.x; c.bid = blockIdx.x; c.ws = ws; return c;
}
__device__ __forceinline__ const GAS float* inp(const Ctx& c, int i) {
    unsigned ao = (unsigned)(PTR_OFF + 8 * i); asm volatile("" : "+v"(ao));
    const volatile LAS unsigned* p = (const volatile LAS unsigned*)(c.lds + ao);
    const unsigned lo = __builtin_amdgcn_readfirstlane(p[0]), hi = __builtin_amdgcn_readfirstlane(p[1]);
    return (const GAS float*)(((unsigned long long)hi << 32) | (unsigned long long)lo);
}

__device__ __forceinline__ void transpose_item(const GAS float* W, int N, GAS bf16_t* WT, int ldk, int k0, int n0, int drow0, LAS float* scr, int lane) {
    float wv[32];
    const GAS float* wp = W + (size_t)(k0 + (lane >> 5)) * N + n0 + (lane & 31);
#pragma unroll
    for (int i = 0; i < 32; ++i) wv[i] = wp[(size_t)(2 * i) * N];
#pragma unroll
    for (int i = 0; i < 32; ++i) scr[(2 * i + (lane >> 5)) * 33 + (lane & 31)] = wv[i];
    LDS_WAIT(); asm volatile("" ::: "memory");
    const int c = lane & 7;
#pragma unroll
    for (int j = 0; j < 4; ++j) { const int n = (lane >> 3) + 8 * j; const LAS float* s = scr + (8 * c) * 33 + n;
        u32x4 o; o.x = cvt_pk_bf16(s[0 * 33], s[1 * 33]); o.y = cvt_pk_bf16(s[2 * 33], s[3 * 33]); o.z = cvt_pk_bf16(s[4 * 33], s[5 * 33]); o.w = cvt_pk_bf16(s[6 * 33], s[7 * 33]);
        *(GAS u32x4*)(WT + (size_t)(drow0 + n) * ldk + k0 + 8 * c) = o; }
    LDS_WAIT(); asm volatile("" ::: "memory");
}
__device__ __forceinline__ void conv_mat(const GAS float* W, int K, int N, GAS bf16_t* WT, int mode, int& base, int gw, int NGW, LAS float* scr, int lane, int ldk = 0) {
    if (ldk == 0) ldk = K;
    const int nblk = N / 32, nitems = (K / 64) * nblk;
    const int start = (gw - (base % NGW) + NGW) % NGW;
    for (int it = start; it < nitems; it += NGW) {
        const int kb = it / nblk, nb = it % nblk, n0 = nb * 32;
        const int drow0 = mode == 0 ? n0 : ((n0 >> 7) * 256 + (n0 & 127) + (mode == 2 ? 128 : 0));
        transpose_item(W, N, WT, ldk, kb * 64, n0, drow0, scr, lane);
    }
    base += nitems;
}
__device__ __forceinline__ void ph_convert(const Ctx& c0) {
    const Ctx c = mk_ctx(c0.lds, c0.ws);
    GAS unsigned char* ws = c.ws;
    LAS float* scr = (LAS float*)(c.lds + c.wave * 16384);
    const int gw = c.bid * NWAVES + c.wave, NGW = c.G * NWAVES; int base = 0;
    for (int l = 0; l < DEPTH; ++l) {
        conv_mat(inp(c, I_WIN) + (size_t)l * D * PW, D, PW, (GAS bf16_t*)(ws + WS_WIN) + (size_t)l * PW * D, 0, base, gw, NGW, scr, c.lane);
        conv_mat(inp(c, I_WPA) + (size_t)l * 512 * D, 512, D, (GAS bf16_t*)(ws + WS_WPAB) + (size_t)l * D * D, 0, base, gw, NGW, scr, c.lane, D);
        conv_mat(inp(c, I_WPB) + (size_t)l * 512 * D, 512, D, (GAS bf16_t*)(ws + WS_WPAB) + (size_t)l * D * D + 512, 0, base, gw, NGW, scr, c.lane, D);
        conv_mat(inp(c, I_WO) + (size_t)l * D * D, D, D, (GAS bf16_t*)(ws + WS_WO) + (size_t)l * D * D, 0, base, gw, NGW, scr, c.lane);
    }
    for (int i = 0; i < 2; ++i) {
        conv_mat(inp(c, I_FW1) + (size_t)i * D * FF, D, FF, (GAS bf16_t*)(ws + WS_W13D) + (size_t)i * 2 * FF * D, 1, base, gw, NGW, scr, c.lane);
        conv_mat(inp(c, I_FW3) + (size_t)i * D * FF, D, FF, (GAS bf16_t*)(ws + WS_W13D) + (size_t)i * 2 * FF * D, 2, base, gw, NGW, scr, c.lane);
        conv_mat(inp(c, I_FW2) + (size_t)i * FF * D, FF, D, (GAS bf16_t*)(ws + WS_W2D) + (size_t)i * D * FF, 0, base, gw, NGW, scr, c.lane);
    }
    for (int ie = 0; ie < 2 * NE; ++ie) {
        conv_mat(inp(c, I_MW1) + (size_t)ie * D * FF, D, FF, (GAS bf16_t*)(ws + WS_W13M) + (size_t)ie * 2 * FF * D, 1, base, gw, NGW, scr, c.lane);
        conv_mat(inp(c, I_MW3) + (size_t)ie * D * FF, D, FF, (GAS bf16_t*)(ws + WS_W13M) + (size_t)ie * 2 * FF * D, 2, base, gw, NGW, scr, c.lane);
        conv_mat(inp(c, I_MW2) + (size_t)ie * FF * D, FF, D, (GAS bf16_t*)(ws + WS_W2M) + (size_t)ie * D * FF, 0, base, gw, NGW, scr, c.lane);
    }
}

__device__ __forceinline__ void ph_mod(const Ctx& c0) {
    const Ctx c = mk_ctx(c0.lds, c0.ws);
    GAS float* mod = (GAS float*)(c.ws + WS_MOD);
    LAS float* s = (LAS float*)c.lds; LAS float* part = s + 5 * 1024;
    const GAS float* cin = inp(c, I_C); const GAS float* cctx = inp(c, I_CCTX); const GAS float* wmod = inp(c, I_WMOD); const GAS float* bmod = inp(c, I_BMOD);
    for (int i = c.tid; i < 5 * 1024; i += NTHR) { const int r = i >> 10, k = i & 1023; const float v = r < 4 ? cin[r * 1024 + k] : cctx[k]; s[i] = v * sigmoidf_(v); }
    __syncthreads();
    for (int unit = c.bid; unit < DEPTH * 96; unit += c.G) {
        const int l = unit / 96, j0 = (unit % 96) * 64;
        const GAS float* w = wmod + (size_t)l * D * 6144 + j0 + c.lane;
        float acc[5] = {0.f, 0.f, 0.f, 0.f, 0.f};
        const int kb = c.wave * 128;
#pragma unroll 32
        for (int k = 0; k < 128; ++k) { const float wv = w[(size_t)(kb + k) * 6144];
#pragma unroll
            for (int r = 0; r < 5; ++r) acc[r] += s[r * 1024 + kb + k] * wv; }
#pragma unroll
        for (int r = 0; r < 5; ++r) part[(c.wave * 5 + r) * 64 + c.lane] = acc[r];
        __syncthreads();
        if (c.tid < 320) { const int r = c.tid >> 6, ln = c.tid & 63; float sum = 0.f;
#pragma unroll
            for (int w8 = 0; w8 < 8; ++w8) sum += part[(w8 * 5 + r) * 64 + ln];
            mod[(size_t)(l * 5 + r) * 6144 + j0 + ln] = sum + bmod[l * 6144 + j0 + ln]; }
        __syncthreads();
    }
}

__device__ __forceinline__ void ph_filt(const Ctx& c0) {
    const Ctx c = mk_ctx(c0.lds, c0.ws);
    const GAS float* hb1 = inp(c, I_HB1); const GAS float* hw1 = inp(c, I_HW1); const GAS float* hb2 = inp(c, I_HB2); const GAS float* hw2 = inp(c, I_HW2); const GAS float* hfreq = inp(c, I_HFREQ); const GAS float* hw3 = inp(c, I_HW3);
    LAS float* zb = (LAS float*)c.lds;
    LAS float* a1 = zb + 16 * 36;
    LAS float* a2 = a1 + 16 * 64;
    const float MINDEC = -3.0701134573253945f, MAXDEC = -15.350567286626973f;
    for (int unit = c.bid; unit < DEPTH * 272; unit += c.G) {
        const int l = unit / 272, uu = unit % 272;
        const int L = uu < 256 ? 4096 : 256, p0 = uu < 256 ? uu * 16 : (uu - 256) * 16;
        for (int i = c.tid; i < 16 * 33; i += NTHR) { const int p = i / 33, q = i % 33; const int pos = p0 + p; float v;
            if (q == 0) v = (float)pos / (float)(L - 1);
            else { const int j = (q - 1) & 15; const double band = 1e-4 + (double)j * ((15.0 - 1e-4) / 15.0); double rev = (double)pos * band / (double)L; rev -= floor(rev);
                v = q <= 16 ? __builtin_amdgcn_cosf((float)rev) : -__builtin_amdgcn_sinf((float)rev); }
            zb[p * 36 + q] = v; }
        __syncthreads();
        for (int i = c.tid; i < 16 * 64; i += NTHR) { const int p = i >> 6, j = i & 63; float s = hb1[l * 64 + j];
            const GAS float* w = hw1 + (size_t)l * 33 * 64 + j;
            for (int q = 0; q < 33; ++q) s += zb[p * 36 + q] * w[q * 64];
            a1[p * 64 + j] = sin_rad(hfreq[l * 128 + j] * s); }
        __syncthreads();
        for (int i = c.tid; i < 16 * 64; i += NTHR) { const int p = i >> 6, j = i & 63; float s = hb2[l * 64 + j];
            const GAS float* w = hw2 + (size_t)l * 64 * 64 + j;
            for (int q = 0; q < 64; ++q) s += a1[p * 64 + q] * w[q * 64];
            a2[p * 64 + j] = sin_rad(hfreq[l * 128 + 64 + j] * s); }
        __syncthreads();
        {
            float acc0[16], acc1[16];
#pragma unroll
            for (int p = 0; p < 16; ++p) { acc0[p] = 0.f; acc1[p] = 0.f; }
            const GAS float* w3 = hw3 + (size_t)l * 64 * 1024 + c.tid;
            for (int k = 0; k < 64; k += 4) { float wa[4], wb[4];
#pragma unroll
                for (int q = 0; q < 4; ++q) { wa[q] = w3[(k + q) * 1024]; wb[q] = w3[(k + q) * 1024 + 512]; }
#pragma unroll
                for (int p = 0; p < 16; ++p) { const f32x4 av = *(const LAS f32x4*)(a2 + p * 64 + k);
#pragma unroll
                    for (int q = 0; q < 4; ++q) { acc0[p] += av[q] * wa[q]; acc1[p] += av[q] * wb[q]; } } }
            GAS bf16_t* hro = uu < 256 ? (GAS bf16_t*)(c.ws + WS_HRL) + ((size_t)(l * 2) * 512 + c.tid) * (4096 + 64) : (GAS bf16_t*)(c.ws + WS_HRC) + ((size_t)(l * 2) * 512 + c.tid) * (256 + 64);
            const size_t ostride = (size_t)512 * (L + 64);
            float f0[16], f1[16];
            const float r0 = fabsf(MINDEC + (float)c.tid * ((MAXDEC - MINDEC) / 1023.f)), r1 = fabsf(MINDEC + (float)(c.tid + 512) * ((MAXDEC - MINDEC) / 1023.f));
#pragma unroll
            for (int p = 0; p < 16; ++p) { const int pos = p0 + p; const float dist = fabsf((float)(pos - L / 2)) * (2.f / (float)L);
                f0[p] = acc0[p] * (__expf(-dist * r0) + 0.05f); f1[p] = acc1[p] * (__expf(-dist * r1) + 0.05f); }
            {   u32x4 w0, w1, v0, v1;
                w0.x = cvt_pk_bf16(f0[15], f0[14]); w0.y = cvt_pk_bf16(f0[13], f0[12]); w0.z = cvt_pk_bf16(f0[11], f0[10]); w0.w = cvt_pk_bf16(f0[9], f0[8]);
                w1.x = cvt_pk_bf16(f0[7], f0[6]); w1.y = cvt_pk_bf16(f0[5], f0[4]); w1.z = cvt_pk_bf16(f0[3], f0[2]); w1.w = cvt_pk_bf16(f0[1], f0[0]);
                v0.x = cvt_pk_bf16(f1[15], f1[14]); v0.y = cvt_pk_bf16(f1[13], f1[12]); v0.z = cvt_pk_bf16(f1[11], f1[10]); v0.w = cvt_pk_bf16(f1[9], f1[8]);
                v1.x = cvt_pk_bf16(f1[7], f1[6]); v1.y = cvt_pk_bf16(f1[5], f1[4]); v1.z = cvt_pk_bf16(f1[3], f1[2]); v1.w = cvt_pk_bf16(f1[1], f1[0]);
                GAS bf16_t* d0 = hro + (L + 16 - p0); GAS bf16_t* d1 = d0 + ostride;
                *(GAS u32x4*)d0 = w0; *(GAS u32x4*)(d0 + 8) = w1; *(GAS u32x4*)d1 = v0; *(GAS u32x4*)(d1 + 8) = v1;
                const u32x4 z4 = (u32x4){0u, 0u, 0u, 0u};
                if (p0 == 0) { for (int k = 0; k < 4; ++k) { *(GAS u32x4*)(hro + L + 32 + 8 * k) = z4; *(GAS u32x4*)(hro + ostride + L + 32 + 8 * k) = z4; } }
                if (p0 == L - 16) { for (int k = 0; k < 4; ++k) { *(GAS u32x4*)(hro + 8 * k) = z4; *(GAS u32x4*)(hro + ostride + 8 * k) = z4; } } }
        }
        __syncthreads();
    }
}

struct MoeComb { const GAS int* route; const GAS float* rwt; const GAS bf16_t* y; const GAS float* gate; };
__device__ __forceinline__ void moe_combine_row(const MoeComb& mc, const LAS unsigned* offs, int row, int b, int lane, f32x4 (&v)[4]) {
    const int e1 = mc.route[(size_t)row * 4 + 0], p1 = mc.route[(size_t)row * 4 + 1], e2 = mc.route[(size_t)row * 4 + 2], p2 = mc.route[(size_t)row * 4 + 3];
    const float w1 = mc.rwt[(size_t)row * 2], w2 = mc.rwt[(size_t)row * 2 + 1];
    const size_t s1 = (size_t)offs[e1] + p1, s2 = (size_t)offs[e2] + p2;
    const GAS float* gt = mc.gate + (size_t)b * 6144;
#pragma unroll
    for (int j = 0; j < 4; ++j) { const int k0 = 4 * (lane + 64 * j);
        const u32x2 a = *(const GAS u32x2*)(mc.y + s1 * D + k0), bq = *(const GAS u32x2*)(mc.y + s2 * D + k0); const f32x4 g4 = *(const GAS f32x4*)(gt + k0);
        v[j][0] += g4[0] * (w1 * bflo(a.x) + w2 * bflo(bq.x)); v[j][1] += g4[1] * (w1 * bfhi(a.x) + w2 * bfhi(bq.x));
        v[j][2] += g4[2] * (w1 * bflo(a.y) + w2 * bflo(bq.y)); v[j][3] += g4[3] * (w1 * bfhi(a.y) + w2 * bfhi(bq.y)); }
}
__device__ __forceinline__ void moe_offsets(const Ctx& c, int i, LAS unsigned* offs) {
    if (c.tid == 0) { const GAS unsigned* cnt = (const GAS unsigned*)(c.ws + WS_CTL) + CW_CNT + 64 * i; unsigned o = 0;
        for (int e = 0; e < 8; ++e) { offs[e] = o; o += (cnt[e] + 255u) & ~255u; } offs[8] = o; }
}
__device__ __forceinline__ void ph_norm(const Ctx& c0, int l, int which) {
    const Ctx c = mk_ctx(c0.lds, c0.ws);
    GAS float* xres = (GAS float*)(c.ws + WS_X); GAS bf16_t* h = (GAS bf16_t*)(c.ws + WS_H);
    const GAS float* mod = (const GAS float*)(c.ws + WS_MOD) + (size_t)l * 5 * 6144;
    const GAS float* gp = (which == 0 ? inp(c, I_N1G) : inp(c, I_N2G)) + l * D;
    const bool first = (l == 0 && which == 0), route = (which == 1 && (l & 1));
    const int comb = (which == 0 && l >= 1 && ((l - 1) & 1)) ? ((l - 1) >> 1) : -1;
    const GAS float* router = inp(c, I_ROUTER) + (size_t)(l >> 1) * D * NE;
    GAS int* routeb = (GAS int*)(c.ws + WS_ROUTE); GAS float* rwt = (GAS float*)(c.ws + WS_RWT); GAS int* tokenof = (GAS int*)(c.ws + WS_TOK);
    const MoeComb mc{routeb, rwt, (const GAS bf16_t*)(c.ws + WS_Y), (const GAS float*)(c.ws + WS_MOD) + (size_t)(l > 0 ? l - 1 : 0) * 5 * 6144 + 5 * 1024};
    LAS unsigned* lcnt = (LAS unsigned*)c.lds; LAS unsigned* gbase = lcnt + 16; LAS unsigned* offs = lcnt + 32; LAS int* pend = (LAS int*)(c.lds + 256);
    if (c.tid < 8) lcnt[c.tid] = 0u;
    if (comb >= 0) moe_offsets(c, comb, offs);
    LAS float* rlds = (LAS float*)(c.lds + 4096);
    if (route) { for (int i = c.tid; i < D * NE / 4; i += NTHR) *(LAS f32x4*)(rlds + 4 * i) = *(const GAS f32x4*)(router + 4 * i); }
    LAS float* gsl = (LAS float*)(c.lds + 40960); LAS float* shl = gsl + 5 * 1024;
    for (int i = c.tid; i < 5 * 256; i += NTHR) { const int bb = i >> 8, k0 = (i & 255) * 4; const GAS float* shp = mod + (size_t)bb * 6144 + (which == 0 ? 0 : 3) * 1024;
        const f32x4 g4 = *(const GAS f32x4*)(gp + k0), s4 = *(const GAS f32x4*)(shp + 1024 + k0), h4 = *(const GAS f32x4*)(shp + k0);
        *(LAS f32x4*)(gsl + bb * 1024 + k0) = g4 * (s4 + 1.f); *(LAS f32x4*)(shl + bb * 1024 + k0) = h4; }
    __syncthreads();
    const GAS float* xin = inp(c, I_X); const GAS float* ctxin = inp(c, I_CTX);
    int nrows = 0;
    const int nrow_all = (which == 1 && l == DEPTH - 1) ? TL : T;
#define NORM_SRC(rw) (first ? ((rw) < TL ? xin + (size_t)(rw) * D : ctxin + (size_t)((rw) - TL) * D) : xres + (size_t)(rw) * D)
    const int rstride = c.G * NWAVES;
    f32x4 vnx[4];
    { const int row = c.bid * NWAVES + c.wave; if (row < nrow_all) { const GAS float* src = NORM_SRC(row);
#pragma unroll
        for (int j = 0; j < 4; ++j) vnx[j] = *(const GAS f32x4*)(src + 4 * (c.lane + 64 * j)); } }
    for (int row = c.bid * NWAVES + c.wave; row < nrow_all; row += rstride, ++nrows) {
        const int b = row < TL ? (row >> 12) : 4;
        f32x4 v[4]; float ss = 0.f;
#pragma unroll
        for (int j = 0; j < 4; ++j) v[j] = vnx[j];
        if (row + rstride < nrow_all) { const GAS float* srcn = NORM_SRC(row + rstride);
#pragma unroll
            for (int j = 0; j < 4; ++j) vnx[j] = *(const GAS f32x4*)(srcn + 4 * (c.lane + 64 * j)); }
        if (comb >= 0) moe_combine_row(mc, offs, row, b, c.lane, v);
#pragma unroll
        for (int j = 0; j < 4; ++j) ss += (v[j][0] * v[j][0] + v[j][1] * v[j][1]) + (v[j][2] * v[j][2] + v[j][3] * v[j][3]);
        ss = wave_sum(ss, c.lane);
        const float rstd = 1.f / sqrtf(ss * (1.f / D) + EPS);
        if (first || comb >= 0) {
#pragma unroll
            for (int j = 0; j < 4; ++j) *(GAS f32x4*)(xres + (size_t)row * D + 4 * (c.lane + 64 * j)) = v[j];
        }
        float lg[8] = {0.f, 0.f, 0.f, 0.f, 0.f, 0.f, 0.f, 0.f};
#pragma unroll
        for (int j = 0; j < 4; ++j) { const int k0 = 4 * (c.lane + 64 * j);
            const f32x4 g4 = *(const LAS f32x4*)(gsl + b * 1024 + k0), h4 = *(const LAS f32x4*)(shl + b * 1024 + k0);
            f32x4 o;
#pragma unroll
            for (int q = 0; q < 4; ++q) o[q] = v[j][q] * rstd * g4[q] + h4[q];
            u32x2 w; w.x = cvt_pk_bf16(o[0], o[1]); w.y = cvt_pk_bf16(o[2], o[3]);
            *(GAS u32x2*)(h + (size_t)row * D + k0) = w;
            if (route) {
#pragma unroll
                for (int q = 0; q < 4; ++q) { const f32x4 ra = *(const LAS f32x4*)(rlds + (k0 + q) * 8), rb = *(const LAS f32x4*)(rlds + (k0 + q) * 8 + 4);
                    lg[0] += o[q] * ra[0]; lg[1] += o[q] * ra[1]; lg[2] += o[q] * ra[2]; lg[3] += o[q] * ra[3];
                    lg[4] += o[q] * rb[0]; lg[5] += o[q] * rb[1]; lg[6] += o[q] * rb[2]; lg[7] += o[q] * rb[3]; }
            }
        }
        if (route) {
#pragma unroll
            for (int e = 0; e < 8; ++e) lg[e] = wave_sum(lg[e], c.lane);
            int i1 = 0; float v1 = lg[0];
#pragma unroll
            for (int e = 1; e < 8; ++e) if (lg[e] > v1) { v1 = lg[e]; i1 = e; }
            int i2 = -1; float v2 = -3.0e38f;
#pragma unroll
            for (int e = 0; e < 8; ++e) if (e != i1 && lg[e] > v2) { v2 = lg[e]; i2 = e; }
            const float w1 = 1.f / (1.f + __expf(v2 - v1)), w2 = 1.f - w1;
            if (c.lane == 0) {
                const unsigned lp1 = __hip_atomic_fetch_add(lcnt + i1, 1u, __ATOMIC_RELAXED, __HIP_MEMORY_SCOPE_WORKGROUP), lp2 = __hip_atomic_fetch_add(lcnt + i2, 1u, __ATOMIC_RELAXED, __HIP_MEMORY_SCOPE_WORKGROUP);
                LAS int* pe = pend + (c.wave * 16 + nrows) * 4; pe[0] = row; pe[1] = i1 | (i2 << 8); pe[2] = (int)lp1; pe[3] = (int)lp2;
                rwt[(size_t)row * 2] = w1; rwt[(size_t)row * 2 + 1] = w2; }
        }
    }
    if (route) {
        __syncthreads();
        if (c.tid < 8) gbase[c.tid] = __hip_atomic_fetch_add((GAS unsigned*)(c.ws + WS_CTL) + CW_CNT + 64 * (l >> 1) + c.tid, lcnt[c.tid], __ATOMIC_RELAXED, __HIP_MEMORY_SCOPE_AGENT);
        __syncthreads();
        if (c.lane < nrows) { const LAS int* pe = pend + (c.wave * 16 + c.lane) * 4; const int row = pe[0], e1 = pe[1] & 255, e2 = pe[1] >> 8;
            const int p1 = (int)gbase[e1] + pe[2], p2 = (int)gbase[e2] + pe[3];
            tokenof[(size_t)e1 * T + p1] = row; tokenof[(size_t)e2 * T + p2] = row;
            routeb[(size_t)row * 4 + 0] = e1; routeb[(size_t)row * 4 + 1] = p1; routeb[(size_t)row * 4 + 2] = e2; routeb[(size_t)row * 4 + 3] = p2; }
    }
    __syncthreads();
}

__device__ __forceinline__ void ph_sc(const Ctx& c0, int l) {
    const Ctx c = mk_ctx(c0.lds, c0.ws);
    const GAS bf16_t* P = (const GAS bf16_t*)(c.ws + WS_P); GAS bf16_t* uT = (GAS bf16_t*)(c.ws + WS_B); GAS bf16_t* VT = (GAS bf16_t*)(c.ws + WS_VT);
    const GAS float* cw = inp(c, I_HCW) + (size_t)l * 3 * 1536; const GAS float* cb = inp(c, I_HCB) + (size_t)l * 1536;
    LAS unsigned char* scr = c.lds + c.wave * 16384;
    for (int tile = c.bid * NWAVES + c.wave; tile < (T / 64) * 32; tile += c.G * NWAVES) {
        const int rt = tile / 32, row0 = rt * 64, ct = tile % 32; const bool isv = ct >= 24;
        const int ch0 = isv ? (ct - 24) * 64 : ct * 64, scol = isv ? PV + ch0 : PHY + ch0; GAS bf16_t* dst = isv ? VT : uT;
        const int tpos = row0 < TL ? (row0 & 4095) : ((row0 - TL) & 255), Ls = row0 < TL ? 4096 : 256;
        for (int idx = c.lane; idx < 66 * 8; idx += 64) { const int rr = idx >> 3, ck = idx & 7; const int grow = row0 - 1 + rr;
            const bool ok = !((rr == 0 && tpos == 0) || (rr == 65 && tpos + 64 == Ls));
            u32x4 v = (u32x4){0u, 0u, 0u, 0u};
            if (ok) v = *(const GAS u32x4*)(P + (size_t)grow * PW + scol + ck * 8);
            LAS unsigned* d = (LAS unsigned*)(scr + rr * 132 + ck * 16); d[0] = v.x; d[1] = v.y; d[2] = v.z; d[3] = v.w; }
        LDS_WAIT(); asm volatile("" ::: "memory");
        const int ch = ch0 + c.lane; const float w0 = isv ? 0.f : cw[ch], w1 = isv ? 1.f : cw[1536 + ch], w2 = isv ? 0.f : cw[3072 + ch], bb = isv ? 0.f : cb[ch];
        unsigned ow[32];
        { float prev = bf2f(*(const LAS unsigned short*)(scr + 0 * 132 + c.lane * 2)), cur = bf2f(*(const LAS unsigned short*)(scr + 1 * 132 + c.lane * 2)); float o0 = 0.f;
#pragma unroll
          for (int r = 0; r < 64; ++r) { const float nxt = bf2f(*(const LAS unsigned short*)(scr + (r + 2) * 132 + c.lane * 2));
              const float o = w0 * prev + w1 * cur + w2 * nxt + bb; prev = cur; cur = nxt;
              if (r & 1) ow[r >> 1] = cvt_pk_bf16(o0, o); else o0 = o; } }
        LDS_WAIT(); asm volatile("" ::: "memory");
#pragma unroll
        for (int k = 0; k < 8; ++k) { u32x4 v; v.x = ow[4 * k]; v.y = ow[4 * k + 1]; v.z = ow[4 * k + 2]; v.w = ow[4 * k + 3]; *(LAS u32x4*)(scr + c.lane * 144 + k * 16) = v; }
        LDS_WAIT(); asm volatile("" ::: "memory");
#pragma unroll
        for (int k = 0; k < 8; ++k) { const int cc = (c.lane >> 3) + 8 * k, ck = c.lane & 7; const u32x4 v = *(const LAS u32x4*)(scr + cc * 144 + ck * 16);
            *(GAS u32x4*)(dst + (size_t)(ch0 + cc) * T + row0 + ck * 8) = v; }
        LDS_WAIT(); asm volatile("" ::: "memory");
    }
}

constexpr int HY_HR_OFF = 512, HY_U_OFF = HY_HR_OFF + 66560, HY_ZB_OFF = HY_U_OFF + 4 * 8208;
template <int L, bool DUAL>
__device__ __forceinline__ void hy_span(LAS unsigned char* lds, int nsteps, int aaddr, int ubase, int sX, int sY, f32x16& accX, f32x16& accY) {
#define HY_BADDR(sv) (((unsigned)(sv) <= (unsigned)(L - 16)) ? ubase + 2 * (sv) : HY_ZB_OFF)
    int k = 0;
    for (; k + 4 <= nsteps; k += 4) {
        const int pa = aaddr - 768;
        const int px0 = HY_BADDR(sX), px1 = HY_BADDR(sX - 16), px2 = HY_BADDR(sX - 32), px3 = HY_BADDR(sX - 48);
        bf16x8 a0, a1, a2, a3, x0, x1, x2, x3;
        if (DUAL) {
            const int py0 = HY_BADDR(sY), py1 = HY_BADDR(sY - 16), py2 = HY_BADDR(sY - 32), py3 = HY_BADDR(sY - 48);
            bf16x8 y0, y1, y2, y3;
            asm volatile(
                "ds_read_b128 %[a0], %[pa] offset:768\n\tds_read_b128 %[x0], %[px0]\n\tds_read_b128 %[y0], %[py0]\n\t"
                "ds_read_b128 %[a1], %[pa] offset:512\n\tds_read_b128 %[x1], %[px1]\n\tds_read_b128 %[y1], %[py1]\n\t"
                "ds_read_b128 %[a2], %[pa] offset:256\n\tds_read_b128 %[x2], %[px2]\n\tds_read_b128 %[y2], %[py2]\n\t"
                "ds_read_b128 %[a3], %[pa]\n\tds_read_b128 %[x3], %[px3]\n\tds_read_b128 %[y3], %[py3]\n\t"
                "s_waitcnt lgkmcnt(9)\n\tv_mfma_f32_32x32x16_bf16 %[cx], %[a0], %[x0], %[cx]\n\tv_mfma_f32_32x32x16_bf16 %[cy], %[a0], %[y0], %[cy]\n\t"
                "s_waitcnt lgkmcnt(6)\n\tv_mfma_f32_32x32x16_bf16 %[cx], %[a1], %[x1], %[cx]\n\tv_mfma_f32_32x32x16_bf16 %[cy], %[a1], %[y1], %[cy]\n\t"
                "s_waitcnt lgkmcnt(3)\n\tv_mfma_f32_32x32x16_bf16 %[cx], %[a2], %[x2], %[cx]\n\tv_mfma_f32_32x32x16_bf16 %[cy], %[a2], %[y2], %[cy]\n\t"
                "s_waitcnt lgkmcnt(0)\n\tv_mfma_f32_32x32x16_bf16 %[cx], %[a3], %[x3], %[cx]\n\tv_mfma_f32_32x32x16_bf16 %[cy], %[a3], %[y3], %[cy]\n\t"
                : [cx] "+v"(accX), [cy] "+v"(accY), [a0] "=&v"(a0), [a1] "=&v"(a1), [a2] "=&v"(a2), [a3] "=&v"(a3), [x0] "=&v"(x0), [x1] "=&v"(x1), [x2] "=&v"(x2), [x3] "=&v"(x3),
                  [y0] "=&v"(y0), [y1] "=&v"(y1), [y2] "=&v"(y2), [y3] "=&v"(y3)
                : [pa] "v"(pa), [px0] "v"(px0), [px1] "v"(px1), [px2] "v"(px2), [px3] "v"(px3), [py0] "v"(py0), [py1] "v"(py1), [py2] "v"(py2), [py3] "v"(py3));
        } else {
            asm volatile(
                "ds_read_b128 %[a0], %[pa] offset:768\n\tds_read_b128 %[x0], %[px0]\n\t"
                "ds_read_b128 %[a1], %[pa] offset:512\n\tds_read_b128 %[x1], %[px1]\n\t"
                "ds_read_b128 %[a2], %[pa] offset:256\n\tds_read_b128 %[x2], %[px2]\n\t"
                "ds_read_b128 %[a3], %[pa]\n\tds_read_b128 %[x3], %[px3]\n\t"
                "s_waitcnt lgkmcnt(6)\n\tv_mfma_f32_32x32x16_bf16 %[cx], %[a0], %[x0], %[cx]\n\t"
                "s_waitcnt lgkmcnt(4)\n\tv_mfma_f32_32x32x16_bf16 %[cx], %[a1], %[x1], %[cx]\n\t"
                "s_waitcnt lgkmcnt(2)\n\tv_mfma_f32_32x32x16_bf16 %[cx], %[a2], %[x2], %[cx]\n\t"
                "s_waitcnt lgkmcnt(0)\n\tv_mfma_f32_32x32x16_bf16 %[cx], %[a3], %[x3], %[cx]\n\t"
                : [cx] "+v"(accX), [a0] "=&v"(a0), [a1] "=&v"(a1), [a2] "=&v"(a2), [a3] "=&v"(a3), [x0] "=&v"(x0), [x1] "=&v"(x1), [x2] "=&v"(x2), [x3] "=&v"(x3)
                : [pa] "v"(pa), [px0] "v"(px0), [px1] "v"(px1), [px2] "v"(px2), [px3] "v"(px3));
        }
        aaddr -= 1024; sX -= 64; sY -= 64;
    }
    for (; k < nsteps; ++k) {
        const bf16x8 af = *(const LAS bf16x8*)(lds + aaddr), xf = *(const LAS bf16x8*)(lds + HY_BADDR(sX));
        accX = __builtin_amdgcn_mfma_f32_32x32x16_bf16(af, xf, accX, 0, 0, 0);
        if (DUAL) { const bf16x8 yf = *(const LAS bf16x8*)(lds + HY_BADDR(sY)); accY = __builtin_amdgcn_mfma_f32_32x32x16_bf16(af, yf, accY, 0, 0, 0); }
        aaddr -= 256; sX -= 16; sY -= 16;
    }
#undef HY_BADDR
}
template <int L>
__device__ __forceinline__ void hy_unit(const Ctx& c, int l, int ch, const GAS float* hbias) {
    constexpr int H = L / 2, NG = L / 256, LP = L + 64, NW = L / 8 + 8, ROWB = 2 * L + 16;
    LAS unsigned char* lds = c.lds;
    const GAS bf16_t* uT = (const GAS bf16_t*)(c.ws + WS_B); GAS bf16_t* oht = (GAS bf16_t*)(c.ws + WS_OHT);
    const int seq0 = (L == 4096) ? 0 : TL;
    const GAS bf16_t* hrbase = (L == 4096) ? (const GAS bf16_t*)(c.ws + WS_HRL) : (const GAS bf16_t*)(c.ws + WS_HRC);
    int gA, gB;
    if (NG == 16) { gA = c.wave < 4 ? c.wave : 4 + c.wave; gB = c.wave < 4 ? 7 - c.wave : 19 - c.wave; } else { gA = c.wave == 0 ? 0 : -1; gB = -1; }
    const int n = c.lane & 31, g = c.lane >> 5, tbl = n >> 2, b = n & 3;
    const int loA = gA < 0 ? 1 << 30 : max(-H - 16, 256 * gA - (L - 16)), hiA = gA < 0 ? -(1 << 30) : min(H, 256 * gA + 224);
    const int loB = gB < 0 ? 1 << 30 : max(-H - 16, 256 * gB - (L - 16)), hiB = gB < 0 ? -(1 << 30) : min(H, 256 * gB + 224);
    const int dlo = min(loA, loB), dhi = max(hiA, hiB);
    unsigned zreg[2][4][2];
    u32x4 fwA[2], fwB[2];
#define HY_LOAD_FW(oo) do { const GAS bf16_t* hr_ = hrbase + ((size_t)(l * 2 + (oo)) * 512 + ch) * LP; _Pragma("unroll") for (int k_ = 0; k_ < 2; ++k_) { const int w_ = c.tid + NTHR * k_; \
        const int wc_ = w_ < NW ? w_ : 0; fwA[k_] = *(const GAS u32x4*)(hr_ + 8 * (wc_ > 0 ? wc_ - 1 : 0)); fwB[k_] = *(const GAS u32x4*)(hr_ + 8 * wc_); } } while (0)
    HY_LOAD_FW(0);
    for (int o = 0; o < 2; ++o) {
#pragma unroll
        for (int kf = 0; kf < 2; ++kf) { const int w = c.tid + NTHR * kf; if (w < NW) {
            const u32x4 A4 = w > 0 ? fwA[kf] : (u32x4){0u, 0u, 0u, 0u}, B4 = fwB[kf];
            const unsigned Dd[8] = {A4.x, A4.y, A4.z, A4.w, B4.x, B4.y, B4.z, B4.w};
#pragma unroll
            for (int q = 0; q < 8; ++q) { u32x4 ov;
                if ((q & 1) == 0) { const int j = (8 - q) / 2; ov.x = Dd[j]; ov.y = Dd[j + 1]; ov.z = Dd[j + 2]; ov.w = Dd[j + 3]; }
                else { const int j = (7 - q) / 2; ov.x = __builtin_amdgcn_alignbit(Dd[j + 1], Dd[j], 16); ov.y = __builtin_amdgcn_alignbit(Dd[j + 2], Dd[j + 1], 16);
                       ov.z = __builtin_amdgcn_alignbit(Dd[j + 3], Dd[j + 2], 16); ov.w = __builtin_amdgcn_alignbit(Dd[j + 4], Dd[j + 3], 16); }
                *(LAS u32x4*)(lds + HY_HR_OFF + (8 * w + q) * 16) = ov; }
        } }
        if (o == 0) {
            for (int idx = c.tid; idx < 4 * (L / 8); idx += NTHR) { const int bb = idx / (L / 8), wq = idx % (L / 8);
                *(LAS u32x4*)(lds + HY_U_OFF + bb * ROWB + wq * 16) = *(const GAS u32x4*)(uT + (size_t)ch * T + seq0 + bb * L + wq * 8); }
            if (c.tid < 16) *(LAS unsigned*)(lds + HY_ZB_OFF + c.tid * 4) = 0u;
        } else {
#pragma unroll
            for (int gi = 0; gi < 2; ++gi) { const int G = gi == 0 ? gA : gB; if (G >= 0) {
#pragma unroll
                for (int rq = 0; rq < 4; ++rq) { const int t = 32 * (8 * G + tbl) + 8 * rq + 4 * g;
                    u32x2 zz; zz.x = zreg[gi][rq][0]; zz.y = zreg[gi][rq][1]; *(LAS u32x2*)(lds + HY_U_OFF + b * ROWB + 2 * t) = zz; } } }
        }
        __syncthreads();
        u32x2 xv[2][4];
#pragma unroll
        for (int gi = 0; gi < 2; ++gi) { const int G = gi == 0 ? gA : gB;
#pragma unroll
            for (int rq = 0; rq < 4; ++rq)
                xv[gi][rq] = *(const GAS u32x2*)(uT + (size_t)((o == 0 ? 512 : 1024) + ch) * T + (size_t)seq0 + b * L + 32 * (8 * (G >= 0 ? G : 0) + tbl) + 8 * rq + 4 * g); }
        if (o == 0) HY_LOAD_FW(1);
        __builtin_amdgcn_sched_barrier(0);
        f32x16 accA, accB;
#pragma unroll
        for (int r = 0; r < 16; ++r) { accA[r] = 0.f; accB[r] = 0.f; }
        {
            const int qq = (n + 1) & 7, ubase = HY_U_OFF + b * ROWB + 16 * g;
#define HY_AADDR(d) (HY_HR_OFF + (8 * ((H + 31 - (d) - n + 8 * g + qq) >> 3) + qq) * 16)
#define HY_S0(G, d) (32 * (8 * (G) + tbl) - (d))
            if (gB < 0) { if (gA >= 0) hy_span<L, false>(lds, (hiA - loA) / 16 + 1, HY_AADDR(loA), ubase, HY_S0(gA, loA), 0, accA, accB); }
            else {
                const int dS = max(loA, loB), dE = min(hiA, hiB);
                if (loA < dS) hy_span<L, false>(lds, (dS - loA) / 16, HY_AADDR(loA), ubase, HY_S0(gA, loA), 0, accA, accB);
                else if (loB < dS) hy_span<L, false>(lds, (dS - loB) / 16, HY_AADDR(loB), ubase, HY_S0(gB, loB), 0, accB, accA);
                hy_span<L, true>(lds, (dE - dS) / 16 + 1, HY_AADDR(dS), ubase, HY_S0(gA, dS), HY_S0(gB, dS), accA, accB);
                if (hiA > dE) hy_span<L, false>(lds, (hiA - dE) / 16, HY_AADDR(dE + 16), ubase, HY_S0(gA, dE + 16), 0, accA, accB);
                else if (hiB > dE) hy_span<L, false>(lds, (hiB - dE) / 16, HY_AADDR(dE + 16), ubase, HY_S0(gB, dE + 16), 0, accB, accA);
            }
#undef HY_AADDR
#undef HY_S0
        }
        const float bias = hbias[(l * 2 + o) * 512 + ch];
        int tbl_e = tbl, b_e = b, g_e = g; asm volatile("" : "+v"(tbl_e), "+v"(b_e), "+v"(g_e));
#pragma unroll
        for (int gi = 0; gi < 2; ++gi) { const int G = gi == 0 ? gA : gB; if (G >= 0) {
#pragma unroll
            for (int rq = 0; rq < 4; ++rq) { const int t = 32 * (8 * G + tbl_e) + 8 * rq + 4 * g_e;
                const u32x2 uv = *(const LAS u32x2*)(lds + HY_U_OFF + b_e * ROWB + 2 * t);
                const size_t grow = (size_t)seq0 + b_e * L + t;
                const u32x2 xvv = xv[gi][rq];
                float y[4];
#pragma unroll
                for (int k = 0; k < 4; ++k) y[k] = gi == 0 ? accA[4 * rq + k] : accB[4 * rq + k];
                const float r0 = bflo(xvv.x) * (y[0] + bias * bflo(uv.x)), r1 = bfhi(xvv.x) * (y[1] + bias * bfhi(uv.x));
                const float r2 = bflo(xvv.y) * (y[2] + bias * bflo(uv.y)), r3 = bfhi(xvv.y) * (y[3] + bias * bfhi(uv.y));
                const unsigned p0 = cvt_pk_bf16(r0, r1), p1 = cvt_pk_bf16(r2, r3);
                if (o == 0) { zreg[gi][rq][0] = p0; zreg[gi][rq][1] = p1; }
                else { u32x2 ov; ov.x = p0; ov.y = p1; *(GAS u32x2*)(oht + (size_t)ch * T + grow) = ov;   } } } }
        __syncthreads();
    }
}
#undef HY_LOAD_FW
__device__ __forceinline__ void ph_hyena(const Ctx& c0, int l) {
    const Ctx c = mk_ctx(c0.lds, c0.ws);
    const GAS float* hbias = inp(c, I_HBIAS);
    for (int unit = c.bid; unit < HYW; unit += c.G) { hy_unit<4096>(c, l, unit, hbias); if (l < DEPTH - 1) hy_unit<256>(c, l, unit, hbias); }
}

__device__ __forceinline__ void ph_ohy_t(const Ctx& c0) {
    const Ctx c = mk_ctx(c0.lds, c0.ws);
    const GAS bf16_t* src = (const GAS bf16_t*)(c.ws + WS_OHT); GAS bf16_t* dst = (GAS bf16_t*)(c.ws + WS_OAH) + 512;
    LAS unsigned char* scr = c.lds + c.wave * 16384;
    for (int tile = c.bid * NWAVES + c.wave; tile < (T / 64) * 8; tile += c.G * NWAVES) {
        const int row0 = (tile >> 3) * 64, ch0 = (tile & 7) * 64;
#pragma unroll
        for (int k = 0; k < 8; ++k) { const int cc = (c.lane >> 3) + 8 * k, ck = c.lane & 7;
            const u32x4 v = *(const GAS u32x4*)(src + (size_t)(ch0 + cc) * T + row0 + ck * 8);
            LAS unsigned* d = (LAS unsigned*)(scr + cc * 132 + ck * 16); d[0] = v.x; d[1] = v.y; d[2] = v.z; d[3] = v.w; }
        LDS_WAIT(); asm volatile("" ::: "memory");
        unsigned ow[32];
#pragma unroll
        for (int j = 0; j < 32; ++j) { const unsigned lo = *(const LAS unsigned short*)(scr + (2 * j) * 132 + c.lane * 2), hi = *(const LAS unsigned short*)(scr + (2 * j + 1) * 132 + c.lane * 2); ow[j] = lo | (hi << 16); }
        LDS_WAIT(); asm volatile("" ::: "memory");
#pragma unroll
        for (int k = 0; k < 8; ++k) { u32x4 v; v.x = ow[4 * k]; v.y = ow[4 * k + 1]; v.z = ow[4 * k + 2]; v.w = ow[4 * k + 3]; *(LAS u32x4*)(scr + c.lane * 144 + k * 16) = v; }
        LDS_WAIT(); asm volatile("" ::: "memory");
#pragma unroll
        for (int k = 0; k < 8; ++k) { const int rr = (c.lane >> 3) + 8 * k, ck = c.lane & 7; const u32x4 v = *(const LAS u32x4*)(scr + rr * 144 + ck * 16);
            *(GAS u32x4*)(dst + (size_t)(row0 + rr) * 1024 + ch0 + ck * 8) = v; }
        LDS_WAIT(); asm volatile("" ::: "memory");
    }
}

constexpr int ATT_RPB_OFF = 1024, ATT_VT_OFF = ATT_RPB_OFF + 8 * 15 * 32 * 4, ATT_VT_BYTES = 64 * 72;
template <int MODE>
__device__ __forceinline__ void att_block(const GAS bf16_t* P, const GAS bf16_t* VT, LAS unsigned char* lds, LAS unsigned char* vt, int lane, int n, int h, int head,
                                          int tokk, int ctok, int tabaddr, int vb, const bf16x8 (&qf)[4], f32x16& ot0, f32x16& ot1, float& m, float& lsum) {
    bf16x8 kf[4];
#pragma unroll
    for (int ks = 0; ks < 4; ++ks) kf[ks] = *(const GAS bf16x8*)(P + (size_t)tokk * PW + PK + head * 64 + 16 * ks + 8 * h);
    u32x2 vr[8];
#pragma unroll
    for (int it = 0; it < 8; ++it) vr[it] = *(const GAS u32x2*)(VT + (size_t)(head * 64 + it * 8 + (lane >> 3)) * T + ctok);
    f32x16 st;
#pragma unroll
    for (int r = 0; r < 16; ++r) st[r] = 0.f;
#pragma unroll
    for (int ks = 0; ks < 4; ++ks) st = __builtin_amdgcn_mfma_f32_32x32x16_bf16(kf[ks], qf[ks], st, 0, 0, 0);
    const float SC = 0.18033688011112042f;
    float sv[16];
    if (MODE == 2) {
#pragma unroll
        for (int r = 0; r < 16; ++r) sv[r] = st[r] * SC;
    } else {
        float bias[16];
#pragma unroll
        for (int r = 0; r < 16; ++r) { const int imm = MODE == 0 ? (8 * (r >> 2) + (r & 3)) * 4 : ((r >> 2) * 32 + (r & 3)) * 4; bias[r] = *(const volatile LAS float*)(lds + tabaddr + imm); }
#pragma unroll
        for (int r = 0; r < 16; ++r) { const int cr = MODE == 0 ? 8 * (r >> 2) + (r & 3) : (r & 3);
            const float v = st[r] * SC + bias[r]; sv[r] = ((unsigned)(vb + cr) < 16u) ? v : -1.0e30f; }
    }
    float bm = sv[0];
#pragma unroll
    for (int r = 1; r < 16; ++r) bm = fmaxf(bm, sv[r]);
    bm = fmaxf(bm, __int_as_float(__builtin_amdgcn_ds_bpermute((lane ^ 32) << 2, __float_as_int(bm))));
    const float mn = fmaxf(m, bm), alpha = __builtin_amdgcn_exp2f(m - mn); m = mn;
    float psum = 0.f;
#pragma unroll
    for (int r = 0; r < 16; ++r) { const float pv = __builtin_amdgcn_exp2f(sv[r] - mn); psum += pv; sv[r] = pv; }
    lsum = lsum * alpha + psum;
#pragma unroll
    for (int r = 0; r < 16; ++r) { ot0[r] *= alpha; ot1[r] *= alpha; }
    bf16x8 pb[2];
#pragma unroll
    for (int s2 = 0; s2 < 2; ++s2) { u32x4 w; w.x = cvt_pk_bf16(sv[8 * s2], sv[8 * s2 + 1]); w.y = cvt_pk_bf16(sv[8 * s2 + 2], sv[8 * s2 + 3]);
        w.z = cvt_pk_bf16(sv[8 * s2 + 4], sv[8 * s2 + 5]); w.w = cvt_pk_bf16(sv[8 * s2 + 6], sv[8 * s2 + 7]); pb[s2] = __builtin_bit_cast(bf16x8, w); }
#pragma unroll
    for (int it = 0; it < 8; ++it) *(LAS u32x2*)(vt + (it * 8 + (lane >> 3)) * 72 + (lane & 7) * 8) = vr[it];
#pragma unroll
    for (int s2 = 0; s2 < 2; ++s2) {
        { const u32x2 a = *(const LAS u32x2*)(vt + n * 72 + (4 * s2 + h) * 8), bq = *(const LAS u32x2*)(vt + n * 72 + (4 * s2 + 2 + h) * 8);
          u32x4 w; w.x = a.x; w.y = a.y; w.z = bq.x; w.w = bq.y; ot0 = __builtin_amdgcn_mfma_f32_32x32x16_bf16(__builtin_bit_cast(bf16x8, w), pb[s2], ot0, 0, 0, 0); }
        { const u32x2 a = *(const LAS u32x2*)(vt + (32 + n) * 72 + (4 * s2 + h) * 8), bq = *(const LAS u32x2*)(vt + (32 + n) * 72 + (4 * s2 + 2 + h) * 8);
          u32x4 w; w.x = a.x; w.y = a.y; w.z = bq.x; w.w = bq.y; ot1 = __builtin_amdgcn_mfma_f32_32x32x16_bf16(__builtin_bit_cast(bf16x8, w), pb[s2], ot1, 0, 0, 0); }
    }
}
constexpr int ATT_UNITS = 4096 + 256;
__device__ __forceinline__ void ph_attn(const Ctx& c0, int l) {
    const Ctx c = mk_ctx(c0.lds, c0.ws);
    const GAS bf16_t* P = (const GAS bf16_t*)(c.ws + WS_P); const GAS bf16_t* VT = (const GAS bf16_t*)(c.ws + WS_VT); GAS bf16_t* oatt = (GAS bf16_t*)(c.ws + WS_OAH);
    const GAS float* rpb = inp(c, I_RPB) + (size_t)l * 8 * 15 * 31;
    LAS unsigned char* lds = c.lds;
    for (int i = c.tid; i < 8 * 15 * 32; i += NTHR) { const int hd = i / 480, rem = i % 480, dr = rem >> 5, dc = rem & 31;
        *(LAS float*)(lds + ATT_RPB_OFF + i * 4) = dc < 31 ? rpb[(hd * 15 + dr) * 31 + dc] * 1.4426950408889634f : 0.f; }
    __syncthreads();
    LAS unsigned char* vt = lds + ATT_VT_OFF + c.wave * ATT_VT_BYTES;
    const int lane = c.lane, n = lane & 31, h = lane >> 5;
    const int natt = l < DEPTH - 1 ? ATT_UNITS : 4096;
    for (int u = c.bid * NWAVES + c.wave; u < natt; u += c.G * NWAVES) {
        const bool lat = u < 4096;
        int b, head, r = 0, hf = 0, tokq;
        if (lat) { hf = u & 1; r = (u >> 1) & 63; head = (u >> 7) & 7; b = u >> 10; tokq = b * 4096 + r * 64 + 32 * hf + n; }
        else { const int uu = u - 4096; head = (uu >> 3) & 7; b = uu >> 6; tokq = TL + b * 256 + 32 * (uu & 7) + n; }
        bf16x8 qf[4];
#pragma unroll
        for (int ks = 0; ks < 4; ++ks) qf[ks] = *(const GAS bf16x8*)(P + (size_t)tokq * PW + PQ + head * 64 + 16 * ks + 8 * h);
        f32x16 ot0, ot1;
#pragma unroll
        for (int q = 0; q < 16; ++q) { ot0[q] = 0.f; ot1[q] = 0.f; }
        float m = -1.0e30f, lsum = 0.f;
        if (lat) {
            const int r0 = min(max(r - 4, 0), 56), lo = hf ? 24 : 0, qc = 32 * hf + n, c0q = min(max(qc - 8, 0), 48);
            for (int kb = 0; kb < 8; ++kb) {
                const int base = b * 4096 + (r0 + kb) * 64 + lo, kx = lo + 4 * h;
                const int tabaddr = ATT_RPB_OFF + (((head * 15 + (r0 + kb - r + 7)) * 32) + kx - qc + 15) * 4;
                att_block<0>(P, VT, lds, vt, lane, n, h, head, base + n, base + 4 * (lane & 7), tabaddr, kx - c0q, qf, ot0, ot1, m, lsum);
            }
            for (int kb = 0; kb < 2; ++kb) {
                const int rowb = b * 4096 + (r0 + 4 * kb) * 64 + lo + 32, kx = lo + 32 + 4 * h, cc = lane & 7;
                const int tabaddr = ATT_RPB_OFF + (((head * 15 + (r0 + 4 * kb - r + 7)) * 32) + kx - qc + 15) * 4;
                att_block<1>(P, VT, lds, vt, lane, n, h, head, rowb + (n >> 3) * 64 + (n & 7), rowb + (cc >> 1) * 64 + 4 * (cc & 1), tabaddr, kx - c0q, qf, ot0, ot1, m, lsum);
            }
        }
        for (int kb = 0; kb < 8; ++kb) { const int base = TL + b * 256 + 32 * kb;
            att_block<2>(P, VT, lds, vt, lane, n, h, head, base + n, base + 4 * (lane & 7), 0, 0, qf, ot0, ot1, m, lsum); }
        const float ltot = lsum + __int_as_float(__builtin_amdgcn_ds_bpermute((lane ^ 32) << 2, __float_as_int(lsum)));
        const float inv = __builtin_amdgcn_rcpf(ltot);
        GAS bf16_t* op = oatt + (size_t)tokq * 1024 + head * 64 + 4 * h;
#pragma unroll
        for (int rq = 0; rq < 4; ++rq) {
            u32x2 w0, w1; w0.x = cvt_pk_bf16(ot0[4 * rq] * inv, ot0[4 * rq + 1] * inv); w0.y = cvt_pk_bf16(ot0[4 * rq + 2] * inv, ot0[4 * rq + 3] * inv);
            w1.x = cvt_pk_bf16(ot1[4 * rq] * inv, ot1[4 * rq + 1] * inv); w1.y = cvt_pk_bf16(ot1[4 * rq + 2] * inv, ot1[4 * rq + 3] * inv);
            *(GAS u32x2*)(op + 8 * rq) = w0; *(GAS u32x2*)(op + 32 + 8 * rq) = w1; }
    }
    __syncthreads();
}

__device__ __forceinline__ void ph_final(const Ctx& c0) {
    const Ctx c = mk_ctx(c0.lds, c0.ws);
    const GAS float* xres = (const GAS float*)(c.ws + WS_X); const GAS float* gp = inp(c, I_FINALG); GAS float* outp = (GAS float*)inp(c, 30);
    const MoeComb mc{(const GAS int*)(c.ws + WS_ROUTE), (const GAS float*)(c.ws + WS_RWT), (const GAS bf16_t*)(c.ws + WS_Y), (const GAS float*)(c.ws + WS_MOD) + (size_t)(DEPTH - 1) * 5 * 6144 + 5 * 1024};
    LAS unsigned* offs = (LAS unsigned*)c.lds + 32;
    moe_offsets(c, 1, offs);
    __syncthreads();
    for (int row = c.bid * NWAVES + c.wave; row < TL; row += c.G * NWAVES) {
        const GAS float* src = xres + (size_t)row * D; f32x4 v[4]; float ss = 0.f;
#pragma unroll
        for (int j = 0; j < 4; ++j) v[j] = *(const GAS f32x4*)(src + 4 * (c.lane + 64 * j));
        moe_combine_row(mc, offs, row, row >> 12, c.lane, v);
#pragma unroll
        for (int j = 0; j < 4; ++j) ss += (v[j][0] * v[j][0] + v[j][1] * v[j][1]) + (v[j][2] * v[j][2] + v[j][3] * v[j][3]);
        ss = wave_sum(ss, c.lane);
        const float rstd = 1.f / sqrtf(ss * (1.f / D) + EPS);
#pragma unroll
        for (int j = 0; j < 4; ++j) { const int k0 = 4 * (c.lane + 64 * j); const f32x4 g4 = *(const GAS f32x4*)(gp + k0); *(GAS f32x4*)(outp + (size_t)row * D + k0) = v[j] * rstd * g4; }
    }
}

constexpr int MOE_OFF = 132096;
template <bool GATHER_> struct MoeOrder {
    static constexpr bool GATHER = GATHER_;
    int nM, nN, nwg, G, c; const GAS char* A; const GAS char* B; size_t astep, bstep, estep; const GAS int* tokenof; const LAS unsigned* tab;
    __device__ void init(const GAS void* A_, int lda, const GAS void* B_, int ldb, size_t estep_bytes, int N, int G_, int c_, const GAS int* tok, const LAS unsigned* tab_) {
        tab = tab_; nM = (int)((unsigned)__builtin_amdgcn_readfirstlane(tab[8]) >> 8); nN = N / pg8::BM; nwg = nM * nN; G = G_; c = c_; A = (const GAS char*)A_; B = (const GAS char*)B_;
        astep = (size_t)pg8::BM * lda * 2; bstep = (size_t)pg8::BM * ldb * 2; estep = estep_bytes; tokenof = tok; }
    __device__ bool next(int i, pg8::Unit& u) const {
        const long L = (long)i * G + c; if (L >= nwg) return false;
        int wgid = (int)L; { const int q = nwg / pg8::NXCD, r = nwg % pg8::NXCD, xcd = wgid % pg8::NXCD, off = wgid / pg8::NXCD; wgid = (xcd < r ? xcd * (q + 1) : r * (q + 1) + (xcd - r) * q) + off; }
        const int nig = pg8::WGM * nN, gid = wgid / nig, fm = gid * pg8::WGM, gsz = (nM - fm) < pg8::WGM ? (nM - fm) : pg8::WGM;
        u.pm = fm + ((wgid % nig) % gsz); u.pn = (wgid % nig) / gsz;
        const unsigned slot0 = (unsigned)u.pm << 8; int e = 0;
#pragma unroll
        for (int j = 1; j < 8; ++j) e += (slot0 >= (unsigned)__builtin_amdgcn_readfirstlane(tab[j])) ? 1 : 0;
        const unsigned pos0 = slot0 - (unsigned)__builtin_amdgcn_readfirstlane(tab[e]), cnt = (unsigned)__builtin_amdgcn_readfirstlane(tab[16 + e]);
        u.nvalid = cnt > pos0 ? (int)(cnt - pos0) : 0; u.tk = tokenof + (size_t)e * T + pos0;
        u.a = GATHER ? A : A + (size_t)u.pm * astep; u.b = B + (size_t)e * estep + (size_t)u.pn * bstep; return true;
    }
    __device__ __forceinline__ int arow(const pg8::Unit& u, int r) const { return r < u.nvalid ? u.tk[r] : 0; }
    __device__ __forceinline__ void a_ready(const pg8::Unit&) const {}
    __device__ __forceinline__ void done(const pg8::Unit&) const {}
};
__device__ __forceinline__ void moe_table(const Ctx& c, int i) {
    LAS unsigned* tab = (LAS unsigned*)(c.lds + MOE_OFF);
    if (c.tid == 0) { const GAS unsigned* cnt = (const GAS unsigned*)(c.ws + WS_CTL) + CW_CNT + 64 * i; unsigned o = 0;
        for (int e = 0; e < 8; ++e) { const unsigned ce = cnt[e]; tab[e] = o; tab[16 + e] = ce; o += (ce + 255u) & ~255u; } tab[8] = o; }
    __syncthreads();
}

#define XB_TMO      128
#define XB_XCNT(j)  (256  + 64 * (j))
#define XB_XSUB(j)  (1280 + 64 * (j))
#define XB_XGEN(j)  (2304 + 64 * (j))
#define XB_TOP      3328
#define XB_TOPGEN   3392
#define XCD_BAR_WORDS 3456
#define XB_SPIN_CAP (1u << 18)
__device__ __forceinline__ unsigned xb_ld(GAS unsigned* p)              { return __hip_atomic_load(p, __ATOMIC_RELAXED, __HIP_MEMORY_SCOPE_AGENT); }
__device__ __forceinline__ unsigned xb_add(GAS unsigned* p, unsigned v) { return __hip_atomic_fetch_add(p, v, __ATOMIC_RELAXED, __HIP_MEMORY_SCOPE_AGENT); }
__device__ __forceinline__ unsigned xb_xcc_id() { return (unsigned)__builtin_amdgcn_s_getreg((3 << 11) | 20) & 0xFu; }
#define XB_SPIN(cond, bar) do { unsigned _sp = 0; while (cond) { __builtin_amdgcn_s_sleep(1); \
    if ((++_sp & 255u) == 0u) { if (xb_ld(&(bar)[XB_TMO])) break; if (_sp > XB_SPIN_CAP) { (void)xb_add(&(bar)[XB_TMO], 1u); break; } } } } while (0)
struct XcdBarrier { GAS unsigned* bar; unsigned x; volatile LAS unsigned* st; };
__device__ __forceinline__ XcdBarrier xcd_barrier_post(GAS unsigned* bar, volatile LAS unsigned* st) {
    XcdBarrier b; b.bar = bar; b.x = xb_xcc_id(); b.st = st;
    if (threadIdx.x == 0) (void)xb_add(&bar[XB_XCNT(b.x)], 1u);
    return b;
}
__device__ __forceinline__ void xcd_barrier_complete(GAS unsigned* bar, unsigned x, unsigned& nloc, unsigned& nx) {
    const unsigned G = gridDim.x * gridDim.y * gridDim.z;
    unsigned sum, cnt, mine, sp = 0u;
    for (;;) {
        sum = 0u; cnt = 0u; mine = 0u;
#pragma unroll
        for (unsigned j = 0; j < 16; ++j) { const unsigned c = xb_ld(&bar[XB_XCNT(j)]); sum += c; cnt += (c > 0u) ? 1u : 0u; mine = (j == x) ? c : mine; }
        if (sum == G) break;
        __builtin_amdgcn_s_sleep(1);
        if ((++sp & 255u) == 0u) { if (xb_ld(&bar[XB_TMO])) break; if (sp > XB_SPIN_CAP) { (void)xb_add(&bar[XB_TMO], 1u); break; } }
    }
    nloc = mine > 0u ? mine : 1u; nx = cnt > 0u ? cnt : 1u;
}
__device__ __forceinline__ void xcd_barrier(const XcdBarrier& b) {
    asm volatile("s_waitcnt vmcnt(0)" ::: "memory");
    __syncthreads();
    if (threadIdx.x == 0) {
        GAS unsigned* bar = b.bar; asm volatile("" : "+s"(bar));     const unsigned bx = xb_xcc_id();
        __builtin_amdgcn_s_waitcnt(0);
        unsigned nloc = b.st[0], nx = b.st[1];
        if (nloc == 0u) { xcd_barrier_complete(bar, bx, nloc, nx); b.st[0] = nloc; b.st[1] = nx; }
        const unsigned old = xb_add(&bar[XB_XSUB(bx)], 1u);
        const unsigned gen = old / nloc;
        if (old + 1u == (gen + 1u) * nloc) {
            __builtin_amdgcn_fence(__ATOMIC_RELEASE, "agent");
            asm volatile("s_waitcnt vmcnt(0)" ::: "memory");
            const unsigned og = xb_add(&bar[XB_TOP], 1u);
            const unsigned tg = og / nx;
            if (og + 1u == (tg + 1u) * nx) xb_add(&bar[XB_TOPGEN], 1u);
            else XB_SPIN(xb_ld(&bar[XB_TOPGEN]) == tg, bar);
            __builtin_amdgcn_fence(__ATOMIC_ACQUIRE, "agent");
            xb_add(&bar[XB_XGEN(bx)], 1u);
            asm volatile("s_waitcnt vmcnt(0)" ::: "memory");
        } else {
            XB_SPIN(xb_ld(&bar[XB_XGEN(bx)]) == gen, bar);
            __builtin_amdgcn_fence(__ATOMIC_ACQUIRE, "agent");
            asm volatile("s_waitcnt vmcnt(0)" ::: "memory");
        }
    }
    __syncthreads();
}

constexpr int CW_BAR = 4096;

__global__ void __launch_bounds__(NTHR, 2) fwd(Args args) {
    extern __shared__ __attribute__((aligned(16))) unsigned char lds_raw[];
    Ctx c; c.lds = (LAS unsigned char*)lds_raw; c.tid = threadIdx.x; c.lane = c.tid & 63; c.wave = __builtin_amdgcn_readfirstlane(c.tid >> 6); c.G = gridDim.x; c.bid = blockIdx.x; c.ws = (GAS unsigned char*)args.ws;
    GAS unsigned char* ws = (GAS unsigned char*)args.ws;
    volatile LAS unsigned* MISC = (volatile LAS unsigned*)(c.lds + MISC_OFF);
    if (c.tid < 32) MISC[c.tid] = 0u;
    if (c.tid < 31) { const unsigned long long pv = c.tid < 30 ? (unsigned long long)args.in[c.tid] : (unsigned long long)args.out;
        volatile LAS unsigned* pt = (volatile LAS unsigned*)(c.lds + PTR_OFF) + 2 * c.tid; pt[0] = (unsigned)pv; pt[1] = (unsigned)(pv >> 32); }
    __syncthreads();
    XcdBarrier bar = xcd_barrier_post((GAS unsigned*)(ws + WS_CTL) + CW_BAR, MISC + 8);
#define GRID_BAR() xcd_barrier(bar)
#ifndef PROFILE_ID
#define PROFILE_ID (-1)
#endif
#define PROF(id) do { if (PROFILE_ID >= 0 && blockIdx.x == 0 && threadIdx.x == 0) { const unsigned long long t_ = __builtin_amdgcn_s_memrealtime(); \
        volatile LAS unsigned* q_ = MISC + 16; const unsigned long long prev_ = ((unsigned long long)q_[1] << 32) | q_[0]; \
        if ((id) == PROFILE_ID) { const unsigned long long a_ = (((unsigned long long)q_[3] << 32) | q_[2]) + (t_ - prev_); q_[2] = (unsigned)a_; q_[3] = (unsigned)(a_ >> 32); } \
        q_[0] = (unsigned)t_; q_[1] = (unsigned)(t_ >> 32); } } while (0)
    PROF(99);

    ph_convert(c); __syncthreads(); ph_mod(c); __syncthreads(); ph_filt(c);
    GRID_BAR(); PROF(0);
    for (int l = 0; l < DEPTH; ++l) {
        ph_norm(c, l, 0);
        GRID_BAR(); PROF(1);
        {   GAS unsigned char* ws = c.ws; asm volatile("" : "+s"(ws));
            pg8::Gemm g{D, D, D, STAG}; pg8::StaticOrder S; S.init(ws + WS_H, D, (GAS bf16_t*)(ws + WS_WIN) + (size_t)l * PW * D, D, T, PW, c.G, c.bid);
            EpiStoreBf16 E{(GAS bf16_t*)(ws + WS_P), PW};
            pg8::gemm_phase(c.lds, g, S, E); }
        GRID_BAR(); PROF(2);
        ph_sc(c, l);
        GRID_BAR(); PROF(3);
        ph_hyena(c, l); ph_attn(c, l);
        GRID_BAR(); PROF(4);
        ph_ohy_t(c);
        GRID_BAR(); PROF(5);
        {   GAS unsigned char* ws = c.ws; asm volatile("" : "+s"(ws));
            const GAS bf16_t* wab = (const GAS bf16_t*)(ws + WS_WPAB) + (size_t)l * D * D;
            pg8::Gemm g{D, D, D}; pg8::StaticOrder S; S.init(ws + WS_OAH, D, wab, D, TL, D, c.G, c.bid);
            EpiMergeK E{(const GAS bf16_t*)(ws + WS_P), (GAS bf16_t*)(ws + WS_H)};
            pg8::gemm_phase(c.lds, g, S, E);
            if (l < DEPTH - 1) ctx_gemm(c.lds, (const GAS bf16_t*)(ws + WS_OAH), D, wab, D, D, CEpiMergeK{(const GAS bf16_t*)(ws + WS_P), (GAS bf16_t*)(ws + WS_H)}); }
        GRID_BAR(); PROF(6);
        {   GAS unsigned char* ws = c.ws; asm volatile("" : "+s"(ws));
            const GAS float* modl = (const GAS float*)(ws + WS_MOD) + (size_t)l * 5 * 6144;
            pg8::Gemm g{D, D, D}; pg8::StaticOrder S; S.init(ws + WS_H, D, (GAS bf16_t*)(ws + WS_WO) + (size_t)l * D * D, D, TL, D, c.G, c.bid);
            EpiResid E{(GAS float*)(ws + WS_X), modl + 2 * 1024};
            pg8::gemm_phase(c.lds, g, S, E);
            if (l < DEPTH - 1) ctx_gemm(c.lds, (const GAS bf16_t*)(ws + WS_H), D, (const GAS bf16_t*)(ws + WS_WO) + (size_t)l * D * D, D, D, CEpiResid{(GAS float*)(ws + WS_X), modl + 4 * 6144 + 2 * 1024}); }
        GRID_BAR(); PROF(7);
        ph_norm(c, l, 1);
        GRID_BAR(); PROF(8);
        if ((l & 1) == 0) {
            {   GAS unsigned char* ws = c.ws; asm volatile("" : "+s"(ws));
                const GAS bf16_t* w = (const GAS bf16_t*)(ws + WS_W13D) + (size_t)(l >> 1) * 2 * FF * D;
                pg8::Gemm g{D, D, D, STAG}; pg8::StaticOrder S; S.init(ws + WS_H, D, w, D, T, 2 * FF, c.G, c.bid);
                EpiSwiglu E{(GAS bf16_t*)(ws + WS_P)};
                pg8::gemm_phase(c.lds, g, S, E); }
            GRID_BAR(); PROF(9);
            {   GAS unsigned char* ws = c.ws; asm volatile("" : "+s"(ws));
                const GAS float* modl = (const GAS float*)(ws + WS_MOD) + (size_t)l * 5 * 6144;
                const GAS bf16_t* w = (const GAS bf16_t*)(ws + WS_W2D) + (size_t)(l >> 1) * D * FF;
                pg8::Gemm g{FF, FF, FF}; pg8::StaticOrder S; S.init(ws + WS_P, FF, w, FF, TL, D, c.G, c.bid);
                EpiResid E{(GAS float*)(ws + WS_X), modl + 5 * 1024};
                pg8::gemm_phase(c.lds, g, S, E);
                ctx_gemm(c.lds, (const GAS bf16_t*)(ws + WS_P), FF, w, FF, FF, CEpiResid{(GAS float*)(ws + WS_X), modl + 4 * 6144 + 5 * 1024}); }
            GRID_BAR(); PROF(10);
        } else {
            const Ctx cm = mk_ctx(c.lds, c.ws);
            moe_table(cm, l >> 1);
            {   GAS unsigned char* ws = c.ws; asm volatile("" : "+s"(ws));
                const GAS bf16_t* w = (const GAS bf16_t*)(ws + WS_W13M) + (size_t)((l >> 1) * NE) * 2 * FF * D;
                pg8::Gemm g{D, D, D, STAG}; MoeOrder<true> S; S.init(ws + WS_H, D, w, D, (size_t)2 * FF * D * 2, 2 * FF, c.G, c.bid, (const GAS int*)(ws + WS_TOK), (const LAS unsigned*)(c.lds + MOE_OFF));
                EpiSwiglu E{(GAS bf16_t*)(ws + WS_P)};
                pg8::gemm_phase(c.lds, g, S, E); }
            GRID_BAR(); PROF(11);
            {   GAS unsigned char* ws = c.ws; asm volatile("" : "+s"(ws));
                const GAS bf16_t* w = (const GAS bf16_t*)(ws + WS_W2M) + (size_t)((l >> 1) * NE) * D * FF;
                pg8::Gemm g{FF, FF, FF, STAG}; MoeOrder<false> S; S.init(ws + WS_P, FF, w, FF, (size_t)D * FF * 2, D, c.G, c.bid, (const GAS int*)(ws + WS_TOK), (const LAS unsigned*)(c.lds + MOE_OFF));
                EpiStoreBf16 E{(GAS bf16_t*)(ws + WS_Y), D};
                pg8::gemm_phase(c.lds, g, S, E); }
            GRID_BAR(); PROF(12);
        }
    }
    ph_final(c);
    if (PROFILE_ID >= 0 && blockIdx.x == 0) {
        if (threadIdx.x == 0) { PROF(13); volatile LAS unsigned* q_ = MISC + 16; const unsigned long long a_ = ((unsigned long long)q_[3] << 32) | q_[2], t0_ = __builtin_amdgcn_s_memrealtime();
            while (__builtin_amdgcn_s_memrealtime() - t0_ < a_) __builtin_amdgcn_s_sleep(8); }
        __syncthreads();
    }
}

extern "C" void kernel_launch(void* const* d_in, const int* in_sizes, int n_in, void* d_out, int out_size, void* d_ws, size_t ws_size, hipStream_t stream) {
    static int grid = 0;
    if (grid == 0) {
        if (n_in != 30 || out_size != TL * D || ws_size < WS_END) { fprintf(stderr, "kernel_launch: unexpected shapes (n_in %d out %d ws %zu)\n", n_in, out_size, ws_size); grid = -1; return; }
        int dev = 0, cus = 0, per_cu = 0; (void)hipGetDevice(&dev); (void)hipDeviceGetAttribute(&cus, hipDeviceAttributeMultiprocessorCount, dev);
        if (hipFuncSetAttribute((const void*)fwd, hipFuncAttributeMaxDynamicSharedMemorySize, LDS_BYTES) != hipSuccess) { fprintf(stderr, "kernel_launch: hipFuncSetAttribute failed\n"); grid = -1; return; }
        if (hipOccupancyMaxActiveBlocksPerMultiprocessor(&per_cu, (const void*)fwd, NTHR, LDS_BYTES) != hipSuccess || per_cu < 1) fprintf(stderr, "kernel_launch: occupancy query reports %d\n", per_cu);
        (void)hipGetLastError();
        grid = cus > 0 ? cus : 256;
    }
    if (grid < 0) return;
    (void)hipMemsetAsync((char*)d_ws + WS_CTL, 0, CTL_ZERO_BYTES, stream);
    Args a{};
    for (int i = 0; i < 30; ++i) a.in[i] = (const float*)d_in[i];
    a.out = (float*)d_out; a.ws = (unsigned char*)d_ws;
    hipLaunchKernelGGL(fwd, dim3(grid), dim3(NTHR), LDS_BYTES, stream, a);
}
```

```cpp
#include <hip/hip_runtime.h>
#include <cstdio>
#include <cstdint>

#define LAS __attribute__((address_space(3)))
#define GAS __attribute__((address_space(1)))
typedef unsigned short bf16_t;
typedef short bf16x8 __attribute__((ext_vector_type(8)));
typedef float f32x4 __attribute__((ext_vector_type(4)));
typedef float f32x2 __attribute__((ext_vector_type(2)));
typedef float f32x16 __attribute__((ext_vector_type(16)));
typedef unsigned u32x4 __attribute__((ext_vector_type(4)));
typedef unsigned u32x2 __attribute__((ext_vector_type(2)));

constexpr int D = 1024, NB = 4, SEQ = 4096, DEPTH = 4, CTX = 256;
constexpr int TL = NB * SEQ, TC = NB * CTX, T = TL + TC;
constexpr int PW = 5120, FF = 2816, NE = 8, HYW = 512;
constexpr int PQ = 0, PK = 512, PV = 1024, PHY = 1536, PGA = 3072, PGB = 4096;
constexpr float EPS = 1e-6f;

constexpr size_t MiB = 1u << 20;
constexpr size_t WS_CTL = 0, CTL_ZERO_BYTES = 1 * MiB;
constexpr size_t WS_MOD = 1 * MiB;
constexpr size_t WS_ROUTE = 2 * MiB;
constexpr size_t WS_RWT = 2 * MiB + 512 * 1024;
constexpr size_t WS_TOK = 3 * MiB;
constexpr int CW_CNT = 8192;
constexpr int MAXSLOT = 36864;
constexpr size_t WS_Y = 660 * MiB;
constexpr size_t WS_WIN = 4 * MiB;
constexpr size_t WS_WPAB = 44 * MiB;
constexpr size_t WS_WO = 52 * MiB;
constexpr size_t WS_W13D = 60 * MiB;
constexpr size_t WS_W2D = 82 * MiB;
constexpr size_t WS_W13M = 93 * MiB;
constexpr size_t WS_W2M = 269 * MiB;
constexpr size_t WS_G8 = 391 * MiB;
constexpr size_t WS_X = 357 * MiB;
constexpr size_t WS_H = 425 * MiB;
constexpr size_t WS_P = 459 * MiB;
constexpr size_t WS_OAH = 629 * MiB;
constexpr size_t WS_B = 663 * MiB;
constexpr size_t WS_OHT = WS_B + 51 * MiB;
constexpr size_t WS_VT = 748 * MiB;
constexpr size_t WS_HRL = 816 * MiB;
constexpr size_t WS_HRC = 850 * MiB;
constexpr size_t WS_END = 853 * MiB;

constexpr int STAG = 3;
constexpr int LDS_BYTES = 147456;
constexpr int NWAVES = 8, NTHR = 512;

#define LDS_WAIT() asm volatile("s_waitcnt lgkmcnt(0)" ::: "memory")
#define VM_WAIT() asm volatile("s_waitcnt vmcnt(0)" ::: "memory")
__device__ __forceinline__ int cur_tid(int wave) { int lane; asm volatile("v_mbcnt_lo_u32_b32 %0, -1, 0\n\tv_mbcnt_hi_u32_b32 %0, -1, %0" : "=v"(lane)); return wave * 64 + lane; }
__device__ __forceinline__ float bf2f(unsigned b) { return __uint_as_float(b << 16); }
__device__ __forceinline__ float bflo(unsigned w) { return __uint_as_float(w << 16); }
__device__ __forceinline__ float bfhi(unsigned w) { return __uint_as_float(w & 0xffff0000u); }
__device__ __forceinline__ unsigned cvt_pk_bf16(float lo, float hi) { unsigned r; asm volatile("v_cvt_pk_bf16_f32 %0, %1, %2" : "=v"(r) : "v"(lo), "v"(hi)); return r; }
__device__ __forceinline__ float wave_sum(float v, int lane) {
#pragma unroll
    for (int o = 1; o < 64; o <<= 1) v += __int_as_float(__builtin_amdgcn_ds_bpermute((lane ^ o) << 2, __float_as_int(v)));
    return v;
}
__device__ __forceinline__ float sigmoidf_(float x) { return __builtin_amdgcn_rcpf(1.f + __expf(-x)); }
__device__ __forceinline__ float sin_rev(float r) { return __builtin_amdgcn_sinf(__builtin_amdgcn_fractf(r)); }
__device__ __forceinline__ float sin_rad(float x) { return sin_rev(x * 0.15915494309189535f); }

namespace pg8 {
constexpr int BM = 256, BK = 64, HALF = 128, HTB = HALF * BK * 2, STAGE_BYTES = 8 * HTB, NXCD = 8, WGM = 2;
__host__ __device__ __forceinline__ int lds_byte(int r, int c) { const int st = (r >> 4) * 2 + (c >> 5), rr = r & 15, cc = c & 31, ob = rr * 64 + cc * 2; return st * 1024 + (ob ^ (((ob >> 9) & 1) << 5)); }
__host__ __device__ __forceinline__ void stage_rc(int b, int& R, int& C) { const int st = b / 1024, sb = b % 1024, swz = sb ^ (((sb >> 9) & 1) << 5); R = (st >> 1) * 16 + swz / 64; C = (st & 1) * 32 + (swz % 64) / 2; }
__host__ __device__ __forceinline__ int perm32(int rho) { const int n = rho >> 4, i = rho & 15; return 8 * (i >> 2) + 4 * n + (i & 3); }

struct Unit { int pm, pn; const GAS char* a; const GAS char* b; const GAS int* tk; int nvalid; int nt, part; };
struct Gemm { int K, lda, ldb; int stagger = 0; };

struct StaticOrder {
    int nM, nN, nwg, G, c; const GAS char* A; const GAS char* B; size_t astep, bstep;
    __device__ void init(const GAS void* A_, int lda, const GAS void* B_, int ldb, int M, int N, int G_, int c_) {
        nM = M / BM; nN = N / BM; nwg = nM * nN; G = G_; c = c_; A = (const GAS char*)A_; B = (const GAS char*)B_; astep = (size_t)BM * lda * 2; bstep = (size_t)BM * ldb * 2; }
    __device__ bool next(int i, Unit& u) const {
        const long L = (long)i * G + c; if (L >= nwg) return false;
        int wgid = (int)L; { const int q = nwg / NXCD, r = nwg % NXCD, xcd = wgid % NXCD, off = wgid / NXCD; wgid = (xcd < r ? xcd * (q + 1) : r * (q + 1) + (xcd - r) * q) + off; }
        const int nig = WGM * nN, gid = wgid / nig, fm = gid * WGM, gsz = (nM - fm) < WGM ? (nM - fm) : WGM;
        u.pm = fm + ((wgid % nig) % gsz); u.pn = (wgid % nig) / gsz; u.a = A + (size_t)u.pm * astep; u.b = B + (size_t)u.pn * bstep; return true;
    }
    static constexpr bool GATHER = false, VARK = false;
    __device__ __forceinline__ int arow(const Unit&, int) const { return 0; }
    __device__ __forceinline__ void a_ready(const Unit&) const {}
    __device__ __forceinline__ void done(const Unit&) const {}
};

template <class Epi, class Sched, bool ALIGN_EPI = true>
__device__ __forceinline__ void gemm_phase(LAS unsigned char* lds, const Gemm g, const Sched& S, const Epi& E, int wave_) {
    int tid = cur_tid(wave_); asm volatile("" : "+v"(tid));
    const int wid = __builtin_amdgcn_readfirstlane(tid >> 6), lane = tid & 63, wr = wid >> 2, wc = wid & 3, fr = lane & 15, fq = lane >> 4;
    const int K = g.K, nt = K / BK;
    constexpr bool GATHER = Sched::GATHER;
    unsigned voffB[2]; unsigned cA0[2], cA1[2], nA0[2], nA1[2]; int RA[2], CA[2];
    const size_t hstepA = (size_t)HALF * g.lda * 2, hstepB = (size_t)HALF * g.ldb * 2;
#pragma unroll
    for (int i = 0; i < 2; ++i) { int R, C; stage_rc(tid * 16 + i * 8192, R, C); const int Rb = Epi::PERM ? ((R & ~31) + perm32(R & 31)) : R;
        RA[i] = R; CA[i] = C; voffB[i] = (unsigned)(Rb * g.ldb + C) * 2u;
        cA0[i] = (unsigned)(R * g.lda + C) * 2u; cA1[i] = cA0[i]; nA0[i] = cA0[i]; nA1[i] = cA0[i]; }
    const size_t h1A = GATHER ? 0 : hstepA;
    const size_t kstep = (size_t)(BK * 2);
    const unsigned ldsw = (unsigned)wid * 1024u;
    const int aoff = lds_byte(wr * 64 + fr, fq * 8), boff = lds_byte(wc * 32 + fr, fq * 8);
#define PG8_SA(b, h) (((b) * 2 + (h)) * HTB)
#define PG8_SB(b, h) ((4 + (b) * 2 + (h)) * HTB)
#define PG8_STAGE(bufoff, gbase, voff) do { _Pragma("unroll") for (int _i = 0; _i < 2; ++_i) \
        __builtin_amdgcn_global_load_lds((const GAS unsigned*)((const GAS char*)(gbase) + (voff)[_i]), (LAS unsigned*)(lds + (bufoff) + ldsw + _i * 8192), 16, 0, 0); } while (0)
#define PG8_LDA(dst, b, h) do { _Pragma("unroll") for (int m = 0; m < 4; ++m) _Pragma("unroll") for (int k = 0; k < 2; ++k) dst[m][k] = *(const LAS bf16x8*)(lds + PG8_SA(b, h) + aoff + m * 2048 + k * 1024); } while (0)
#define PG8_LDB(dst, b, h) do { _Pragma("unroll") for (int n = 0; n < 2; ++n) _Pragma("unroll") for (int k = 0; k < 2; ++k) dst[n][k] = *(const LAS bf16x8*)(lds + PG8_SB(b, h) + boff + n * 2048 + k * 1024); } while (0)
#define PG8_MMA(ai, bj, At, Bt) do { __builtin_amdgcn_s_setprio(1); _Pragma("unroll") for (int m = 0; m < 4; ++m) _Pragma("unroll") for (int n = 0; n < 2; ++n) _Pragma("unroll") for (int k = 0; k < 2; ++k) \
        acc[ai][bj][m][n] = __builtin_amdgcn_mfma_f32_16x16x32_bf16(Bt[n][k], At[m][k], acc[ai][bj][m][n], 0, 0, 0); __builtin_amdgcn_s_setprio(0); } while (0)
#define PG8_WAIT_V(n) asm volatile("s_waitcnt vmcnt(" #n ")" ::: "memory")
#define PG8_WAIT_L(n) asm volatile("s_waitcnt lgkmcnt(" #n ")" ::: "memory")
#define PG8_BAR __builtin_amdgcn_s_barrier()
#define PG8_SCHED __builtin_amdgcn_sched_barrier(0)
    Unit cur, nxt; int ui = 0;
    if (!S.next(0, cur)) return;
    int ntc = nt; if constexpr (Sched::VARK) ntc = cur.nt;
    if (g.stagger > 0) {
        const int slot = (blockIdx.x >> 3) & 7;
        int steps = slot * g.stagger;
        for (int i = 0; i < steps; ++i) __builtin_amdgcn_s_sleep(16);
    }
    if constexpr (GATHER) {
#pragma unroll
        for (int i = 0; i < 2; ++i) { cA0[i] = (unsigned)(S.arow(cur, RA[i]) * g.lda + CA[i]) * 2u; cA1[i] = (unsigned)(S.arow(cur, HALF + RA[i]) * g.lda + CA[i]) * 2u; }
    }
    f32x4 acc[2][2][4][2];
#pragma unroll
    for (int a = 0; a < 2; ++a)
#pragma unroll
        for (int b = 0; b < 2; ++b)
#pragma unroll
            for (int m = 0; m < 4; ++m)
#pragma unroll
                for (int n = 0; n < 2; ++n) acc[a][b][m][n] = (f32x4){0.f, 0.f, 0.f, 0.f};
    bf16x8 At[4][2], B0[2][2], B1[2][2];
    const GAS char* cA = cur.a; const GAS char* cB = cur.b;
    S.a_ready(cur);
    PG8_STAGE(PG8_SB(0, 0), cB, voffB); PG8_STAGE(PG8_SB(0, 1), cB + hstepB, voffB); PG8_STAGE(PG8_SA(0, 0), cA, cA0); PG8_STAGE(PG8_SA(0, 1), cA + h1A, cA1);
    if (wr == 1) PG8_BAR;
    PG8_WAIT_V(2); PG8_BAR;
    PG8_STAGE(PG8_SB(1, 0), cB + kstep, voffB); PG8_STAGE(PG8_SA(1, 0), cA + kstep, cA0); PG8_STAGE(PG8_SB(1, 1), cB + hstepB + kstep, voffB);
    PG8_WAIT_V(6); PG8_BAR;
    for (;;) {
        const bool has_next = S.next(ui + 1, nxt);
        const GAS char* nA = has_next ? nxt.a : cA; const GAS char* nB = has_next ? nxt.b : cB;
        if constexpr (GATHER) {
#pragma unroll
            for (int i = 0; i < 2; ++i) { nA0[i] = has_next ? (unsigned)(S.arow(nxt, RA[i]) * g.lda + CA[i]) * 2u : cA0[i]; nA1[i] = has_next ? (unsigned)(S.arow(nxt, HALF + RA[i]) * g.lda + CA[i]) * 2u : cA1[i]; }
        }
        for (int kh = 0; kh < (Epi::MIDK ? 2 : 1); ++kh) {
        const int tb = Epi::MIDK ? kh * (ntc / 2) : 0, te = Epi::MIDK ? tb + ntc / 2 : ntc;
        for (int t = tb; t < te; t += 2) {
            const bool last = (t == ntc - 2);
            const GAS char* a1 = cA + (size_t)(t + 1) * kstep;
            const GAS char* a2 = last ? nA : cA + (size_t)(t + 2) * kstep; const GAS char* b2 = last ? nB : cB + (size_t)(t + 2) * kstep;
            const GAS char* a3 = a2 + kstep; const GAS char* b3 = b2 + kstep;
            unsigned x0[2], x1[2];
#pragma unroll
            for (int i = 0; i < 2; ++i) { x0[i] = (GATHER && last) ? nA0[i] : cA0[i]; x1[i] = GATHER ? (last ? nA1[i] : cA1[i]) : cA0[i]; }
            if (last && has_next) S.a_ready(nxt);
            PG8_LDB(B0, 0, 0); PG8_LDB(B1, 0, 1); PG8_SCHED; PG8_LDA(At, 0, 0); PG8_STAGE(PG8_SA(1, 1), a1 + h1A, cA1);
            PG8_WAIT_V(8); PG8_WAIT_L(0); PG8_BAR; PG8_MMA(0, 0, At, B0); PG8_MMA(0, 1, At, B1); PG8_BAR; PG8_SCHED;
            PG8_LDA(At, 0, 1); PG8_STAGE(PG8_SB(0, 0), b2, voffB); PG8_STAGE(PG8_SB(0, 1), b2 + hstepB, voffB); PG8_STAGE(PG8_SA(0, 0), a2, x0);
            PG8_WAIT_V(8); PG8_WAIT_L(0); PG8_BAR; PG8_MMA(1, 0, At, B0); PG8_MMA(1, 1, At, B1); PG8_BAR; PG8_SCHED;
            PG8_LDB(B0, 1, 0); PG8_LDB(B1, 1, 1); PG8_SCHED; PG8_LDA(At, 1, 0); PG8_STAGE(PG8_SA(0, 1), a2 + h1A, x1);
            PG8_WAIT_V(8); PG8_WAIT_L(0); PG8_BAR; PG8_MMA(0, 0, At, B0); PG8_MMA(0, 1, At, B1); PG8_BAR; PG8_SCHED;
            PG8_LDA(At, 1, 1); PG8_STAGE(PG8_SB(1, 0), b3, voffB); PG8_STAGE(PG8_SB(1, 1), b3 + hstepB, voffB); PG8_STAGE(PG8_SA(1, 0), a3, x0);
            PG8_WAIT_V(8); PG8_WAIT_L(0); PG8_BAR; PG8_MMA(1, 0, At, B0); PG8_MMA(1, 1, At, B1); PG8_BAR; PG8_SCHED;
        }
        if constexpr (Epi::MIDK) { if (kh == 0) E.mid(acc, cur, wr, wc, fr, fq); }
        }
        if constexpr (ALIGN_EPI) { if (wr == 0) PG8_BAR; }
        E(acc, cur, wr, wc, fr, fq); S.done(cur);
        if (!has_next) break;
#pragma unroll
        for (int a = 0; a < 2; ++a)
#pragma unroll
            for (int b = 0; b < 2; ++b)
#pragma unroll
                for (int m = 0; m < 4; ++m)
#pragma unroll
                    for (int n = 0; n < 2; ++n) acc[a][b][m][n] = (f32x4){0.f, 0.f, 0.f, 0.f};
        cur = nxt; cA = nA; cB = nB; ++ui; if constexpr (Sched::VARK) ntc = cur.nt;
        if constexpr (GATHER) {
#pragma unroll
            for (int i = 0; i < 2; ++i) { cA0[i] = nA0[i]; cA1[i] = nA1[i]; }
        }
        if constexpr (ALIGN_EPI) { if (wr == 1) PG8_BAR; }
    }
    PG8_WAIT_V(0);
    if constexpr (!ALIGN_EPI) { if (wr == 0) PG8_BAR; }
    PG8_BAR;
#undef PG8_SA
#undef PG8_SB
#undef PG8_STAGE
#undef PG8_LDA
#undef PG8_LDB
#undef PG8_MMA
#undef PG8_WAIT_V
#undef PG8_WAIT_L
#undef PG8_BAR
#undef PG8_SCHED
}
}

typedef f32x4 AccT[2][2][4][2];
struct EpiStoreBf16 {
    static constexpr bool PERM = true, MIDK = false;
    GAS bf16_t* O; int ldc;
    __device__ __forceinline__ void operator()(const AccT& acc, const pg8::Unit& u, int wr, int wc, int fr, int fq) const {
        const int row0 = u.pm * 256 + wr * 64 + fr, col0 = u.pn * 256 + wc * 32 + 8 * fq;
#pragma unroll
        for (int ai = 0; ai < 2; ++ai)
#pragma unroll
            for (int m = 0; m < 4; ++m) { GAS bf16_t* rowp = O + (size_t)(row0 + ai * 128 + m * 16) * ldc + col0;
#pragma unroll
                for (int bj = 0; bj < 2; ++bj) { const f32x4 v0 = acc[ai][bj][m][0], v1 = acc[ai][bj][m][1];
                    u32x4 w; w.x = cvt_pk_bf16(v0[0], v0[1]); w.y = cvt_pk_bf16(v0[2], v0[3]); w.z = cvt_pk_bf16(v1[0], v1[1]); w.w = cvt_pk_bf16(v1[2], v1[3]);
                    *(GAS u32x4*)(rowp + bj * 128) = w; } }
    }
};
struct EpiStoreY {
    static constexpr bool PERM = true, MIDK = false;
    GAS bf16_t* Y0; GAS bf16_t* Y1; int pm0;
    __device__ __forceinline__ void operator()(const AccT& acc, const pg8::Unit& u, int wr, int wc, int fr, int fq) const {
        const EpiStoreBf16 e{u.part ? Y1 - (size_t)pm0 * 256 * D : Y0, D}; e(acc, u, wr, wc, fr, fq); }
};
__device__ __forceinline__ unsigned gate_q(float g) { return (unsigned)(255.f * __builtin_amdgcn_rcpf(1.f + __expf(-g)) + 0.5f); }
__device__ __forceinline__ unsigned gate_q4(const f32x4& v) { return gate_q(v[0]) | (gate_q(v[1]) << 8) | (gate_q(v[2]) << 16) | (gate_q(v[3]) << 24); }
__device__ __forceinline__ float ubyte_f(unsigned w, int k) { return (float)((w >> (8 * k)) & 0xffu); }
__device__ __forceinline__ float gq_ratio(unsigned wa, unsigned wb, int k) { return ubyte_f(wa, k) * __builtin_amdgcn_rcpf(fmaxf(ubyte_f(wb, k), 1.f)); }
__device__ __forceinline__ float gq_final(unsigned wb, int k) { return fmaxf(ubyte_f(wb, k), 1.f) * (1.f / 255.f); }
struct EpiStoreIn {
    static constexpr bool PERM = true, MIDK = false;
    GAS bf16_t* O; GAS unsigned char* G;
    __device__ __forceinline__ void operator()(const AccT& acc, const pg8::Unit& u, int wr, int wc, int fr, int fq) const {
        if (u.pn < PGA / 256) { const EpiStoreBf16 e{O, PW}; e(acc, u, wr, wc, fr, fq); return; }
        const int row0 = u.pm * 256 + wr * 64 + fr, cg0 = u.pn * 256 - PGA + wc * 32 + 8 * fq;
#pragma unroll
        for (int ai = 0; ai < 2; ++ai)
#pragma unroll
            for (int m = 0; m < 4; ++m) { GAS unsigned char* rowp = G + (size_t)(row0 + ai * 128 + m * 16) * 2048 + cg0;
#pragma unroll
                for (int bj = 0; bj < 2; ++bj) { u32x2 w; w.x = gate_q4(acc[ai][bj][m][0]); w.y = gate_q4(acc[ai][bj][m][1]); *(GAS u32x2*)(rowp + bj * 128) = w; } }
    }
};
struct EpiMergeK {
    static constexpr bool PERM = true, MIDK = true;
    const GAS unsigned char* G; GAS bf16_t* O;
    __device__ __forceinline__ void mid(AccT& acc, const pg8::Unit& u, int wr, int wc, int fr, int fq) const {
        asm volatile("" : "+v"(fr), "+v"(fq));
        const int row0 = u.pm * 256 + wr * 64 + fr, col0 = u.pn * 256 + wc * 32 + 8 * fq;
#pragma unroll
        for (int ai = 0; ai < 2; ++ai)
#pragma unroll
            for (int m = 0; m < 4; ++m) { const int r = row0 + ai * 128 + m * 16;
#pragma unroll
                for (int bj = 0; bj < 2; ++bj) { const int c = col0 + bj * 128;
                    const u32x2 a = *(const GAS u32x2*)(G + (size_t)r * 2048 + c), b = *(const GAS u32x2*)(G + (size_t)r * 2048 + 1024 + c);
#pragma unroll
                    for (int k = 0; k < 4; ++k) { acc[ai][bj][m][0][k] *= gq_ratio(a.x, b.x, k); acc[ai][bj][m][1][k] *= gq_ratio(a.y, b.y, k); } } }
    }
    __device__ __forceinline__ void operator()(const AccT& acc, const pg8::Unit& u, int wr, int wc, int fr, int fq) const {
        asm volatile("" : "+v"(fr), "+v"(fq));
        const int row0 = u.pm * 256 + wr * 64 + fr, col0 = u.pn * 256 + wc * 32 + 8 * fq;
#pragma unroll
        for (int ai = 0; ai < 2; ++ai)
#pragma unroll
            for (int m = 0; m < 4; ++m) { const int r = row0 + ai * 128 + m * 16;
#pragma unroll
                for (int bj = 0; bj < 2; ++bj) { const int c = col0 + bj * 128;
                    const u32x2 b = *(const GAS u32x2*)(G + (size_t)r * 2048 + 1024 + c);
                    const f32x4 v0 = acc[ai][bj][m][0], v1 = acc[ai][bj][m][1];
                    u32x4 w; w.x = cvt_pk_bf16(v0[0] * gq_final(b.x, 0), v0[1] * gq_final(b.x, 1)); w.y = cvt_pk_bf16(v0[2] * gq_final(b.x, 2), v0[3] * gq_final(b.x, 3));
                    w.z = cvt_pk_bf16(v1[0] * gq_final(b.y, 0), v1[1] * gq_final(b.y, 1)); w.w = cvt_pk_bf16(v1[2] * gq_final(b.y, 2), v1[3] * gq_final(b.y, 3));
                    *(GAS u32x4*)(O + (size_t)r * D + c) = w; } }
    }
};
struct EpiResid {
    static constexpr bool PERM = true, MIDK = false;
    GAS bf16_t* x; const GAS float* gate;
    __device__ __forceinline__ void operator()(const AccT& acc, const pg8::Unit& u, int wr, int wc, int fr, int fq) const {
        const int row0 = u.pm * 256 + wr * 64 + fr, col0 = u.pn * 256 + wc * 32 + 8 * fq;
        const int b = (u.pm < 64) ? (u.pm >> 4) : 4;
        const GAS float* gp = gate + (size_t)b * 6144 + col0;
        f32x4 gv[2][2];
#pragma unroll
        for (int bj = 0; bj < 2; ++bj)
#pragma unroll
            for (int n = 0; n < 2; ++n) gv[bj][n] = *(const GAS f32x4*)(gp + bj * 128 + n * 4);
#pragma unroll
        for (int ai = 0; ai < 2; ++ai)
#pragma unroll
            for (int m = 0; m < 4; ++m) { GAS bf16_t* rowp = x + (size_t)(row0 + ai * 128 + m * 16) * D + col0;
#pragma unroll
                for (int bj = 0; bj < 2; ++bj) { GAS u32x4* p = (GAS u32x4*)(rowp + bj * 128); const u32x4 xv = *p; const f32x4 v0 = acc[ai][bj][m][0], v1 = acc[ai][bj][m][1]; const f32x4 g0 = gv[bj][0], g1 = gv[bj][1];
                    u32x4 w; w.x = cvt_pk_bf16(bflo(xv.x) + g0[0] * v0[0], bfhi(xv.x) + g0[1] * v0[1]); w.y = cvt_pk_bf16(bflo(xv.y) + g0[2] * v0[2], bfhi(xv.y) + g0[3] * v0[3]);
                    w.z = cvt_pk_bf16(bflo(xv.z) + g1[0] * v1[0], bfhi(xv.z) + g1[1] * v1[1]); w.w = cvt_pk_bf16(bflo(xv.w) + g1[2] * v1[2], bfhi(xv.w) + g1[3] * v1[3]);
                    *p = w; } }
    }
};
struct EpiSwiglu {
    static constexpr bool PERM = true, MIDK = false;
    GAS bf16_t* O;
    __device__ __forceinline__ void operator()(const AccT& acc, const pg8::Unit& u, int wr, int wc, int fr, int fq) const {
        const int row0 = u.pm * 256 + wr * 64 + fr, col0 = u.pn * 128 + wc * 32 + 8 * fq;
#pragma unroll
        for (int ai = 0; ai < 2; ++ai)
#pragma unroll
            for (int m = 0; m < 4; ++m) { const int r = row0 + ai * 128 + m * 16;
                float o[8];
#pragma unroll
                for (int n = 0; n < 2; ++n)
#pragma unroll
                    for (int j = 0; j < 4; ++j) { const float a = acc[ai][0][m][n][j], g = acc[ai][1][m][n][j]; o[n * 4 + j] = a * sigmoidf_(a) * g; }
                u32x4 w; w.x = cvt_pk_bf16(o[0], o[1]); w.y = cvt_pk_bf16(o[2], o[3]); w.z = cvt_pk_bf16(o[4], o[5]); w.w = cvt_pk_bf16(o[6], o[7]);
                *(GAS u32x4*)(O + (size_t)r * FF + col0) = w; }
    }
};

struct CEpiMergeK { const GAS unsigned char* G; GAS bf16_t* O; static constexpr bool MIDK = true;
    __device__ __forceinline__ void mid(f32x4& acc, int r, int c) const { const unsigned a = *(const GAS unsigned*)(G + (size_t)r * 2048 + c), b = *(const GAS unsigned*)(G + (size_t)r * 2048 + 1024 + c);
#pragma unroll
        for (int k = 0; k < 4; ++k) acc[k] *= gq_ratio(a, b, k); }
    __device__ __forceinline__ void operator()(const f32x4& acc, int r, int c) const { const unsigned b = *(const GAS unsigned*)(G + (size_t)r * 2048 + 1024 + c);
        u32x2 w; w.x = cvt_pk_bf16(acc[0] * gq_final(b, 0), acc[1] * gq_final(b, 1)); w.y = cvt_pk_bf16(acc[2] * gq_final(b, 2), acc[3] * gq_final(b, 3));
        *(GAS u32x2*)(O + (size_t)r * D + c) = w; } };
struct CEpiResid { GAS bf16_t* x; const GAS float* gate; static constexpr bool MIDK = false;
    __device__ __forceinline__ void mid(f32x4&, int, int) const {}
    __device__ __forceinline__ void operator()(const f32x4& acc, int r, int c) const { GAS u32x2* p = (GAS u32x2*)(x + (size_t)r * D + c); const u32x2 xv = *p; const f32x4 g = *(const GAS f32x4*)(gate + c);
        u32x2 w; w.x = cvt_pk_bf16(bflo(xv.x) + g[0] * acc[0], bfhi(xv.x) + g[1] * acc[1]); w.y = cvt_pk_bf16(bflo(xv.y) + g[2] * acc[2], bfhi(xv.y) + g[3] * acc[3]); *p = w; } };
template <class Epi>
__device__ __forceinline__ void ctx_gemm(LAS unsigned char* lds, int wave_, const GAS bf16_t* X, int ldx, const GAS bf16_t* Wt, int ldw, int K, const Epi& E) {
    int tid = cur_tid(wave_); asm volatile("" : "+v"(tid));
    const int wave = tid >> 6, lane = tid & 63, li = lane & 15, kg = lane >> 4, rb = wave & 3, ch = wave >> 2;
    constexpr int PITCH = 272, XB = 64 * PITCH, BUF = 2 * XB;
    const int nk = K >> 7;
    for (int tile = blockIdx.x; tile < 256; tile += gridDim.x) {
        const int row0 = TL + (tile >> 4) * 64, col0 = (tile & 15) * 64;
        const int pr0 = tid >> 4, pc = tid & 15, pr1 = pr0 + 32;
        const GAS bf16_t* xs0 = X + (size_t)(row0 + pr0) * ldx + 8 * pc; const GAS bf16_t* xs1 = X + (size_t)(row0 + pr1) * ldx + 8 * pc;
        const GAS bf16_t* ws0 = Wt + (size_t)(col0 + pr0) * ldw + 8 * pc; const GAS bf16_t* ws1 = Wt + (size_t)(col0 + pr1) * ldw + 8 * pc;
        const int so0 = pr0 * PITCH + pc * 16, so1 = pr1 * PITCH + pc * 16;
        f32x4 acc[2] = {(f32x4){0.f, 0.f, 0.f, 0.f}, (f32x4){0.f, 0.f, 0.f, 0.f}};
        u32x4 sx0 = *(const GAS u32x4*)xs0, sx1 = *(const GAS u32x4*)xs1, sw0 = *(const GAS u32x4*)ws0, sw1 = *(const GAS u32x4*)ws1;
        *(LAS u32x4*)(lds + so0) = sx0; *(LAS u32x4*)(lds + so1) = sx1; *(LAS u32x4*)(lds + XB + so0) = sw0; *(LAS u32x4*)(lds + XB + so1) = sw1;
        __syncthreads();
        for (int kt = 0; kt < nk; ++kt) {
            const bool more = kt + 1 < nk;
            if (more) { const int ko = (kt + 1) * 128; sx0 = *(const GAS u32x4*)(xs0 + ko); sx1 = *(const GAS u32x4*)(xs1 + ko); sw0 = *(const GAS u32x4*)(ws0 + ko); sw1 = *(const GAS u32x4*)(ws1 + ko); }
            LAS unsigned char* xb = lds + (kt & 1) * BUF; LAS unsigned char* wb = xb + XB;
#pragma unroll
            for (int ks = 0; ks < 4; ++ks) {
                const bf16x8 xf = *(const LAS bf16x8*)(xb + (16 * rb + li) * PITCH + (32 * ks + 8 * kg) * 2);
#pragma unroll
                for (int cb = 0; cb < 2; ++cb) { const bf16x8 wf = *(const LAS bf16x8*)(wb + (32 * ch + 16 * cb + li) * PITCH + (32 * ks + 8 * kg) * 2);
                    acc[cb] = __builtin_amdgcn_mfma_f32_16x16x32_bf16(wf, xf, acc[cb], 0, 0, 0); }
            }
            if constexpr (Epi::MIDK) { if (kt + 1 == (nk >> 1)) {
#pragma unroll
                for (int cb = 0; cb < 2; ++cb) E.mid(acc[cb], row0 + 16 * rb + li, col0 + 32 * ch + 16 * cb + 4 * kg); } }
            if (more) { LAS unsigned char* nb = lds + ((kt + 1) & 1) * BUF;
                *(LAS u32x4*)(nb + so0) = sx0; *(LAS u32x4*)(nb + so1) = sx1; *(LAS u32x4*)(nb + XB + so0) = sw0; *(LAS u32x4*)(nb + XB + so1) = sw1; }
            __syncthreads();
        }
#pragma unroll
        for (int cb = 0; cb < 2; ++cb) E(acc[cb], row0 + 16 * rb + li, col0 + 32 * ch + 16 * cb + 4 * kg);
        __syncthreads();
    }
}

struct Args { const float* in[30]; float* out; unsigned char* ws; int l, e, ph, pad; };
enum { I_X = 0, I_C, I_CTX, I_CCTX, I_WMOD, I_BMOD, I_N1G, I_N2G, I_WIN, I_RPB, I_HCW, I_HCB, I_HW1, I_HB1, I_HW2, I_HB2, I_HW3, I_HFREQ, I_HBIAS,
       I_WPA, I_WPB, I_WO, I_FW1, I_FW3, I_FW2, I_ROUTER, I_MW1, I_MW3, I_MW2, I_FINALG };

constexpr int MISC_OFF = 131072 + 320;
constexpr int PTR_OFF = MISC_OFF + 128;
struct Ctx {
    LAS unsigned char* lds; int tid, lane, wave, G, bid; GAS unsigned char* ws;
};
__device__ __forceinline__ Ctx mk_ctx(LAS unsigned char* lds, GAS unsigned char* ws, int wave_) {
    Ctx c; int t = cur_tid(wave_); asm volatile("" : "+v"(t)); asm volatile("" : "+s"(ws)); c.lds = lds; c.tid = t; c.lane = t & 63; c.wave = __builtin_amdgcn_readfirstlane(t >> 6); c.G = gridDim.x; c.bid = blockIdx.x; c.ws = ws; return c;
}
__device__ __forceinline__ const GAS float* inp(const Ctx& c, int i) {
    unsigned ao = (unsigned)(PTR_OFF + 8 * i); asm volatile("" : "+v"(ao));
    const volatile LAS unsigned* p = (const volatile LAS unsigned*)(c.lds + ao);
    const unsigned lo = __builtin_amdgcn_readfirstlane(p[0]), hi = __builtin_amdgcn_readfirstlane(p[1]);
    return (const GAS float*)(((unsigned long long)hi << 32) | (unsigned long long)lo);
}

__device__ __forceinline__ void transpose_item(const GAS float* W, int N, GAS bf16_t* WT, int ldk, int k0, int n0, int drow0, LAS float* scr, int lane) {
    float wv[32];
    const GAS float* wp = W + (size_t)(k0 + (lane >> 5)) * N + n0 + (lane & 31);
#pragma unroll
    for (int i = 0; i < 32; ++i) wv[i] = wp[(size_t)(2 * i) * N];
#pragma unroll
    for (int i = 0; i < 32; ++i) scr[(2 * i + (lane >> 5)) * 33 + (lane & 31)] = wv[i];
    LDS_WAIT(); asm volatile("" ::: "memory");
    const int c = lane & 7;
#pragma unroll
    for (int j = 0; j < 4; ++j) { const int n = (lane >> 3) + 8 * j; const LAS float* s = scr + (8 * c) * 33 + n;
        u32x4 o; o.x = cvt_pk_bf16(s[0 * 33], s[1 * 33]); o.y = cvt_pk_bf16(s[2 * 33], s[3 * 33]); o.z = cvt_pk_bf16(s[4 * 33], s[5 * 33]); o.w = cvt_pk_bf16(s[6 * 33], s[7 * 33]);
        *(GAS u32x4*)(WT + (size_t)(drow0 + n) * ldk + k0 + 8 * c) = o; }
    LDS_WAIT(); asm volatile("" ::: "memory");
}
__device__ __forceinline__ void conv_mat(const GAS float* W, int K, int N, GAS bf16_t* WT, int mode, int& base, int gw, int NGW, LAS float* scr, int lane, int ldk = 0) {
    if (ldk == 0) ldk = K;
    const int nblk = N / 32, nitems = (K / 64) * nblk;
    const int start = (gw - (base % NGW) + NGW) % NGW;
    for (int it = start; it < nitems; it += NGW) {
        const int kb = it / nblk, nb = it % nblk, n0 = nb * 32;
        const int drow0 = mode == 0 ? n0 : ((n0 >> 7) * 256 + (n0 & 127) + (mode == 2 ? 128 : 0));
        transpose_item(W, N, WT, ldk, kb * 64, n0, drow0, scr, lane);
    }
    base += nitems;
}
__device__ __forceinline__ void ph_convert(const Ctx& c0, int rank, int nrank) {
    const Ctx c = mk_ctx(c0.lds, c0.ws, c0.wave);
    GAS unsigned char* ws = c.ws;
    LAS float* scr = (LAS float*)(c.lds + c.wave * 16384);
    if (rank < 0) return;
    const int gw = rank * NWAVES + c.wave, NGW = nrank * NWAVES; int base = 0;
    for (int l = 0; l < DEPTH; ++l) {
        conv_mat(inp(c, I_WIN) + (size_t)l * D * PW, D, PW, (GAS bf16_t*)(ws + WS_WIN) + (size_t)l * PW * D, 0, base, gw, NGW, scr, c.lane);
        conv_mat(inp(c, I_WPA) + (size_t)l * 512 * D, 512, D, (GAS bf16_t*)(ws + WS_WPAB) + (size_t)l * D * D, 0, base, gw, NGW, scr, c.lane, D);
        conv_mat(inp(c, I_WPB) + (size_t)l * 512 * D, 512, D, (GAS bf16_t*)(ws + WS_WPAB) + (size_t)l * D * D + 512, 0, base, gw, NGW, scr, c.lane, D);
        conv_mat(inp(c, I_WO) + (size_t)l * D * D, D, D, (GAS bf16_t*)(ws + WS_WO) + (size_t)l * D * D, 0, base, gw, NGW, scr, c.lane);
    }
    for (int i = 0; i < 2; ++i) {
        conv_mat(inp(c, I_FW1) + (size_t)i * D * FF, D, FF, (GAS bf16_t*)(ws + WS_W13D) + (size_t)i * 2 * FF * D, 1, base, gw, NGW, scr, c.lane);
        conv_mat(inp(c, I_FW3) + (size_t)i * D * FF, D, FF, (GAS bf16_t*)(ws + WS_W13D) + (size_t)i * 2 * FF * D, 2, base, gw, NGW, scr, c.lane);
        conv_mat(inp(c, I_FW2) + (size_t)i * FF * D, FF, D, (GAS bf16_t*)(ws + WS_W2D) + (size_t)i * D * FF, 0, base, gw, NGW, scr, c.lane);
    }
    for (int ie = 0; ie < 2 * NE; ++ie) {
        conv_mat(inp(c, I_MW1) + (size_t)ie * D * FF, D, FF, (GAS bf16_t*)(ws + WS_W13M) + (size_t)ie * 2 * FF * D, 1, base, gw, NGW, scr, c.lane);
        conv_mat(inp(c, I_MW3) + (size_t)ie * D * FF, D, FF, (GAS bf16_t*)(ws + WS_W13M) + (size_t)ie * 2 * FF * D, 2, base, gw, NGW, scr, c.lane);
        conv_mat(inp(c, I_MW2) + (size_t)ie * FF * D, FF, D, (GAS bf16_t*)(ws + WS_W2M) + (size_t)ie * D * FF, 0, base, gw, NGW, scr, c.lane);
    }
}

__device__ __forceinline__ void ph_mod(const Ctx& c0, int rank, int nrank) {
    const Ctx c = mk_ctx(c0.lds, c0.ws, c0.wave);
    GAS float* mod = (GAS float*)(c.ws + WS_MOD);
    LAS float* s = (LAS float*)c.lds; LAS float* part = s + 5 * 1024;
    const GAS float* cin = inp(c, I_C); const GAS float* cctx = inp(c, I_CCTX); const GAS float* wmod = inp(c, I_WMOD); const GAS float* bmod = inp(c, I_BMOD);
    for (int i = c.tid; i < 5 * 1024; i += NTHR) { const int r = i >> 10, k = i & 1023; const float v = r < 4 ? cin[r * 1024 + k] : cctx[k]; s[i] = v * sigmoidf_(v); }
    __syncthreads();
    if (rank < 0) return;
    for (int unit = rank; unit < DEPTH * 96; unit += nrank) {
        const int l = unit / 96, j0 = (unit % 96) * 64;
        const GAS float* w = wmod + (size_t)l * D * 6144 + j0 + c.lane;
        float acc[5] = {0.f, 0.f, 0.f, 0.f, 0.f};
        const int kb = c.wave * 128;
#pragma unroll 32
        for (int k = 0; k < 128; ++k) { const float wv = w[(size_t)(kb + k) * 6144];
#pragma unroll
            for (int r = 0; r < 5; ++r) acc[r] += s[r * 1024 + kb + k] * wv; }
#pragma unroll
        for (int r = 0; r < 5; ++r) part[(c.wave * 5 + r) * 64 + c.lane] = acc[r];
        __syncthreads();
        if (c.tid < 320) { const int r = c.tid >> 6, ln = c.tid & 63; float sum = 0.f;
#pragma unroll
            for (int w8 = 0; w8 < 8; ++w8) sum += part[(w8 * 5 + r) * 64 + ln];
            mod[(size_t)(l * 5 + r) * 6144 + j0 + ln] = sum + bmod[l * 6144 + j0 + ln]; }
        __syncthreads();
    }
}

__device__ __forceinline__ void ph_filt(const Ctx& c0, int l, int rank, int nrank) {
    const Ctx c = mk_ctx(c0.lds, c0.ws, c0.wave);
    const GAS float* hb1 = inp(c, I_HB1); const GAS float* hw1 = inp(c, I_HW1); const GAS float* hb2 = inp(c, I_HB2); const GAS float* hw2 = inp(c, I_HW2); const GAS float* hfreq = inp(c, I_HFREQ); const GAS float* hw3 = inp(c, I_HW3);
    LAS float* zb = (LAS float*)c.lds;
    LAS float* a1 = zb + 16 * 36;
    LAS float* a2 = a1 + 16 * 64;
    LAS float* w1s = a2 + 16 * 64;
    LAS float* w2s = w1s + 33 * 64;
    LAS float* b1s = w2s + 64 * 64;
    LAS float* ob = b1s + 256;
    if (rank >= 272) return;
    for (int i = c.tid; i < 33 * 64; i += NTHR) w1s[i] = hw1[(size_t)l * 33 * 64 + i];
    for (int i = c.tid; i < 64 * 64; i += NTHR) w2s[i] = hw2[(size_t)l * 64 * 64 + i];
    if (c.tid < 64) { b1s[c.tid] = hb1[l * 64 + c.tid]; b1s[64 + c.tid] = hb2[l * 64 + c.tid]; }
    if (c.tid < 128) b1s[128 + c.tid] = hfreq[l * 128 + c.tid];
    __syncthreads();
    const float MINDEC = -3.0701134573253945f, MAXDEC = -15.350567286626973f;
    for (int uu = rank; uu < 272; uu += nrank) {
        const int L = uu < 256 ? 4096 : 256, p0 = uu < 256 ? uu * 16 : (uu - 256) * 16;
        for (int i = c.tid; i < 16 * 33; i += NTHR) { const int p = i / 33, q = i % 33; const int pos = p0 + p; float v;
            if (q == 0) v = (float)pos / (float)(L - 1);
            else { const int j = (q - 1) & 15; const double band = 1e-4 + (double)j * ((15.0 - 1e-4) / 15.0); double rev = (double)pos * band / (double)L; rev -= floor(rev);
                v = q <= 16 ? __builtin_amdgcn_cosf((float)rev) : -__builtin_amdgcn_sinf((float)rev); }
            zb[p * 36 + q] = v; }
        __syncthreads();
        for (int i = c.tid; i < 16 * 64; i += NTHR) { const int p = i >> 6, j = i & 63; float s = b1s[j];
#pragma unroll
            for (int q = 0; q < 33; ++q) s += zb[p * 36 + q] * w1s[q * 64 + j];
            a1[p * 64 + j] = sin_rad(b1s[128 + j] * s); }
        __syncthreads();
        for (int i = c.tid; i < 16 * 64; i += NTHR) { const int p = i >> 6, j = i & 63; float s = b1s[64 + j];
#pragma unroll 16
            for (int q = 0; q < 64; ++q) s += a1[p * 64 + q] * w2s[q * 64 + j];
            a2[p * 64 + j] = sin_rad(b1s[192 + j] * s); }
        __syncthreads();
        {
            const int j = c.lane & 15, g = c.lane >> 4;
            float af[16];
#pragma unroll
            for (int ks = 0; ks < 16; ++ks) af[ks] = a2[j * 64 + 4 * ks + g];
            const GAS float* wb = hw3 + (size_t)l * 64 * 1024 + (size_t)g * 1024 + c.wave * 128 + j;
            float bn[16];
#pragma unroll
            for (int ks = 0; ks < 16; ++ks) bn[ks] = wb[ks * 4096];
#pragma unroll 1
            for (int t = 0; t < 8; ++t) {
                float bc[16];
#pragma unroll
                for (int ks = 0; ks < 16; ++ks) bc[ks] = bn[ks];
                const int tn = (t < 7 ? t + 1 : 7) * 16;
#pragma unroll
                for (int ks = 0; ks < 16; ++ks) bn[ks] = wb[ks * 4096 + tn];
                f32x4 acc4 = (f32x4){0.f, 0.f, 0.f, 0.f};
#pragma unroll
                for (int ks = 0; ks < 16; ++ks) acc4 = __builtin_amdgcn_mfma_f32_16x16x4f32(af[ks], bc[ks], acc4, 0, 0, 0);
#pragma unroll
                for (int r = 0; r < 4; ++r) ob[(4 * g + r) * 1028 + c.wave * 128 + t * 16 + j] = acc4[r];
            }
        }
        __syncthreads();
#pragma unroll 1
        for (int hc = 0; hc < 2; ++hc) {
            const int ch = c.tid + hc * 512;
            float acc[16];
#pragma unroll
            for (int p = 0; p < 16; ++p) acc[p] = ob[p * 1028 + ch];
            const size_t ostride = (size_t)512 * (L + 64);
            GAS bf16_t* hro = (uu < 256 ? (GAS bf16_t*)(c.ws + WS_HRL) + ((size_t)(l * 2) * 512 + c.tid) * (4096 + 64) : (GAS bf16_t*)(c.ws + WS_HRC) + ((size_t)(l * 2) * 512 + c.tid) * (256 + 64)) + hc * ostride;
            const float r0 = fabsf(MINDEC + (float)ch * ((MAXDEC - MINDEC) / 1023.f));
            float f0[16];
#pragma unroll
            for (int p = 0; p < 16; ++p) { const int pos = p0 + p; const float dist = fabsf((float)(pos - L / 2)) * (2.f / (float)L); f0[p] = acc[p] * (__expf(-dist * r0) + 0.05f); }
            {   u32x4 w0, w1;
                w0.x = cvt_pk_bf16(f0[15], f0[14]); w0.y = cvt_pk_bf16(f0[13], f0[12]); w0.z = cvt_pk_bf16(f0[11], f0[10]); w0.w = cvt_pk_bf16(f0[9], f0[8]);
                w1.x = cvt_pk_bf16(f0[7], f0[6]); w1.y = cvt_pk_bf16(f0[5], f0[4]); w1.z = cvt_pk_bf16(f0[3], f0[2]); w1.w = cvt_pk_bf16(f0[1], f0[0]);
                GAS bf16_t* d0 = hro + (L + 16 - p0);
                *(GAS u32x4*)d0 = w0; *(GAS u32x4*)(d0 + 8) = w1;
                const u32x4 z4 = (u32x4){0u, 0u, 0u, 0u};
                if (p0 == 0) { for (int k = 0; k < 4; ++k) *(GAS u32x4*)(hro + L + 32 + 8 * k) = z4; }
                if (p0 == L - 16) { for (int k = 0; k < 4; ++k) *(GAS u32x4*)(hro + 8 * k) = z4; } }
        }
        __syncthreads();
    }
}

struct MoeComb { const GAS int* route; const GAS float* rwt; const GAS bf16_t* y; const GAS float* gate; const GAS bf16_t* y1; };
__device__ __forceinline__ void moe_combine_row(const MoeComb& mc, const LAS unsigned* offs, int row, int b, int lane, f32x4 (&v)[4]) {
    const int e1 = mc.route[(size_t)row * 4 + 0], p1 = mc.route[(size_t)row * 4 + 1], e2 = mc.route[(size_t)row * 4 + 2], p2 = mc.route[(size_t)row * 4 + 3];
    const float w1 = mc.rwt[(size_t)row * 2], w2 = mc.rwt[(size_t)row * 2 + 1];
    const size_t s1 = (size_t)offs[e1] + p1, s2 = (size_t)offs[e2] + p2, sp0 = (size_t)offs[9];
    const GAS float* gt = mc.gate + (size_t)b * 6144;
    const bool sp1 = s1 >= sp0, sp2 = s2 >= sp0;
#pragma unroll
    for (int j = 0; j < 4; ++j) { const int k0 = 4 * (lane + 64 * j);
        const u32x2 a = *(const GAS u32x2*)(mc.y + s1 * D + k0), bq = *(const GAS u32x2*)(mc.y + s2 * D + k0); const f32x4 g4 = *(const GAS f32x4*)(gt + k0);
        f32x4 ya = (f32x4){bflo(a.x), bfhi(a.x), bflo(a.y), bfhi(a.y)}, yb = (f32x4){bflo(bq.x), bfhi(bq.x), bflo(bq.y), bfhi(bq.y)};
        if (sp1) { const u32x2 t = *(const GAS u32x2*)(mc.y1 + (s1 - sp0) * D + k0); ya += (f32x4){bflo(t.x), bfhi(t.x), bflo(t.y), bfhi(t.y)}; }
        if (sp2) { const u32x2 t = *(const GAS u32x2*)(mc.y1 + (s2 - sp0) * D + k0); yb += (f32x4){bflo(t.x), bfhi(t.x), bflo(t.y), bfhi(t.y)}; }
        v[j] += g4 * (w1 * ya + w2 * yb); }
}
__device__ __forceinline__ unsigned moe_split0(unsigned offs7, unsigned total);
__device__ __forceinline__ void moe_offsets(const Ctx& c, int i, LAS unsigned* offs) {
    if (c.tid == 0) { const GAS unsigned* cnt = (const GAS unsigned*)(c.ws + WS_CTL) + CW_CNT + 64 * i; unsigned o = 0;
        for (int e = 0; e < 8; ++e) { offs[e] = o; o += (cnt[e] + 255u) & ~255u; } offs[8] = o; offs[9] = moe_split0(offs[7], o); }
}
__device__ __forceinline__ void ph_norm(const Ctx& c0, int l, int which) {
    const Ctx c = mk_ctx(c0.lds, c0.ws, c0.wave);
    GAS bf16_t* xres = (GAS bf16_t*)(c.ws + WS_X); GAS bf16_t* h = (GAS bf16_t*)(c.ws + WS_H);
    const GAS float* mod = (const GAS float*)(c.ws + WS_MOD) + (size_t)l * 5 * 6144;
    const GAS float* gp = (which == 0 ? inp(c, I_N1G) : inp(c, I_N2G)) + l * D;
    const bool first = (l == 0 && which == 0), route = (which == 1 && (l & 1));
    const int comb = (which == 0 && l >= 1 && ((l - 1) & 1)) ? ((l - 1) >> 1) : -1;
    const GAS float* router = inp(c, I_ROUTER) + (size_t)(l >> 1) * D * NE;
    GAS int* routeb = (GAS int*)(c.ws + WS_ROUTE); GAS float* rwt = (GAS float*)(c.ws + WS_RWT); GAS int* tokenof = (GAS int*)(c.ws + WS_TOK);
    const MoeComb mc{routeb, rwt, (const GAS bf16_t*)(c.ws + WS_Y), (const GAS float*)(c.ws + WS_MOD) + (size_t)(l > 0 ? l - 1 : 0) * 5 * 6144 + 5 * 1024, (const GAS bf16_t*)(c.ws + WS_VT)};
    LAS unsigned* lcnt = (LAS unsigned*)c.lds; LAS unsigned* gbase = lcnt + 16; LAS unsigned* offs = lcnt + 32; LAS int* pend = (LAS int*)(c.lds + 256);
    if (c.tid < 8) lcnt[c.tid] = 0u;
    if (comb >= 0) moe_offsets(c, comb, offs);
    LAS float* rlds = (LAS float*)(c.lds + 4096);
    if (route) { for (int i = c.tid; i < D * NE / 4; i += NTHR) { const f32x4 rv = *(const GAS f32x4*)(router + 4 * i); const int k = i >> 1, e0 = (i & 1) * 4;
#pragma unroll
            for (int q = 0; q < 4; ++q) rlds[(e0 + q) * 1024 + k] = rv[q]; } }
    LAS float* gsl = (LAS float*)(c.lds + 40960); LAS float* shl = gsl + 5 * 1024;
    for (int i = c.tid; i < 5 * 256; i += NTHR) { const int bb = i >> 8, k0 = (i & 255) * 4; const GAS float* shp = mod + (size_t)bb * 6144 + (which == 0 ? 0 : 3) * 1024;
        const f32x4 g4 = *(const GAS f32x4*)(gp + k0), s4 = *(const GAS f32x4*)(shp + 1024 + k0), h4 = *(const GAS f32x4*)(shp + k0);
        *(LAS f32x4*)(gsl + bb * 1024 + k0) = g4 * (s4 + 1.f); *(LAS f32x4*)(shl + bb * 1024 + k0) = h4; }
    __syncthreads();
    const GAS float* xin = inp(c, I_X); const GAS float* ctxin = inp(c, I_CTX);
    int nrows = 0;
    const int nrow_all = (which == 1 && l == DEPTH - 1) ? TL : T;
#define NORM_LOAD(dst, rw) do { if (first) { const GAS float* s_ = ((rw) < TL ? xin + (size_t)(rw) * D : ctxin + (size_t)((rw) - TL) * D); \
            _Pragma("unroll") for (int j = 0; j < 4; ++j) dst[j] = *(const GAS u32x4*)(s_ + 4 * (c.lane + 64 * j)); } \
        else { const GAS bf16_t* s_ = xres + (size_t)(rw) * D; \
            _Pragma("unroll") for (int j = 0; j < 4; ++j) { const u32x2 t_ = *(const GAS u32x2*)(s_ + 4 * (c.lane + 64 * j)); dst[j].x = t_.x; dst[j].y = t_.y; } } } while (0)
    const int rstride = c.G * NWAVES;
    u32x4 vnx[4] = {(u32x4){0u, 0u, 0u, 0u}, (u32x4){0u, 0u, 0u, 0u}, (u32x4){0u, 0u, 0u, 0u}, (u32x4){0u, 0u, 0u, 0u}};
    { const int row = c.bid * NWAVES + c.wave; if (row < nrow_all) NORM_LOAD(vnx, row); }
    for (int row = c.bid * NWAVES + c.wave; row < nrow_all; row += rstride, ++nrows) {
        const int b = row < TL ? (row >> 12) : 4;
        f32x4 v[4]; float ss = 0.f;
#pragma unroll
        for (int j = 0; j < 4; ++j) { const u32x4 r_ = vnx[j];
            v[j][0] = first ? __uint_as_float(r_.x) : bflo(r_.x); v[j][1] = first ? __uint_as_float(r_.y) : bfhi(r_.x); v[j][2] = first ? __uint_as_float(r_.z) : bflo(r_.y); v[j][3] = first ? __uint_as_float(r_.w) : bfhi(r_.y); }
        if (row + rstride < nrow_all) NORM_LOAD(vnx, row + rstride);
        if (comb >= 0) moe_combine_row(mc, offs, row, b, c.lane, v);
#pragma unroll
        for (int j = 0; j < 4; ++j) ss += (v[j][0] * v[j][0] + v[j][1] * v[j][1]) + (v[j][2] * v[j][2] + v[j][3] * v[j][3]);
        ss = wave_sum(ss, c.lane);
        const float rstd = 1.f / sqrtf(ss * (1.f / D) + EPS);
        if (first || comb >= 0) {
#pragma unroll
            for (int j = 0; j < 4; ++j) { u32x2 w; w.x = cvt_pk_bf16(v[j][0], v[j][1]); w.y = cvt_pk_bf16(v[j][2], v[j][3]); *(GAS u32x2*)(xres + (size_t)row * D + 4 * (c.lane + 64 * j)) = w; }
        }
        float lg[8] = {0.f, 0.f, 0.f, 0.f, 0.f, 0.f, 0.f, 0.f};
#pragma unroll
        for (int j = 0; j < 4; ++j) { const int k0 = 4 * (c.lane + 64 * j);
            const f32x4 g4 = *(const LAS f32x4*)(gsl + b * 1024 + k0), h4 = *(const LAS f32x4*)(shl + b * 1024 + k0);
            f32x4 o;
#pragma unroll
            for (int q = 0; q < 4; ++q) o[q] = v[j][q] * rstd * g4[q] + h4[q];
            u32x2 w; w.x = cvt_pk_bf16(o[0], o[1]); w.y = cvt_pk_bf16(o[2], o[3]);
            *(GAS u32x2*)(h + (size_t)row * D + k0) = w;
            if (route) {
#pragma unroll
                for (int e = 0; e < 8; ++e) { const f32x4 re = *(const LAS f32x4*)(rlds + e * 1024 + k0);
                    lg[e] += o[0] * re[0]; lg[e] += o[1] * re[1]; lg[e] += o[2] * re[2]; lg[e] += o[3] * re[3]; }
            }
        }
        if (route) {
#pragma unroll
            for (int e = 0; e < 8; ++e) lg[e] = wave_sum(lg[e], c.lane);
            int i1 = 0; float v1 = lg[0];
#pragma unroll
            for (int e = 1; e < 8; ++e) if (lg[e] > v1) { v1 = lg[e]; i1 = e; }
            int i2 = -1; float v2 = -3.0e38f;
#pragma unroll
            for (int e = 0; e < 8; ++e) if (e != i1 && lg[e] > v2) { v2 = lg[e]; i2 = e; }
            const float w1 = 1.f / (1.f + __expf(v2 - v1)), w2 = 1.f - w1;
            if (c.lane == 0) {
                const unsigned lp1 = __hip_atomic_fetch_add(lcnt + i1, 1u, __ATOMIC_RELAXED, __HIP_MEMORY_SCOPE_WORKGROUP), lp2 = __hip_atomic_fetch_add(lcnt + i2, 1u, __ATOMIC_RELAXED, __HIP_MEMORY_SCOPE_WORKGROUP);
                LAS int* pe = pend + (c.wave * 16 + nrows) * 4; pe[0] = row; pe[1] = i1 | (i2 << 8); pe[2] = (int)lp1; pe[3] = (int)lp2;
                rwt[(size_t)row * 2] = w1; rwt[(size_t)row * 2 + 1] = w2; }
        }
    }
    if (route) {
        __syncthreads();
        if (c.tid < 8) gbase[c.tid] = __hip_atomic_fetch_add((GAS unsigned*)(c.ws + WS_CTL) + CW_CNT + 64 * (l >> 1) + c.tid, lcnt[c.tid], __ATOMIC_RELAXED, __HIP_MEMORY_SCOPE_AGENT);
        __syncthreads();
        if (c.lane < nrows) { const LAS int* pe = pend + (c.wave * 16 + c.lane) * 4; const int row = pe[0], e1 = pe[1] & 255, e2 = pe[1] >> 8;
            const int p1 = (int)gbase[e1] + pe[2], p2 = (int)gbase[e2] + pe[3];
            tokenof[(size_t)e1 * T + p1] = row; tokenof[(size_t)e2 * T + p2] = row;
            routeb[(size_t)row * 4 + 0] = e1; routeb[(size_t)row * 4 + 1] = p1; routeb[(size_t)row * 4 + 2] = e2; routeb[(size_t)row * 4 + 3] = p2; }
    }
    __syncthreads();
}

__device__ __forceinline__ void sc_load(const GAS bf16_t* P, int tile, int lane, u32x4 (&pre)[9]) {
    const int rt = tile / 32, row0 = rt * 64, ct = tile % 32; const bool isv = ct >= 24;
    const int scol = isv ? PV + (ct - 24) * 64 : PHY + ct * 64;
    const int tpos = row0 < TL ? (row0 & 4095) : ((row0 - TL) & 255), Ls = row0 < TL ? 4096 : 256;
#pragma unroll
    for (int it = 0; it < 9; ++it) { const int idx = lane + 64 * it, rr = idx >> 3, ck = idx & 7;
        const bool ok = idx < 66 * 8 && !((rr == 0 && tpos == 0) || (rr == 65 && tpos + 64 == Ls));
        const int rrs = ok ? rr : 1;
        const u32x4 v = *(const GAS u32x4*)(P + (size_t)(row0 - 1 + rrs) * PW + scol + ck * 8);
        pre[it] = ok ? v : (u32x4){0u, 0u, 0u, 0u}; }
}
__device__ __forceinline__ void ph_sc(const Ctx& c0, int l, int o0, int ostride, int ocount) {
    const Ctx c = mk_ctx(c0.lds, c0.ws, c0.wave);
    const GAS bf16_t* P = (const GAS bf16_t*)(c.ws + WS_P); GAS bf16_t* uT = (GAS bf16_t*)(c.ws + WS_B); GAS bf16_t* VT = (GAS bf16_t*)(c.ws + WS_VT);
    const GAS float* cw = inp(c, I_HCW) + (size_t)l * 3 * 1536; const GAS float* cb = inp(c, I_HCB) + (size_t)l * 1536;
    LAS unsigned char* scr = c.lds + c.wave * 16384;
    const int tstride = ostride * NWAVES;
    u32x4 pre[9];
    if (ocount > 0) sc_load(P, o0 * NWAVES + c.wave, c.lane, pre);
    for (int k = 0, tile = o0 * NWAVES + c.wave; k < ocount; ++k, tile += tstride) {
        const int rt = tile / 32, row0 = rt * 64, ct = tile % 32; const bool isv = ct >= 24;
        const int ch0 = isv ? (ct - 24) * 64 : ct * 64; GAS bf16_t* dst = isv ? VT : uT;
#pragma unroll
        for (int it = 0; it < 9; ++it) { const int idx = c.lane + 64 * it, rr = idx >> 3, ck = idx & 7;
            if (idx < 66 * 8) { LAS unsigned* d = (LAS unsigned*)(scr + rr * 132 + ck * 16); d[0] = pre[it].x; d[1] = pre[it].y; d[2] = pre[it].z; d[3] = pre[it].w; } }
        if (k + 1 < ocount) sc_load(P, tile + tstride, c.lane, pre);
        LDS_WAIT(); asm volatile("" ::: "memory");
        const int ch = ch0 + c.lane; const float w0 = isv ? 0.f : cw[ch], w1 = isv ? 1.f : cw[1536 + ch], w2 = isv ? 0.f : cw[3072 + ch], bb = isv ? 0.f : cb[ch];
        unsigned ow[32];
        { float prev = bf2f(*(const LAS unsigned short*)(scr + 0 * 132 + c.lane * 2)), cur = bf2f(*(const LAS unsigned short*)(scr + 1 * 132 + c.lane * 2)); float o0 = 0.f;
#pragma unroll
          for (int r = 0; r < 64; ++r) { const float nxt = bf2f(*(const LAS unsigned short*)(scr + (r + 2) * 132 + c.lane * 2));
              const float o = w0 * prev + w1 * cur + w2 * nxt + bb; prev = cur; cur = nxt;
              if (r & 1) ow[r >> 1] = cvt_pk_bf16(o0, o); else o0 = o; } }
        LDS_WAIT(); asm volatile("" ::: "memory");
#pragma unroll
        for (int k = 0; k < 8; ++k) { u32x4 v; v.x = ow[4 * k]; v.y = ow[4 * k + 1]; v.z = ow[4 * k + 2]; v.w = ow[4 * k + 3]; *(LAS u32x4*)(scr + c.lane * 144 + k * 16) = v; }
        LDS_WAIT(); asm volatile("" ::: "memory");
#pragma unroll
        for (int k = 0; k < 8; ++k) { const int cc = (c.lane >> 3) + 8 * k, ck = c.lane & 7; const u32x4 v = *(const LAS u32x4*)(scr + cc * 144 + ck * 16);
            *(GAS u32x4*)(dst + (size_t)(ch0 + cc) * T + row0 + ck * 8) = v; }
        LDS_WAIT(); asm volatile("" ::: "memory");
    }
}

constexpr int HY_HR_OFF = 512, HY_U_OFF = HY_HR_OFF + 66560, HY_ZB_OFF = HY_U_OFF + 4 * 8208;
template <int L, bool DUAL>
__device__ __forceinline__ void hy_span(LAS unsigned char* lds, int nsteps, int aaddr, int ubase, int sX, int sY, f32x16& accX, f32x16& accY) {
#define HY_BADDR(sv) (((unsigned)(sv) <= (unsigned)(L - 16)) ? ubase + 2 * (sv) : HY_ZB_OFF)
    int k = 0;
    for (; k + 4 <= nsteps; k += 4) {
        const int pa = aaddr - 768;
        const int px0 = HY_BADDR(sX), px1 = HY_BADDR(sX - 16), px2 = HY_BADDR(sX - 32), px3 = HY_BADDR(sX - 48);
        bf16x8 a0, a1, a2, a3, x0, x1, x2, x3;
        if (DUAL) {
            const int py0 = HY_BADDR(sY), py1 = HY_BADDR(sY - 16), py2 = HY_BADDR(sY - 32), py3 = HY_BADDR(sY - 48);
            bf16x8 y0, y1, y2, y3;
            asm volatile(
                "ds_read_b128 %[a0], %[pa] offset:768\n\tds_read_b128 %[x0], %[px0]\n\tds_read_b128 %[y0], %[py0]\n\t"
                "ds_read_b128 %[a1], %[pa] offset:512\n\tds_read_b128 %[x1], %[px1]\n\tds_read_b128 %[y1], %[py1]\n\t"
                "ds_read_b128 %[a2], %[pa] offset:256\n\tds_read_b128 %[x2], %[px2]\n\tds_read_b128 %[y2], %[py2]\n\t"
                "ds_read_b128 %[a3], %[pa]\n\tds_read_b128 %[x3], %[px3]\n\tds_read_b128 %[y3], %[py3]\n\t"
                "s_waitcnt lgkmcnt(9)\n\tv_mfma_f32_32x32x16_bf16 %[cx], %[a0], %[x0], %[cx]\n\tv_mfma_f32_32x32x16_bf16 %[cy], %[a0], %[y0], %[cy]\n\t"
                "s_waitcnt lgkmcnt(6)\n\tv_mfma_f32_32x32x16_bf16 %[cx], %[a1], %[x1], %[cx]\n\tv_mfma_f32_32x32x16_bf16 %[cy], %[a1], %[y1], %[cy]\n\t"
                "s_waitcnt lgkmcnt(3)\n\tv_mfma_f32_32x32x16_bf16 %[cx], %[a2], %[x2], %[cx]\n\tv_mfma_f32_32x32x16_bf16 %[cy], %[a2], %[y2], %[cy]\n\t"
                "s_waitcnt lgkmcnt(0)\n\tv_mfma_f32_32x32x16_bf16 %[cx], %[a3], %[x3], %[cx]\n\tv_mfma_f32_32x32x16_bf16 %[cy], %[a3], %[y3], %[cy]\n\t"
                : [cx] "+v"(accX), [cy] "+v"(accY), [a0] "=&v"(a0), [a1] "=&v"(a1), [a2] "=&v"(a2), [a3] "=&v"(a3), [x0] "=&v"(x0), [x1] "=&v"(x1), [x2] "=&v"(x2), [x3] "=&v"(x3),
                  [y0] "=&v"(y0), [y1] "=&v"(y1), [y2] "=&v"(y2), [y3] "=&v"(y3)
                : [pa] "v"(pa), [px0] "v"(px0), [px1] "v"(px1), [px2] "v"(px2), [px3] "v"(px3), [py0] "v"(py0), [py1] "v"(py1), [py2] "v"(py2), [py3] "v"(py3));
        } else {
            asm volatile(
                "ds_read_b128 %[a0], %[pa] offset:768\n\tds_read_b128 %[x0], %[px0]\n\t"
                "ds_read_b128 %[a1], %[pa] offset:512\n\tds_read_b128 %[x1], %[px1]\n\t"
                "ds_read_b128 %[a2], %[pa] offset:256\n\tds_read_b128 %[x2], %[px2]\n\t"
                "ds_read_b128 %[a3], %[pa]\n\tds_read_b128 %[x3], %[px3]\n\t"
                "s_waitcnt lgkmcnt(6)\n\tv_mfma_f32_32x32x16_bf16 %[cx], %[a0], %[x0], %[cx]\n\t"
                "s_waitcnt lgkmcnt(4)\n\tv_mfma_f32_32x32x16_bf16 %[cx], %[a1], %[x1], %[cx]\n\t"
                "s_waitcnt lgkmcnt(2)\n\tv_mfma_f32_32x32x16_bf16 %[cx], %[a2], %[x2], %[cx]\n\t"
                "s_waitcnt lgkmcnt(0)\n\tv_mfma_f32_32x32x16_bf16 %[cx], %[a3], %[x3], %[cx]\n\t"
                : [cx] "+v"(accX), [a0] "=&v"(a0), [a1] "=&v"(a1), [a2] "=&v"(a2), [a3] "=&v"(a3), [x0] "=&v"(x0), [x1] "=&v"(x1), [x2] "=&v"(x2), [x3] "=&v"(x3)
                : [pa] "v"(pa), [px0] "v"(px0), [px1] "v"(px1), [px2] "v"(px2), [px3] "v"(px3));
        }
        aaddr -= 1024; sX -= 64; sY -= 64;
    }
    for (; k < nsteps; ++k) {
        const bf16x8 af = *(const LAS bf16x8*)(lds + aaddr), xf = *(const LAS bf16x8*)(lds + HY_BADDR(sX));
        accX = __builtin_amdgcn_mfma_f32_32x32x16_bf16(af, xf, accX, 0, 0, 0);
        if (DUAL) { const bf16x8 yf = *(const LAS bf16x8*)(lds + HY_BADDR(sY)); accY = __builtin_amdgcn_mfma_f32_32x32x16_bf16(af, yf, accY, 0, 0, 0); }
        aaddr -= 256; sX -= 16; sY -= 16;
    }
#undef HY_BADDR
}
__device__ __forceinline__ void hy_dual_interior(int nblk, int aaddr, int bx, int by, f32x16& accX, f32x16& accY) {
    if (nblk <= 0) return;
    int pa = aaddr - 768, px = bx - 96, py = by - 96;
    bf16x8 a0, a1, a2, a3, x0, x1, x2, x3, y0, y1, y2, y3;
    asm volatile(
        "ds_read_b128 %[a0], %[pa] offset:768\n\tds_read_b128 %[x0], %[px] offset:96\n\tds_read_b128 %[y0], %[py] offset:96\n\t"
        "ds_read_b128 %[a1], %[pa] offset:512\n\tds_read_b128 %[x1], %[px] offset:64\n\tds_read_b128 %[y1], %[py] offset:64\n"
        "L_hyint_%=:\n\t"
        "ds_read_b128 %[a2], %[pa] offset:256\n\tds_read_b128 %[x2], %[px] offset:32\n\tds_read_b128 %[y2], %[py] offset:32\n\t"
        "ds_read_b128 %[a3], %[pa]\n\tds_read_b128 %[x3], %[px]\n\tds_read_b128 %[y3], %[py]\n\t"
        "s_waitcnt lgkmcnt(9)\n\tv_mfma_f32_32x32x16_bf16 %[cx], %[a0], %[x0], %[cx]\n\tv_mfma_f32_32x32x16_bf16 %[cy], %[a0], %[y0], %[cy]\n\t"
        "s_waitcnt lgkmcnt(6)\n\tv_mfma_f32_32x32x16_bf16 %[cx], %[a1], %[x1], %[cx]\n\tv_mfma_f32_32x32x16_bf16 %[cy], %[a1], %[y1], %[cy]\n\t"
        "v_add_u32 %[pa], 0xfffffc00, %[pa]\n\tv_add_u32 %[px], 0xffffff80, %[px]\n\tv_add_u32 %[py], 0xffffff80, %[py]\n\t"
        "ds_read_b128 %[a0], %[pa] offset:768\n\tds_read_b128 %[x0], %[px] offset:96\n\tds_read_b128 %[y0], %[py] offset:96\n\t"
        "ds_read_b128 %[a1], %[pa] offset:512\n\tds_read_b128 %[x1], %[px] offset:64\n\tds_read_b128 %[y1], %[py] offset:64\n\t"
        "s_waitcnt lgkmcnt(9)\n\tv_mfma_f32_32x32x16_bf16 %[cx], %[a2], %[x2], %[cx]\n\tv_mfma_f32_32x32x16_bf16 %[cy], %[a2], %[y2], %[cy]\n\t"
        "s_waitcnt lgkmcnt(6)\n\tv_mfma_f32_32x32x16_bf16 %[cx], %[a3], %[x3], %[cx]\n\tv_mfma_f32_32x32x16_bf16 %[cy], %[a3], %[y3], %[cy]\n\t"
        "s_sub_u32 %[n], %[n], 1\n\ts_cmp_lg_u32 %[n], 0\n\ts_cbranch_scc1 L_hyint_%=\n\t"
        "s_waitcnt lgkmcnt(0)\n\t"
        : [cx] "+v"(accX), [cy] "+v"(accY), [a0] "=&v"(a0), [a1] "=&v"(a1), [a2] "=&v"(a2), [a3] "=&v"(a3), [x0] "=&v"(x0), [x1] "=&v"(x1), [x2] "=&v"(x2), [x3] "=&v"(x3),
          [y0] "=&v"(y0), [y1] "=&v"(y1), [y2] "=&v"(y2), [y3] "=&v"(y3), [pa] "+v"(pa), [px] "+v"(px), [py] "+v"(py), [n] "+s"(nblk)
        :
        : "scc");
}
__device__ __forceinline__ void hy_single_interior(int nblk, int aaddr, int bx, f32x16& accX) {
    if (nblk <= 0) return;
    int pa = aaddr - 768, px = bx - 96;
    bf16x8 a0, a1, a2, a3, x0, x1, x2, x3;
    asm volatile(
        "ds_read_b128 %[a0], %[pa] offset:768\n\tds_read_b128 %[x0], %[px] offset:96\n\t"
        "ds_read_b128 %[a1], %[pa] offset:512\n\tds_read_b128 %[x1], %[px] offset:64\n"
        "L_hysint_%=:\n\t"
        "ds_read_b128 %[a2], %[pa] offset:256\n\tds_read_b128 %[x2], %[px] offset:32\n\t"
        "ds_read_b128 %[a3], %[pa]\n\tds_read_b128 %[x3], %[px]\n\t"
        "s_waitcnt lgkmcnt(6)\n\tv_mfma_f32_32x32x16_bf16 %[cx], %[a0], %[x0], %[cx]\n\t"
        "s_waitcnt lgkmcnt(4)\n\tv_mfma_f32_32x32x16_bf16 %[cx], %[a1], %[x1], %[cx]\n\t"
        "v_add_u32 %[pa], 0xfffffc00, %[pa]\n\tv_add_u32 %[px], 0xffffff80, %[px]\n\t"
        "ds_read_b128 %[a0], %[pa] offset:768\n\tds_read_b128 %[x0], %[px] offset:96\n\t"
        "ds_read_b128 %[a1], %[pa] offset:512\n\tds_read_b128 %[x1], %[px] offset:64\n\t"
        "s_waitcnt lgkmcnt(6)\n\tv_mfma_f32_32x32x16_bf16 %[cx], %[a2], %[x2], %[cx]\n\t"
        "s_waitcnt lgkmcnt(4)\n\tv_mfma_f32_32x32x16_bf16 %[cx], %[a3], %[x3], %[cx]\n\t"
        "s_sub_u32 %[n], %[n], 1\n\ts_cmp_lg_u32 %[n], 0\n\ts_cbranch_scc1 L_hysint_%=\n\t"
        "s_waitcnt lgkmcnt(0)\n\t"
        : [cx] "+v"(accX), [a0] "=&v"(a0), [a1] "=&v"(a1), [a2] "=&v"(a2), [a3] "=&v"(a3), [x0] "=&v"(x0), [x1] "=&v"(x1), [x2] "=&v"(x2), [x3] "=&v"(x3),
          [pa] "+v"(pa), [px] "+v"(px), [n] "+s"(nblk)
        :
        : "scc");
}
template <int L>
__device__ __forceinline__ void hy_single_span(LAS unsigned char* lds, int nsteps, int d0, int G, int n, int g, int tbl, int qq, int ubase, f32x16& acc, f32x16& dummy) {
    constexpr int H = L / 2;
#define HY_AADDR2(d) (HY_HR_OFF + (8 * ((H + 31 - (d) - n + 8 * g + qq) >> 3) + qq) * 16)
#define HY_S02(d) (32 * (8 * G + tbl) - (d))
    if (nsteps <= 0) return;
    const int dE = d0 + 16 * (nsteps - 1);
    const int di0 = max(d0, 256 * G + 240 - L), di1 = min(dE, 256 * G);
    const int nint = di1 >= di0 ? (di1 - di0) / 16 + 1 : 0, nblk = nint >> 2, npre = nblk > 0 ? (di0 - d0) / 16 : 0;
    if (npre > 0) hy_span<L, false>(lds, npre, HY_AADDR2(d0), ubase, HY_S02(d0), 0, acc, dummy);
    if (nblk > 0) hy_single_interior(nblk, HY_AADDR2(di0), ubase + 2 * HY_S02(di0), acc);
    const int dpost = nblk > 0 ? di0 + 64 * nblk : d0;
    if (dpost <= dE) hy_span<L, false>(lds, (dE - dpost) / 16 + 1, HY_AADDR2(dpost), ubase, HY_S02(dpost), 0, acc, dummy);
#undef HY_AADDR2
#undef HY_S02
}
template <int L>
__device__ __forceinline__ void hy_unit(const Ctx& c, int l, int ch, const GAS float* hbias) {
    constexpr int H = L / 2, NG = L / 256, LP = L + 64, NW = L / 8 + 8, ROWB = 2 * L + 16;
    LAS unsigned char* lds = c.lds;
    const GAS bf16_t* uT = (const GAS bf16_t*)(c.ws + WS_B); GAS bf16_t* oht = (GAS bf16_t*)(c.ws + WS_OHT);
    const int seq0 = (L == 4096) ? 0 : TL;
    const GAS bf16_t* hrbase = (L == 4096) ? (const GAS bf16_t*)(c.ws + WS_HRL) : (const GAS bf16_t*)(c.ws + WS_HRC);
    int gA, gB;
    if (NG == 16) { gA = (int)((0xDA109843u >> (4 * c.wave)) & 15u); gB = (int)((0xEF25BC67u >> (4 * c.wave)) & 15u); } else { gA = c.wave == 0 ? 0 : -1; gB = -1; }
    const int n = c.lane & 31, g = c.lane >> 5, tbl = n >> 2, b = n & 3;
    const int loA = gA < 0 ? 1 << 30 : max(-H - 16, 256 * gA - (L - 16)), hiA = gA < 0 ? -(1 << 30) : min(H, 256 * gA + 224);
    const int loB = gB < 0 ? 1 << 30 : max(-H - 16, 256 * gB - (L - 16)), hiB = gB < 0 ? -(1 << 30) : min(H, 256 * gB + 224);
    const int dlo = min(loA, loB), dhi = max(hiA, hiB);
    unsigned zreg[2][4][2];
    u32x4 fwA[2], fwB[2];
#define HY_LOAD_FW(oo) do { const GAS bf16_t* hr_ = hrbase + ((size_t)(l * 2 + (oo)) * 512 + ch) * LP; _Pragma("unroll") for (int k_ = 0; k_ < 2; ++k_) { const int w_ = c.tid + NTHR * k_; \
        const int wc_ = w_ < NW ? w_ : 0; fwA[k_] = *(const GAS u32x4*)(hr_ + 8 * (wc_ > 0 ? wc_ - 1 : 0)); fwB[k_] = *(const GAS u32x4*)(hr_ + 8 * wc_); } } while (0)
    HY_LOAD_FW(0);
    for (int o = 0; o < 2; ++o) {
#pragma unroll
        for (int kf = 0; kf < 2; ++kf) { const int w = c.tid + NTHR * kf; if (w < NW) {
            const u32x4 A4 = w > 0 ? fwA[kf] : (u32x4){0u, 0u, 0u, 0u}, B4 = fwB[kf];
            const unsigned Dd[8] = {A4.x, A4.y, A4.z, A4.w, B4.x, B4.y, B4.z, B4.w};
#pragma unroll
            for (int q = 0; q < 8; ++q) { u32x4 ov;
                if ((q & 1) == 0) { const int j = (8 - q) / 2; ov.x = Dd[j]; ov.y = Dd[j + 1]; ov.z = Dd[j + 2]; ov.w = Dd[j + 3]; }
                else { const int j = (7 - q) / 2; ov.x = __builtin_amdgcn_alignbit(Dd[j + 1], Dd[j], 16); ov.y = __builtin_amdgcn_alignbit(Dd[j + 2], Dd[j + 1], 16);
                       ov.z = __builtin_amdgcn_alignbit(Dd[j + 3], Dd[j + 2], 16); ov.w = __builtin_amdgcn_alignbit(Dd[j + 4], Dd[j + 3], 16); }
                *(LAS u32x4*)(lds + HY_HR_OFF + (8 * w + q) * 16) = ov; }
        } }
        if (o == 0) {
            for (int idx = c.tid; idx < 4 * (L / 8); idx += NTHR) { const int bb = idx / (L / 8), wq = idx % (L / 8);
                *(LAS u32x4*)(lds + HY_U_OFF + bb * ROWB + wq * 16) = *(const GAS u32x4*)(uT + (size_t)ch * T + seq0 + bb * L + wq * 8); }
            if (c.tid < 16) *(LAS unsigned*)(lds + HY_ZB_OFF + c.tid * 4) = 0u;
        } else {
#pragma unroll
            for (int gi = 0; gi < 2; ++gi) { const int G = gi == 0 ? gA : gB; if (G >= 0) {
#pragma unroll
                for (int rq = 0; rq < 4; ++rq) { const int t = 32 * (8 * G + tbl) + 8 * rq + 4 * g;
                    u32x2 zz; zz.x = zreg[gi][rq][0]; zz.y = zreg[gi][rq][1]; *(LAS u32x2*)(lds + HY_U_OFF + b * ROWB + 2 * t) = zz; } } }
        }
        __syncthreads();
        u32x2 xv[2][4];
#pragma unroll
        for (int gi = 0; gi < 2; ++gi) { const int G = gi == 0 ? gA : gB;
#pragma unroll
            for (int rq = 0; rq < 4; ++rq)
                xv[gi][rq] = *(const GAS u32x2*)(uT + (size_t)((o == 0 ? 512 : 1024) + ch) * T + (size_t)seq0 + b * L + 32 * (8 * (G >= 0 ? G : 0) + tbl) + 8 * rq + 4 * g); }
        if (o == 0) HY_LOAD_FW(1);
        __builtin_amdgcn_sched_barrier(0);
        f32x16 accA, accB;
#pragma unroll
        for (int r = 0; r < 16; ++r) { accA[r] = 0.f; accB[r] = 0.f; }
        {
            const int qq = (n + 1) & 7, ubase = HY_U_OFF + b * ROWB + 16 * g;
#define HY_AADDR(d) (HY_HR_OFF + (8 * ((H + 31 - (d) - n + 8 * g + qq) >> 3) + qq) * 16)
#define HY_S0(G, d) (32 * (8 * (G) + tbl) - (d))
            if (gB < 0) { if (gA >= 0) hy_single_span<L>(lds, (hiA - loA) / 16 + 1, loA, gA, n, g, tbl, qq, ubase, accA, accB); }
            else {
                const int dS = max(loA, loB), dE = min(hiA, hiB);
                if (loA < dS) hy_single_span<L>(lds, (dS - loA) / 16, loA, gA, n, g, tbl, qq, ubase, accA, accB);
                else if (loB < dS) hy_single_span<L>(lds, (dS - loB) / 16, loB, gB, n, g, tbl, qq, ubase, accB, accA);
                {
                    const int gmx = max(gA, gB), gmn = min(gA, gB);
                    const int di0 = max(dS, 256 * gmx + 240 - L), di1 = min(dE, 256 * gmn);
                    const int nint = di1 >= di0 ? (di1 - di0) / 16 + 1 : 0, nblk = nint >> 2, npre = nblk > 0 ? (di0 - dS) / 16 : 0;
                    if (npre > 0) hy_span<L, true>(lds, npre, HY_AADDR(dS), ubase, HY_S0(gA, dS), HY_S0(gB, dS), accA, accB);
                    if (nblk > 0) hy_dual_interior(nblk, HY_AADDR(di0), ubase + 2 * HY_S0(gA, di0), ubase + 2 * HY_S0(gB, di0), accA, accB);
                    const int dpost = nblk > 0 ? di0 + 64 * nblk : dS;
                    if (dpost <= dE) hy_span<L, true>(lds, (dE - dpost) / 16 + 1, HY_AADDR(dpost), ubase, HY_S0(gA, dpost), HY_S0(gB, dpost), accA, accB);
                }
                if (hiA > dE) hy_single_span<L>(lds, (hiA - dE) / 16, dE + 16, gA, n, g, tbl, qq, ubase, accA, accB);
                else if (hiB > dE) hy_single_span<L>(lds, (hiB - dE) / 16, dE + 16, gB, n, g, tbl, qq, ubase, accB, accA);
            }
#undef HY_AADDR
#undef HY_S0
        }
        const float bias = hbias[(l * 2 + o) * 512 + ch];
        int tbl_e = tbl, b_e = b, g_e = g; asm volatile("" : "+v"(tbl_e), "+v"(b_e), "+v"(g_e));
#pragma unroll
        for (int gi = 0; gi < 2; ++gi) { const int G = gi == 0 ? gA : gB; if (G >= 0) {
#pragma unroll
            for (int rq = 0; rq < 4; ++rq) { const int t = 32 * (8 * G + tbl_e) + 8 * rq + 4 * g_e;
                const u32x2 uv = *(const LAS u32x2*)(lds + HY_U_OFF + b_e * ROWB + 2 * t);
                const size_t grow = (size_t)seq0 + b_e * L + t;
                const u32x2 xvv = xv[gi][rq];
                float y[4];
#pragma unroll
                for (int k = 0; k < 4; ++k) y[k] = gi == 0 ? accA[4 * rq + k] : accB[4 * rq + k];
                const float r0 = bflo(xvv.x) * (y[0] + bias * bflo(uv.x)), r1 = bfhi(xvv.x) * (y[1] + bias * bfhi(uv.x));
                const float r2 = bflo(xvv.y) * (y[2] + bias * bflo(uv.y)), r3 = bfhi(xvv.y) * (y[3] + bias * bfhi(uv.y));
                const unsigned p0 = cvt_pk_bf16(r0, r1), p1 = cvt_pk_bf16(r2, r3);
                if (o == 0) { zreg[gi][rq][0] = p0; zreg[gi][rq][1] = p1; }
                else { u32x2 ov; ov.x = p0; ov.y = p1; *(GAS u32x2*)(oht + (size_t)ch * T + grow) = ov;   } } } }
        __syncthreads();
    }
}
#undef HY_LOAD_FW
__device__ __forceinline__ void ph_hyena(const Ctx& c0, int l) {
    const Ctx c = mk_ctx(c0.lds, c0.ws, c0.wave);
    const GAS float* hbias = inp(c, I_HBIAS);
    for (int unit = c.bid; unit < HYW; unit += c.G) { hy_unit<4096>(c, l, unit, hbias); if (l < DEPTH - 1) hy_unit<256>(c, l, unit, hbias); }
}

__device__ __forceinline__ void ph_ohy_t(const Ctx& c0) {
    const Ctx c = mk_ctx(c0.lds, c0.ws, c0.wave);
    const GAS bf16_t* src = (const GAS bf16_t*)(c.ws + WS_OHT); GAS bf16_t* dst = (GAS bf16_t*)(c.ws + WS_OAH) + 512;
    LAS unsigned char* scr = c.lds + c.wave * 16384;
    for (int tile = c.bid * NWAVES + c.wave; tile < (T / 64) * 8; tile += c.G * NWAVES) {
        const int row0 = (tile >> 3) * 64, ch0 = (tile & 7) * 64;
#pragma unroll
        for (int k = 0; k < 8; ++k) { const int cc = (c.lane >> 3) + 8 * k, ck = c.lane & 7;
            const u32x4 v = *(const GAS u32x4*)(src + (size_t)(ch0 + cc) * T + row0 + ck * 8);
            LAS unsigned* d = (LAS unsigned*)(scr + cc * 132 + ck * 16); d[0] = v.x; d[1] = v.y; d[2] = v.z; d[3] = v.w; }
        LDS_WAIT(); asm volatile("" ::: "memory");
        unsigned ow[32];
#pragma unroll
        for (int j = 0; j < 32; ++j) { const unsigned lo = *(const LAS unsigned short*)(scr + (2 * j) * 132 + c.lane * 2), hi = *(const LAS unsigned short*)(scr + (2 * j + 1) * 132 + c.lane * 2); ow[j] = lo | (hi << 16); }
        LDS_WAIT(); asm volatile("" ::: "memory");
#pragma unroll
        for (int k = 0; k < 8; ++k) { u32x4 v; v.x = ow[4 * k]; v.y = ow[4 * k + 1]; v.z = ow[4 * k + 2]; v.w = ow[4 * k + 3]; *(LAS u32x4*)(scr + c.lane * 144 + k * 16) = v; }
        LDS_WAIT(); asm volatile("" ::: "memory");
#pragma unroll
        for (int k = 0; k < 8; ++k) { const int rr = (c.lane >> 3) + 8 * k, ck = c.lane & 7; const u32x4 v = *(const LAS u32x4*)(scr + rr * 144 + ck * 16);
            *(GAS u32x4*)(dst + (size_t)(row0 + rr) * 1024 + ch0 + ck * 8) = v; }
        LDS_WAIT(); asm volatile("" ::: "memory");
    }
}

constexpr int ATT_RPB_OFF = 1024, ATT_VT_OFF = ATT_RPB_OFF + 8 * 15 * 32 * 4, ATT_VT_BYTES = 64 * 72;
template <int MODE>
__device__ __forceinline__ void att_block(const GAS bf16_t* P, const GAS bf16_t* VT, LAS unsigned char* lds, LAS unsigned char* vt, int lane, int n, int h, int head,
                                          int tokk, int ctok, int tabaddr, int vb, const bf16x8 (&qf)[4], f32x16& ot0, f32x16& ot1, float& m, float& lsum) {
    bf16x8 kf[4];
#pragma unroll
    for (int ks = 0; ks < 4; ++ks) kf[ks] = *(const GAS bf16x8*)(P + (size_t)tokk * PW + PK + head * 64 + 16 * ks + 8 * h);
    u32x2 vr[8];
#pragma unroll
    for (int it = 0; it < 8; ++it) vr[it] = *(const GAS u32x2*)(VT + (size_t)(head * 64 + it * 8 + (lane >> 3)) * T + ctok);
    f32x16 st;
#pragma unroll
    for (int r = 0; r < 16; ++r) st[r] = 0.f;
#pragma unroll
    for (int ks = 0; ks < 4; ++ks) st = __builtin_amdgcn_mfma_f32_32x32x16_bf16(kf[ks], qf[ks], st, 0, 0, 0);
    const float SC = 0.18033688011112042f;
    float sv[16];
    if (MODE == 2) {
#pragma unroll
        for (int r = 0; r < 16; ++r) sv[r] = st[r] * SC;
    } else {
        float bias[16];
#pragma unroll
        for (int r = 0; r < 16; ++r) { const int imm = MODE == 0 ? (8 * (r >> 2) + (r & 3)) * 4 : ((r >> 2) * 32 + (r & 3)) * 4; bias[r] = *(const volatile LAS float*)(lds + tabaddr + imm); }
#pragma unroll
        for (int r = 0; r < 16; ++r) { const int cr = MODE == 0 ? 8 * (r >> 2) + (r & 3) : (r & 3);
            const float v = st[r] * SC + bias[r]; sv[r] = ((unsigned)(vb + cr) < 16u) ? v : -1.0e30f; }
    }
    float bm = sv[0];
#pragma unroll
    for (int r = 1; r < 16; ++r) bm = fmaxf(bm, sv[r]);
    bm = fmaxf(bm, __int_as_float(__builtin_amdgcn_ds_bpermute((lane ^ 32) << 2, __float_as_int(bm))));
    const float mn = fmaxf(m, bm), alpha = __builtin_amdgcn_exp2f(m - mn); m = mn;
    float psum = 0.f;
#pragma unroll
    for (int r = 0; r < 16; ++r) { const float pv = __builtin_amdgcn_exp2f(sv[r] - mn); psum += pv; sv[r] = pv; }
    lsum = lsum * alpha + psum;
#pragma unroll
    for (int r = 0; r < 16; ++r) { ot0[r] *= alpha; ot1[r] *= alpha; }
    bf16x8 pb[2];
#pragma unroll
    for (int s2 = 0; s2 < 2; ++s2) { u32x4 w; w.x = cvt_pk_bf16(sv[8 * s2], sv[8 * s2 + 1]); w.y = cvt_pk_bf16(sv[8 * s2 + 2], sv[8 * s2 + 3]);
        w.z = cvt_pk_bf16(sv[8 * s2 + 4], sv[8 * s2 + 5]); w.w = cvt_pk_bf16(sv[8 * s2 + 6], sv[8 * s2 + 7]); pb[s2] = __builtin_bit_cast(bf16x8, w); }
#pragma unroll
    for (int it = 0; it < 8; ++it) *(LAS u32x2*)(vt + (it * 8 + (lane >> 3)) * 72 + (lane & 7) * 8) = vr[it];
#pragma unroll
    for (int s2 = 0; s2 < 2; ++s2) {
        { const u32x2 a = *(const LAS u32x2*)(vt + n * 72 + (4 * s2 + h) * 8), bq = *(const LAS u32x2*)(vt + n * 72 + (4 * s2 + 2 + h) * 8);
          u32x4 w; w.x = a.x; w.y = a.y; w.z = bq.x; w.w = bq.y; ot0 = __builtin_amdgcn_mfma_f32_32x32x16_bf16(__builtin_bit_cast(bf16x8, w), pb[s2], ot0, 0, 0, 0); }
        { const u32x2 a = *(const LAS u32x2*)(vt + (32 + n) * 72 + (4 * s2 + h) * 8), bq = *(const LAS u32x2*)(vt + (32 + n) * 72 + (4 * s2 + 2 + h) * 8);
          u32x4 w; w.x = a.x; w.y = a.y; w.z = bq.x; w.w = bq.y; ot1 = __builtin_amdgcn_mfma_f32_32x32x16_bf16(__builtin_bit_cast(bf16x8, w), pb[s2], ot1, 0, 0, 0); }
    }
}
constexpr int ATT_UNITS = 4096 + 256;
__device__ __forceinline__ void ph_attn(const Ctx& c0, int l) {
    const Ctx c = mk_ctx(c0.lds, c0.ws, c0.wave);
    const GAS bf16_t* P = (const GAS bf16_t*)(c.ws + WS_P); const GAS bf16_t* VT = (const GAS bf16_t*)(c.ws + WS_VT); GAS bf16_t* oatt = (GAS bf16_t*)(c.ws + WS_OAH);
    const GAS float* rpb = inp(c, I_RPB) + (size_t)l * 8 * 15 * 31;
    LAS unsigned char* lds = c.lds;
    for (int i = c.tid; i < 8 * 15 * 32; i += NTHR) { const int hd = i / 480, rem = i % 480, dr = rem >> 5, dc = rem & 31;
        *(LAS float*)(lds + ATT_RPB_OFF + i * 4) = dc < 31 ? rpb[(hd * 15 + dr) * 31 + dc] * 1.4426950408889634f : 0.f; }
    __syncthreads();
    LAS unsigned char* vt = lds + ATT_VT_OFF + c.wave * ATT_VT_BYTES;
    const int lane = c.lane, n = lane & 31, h = lane >> 5;
    if (l < DEPTH - 1) {
        LAS float* opart = (LAS float*)(lds + ATT_VT_OFF + NWAVES * ATT_VT_BYTES);
        LAS float* stat = opart + 8 * 32 * 64;
        for (int uu = c.bid; uu < 256; uu += c.G) {
            const int head = (uu >> 3) & 7, b = uu >> 6, tokq0 = TL + b * 256 + 32 * (uu & 7), tokq = tokq0 + n;
            bf16x8 qf[4];
#pragma unroll
            for (int ks = 0; ks < 4; ++ks) qf[ks] = *(const GAS bf16x8*)(P + (size_t)tokq * PW + PQ + head * 64 + 16 * ks + 8 * h);
            f32x16 ot0, ot1;
#pragma unroll
            for (int q = 0; q < 16; ++q) { ot0[q] = 0.f; ot1[q] = 0.f; }
            float m = -1.0e30f, lsum = 0.f;
            { const int base = TL + b * 256 + 32 * c.wave;
              att_block<2>(P, VT, lds, vt, lane, n, h, head, base + n, base + 4 * (lane & 7), 0, 0, qf, ot0, ot1, m, lsum); }
            const float ltot = lsum + __int_as_float(__builtin_amdgcn_ds_bpermute((lane ^ 32) << 2, __float_as_int(lsum)));
            if (h == 0) { stat[(c.wave * 32 + n) * 2] = m; stat[(c.wave * 32 + n) * 2 + 1] = ltot; }
#pragma unroll
            for (int rq = 0; rq < 4; ++rq) {
                *(LAS f32x4*)(opart + (c.wave * 32 + n) * 64 + 8 * rq + 4 * h) = (f32x4){ot0[4 * rq], ot0[4 * rq + 1], ot0[4 * rq + 2], ot0[4 * rq + 3]};
                *(LAS f32x4*)(opart + (c.wave * 32 + n) * 64 + 32 + 8 * rq + 4 * h) = (f32x4){ot1[4 * rq], ot1[4 * rq + 1], ot1[4 * rq + 2], ot1[4 * rq + 3]}; }
            __syncthreads();
            { const int q = 4 * c.wave + (lane >> 4), d4 = (lane & 15) * 4;
              float mw[8], M = -1.0e30f;
#pragma unroll
              for (int w = 0; w < 8; ++w) { mw[w] = stat[(w * 32 + q) * 2]; M = fmaxf(M, mw[w]); }
              float L = 0.f; f32x4 o = (f32x4){0.f, 0.f, 0.f, 0.f};
#pragma unroll
              for (int w = 0; w < 8; ++w) { const float sc = __builtin_amdgcn_exp2f(mw[w] - M); L += sc * stat[(w * 32 + q) * 2 + 1]; o += *(const LAS f32x4*)(opart + (w * 32 + q) * 64 + d4) * sc; }
              const float inv = __builtin_amdgcn_rcpf(L);
              u32x2 wv; wv.x = cvt_pk_bf16(o[0] * inv, o[1] * inv); wv.y = cvt_pk_bf16(o[2] * inv, o[3] * inv);
              *(GAS u32x2*)(oatt + (size_t)(tokq0 + q) * 1024 + head * 64 + d4) = wv; }
            __syncthreads();
        }
    }
    const int natt = 4096;
    for (int u = c.bid * NWAVES + c.wave; u < natt; u += c.G * NWAVES) {
        const bool lat = u < 4096;
        int b, head, r = 0, hf = 0, tokq;
        if (lat) { hf = u & 1; r = (u >> 1) & 63; head = (u >> 7) & 7; b = u >> 10; tokq = b * 4096 + r * 64 + 32 * hf + n; }
        else { const int uu = u - 4096; head = (uu >> 3) & 7; b = uu >> 6; tokq = TL + b * 256 + 32 * (uu & 7) + n; }
        bf16x8 qf[4];
#pragma unroll
        for (int ks = 0; ks < 4; ++ks) qf[ks] = *(const GAS bf16x8*)(P + (size_t)tokq * PW + PQ + head * 64 + 16 * ks + 8 * h);
        f32x16 ot0, ot1;
#pragma unroll
        for (int q = 0; q < 16; ++q) { ot0[q] = 0.f; ot1[q] = 0.f; }
        float m = -1.0e30f, lsum = 0.f;
        if (lat) {
            const int r0 = min(max(r - 4, 0), 56), lo = hf ? 24 : 0, qc = 32 * hf + n, c0q = min(max(qc - 8, 0), 48);
            for (int kb = 0; kb < 8; ++kb) {
                const int base = b * 4096 + (r0 + kb) * 64 + lo, kx = lo + 4 * h;
                const int tabaddr = ATT_RPB_OFF + (((head * 15 + (r0 + kb - r + 7)) * 32) + kx - qc + 15) * 4;
                att_block<0>(P, VT, lds, vt, lane, n, h, head, base + n, base + 4 * (lane & 7), tabaddr, kx - c0q, qf, ot0, ot1, m, lsum);
            }
            for (int kb = 0; kb < 2; ++kb) {
                const int rowb = b * 4096 + (r0 + 4 * kb) * 64 + lo + 32, kx = lo + 32 + 4 * h, cc = lane & 7;
                const int tabaddr = ATT_RPB_OFF + (((head * 15 + (r0 + 4 * kb - r + 7)) * 32) + kx - qc + 15) * 4;
                att_block<1>(P, VT, lds, vt, lane, n, h, head, rowb + (n >> 3) * 64 + (n & 7), rowb + (cc >> 1) * 64 + 4 * (cc & 1), tabaddr, kx - c0q, qf, ot0, ot1, m, lsum);
            }
        }
        for (int kb = 0; kb < 8; ++kb) { const int base = TL + b * 256 + 32 * kb;
            att_block<2>(P, VT, lds, vt, lane, n, h, head, base + n, base + 4 * (lane & 7), 0, 0, qf, ot0, ot1, m, lsum); }
        const float ltot = lsum + __int_as_float(__builtin_amdgcn_ds_bpermute((lane ^ 32) << 2, __float_as_int(lsum)));
        const float inv = __builtin_amdgcn_rcpf(ltot);
        GAS bf16_t* op = oatt + (size_t)tokq * 1024 + head * 64 + 4 * h;
#pragma unroll
        for (int rq = 0; rq < 4; ++rq) {
            u32x2 w0, w1; w0.x = cvt_pk_bf16(ot0[4 * rq] * inv, ot0[4 * rq + 1] * inv); w0.y = cvt_pk_bf16(ot0[4 * rq + 2] * inv, ot0[4 * rq + 3] * inv);
            w1.x = cvt_pk_bf16(ot1[4 * rq] * inv, ot1[4 * rq + 1] * inv); w1.y = cvt_pk_bf16(ot1[4 * rq + 2] * inv, ot1[4 * rq + 3] * inv);
            *(GAS u32x2*)(op + 8 * rq) = w0; *(GAS u32x2*)(op + 32 + 8 * rq) = w1; }
    }
    __syncthreads();
}

__device__ __forceinline__ void ph_final(const Ctx& c0) {
    const Ctx c = mk_ctx(c0.lds, c0.ws, c0.wave);
    const GAS bf16_t* xres = (const GAS bf16_t*)(c.ws + WS_X); const GAS float* gp = inp(c, I_FINALG); GAS float* outp = (GAS float*)inp(c, 30);
    const MoeComb mc{(const GAS int*)(c.ws + WS_ROUTE), (const GAS float*)(c.ws + WS_RWT), (const GAS bf16_t*)(c.ws + WS_Y), (const GAS float*)(c.ws + WS_MOD) + (size_t)(DEPTH - 1) * 5 * 6144 + 5 * 1024, (const GAS bf16_t*)(c.ws + WS_VT)};
    LAS unsigned* offs = (LAS unsigned*)c.lds + 32;
    moe_offsets(c, 1, offs);
    __syncthreads();
    for (int row = c.bid * NWAVES + c.wave; row < TL; row += c.G * NWAVES) {
        const GAS bf16_t* src = xres + (size_t)row * D; f32x4 v[4]; float ss = 0.f;
#pragma unroll
        for (int j = 0; j < 4; ++j) { const u32x2 t = *(const GAS u32x2*)(src + 4 * (c.lane + 64 * j)); v[j] = (f32x4){bflo(t.x), bfhi(t.x), bflo(t.y), bfhi(t.y)}; }
        moe_combine_row(mc, offs, row, row >> 12, c.lane, v);
#pragma unroll
        for (int j = 0; j < 4; ++j) ss += (v[j][0] * v[j][0] + v[j][1] * v[j][1]) + (v[j][2] * v[j][2] + v[j][3] * v[j][3]);
        ss = wave_sum(ss, c.lane);
        const float rstd = 1.f / sqrtf(ss * (1.f / D) + EPS);
#pragma unroll
        for (int j = 0; j < 4; ++j) { const int k0 = 4 * (c.lane + 64 * j); const f32x4 g4 = *(const GAS f32x4*)(gp + k0); *(GAS f32x4*)(outp + (size_t)row * D + k0) = v[j] * rstd * g4; }
    }
}

constexpr int MOE_OFF = 132096;
__device__ __forceinline__ unsigned moe_split0(unsigned offs7, unsigned total) { const unsigned ts = (total - offs7) >> 8; return (ts == 0u || ts > 128u) ? total : offs7; }
template <bool GATHER_, bool SPLIT_ = false> struct MoeOrder {
    static constexpr bool GATHER = GATHER_, VARK = SPLIT_;
    int nM, nN, nwg, G, c; const GAS char* A; const GAS char* B; size_t astep, bstep, estep; const GAS int* tokenof; const LAS unsigned* tab;
    int ts, tsn, ntfull; size_t khalf;
    __device__ void init(const GAS void* A_, int lda, const GAS void* B_, int ldb, size_t estep_bytes, int N, int G_, int c_, const GAS int* tok, const LAS unsigned* tab_, int K = 0) {
        tab = tab_; const unsigned total = (unsigned)__builtin_amdgcn_readfirstlane(tab[8]); nM = (int)(total >> 8); nN = N / pg8::BM; G = G_; c = c_; A = (const GAS char*)A_; B = (const GAS char*)B_;
        ts = 0; tsn = 0; ntfull = K / pg8::BK; khalf = (size_t)K;
        if constexpr (SPLIT_) { const int fp = (int)(moe_split0((unsigned)__builtin_amdgcn_readfirstlane(tab[7]), total) >> 8); ts = nM - fp; tsn = ts * nN; nM = fp; }
        nwg = nM * nN;
        astep = (size_t)pg8::BM * lda * 2; bstep = (size_t)pg8::BM * ldb * 2; estep = estep_bytes; tokenof = tok; }
    __device__ bool next(int i, pg8::Unit& u) const {
        const long L = (long)i * G + c; size_t koff = 0;
        if (L < nwg) {
            int wgid = (int)L; { const int q = nwg / pg8::NXCD, r = nwg % pg8::NXCD, xcd = wgid % pg8::NXCD, off = wgid / pg8::NXCD; wgid = (xcd < r ? xcd * (q + 1) : r * (q + 1) + (xcd - r) * q) + off; }
            const int nig = pg8::WGM * nN, gid = wgid / nig, fm = gid * pg8::WGM, gsz = (nM - fm) < pg8::WGM ? (nM - fm) : pg8::WGM;
            u.pm = fm + ((wgid % nig) % gsz); u.pn = (wgid % nig) / gsz; u.nt = ntfull; u.part = 0;
        } else {
            if constexpr (!SPLIT_) return false;
            int j = (int)(L - nwg); if (j >= 2 * tsn) return false;
            u.part = j >= tsn ? 1 : 0; if (u.part) j -= tsn;
            u.pm = nM + j % ts; u.pn = j / ts; u.nt = ntfull >> 1; koff = u.part ? khalf : 0;
        }
        const unsigned slot0 = (unsigned)u.pm << 8; int e = 0;
#pragma unroll
        for (int j = 1; j < 8; ++j) e += (slot0 >= (unsigned)__builtin_amdgcn_readfirstlane(tab[j])) ? 1 : 0;
        const unsigned pos0 = slot0 - (unsigned)__builtin_amdgcn_readfirstlane(tab[e]), cnt = (unsigned)__builtin_amdgcn_readfirstlane(tab[16 + e]);
        u.nvalid = cnt > pos0 ? (int)(cnt - pos0) : 0; u.tk = tokenof + (size_t)e * T + pos0;
        u.a = GATHER ? A : A + (size_t)u.pm * astep + koff; u.b = B + (size_t)e * estep + (size_t)u.pn * bstep + koff; return true;
    }
    __device__ __forceinline__ int arow(const pg8::Unit& u, int r) const { return r < u.nvalid ? u.tk[r] : 0; }
    __device__ __forceinline__ void a_ready(const pg8::Unit&) const {}
    __device__ __forceinline__ void done(const pg8::Unit&) const {}
};
__device__ __forceinline__ void moe_table(const Ctx& c, int i) {
    LAS unsigned* tab = (LAS unsigned*)(c.lds + MOE_OFF);
    if (c.tid == 0) { const GAS unsigned* cnt = (const GAS unsigned*)(c.ws + WS_CTL) + CW_CNT + 64 * i; unsigned o = 0;
        for (int e = 0; e < 8; ++e) { const unsigned ce = cnt[e]; tab[e] = o; tab[16 + e] = ce; o += (ce + 255u) & ~255u; } tab[8] = o; }
    __syncthreads();
}

#define XB_TMO      128
#define XB_XCNT(j)  (256  + 64 * (j))
#define XB_XSUB(j)  (1280 + 64 * (j))
#define XB_XGEN(j)  (2304 + 64 * (j))
#define XB_TOP      3328
#define XB_TOPGEN   3392
#define XCD_BAR_WORDS 3456
#define XB_SPIN_CAP (1u << 18)
__device__ __forceinline__ unsigned xb_ld(GAS unsigned* p)              { return __hip_atomic_load(p, __ATOMIC_RELAXED, __HIP_MEMORY_SCOPE_AGENT); }
__device__ __forceinline__ unsigned xb_add(GAS unsigned* p, unsigned v) { return __hip_atomic_fetch_add(p, v, __ATOMIC_RELAXED, __HIP_MEMORY_SCOPE_AGENT); }
__device__ __forceinline__ unsigned xb_xcc_id() { return (unsigned)__builtin_amdgcn_s_getreg((3 << 11) | 20) & 0xFu; }
#define XB_SPIN(cond, bar) do { unsigned _sp = 0; while (cond) { __builtin_amdgcn_s_sleep(1); \
    if ((++_sp & 255u) == 0u) { if (xb_ld(&(bar)[XB_TMO])) break; if (_sp > XB_SPIN_CAP) { (void)xb_add(&(bar)[XB_TMO], 1u); break; } } } } while (0)
struct XcdBarrier { GAS unsigned* bar; unsigned x; volatile LAS unsigned* st; int wave; };
__device__ __forceinline__ XcdBarrier xcd_barrier_post(GAS unsigned* bar, volatile LAS unsigned* st) {
    XcdBarrier b; b.bar = bar; b.x = xb_xcc_id(); b.st = st; b.wave = __builtin_amdgcn_readfirstlane(threadIdx.x >> 6);
    if (threadIdx.x == 0) (void)xb_add(&bar[XB_XCNT(b.x)], 1u);
    return b;
}
__device__ __forceinline__ void xcd_barrier_complete(GAS unsigned* bar, unsigned x, unsigned& nloc, unsigned& nx) {
    const unsigned G = gridDim.x * gridDim.y * gridDim.z;
    unsigned sum, cnt, mine, sp = 0u;
    for (;;) {
        sum = 0u; cnt = 0u; mine = 0u;
#pragma unroll
        for (unsigned j = 0; j < 16; ++j) { const unsigned c = xb_ld(&bar[XB_XCNT(j)]); sum += c; cnt += (c > 0u) ? 1u : 0u; mine = (j == x) ? c : mine; }
        if (sum == G) break;
        __builtin_amdgcn_s_sleep(1);
        if ((++sp & 255u) == 0u) { if (xb_ld(&bar[XB_TMO])) break; if (sp > XB_SPIN_CAP) { (void)xb_add(&bar[XB_TMO], 1u); break; } }
    }
    nloc = mine > 0u ? mine : 1u; nx = cnt > 0u ? cnt : 1u;
}
__device__ __forceinline__ void xcd_barrier(const XcdBarrier& b) {
    asm volatile("s_waitcnt vmcnt(0)" ::: "memory");
    __syncthreads();
    if (cur_tid(b.wave) == 0) {
        GAS unsigned* bar = b.bar; asm volatile("" : "+s"(bar));     const unsigned bx = xb_xcc_id();
        __builtin_amdgcn_s_waitcnt(0);
        unsigned nloc = b.st[0], nx = b.st[1];
        if (nloc == 0u) { xcd_barrier_complete(bar, bx, nloc, nx); b.st[0] = nloc; b.st[1] = nx; }
        const unsigned old = xb_add(&bar[XB_XSUB(bx)], 1u);
        const unsigned gen = old / nloc;
        if (old + 1u == (gen + 1u) * nloc) {
            __builtin_amdgcn_fence(__ATOMIC_RELEASE, "agent");
            asm volatile("s_waitcnt vmcnt(0)" ::: "memory");
            const unsigned og = xb_add(&bar[XB_TOP], 1u);
            const unsigned tg = og / nx;
            if (og + 1u == (tg + 1u) * nx) xb_add(&bar[XB_TOPGEN], 1u);
            else XB_SPIN(xb_ld(&bar[XB_TOPGEN]) == tg, bar);
            __builtin_amdgcn_fence(__ATOMIC_ACQUIRE, "agent");
            xb_add(&bar[XB_XGEN(bx)], 1u);
            asm volatile("s_waitcnt vmcnt(0)" ::: "memory");
        } else {
            XB_SPIN(xb_ld(&bar[XB_XGEN(bx)]) == gen, bar);
            __builtin_amdgcn_fence(__ATOMIC_ACQUIRE, "agent");
            asm volatile("s_waitcnt vmcnt(0)" ::: "memory");
        }
    }
    __syncthreads();
}

__device__ __forceinline__ void split_arrive(GAS unsigned* cnt, int wave);
struct InOrder {
    static constexpr bool GATHER = false, VARK = false;
    int nM, nN, na, p0, G, c, arrive_i, wave; const GAS char* A; const GAS char* B; size_t astep, bstep; GAS unsigned* cnt;
    __device__ void init(const GAS void* A_, int lda, const GAS void* B_, int ldb, int M, int N, int G_, int c_, int p0_, int na_, GAS unsigned* cnt_, int wave_) {
        nM = M / pg8::BM; nN = N / pg8::BM; na = na_; p0 = p0_; G = G_; c = c_; A = (const GAS char*)A_; B = (const GAS char*)B_; astep = (size_t)pg8::BM * lda * 2; bstep = (size_t)pg8::BM * ldb * 2;
        cnt = cnt_; wave = wave_; arrive_i = (nM * na - 1) / G; }
    __device__ static void map(int L, int nwg, int nM, int nN, int& pm, int& pn) {
        int wgid = L; { const int q = nwg / pg8::NXCD, r = nwg % pg8::NXCD, xcd = wgid % pg8::NXCD, off = wgid / pg8::NXCD; wgid = (xcd < r ? xcd * (q + 1) : r * (q + 1) + (xcd - r) * q) + off; }
        const int nig = pg8::WGM * nN, gid = wgid / nig, fm = gid * pg8::WGM, gsz = (nM - fm) < pg8::WGM ? (nM - fm) : pg8::WGM;
        pm = fm + ((wgid % nig) % gsz); pn = (wgid % nig) / gsz; }
    __device__ bool next(int i, pg8::Unit& u) const {
        const long L = (long)i * G + c; if (L >= (long)nM * nN) return false;
        const int nwa = nM * na; int pm, pn;
        if (L < nwa) { map((int)L, nwa, nM, na, pm, pn); pn += p0; } else { map((int)L - nwa, nM * (nN - na), nM, nN - na, pm, pn); pn = pn < p0 ? pn : pn + na; }
        u.pm = pm; u.pn = pn; u.nvalid = i; u.a = A + (size_t)pm * astep; u.b = B + (size_t)pn * bstep; return true; }
    __device__ int nunits() const { const int nwg = nM * nN; return c < nwg ? (nwg - c + G - 1) / G : 0; }
    __device__ __forceinline__ int arow(const pg8::Unit&, int) const { return 0; }
    __device__ __forceinline__ void a_ready(const pg8::Unit&) const {}
    __device__ __forceinline__ void done(const pg8::Unit& u) const { if (u.nvalid == arrive_i) split_arrive(cnt, wave); }
};

constexpr int CW_HY = 16384;
__device__ __forceinline__ void split_arrive(GAS unsigned* cnt, int wave) {
    asm volatile("s_waitcnt vmcnt(0)" ::: "memory");
    __syncthreads();
    if (cur_tid(wave) == 0) { __builtin_amdgcn_fence(__ATOMIC_RELEASE, "agent"); asm volatile("s_waitcnt vmcnt(0)" ::: "memory"); (void)xb_add(cnt, 1u); }
}
__device__ __forceinline__ void split_wait(GAS unsigned* cnt, GAS unsigned* bar, int wave) {
    asm volatile("s_waitcnt vmcnt(0)" ::: "memory");
    __syncthreads();
    if (cur_tid(wave) == 0) { const unsigned G = gridDim.x; asm volatile("" : "+s"(bar));
        XB_SPIN(xb_ld(cnt) < G, bar);
        __builtin_amdgcn_fence(__ATOMIC_ACQUIRE, "agent"); asm volatile("s_waitcnt vmcnt(0)" ::: "memory"); }
    __syncthreads();
}

constexpr int CW_BAR = 4096;

__global__ void __launch_bounds__(NTHR, 2) fwd(Args args) {
    extern __shared__ __attribute__((aligned(16))) unsigned char lds_raw[];
    Ctx c; c.lds = (LAS unsigned char*)lds_raw; c.tid = threadIdx.x; c.lane = c.tid & 63; c.wave = __builtin_amdgcn_readfirstlane(c.tid >> 6); c.G = gridDim.x; c.bid = blockIdx.x; c.ws = (GAS unsigned char*)args.ws;
    GAS unsigned char* ws = (GAS unsigned char*)args.ws;
    volatile LAS unsigned* MISC = (volatile LAS unsigned*)(c.lds + MISC_OFF);
    if (c.tid < 32) MISC[c.tid] = 0u;
    if (c.tid < 31) { const unsigned long long pv = c.tid < 30 ? (unsigned long long)args.in[c.tid] : (unsigned long long)args.out;
        volatile LAS unsigned* pt = (volatile LAS unsigned*)(c.lds + PTR_OFF) + 2 * c.tid; pt[0] = (unsigned)pv; pt[1] = (unsigned)(pv >> 32); }
    __syncthreads();
    XcdBarrier bar = xcd_barrier_post((GAS unsigned*)(ws + WS_CTL) + CW_BAR, MISC + 8);
#define GRID_BAR() xcd_barrier(bar)
#ifndef PROFILE_ID
#define PROFILE_ID (-1)
#endif
#define PROF(id) do { if (PROFILE_ID >= 0 && blockIdx.x == 0 && threadIdx.x == 0) { const unsigned long long t_ = __builtin_amdgcn_s_memrealtime(); \
        volatile LAS unsigned* q_ = MISC + 16; const unsigned long long prev_ = ((unsigned long long)q_[1] << 32) | q_[0]; \
        if ((id) == PROFILE_ID) { const unsigned long long a_ = (((unsigned long long)q_[3] << 32) | q_[2]) + (t_ - prev_); q_[2] = (unsigned)a_; q_[3] = (unsigned)(a_ >> 32); } \
        q_[0] = (unsigned)t_; q_[1] = (unsigned)(t_ >> 32); } } while (0)
    PROF(99);

    {
        int crank = c.bid, cn = c.G, fl0 = 0, fl1 = DEPTH, frank = c.bid, fn = c.G, mrank = c.bid, mn = c.G;
        if (c.G == 256) { const int x = c.bid & 7, j = c.bid >> 3;
            if (j < 12) { const int f = j * 8 + x; crank = -1; fl0 = f & 3; fl1 = fl0 + 1; frank = f >> 2; fn = 24; mrank = f; mn = 96; }
            else { crank = (j - 12) * 8 + x; cn = 160; fl1 = 0; mrank = -1; } }
        ph_convert(c, crank, cn); __syncthreads();
        for (int fl = fl0; fl < fl1; ++fl) { ph_filt(c, fl, frank, fn); __syncthreads(); }
        ph_mod(c, mrank, mn); }
    GRID_BAR(); PROF(0);
    const int cperm = (c.G == 256) ? ((c.bid >> 3) & 7) * 32 + (c.bid >> 6) * 8 + (c.bid & 7) : c.bid;
    for (int l = 0; l < DEPTH; ++l) {
        ph_norm(c, l, 0);
        GRID_BAR(); PROF(1);
        {   GAS unsigned char* ws = c.ws; asm volatile("" : "+s"(ws));
            GAS unsigned* scc = (GAS unsigned*)(ws + WS_CTL) + CW_HY + 64 * (DEPTH + l);
            pg8::Gemm g{D, D, D, STAG}; InOrder S; S.init(ws + WS_H, D, (GAS bf16_t*)(ws + WS_WIN) + (size_t)l * PW * D, D, T, PW, c.G, cperm, PV / 256, (PGA - PV) / 256, scc, c.wave);
            EpiStoreIn E{(GAS bf16_t*)(ws + WS_P), (GAS unsigned char*)(ws + WS_G8)};
            pg8::gemm_phase(c.lds, g, S, E, c.wave);
            if (S.nunits() <= S.arrive_i) split_arrive(scc, c.wave);
            split_wait(scc, (GAS unsigned*)(ws + WS_CTL) + CW_BAR, c.wave); PROF(2); }
        {
            constexpr int NO = (T / 64) * 4, NWG = (T / 256) * (PW / 256); const int tail = NWG % c.G; int o0, os, oc;
            if (tail > 0 && 2 * tail <= c.G && 2 * tail <= NO) { const int rest = NO - 2 * tail, ni = c.G - tail, q = rest / ni, r = rest % ni;
                if (cperm < tail) { o0 = 2 * cperm; oc = 2; } else { const int ci = cperm - tail; o0 = 2 * tail + q * ci + (ci < r ? ci : r); oc = q + (ci < r ? 1 : 0); } os = 1; }
            else { o0 = c.bid; os = c.G; oc = c.bid < NO ? (NO - c.bid + c.G - 1) / c.G : 0; }
            ph_sc(c, l, o0, os, oc); }
        GRID_BAR(); PROF(3);
        {   GAS unsigned* hyc = (GAS unsigned*)(c.ws + WS_CTL) + CW_HY + 64 * l;
            ph_hyena(c, l); split_arrive(hyc, c.wave);
            ph_attn(c, l); split_wait(hyc, (GAS unsigned*)(c.ws + WS_CTL) + CW_BAR, c.wave); PROF(4);
            ph_ohy_t(c); }
        GRID_BAR(); PROF(5);
        {   GAS unsigned char* ws = c.ws; asm volatile("" : "+s"(ws));
            const GAS bf16_t* wab = (const GAS bf16_t*)(ws + WS_WPAB) + (size_t)l * D * D;
            pg8::Gemm g{D, D, D}; pg8::StaticOrder S; S.init(ws + WS_OAH, D, wab, D, TL, D, c.G, c.bid);
            EpiMergeK E{(const GAS unsigned char*)(ws + WS_G8), (GAS bf16_t*)(ws + WS_H)};
            pg8::gemm_phase(c.lds, g, S, E, c.wave);
            if (l < DEPTH - 1) ctx_gemm(c.lds, c.wave, (const GAS bf16_t*)(ws + WS_OAH), D, wab, D, D, CEpiMergeK{(const GAS unsigned char*)(ws + WS_G8), (GAS bf16_t*)(ws + WS_H)}); }
        GRID_BAR(); PROF(6);
        {   GAS unsigned char* ws = c.ws; asm volatile("" : "+s"(ws));
            const GAS float* modl = (const GAS float*)(ws + WS_MOD) + (size_t)l * 5 * 6144;
            pg8::Gemm g{D, D, D}; pg8::StaticOrder S; S.init(ws + WS_H, D, (GAS bf16_t*)(ws + WS_WO) + (size_t)l * D * D, D, TL, D, c.G, c.bid);
            EpiResid E{(GAS bf16_t*)(ws + WS_X), modl + 2 * 1024};
            pg8::gemm_phase(c.lds, g, S, E, c.wave);
            if (l < DEPTH - 1) ctx_gemm(c.lds, c.wave, (const GAS bf16_t*)(ws + WS_H), D, (const GAS bf16_t*)(ws + WS_WO) + (size_t)l * D * D, D, D, CEpiResid{(GAS bf16_t*)(ws + WS_X), modl + 4 * 6144 + 2 * 1024}); }
        GRID_BAR(); PROF(7);
        ph_norm(c, l, 1);
        GRID_BAR(); PROF(8);
        if ((l & 1) == 0) {
            {   GAS unsigned char* ws = c.ws; asm volatile("" : "+s"(ws));
                const GAS bf16_t* w = (const GAS bf16_t*)(ws + WS_W13D) + (size_t)(l >> 1) * 2 * FF * D;
                pg8::Gemm g{D, D, D, STAG}; pg8::StaticOrder S; S.init(ws + WS_H, D, w, D, T, 2 * FF, c.G, cperm);
                EpiSwiglu E{(GAS bf16_t*)(ws + WS_P)};
                pg8::gemm_phase(c.lds, g, S, E, c.wave); }
            GRID_BAR(); PROF(9);
            {   GAS unsigned char* ws = c.ws; asm volatile("" : "+s"(ws));
                const GAS float* modl = (const GAS float*)(ws + WS_MOD) + (size_t)l * 5 * 6144;
                const GAS bf16_t* w = (const GAS bf16_t*)(ws + WS_W2D) + (size_t)(l >> 1) * D * FF;
                pg8::Gemm g{FF, FF, FF}; pg8::StaticOrder S; S.init(ws + WS_P, FF, w, FF, TL, D, c.G, c.bid);
                EpiResid E{(GAS bf16_t*)(ws + WS_X), modl + 5 * 1024};
                pg8::gemm_phase(c.lds, g, S, E, c.wave);
                ctx_gemm(c.lds, c.wave, (const GAS bf16_t*)(ws + WS_P), FF, w, FF, FF, CEpiResid{(GAS bf16_t*)(ws + WS_X), modl + 4 * 6144 + 5 * 1024}); }
            GRID_BAR(); PROF(10);
        } else {
            const Ctx cm = mk_ctx(c.lds, c.ws, c.wave);
            moe_table(cm, l >> 1);
            {   GAS unsigned char* ws = c.ws; asm volatile("" : "+s"(ws));
                const GAS bf16_t* w = (const GAS bf16_t*)(ws + WS_W13M) + (size_t)((l >> 1) * NE) * 2 * FF * D;
                pg8::Gemm g{D, D, D, STAG}; MoeOrder<true> S; S.init(ws + WS_H, D, w, D, (size_t)2 * FF * D * 2, 2 * FF, c.G, cperm, (const GAS int*)(ws + WS_TOK), (const LAS unsigned*)(c.lds + MOE_OFF));
                EpiSwiglu E{(GAS bf16_t*)(ws + WS_P)};
                pg8::gemm_phase(c.lds, g, S, E, c.wave); }
            GRID_BAR(); PROF(11);
            {   GAS unsigned char* ws = c.ws; asm volatile("" : "+s"(ws));
                const GAS bf16_t* w = (const GAS bf16_t*)(ws + WS_W2M) + (size_t)((l >> 1) * NE) * D * FF;
                pg8::Gemm g{FF, FF, FF, STAG}; MoeOrder<false, true> S; S.init(ws + WS_P, FF, w, FF, (size_t)D * FF * 2, D, c.G, cperm, (const GAS int*)(ws + WS_TOK), (const LAS unsigned*)(c.lds + MOE_OFF), FF);
                EpiStoreY E{(GAS bf16_t*)(ws + WS_Y), (GAS bf16_t*)(ws + WS_VT), S.nM};
                pg8::gemm_phase(c.lds, g, S, E, c.wave); }
            GRID_BAR(); PROF(12);
        }
    }
    ph_final(c);
    if (PROFILE_ID >= 0 && blockIdx.x == 0) {
        if (threadIdx.x == 0) { PROF(13); volatile LAS unsigned* q_ = MISC + 16; const unsigned long long a_ = ((unsigned long long)q_[3] << 32) | q_[2], t0_ = __builtin_amdgcn_s_memrealtime();
            while (__builtin_amdgcn_s_memrealtime() - t0_ < a_) __builtin_amdgcn_s_sleep(8); }
        __syncthreads();
    }
}

extern "C" void kernel_launch(void* const* d_in, const int* in_sizes, int n_in, void* d_out, int out_size, void* d_ws, size_t ws_size, hipStream_t stream) {
    static int grid = 0;
    if (grid == 0) {
        if (n_in != 30 || out_size != TL * D || ws_size < WS_END) { fprintf(stderr, "kernel_launch: unexpected shapes (n_in %d out %d ws %zu)\n", n_in, out_size, ws_size); grid = -1; return; }
        int dev = 0, cus = 0, per_cu = 0; (void)hipGetDevice(&dev); (void)hipDeviceGetAttribute(&cus, hipDeviceAttributeMultiprocessorCount, dev);
        if (hipFuncSetAttribute((const void*)fwd, hipFuncAttributeMaxDynamicSharedMemorySize, LDS_BYTES) != hipSuccess) { fprintf(stderr, "kernel_launch: hipFuncSetAttribute failed\n"); grid = -1; return; }
        if (hipOccupancyMaxActiveBlocksPerMultiprocessor(&per_cu, (const void*)fwd, NTHR, LDS_BYTES) != hipSuccess || per_cu < 1) fprintf(stderr, "kernel_launch: occupancy query reports %d\n", per_cu);
        (void)hipGetLastError();
        grid = cus > 0 ? cus : 256;
    }
    if (grid < 0) return;
    (void)hipMemsetAsync((char*)d_ws + WS_CTL, 0, CTL_ZERO_BYTES, stream);
    Args a{};
    for (int i = 0; i < 30; ++i) a.in[i] = (const float*)d_in[i];
    a.out = (float*)d_out; a.ws = (unsigned char*)d_ws;
    hipLaunchKernelGGL(fwd, dim3(grid), dim3(NTHR), LDS_BYTES, stream, a);
}
```
